# Optimizing an MI355X kernel written in HIP

```python
import math
import jax, jax.numpy as jnp
from jax import lax
import numpy as np

D_MODEL = 1024
BATCH = 32
SEQ = 2048
DEPTH = 1

CTX_LEN = 256
GRID_W = 64
D_INNER = 2 * D_MODEL
ATTN_WIDTH = D_INNER // 2
SSD_WIDTH = D_INNER - ATTN_WIDTH
HEAD_DIM = 64
N_Q_HEADS = ATTN_WIDTH // HEAD_DIM
N_KV_HEADS = 4
Q_PER_KV = N_Q_HEADS // N_KV_HEADS
KV_WIDTH = N_KV_HEADS * HEAD_DIM
SSD_HEAD_DIM = 64
SSD_HEADS = SSD_WIDTH // SSD_HEAD_DIM
SSD_GROUPS = 2
SSD_HEADS_PER_GROUP = SSD_HEADS // SSD_GROUPS
D_STATE = 128
GN = SSD_GROUPS * D_STATE
D_CONV = 5
CHUNK = 128
Q_BLOCK = 128
ROPE_THETA = 10000.0
ATTN_SCALE = HEAD_DIM ** -0.5
EPS = 1e-6
CONV_CH = SSD_WIDTH + 2 * GN
OFF_V = KV_WIDTH
OFF_XBC = 2 * KV_WIDTH
OFF_DT = OFF_XBC + CONV_CH
CTX_COLS = OFF_DT + 2 * SSD_HEADS
PROJ_COLS = CTX_COLS + 2 * ATTN_WIDTH + SSD_WIDTH

kernel_name = "hymba_ssd_gqa_axial_dit_layer"


def rms_norm(x, g):
    xf = x.astype(jnp.float32)
    y = xf * lax.rsqrt(jnp.mean(xf * xf, axis=-1, keepdims=True) + EPS)
    return (y * g.astype(jnp.float32)).astype(x.dtype)


def axial_rope(x):
    L = x.shape[1]
    rows = L // GRID_W
    row, col = jnp.meshgrid(jnp.arange(rows, dtype=jnp.float32),
                            jnp.arange(GRID_W, dtype=jnp.float32), indexing="ij")
    n_freq = HEAD_DIM // 4
    inv_freq = ROPE_THETA ** (-jnp.arange(n_freq, dtype=jnp.float32) / n_freq)
    ang = jnp.stack([row.reshape(-1)[:, None] * inv_freq,
                     col.reshape(-1)[:, None] * inv_freq], axis=1)
    cos = jnp.cos(ang)[:, None].astype(x.dtype)
    sin = jnp.sin(ang)[:, None].astype(x.dtype)
    xr = x.reshape(*x.shape[:3], 2, 2, n_freq)
    x1, x2 = xr[..., 0, :], xr[..., 1, :]
    out = jnp.stack([x1 * cos - x2 * sin, x2 * cos + x1 * sin], axis=-2)
    return out.reshape(x.shape)


def dwconv_centred(u, w, b):
    pad = D_CONV // 2
    y = lax.conv_general_dilated(u, w[:, None, :].astype(u.dtype), window_strides=(1,),
                                 padding=[(pad, pad)], dimension_numbers=("NWC", "WIO", "NWC"),
                                 feature_group_count=u.shape[-1])
    return y + b


def ssd_inputs(xbc_raw, dt_raw, conv_w, conv_b, dt_bias):
    bsz, L = xbc_raw.shape[:2]
    xbc = jax.nn.silu(dwconv_centred(xbc_raw, conv_w, conv_b))
    xs = xbc[..., :SSD_WIDTH].reshape(bsz, L, SSD_HEADS, SSD_HEAD_DIM)
    bm = xbc[..., SSD_WIDTH:SSD_WIDTH + GN].reshape(bsz, L, SSD_GROUPS, D_STATE)
    cm = xbc[..., SSD_WIDTH + GN:].reshape(bsz, L, SSD_GROUPS, D_STATE)
    dt = jax.nn.softplus(dt_raw.reshape(bsz, L, 2, SSD_HEADS).astype(jnp.float32) + dt_bias)
    return xs, bm, cm, dt


def ssd_scan(xs, dt, a_neg, b_in, c_in, init_state, want_y):
    bsz, L = xs.shape[:2]
    nc = L // CHUNK
    X = (xs * dt[..., None]).reshape(bsz, nc, CHUNK, SSD_GROUPS, SSD_HEADS_PER_GROUP, SSD_HEAD_DIM)
    a = (dt * a_neg).reshape(bsz, nc, CHUNK, SSD_GROUPS, SSD_HEADS_PER_GROUP)
    a_cs = jnp.cumsum(jnp.transpose(a, (0, 3, 4, 1, 2)), axis=-1)
    bc = b_in.reshape(bsz, nc, CHUNK, SSD_GROUPS, D_STATE)
    cc = c_in.reshape(bsz, nc, CHUNK, SSD_GROUPS, D_STATE)
    decay_to_end = jnp.exp(a_cs[..., -1:] - a_cs)
    chunk_states = jnp.einsum("bcsgn,bgrcs,bcsgrp->bcgrpn", bc, decay_to_end, X)
    chunk_decay = jnp.exp(a_cs[..., -1])

    def step(state, inp):
        st, dec = inp
        return state * dec[..., None, None] + st, state

    final, entering = lax.scan(step, init_state.astype(chunk_states.dtype),
                               (jnp.moveaxis(chunk_states, 1, 0), jnp.moveaxis(chunk_decay, -1, 0)))
    if not want_y:
        return None, final
    entering = jnp.moveaxis(entering, 0, 1)
    tril = jnp.tril(jnp.ones((CHUNK, CHUNK), dtype=bool))
    seg = a_cs[..., :, None] - a_cs[..., None, :]
    lmat = jnp.exp(jnp.where(tril, seg, -jnp.inf))
    cb = jnp.einsum("bclgn,bcsgn->bgcls", cc, bc)
    y_diag = jnp.einsum("bgrcls,bcsgrp->bclgrp", cb[:, :, None] * lmat, X)
    y_off = jnp.einsum("bclgn,bgrcl,bcgrpn->bclgrp", cc, jnp.exp(a_cs), entering)
    y = (y_diag + y_off).reshape(bsz, L, SSD_HEADS, SSD_HEAD_DIM)
    return y, final


def bidir_ssd(ssd_c, ssd_l, a_neg, want_ctx_y):
    xs_c, b_c, c_c, dt_c = ssd_c
    xs_l, b_l, c_l, dt_l = ssd_l
    bsz = xs_l.shape[0]
    zero = jnp.zeros((bsz, SSD_GROUPS, SSD_HEADS_PER_GROUP, SSD_HEAD_DIM, D_STATE), jnp.float32)
    y_l = 0.0
    y_c = 0.0 if want_ctx_y else None
    for d in range(2):
        fl = (lambda t: jnp.flip(t, axis=1)) if d == 1 else (lambda t: t)
        yc, s_ctx = ssd_scan(fl(xs_c), fl(dt_c[:, :, d]), a_neg[d], fl(b_c), fl(c_c), zero, want_ctx_y)
        yl, _ = ssd_scan(fl(xs_l), fl(dt_l[:, :, d]), a_neg[d], fl(b_l), fl(c_l), s_ctx, True)
        y_l = y_l + fl(yl)
        if want_ctx_y:
            y_c = y_c + fl(yc)
    return y_l, y_c


def gqa_dense(q, k, v):
    bsz, lq = q.shape[:2]
    qg = q.reshape(bsz, lq, N_KV_HEADS, Q_PER_KV, HEAD_DIM)
    s = jnp.einsum("bqkrd,bskd->bkrqs", qg, k, preferred_element_type=jnp.float32) * ATTN_SCALE
    p = jax.nn.softmax(s, axis=-1).astype(v.dtype)
    o = jnp.einsum("bkrqs,bskd->bqkrd", p, v)
    return o.reshape(bsz, lq, ATTN_WIDTH)


def blocked_attention(q, k, v):
    bsz, L = q.shape[:2]
    nb = L // Q_BLOCK
    qb = jnp.moveaxis(q.reshape(bsz, nb, Q_BLOCK, N_Q_HEADS, HEAD_DIM), 1, 0)
    o = lax.map(lambda qi: gqa_dense(qi, k, v), qb)
    return jnp.moveaxis(o, 0, 1).reshape(bsz, L, ATTN_WIDTH)


def split_ctx_cols(p):
    k = p[..., :OFF_V]
    v = p[..., OFF_V:OFF_XBC]
    xbc = p[..., OFF_XBC:OFF_DT]
    dt = p[..., OFF_DT:CTX_COLS]
    return k, v, xbc, dt


def split_query_cols(p):
    q = p[..., CTX_COLS:CTX_COLS + ATTN_WIDTH]
    g_attn = p[..., CTX_COLS + ATTN_WIDTH:CTX_COLS + 2 * ATTN_WIDTH]
    z = p[..., CTX_COLS + 2 * ATTN_WIDTH:]
    return q, g_attn, z


def merge_heads(o_attn, g_attn, y_ssd, z, ssd_norm_g, w_out):
    y_a = o_attn * jax.nn.silu(g_attn)
    y_s = rms_norm(y_ssd * jax.nn.silu(z), ssd_norm_g)
    return jnp.concatenate([y_a, y_s], axis=-1) @ w_out


def hybrid_layer(x_lat, x_ctx, c, c_ctx, ada_w, ada_b, norm_g, w_in, conv_w, conv_b, dt_bias,
                 a_log, d_skip, q_norm_g, k_norm_g, ssd_norm_g, w_out, ctx_out):
    bsz, L = x_lat.shape[:2]
    lc = x_ctx.shape[1]
    mod_l = jax.nn.silu(c) @ ada_w + ada_b
    mod_c = jax.nn.silu(c_ctx) @ ada_w + ada_b
    sh_l, sc_l, g_l = jnp.split(mod_l[:, None, :], 3, axis=-1)
    sh_c, sc_c, g_c = jnp.split(mod_c, 3, axis=-1)
    h_l = rms_norm(x_lat, norm_g) * (1 + sc_l) + sh_l
    h_c = rms_norm(x_ctx, norm_g) * (1 + sc_c) + sh_c
    p_l = h_l @ w_in
    p_c = h_c @ (w_in if ctx_out else w_in[:, :CTX_COLS])
    k_l, v_l, xbc_l, dt_l = split_ctx_cols(p_l)
    k_c, v_c, xbc_c, dt_c = split_ctx_cols(p_c)
    q_l, ga_l, z_l = split_query_cols(p_l)

    k_l = axial_rope(rms_norm(k_l.reshape(bsz, L, N_KV_HEADS, HEAD_DIM), k_norm_g))
    k_c = rms_norm(k_c.reshape(bsz, lc, N_KV_HEADS, HEAD_DIM), k_norm_g)
    v_l = v_l.reshape(bsz, L, N_KV_HEADS, HEAD_DIM)
    v_c = v_c.reshape(bsz, lc, N_KV_HEADS, HEAD_DIM)
    q_l = axial_rope(rms_norm(q_l.reshape(bsz, L, N_Q_HEADS, HEAD_DIM), q_norm_g))
    o_l = blocked_attention(q_l, jnp.concatenate([k_l, k_c], axis=1), jnp.concatenate([v_l, v_c], axis=1))

    ssd_c = ssd_inputs(xbc_c, dt_c, conv_w, conv_b, dt_bias)
    ssd_l = ssd_inputs(xbc_l, dt_l, conv_w, conv_b, dt_bias)
    a_neg = -jnp.exp(a_log.astype(jnp.float32))
    y_l, y_c = bidir_ssd(ssd_c, ssd_l, a_neg, ctx_out)
    y_l = y_l + d_skip[:, None] * ssd_l[0]

    out_l = merge_heads(o_l, ga_l, y_l.reshape(bsz, L, SSD_WIDTH).astype(x_lat.dtype), z_l, ssd_norm_g, w_out)
    new_lat = x_lat + g_l * out_l

    new_ctx = x_ctx
    if ctx_out:
        q_c, ga_c, z_c = split_query_cols(p_c)
        q_c = rms_norm(q_c.reshape(bsz, lc, N_Q_HEADS, HEAD_DIM), q_norm_g)
        o_c = gqa_dense(q_c, k_c, v_c)
        y_c = y_c + d_skip[:, None] * ssd_c[0]
        out_c = merge_heads(o_c, ga_c, y_c.reshape(bsz, lc, SSD_WIDTH).astype(x_ctx.dtype), z_c, ssd_norm_g, w_out)
        new_ctx = x_ctx + g_c * out_c
    return new_lat, new_ctx


def setup_inputs(seed: int = 0) -> dict:
    key = jax.random.key(seed)
    ks = jax.random.split(key, 20)
    f32 = jnp.float32
    nrm = lambda k, shape, s: jax.random.normal(k, shape, f32) * s
    dt0 = jnp.exp(jax.random.uniform(ks[9], (DEPTH, 2, SSD_HEADS), f32, math.log(1e-3), math.log(1e-1)))
    return {
        "x": nrm(ks[0], (BATCH, SEQ, D_MODEL), 1.0),
        "c": nrm(ks[1], (BATCH, D_MODEL), 1.0),
        "ctx": nrm(ks[2], (BATCH, CTX_LEN, D_MODEL), 1.0),
        "c_ctx": nrm(ks[3], (D_MODEL,), 1.0),
        "ada_w": nrm(ks[4], (DEPTH, D_MODEL, 3 * D_MODEL), 0.5 * D_MODEL ** -0.5),
        "ada_b": nrm(ks[5], (DEPTH, 3 * D_MODEL), 0.01),
        "norm_g": 1.0 + nrm(ks[6], (DEPTH, D_MODEL), 0.05),
        "w_in": nrm(ks[7], (DEPTH, D_MODEL, PROJ_COLS), D_MODEL ** -0.5),
        "conv_w": nrm(ks[8], (DEPTH, D_CONV, CONV_CH), D_CONV ** -0.5),
        "conv_b": nrm(ks[10], (DEPTH, CONV_CH), 0.01),
        "dt_bias": dt0 + jnp.log(-jnp.expm1(-dt0)),
        "a_log": jnp.log(jax.random.uniform(ks[11], (DEPTH, 2, SSD_HEADS), f32, 1.0, 16.0)),
        "d_skip": 1.0 + nrm(ks[12], (DEPTH, SSD_HEADS), 0.05),
        "q_norm_g": 1.0 + nrm(ks[13], (DEPTH, HEAD_DIM), 0.05),
        "k_norm_g": 1.0 + nrm(ks[14], (DEPTH, HEAD_DIM), 0.05),
        "ssd_norm_g": 1.0 + nrm(ks[15], (DEPTH, SSD_WIDTH), 0.05),
        "w_out": nrm(ks[16], (DEPTH, D_INNER, D_MODEL), D_INNER ** -0.5),
        "final_g": 1.0 + nrm(ks[17], (D_MODEL,), 0.05),
    }


def reference(x, c, ctx, c_ctx, ada_w, ada_b, norm_g, w_in, conv_w, conv_b, dt_bias, a_log, d_skip,
              q_norm_g, k_norm_g, ssd_norm_g, w_out, final_g):
    x_lat, x_ctx = x, ctx
    for layer in range(DEPTH):
        ctx_out = layer < DEPTH - 1
        x_lat, x_ctx = hybrid_layer(x_lat, x_ctx, c, c_ctx, ada_w[layer], ada_b[layer], norm_g[layer],
                                    w_in[layer], conv_w[layer], conv_b[layer], dt_bias[layer],
                                    a_log[layer], d_skip[layer], q_norm_g[layer], k_norm_g[layer],
                                    ssd_norm_g[layer], w_out[layer], ctx_out)
    return rms_norm(x_lat, final_g)
```

```cpp
#include <hip/hip_runtime.h>
#include <cstdio>
#include <cstdint>

constexpr int DM = 1024, NB = 32, SEQ = 2048, CTXL = 256, KVL = SEQ + CTXL;
constexpr int ML = NB * SEQ, MC = NB * CTXL, MT = ML + MC;
constexpr int PROJ = 5152, OFF_XBC = 512, OFF_DT = 2048, CTXC = 2080, CONVC = 1536;
constexpr int N1 = 21 * 256;
constexpr float EPS = 1e-6f;
constexpr float C2 = 0.125f * 1.4426950408889634f;

typedef unsigned short bf16;
__host__ __device__ __forceinline__ unsigned f2bf(float f) { unsigned u = __builtin_bit_cast(unsigned, f); return (u + 0x7fffu + ((u >> 16) & 1u)) >> 16; }
__host__ __device__ __forceinline__ float bf2f(unsigned h) { return __builtin_bit_cast(float, (h & 0xffffu) << 16); }
__device__ __forceinline__ float siluf(float v) { return v / (1.f + __expf(-v)); }
__device__ __forceinline__ float softplusf(float v) { return v > 20.f ? v : log1pf(expf(v)); }

constexpr size_t MiB = 1u << 20;
constexpr size_t WS_CTL = 0;
constexpr size_t WS_MOD = 2 * MiB;
constexpr size_t WS_ROPE = 3 * MiB;
constexpr size_t WS_SSQ = 4 * MiB;
constexpr size_t WS_RPART = 8 * MiB;
constexpr size_t WS_BT1 = 12 * MiB;
constexpr size_t WS_BT2 = 23 * MiB;
constexpr size_t WS_DT = 28 * MiB;
constexpr size_t WS_KB = 38 * MiB;
constexpr size_t WS_VB = 74 * MiB;
constexpr size_t WS_R1 = 110 * MiB;
constexpr size_t WS_XBC = 326 * MiB;
constexpr size_t WS_YQ = 542 * MiB;
constexpr size_t WS_Z = 798 * MiB;
constexpr size_t WS_END = 926 * MiB;

__host__ __device__ __forceinline__ int hperm_dim(int vin) {
    const int bj = vin >> 7, wc = (vin >> 5) & 3, s = vin & 31, fq = s >> 3, e = s & 7;
    return wc * 64 + bj * 32 + (e >> 2) * 16 + 4 * fq + (e & 3);
}
__host__ __device__ __forceinline__ int hperm_inv(int head, int dim) {
    const int axis = dim >> 5, half = (dim >> 4) & 1, i16 = dim & 15, fq = i16 >> 2, e = (i16 & 3) + 4 * half;
    return 128 * axis + 32 * head + 8 * fq + e;
}
__host__ __device__ __forceinline__ int vcol_actual(int v) {
    const int t = v >> 8, vin = v & 255;
    if (t == 0) return hperm_dim(vin);
    if (t == 1) return 256 + vin;
    if (t < 8) return v;
    if (t == 8) return vin < 32 ? OFF_DT + vin : -1;
    if (t < 13) return CTXC + (t - 9) * 256 + hperm_dim(vin);
    if (t < 17) return CTXC + 1024 + (v - 13 * 256);
    return CTXC + 2048 + (v - 17 * 256);
}

__global__ void k_mod(const float* c, const float* c_ctx, const float* ada_w, const float* ada_b, float* mod) {
    const int i = blockIdx.x * 256 + threadIdx.x; if (i >= 33 * 3072) return;
    const int b = i / 3072, n = i % 3072; const float* cv = b < 32 ? c + b * 1024 : c_ctx;
    float acc = 0.f;
    for (int k = 0; k < 1024; ++k) acc += siluf(cv[k]) * ada_w[(size_t)k * 3072 + n];
    mod[i] = acc + ada_b[n];
}
__global__ void k_tables(float* rope) {
    const int i = blockIdx.x * 256 + threadIdx.x; if (i >= 1024) return;
    const int p = i >> 4, f = i & 15; const float inv = powf(10000.f, -(float)f / 16.f); const float ang = (float)p * inv;
    rope[i] = cosf(ang); rope[1024 + i] = sinf(ang);
}
__global__ void k_bt1(const float* w_in, bf16* bt1) {
    const size_t i = (size_t)blockIdx.x * 256 + threadIdx.x; if (i >= (size_t)N1 * 1024) return;
    const int v = (int)(i >> 10), k = (int)(i & 1023); const int a = vcol_actual(v);
    bt1[i] = (bf16)(a >= 0 ? f2bf(w_in[(size_t)k * PROJ + a]) : 0u);
}
__global__ void k_bt2(const float* w_out, const float* ssd_g, bf16* bt2) {
    const size_t i = (size_t)blockIdx.x * 256 + threadIdx.x; if (i >= (size_t)1024 * 2048) return;
    const int n = (int)(i >> 11), kk = (int)(i & 2047);
    const float v = kk < 1024 ? w_out[(size_t)(1024 + kk) * 1024 + n] * ssd_g[kk] : w_out[(size_t)(kk - 1024) * 1024 + n];
    bt2[i] = (bf16)f2bf(v);
}
__global__ void k_norm(const float* x, const float* ctx, const float* norm_g, const float* mod, bf16* H) {
    const int row = blockIdx.x * 4 + (threadIdx.x >> 6), lane = threadIdx.x & 63; if (row >= MT) return;
    const float* xr = row < ML ? x + (size_t)row * DM : ctx + (size_t)(row - ML) * DM;
    const float* md = mod + (size_t)(row < ML ? row / SEQ : 32) * 3072;
    float v[16]; float s = 0.f;
    for (int j = 0; j < 16; ++j) { v[j] = xr[lane + 64 * j]; s += v[j] * v[j]; }
    for (int o = 1; o < 64; o <<= 1) s += __shfl_xor(s, o);
    const float rstd = rsqrtf(s * (1.f / DM) + EPS);
    for (int j = 0; j < 16; ++j) { const int k = lane + 64 * j; const float h = v[j] * rstd * norm_g[k] * (1.f + md[1024 + k]) + md[k]; H[(size_t)row * DM + k] = (bf16)f2bf(h); }
}
__global__ __launch_bounds__(256) void k_gemm1(const bf16* H, const bf16* bt1, const float* rope, const float* qg, const float* kg, const float* dt_bias,
                                                bf16* KB, bf16* VB, bf16* XBC, float* DT, bf16* YQ, bf16* Z) {
    __shared__ float As[32][65];
    __shared__ float Ps[32][257];
    const int pn = blockIdx.x, rt = blockIdx.y, tid = threadIdx.x; const int row0 = rt * 32;
    if (row0 >= ML && pn > 8) return;
    float acc[32];
    for (int r = 0; r < 32; ++r) acc[r] = 0.f;
    const bf16* bp = bt1 + (size_t)(pn * 256 + tid) * 1024;
    for (int k0 = 0; k0 < 1024; k0 += 64) {
        __syncthreads();
        for (int e = tid; e < 32 * 64; e += 256) { const int r = e >> 6, kk = e & 63; As[r][kk] = bf2f(H[(size_t)(row0 + r) * DM + k0 + kk]); }
        __syncthreads();
        for (int kk = 0; kk < 64; ++kk) { const float b = bf2f(bp[k0 + kk]);
            for (int r = 0; r < 32; ++r) acc[r] += As[r][kk] * b; }
    }
    for (int r = 0; r < 32; ++r) Ps[r][tid] = acc[r];
    __syncthreads();
    const bool isctx = row0 >= ML;
    if (pn == 0 || (pn >= 9 && pn < 13)) {
        {
            const int r = tid >> 3, hd = (tid >> 1) & 3, ax = tid & 1, row = row0 + r; const float* g = pn == 0 ? kg : qg;
            float s = 0.f;
            for (int d = 0; d < 32; ++d) { const float v = Ps[r][hperm_inv(hd, ax * 32 + d)]; s += v * v; }
            s += __shfl_xor(s, 1);
            const float rstd = rsqrtf(s * (1.f / 64.f) + EPS);
            const int t = row % SEQ, p = ax == 0 ? (t >> 6) : (t & 63);
            bf16* dst; float osc = 1.f;
            if (pn == 0) { const int b = isctx ? (row - ML) / CTXL : row / SEQ, pos = isctx ? SEQ + (row - ML) % CTXL : row % SEQ; dst = KB + ((size_t)b * KVL + pos) * 256 + hd * 64 + ax * 32; }
            else { dst = YQ + (size_t)row * 2048 + 1024 + ((pn - 9) * 4 + hd) * 64 + ax * 32; osc = C2; }
            for (int f = 0; f < 16; ++f) {
                const float x1 = Ps[r][hperm_inv(hd, ax * 32 + f)] * rstd * g[ax * 32 + f], x2 = Ps[r][hperm_inv(hd, ax * 32 + 16 + f)] * rstd * g[ax * 32 + 16 + f];
                float o1 = x1, o2 = x2;
                if (!isctx) { const float cs = rope[p * 16 + f], sn = rope[1024 + p * 16 + f]; o1 = x1 * cs - x2 * sn; o2 = x2 * cs + x1 * sn; }
                dst[f] = (bf16)f2bf(o1 * osc); dst[16 + f] = (bf16)f2bf(o2 * osc);
            }
        }
    } else {
        for (int r = 0; r < 32; ++r) { const int row = row0 + r; const float v = Ps[r][tid];
            if (pn == 1) { const int b = isctx ? (row - ML) / CTXL : row / SEQ, pos = isctx ? SEQ + (row - ML) % CTXL : row % SEQ;
                VB[((size_t)b * KVL + pos) * 256 + tid] = (bf16)f2bf(v); }
            else if (pn < 8) XBC[(size_t)row * CONVC + (pn - 2) * 256 + tid] = (bf16)f2bf(v);
            else if (pn == 8) { if (tid < 32) DT[(size_t)row * 32 + tid] = softplusf(v + dt_bias[tid]); }
            else if (pn < 17) YQ[(size_t)row * 2048 + (pn - 13) * 256 + tid] = (bf16)f2bf(siluf(v));
            else Z[(size_t)row * 1024 + (pn - 17) * 256 + tid] = (bf16)f2bf(siluf(v)); }
    }
}
__global__ __launch_bounds__(256) void k_attn(bf16* YQ, const bf16* KB, const bf16* VB) {
    __shared__ float Qs[64][65]; __shared__ float Ks[64][65]; __shared__ float Ps[64][65]; __shared__ bf16 Vs[64][66];
    const int qb = blockIdx.x, h = blockIdx.y, b = blockIdx.z, tid = threadIdx.x, ty = tid >> 4, tx = tid & 15;
    const size_t row0 = (size_t)b * SEQ + qb * 64; const int kvh = h >> 2;
    for (int e = tid; e < 4096; e += 256) { const int r = e >> 6, d = e & 63; Qs[r][d] = bf2f(YQ[(row0 + r) * 2048 + 1024 + h * 64 + d]); }
    float o[4][4], l[4];
    for (int i = 0; i < 4; ++i) { l[i] = 0.f; for (int j = 0; j < 4; ++j) o[i][j] = 0.f; }
    for (int kt = 0; kt < KVL / 64; ++kt) {
        __syncthreads();
        for (int e = tid; e < 4096; e += 256) { const int r = e >> 6, d = e & 63; const size_t src = ((size_t)b * KVL + kt * 64 + r) * 256 + kvh * 64 + d;
            Ks[r][d] = bf2f(KB[src]); Vs[r][d] = VB[src]; }
        __syncthreads();
        float s[4][4];
        for (int i = 0; i < 4; ++i) for (int j = 0; j < 4; ++j) s[i][j] = 0.f;
        for (int d = 0; d < 64; ++d) { float a[4], k4[4];
            for (int i = 0; i < 4; ++i) { a[i] = Qs[ty * 4 + i][d]; k4[i] = Ks[tx * 4 + i][d]; }
            for (int i = 0; i < 4; ++i) for (int j = 0; j < 4; ++j) s[i][j] += a[i] * k4[j]; }
        for (int i = 0; i < 4; ++i) for (int j = 0; j < 4; ++j) Ps[ty * 4 + i][tx * 4 + j] = exp2f(s[i][j]);
        __syncthreads();
        for (int key = 0; key < 64; ++key) { float p[4], v4[4];
            for (int i = 0; i < 4; ++i) { p[i] = Ps[ty * 4 + i][key]; v4[i] = bf2f(Vs[key][tx * 4 + i]); }
            for (int i = 0; i < 4; ++i) { l[i] += p[i]; for (int j = 0; j < 4; ++j) o[i][j] += p[i] * v4[j]; } }
    }
    for (int i = 0; i < 4; ++i) for (int j = 0; j < 4; ++j) { const size_t row = row0 + ty * 4 + i; const int d = tx * 4 + j;
        const float ga = bf2f(YQ[row * 2048 + h * 64 + d]);
        YQ[row * 2048 + 1024 + h * 64 + d] = (bf16)f2bf(o[i][j] / l[i] * ga); }
}
__global__ void k_conv(const bf16* XBC, const float* cw, const float* cb, bf16* XC) {
    const size_t i = (size_t)blockIdx.x * 256 + threadIdx.x; if (i >= (size_t)MT * CONVC) return;
    const int row = (int)(i / CONVC), ch = (int)(i % CONVC);
    int t, len; if (row < ML) { t = row % SEQ; len = SEQ; } else { t = (row - ML) % CTXL; len = CTXL; }
    float acc = cb[ch];
    for (int j = 0; j < 5; ++j) { const int tt = t + j - 2; if (tt >= 0 && tt < len) acc += cw[j * CONVC + ch] * bf2f(XBC[(size_t)(row + j - 2) * CONVC + ch]); }
    XC[i] = (bf16)f2bf(siluf(acc));
}
__global__ __launch_bounds__(512) void k_ssd(const bf16* XC, const float* DT, const bf16* Z, const float* a_log, const float* d_skip, bf16* YQ, float* SSQ) {
    __shared__ float ysq[64];
    const int h = blockIdx.x, b = blockIdx.y, tid = threadIdx.x, p = tid >> 3, nc = tid & 7, g = h >> 3;
    for (int dd = 0; dd < 2; ++dd) { const int d = 1 - dd;
        const float a_neg = -expf(a_log[d * 16 + h]);
        float S[16];
        for (int j = 0; j < 16; ++j) S[j] = 0.f;
        for (int seq = 0; seq < 2; ++seq) { const int len = seq == 0 ? CTXL : SEQ; const size_t rbase = seq == 0 ? (size_t)ML + (size_t)b * CTXL : (size_t)b * SEQ;
            for (int st = 0; st < len; ++st) { const int t = d ? len - 1 - st : st; const size_t row = rbase + t;
                const float dt = DT[row * 32 + d * 16 + h]; const float dec = expf(dt * a_neg);
                const float xs = bf2f(XC[row * CONVC + h * 64 + p]); const float X = xs * dt;
                const bf16* Bp = XC + row * CONVC + 1024 + g * 128 + nc * 16; const bf16* Cp = Bp + 256;
                float y = 0.f;
                for (int j = 0; j < 16; ++j) { S[j] = S[j] * dec + X * bf2f(Bp[j]); y += bf2f(Cp[j]) * S[j]; }
                y += __shfl_xor(y, 1); y += __shfl_xor(y, 2); y += __shfl_xor(y, 4);
                if (seq == 1) {
                    bf16* yp = YQ + row * 2048 + h * 64 + p;
                    if (d == 1) { if (nc == 0) *yp = (bf16)f2bf(y); }
                    else {
                        float yg = 0.f;
                        if (nc == 0) { const float yt = y + bf2f(*yp) + d_skip[h] * xs; yg = yt * bf2f(Z[row * 1024 + h * 64 + p]); *yp = (bf16)f2bf(yg); ysq[p] = yg * yg; }
                        __syncthreads();
                        if (tid < 64) { float q = ysq[tid]; for (int o = 1; o < 64; o <<= 1) q += __shfl_xor(q, o); if (tid == 0) SSQ[row * 16 + h] = q; }
                        __syncthreads();
                    }
                }
            }
        }
    }
}
__global__ __launch_bounds__(256) void k_gemm2(const bf16* YQ, const bf16* bt2, const float* SSQ, const float* x, const float* mod, float* out, float* RPART) {
    __shared__ float As[32][65]; __shared__ float red[32][4];
    const int pn = blockIdx.x, rt = blockIdx.y, tid = threadIdx.x, row0 = rt * 32;
    float acc[32];
    for (int r = 0; r < 32; ++r) acc[r] = 0.f;
    const bf16* bp = bt2 + (size_t)(pn * 256 + tid) * 2048;
    for (int k0 = 0; k0 < 2048; k0 += 64) {
        if (k0 == 1024) { for (int r = 0; r < 32; ++r) { float s = 0.f; for (int j = 0; j < 16; ++j) s += SSQ[(size_t)(row0 + r) * 16 + j]; acc[r] *= rsqrtf(s * (1.f / 1024.f) + EPS); } }
        __syncthreads();
        for (int e = tid; e < 32 * 64; e += 256) { const int r = e >> 6, kk = e & 63; As[r][kk] = bf2f(YQ[(size_t)(row0 + r) * 2048 + k0 + kk]); }
        __syncthreads();
        for (int kk = 0; kk < 64; ++kk) { const float bv = bf2f(bp[k0 + kk]);
            for (int r = 0; r < 32; ++r) acc[r] += As[r][kk] * bv; }
    }
    const int n = pn * 256 + tid;
    for (int r = 0; r < 32; ++r) { const int row = row0 + r; const float v = x[(size_t)row * DM + n] + mod[(size_t)(row / SEQ) * 3072 + 2048 + n] * acc[r];
        out[(size_t)row * DM + n] = v; float q = v * v;
        for (int o = 1; o < 64; o <<= 1) q += __shfl_xor(q, o);
        if ((tid & 63) == 0) RPART[(size_t)row * 16 + pn * 4 + (tid >> 6)] = q; }
}
__global__ void k_final(float* out, const float* RPART, const float* fg) {
    const int row = blockIdx.x * 4 + (threadIdx.x >> 6), lane = threadIdx.x & 63;
    float s = 0.f;
    for (int j = 0; j < 16; ++j) s += RPART[(size_t)row * 16 + j];
    const float rstd = rsqrtf(s * (1.f / DM) + EPS);
    for (int j = 0; j < 16; ++j) { const int k = lane + 64 * j; out[(size_t)row * DM + k] *= rstd * fg[k]; }
}

extern "C" void kernel_launch(void* const* d_in, const int* in_sizes, int n_in, void* d_out, int out_size, void* d_ws, size_t ws_size, hipStream_t stream) {
    if (n_in != 18 || out_size != ML * DM || ws_size < WS_END) { fprintf(stderr, "kernel_launch: unexpected shapes (n_in %d out %d ws %zu)\n", n_in, out_size, ws_size); return; }
    const float* x = (const float*)d_in[0]; const float* c = (const float*)d_in[1]; const float* ctx = (const float*)d_in[2]; const float* c_ctx = (const float*)d_in[3];
    const float* ada_w = (const float*)d_in[4]; const float* ada_b = (const float*)d_in[5]; const float* norm_g = (const float*)d_in[6]; const float* w_in = (const float*)d_in[7];
    const float* conv_w = (const float*)d_in[8]; const float* conv_b = (const float*)d_in[9]; const float* dt_bias = (const float*)d_in[10]; const float* a_log = (const float*)d_in[11];
    const float* d_skip = (const float*)d_in[12]; const float* qg = (const float*)d_in[13]; const float* kg = (const float*)d_in[14]; const float* ssd_g = (const float*)d_in[15];
    const float* w_out = (const float*)d_in[16]; const float* final_g = (const float*)d_in[17];
    unsigned char* ws = (unsigned char*)d_ws; float* out = (float*)d_out;
    float* mod = (float*)(ws + WS_MOD); float* rope = (float*)(ws + WS_ROPE); float* SSQ = (float*)(ws + WS_SSQ); float* RPART = (float*)(ws + WS_RPART);
    bf16* bt1 = (bf16*)(ws + WS_BT1); bf16* bt2 = (bf16*)(ws + WS_BT2); float* DT = (float*)(ws + WS_DT); bf16* KB = (bf16*)(ws + WS_KB); bf16* VB = (bf16*)(ws + WS_VB);
    bf16* H = (bf16*)(ws + WS_R1); bf16* XC = (bf16*)(ws + WS_R1); bf16* XBC = (bf16*)(ws + WS_XBC); bf16* YQ = (bf16*)(ws + WS_YQ); bf16* Z = (bf16*)(ws + WS_Z);
    k_mod<<<(33 * 3072 + 255) / 256, 256, 0, stream>>>(c, c_ctx, ada_w, ada_b, mod);
    k_tables<<<4, 256, 0, stream>>>(rope);
    k_bt1<<<(N1 * 1024) / 256, 256, 0, stream>>>(w_in, bt1);
    k_bt2<<<(1024 * 2048) / 256, 256, 0, stream>>>(w_out, ssd_g, bt2);
    k_norm<<<MT / 4, 256, 0, stream>>>(x, ctx, norm_g, mod, H);
    k_gemm1<<<dim3(21, MT / 32), 256, 0, stream>>>(H, bt1, rope, qg, kg, dt_bias, KB, VB, XBC, DT, YQ, Z);
    k_attn<<<dim3(SEQ / 64, 16, NB), 256, 0, stream>>>(YQ, KB, VB);
    k_conv<<<(unsigned)(((size_t)MT * CONVC + 255) / 256), 256, 0, stream>>>(XBC, conv_w, conv_b, XC);
    k_ssd<<<dim3(16, NB), 512, 0, stream>>>(XC, DT, Z, a_log, d_skip, YQ, SSQ);
    k_gemm2<<<dim3(4, ML / 32), 256, 0, stream>>>(YQ, bt2, SSQ, x, mod, out, RPART);
    k_final<<<ML / 4, 256, 0, stream>>>(out, RPART, final_g);
}
```

```cpp
#include <hip/hip_runtime.h>
#include <cstdio>
#include <cstdint>

constexpr int DM = 1024, NB = 32, SEQ = 2048, CTXL = 256, KVL = SEQ + CTXL;
constexpr int ML = NB * SEQ, MC = NB * CTXL, MT = ML + MC;
constexpr int PROJ = 5152, OFF_XBC = 512, OFF_DT = 2048, CTXC = 2080, CONVC = 1536;
constexpr int N1 = 21 * 256;
constexpr float EPS = 1e-6f;
constexpr float C2 = 0.125f * 1.4426950408889634f;

typedef unsigned short bf16;
__host__ __device__ __forceinline__ unsigned f2bf(float f) { unsigned u = __builtin_bit_cast(unsigned, f); return (u + 0x7fffu + ((u >> 16) & 1u)) >> 16; }
__host__ __device__ __forceinline__ float bf2f(unsigned h) { return __builtin_bit_cast(float, (h & 0xffffu) << 16); }
__device__ __forceinline__ float siluf(float v) { return v / (1.f + __expf(-v)); }
__device__ __forceinline__ float softplusf(float v) { return v > 20.f ? v : log1pf(expf(v)); }

constexpr size_t MiB = 1u << 20;
constexpr size_t WS_CTL = 0;
constexpr size_t WS_MOD = 2 * MiB;
constexpr size_t WS_ROPE = 3 * MiB;
constexpr size_t WS_SSQ = 4 * MiB;
constexpr size_t WS_RPART = 8 * MiB;
constexpr size_t WS_BT1 = 12 * MiB;
constexpr size_t WS_BT2 = 23 * MiB;
constexpr size_t WS_DT = 28 * MiB;
constexpr size_t WS_KB = 38 * MiB;
constexpr size_t WS_VB = 74 * MiB;
constexpr size_t WS_R1 = 110 * MiB;
constexpr size_t WS_XBC = 326 * MiB;
constexpr size_t WS_YQ = 542 * MiB;
constexpr size_t WS_Z = 798 * MiB;
constexpr size_t WS_END = 926 * MiB;

__host__ __device__ __forceinline__ int hperm_dim(int vin) {
    const int bj = vin >> 7, wc = (vin >> 5) & 3, s = vin & 31, fq = s >> 3, e = s & 7;
    return wc * 64 + bj * 32 + (e >> 2) * 16 + 4 * fq + (e & 3);
}
__host__ __device__ __forceinline__ int hperm_inv(int head, int dim) {
    const int axis = dim >> 5, half = (dim >> 4) & 1, i16 = dim & 15, fq = i16 >> 2, e = (i16 & 3) + 4 * half;
    return 128 * axis + 32 * head + 8 * fq + e;
}
__host__ __device__ __forceinline__ int vcol_actual(int v) {
    const int t = v >> 8, vin = v & 255;
    if (t == 0) return hperm_dim(vin);
    if (t == 1) return 256 + vin;
    if (t < 8) return v;
    if (t == 8) return vin < 32 ? OFF_DT + vin : -1;
    if (t < 13) return CTXC + (t - 9) * 256 + hperm_dim(vin);
    if (t < 17) return CTXC + 1024 + (v - 13 * 256);
    return CTXC + 2048 + (v - 17 * 256);
}

namespace pg8 {
#define PG8_LAS __attribute__((address_space(3)))
typedef unsigned short bf16_t;
typedef short bf16x8 __attribute__((ext_vector_type(8)));
typedef float f32x4 __attribute__((ext_vector_type(4)));
typedef unsigned u32x4 __attribute__((ext_vector_type(4)));
constexpr int BM = 256, BK = 64, HALF = 128, HTB = HALF * BK * 2  , STAGE_BYTES = 8 * HTB, NXCD = 8, WGM = 8;

__host__ __device__ __forceinline__ int lds_byte(int r, int c) { const int st = (r >> 4) * 2 + (c >> 5), rr = r & 15, cc = c & 31, ob = rr * 64 + cc * 2; return st * 1024 + (ob ^ (((ob >> 9) & 1) << 5)); }
__host__ __device__ __forceinline__ void stage_rc(int b, int& R, int& C) { const int st = b / 1024, sb = b % 1024, swz = sb ^ (((sb >> 9) & 1) << 5); R = (st >> 1) * 16 + swz / 64; C = (st & 1) * 32 + (swz % 64) / 2; }
__host__ __device__ __forceinline__ int perm32(int rho) { const int n = rho >> 4, i = rho & 15; return 8 * (i >> 2) + 4 * n + (i & 3); }

struct Unit { int pm, pn; };
struct Gemm { const bf16_t* A; const bf16_t* Bt; int M, N, K; };

__device__ __forceinline__ unsigned cvt_pk_bf16(float lo, float hi) { unsigned r; asm volatile("v_cvt_pk_bf16_f32 %0, %1, %2" : "=v"(r) : "v"(lo), "v"(hi)); return r; }
typedef float f32x2 __attribute__((ext_vector_type(2)));
template <class Epi, class Sched, bool ALIGN_EPI = false, bool SP2 = false>
__device__ __forceinline__ void gemm_phase(PG8_LAS unsigned char* lds, const Gemm g, const Sched& S, const Epi& E) {
    const int tid = threadIdx.x, wid = __builtin_amdgcn_readfirstlane(tid >> 6), lane = tid & 63, wr = wid >> 2, wc = wid & 3, fr = lane & 15, fq = lane >> 4;
    const int K = g.K, nt = K / BK;
    unsigned voffA[2], voffB[2];
#pragma unroll
    for (int i = 0; i < 2; ++i) { int R, C; stage_rc(tid * 16 + i * 8192, R, C); const int Rb = Epi::PERM ? ((R & ~31) + perm32(R & 31)) : R;
        voffA[i] = (unsigned)(R * K + C) * 2u; voffB[i] = (unsigned)(Rb * K + C) * 2u; }
    const size_t kstep = (size_t)(BK * 2);
    const size_t hstep = (size_t)HALF * K * 2;
    const size_t tstep = 2 * hstep;
    const unsigned ldsw = (unsigned)wid * 1024u;
    const int aoff = lds_byte(wr * 64 + fr, fq * 8), boff = lds_byte(wc * 32 + fr, fq * 8);
#define PG8_SA(b, h) (((b) * 2 + (h)) * HTB)
#define PG8_SB(b, h) ((4 + (b) * 2 + (h)) * HTB)
#define PG8_STAGE(bufoff, gbase, voff) do { _Pragma("unroll") for (int _i = 0; _i < 2; ++_i) \
        __builtin_amdgcn_global_load_lds((const unsigned*)((const char*)(gbase) + (voff)[_i]), (PG8_LAS unsigned*)(lds + (bufoff) + ldsw + _i * 8192), 16, 0, 0); } while (0)
#define PG8_LDA(dst, b, h) do { _Pragma("unroll") for (int m = 0; m < 4; ++m) _Pragma("unroll") for (int k = 0; k < 2; ++k) dst[m][k] = *(const PG8_LAS bf16x8*)(lds + PG8_SA(b, h) + aoff + m * 2048 + k * 1024); } while (0)
#define PG8_LDB(dst, b, h) do { _Pragma("unroll") for (int n = 0; n < 2; ++n) _Pragma("unroll") for (int k = 0; k < 2; ++k) dst[n][k] = *(const PG8_LAS bf16x8*)(lds + PG8_SB(b, h) + boff + n * 2048 + k * 1024); } while (0)
#define PG8_MMA(ai, bj, At, Bt) do { __builtin_amdgcn_s_setprio(1); _Pragma("unroll") for (int m = 0; m < 4; ++m) _Pragma("unroll") for (int n = 0; n < 2; ++n) _Pragma("unroll") for (int k = 0; k < 2; ++k) \
        acc[ai][bj][m][n] = __builtin_amdgcn_mfma_f32_16x16x32_bf16(Bt[n][k], At[m][k], acc[ai][bj][m][n], 0, 0, 0); __builtin_amdgcn_s_setprio(0); } while (0)
#define PG8_WAIT_V(n) asm volatile("s_waitcnt vmcnt(" #n ")" ::: "memory")
#define PG8_WAIT_L(n) asm volatile("s_waitcnt lgkmcnt(" #n ")" ::: "memory")
#define PG8_BAR __builtin_amdgcn_s_barrier()
#define PG8_SCHED __builtin_amdgcn_sched_barrier(0)
    Unit cur, nxt; int ui = 0;
    if (!S.next(0, cur)) return;
    f32x4 acc[2][2][4][2];
#pragma unroll
    for (int a = 0; a < 2; ++a)
#pragma unroll
        for (int b = 0; b < 2; ++b)
#pragma unroll
            for (int m = 0; m < 4; ++m)
#pragma unroll
                for (int n = 0; n < 2; ++n) acc[a][b][m][n] = (f32x4){0.f, 0.f, 0.f, 0.f};
    bf16x8 At[4][2], B0[2][2], B1[2][2];
    const char* cA = (const char*)g.A + (size_t)cur.pm * tstep; const char* cB = (const char*)g.Bt + (size_t)cur.pn * tstep;
    S.a_ready(cur);
    if constexpr (SP2) {
        PG8_STAGE(PG8_SB(0, 0), cB, voffB); PG8_STAGE(PG8_SB(0, 1), cB + hstep, voffB); PG8_STAGE(PG8_SA(0, 0), cA, voffA); PG8_STAGE(PG8_SA(0, 1), cA + hstep, voffA);
        if (wr == 1) PG8_BAR;
        PG8_WAIT_V(2); PG8_BAR;
        PG8_STAGE(PG8_SB(1, 0), cB + kstep, voffB); PG8_STAGE(PG8_SA(1, 0), cA + kstep, voffA); PG8_STAGE(PG8_SB(1, 1), cB + hstep + kstep, voffB);
        PG8_WAIT_V(6); PG8_BAR;
    } else {
        PG8_STAGE(PG8_SB(0, 0), cB, voffB); PG8_STAGE(PG8_SA(0, 0), cA, voffA); PG8_STAGE(PG8_SB(0, 1), cB + hstep, voffB); PG8_STAGE(PG8_SA(0, 1), cA + hstep, voffA);
        if (wr == 1) PG8_BAR;
        PG8_WAIT_V(4); PG8_BAR;
        PG8_STAGE(PG8_SB(1, 0), cB + kstep, voffB); PG8_STAGE(PG8_SA(1, 0), cA + kstep, voffA); PG8_STAGE(PG8_SB(1, 1), cB + hstep + kstep, voffB);
        PG8_WAIT_V(6); PG8_BAR;
    }
    for (;;) {
        const bool has_next = S.next(ui + 1, nxt);
        const char* nA = has_next ? (const char*)g.A + (size_t)nxt.pm * tstep : cA; const char* nB = has_next ? (const char*)g.Bt + (size_t)nxt.pn * tstep : cB;
        for (int t = 0; t < nt; t += 2) {
            if constexpr (Epi::MIDK) { if (t == nt / 2) E.midk(acc, ui, wr, fr); }
            const bool last = (t == nt - 2);
            const char* a1 = cA + (size_t)(t + 1) * kstep;
            const char* a2 = last ? nA : cA + (size_t)(t + 2) * kstep; const char* b2 = last ? nB : cB + (size_t)(t + 2) * kstep;
            const char* a3 = a2 + kstep; const char* b3 = b2 + kstep;
            if (last && has_next) S.a_ready(nxt);
            if constexpr (SP2) {
            PG8_LDB(B0, 0, 0); PG8_LDB(B1, 0, 1); PG8_SCHED; PG8_LDA(At, 0, 0); PG8_STAGE(PG8_SA(1, 1), a1 + hstep, voffA);
            PG8_WAIT_V(8); PG8_WAIT_L(0); PG8_BAR; PG8_MMA(0, 0, At, B0); PG8_MMA(0, 1, At, B1); PG8_BAR; PG8_SCHED;
            PG8_LDA(At, 0, 1); PG8_STAGE(PG8_SB(0, 0), b2, voffB); PG8_STAGE(PG8_SB(0, 1), b2 + hstep, voffB); PG8_STAGE(PG8_SA(0, 0), a2, voffA);
            PG8_WAIT_V(8); PG8_WAIT_L(0); PG8_BAR; PG8_MMA(1, 0, At, B0); PG8_MMA(1, 1, At, B1); PG8_BAR; PG8_SCHED;
            PG8_LDB(B0, 1, 0); PG8_LDB(B1, 1, 1); PG8_SCHED; PG8_LDA(At, 1, 0); PG8_STAGE(PG8_SA(0, 1), a2 + hstep, voffA);
            PG8_WAIT_V(8); PG8_WAIT_L(0); PG8_BAR; PG8_MMA(0, 0, At, B0); PG8_MMA(0, 1, At, B1); PG8_BAR; PG8_SCHED;
            PG8_LDA(At, 1, 1); PG8_STAGE(PG8_SB(1, 0), b3, voffB); PG8_STAGE(PG8_SB(1, 1), b3 + hstep, voffB); PG8_STAGE(PG8_SA(1, 0), a3, voffA);
            PG8_WAIT_V(8); PG8_WAIT_L(0); PG8_BAR; PG8_MMA(1, 0, At, B0); PG8_MMA(1, 1, At, B1); PG8_BAR; PG8_SCHED;
            } else {
            PG8_LDB(B0, 0, 0); PG8_SCHED; PG8_LDA(At, 0, 0); PG8_STAGE(PG8_SA(1, 1), a1 + hstep, voffA);
            PG8_WAIT_L(8); PG8_BAR; PG8_WAIT_L(0); PG8_MMA(0, 0, At, B0); PG8_BAR; PG8_SCHED;
            PG8_LDB(B1, 0, 1); PG8_STAGE(PG8_SB(0, 0), b2, voffB);
            PG8_BAR; PG8_WAIT_L(0); PG8_MMA(0, 1, At, B1); PG8_BAR;
            PG8_LDA(At, 0, 1); PG8_STAGE(PG8_SA(0, 0), a2, voffA);
            PG8_BAR; PG8_WAIT_L(0); PG8_MMA(1, 0, At, B0); PG8_BAR; PG8_SCHED;
            PG8_STAGE(PG8_SB(0, 1), b2 + hstep, voffB);
            PG8_WAIT_V(6); PG8_BAR; PG8_MMA(1, 1, At, B1); PG8_BAR;
            PG8_LDB(B0, 1, 0); PG8_SCHED; PG8_LDA(At, 1, 0); PG8_STAGE(PG8_SA(0, 1), a2 + hstep, voffA);
            PG8_WAIT_L(8); PG8_BAR; PG8_WAIT_L(0); PG8_MMA(0, 0, At, B0); PG8_BAR; PG8_SCHED;
            PG8_LDB(B1, 1, 1); PG8_STAGE(PG8_SB(1, 0), b3, voffB);
            PG8_BAR; PG8_WAIT_L(0); PG8_MMA(0, 1, At, B1); PG8_BAR;
            PG8_LDA(At, 1, 1); PG8_STAGE(PG8_SA(1, 0), a3, voffA);
            PG8_BAR; PG8_WAIT_L(0); PG8_MMA(1, 0, At, B0); PG8_BAR; PG8_SCHED;
            PG8_STAGE(PG8_SB(1, 1), b3 + hstep, voffB);
            PG8_WAIT_V(6); PG8_BAR; PG8_MMA(1, 1, At, B1); PG8_BAR;
            }
        }
        if constexpr (ALIGN_EPI) { if (wr == 0) PG8_BAR; }
        if constexpr (!Epi::AFTER_DRAIN) { E(acc, cur, wr, wc, fr, fq); S.done(cur); }
        if (!has_next) break;
#pragma unroll
        for (int a = 0; a < 2; ++a)
#pragma unroll
            for (int b = 0; b < 2; ++b)
#pragma unroll
                for (int m = 0; m < 4; ++m)
#pragma unroll
                    for (int n = 0; n < 2; ++n) acc[a][b][m][n] = (f32x4){0.f, 0.f, 0.f, 0.f};
        cur = nxt; cA = nA; cB = nB; ++ui;
        if constexpr (ALIGN_EPI) { if (wr == 1) PG8_BAR; }
    }
    PG8_WAIT_V(0);
    if constexpr (!ALIGN_EPI) { if (wr == 0) PG8_BAR; }
    PG8_BAR;
    if constexpr (Epi::AFTER_DRAIN) { E.fused(acc, cur, wr, wc, fr, fq, lds, wid, lane); S.done(cur); }
#undef PG8_SA
#undef PG8_SB
#undef PG8_STAGE
#undef PG8_LDA
#undef PG8_LDB
#undef PG8_MMA
#undef PG8_WAIT_V
#undef PG8_WAIT_L
#undef PG8_BAR
#undef PG8_SCHED
}
struct Sched1 {
    int G, c;
    __device__ __forceinline__ void init(int G_, int c_) { G = G_; c = c_; }
    __device__ __forceinline__ bool next(int i, Unit& u) const {
        constexpr int nN = 21, nwg = 256 * nN;
        const int L = i * G + c;
        if (L < nwg) { const int wgid = (L % NXCD) * (nwg / NXCD) + L / NXCD; const int nig = WGM * nN, fm = (wgid / nig) * WGM;
            u.pm = fm + ((wgid % nig) % WGM); u.pn = (wgid % nig) / WGM; return true; }
        const int L2 = L - nwg; if (L2 >= 288) return false;
        const int wg = (L2 % NXCD) * 36 + L2 / NXCD; u.pn = wg >> 5; u.pm = 256 + (wg & 31); return true;
    }
    __device__ __forceinline__ void a_ready(const Unit&) const {}
    __device__ __forceinline__ void done(const Unit&) const {}
};
struct Sched2 {
    int G, c;
    __device__ __forceinline__ void init(int G_, int c_) { G = G_; c = c_; }
    __device__ __forceinline__ bool next(int i, Unit& u) const {
        constexpr int nN = 4, nwg = 256 * nN;
        const int L = i * G + c; if (L >= nwg) return false;
        const int wgid = (L % NXCD) * (nwg / NXCD) + L / NXCD; const int nig = WGM * nN, fm = (wgid / nig) * WGM;
        u.pm = fm + ((wgid % nig) % WGM); u.pn = (wgid % nig) / WGM; return true;
    }
    __device__ __forceinline__ void a_ready(const Unit&) const {}
    __device__ __forceinline__ void done(const Unit&) const {}
};
__device__ __forceinline__ float dot4(const f32x4 a) { return (a[0] * a[0] + a[1] * a[1]) + (a[2] * a[2] + a[3] * a[3]); }
__device__ __forceinline__ float silu1(float v) { return v * __builtin_amdgcn_rcpf(1.f + __expf(-v)); }
typedef unsigned u32x2 __attribute__((ext_vector_type(2)));
__device__ __forceinline__ u32x2 pk4(const f32x4 v) { u32x2 w; w.x = cvt_pk_bf16(v[0], v[1]); w.y = cvt_pk_bf16(v[2], v[3]); return w; }
struct Epi1 {
    static constexpr bool PERM = true, AFTER_DRAIN = false, MIDK = false;
    bf16_t *KB, *VB, *XBC, *YQ, *Z; float* DT; const float *rope, *qg, *kg, *dt_bias;
    __device__ __forceinline__ void midk(f32x4 (&)[2][2][4][2], int, int, int) const {}
    __device__ __forceinline__ void operator()(const f32x4 (&acc)[2][2][4][2], const Unit& u, int wr, int wc, int fr_in, int fq_in) const {
        int fr = fr_in, fq = fq_in; asm volatile("" : "+v"(fr), "+v"(fq));
        const int pn = u.pn, pm = u.pm; const bool isctx = pm >= 256; const int rloc = wr * 64 + fr;
        const int bb = isctx ? pm - 256 : pm >> 3, pos0 = isctx ? SEQ : (pm & 7) * 256;
        if (pn == 0 || (pn >= 9 && pn < 13)) {
            const float* g = pn == 0 ? kg : qg;
            const f32x4 g00 = *(const f32x4*)(g + 4 * fq), g01 = *(const f32x4*)(g + 16 + 4 * fq), g10 = *(const f32x4*)(g + 32 + 4 * fq), g11 = *(const f32x4*)(g + 48 + 4 * fq);
            const float osc = pn == 0 ? 1.f : C2;
            bf16_t* dbase; size_t pitch;
            if (pn == 0) { dbase = KB + ((size_t)bb * KVL + pos0) * 256 + wc * 64 + 4 * fq; pitch = 256; }
            else { dbase = YQ + (size_t)pm * 256 * 2048 + 1024 + ((pn - 9) * 4 + wc) * 64 + 4 * fq; pitch = 2048; }
#pragma unroll
            for (int ai = 0; ai < 2; ++ai) {
                const int prow = (pm & 7) * 4 + 2 * ai + wr;
                f32x4 c0 = (f32x4){1.f, 1.f, 1.f, 1.f}, s0 = (f32x4){0.f, 0.f, 0.f, 0.f};
                if (!isctx) { c0 = *(const f32x4*)(rope + prow * 16 + 4 * fq); s0 = *(const f32x4*)(rope + 1024 + prow * 16 + 4 * fq); }
#pragma unroll
                for (int m = 0; m < 4; ++m) {
                    f32x4 a0 = acc[ai][0][m][0], a1 = acc[ai][0][m][1], b0 = acc[ai][1][m][0], b1 = acc[ai][1][m][1];
                    float s = (dot4(a0) + dot4(a1)) + (dot4(b0) + dot4(b1));
                    s += __shfl_xor(s, 16); s += __shfl_xor(s, 32);
                    const float rstd = rsqrtf(s * (1.f / 64.f) + EPS) * osc;
                    a0 = a0 * rstd * g00; a1 = a1 * rstd * g01; b0 = b0 * rstd * g10; b1 = b1 * rstd * g11;
                    f32x4 c1 = (f32x4){1.f, 1.f, 1.f, 1.f}, s1 = (f32x4){0.f, 0.f, 0.f, 0.f};
                    if (!isctx) { const int pcol = 16 * m + fr; c1 = *(const f32x4*)(rope + pcol * 16 + 4 * fq); s1 = *(const f32x4*)(rope + 1024 + pcol * 16 + 4 * fq); }
                    const f32x4 o00 = a0 * c0 - a1 * s0, o01 = a1 * c0 + a0 * s0, o10 = b0 * c1 - b1 * s1, o11 = b1 * c1 + b0 * s1;
                    bf16_t* dst = dbase + (size_t)(rloc + 128 * ai + 16 * m) * pitch;
                    *(u32x2*)(dst) = pk4(o00); *(u32x2*)(dst + 16) = pk4(o01); *(u32x2*)(dst + 32) = pk4(o10); *(u32x2*)(dst + 48) = pk4(o11);
                    asm volatile("" ::: "memory");
                }
            }
        } else if (pn == 8) {
            if (wc == 0) {
                const f32x4 bA = *(const f32x4*)(dt_bias + 8 * fq), bB = *(const f32x4*)(dt_bias + 8 * fq + 4);
#pragma unroll
                for (int ai = 0; ai < 2; ++ai)
#pragma unroll
                    for (int m = 0; m < 4; ++m) { const size_t row = (size_t)pm * 256 + rloc + 128 * ai + 16 * m;
                        f32x4 v0 = acc[ai][0][m][0] + bA, v1 = acc[ai][0][m][1] + bB;
#pragma unroll
                        for (int e = 0; e < 4; ++e) { v0[e] = v0[e] > 20.f ? v0[e] : log1pf(__expf(v0[e])); v1[e] = v1[e] > 20.f ? v1[e] : log1pf(__expf(v1[e])); }
                        *(f32x4*)(DT + row * 32 + 8 * fq) = v0; *(f32x4*)(DT + row * 32 + 8 * fq + 4) = v1; asm volatile("" ::: "memory"); }
            }
        } else {
            bf16_t* dbase; size_t pitch; bool act = false;
            const int cin = wc * 32 + 8 * fq;
            if (pn == 1) { dbase = VB + ((size_t)bb * KVL + pos0) * 256 + cin; pitch = 256; }
            else if (pn < 8) { dbase = XBC + (size_t)pm * 256 * CONVC + (pn - 2) * 256 + cin; pitch = CONVC; }
            else if (pn < 17) { dbase = YQ + (size_t)pm * 256 * 2048 + (pn - 13) * 256 + cin; pitch = 2048; act = true; }
            else { dbase = Z + (size_t)pm * 256 * 1024 + (pn - 17) * 256 + cin; pitch = 1024; act = true; }
#pragma unroll
            for (int ai = 0; ai < 2; ++ai)
#pragma unroll
                for (int m = 0; m < 4; ++m) { bf16_t* dst = dbase + (size_t)(rloc + 128 * ai + 16 * m) * pitch;
#pragma unroll
                    for (int bj = 0; bj < 2; ++bj) { f32x4 v0 = acc[ai][bj][m][0], v1 = acc[ai][bj][m][1];
                        if (act) {
#pragma unroll
                            for (int e = 0; e < 4; ++e) { v0[e] = silu1(v0[e]); v1[e] = silu1(v1[e]); } }
                        u32x4 w; w.x = cvt_pk_bf16(v0[0], v0[1]); w.y = cvt_pk_bf16(v0[2], v0[3]); w.z = cvt_pk_bf16(v1[0], v1[1]); w.w = cvt_pk_bf16(v1[2], v1[3]);
                        *(u32x4*)(dst + bj * HALF) = w; } asm volatile("" ::: "memory"); }
        }
    }
};
struct Epi2 {
    static constexpr bool PERM = false, AFTER_DRAIN = false, MIDK = true;
    const float* x; const float* mod; float* out; float* RPART; const PG8_LAS float* rstd_tab;
    __device__ __forceinline__ void midk(f32x4 (&acc)[2][2][4][2], int ui, int wr, int fr) const {
#pragma unroll
        for (int ai = 0; ai < 2; ++ai)
#pragma unroll
            for (int m = 0; m < 4; ++m) { const float r = rstd_tab[ui * 256 + 128 * ai + 64 * wr + 16 * m + fr];
#pragma unroll
                for (int bj = 0; bj < 2; ++bj)
#pragma unroll
                    for (int n = 0; n < 2; ++n) acc[ai][bj][m][n] *= r; }
    }
    __device__ __forceinline__ void operator()(const f32x4 (&acc)[2][2][4][2], const Unit& u, int wr, int wc, int fr_in, int fq_in) const {
        int fr = fr_in, fq = fq_in; asm volatile("" : "+v"(fr), "+v"(fq));
        const int b = u.pm >> 3, col0 = u.pn * BM + wc * 32 + 4 * fq;
        f32x4 gv[2][2];
#pragma unroll
        for (int bj = 0; bj < 2; ++bj)
#pragma unroll
            for (int n = 0; n < 2; ++n) gv[bj][n] = *(const f32x4*)(mod + (size_t)b * 3072 + 2048 + col0 + bj * HALF + n * 16);
#pragma unroll
        for (int ai = 0; ai < 2; ++ai)
#pragma unroll
            for (int m = 0; m < 4; ++m) { const size_t row = (size_t)u.pm * BM + 128 * ai + 64 * wr + 16 * m + fr; const size_t off = row * 1024 + col0; float q = 0.f;
#pragma unroll
                for (int bj = 0; bj < 2; ++bj)
#pragma unroll
                    for (int n = 0; n < 2; ++n) { const f32x4 xv = *(const f32x4*)(x + off + bj * HALF + n * 16); const f32x4 o = xv + gv[bj][n] * acc[ai][bj][m][n];
                        *(f32x4*)(out + off + bj * HALF + n * 16) = o; q += dot4(o); }
                q += __shfl_xor(q, 16); q += __shfl_xor(q, 32);
                if (fq == 0) RPART[row * 16 + u.pn * 4 + wc] = q; }
    }
};
}
#define GAS __attribute__((address_space(1)))
#define LAS __attribute__((address_space(3)))
typedef unsigned v4u __attribute__((ext_vector_type(4)));
typedef GAS unsigned gu32;
typedef GAS unsigned long long gu64;
#define RLX_AGENT __ATOMIC_RELAXED, __HIP_MEMORY_SCOPE_AGENT
#define LDS_WAIT() asm volatile("s_waitcnt lgkmcnt(0)" ::: "memory")
#define VM_WAIT() asm volatile("s_waitcnt vmcnt(0)" ::: "memory")
__device__ __forceinline__ unsigned long long rt() { return __builtin_amdgcn_s_memrealtime(); }
__device__ __forceinline__ unsigned pk2(float lo, float hi) { return f2bf(lo) | (f2bf(hi) << 16); }
#define XB_TMO      128
#define XB_XCNT(j)  (256  + 64 * (j))
#define XB_XSUB(j)  (1280 + 64 * (j))
#define XB_XGEN(j)  (2304 + 64 * (j))
#define XB_TOP      3328
#define XB_TOPGEN   3392
#define XCD_BAR_WORDS 3456
#define XB_SPIN_CAP (1u << 22)

__device__ __forceinline__ unsigned xb_ld(unsigned* p)              { return __hip_atomic_load(p, __ATOMIC_RELAXED, __HIP_MEMORY_SCOPE_AGENT); }
__device__ __forceinline__ unsigned xb_add(unsigned* p, unsigned v) { return __hip_atomic_fetch_add(p, v, __ATOMIC_RELAXED, __HIP_MEMORY_SCOPE_AGENT); }
__device__ __forceinline__ unsigned xb_xcc_id() { return (unsigned)__builtin_amdgcn_s_getreg((3 << 11) | 20) & 0xFu; }
#define XB_SPIN(cond, bar) do { unsigned _sp = 0; while (cond) { __builtin_amdgcn_s_sleep(1); \
    if ((++_sp & 255u) == 0u) { if (xb_ld(&(bar)[XB_TMO])) break; if (_sp > XB_SPIN_CAP) { atomicAdd(&(bar)[XB_TMO], 1u); break; } } } } while (0)

struct XcdBarrier {
    unsigned* bar; unsigned x;
    volatile LAS unsigned* st;
};

__device__ __forceinline__ XcdBarrier xcd_barrier_post(unsigned* bar, volatile LAS unsigned* st) {
    XcdBarrier b; b.bar = bar; b.x = xb_xcc_id(); b.st = st;
    if (threadIdx.x == 0) (void)xb_add(&bar[XB_XCNT(b.x)], 1u);
    return b;
}
__device__ __forceinline__ void xcd_barrier_complete(unsigned* bar, unsigned x, unsigned& nloc, unsigned& nx) {
    const unsigned G = gridDim.x * gridDim.y * gridDim.z;
    unsigned sum, cnt, mine, sp = 0u;
    for (;;) {
        sum = 0u; cnt = 0u; mine = 0u;
#pragma unroll
        for (unsigned j = 0; j < 16; ++j) { const unsigned c = xb_ld(&bar[XB_XCNT(j)]); sum += c; cnt += (c > 0u) ? 1u : 0u; mine = (j == x) ? c : mine; }
        if (sum == G) break;
        __builtin_amdgcn_s_sleep(1);
        if ((++sp & 255u) == 0u) { if (xb_ld(&bar[XB_TMO])) break; if (sp > XB_SPIN_CAP) { atomicAdd(&bar[XB_TMO], 1u); break; } }
    }
    nloc = mine > 0u ? mine : 1u; nx = cnt > 0u ? cnt : 1u;
}

__device__ __forceinline__ void xcd_barrier(const XcdBarrier& b) {
    asm volatile("s_waitcnt vmcnt(0)" ::: "memory");
    __syncthreads();
    if (threadIdx.x == 0) {
        unsigned* bar = b.bar;
        __builtin_amdgcn_s_waitcnt(0);
        unsigned nloc = b.st[0], nx = b.st[1];
        if (nloc == 0u) { xcd_barrier_complete(bar, b.x, nloc, nx); b.st[0] = nloc; b.st[1] = nx; }
        const unsigned old = xb_add(&bar[XB_XSUB(b.x)], 1u);
        const unsigned gen = old / nloc;
        if (old + 1u == (gen + 1u) * nloc) {
            __builtin_amdgcn_fence(__ATOMIC_RELEASE, "agent");
            asm volatile("s_waitcnt vmcnt(0)" ::: "memory");
            const unsigned og = xb_add(&bar[XB_TOP], 1u);
            const unsigned tg = og / nx;
            if (og + 1u == (tg + 1u) * nx) xb_add(&bar[XB_TOPGEN], 1u);
            else XB_SPIN(xb_ld(&bar[XB_TOPGEN]) == tg, bar);
            __builtin_amdgcn_fence(__ATOMIC_ACQUIRE, "agent");
            xb_add(&bar[XB_XGEN(b.x)], 1u);
            asm volatile("s_waitcnt vmcnt(0)" ::: "memory");
        } else {
            XB_SPIN(xb_ld(&bar[XB_XGEN(b.x)]) == gen, bar);
            __builtin_amdgcn_fence(__ATOMIC_ACQUIRE, "agent");
            asm volatile("s_waitcnt vmcnt(0)" ::: "memory");
        }
    }
    __syncthreads();
}

constexpr int NWAVES = 8;
constexpr int RING_OFF = 0, RING_BYTES = 131072;
constexpr int LDSCTL_OFF = RING_BYTES, MISC_OFF = LDSCTL_OFF + 320;
constexpr int RSTD_OFF = LDSCTL_OFF + 1024;
constexpr int LDS_BYTES = 147456;
constexpr int CW_BAR = 4096;
constexpr int NPHASE = 7;

struct Args { const float* in[18]; float* out; unsigned char* ws; int ph_lo, ph_hi; };

__global__ void __launch_bounds__(NWAVES * 64, 2) mega(Args args) {
    extern __shared__ __attribute__((aligned(16))) unsigned char lds[];
    LAS unsigned char* ldsp = (LAS unsigned char*)lds;
    volatile LAS unsigned* MISC = (volatile LAS unsigned*)(ldsp + MISC_OFF);
    const int tid = threadIdx.x, lane = tid & 63, wave = __builtin_amdgcn_readfirstlane(tid >> 6);
    const int G = gridDim.x; const int bx = blockIdx.x; const int vcu = (G % 8 == 0) ? (bx % 8) * (G / 8) + bx / 8 : bx;
    unsigned char* ws = args.ws;
    gu32* ctl = (gu32*)(ws + WS_CTL);
    float* mod = (float*)(ws + WS_MOD); float* rope = (float*)(ws + WS_ROPE); float* SSQ = (float*)(ws + WS_SSQ); float* RPART = (float*)(ws + WS_RPART);
    bf16* bt1 = (bf16*)(ws + WS_BT1); bf16* bt2 = (bf16*)(ws + WS_BT2); float* DT = (float*)(ws + WS_DT); bf16* KB = (bf16*)(ws + WS_KB); bf16* VB = (bf16*)(ws + WS_VB);
    bf16* H = (bf16*)(ws + WS_R1); bf16* XC = (bf16*)(ws + WS_R1); bf16* XBC = (bf16*)(ws + WS_XBC); bf16* YQ = (bf16*)(ws + WS_YQ); bf16* Z = (bf16*)(ws + WS_Z);
    for (int u = tid; u < (LDS_BYTES - LDSCTL_OFF) / 4; u += NWAVES * 64) ((LAS unsigned*)(ldsp + LDSCTL_OFF))[u] = 0u;
    __syncthreads();
    const int lo = args.ph_lo, hi = args.ph_hi;
    XcdBarrier bar; bar.bar = (unsigned*)(ctl + CW_BAR); bar.x = 0; bar.st = nullptr;
    if (hi - lo > 1) bar = xcd_barrier_post((unsigned*)(ctl + CW_BAR), MISC + 8);
#define IN(k) (lo <= (k) && (k) < hi)
#define SEAM(k) do { if (IN(k) && IN((k) + 1)) xcd_barrier(bar); } while (0)
    (void)vcu; (void)lane; (void)wave; (void)mod; (void)SSQ; (void)XC; (void)bt2; (void)RPART;

    if (IN(2)) {
        pg8::Gemm g{H, bt1, MT, N1, 1024}; pg8::Sched1 S; S.init(G, bx);
        pg8::Epi1 E{KB, VB, XBC, YQ, Z, DT, rope, args.in[13], args.in[14], args.in[10]};
        pg8::gemm_phase<pg8::Epi1, pg8::Sched1, true, true>(ldsp + RING_OFF, g, S, E);
    }
    SEAM(2);
    if (IN(5)) {
        pg8::Sched2 S; S.init(G, bx);
        LAS float* rt = (LAS float*)(ldsp + RSTD_OFF);
        { pg8::Unit u; for (int i = 0; i < 4 && S.next(i, u); ++i) if (tid < 256) { const float* q = SSQ + ((size_t)u.pm * 256 + tid) * 16; float s = 0.f;
#pragma unroll
                for (int j = 0; j < 16; ++j) s += q[j];
                rt[i * 256 + tid] = rsqrtf(s * (1.f / 1024.f) + EPS); } }
        __syncthreads();
        pg8::Gemm g{YQ, bt2, ML, 1024, 2048};
        pg8::Epi2 E{args.in[0], mod, args.out, RPART, (const LAS float*)rt};
        pg8::gemm_phase<pg8::Epi2, pg8::Sched2, true, true>(ldsp + RING_OFF, g, S, E);
    }
    SEAM(5);
#undef IN
#undef SEAM
}

__global__ void k_mod(const float* c, const float* c_ctx, const float* ada_w, const float* ada_b, float* mod) {
    const int i = blockIdx.x * 256 + threadIdx.x; if (i >= 33 * 3072) return;
    const int b = i / 3072, n = i % 3072; const float* cv = b < 32 ? c + b * 1024 : c_ctx;
    float acc = 0.f;
    for (int k = 0; k < 1024; ++k) acc += siluf(cv[k]) * ada_w[(size_t)k * 3072 + n];
    mod[i] = acc + ada_b[n];
}
__global__ void k_tables(float* rope) {
    const int i = blockIdx.x * 256 + threadIdx.x; if (i >= 1024) return;
    const int p = i >> 4, f = i & 15; const float inv = powf(10000.f, -(float)f / 16.f); const float ang = (float)p * inv;
    rope[i] = cosf(ang); rope[1024 + i] = sinf(ang);
}
__global__ void k_bt1(const float* w_in, bf16* bt1) {
    const size_t i = (size_t)blockIdx.x * 256 + threadIdx.x; if (i >= (size_t)N1 * 1024) return;
    const int v = (int)(i >> 10), k = (int)(i & 1023); const int a = vcol_actual(v);
    bt1[i] = (bf16)(a >= 0 ? f2bf(w_in[(size_t)k * PROJ + a]) : 0u);
}
__global__ void k_bt2(const float* w_out, const float* ssd_g, bf16* bt2) {
    const size_t i = (size_t)blockIdx.x * 256 + threadIdx.x; if (i >= (size_t)1024 * 2048) return;
    const int n = (int)(i >> 11), kk = (int)(i & 2047);
    const float v = kk < 1024 ? w_out[(size_t)(1024 + kk) * 1024 + n] * ssd_g[kk] : w_out[(size_t)(kk - 1024) * 1024 + n];
    bt2[i] = (bf16)f2bf(v);
}
__global__ void k_norm(const float* x, const float* ctx, const float* norm_g, const float* mod, bf16* H) {
    const int row = blockIdx.x * 4 + (threadIdx.x >> 6), lane = threadIdx.x & 63; if (row >= MT) return;
    const float* xr = row < ML ? x + (size_t)row * DM : ctx + (size_t)(row - ML) * DM;
    const float* md = mod + (size_t)(row < ML ? row / SEQ : 32) * 3072;
    float v[16]; float s = 0.f;
    for (int j = 0; j < 16; ++j) { v[j] = xr[lane + 64 * j]; s += v[j] * v[j]; }
    for (int o = 1; o < 64; o <<= 1) s += __shfl_xor(s, o);
    const float rstd = rsqrtf(s * (1.f / DM) + EPS);
    for (int j = 0; j < 16; ++j) { const int k = lane + 64 * j; const float h = v[j] * rstd * norm_g[k] * (1.f + md[1024 + k]) + md[k]; H[(size_t)row * DM + k] = (bf16)f2bf(h); }
}
__global__ __launch_bounds__(256) void k_gemm1(const bf16* H, const bf16* bt1, const float* rope, const float* qg, const float* kg, const float* dt_bias,
                                                bf16* KB, bf16* VB, bf16* XBC, float* DT, bf16* YQ, bf16* Z) {
    __shared__ float As[32][65];
    __shared__ float Ps[32][257];
    const int pn = blockIdx.x, rt = blockIdx.y, tid = threadIdx.x; const int row0 = rt * 32;
    if (row0 >= ML && pn > 8) return;
    float acc[32];
    for (int r = 0; r < 32; ++r) acc[r] = 0.f;
    const bf16* bp = bt1 + (size_t)(pn * 256 + tid) * 1024;
    for (int k0 = 0; k0 < 1024; k0 += 64) {
        __syncthreads();
        for (int e = tid; e < 32 * 64; e += 256) { const int r = e >> 6, kk = e & 63; As[r][kk] = bf2f(H[(size_t)(row0 + r) * DM + k0 + kk]); }
        __syncthreads();
        for (int kk = 0; kk < 64; ++kk) { const float b = bf2f(bp[k0 + kk]);
            for (int r = 0; r < 32; ++r) acc[r] += As[r][kk] * b; }
    }
    for (int r = 0; r < 32; ++r) Ps[r][tid] = acc[r];
    __syncthreads();
    const bool isctx = row0 >= ML;
    if (pn == 0 || (pn >= 9 && pn < 13)) {
        {
            const int r = tid >> 3, hd = (tid >> 1) & 3, ax = tid & 1, row = row0 + r; const float* g = pn == 0 ? kg : qg;
            float s = 0.f;
            for (int d = 0; d < 32; ++d) { const float v = Ps[r][hperm_inv(hd, ax * 32 + d)]; s += v * v; }
            s += __shfl_xor(s, 1);
            const float rstd = rsqrtf(s * (1.f / 64.f) + EPS);
            const int t = row % SEQ, p = ax == 0 ? (t >> 6) : (t & 63);
            bf16* dst; float osc = 1.f;
            if (pn == 0) { const int b = isctx ? (row - ML) / CTXL : row / SEQ, pos = isctx ? SEQ + (row - ML) % CTXL : row % SEQ; dst = KB + ((size_t)b * KVL + pos) * 256 + hd * 64 + ax * 32; }
            else { dst = YQ + (size_t)row * 2048 + 1024 + ((pn - 9) * 4 + hd) * 64 + ax * 32; osc = C2; }
            for (int f = 0; f < 16; ++f) {
                const float x1 = Ps[r][hperm_inv(hd, ax * 32 + f)] * rstd * g[ax * 32 + f], x2 = Ps[r][hperm_inv(hd, ax * 32 + 16 + f)] * rstd * g[ax * 32 + 16 + f];
                float o1 = x1, o2 = x2;
                if (!isctx) { const float cs = rope[p * 16 + f], sn = rope[1024 + p * 16 + f]; o1 = x1 * cs - x2 * sn; o2 = x2 * cs + x1 * sn; }
                dst[f] = (bf16)f2bf(o1 * osc); dst[16 + f] = (bf16)f2bf(o2 * osc);
            }
        }
    } else {
        for (int r = 0; r < 32; ++r) { const int row = row0 + r; const float v = Ps[r][tid];
            if (pn == 1) { const int b = isctx ? (row - ML) / CTXL : row / SEQ, pos = isctx ? SEQ + (row - ML) % CTXL : row % SEQ;
                VB[((size_t)b * KVL + pos) * 256 + tid] = (bf16)f2bf(v); }
            else if (pn < 8) XBC[(size_t)row * CONVC + (pn - 2) * 256 + tid] = (bf16)f2bf(v);
            else if (pn == 8) { if (tid < 32) DT[(size_t)row * 32 + tid] = softplusf(v + dt_bias[tid]); }
            else if (pn < 17) YQ[(size_t)row * 2048 + (pn - 13) * 256 + tid] = (bf16)f2bf(siluf(v));
            else Z[(size_t)row * 1024 + (pn - 17) * 256 + tid] = (bf16)f2bf(siluf(v)); }
    }
}
__global__ __launch_bounds__(256) void k_attn(bf16* YQ, const bf16* KB, const bf16* VB) {
    __shared__ float Qs[64][65]; __shared__ float Ks[64][65]; __shared__ float Ps[64][65]; __shared__ bf16 Vs[64][66];
    const int qb = blockIdx.x, h = blockIdx.y, b = blockIdx.z, tid = threadIdx.x, ty = tid >> 4, tx = tid & 15;
    const size_t row0 = (size_t)b * SEQ + qb * 64; const int kvh = h >> 2;
    for (int e = tid; e < 4096; e += 256) { const int r = e >> 6, d = e & 63; Qs[r][d] = bf2f(YQ[(row0 + r) * 2048 + 1024 + h * 64 + d]); }
    float o[4][4], l[4];
    for (int i = 0; i < 4; ++i) { l[i] = 0.f; for (int j = 0; j < 4; ++j) o[i][j] = 0.f; }
    for (int kt = 0; kt < KVL / 64; ++kt) {
        __syncthreads();
        for (int e = tid; e < 4096; e += 256) { const int r = e >> 6, d = e & 63; const size_t src = ((size_t)b * KVL + kt * 64 + r) * 256 + kvh * 64 + d;
            Ks[r][d] = bf2f(KB[src]); Vs[r][d] = VB[src]; }
        __syncthreads();
        float s[4][4];
        for (int i = 0; i < 4; ++i) for (int j = 0; j < 4; ++j) s[i][j] = 0.f;
        for (int d = 0; d < 64; ++d) { float a[4], k4[4];
            for (int i = 0; i < 4; ++i) { a[i] = Qs[ty * 4 + i][d]; k4[i] = Ks[tx * 4 + i][d]; }
            for (int i = 0; i < 4; ++i) for (int j = 0; j < 4; ++j) s[i][j] += a[i] * k4[j]; }
        for (int i = 0; i < 4; ++i) for (int j = 0; j < 4; ++j) Ps[ty * 4 + i][tx * 4 + j] = exp2f(s[i][j]);
        __syncthreads();
        for (int key = 0; key < 64; ++key) { float p[4], v4[4];
            for (int i = 0; i < 4; ++i) { p[i] = Ps[ty * 4 + i][key]; v4[i] = bf2f(Vs[key][tx * 4 + i]); }
            for (int i = 0; i < 4; ++i) { l[i] += p[i]; for (int j = 0; j < 4; ++j) o[i][j] += p[i] * v4[j]; } }
    }
    for (int i = 0; i < 4; ++i) for (int j = 0; j < 4; ++j) { const size_t row = row0 + ty * 4 + i; const int d = tx * 4 + j;
        const float ga = bf2f(YQ[row * 2048 + h * 64 + d]);
        YQ[row * 2048 + 1024 + h * 64 + d] = (bf16)f2bf(o[i][j] / l[i] * ga); }
}
__global__ void k_conv(const bf16* XBC, const float* cw, const float* cb, bf16* XC) {
    const size_t i = (size_t)blockIdx.x * 256 + threadIdx.x; if (i >= (size_t)MT * CONVC) return;
    const int row = (int)(i / CONVC), ch = (int)(i % CONVC);
    int t, len; if (row < ML) { t = row % SEQ; len = SEQ; } else { t = (row - ML) % CTXL; len = CTXL; }
    float acc = cb[ch];
    for (int j = 0; j < 5; ++j) { const int tt = t + j - 2; if (tt >= 0 && tt < len) acc += cw[j * CONVC + ch] * bf2f(XBC[(size_t)(row + j - 2) * CONVC + ch]); }
    XC[i] = (bf16)f2bf(siluf(acc));
}
__global__ __launch_bounds__(512) void k_ssd(const bf16* XC, const float* DT, const bf16* Z, const float* a_log, const float* d_skip, bf16* YQ, float* SSQ) {
    __shared__ float ysq[64];
    const int h = blockIdx.x, b = blockIdx.y, tid = threadIdx.x, p = tid >> 3, nc = tid & 7, g = h >> 3;
    for (int dd = 0; dd < 2; ++dd) { const int d = 1 - dd;
        const float a_neg = -expf(a_log[d * 16 + h]);
        float S[16];
        for (int j = 0; j < 16; ++j) S[j] = 0.f;
        for (int seq = 0; seq < 2; ++seq) { const int len = seq == 0 ? CTXL : SEQ; const size_t rbase = seq == 0 ? (size_t)ML + (size_t)b * CTXL : (size_t)b * SEQ;
            for (int st = 0; st < len; ++st) { const int t = d ? len - 1 - st : st; const size_t row = rbase + t;
                const float dt = DT[row * 32 + d * 16 + h]; const float dec = expf(dt * a_neg);
                const float xs = bf2f(XC[row * CONVC + h * 64 + p]); const float X = xs * dt;
                const bf16* Bp = XC + row * CONVC + 1024 + g * 128 + nc * 16; const bf16* Cp = Bp + 256;
                float y = 0.f;
                for (int j = 0; j < 16; ++j) { S[j] = S[j] * dec + X * bf2f(Bp[j]); y += bf2f(Cp[j]) * S[j]; }
                y += __shfl_xor(y, 1); y += __shfl_xor(y, 2); y += __shfl_xor(y, 4);
                if (seq == 1) {
                    bf16* yp = YQ + row * 2048 + h * 64 + p;
                    if (d == 1) { if (nc == 0) *yp = (bf16)f2bf(y); }
                    else {
                        float yg = 0.f;
                        if (nc == 0) { const float yt = y + bf2f(*yp) + d_skip[h] * xs; yg = yt * bf2f(Z[row * 1024 + h * 64 + p]); *yp = (bf16)f2bf(yg); ysq[p] = yg * yg; }
                        __syncthreads();
                        if (tid < 64) { float q = ysq[tid]; for (int o = 1; o < 64; o <<= 1) q += __shfl_xor(q, o); if (tid == 0) SSQ[row * 16 + h] = q; }
                        __syncthreads();
                    }
                }
            }
        }
    }
}
__global__ __launch_bounds__(256) void k_gemm2(const bf16* YQ, const bf16* bt2, const float* SSQ, const float* x, const float* mod, float* out, float* RPART) {
    __shared__ float As[32][65]; __shared__ float red[32][4];
    const int pn = blockIdx.x, rt = blockIdx.y, tid = threadIdx.x, row0 = rt * 32;
    float acc[32];
    for (int r = 0; r < 32; ++r) acc[r] = 0.f;
    const bf16* bp = bt2 + (size_t)(pn * 256 + tid) * 2048;
    for (int k0 = 0; k0 < 2048; k0 += 64) {
        if (k0 == 1024) { for (int r = 0; r < 32; ++r) { float s = 0.f; for (int j = 0; j < 16; ++j) s += SSQ[(size_t)(row0 + r) * 16 + j]; acc[r] *= rsqrtf(s * (1.f / 1024.f) + EPS); } }
        __syncthreads();
        for (int e = tid; e < 32 * 64; e += 256) { const int r = e >> 6, kk = e & 63; As[r][kk] = bf2f(YQ[(size_t)(row0 + r) * 2048 + k0 + kk]); }
        __syncthreads();
        for (int kk = 0; kk < 64; ++kk) { const float bv = bf2f(bp[k0 + kk]);
            for (int r = 0; r < 32; ++r) acc[r] += As[r][kk] * bv; }
    }
    const int n = pn * 256 + tid;
    for (int r = 0; r < 32; ++r) { const int row = row0 + r; const float v = x[(size_t)row * DM + n] + mod[(size_t)(row / SEQ) * 3072 + 2048 + n] * acc[r];
        out[(size_t)row * DM + n] = v; float q = v * v;
        for (int o = 1; o < 64; o <<= 1) q += __shfl_xor(q, o);
        if ((tid & 63) == 0) RPART[(size_t)row * 16 + pn * 4 + (tid >> 6)] = q; }
}
__global__ void k_final(float* out, const float* RPART, const float* fg) {
    const int row = blockIdx.x * 4 + (threadIdx.x >> 6), lane = threadIdx.x & 63;
    float s = 0.f;
    for (int j = 0; j < 16; ++j) s += RPART[(size_t)row * 16 + j];
    const float rstd = rsqrtf(s * (1.f / DM) + EPS);
    for (int j = 0; j < 16; ++j) { const int k = lane + 64 * j; out[(size_t)row * DM + k] *= rstd * fg[k]; }
}


#ifndef FAST_MASK
#define FAST_MASK ((1 << 2) | (1 << 5))
#endif
extern "C" void kernel_launch(void* const* d_in, const int* in_sizes, int n_in, void* d_out, int out_size, void* d_ws, size_t ws_size, hipStream_t stream) {
    if (n_in != 18 || out_size != ML * DM || ws_size < WS_END) { fprintf(stderr, "kernel_launch: unexpected shapes (n_in %d out %d ws %zu)\n", n_in, out_size, ws_size); return; }
    static int grid = 0;
    if (grid == 0) {
        int dev = 0, cus = 0;
        if (hipGetDevice(&dev) != hipSuccess || hipDeviceGetAttribute(&cus, hipDeviceAttributeMultiprocessorCount, dev) != hipSuccess) { fprintf(stderr, "kernel_launch: device query failed\n"); grid = -1; return; }
        if (hipFuncSetAttribute((const void*)mega, hipFuncAttributeMaxDynamicSharedMemorySize, LDS_BYTES) != hipSuccess) { fprintf(stderr, "kernel_launch: hipFuncSetAttribute failed\n"); grid = -1; return; }
        int per_cu = 0;
        if (hipOccupancyMaxActiveBlocksPerMultiprocessor(&per_cu, (const void*)mega, NWAVES * 64, LDS_BYTES) != hipSuccess || per_cu < 1) fprintf(stderr, "kernel_launch: note: occupancy query says %d blocks/CU\n", per_cu);
        (void)hipGetLastError();
        grid = cus;
    }
    if (grid < 0) return;
    const float* x = (const float*)d_in[0]; const float* c = (const float*)d_in[1]; const float* ctx = (const float*)d_in[2]; const float* c_ctx = (const float*)d_in[3];
    const float* ada_w = (const float*)d_in[4]; const float* ada_b = (const float*)d_in[5]; const float* norm_g = (const float*)d_in[6]; const float* w_in = (const float*)d_in[7];
    const float* conv_w = (const float*)d_in[8]; const float* conv_b = (const float*)d_in[9]; const float* dt_bias = (const float*)d_in[10]; const float* a_log = (const float*)d_in[11];
    const float* d_skip = (const float*)d_in[12]; const float* qg = (const float*)d_in[13]; const float* kg = (const float*)d_in[14]; const float* ssd_g = (const float*)d_in[15];
    const float* w_out = (const float*)d_in[16]; const float* final_g = (const float*)d_in[17];
    unsigned char* ws = (unsigned char*)d_ws; float* out = (float*)d_out;
    float* mod = (float*)(ws + WS_MOD); float* rope = (float*)(ws + WS_ROPE); float* SSQ = (float*)(ws + WS_SSQ); float* RPART = (float*)(ws + WS_RPART);
    bf16* bt1 = (bf16*)(ws + WS_BT1); bf16* bt2 = (bf16*)(ws + WS_BT2); float* DT = (float*)(ws + WS_DT); bf16* KB = (bf16*)(ws + WS_KB); bf16* VB = (bf16*)(ws + WS_VB);
    bf16* H = (bf16*)(ws + WS_R1); bf16* XC = (bf16*)(ws + WS_R1); bf16* XBC = (bf16*)(ws + WS_XBC); bf16* YQ = (bf16*)(ws + WS_YQ); bf16* Z = (bf16*)(ws + WS_Z);
    (void)hipMemsetAsync(ws + WS_CTL, 0, 1 * MiB, stream);
    Args a{};
    for (int i = 0; i < 18; ++i) a.in[i] = (const float*)d_in[i];
    a.out = out; a.ws = ws;
    for (int ph = 0; ph < NPHASE;) {
        if ((FAST_MASK >> ph) & 1) { int e = ph; while (e < NPHASE && ((FAST_MASK >> e) & 1)) ++e;
            a.ph_lo = ph; a.ph_hi = e; hipLaunchKernelGGL(mega, dim3(grid), dim3(NWAVES * 64), LDS_BYTES, stream, a);
            const hipError_t le = hipPeekAtLastError(); if (le != hipSuccess) fprintf(stderr, "kernel_launch: mega launch failed: %s\n", hipGetErrorName(le));
            ph = e; continue; }
        switch (ph) {
        case 0: k_mod<<<(33 * 3072 + 255) / 256, 256, 0, stream>>>(c, c_ctx, ada_w, ada_b, mod); k_tables<<<4, 256, 0, stream>>>(rope);
                k_bt1<<<(N1 * 1024) / 256, 256, 0, stream>>>(w_in, bt1); k_bt2<<<(1024 * 2048) / 256, 256, 0, stream>>>(w_out, ssd_g, bt2); break;
        case 1: k_norm<<<MT / 4, 256, 0, stream>>>(x, ctx, norm_g, mod, H); break;
        case 2: k_gemm1<<<dim3(21, MT / 32), 256, 0, stream>>>(H, bt1, rope, qg, kg, dt_bias, KB, VB, XBC, DT, YQ, Z); break;
        case 3: k_attn<<<dim3(SEQ / 64, 16, NB), 256, 0, stream>>>(YQ, KB, VB); k_conv<<<(unsigned)(((size_t)MT * CONVC + 255) / 256), 256, 0, stream>>>(XBC, conv_w, conv_b, XC); break;
        case 4: k_ssd<<<dim3(16, NB), 512, 0, stream>>>(XC, DT, Z, a_log, d_skip, YQ, SSQ); break;
        case 5: k_gemm2<<<dim3(4, ML / 32), 256, 0, stream>>>(YQ, bt2, SSQ, x, mod, out, RPART); break;
        case 6: k_final<<<ML / 4, 256, 0, stream>>>(out, RPART, final_g); break;
        }
        ++ph;
    }
}
```

```cpp
#include <hip/hip_runtime.h>
#include <cstdio>
#include <cstdint>
#include <hip/hip_bf16.h>

constexpr int DM = 1024, NB = 32, SEQ = 2048, CTXL = 256, KVL = SEQ + CTXL;
constexpr int ML = NB * SEQ, MC = NB * CTXL, MT = ML + MC;
constexpr int PROJ = 5152, OFF_XBC = 512, OFF_DT = 2048, CTXC = 2080, CONVC = 1536;
constexpr int N1 = 21 * 256;
constexpr float EPS = 1e-6f;
constexpr float C2 = 0.125f * 1.4426950408889634f;

typedef unsigned short bf16;
__host__ __device__ __forceinline__ unsigned f2bf(float f) { unsigned u = __builtin_bit_cast(unsigned, f); return (u + 0x7fffu + ((u >> 16) & 1u)) >> 16; }
__host__ __device__ __forceinline__ float bf2f(unsigned h) { return __builtin_bit_cast(float, (h & 0xffffu) << 16); }
__device__ __forceinline__ float siluf(float v) { return v / (1.f + __expf(-v)); }
__device__ __forceinline__ float softplusf(float v) { return v > 20.f ? v : log1pf(expf(v)); }

constexpr size_t MiB = 1u << 20;
constexpr size_t WS_CTL = 0;
constexpr size_t WS_MOD = 2 * MiB;
constexpr size_t WS_ROPE = 3 * MiB;
constexpr size_t WS_SSQ = 4 * MiB;
constexpr size_t WS_RPART = 8 * MiB;
constexpr size_t WS_BT1 = 12 * MiB;
constexpr size_t WS_BT2 = 23 * MiB;
constexpr size_t WS_DT = 28 * MiB;
constexpr size_t WS_KB = 38 * MiB;
constexpr size_t WS_VB = 74 * MiB;
constexpr size_t WS_R1 = 110 * MiB;
constexpr size_t WS_XBC = 326 * MiB;
constexpr size_t WS_YQ = 542 * MiB;
constexpr size_t WS_Z = 798 * MiB;
constexpr size_t WS_END = 926 * MiB;

__host__ __device__ __forceinline__ int hperm_dim(int vin) {
    const int bj = vin >> 7, wc = (vin >> 5) & 3, s = vin & 31, fq = s >> 3, e = s & 7;
    return wc * 64 + bj * 32 + (e >> 2) * 16 + 4 * fq + (e & 3);
}
__host__ __device__ __forceinline__ int hperm_inv(int head, int dim) {
    const int axis = dim >> 5, half = (dim >> 4) & 1, i16 = dim & 15, fq = i16 >> 2, e = (i16 & 3) + 4 * half;
    return 128 * axis + 32 * head + 8 * fq + e;
}
__host__ __device__ __forceinline__ int vcol_actual(int v) {
    const int t = v >> 8, vin = v & 255;
    if (t == 0) return hperm_dim(vin);
    if (t == 1) return 256 + vin;
    if (t < 8) return v;
    if (t == 8) return vin < 32 ? OFF_DT + vin : -1;
    if (t < 13) return CTXC + (t - 9) * 256 + hperm_dim(vin);
    if (t < 17) return CTXC + 1024 + (v - 13 * 256);
    return CTXC + 2048 + (v - 17 * 256);
}

namespace pg8 {
#define PG8_LAS __attribute__((address_space(3)))
typedef unsigned short bf16_t;
typedef short bf16x8 __attribute__((ext_vector_type(8)));
typedef float f32x4 __attribute__((ext_vector_type(4)));
typedef unsigned u32x4 __attribute__((ext_vector_type(4)));
constexpr int BM = 256, BK = 64, HALF = 128, HTB = HALF * BK * 2  , STAGE_BYTES = 8 * HTB, NXCD = 8, WGM = 8;

__host__ __device__ __forceinline__ int lds_byte(int r, int c) { const int st = (r >> 4) * 2 + (c >> 5), rr = r & 15, cc = c & 31, ob = rr * 64 + cc * 2; return st * 1024 + (ob ^ (((ob >> 9) & 1) << 5)); }
__host__ __device__ __forceinline__ void stage_rc(int b, int& R, int& C) { const int st = b / 1024, sb = b % 1024, swz = sb ^ (((sb >> 9) & 1) << 5); R = (st >> 1) * 16 + swz / 64; C = (st & 1) * 32 + (swz % 64) / 2; }
__host__ __device__ __forceinline__ int perm32(int rho) { const int n = rho >> 4, i = rho & 15; return 8 * (i >> 2) + 4 * n + (i & 3); }

struct Unit { int pm, pn; };
struct Gemm { const bf16_t* A; const bf16_t* Bt; int M, N, K; };

__device__ __forceinline__ unsigned cvt_pk_bf16(float lo, float hi) { unsigned r; asm volatile("v_cvt_pk_bf16_f32 %0, %1, %2" : "=v"(r) : "v"(lo), "v"(hi)); return r; }
typedef float f32x2 __attribute__((ext_vector_type(2)));
template <class Epi, class Sched, bool ALIGN_EPI = false, bool SP2 = false>
__device__ __forceinline__ void gemm_phase(PG8_LAS unsigned char* lds, const Gemm g, const Sched& S, const Epi& E) {
    const int tid = threadIdx.x, wid = __builtin_amdgcn_readfirstlane(tid >> 6), lane = tid & 63, wr = wid >> 2, wc = wid & 3, fr = lane & 15, fq = lane >> 4;
    const int K = g.K, nt = K / BK;
    unsigned voffA[2], voffB[2];
#pragma unroll
    for (int i = 0; i < 2; ++i) { int R, C; stage_rc(tid * 16 + i * 8192, R, C); const int Rb = Epi::PERM ? ((R & ~31) + perm32(R & 31)) : R;
        voffA[i] = (unsigned)(R * K + C) * 2u; voffB[i] = (unsigned)(Rb * K + C) * 2u; }
    const size_t kstep = (size_t)(BK * 2);
    const size_t hstep = (size_t)HALF * K * 2;
    const size_t tstep = 2 * hstep;
    const unsigned ldsw = (unsigned)wid * 1024u;
    const int aoff = lds_byte(wr * 64 + fr, fq * 8), boff = lds_byte(wc * 32 + fr, fq * 8);
#define PG8_SA(b, h) (((b) * 2 + (h)) * HTB)
#define PG8_SB(b, h) ((4 + (b) * 2 + (h)) * HTB)
#define PG8_STAGE(bufoff, gbase, voff) do { _Pragma("unroll") for (int _i = 0; _i < 2; ++_i) \
        __builtin_amdgcn_global_load_lds((const unsigned*)((const char*)(gbase) + (voff)[_i]), (PG8_LAS unsigned*)(lds + (bufoff) + ldsw + _i * 8192), 16, 0, 0); } while (0)
#define PG8_LDA(dst, b, h) do { _Pragma("unroll") for (int m = 0; m < 4; ++m) _Pragma("unroll") for (int k = 0; k < 2; ++k) dst[m][k] = *(const PG8_LAS bf16x8*)(lds + PG8_SA(b, h) + aoff + m * 2048 + k * 1024); } while (0)
#define PG8_LDB(dst, b, h) do { _Pragma("unroll") for (int n = 0; n < 2; ++n) _Pragma("unroll") for (int k = 0; k < 2; ++k) dst[n][k] = *(const PG8_LAS bf16x8*)(lds + PG8_SB(b, h) + boff + n * 2048 + k * 1024); } while (0)
#define PG8_MMA(ai, bj, At, Bt) do { __builtin_amdgcn_s_setprio(1); _Pragma("unroll") for (int m = 0; m < 4; ++m) _Pragma("unroll") for (int n = 0; n < 2; ++n) _Pragma("unroll") for (int k = 0; k < 2; ++k) \
        acc[ai][bj][m][n] = __builtin_amdgcn_mfma_f32_16x16x32_bf16(Bt[n][k], At[m][k], acc[ai][bj][m][n], 0, 0, 0); __builtin_amdgcn_s_setprio(0); } while (0)
#define PG8_WAIT_V(n) asm volatile("s_waitcnt vmcnt(" #n ")" ::: "memory")
#define PG8_WAIT_L(n) asm volatile("s_waitcnt lgkmcnt(" #n ")" ::: "memory")
#define PG8_BAR __builtin_amdgcn_s_barrier()
#define PG8_SCHED __builtin_amdgcn_sched_barrier(0)
    Unit cur, nxt; int ui = 0;
    if (!S.next(0, cur)) return;
    f32x4 acc[2][2][4][2];
#pragma unroll
    for (int a = 0; a < 2; ++a)
#pragma unroll
        for (int b = 0; b < 2; ++b)
#pragma unroll
            for (int m = 0; m < 4; ++m)
#pragma unroll
                for (int n = 0; n < 2; ++n) acc[a][b][m][n] = (f32x4){0.f, 0.f, 0.f, 0.f};
    bf16x8 At[4][2], B0[2][2], B1[2][2];
    const char* cA = (const char*)g.A + (size_t)cur.pm * tstep; const char* cB = (const char*)g.Bt + (size_t)cur.pn * tstep;
    S.a_ready(cur);
    if constexpr (SP2) {
        PG8_STAGE(PG8_SB(0, 0), cB, voffB); PG8_STAGE(PG8_SB(0, 1), cB + hstep, voffB); PG8_STAGE(PG8_SA(0, 0), cA, voffA); PG8_STAGE(PG8_SA(0, 1), cA + hstep, voffA);
        if (wr == 1) PG8_BAR;
        PG8_WAIT_V(2); PG8_BAR;
        PG8_STAGE(PG8_SB(1, 0), cB + kstep, voffB); PG8_STAGE(PG8_SA(1, 0), cA + kstep, voffA); PG8_STAGE(PG8_SB(1, 1), cB + hstep + kstep, voffB);
        PG8_WAIT_V(6); PG8_BAR;
    } else {
        PG8_STAGE(PG8_SB(0, 0), cB, voffB); PG8_STAGE(PG8_SA(0, 0), cA, voffA); PG8_STAGE(PG8_SB(0, 1), cB + hstep, voffB); PG8_STAGE(PG8_SA(0, 1), cA + hstep, voffA);
        if (wr == 1) PG8_BAR;
        PG8_WAIT_V(4); PG8_BAR;
        PG8_STAGE(PG8_SB(1, 0), cB + kstep, voffB); PG8_STAGE(PG8_SA(1, 0), cA + kstep, voffA); PG8_STAGE(PG8_SB(1, 1), cB + hstep + kstep, voffB);
        PG8_WAIT_V(6); PG8_BAR;
    }
    for (;;) {
        const bool has_next = S.next(ui + 1, nxt);
        const char* nA = has_next ? (const char*)g.A + (size_t)nxt.pm * tstep : cA; const char* nB = has_next ? (const char*)g.Bt + (size_t)nxt.pn * tstep : cB;
        for (int t = 0; t < nt; t += 2) {
            if constexpr (Epi::MIDK) { if (t == nt / 2) E.midk(acc, ui, wr, fr); }
            const bool last = (t == nt - 2);
            const char* a1 = cA + (size_t)(t + 1) * kstep;
            const char* a2 = last ? nA : cA + (size_t)(t + 2) * kstep; const char* b2 = last ? nB : cB + (size_t)(t + 2) * kstep;
            const char* a3 = a2 + kstep; const char* b3 = b2 + kstep;
            if (last && has_next) S.a_ready(nxt);
            if constexpr (SP2) {
            PG8_LDB(B0, 0, 0); PG8_LDB(B1, 0, 1); PG8_SCHED; PG8_LDA(At, 0, 0); PG8_STAGE(PG8_SA(1, 1), a1 + hstep, voffA);
            PG8_WAIT_V(8); PG8_WAIT_L(0); PG8_BAR; PG8_MMA(0, 0, At, B0); PG8_MMA(0, 1, At, B1); PG8_BAR; PG8_SCHED;
            PG8_LDA(At, 0, 1); PG8_STAGE(PG8_SB(0, 0), b2, voffB); PG8_STAGE(PG8_SB(0, 1), b2 + hstep, voffB); PG8_STAGE(PG8_SA(0, 0), a2, voffA);
            PG8_WAIT_V(8); PG8_WAIT_L(0); PG8_BAR; PG8_MMA(1, 0, At, B0); PG8_MMA(1, 1, At, B1); PG8_BAR; PG8_SCHED;
            PG8_LDB(B0, 1, 0); PG8_LDB(B1, 1, 1); PG8_SCHED; PG8_LDA(At, 1, 0); PG8_STAGE(PG8_SA(0, 1), a2 + hstep, voffA);
            PG8_WAIT_V(8); PG8_WAIT_L(0); PG8_BAR; PG8_MMA(0, 0, At, B0); PG8_MMA(0, 1, At, B1); PG8_BAR; PG8_SCHED;
            PG8_LDA(At, 1, 1); PG8_STAGE(PG8_SB(1, 0), b3, voffB); PG8_STAGE(PG8_SB(1, 1), b3 + hstep, voffB); PG8_STAGE(PG8_SA(1, 0), a3, voffA);
            PG8_WAIT_V(8); PG8_WAIT_L(0); PG8_BAR; PG8_MMA(1, 0, At, B0); PG8_MMA(1, 1, At, B1); PG8_BAR; PG8_SCHED;
            } else {
            PG8_LDB(B0, 0, 0); PG8_SCHED; PG8_LDA(At, 0, 0); PG8_STAGE(PG8_SA(1, 1), a1 + hstep, voffA);
            PG8_WAIT_L(8); PG8_BAR; PG8_WAIT_L(0); PG8_MMA(0, 0, At, B0); PG8_BAR; PG8_SCHED;
            PG8_LDB(B1, 0, 1); PG8_STAGE(PG8_SB(0, 0), b2, voffB);
            PG8_BAR; PG8_WAIT_L(0); PG8_MMA(0, 1, At, B1); PG8_BAR;
            PG8_LDA(At, 0, 1); PG8_STAGE(PG8_SA(0, 0), a2, voffA);
            PG8_BAR; PG8_WAIT_L(0); PG8_MMA(1, 0, At, B0); PG8_BAR; PG8_SCHED;
            PG8_STAGE(PG8_SB(0, 1), b2 + hstep, voffB);
            PG8_WAIT_V(6); PG8_BAR; PG8_MMA(1, 1, At, B1); PG8_BAR;
            PG8_LDB(B0, 1, 0); PG8_SCHED; PG8_LDA(At, 1, 0); PG8_STAGE(PG8_SA(0, 1), a2 + hstep, voffA);
            PG8_WAIT_L(8); PG8_BAR; PG8_WAIT_L(0); PG8_MMA(0, 0, At, B0); PG8_BAR; PG8_SCHED;
            PG8_LDB(B1, 1, 1); PG8_STAGE(PG8_SB(1, 0), b3, voffB);
            PG8_BAR; PG8_WAIT_L(0); PG8_MMA(0, 1, At, B1); PG8_BAR;
            PG8_LDA(At, 1, 1); PG8_STAGE(PG8_SA(1, 0), a3, voffA);
            PG8_BAR; PG8_WAIT_L(0); PG8_MMA(1, 0, At, B0); PG8_BAR; PG8_SCHED;
            PG8_STAGE(PG8_SB(1, 1), b3 + hstep, voffB);
            PG8_WAIT_V(6); PG8_BAR; PG8_MMA(1, 1, At, B1); PG8_BAR;
            }
        }
        if constexpr (ALIGN_EPI) { if (wr == 0) PG8_BAR; }
        if constexpr (!Epi::AFTER_DRAIN) { E(acc, cur, wr, wc, fr, fq); S.done(cur); }
        if (!has_next) break;
#pragma unroll
        for (int a = 0; a < 2; ++a)
#pragma unroll
            for (int b = 0; b < 2; ++b)
#pragma unroll
                for (int m = 0; m < 4; ++m)
#pragma unroll
                    for (int n = 0; n < 2; ++n) acc[a][b][m][n] = (f32x4){0.f, 0.f, 0.f, 0.f};
        cur = nxt; cA = nA; cB = nB; ++ui;
        if constexpr (ALIGN_EPI) { if (wr == 1) PG8_BAR; }
    }
    PG8_WAIT_V(0);
    if constexpr (!ALIGN_EPI) { if (wr == 0) PG8_BAR; }
    PG8_BAR;
    if constexpr (Epi::AFTER_DRAIN) { E.fused(acc, cur, wr, wc, fr, fq, lds, wid, lane); S.done(cur); }
#undef PG8_SA
#undef PG8_SB
#undef PG8_STAGE
#undef PG8_LDA
#undef PG8_LDB
#undef PG8_MMA
#undef PG8_WAIT_V
#undef PG8_WAIT_L
#undef PG8_BAR
#undef PG8_SCHED
}
struct Sched1 {
    int G, c;
    __device__ __forceinline__ void init(int G_, int c_) { G = G_; c = c_; }
    __device__ __forceinline__ bool next(int i, Unit& u) const {
        constexpr int nN = 21, nwg = 256 * nN;
        const int L = i * G + c;
        if (L < nwg) { const int wgid = (L % NXCD) * (nwg / NXCD) + L / NXCD; const int nig = WGM * nN, fm = (wgid / nig) * WGM;
            u.pm = fm + ((wgid % nig) % WGM); u.pn = (wgid % nig) / WGM; return true; }
        const int L2 = L - nwg; if (L2 >= 288) return false;
        const int wg = (L2 % NXCD) * 36 + L2 / NXCD; u.pn = wg >> 5; u.pm = 256 + (wg & 31); return true;
    }
    __device__ __forceinline__ void a_ready(const Unit&) const {}
    __device__ __forceinline__ void done(const Unit&) const {}
};
struct Sched2 {
    int G, c;
    __device__ __forceinline__ void init(int G_, int c_) { G = G_; c = c_; }
    __device__ __forceinline__ bool next(int i, Unit& u) const {
        constexpr int nN = 4, nwg = 256 * nN;
        const int L = i * G + c; if (L >= nwg) return false;
        const int wgid = (L % NXCD) * (nwg / NXCD) + L / NXCD; const int nig = WGM * nN, fm = (wgid / nig) * WGM;
        u.pm = fm + ((wgid % nig) % WGM); u.pn = (wgid % nig) / WGM; return true;
    }
    __device__ __forceinline__ void a_ready(const Unit&) const {}
    __device__ __forceinline__ void done(const Unit&) const {}
};
__device__ __forceinline__ float dot4(const f32x4 a) { return (a[0] * a[0] + a[1] * a[1]) + (a[2] * a[2] + a[3] * a[3]); }
__device__ __forceinline__ float silu1(float v) { return v * __builtin_amdgcn_rcpf(1.f + __expf(-v)); }
typedef unsigned u32x2 __attribute__((ext_vector_type(2)));
__device__ __forceinline__ u32x2 pk4(const f32x4 v) { u32x2 w; w.x = cvt_pk_bf16(v[0], v[1]); w.y = cvt_pk_bf16(v[2], v[3]); return w; }
struct Epi1 {
    static constexpr bool PERM = true, AFTER_DRAIN = false, MIDK = false;
    bf16_t *KB, *VB, *XBC, *YQ, *Z; float* DT; const float *rope, *qg, *kg, *dt_bias;
    __device__ __forceinline__ void midk(f32x4 (&)[2][2][4][2], int, int, int) const {}
    __device__ __forceinline__ void operator()(const f32x4 (&acc)[2][2][4][2], const Unit& u, int wr, int wc, int fr_in, int fq_in) const {
        int fr = fr_in, fq = fq_in; asm volatile("" : "+v"(fr), "+v"(fq));
        const int pn = u.pn, pm = u.pm; const bool isctx = pm >= 256; const int rloc = wr * 64 + fr;
        const int bb = isctx ? pm - 256 : pm >> 3, pos0 = isctx ? SEQ : (pm & 7) * 256;
        if (pn == 0 || (pn >= 9 && pn < 13)) {
            const float* g = pn == 0 ? kg : qg;
            const f32x4 g00 = *(const f32x4*)(g + 4 * fq), g01 = *(const f32x4*)(g + 16 + 4 * fq), g10 = *(const f32x4*)(g + 32 + 4 * fq), g11 = *(const f32x4*)(g + 48 + 4 * fq);
            const float osc = pn == 0 ? 1.f : C2;
            bf16_t* dbase; size_t pitch;
            if (pn == 0) { dbase = KB + ((size_t)bb * KVL + pos0) * 256 + wc * 64 + 4 * fq; pitch = 256; }
            else { dbase = YQ + (size_t)pm * 256 * 2048 + 1024 + ((pn - 9) * 4 + wc) * 64 + 4 * fq; pitch = 2048; }
#pragma unroll
            for (int ai = 0; ai < 2; ++ai) {
                const int prow = (pm & 7) * 4 + 2 * ai + wr;
                f32x4 c0 = (f32x4){1.f, 1.f, 1.f, 1.f}, s0 = (f32x4){0.f, 0.f, 0.f, 0.f};
                if (!isctx) { c0 = *(const f32x4*)(rope + prow * 16 + 4 * fq); s0 = *(const f32x4*)(rope + 1024 + prow * 16 + 4 * fq); }
#pragma unroll
                for (int m = 0; m < 4; ++m) {
                    f32x4 a0 = acc[ai][0][m][0], a1 = acc[ai][0][m][1], b0 = acc[ai][1][m][0], b1 = acc[ai][1][m][1];
                    float s = (dot4(a0) + dot4(a1)) + (dot4(b0) + dot4(b1));
                    s += __shfl_xor(s, 16); s += __shfl_xor(s, 32);
                    const float rstd = rsqrtf(s * (1.f / 64.f) + EPS) * osc;
                    a0 = a0 * rstd * g00; a1 = a1 * rstd * g01; b0 = b0 * rstd * g10; b1 = b1 * rstd * g11;
                    f32x4 c1 = (f32x4){1.f, 1.f, 1.f, 1.f}, s1 = (f32x4){0.f, 0.f, 0.f, 0.f};
                    if (!isctx) { const int pcol = 16 * m + fr; c1 = *(const f32x4*)(rope + pcol * 16 + 4 * fq); s1 = *(const f32x4*)(rope + 1024 + pcol * 16 + 4 * fq); }
                    const f32x4 o00 = a0 * c0 - a1 * s0, o01 = a1 * c0 + a0 * s0, o10 = b0 * c1 - b1 * s1, o11 = b1 * c1 + b0 * s1;
                    bf16_t* dst = dbase + (size_t)(rloc + 128 * ai + 16 * m) * pitch;
                    *(u32x2*)(dst) = pk4(o00); *(u32x2*)(dst + 16) = pk4(o01); *(u32x2*)(dst + 32) = pk4(o10); *(u32x2*)(dst + 48) = pk4(o11);
                    asm volatile("" ::: "memory");
                }
            }
        } else if (pn == 8) {
            if (wc == 0) {
                const f32x4 bA = *(const f32x4*)(dt_bias + 8 * fq), bB = *(const f32x4*)(dt_bias + 8 * fq + 4);
#pragma unroll
                for (int ai = 0; ai < 2; ++ai)
#pragma unroll
                    for (int m = 0; m < 4; ++m) { const size_t row = (size_t)pm * 256 + rloc + 128 * ai + 16 * m;
                        f32x4 v0 = acc[ai][0][m][0] + bA, v1 = acc[ai][0][m][1] + bB;
#pragma unroll
                        for (int e = 0; e < 4; ++e) { v0[e] = v0[e] > 20.f ? v0[e] : log1pf(__expf(v0[e])); v1[e] = v1[e] > 20.f ? v1[e] : log1pf(__expf(v1[e])); }
                        *(f32x4*)(DT + row * 32 + 8 * fq) = v0; *(f32x4*)(DT + row * 32 + 8 * fq + 4) = v1; asm volatile("" ::: "memory"); }
            }
        } else {
            bf16_t* dbase; size_t pitch; bool act = false;
            const int cin = wc * 32 + 8 * fq;
            if (pn == 1) { dbase = VB + ((size_t)bb * KVL + pos0) * 256 + cin; pitch = 256; }
            else if (pn < 8) { dbase = XBC + (size_t)pm * 256 * CONVC + (pn - 2) * 256 + cin; pitch = CONVC; }
            else if (pn < 17) { dbase = YQ + (size_t)pm * 256 * 2048 + (pn - 13) * 256 + cin; pitch = 2048; act = true; }
            else { dbase = Z + (size_t)pm * 256 * 1024 + (pn - 17) * 256 + cin; pitch = 1024; act = true; }
#pragma unroll
            for (int ai = 0; ai < 2; ++ai)
#pragma unroll
                for (int m = 0; m < 4; ++m) { bf16_t* dst = dbase + (size_t)(rloc + 128 * ai + 16 * m) * pitch;
#pragma unroll
                    for (int bj = 0; bj < 2; ++bj) { f32x4 v0 = acc[ai][bj][m][0], v1 = acc[ai][bj][m][1];
                        if (act) {
#pragma unroll
                            for (int e = 0; e < 4; ++e) { v0[e] = silu1(v0[e]); v1[e] = silu1(v1[e]); } }
                        u32x4 w; w.x = cvt_pk_bf16(v0[0], v0[1]); w.y = cvt_pk_bf16(v0[2], v0[3]); w.z = cvt_pk_bf16(v1[0], v1[1]); w.w = cvt_pk_bf16(v1[2], v1[3]);
                        *(u32x4*)(dst + bj * HALF) = w; } asm volatile("" ::: "memory"); }
        }
    }
};
struct Epi2 {
    static constexpr bool PERM = false, AFTER_DRAIN = false, MIDK = true;
    const float* x; const float* mod; float* out; float* RPART; const PG8_LAS float* rstd_tab;
    __device__ __forceinline__ void midk(f32x4 (&acc)[2][2][4][2], int ui, int wr, int fr) const {
#pragma unroll
        for (int ai = 0; ai < 2; ++ai)
#pragma unroll
            for (int m = 0; m < 4; ++m) { const float r = rstd_tab[ui * 256 + 128 * ai + 64 * wr + 16 * m + fr];
#pragma unroll
                for (int bj = 0; bj < 2; ++bj)
#pragma unroll
                    for (int n = 0; n < 2; ++n) acc[ai][bj][m][n] *= r; }
    }
    __device__ __forceinline__ void operator()(const f32x4 (&acc)[2][2][4][2], const Unit& u, int wr, int wc, int fr_in, int fq_in) const {
        int fr = fr_in, fq = fq_in; asm volatile("" : "+v"(fr), "+v"(fq));
        const int b = u.pm >> 3, col0 = u.pn * BM + wc * 32 + 4 * fq;
        f32x4 gv[2][2];
#pragma unroll
        for (int bj = 0; bj < 2; ++bj)
#pragma unroll
            for (int n = 0; n < 2; ++n) gv[bj][n] = *(const f32x4*)(mod + (size_t)b * 3072 + 2048 + col0 + bj * HALF + n * 16);
#pragma unroll
        for (int ai = 0; ai < 2; ++ai)
#pragma unroll
            for (int m = 0; m < 4; ++m) { const size_t row = (size_t)u.pm * BM + 128 * ai + 64 * wr + 16 * m + fr; const size_t off = row * 1024 + col0; float q = 0.f;
#pragma unroll
                for (int bj = 0; bj < 2; ++bj)
#pragma unroll
                    for (int n = 0; n < 2; ++n) { const f32x4 xv = *(const f32x4*)(x + off + bj * HALF + n * 16); const f32x4 o = xv + gv[bj][n] * acc[ai][bj][m][n];
                        *(f32x4*)(out + off + bj * HALF + n * 16) = o; q += dot4(o); }
                q += __shfl_xor(q, 16); q += __shfl_xor(q, 32);
                if (fq == 0) RPART[row * 16 + u.pn * 4 + wc] = q; }
    }
};
}
#define GAS __attribute__((address_space(1)))
#define LAS __attribute__((address_space(3)))
typedef unsigned v4u __attribute__((ext_vector_type(4)));
typedef GAS unsigned gu32;
typedef GAS unsigned long long gu64;
#define RLX_AGENT __ATOMIC_RELAXED, __HIP_MEMORY_SCOPE_AGENT
#define LDS_WAIT() asm volatile("s_waitcnt lgkmcnt(0)" ::: "memory")
#define VM_WAIT() asm volatile("s_waitcnt vmcnt(0)" ::: "memory")
__device__ __forceinline__ unsigned long long rt() { return __builtin_amdgcn_s_memrealtime(); }
__device__ __forceinline__ unsigned pk2(float lo, float hi) { return f2bf(lo) | (f2bf(hi) << 16); }
#define XB_TMO      128
#define XB_XCNT(j)  (256  + 64 * (j))
#define XB_XSUB(j)  (1280 + 64 * (j))
#define XB_XGEN(j)  (2304 + 64 * (j))
#define XB_TOP      3328
#define XB_TOPGEN   3392
#define XCD_BAR_WORDS 3456
#define XB_SPIN_CAP (1u << 22)

__device__ __forceinline__ unsigned xb_ld(unsigned* p)              { return __hip_atomic_load(p, __ATOMIC_RELAXED, __HIP_MEMORY_SCOPE_AGENT); }
__device__ __forceinline__ unsigned xb_add(unsigned* p, unsigned v) { return __hip_atomic_fetch_add(p, v, __ATOMIC_RELAXED, __HIP_MEMORY_SCOPE_AGENT); }
__device__ __forceinline__ unsigned xb_xcc_id() { return (unsigned)__builtin_amdgcn_s_getreg((3 << 11) | 20) & 0xFu; }
#define XB_SPIN(cond, bar) do { unsigned _sp = 0; while (cond) { __builtin_amdgcn_s_sleep(1); \
    if ((++_sp & 255u) == 0u) { if (xb_ld(&(bar)[XB_TMO])) break; if (_sp > XB_SPIN_CAP) { atomicAdd(&(bar)[XB_TMO], 1u); break; } } } } while (0)

struct XcdBarrier {
    unsigned* bar; unsigned x;
    volatile LAS unsigned* st;
};

__device__ __forceinline__ XcdBarrier xcd_barrier_post(unsigned* bar, volatile LAS unsigned* st) {
    XcdBarrier b; b.bar = bar; b.x = xb_xcc_id(); b.st = st;
    if (threadIdx.x == 0) (void)xb_add(&bar[XB_XCNT(b.x)], 1u);
    return b;
}
__device__ __forceinline__ void xcd_barrier_complete(unsigned* bar, unsigned x, unsigned& nloc, unsigned& nx) {
    const unsigned G = gridDim.x * gridDim.y * gridDim.z;
    unsigned sum, cnt, mine, sp = 0u;
    for (;;) {
        sum = 0u; cnt = 0u; mine = 0u;
#pragma unroll
        for (unsigned j = 0; j < 16; ++j) { const unsigned c = xb_ld(&bar[XB_XCNT(j)]); sum += c; cnt += (c > 0u) ? 1u : 0u; mine = (j == x) ? c : mine; }
        if (sum == G) break;
        __builtin_amdgcn_s_sleep(1);
        if ((++sp & 255u) == 0u) { if (xb_ld(&bar[XB_TMO])) break; if (sp > XB_SPIN_CAP) { atomicAdd(&bar[XB_TMO], 1u); break; } }
    }
    nloc = mine > 0u ? mine : 1u; nx = cnt > 0u ? cnt : 1u;
}

__device__ __forceinline__ void xcd_barrier(const XcdBarrier& b) {
    asm volatile("s_waitcnt vmcnt(0)" ::: "memory");
    __syncthreads();
    if (threadIdx.x == 0) {
        unsigned* bar = b.bar;
        __builtin_amdgcn_s_waitcnt(0);
        unsigned nloc = b.st[0], nx = b.st[1];
        if (nloc == 0u) { xcd_barrier_complete(bar, b.x, nloc, nx); b.st[0] = nloc; b.st[1] = nx; }
        const unsigned old = xb_add(&bar[XB_XSUB(b.x)], 1u);
        const unsigned gen = old / nloc;
        if (old + 1u == (gen + 1u) * nloc) {
            __builtin_amdgcn_fence(__ATOMIC_RELEASE, "agent");
            asm volatile("s_waitcnt vmcnt(0)" ::: "memory");
            const unsigned og = xb_add(&bar[XB_TOP], 1u);
            const unsigned tg = og / nx;
            if (og + 1u == (tg + 1u) * nx) xb_add(&bar[XB_TOPGEN], 1u);
            else XB_SPIN(xb_ld(&bar[XB_TOPGEN]) == tg, bar);
            __builtin_amdgcn_fence(__ATOMIC_ACQUIRE, "agent");
            xb_add(&bar[XB_XGEN(b.x)], 1u);
            asm volatile("s_waitcnt vmcnt(0)" ::: "memory");
        } else {
            XB_SPIN(xb_ld(&bar[XB_XGEN(b.x)]) == gen, bar);
            __builtin_amdgcn_fence(__ATOMIC_ACQUIRE, "agent");
            asm volatile("s_waitcnt vmcnt(0)" ::: "memory");
        }
    }
    __syncthreads();
}

typedef float f32x4 __attribute__((ext_vector_type(4)));
constexpr int NWAVES = 8;
__device__ __forceinline__ float wave_sum(float v) {
#pragma unroll
    for (int o = 1; o < 64; o <<= 1) v += __shfl_xor(v, o);
    return v;
}
__device__ __forceinline__ float dot4g(const f32x4 a) { return (a[0] * a[0] + a[1] * a[1]) + (a[2] * a[2] + a[3] * a[3]); }
__device__ __forceinline__ void p0_bt1_item(const float* W, bf16* WT, LAS float* scr, int item, int lane) {
    const int kb = item / 168, vb = item % 168, k0 = 64 * kb, v0 = 32 * vb;
    const int a = vcol_actual(v0 + (lane & 31));
#pragma unroll 8
    for (int i = 0; i < 32; ++i) { const int kk = 2 * i + (lane >> 5); scr[kk * 33 + (lane & 31)] = a >= 0 ? W[(size_t)(k0 + kk) * PROJ + a] : 0.f; }
    LDS_WAIT(); asm volatile("" ::: "memory");
    const int c = lane & 7;
#pragma unroll
    for (int j = 0; j < 4; ++j) { const int n = (lane >> 3) + 8 * j; const LAS float* s = scr + (8 * c) * 33 + n;
        v4u o; o.x = pk2(s[0 * 33], s[1 * 33]); o.y = pk2(s[2 * 33], s[3 * 33]); o.z = pk2(s[4 * 33], s[5 * 33]); o.w = pk2(s[6 * 33], s[7 * 33]);
        *(GAS v4u*)(WT + (size_t)(v0 + n) * 1024 + k0 + 8 * c) = o; }
    LDS_WAIT(); asm volatile("" ::: "memory");
}
__device__ __forceinline__ void p0_bt2_item(const float* W, const float* sg, bf16* WT, LAS float* scr, int item, int lane) {
    const int kb = item >> 5, nb = item & 31, kk0 = 64 * kb, n0 = 32 * nb;
#pragma unroll 8
    for (int i = 0; i < 32; ++i) { const int kk = 2 * i + (lane >> 5), kq = kk0 + kk; const int ks = kq < 1024 ? 1024 + kq : kq - 1024;
        float v = W[(size_t)ks * 1024 + n0 + (lane & 31)]; if (kq < 1024) v *= sg[kq]; scr[kk * 33 + (lane & 31)] = v; }
    LDS_WAIT(); asm volatile("" ::: "memory");
    const int c = lane & 7;
#pragma unroll
    for (int j = 0; j < 4; ++j) { const int n = (lane >> 3) + 8 * j; const LAS float* s = scr + (8 * c) * 33 + n;
        v4u o; o.x = pk2(s[0 * 33], s[1 * 33]); o.y = pk2(s[2 * 33], s[3 * 33]); o.z = pk2(s[4 * 33], s[5 * 33]); o.w = pk2(s[6 * 33], s[7 * 33]);
        *(GAS v4u*)(WT + (size_t)(n0 + n) * 2048 + kk0 + 8 * c) = o; }
    LDS_WAIT(); asm volatile("" ::: "memory");
}
__device__ __forceinline__ void p0_mod_block(const float* c, const float* c_ctx, const float* ada_w, const float* ada_b, float* mod, LAS float* ldsf, int cb, int tid, int lane, int wave) {
    LAS float* sil = ldsf; LAS float* red = ldsf + 33 * 256;
    float acc[33];
#pragma unroll
    for (int b = 0; b < 33; ++b) acc[b] = 0.f;
    for (int q = 0; q < 4; ++q) {
        __syncthreads();
        for (int e = tid; e < 33 * 256; e += NWAVES * 64) { const int b = e >> 8, k = e & 255; const float v = b < 32 ? c[b * 1024 + q * 256 + k] : c_ctx[q * 256 + k]; sil[e] = siluf(v); }
        __syncthreads();
        for (int kk = 0; kk < 32; ++kk) { const int kl = wave * 32 + kk; const float w = ada_w[(size_t)(q * 256 + kl) * 3072 + cb * 64 + lane];
#pragma unroll
            for (int b = 0; b < 33; ++b) acc[b] += sil[b * 256 + kl] * w; }
    }
#pragma unroll
    for (int b = 0; b < 33; ++b) red[(wave * 33 + b) * 64 + lane] = acc[b];
    __syncthreads();
    for (int e = tid; e < 33 * 64; e += NWAVES * 64) { const int b = e >> 6, col = e & 63; float s = 0.f;
#pragma unroll
        for (int w = 0; w < 8; ++w) s += red[(w * 33 + b) * 64 + col];
        mod[b * 3072 + cb * 64 + col] = s + ada_b[cb * 64 + col]; }
    __syncthreads();
}
__device__ __forceinline__ void p1_norm_row(const float* xrow, const float* md, const float* ng, bf16* orow, int lane) {
    const GAS f32x4* xr = (const GAS f32x4*)xrow + lane;
    f32x4 v[4]; float s = 0.f;
#pragma unroll
    for (int j = 0; j < 4; ++j) { v[j] = xr[64 * j]; s += dot4g(v[j]); }
    const float rstd = rsqrtf(wave_sum(s) * (1.f / DM) + EPS);
    GAS unsigned long long* o8 = (GAS unsigned long long*)orow + lane;
#pragma unroll
    for (int j = 0; j < 4; ++j) { const int k = 4 * lane + 256 * j;
        const f32x4 g = *(const f32x4*)(ng + k), sc = *(const f32x4*)(md + 1024 + k), sh = *(const f32x4*)(md + k);
        const f32x4 h = v[j] * rstd * g * (sc + 1.f) + sh;
        o8[64 * j] = (unsigned long long)pk2(h[0], h[1]) | ((unsigned long long)pk2(h[2], h[3]) << 32); }
}
__device__ __forceinline__ void conv_phase(const bf16* XBC, const float* cw, const float* cb, bf16* XC, int bx, int G, int tid) {
    if (tid < 384) {
        const int cg = tid % 192, sub = tid / 192;
        f32x4 w[5][2], bias[2];
#pragma unroll
        for (int j = 0; j < 5; ++j) { w[j][0] = *(const f32x4*)(cw + j * CONVC + cg * 8); w[j][1] = *(const f32x4*)(cw + j * CONVC + cg * 8 + 4); }
        bias[0] = *(const f32x4*)(cb + cg * 8); bias[1] = *(const f32x4*)(cb + cg * 8 + 4);
        for (int seg = bx; seg < MT / 32; seg += G) {
            const int row0 = seg * 32 + sub * 16; int t0, len;
            if (row0 < ML) { t0 = row0 % SEQ; len = SEQ; } else { t0 = (row0 - ML) % CTXL; len = CTXL; }
            const bf16* src = XBC + (size_t)row0 * CONVC + cg * 8; bf16* dst = XC + (size_t)row0 * CONVC + cg * 8;
            f32x4 r[5][2];
#pragma unroll
            for (int j = 0; j < 5; ++j) { const int tt = t0 + j - 2; v4u u = (v4u){0u, 0u, 0u, 0u};
                if (tt >= 0 && tt < len) u = *(const v4u*)(src + (ptrdiff_t)(j - 2) * CONVC);
                r[j][0] = (f32x4){__uint_as_float(u.x << 16), __uint_as_float(u.x & 0xffff0000u), __uint_as_float(u.y << 16), __uint_as_float(u.y & 0xffff0000u)};
                r[j][1] = (f32x4){__uint_as_float(u.z << 16), __uint_as_float(u.z & 0xffff0000u), __uint_as_float(u.w << 16), __uint_as_float(u.w & 0xffff0000u)}; }
#pragma unroll
            for (int i = 0; i < 16; ++i) {
                f32x4 a0 = bias[0], a1 = bias[1];
#pragma unroll
                for (int j = 0; j < 5; ++j) { a0 += w[j][0] * r[j][0]; a1 += w[j][1] * r[j][1]; }
#pragma unroll
                for (int e = 0; e < 4; ++e) { a0[e] = siluf(a0[e]); a1[e] = siluf(a1[e]); }
                v4u o; o.x = pk2(a0[0], a0[1]); o.y = pk2(a0[2], a0[3]); o.z = pk2(a1[0], a1[1]); o.w = pk2(a1[2], a1[3]);
                *(v4u*)(dst + (size_t)i * CONVC) = o;
#pragma unroll
                for (int j = 0; j < 4; ++j) { r[j][0] = r[j + 1][0]; r[j][1] = r[j + 1][1]; }
                const int tt = t0 + i + 3; v4u u = (v4u){0u, 0u, 0u, 0u};
                if (i < 15 && tt < len) u = *(const v4u*)(src + (size_t)(i + 3) * CONVC);
                r[4][0] = (f32x4){__uint_as_float(u.x << 16), __uint_as_float(u.x & 0xffff0000u), __uint_as_float(u.y << 16), __uint_as_float(u.y & 0xffff0000u)};
                r[4][1] = (f32x4){__uint_as_float(u.z << 16), __uint_as_float(u.z & 0xffff0000u), __uint_as_float(u.w << 16), __uint_as_float(u.w & 0xffff0000u)};
            }
        }
    }
}
__device__ __forceinline__ void ssd_item_naive(int b, int h, const bf16* XC, const float* DT, const bf16* Z, const float* a_log, const float* d_skip, bf16* YQ, float* SSQ, LAS float* ysq, int tid) {
    const int p = tid >> 3, nc = tid & 7, g = h >> 3;
    for (int dd = 0; dd < 2; ++dd) { const int d = 1 - dd;
        const float a_neg = -expf(a_log[d * 16 + h]);
        float S[16];
#pragma unroll
        for (int j = 0; j < 16; ++j) S[j] = 0.f;
        for (int seq = 0; seq < 2; ++seq) { const int len = seq == 0 ? CTXL : SEQ; const size_t rbase = seq == 0 ? (size_t)ML + (size_t)b * CTXL : (size_t)b * SEQ;
            for (int st = 0; st < len; ++st) { const int t = d ? len - 1 - st : st; const size_t row = rbase + t;
                const float dt = DT[row * 32 + d * 16 + h]; const float dec = expf(dt * a_neg);
                const float xs = bf2f(XC[row * CONVC + h * 64 + p]); const float X = xs * dt;
                const v4u b0 = *(const v4u*)(XC + row * CONVC + 1024 + g * 128 + nc * 16), b1 = *(const v4u*)(XC + row * CONVC + 1024 + g * 128 + nc * 16 + 8);
                const v4u c0 = *(const v4u*)(XC + row * CONVC + 1280 + g * 128 + nc * 16), c1 = *(const v4u*)(XC + row * CONVC + 1280 + g * 128 + nc * 16 + 8);
                const unsigned bw[8] = {b0.x, b0.y, b0.z, b0.w, b1.x, b1.y, b1.z, b1.w}, cw8[8] = {c0.x, c0.y, c0.z, c0.w, c1.x, c1.y, c1.z, c1.w};
                float y = 0.f;
#pragma unroll
                for (int j = 0; j < 8; ++j) { S[2 * j] = S[2 * j] * dec + X * __uint_as_float(bw[j] << 16); y += __uint_as_float(cw8[j] << 16) * S[2 * j];
                    S[2 * j + 1] = S[2 * j + 1] * dec + X * __uint_as_float(bw[j] & 0xffff0000u); y += __uint_as_float(cw8[j] & 0xffff0000u) * S[2 * j + 1]; }
                y += __shfl_xor(y, 1); y += __shfl_xor(y, 2); y += __shfl_xor(y, 4);
                if (seq == 1) {
                    bf16* yp = YQ + row * 2048 + h * 64 + p;
                    if (d == 1) { if (nc == 0) *yp = (bf16)f2bf(y); }
                    else {
                        if (nc == 0) { const float yt = y + bf2f(*yp) + d_skip[h] * xs; const float yg = yt * bf2f(Z[row * 1024 + h * 64 + p]); *yp = (bf16)f2bf(yg); ysq[p] = yg * yg; }
                        __syncthreads();
                        if (tid < 64) { float q = ysq[tid]; q = wave_sum(q); if (tid == 0) SSQ[row * 16 + h] = q; }
                        __syncthreads();
                    }
                }
            }
        }
        VM_WAIT(); __syncthreads();
    }
}

namespace attn_body {
using bf16=__hip_bfloat16;
using bf16x8=__attribute__((ext_vector_type(8)))short;
using s16x4=__attribute__((ext_vector_type(4)))short;
using f32x16=__attribute__((ext_vector_type(16)))float;
using u32x4=__attribute__((ext_vector_type(4)))unsigned;
constexpr int D=64,QP=2048,KP=256;
constexpr int NW=8,QBLK=32,QB=QBLK*NW,KVBLK=64,NQB=SEQ/QB;
constexpr int ATTN_UNIT_ROWS=QB;
__device__ __forceinline__ int crow(int r,int hi){return (r&3)+8*(r>>2)+4*hi;}
#define SBAR() __builtin_amdgcn_sched_barrier(0)
__device__ __forceinline__ void cmask(f32x16&p0,f32x16&p1,int jb,int qrel,int hi){
  const float NEG=-INFINITY; int kb=64*jb+4*hi;
  #pragma unroll
  for(int r=0;r<16;++r){int kv=kb+(r&3)+8*(r>>2); if(kv>qrel)p0[r]=NEG; if(kv+32>qrel)p1[r]=NEG;}
}

constexpr int NSLOT=3, SLOTB=8192;
constexpr int LDS_K=0, LDS_V=NSLOT*SLOTB, LDS_WS=2*NSLOT*SLOTB, LDS_OST=LDS_WS+NW*64*4, LDS_BYTES=LDS_OST+NW*8192;
constexpr float C2=0.125f*1.4426950408889634f;
__device__ __forceinline__ void glds16(const void*gsrc,unsigned lds_dst){unsigned keep;
  asm volatile("s_mov_b32 %0, m0\n\ts_mov_b32 m0, %2\n\ts_nop 0\n\tglobal_load_lds_dwordx4 %1, off\n\ts_mov_b32 m0, %0":"=&s"(keep):"v"(gsrc),"s"(lds_dst):"memory");}
__device__ __forceinline__ float max3f(float a,float b,float c){float r;asm("v_max3_f32 %0, %1, %2, %3":"=v"(r):"v"(a),"v"(b),"v"(c));return r;}
__device__ __forceinline__ float max2f(float a,float b){float r;asm("v_max_f32_e32 %0, %1, %2":"=v"(r):"v"(a),"v"(b));return r;}
__device__ __forceinline__ float fadd_s(float a,float b){float r;asm("v_add_f32_e32 %0, %1, %2":"=v"(r):"v"(a),"v"(b));return r;}
__device__ __forceinline__ float fsub_s(float a,float b){float r;asm("v_sub_f32_e32 %0, %1, %2":"=v"(r):"v"(a),"v"(b));return r;}
typedef float f32x2_t __attribute__((ext_vector_type(2))); typedef float f32x4_t __attribute__((ext_vector_type(4))); typedef __bf16 bf16x2_t __attribute__((ext_vector_type(2)));
__device__ __forceinline__ unsigned cvtpk_s(float lo,float hi){f32x2_t v={lo,hi};bf16x2_t b=__builtin_convertvector(v,bf16x2_t);return __builtin_bit_cast(unsigned,b);}
#define WAIT_BAR(N) asm volatile("s_waitcnt vmcnt(" #N ") lgkmcnt(0)\n\ts_barrier":::"memory")

__device__ __forceinline__ void qkt(f32x16&p0,f32x16&p1,const char*Kslot,const bf16x8*qr,const f32x16&negm,int r32,int hi){
  const char*kb=Kslot+hi*1024+r32*16;
  #pragma unroll
  for(int d0=0;d0<4;++d0){
    const bf16x8 b0=*reinterpret_cast<const bf16x8*>(kb+d0*2048);
    const bf16x8 b1=*reinterpret_cast<const bf16x8*>(kb+d0*2048+512);
    if(d0==0){p0=__builtin_amdgcn_mfma_f32_32x32x16_bf16(b0,qr[0],negm,0,0,0);p1=__builtin_amdgcn_mfma_f32_32x32x16_bf16(b1,qr[0],negm,0,0,0);}
    else{p0=__builtin_amdgcn_mfma_f32_32x32x16_bf16(b0,qr[d0],p0,0,0,0);p1=__builtin_amdgcn_mfma_f32_32x32x16_bf16(b1,qr[d0],p1,0,0,0);}}
}
typedef __attribute__((address_space(3))) const char* lds_cptr;
typedef short v4i16_t __attribute__((ext_vector_type(4)));
__device__ __forceinline__ void kload8(bf16x8*kf,lds_cptr kp){
  kf[0]=*(const __attribute__((address_space(3))) bf16x8*)(kp);      kf[1]=*(const __attribute__((address_space(3))) bf16x8*)(kp+512);
  kf[2]=*(const __attribute__((address_space(3))) bf16x8*)(kp+2048); kf[3]=*(const __attribute__((address_space(3))) bf16x8*)(kp+2560);
  kf[4]=*(const __attribute__((address_space(3))) bf16x8*)(kp+4096); kf[5]=*(const __attribute__((address_space(3))) bf16x8*)(kp+4608);
  kf[6]=*(const __attribute__((address_space(3))) bf16x8*)(kp+6144); kf[7]=*(const __attribute__((address_space(3))) bf16x8*)(kp+6656);
}
__device__ __forceinline__ void kload2(bf16x8*kf,lds_cptr kp,int j){ kf[2*j]=*(const __attribute__((address_space(3))) bf16x8*)(kp+j*2048); kf[2*j+1]=*(const __attribute__((address_space(3))) bf16x8*)(kp+j*2048+512); }
__device__ __forceinline__ s16x4 vtr(lds_cptr p){ return __builtin_bit_cast(s16x4,__builtin_amdgcn_ds_read_tr16_b64_v4i16((__attribute__((address_space(3))) v4i16_t*)p)); }
__device__ __forceinline__ float rowmax(const f32x16&p0,const f32x16&p1){
  float a=max3f(p0[0],p0[1],p1[0]),b=max3f(p0[2],p0[3],p1[1]);a=max3f(a,p1[2],p1[3]);
  #pragma unroll
  for(int r=4;r<16;r+=4){a=max3f(a,p0[r],p0[r+1]);b=max3f(b,p0[r+2],p0[r+3]);a=max3f(a,p1[r],p1[r+1]);b=max3f(b,p1[r+2],p1[r+3]);}
  const float m=max2f(a,b);
  auto rr=__builtin_amdgcn_permlane32_swap(__float_as_uint(m),__float_as_uint(m),false,false);
  return max2f(__uint_as_float(rr[0]),__uint_as_float(rr[1]));
}
__device__ __forceinline__ void pv(f32x16*o,int vb,bf16x8 pa0,bf16x8 pa1,bf16x8 pa2,bf16x8 pa3){
  #pragma unroll
  for(int d0=0;d0<2;++d0){s16x4 lo[4],hi[4];
    #pragma unroll
    for(int ks=0;ks<4;++ks){
      asm volatile("ds_read_b64_tr_b16 %0,%1 offset:%c2":"=&v"(lo[ks]):"v"(vb),"i"(d0*4096+ks*1024):"memory");
      asm volatile("ds_read_b64_tr_b16 %0,%1 offset:%c2":"=&v"(hi[ks]):"v"(vb),"i"(d0*4096+ks*1024+512):"memory");}
    asm volatile("s_waitcnt lgkmcnt(0)":::"memory");SBAR();
    #define PK(k) (bf16x8){lo[k][0],lo[k][1],lo[k][2],lo[k][3],hi[k][0],hi[k][1],hi[k][2],hi[k][3]}
    o[d0]=__builtin_amdgcn_mfma_f32_32x32x16_bf16(pa0,PK(0),o[d0],0,0,0);
    o[d0]=__builtin_amdgcn_mfma_f32_32x32x16_bf16(pa1,PK(1),o[d0],0,0,0);
    o[d0]=__builtin_amdgcn_mfma_f32_32x32x16_bf16(pa2,PK(2),o[d0],0,0,0);
    o[d0]=__builtin_amdgcn_mfma_f32_32x32x16_bf16(pa3,PK(3),o[d0],0,0,0);
    #undef PK
  }
}

#ifndef ATTN_STORE16
#define ATTN_STORE16(p,v) (*(u32x4*)(p)=(v))
#endif
template<int THRL> __device__ __forceinline__ void attn_unit(int b,int h,int qb,bf16*YQb,const bf16*__restrict__ K,const bf16*__restrict__ V,char*shm){
  const int tid=threadIdx.x,lane=tid&63,r32=lane&31,hi=lane>>5; const int wid=__builtin_amdgcn_readfirstlane(tid>>6);
  const long rowbase=(long)b*SEQ; const int q0=qb*QB;
  const bf16*Qw=YQb+(rowbase+q0+wid*QBLK)*QP+1024+h*D;
  const bf16*Kh=K+(long)b*KVL*KP+(h>>2)*D,*Vh=V+(long)b*KVL*KP+(h>>2)*D;
  const unsigned lds0=(unsigned)(uintptr_t)shm;
  float*wsf=(float*)(shm+LDS_WS)+wid*64;
  const bf16*ksrc=Kh+(long)lane*KP+wid*8;
  const bf16*vsrc=Vh+(long)(16*(wid&3)+(lane>>2))*KP+(wid>>2)*32+(lane&3)*8;
  const unsigned kdst=lds0+LDS_K+wid*1024, vdst=lds0+LDS_V+wid*1024;
  #define DMA_K(t,slot) glds16(ksrc+(long)(t)*KVBLK*KP,(unsigned)__builtin_amdgcn_readfirstlane(kdst+(slot)))
  #define DMA_V(t,slot) glds16(vsrc+(long)(t)*KVBLK*KP,(unsigned)__builtin_amdgcn_readfirstlane(vdst+(slot)))
  const int vb0=(int)(lds0+LDS_V)+((lane>>4)&1)*32+(lane&3)*8+(4*hi+((lane&15)>>2))*64;
  const char*Kbase=shm+LDS_K; bf16x8 kf[8];
  const lds_cptr shm3=(lds_cptr)shm; const lds_cptr kp0=shm3+LDS_K+hi*1024+r32*16; const lds_cptr vp0=shm3+LDS_V+((lane>>4)&1)*32+(lane&3)*8+(4*hi+((lane&15)>>2))*64;
  constexpr int NT=KVL/KVBLK;
  DMA_K(0,0);DMA_V(0,0);DMA_K(1,SLOTB);
  bf16x8 qr[4];
  #pragma unroll
  for(int d0=0;d0<4;++d0)qr[d0]=*reinterpret_cast<const bf16x8*>(&Qw[(long)r32*QP+d0*16+hi*8]);
  float mhat=0.f,l_reg=0.f;f32x16 o[2];o[0]=f32x16{};o[1]=f32x16{};f32x16 negm=f32x16{};asm volatile("":"+v"(negm));
  #define CMASK(P0,P1,t) do{}while(0)
  bool resc=false;
  #define START(P0,P1) do{ const float rm=rowmax(P0,P1); resc=false; \
    { const float dl=rm; mhat=fadd_s(mhat,dl); \
      _Pragma("unroll") for(int r=0;r<16;++r){P0[r]=fsub_s(P0[r],dl);P1[r]=fsub_s(P1[r],dl);} \
      _Pragma("unroll") for(int r=0;r<16;++r)negm[r]=-mhat; asm volatile("":"+v"(negm)); } \
    _Pragma("unroll") for(int r=0;r<16;++r)P0[r]=__builtin_amdgcn_exp2f(P0[r]); }while(0)
  #define RESC() do{ if(resc){ asm volatile("s_waitcnt lgkmcnt(0)":::"memory"); \
      _Pragma("unroll") for(int d_=0;d_<2;++d_) _Pragma("unroll") for(int r=0;r<16;++r)o[d_][r]*=wsf[crow(r,hi)]; } }while(0)
  f32x16 pA0,pA1,pB0,pB1;
  int sl_prev=0,sl_cur=0,sl_next=SLOTB;
  #define ROT() do{sl_prev=sl_cur;sl_cur=sl_next;sl_next=(sl_next==(NSLOT-1)*SLOTB)?0:sl_next+SLOTB;}while(0)
  DMA_K(2,2*SLOTB);
  WAIT_BAR(3);
  qkt(pA0,pA1,Kbase,qr,negm,r32,hi);asm volatile("s_nop 15\n\ts_nop 7":"+v"(pA0),"+v"(pA1));CMASK(pA0,pA1,0);
  START(pA0,pA1);
  _Pragma("unroll") for(int r=0;r<16;++r)pA1[r]=__builtin_amdgcn_exp2f(pA1[r]);
  WAIT_BAR(0);
  DMA_K(3,0);DMA_V(1,SLOTB);
  ROT();
  kload8(kf,kp0+sl_cur);
  WAIT_BAR(2);
  s16x4 vlo[8],vhi[8]; u32x4 pw0,pw1,pw2,pw3;
  #define PKW(P,B) cvtpk_s(P[B],P[B+1])
  #define PAF(k) __builtin_bit_cast(bf16x8,pw##k)
  #define VFR(i) (bf16x8){vlo[i][0],vlo[i][1],vlo[i][2],vlo[i][3],vhi[i][0],vhi[i][1],vhi[i][2],vhi[i][3]}
  #define PIN(x) asm volatile("":"+v"(x))
  #define MX3(a,b,c) __builtin_fmaxf(__builtin_fmaxf((a),(b)),(c))
  #define GAPA(MF,A0,A1,A2,A3,W0,W1,PW) do{ MF; sacc+=A0; sacc+=A1; sacc+=A2; sacc+=A3; PIN(sacc); W0; W1; PIN(PW); SBAR(); }while(0)
  #define EX(v) __builtin_amdgcn_exp2f(v)
  #define GAPB(MF,X,B) do{ MF; X[B]=EX(X[B]); X[B+1]=EX(X[B+1]); X[B+2]=EX(X[B+2]); X[B+3]=EX(X[B+3]); PIN(X); SBAR(); }while(0)
  #define VRD(i) do{ vlo[i]=vtr(vp_+(((i)>>2)*4096+((i)&3)*1024)); vhi[i]=vtr(vp_+(((i)>>2)*4096+((i)&3)*1024+512)); }while(0)
  #define KRD(G,j) do{ if(G){ kload2(kf,kp0+sl_next,j); SBAR(); } }while(0)
  #define STEP(C0,C1,P0,P1,t,GK,GV,GL) do{ SBAR(); \
    const lds_cptr vp_=vp0+sl_prev; \
    VRD(0); SBAR(); float sacc=(P0[0]+P0[1]); \
    GAPA(C0=__builtin_amdgcn_mfma_f32_32x32x16_bf16(kf[0],qr[0],negm,0,0,0), P0[2],P0[3],P0[4],P0[5],     pw0[0]=PKW(P0,0), pw0[1]=PKW(P0,2), pw0); \
    VRD(4); SBAR(); GAPA(C1=__builtin_amdgcn_mfma_f32_32x32x16_bf16(kf[1],qr[0],negm,0,0,0), P0[6],P0[7],P0[8],P0[9],     pw0[2]=PKW(P0,4), pw0[3]=PKW(P0,6), pw0); \
    VRD(1); SBAR(); GAPA(C0=__builtin_amdgcn_mfma_f32_32x32x16_bf16(kf[2],qr[1],C0,0,0,0),   P0[10],P0[11],P0[12],P0[13], pw1[0]=PKW(P0,8), pw1[1]=PKW(P0,10), pw1); \
    VRD(5); SBAR(); GAPA(C1=__builtin_amdgcn_mfma_f32_32x32x16_bf16(kf[3],qr[1],C1,0,0,0),   P0[14],P0[15],P1[0],P1[1],   pw1[2]=PKW(P0,12),pw1[3]=PKW(P0,14), pw1); \
    VRD(2); SBAR(); GAPA(C0=__builtin_amdgcn_mfma_f32_32x32x16_bf16(kf[4],qr[2],C0,0,0,0),   P1[2],P1[3],P1[4],P1[5],     pw2[0]=PKW(P1,0), pw2[1]=PKW(P1,2), pw2); \
    VRD(6); SBAR(); GAPA(C1=__builtin_amdgcn_mfma_f32_32x32x16_bf16(kf[5],qr[2],C1,0,0,0),   P1[6],P1[7],P1[8],P1[9],     pw2[2]=PKW(P1,4), pw2[3]=PKW(P1,6), pw2); \
    VRD(3); SBAR(); GAPA(C0=__builtin_amdgcn_mfma_f32_32x32x16_bf16(kf[6],qr[3],C0,0,0,0),   P1[10],P1[11],P1[12],P1[13], pw3[0]=PKW(P1,8), pw3[1]=PKW(P1,10), pw3); \
    VRD(7); SBAR(); GAPA(C1=__builtin_amdgcn_mfma_f32_32x32x16_bf16(kf[7],qr[3],C1,0,0,0),   P1[14],P1[15],0.f,0.f,       pw3[2]=PKW(P1,12),pw3[3]=PKW(P1,14), pw3); \
    l_reg+=sacc; \
    if(GK){DMA_K((t)+3,sl_cur);} if(GV){DMA_V((t)+1,sl_next);} \
    CMASK(C0,C1,t); \
    { float a=MX3(C0[0],C0[1],C1[0]),b=MX3(C0[2],C0[3],C1[1]); a=MX3(a,C1[2],C1[3]); \
      _Pragma("unroll") for(int r=4;r<16;r+=4){a=MX3(a,C0[r],C0[r+1]);b=MX3(b,C0[r+2],C0[r+3]);a=MX3(a,C1[r],C1[r+1]);b=MX3(b,C1[r+2],C1[r+3]);} \
      float rm=__builtin_fmaxf(a,b); { auto rr=__builtin_amdgcn_permlane32_swap(__float_as_uint(rm),__float_as_uint(rm),false,false); rm=__builtin_fmaxf(__uint_as_float(rr[0]),__uint_as_float(rr[1])); } \
      resc=false; \
      if(__builtin_expect(__any(rm>(float)THRL),0)){ const float dl=__builtin_fmaxf(rm,0.f); mhat+=dl; \
        _Pragma("unroll") for(int r=0;r<16;++r){C0[r]-=dl;C1[r]-=dl;} \
        _Pragma("unroll") for(int r=0;r<16;++r)negm[r]=-mhat; asm volatile("":"+v"(negm)); \
        const float f=__builtin_amdgcn_exp2f(-dl); l_reg*=f; if(hi==0)wsf[r32]=f; resc=true; } } \
    SBAR(); \
    GAPB(o[0]=__builtin_amdgcn_mfma_f32_32x32x16_bf16(PAF(0),VFR(0),o[0],0,0,0), C0,0); \
    GAPB(o[1]=__builtin_amdgcn_mfma_f32_32x32x16_bf16(PAF(0),VFR(4),o[1],0,0,0), C0,4); \
    KRD(GL,0); GAPB(o[0]=__builtin_amdgcn_mfma_f32_32x32x16_bf16(PAF(1),VFR(1),o[0],0,0,0), C0,8); \
    KRD(GL,1); GAPB(o[1]=__builtin_amdgcn_mfma_f32_32x32x16_bf16(PAF(1),VFR(5),o[1],0,0,0), C0,12); \
    KRD(GL,2); GAPB(o[0]=__builtin_amdgcn_mfma_f32_32x32x16_bf16(PAF(2),VFR(2),o[0],0,0,0), C1,0); \
    KRD(GL,3); GAPB(o[1]=__builtin_amdgcn_mfma_f32_32x32x16_bf16(PAF(2),VFR(6),o[1],0,0,0), C1,4); \
    GAPB(o[0]=__builtin_amdgcn_mfma_f32_32x32x16_bf16(PAF(3),VFR(3),o[0],0,0,0), C1,8); \
    GAPB(o[1]=__builtin_amdgcn_mfma_f32_32x32x16_bf16(PAF(3),VFR(7),o[1],0,0,0), C1,12); \
    }while(0)
  int t=1;
  #undef CMASK
  #define CMASK(P0,P1,t) do{}while(0)
  for(;t+5<NT;t+=2){
    STEP(pB0,pB1,pA0,pA1,t,true,true,true);     WAIT_BAR(2); RESC(); ROT();
    STEP(pA0,pA1,pB0,pB1,t+1,true,true,true);   WAIT_BAR(2); RESC(); ROT();
  }
  #undef CMASK
  #define CMASK(P0,P1,t) do{}while(0)
  #define ENDW(tt) do{ if((tt)+3<NT){WAIT_BAR(2);} else if((tt)+2<NT){WAIT_BAR(1);} else {WAIT_BAR(0);} }while(0)
  for(;t+1<NT;t+=2){
    STEP(pB0,pB1,pA0,pA1,t,(t+3<NT),(t+1<NT),(t+1<NT));       ENDW(t);   RESC(); ROT();
    STEP(pA0,pA1,pB0,pB1,t+1,(t+4<NT),(t+2<NT),(t+2<NT));     ENDW(t+1); RESC(); ROT();
  }
  STEP(pB0,pB1,pA0,pA1,NT-1,false,false,false); RESC();
  { float sacc=pB0[0]+pB0[1]; _Pragma("unroll") for(int r=2;r<16;++r)sacc+=pB0[r]; _Pragma("unroll") for(int r=0;r<16;++r)sacc+=pB1[r]; l_reg+=sacc;
    pw0=(u32x4){PKW(pB0,0),PKW(pB0,2),PKW(pB0,4),PKW(pB0,6)};pw1=(u32x4){PKW(pB0,8),PKW(pB0,10),PKW(pB0,12),PKW(pB0,14)};pw2=(u32x4){PKW(pB1,0),PKW(pB1,2),PKW(pB1,4),PKW(pB1,6)};pw3=(u32x4){PKW(pB1,8),PKW(pB1,10),PKW(pB1,12),PKW(pB1,14)};
    SBAR(); pv(o,vb0+sl_cur,PAF(0),PAF(1),PAF(2),PAF(3)); }
  #undef PKW
  #undef PAF
  #undef VFR
  #undef PIN
  #undef MX3
  #undef GAPA
  #undef GAPB
  #undef EX
  #undef VRD
  #undef KRD
  #undef STEP
  #undef ENDW
  {auto rr=__builtin_amdgcn_permlane32_swap(__float_as_uint(l_reg),__float_as_uint(l_reg),false,false);l_reg=__uint_as_float(rr[0])+__uint_as_float(rr[1]);}
  if(hi==0)wsf[32+r32]=l_reg;asm volatile("s_waitcnt lgkmcnt(0)":::"memory");
  float rli[16];
  #pragma unroll
  for(int r=0;r<16;++r)rli[r]=__builtin_amdgcn_rcpf(wsf[32+crow(r,hi)]);
  bf16*Ow=YQb+(rowbase+q0+wid*QBLK)*QP+1024+h*D; const bf16*Gw=YQb+(rowbase+q0+wid*QBLK)*QP+h*D;
  { float*stg=(float*)(shm+LDS_OST)+wid*2048;
    #pragma unroll
    for(int r=0;r<16;++r){const int orow=crow(r,hi);
      #pragma unroll
      for(int d0=0;d0<2;++d0)stg[orow*64+d0*32+r32]=o[d0][r]*rli[r];}
    asm volatile("s_waitcnt lgkmcnt(0)":::"memory");
    #pragma unroll
    for(int i=0;i<4;++i){const int row=i*8+(lane>>3),ch=lane&7; const float*sp=stg+row*64+ch*8;
      const f32x4_t a=*(const f32x4_t*)sp,c=*(const f32x4_t*)(sp+4); const u32x4 g=*(const u32x4*)(Gw+(long)row*QP+ch*8);
      u32x4 v; v[0]=cvtpk_s(a[0]*__uint_as_float(g[0]<<16),a[1]*__uint_as_float(g[0]&0xffff0000u)); v[1]=cvtpk_s(a[2]*__uint_as_float(g[1]<<16),a[3]*__uint_as_float(g[1]&0xffff0000u));
      v[2]=cvtpk_s(c[0]*__uint_as_float(g[2]<<16),c[1]*__uint_as_float(g[2]&0xffff0000u)); v[3]=cvtpk_s(c[2]*__uint_as_float(g[3]<<16),c[3]*__uint_as_float(g[3]&0xffff0000u));
      ATTN_STORE16(Ow+(long)row*QP+ch*8,v);} }
  asm volatile("s_waitcnt lgkmcnt(0)\n\ts_barrier":::"memory");
  #undef DMA_K
  #undef DMA_V
  #undef CMASK
  #undef START
  #undef RESC
  #undef ROT
}
constexpr int ATTN_LDS_BYTES=LDS_BYTES;
struct Order {
  int vcu, G;
  __device__ __forceinline__ bool next(int i,int&b,int&h,int&qb)const{
    if(G==256){ if(i>=16)return false; const int x=vcu>>5,j=vcu&31,rd=i>>2,k=i&3; const int pair=x*16+rd*4+(j>>3),un=(j&7)*4+k; b=pair>>2; h=(pair&3)*4+(un&3); qb=un>>2; return true; }
    const int U=i*G+vcu; if(U>=4096)return false; b=U>>7; h=(U>>3)&15; qb=U&7; return true; }
};
template<int THRL=8> __device__ __forceinline__ void attn_phase(char*lds,bf16*YQb,const bf16*K,const bf16*V,const Order&S){
  int b,h,qb;
  for(int i=0;S.next(i,b,h,qb);++i) attn_unit<THRL>(b,h,qb,YQb,K,V,lds);
}
#undef SBAR
#undef WAIT_BAR
}

constexpr int RING_OFF = 0, RING_BYTES = 131072;
constexpr int LDSCTL_OFF = RING_BYTES, MISC_OFF = LDSCTL_OFF + 320;
constexpr int RSTD_OFF = LDSCTL_OFF + 1024;
constexpr int LDS_BYTES = 147456;
constexpr int CW_BAR = 4096;
constexpr int NPHASE = 7;

struct Args { const float* in[18]; float* out; unsigned char* ws; int ph_lo, ph_hi; };

__global__ void __launch_bounds__(NWAVES * 64, 2) mega(Args args) {
    extern __shared__ __attribute__((aligned(16))) unsigned char lds[];
    LAS unsigned char* ldsp = (LAS unsigned char*)lds;
    volatile LAS unsigned* MISC = (volatile LAS unsigned*)(ldsp + MISC_OFF);
    const int tid = threadIdx.x, lane = tid & 63, wave = __builtin_amdgcn_readfirstlane(tid >> 6);
    const int G = gridDim.x; const int bx = blockIdx.x; const int vcu = (G % 8 == 0) ? (bx % 8) * (G / 8) + bx / 8 : bx;
    unsigned char* ws = args.ws;
    gu32* ctl = (gu32*)(ws + WS_CTL);
    float* mod = (float*)(ws + WS_MOD); float* rope = (float*)(ws + WS_ROPE); float* SSQ = (float*)(ws + WS_SSQ); float* RPART = (float*)(ws + WS_RPART);
    bf16* bt1 = (bf16*)(ws + WS_BT1); bf16* bt2 = (bf16*)(ws + WS_BT2); float* DT = (float*)(ws + WS_DT); bf16* KB = (bf16*)(ws + WS_KB); bf16* VB = (bf16*)(ws + WS_VB);
    bf16* H = (bf16*)(ws + WS_R1); bf16* XC = (bf16*)(ws + WS_R1); bf16* XBC = (bf16*)(ws + WS_XBC); bf16* YQ = (bf16*)(ws + WS_YQ); bf16* Z = (bf16*)(ws + WS_Z);
    for (int u = tid; u < (LDS_BYTES - LDSCTL_OFF) / 4; u += NWAVES * 64) ((LAS unsigned*)(ldsp + LDSCTL_OFF))[u] = 0u;
    __syncthreads();
    const int lo = args.ph_lo, hi = args.ph_hi;
    XcdBarrier bar; bar.bar = (unsigned*)(ctl + CW_BAR); bar.x = 0; bar.st = nullptr;
    if (hi - lo > 1) bar = xcd_barrier_post((unsigned*)(ctl + CW_BAR), MISC + 8);
#define IN(k) (lo <= (k) && (k) < hi)
#define SEAM(k) do { if (IN(k) && IN((k) + 1)) xcd_barrier(bar); } while (0)

    if (IN(0)) {
        LAS float* ldsf = (LAS float*)(ldsp + RING_OFF);
        if (bx < 48) p0_mod_block(args.in[1], args.in[3], args.in[4], args.in[5], mod, ldsf, bx, tid, lane, wave);
        else if (bx == 48) { for (int i = tid; i < 1024; i += NWAVES * 64) { const int p = i >> 4, f = i & 15; const float inv = powf(10000.f, -(float)f / 16.f); const float ang = (float)p * inv; rope[i] = cosf(ang); rope[1024 + i] = sinf(ang); } }
        LAS float* scr = ldsf + wave * (64 * 33);
        const int gw = ((bx + G - 49) % G) * NWAVES + wave, NGW = G * NWAVES;
        constexpr int I1 = 16 * 168, I2 = 32 * 32;
        for (int it = gw; it < I1 + I2; it += NGW) { if (it < I1) p0_bt1_item(args.in[7], bt1, scr, it, lane); else p0_bt2_item(args.in[16], args.in[15], bt2, scr, it - I1, lane); }
    }
    SEAM(0);
    if (IN(1)) {
        const int gw = bx * NWAVES + wave, NGW = G * NWAVES;
        for (int m = gw; m < MT; m += NGW) {
            const float* xr = m < ML ? args.in[0] + (size_t)m * DM : args.in[2] + (size_t)(m - ML) * DM;
            p1_norm_row(xr, mod + (size_t)(m < ML ? m / SEQ : 32) * 3072, args.in[6], H + (size_t)m * DM, lane);
        }
    }
    SEAM(1);

    if (IN(2)) {
        pg8::Gemm g{H, bt1, MT, N1, 1024}; pg8::Sched1 S; S.init(G, bx);
        pg8::Epi1 E{KB, VB, XBC, YQ, Z, DT, rope, args.in[13], args.in[14], args.in[10]};
        pg8::gemm_phase<pg8::Epi1, pg8::Sched1, true, true>(ldsp + RING_OFF, g, S, E);
    }
    SEAM(2);
    if (IN(3)) {
        const attn_body::Order S{vcu, G};
        attn_body::attn_phase<8>((char*)lds + RING_OFF, (attn_body::bf16*)YQ, (const attn_body::bf16*)KB, (const attn_body::bf16*)VB, S);
        conv_phase(XBC, args.in[8], args.in[9], XC, bx, G, tid);
    }
    SEAM(3);
    if (IN(4)) {
        for (int it = bx; it < NB * 16; it += G) ssd_item_naive(it >> 4, it & 15, XC, DT, Z, args.in[11], args.in[12], YQ, SSQ, (LAS float*)(ldsp + RING_OFF), tid);
    }
    SEAM(4);

    if (IN(5)) {
        pg8::Sched2 S; S.init(G, bx);
        LAS float* rt = (LAS float*)(ldsp + RSTD_OFF);
        { pg8::Unit u; for (int i = 0; i < 4 && S.next(i, u); ++i) if (tid < 256) { const float* q = SSQ + ((size_t)u.pm * 256 + tid) * 16; float s = 0.f;
#pragma unroll
                for (int j = 0; j < 16; ++j) s += q[j];
                rt[i * 256 + tid] = rsqrtf(s * (1.f / 1024.f) + EPS); } }
        __syncthreads();
        pg8::Gemm g{YQ, bt2, ML, 1024, 2048};
        pg8::Epi2 E{args.in[0], mod, args.out, RPART, (const LAS float*)rt};
        pg8::gemm_phase<pg8::Epi2, pg8::Sched2, true, true>(ldsp + RING_OFF, g, S, E);
    }
    SEAM(5);

    if (IN(6)) {
        const int gw = bx * NWAVES + wave, NGW = G * NWAVES;
        for (int m = gw; m < ML; m += NGW) {
            const f32x4 q0 = *(const f32x4*)(RPART + (size_t)m * 16), q1 = *(const f32x4*)(RPART + (size_t)m * 16 + 4), q2 = *(const f32x4*)(RPART + (size_t)m * 16 + 8), q3 = *(const f32x4*)(RPART + (size_t)m * 16 + 12);
            const float s = ((q0[0] + q0[1]) + (q0[2] + q0[3])) + ((q1[0] + q1[1]) + (q1[2] + q1[3])) + ((q2[0] + q2[1]) + (q2[2] + q2[3])) + ((q3[0] + q3[1]) + (q3[2] + q3[3]));
            const float rstd = rsqrtf(s * (1.f / DM) + EPS);
            GAS f32x4* o = (GAS f32x4*)(args.out + (size_t)m * DM) + lane;
#pragma unroll
            for (int j = 0; j < 4; ++j) { const f32x4 fg = *(const f32x4*)(args.in[17] + 4 * lane + 256 * j); o[64 * j] = o[64 * j] * rstd * fg; }
        }
    }
#undef IN
#undef SEAM
}

__global__ void k_mod(const float* c, const float* c_ctx, const float* ada_w, const float* ada_b, float* mod) {
    const int i = blockIdx.x * 256 + threadIdx.x; if (i >= 33 * 3072) return;
    const int b = i / 3072, n = i % 3072; const float* cv = b < 32 ? c + b * 1024 : c_ctx;
    float acc = 0.f;
    for (int k = 0; k < 1024; ++k) acc += siluf(cv[k]) * ada_w[(size_t)k * 3072 + n];
    mod[i] = acc + ada_b[n];
}
__global__ void k_tables(float* rope) {
    const int i = blockIdx.x * 256 + threadIdx.x; if (i >= 1024) return;
    const int p = i >> 4, f = i & 15; const float inv = powf(10000.f, -(float)f / 16.f); const float ang = (float)p * inv;
    rope[i] = cosf(ang); rope[1024 + i] = sinf(ang);
}
__global__ void k_bt1(const float* w_in, bf16* bt1) {
    const size_t i = (size_t)blockIdx.x * 256 + threadIdx.x; if (i >= (size_t)N1 * 1024) return;
    const int v = (int)(i >> 10), k = (int)(i & 1023); const int a = vcol_actual(v);
    bt1[i] = (bf16)(a >= 0 ? f2bf(w_in[(size_t)k * PROJ + a]) : 0u);
}
__global__ void k_bt2(const float* w_out, const float* ssd_g, bf16* bt2) {
    const size_t i = (size_t)blockIdx.x * 256 + threadIdx.x; if (i >= (size_t)1024 * 2048) return;
    const int n = (int)(i >> 11), kk = (int)(i & 2047);
    const float v = kk < 1024 ? w_out[(size_t)(1024 + kk) * 1024 + n] * ssd_g[kk] : w_out[(size_t)(kk - 1024) * 1024 + n];
    bt2[i] = (bf16)f2bf(v);
}
__global__ void k_norm(const float* x, const float* ctx, const float* norm_g, const float* mod, bf16* H) {
    const int row = blockIdx.x * 4 + (threadIdx.x >> 6), lane = threadIdx.x & 63; if (row >= MT) return;
    const float* xr = row < ML ? x + (size_t)row * DM : ctx + (size_t)(row - ML) * DM;
    const float* md = mod + (size_t)(row < ML ? row / SEQ : 32) * 3072;
    float v[16]; float s = 0.f;
    for (int j = 0; j < 16; ++j) { v[j] = xr[lane + 64 * j]; s += v[j] * v[j]; }
    for (int o = 1; o < 64; o <<= 1) s += __shfl_xor(s, o);
    const float rstd = rsqrtf(s * (1.f / DM) + EPS);
    for (int j = 0; j < 16; ++j) { const int k = lane + 64 * j; const float h = v[j] * rstd * norm_g[k] * (1.f + md[1024 + k]) + md[k]; H[(size_t)row * DM + k] = (bf16)f2bf(h); }
}
__global__ __launch_bounds__(256) void k_gemm1(const bf16* H, const bf16* bt1, const float* rope, const float* qg, const float* kg, const float* dt_bias,
                                                bf16* KB, bf16* VB, bf16* XBC, float* DT, bf16* YQ, bf16* Z) {
    __shared__ float As[32][65];
    __shared__ float Ps[32][257];
    const int pn = blockIdx.x, rt = blockIdx.y, tid = threadIdx.x; const int row0 = rt * 32;
    if (row0 >= ML && pn > 8) return;
    float acc[32];
    for (int r = 0; r < 32; ++r) acc[r] = 0.f;
    const bf16* bp = bt1 + (size_t)(pn * 256 + tid) * 1024;
    for (int k0 = 0; k0 < 1024; k0 += 64) {
        __syncthreads();
        for (int e = tid; e < 32 * 64; e += 256) { const int r = e >> 6, kk = e & 63; As[r][kk] = bf2f(H[(size_t)(row0 + r) * DM + k0 + kk]); }
        __syncthreads();
        for (int kk = 0; kk < 64; ++kk) { const float b = bf2f(bp[k0 + kk]);
            for (int r = 0; r < 32; ++r) acc[r] += As[r][kk] * b; }
    }
    for (int r = 0; r < 32; ++r) Ps[r][tid] = acc[r];
    __syncthreads();
    const bool isctx = row0 >= ML;
    if (pn == 0 || (pn >= 9 && pn < 13)) {
        {
            const int r = tid >> 3, hd = (tid >> 1) & 3, ax = tid & 1, row = row0 + r; const float* g = pn == 0 ? kg : qg;
            float s = 0.f;
            for (int d = 0; d < 32; ++d) { const float v = Ps[r][hperm_inv(hd, ax * 32 + d)]; s += v * v; }
            s += __shfl_xor(s, 1);
            const float rstd = rsqrtf(s * (1.f / 64.f) + EPS);
            const int t = row % SEQ, p = ax == 0 ? (t >> 6) : (t & 63);
            bf16* dst; float osc = 1.f;
            if (pn == 0) { const int b = isctx ? (row - ML) / CTXL : row / SEQ, pos = isctx ? SEQ + (row - ML) % CTXL : row % SEQ; dst = KB + ((size_t)b * KVL + pos) * 256 + hd * 64 + ax * 32; }
            else { dst = YQ + (size_t)row * 2048 + 1024 + ((pn - 9) * 4 + hd) * 64 + ax * 32; osc = C2; }
            for (int f = 0; f < 16; ++f) {
                const float x1 = Ps[r][hperm_inv(hd, ax * 32 + f)] * rstd * g[ax * 32 + f], x2 = Ps[r][hperm_inv(hd, ax * 32 + 16 + f)] * rstd * g[ax * 32 + 16 + f];
                float o1 = x1, o2 = x2;
                if (!isctx) { const float cs = rope[p * 16 + f], sn = rope[1024 + p * 16 + f]; o1 = x1 * cs - x2 * sn; o2 = x2 * cs + x1 * sn; }
                dst[f] = (bf16)f2bf(o1 * osc); dst[16 + f] = (bf16)f2bf(o2 * osc);
            }
        }
    } else {
        for (int r = 0; r < 32; ++r) { const int row = row0 + r; const float v = Ps[r][tid];
            if (pn == 1) { const int b = isctx ? (row - ML) / CTXL : row / SEQ, pos = isctx ? SEQ + (row - ML) % CTXL : row % SEQ;
                VB[((size_t)b * KVL + pos) * 256 + tid] = (bf16)f2bf(v); }
            else if (pn < 8) XBC[(size_t)row * CONVC + (pn - 2) * 256 + tid] = (bf16)f2bf(v);
            else if (pn == 8) { if (tid < 32) DT[(size_t)row * 32 + tid] = softplusf(v + dt_bias[tid]); }
            else if (pn < 17) YQ[(size_t)row * 2048 + (pn - 13) * 256 + tid] = (bf16)f2bf(siluf(v));
            else Z[(size_t)row * 1024 + (pn - 17) * 256 + tid] = (bf16)f2bf(siluf(v)); }
    }
}
__global__ __launch_bounds__(256) void k_attn(bf16* YQ, const bf16* KB, const bf16* VB) {
    __shared__ float Qs[64][65]; __shared__ float Ks[64][65]; __shared__ float Ps[64][65]; __shared__ bf16 Vs[64][66];
    const int qb = blockIdx.x, h = blockIdx.y, b = blockIdx.z, tid = threadIdx.x, ty = tid >> 4, tx = tid & 15;
    const size_t row0 = (size_t)b * SEQ + qb * 64; const int kvh = h >> 2;
    for (int e = tid; e < 4096; e += 256) { const int r = e >> 6, d = e & 63; Qs[r][d] = bf2f(YQ[(row0 + r) * 2048 + 1024 + h * 64 + d]); }
    float o[4][4], l[4];
    for (int i = 0; i < 4; ++i) { l[i] = 0.f; for (int j = 0; j < 4; ++j) o[i][j] = 0.f; }
    for (int kt = 0; kt < KVL / 64; ++kt) {
        __syncthreads();
        for (int e = tid; e < 4096; e += 256) { const int r = e >> 6, d = e & 63; const size_t src = ((size_t)b * KVL + kt * 64 + r) * 256 + kvh * 64 + d;
            Ks[r][d] = bf2f(KB[src]); Vs[r][d] = VB[src]; }
        __syncthreads();
        float s[4][4];
        for (int i = 0; i < 4; ++i) for (int j = 0; j < 4; ++j) s[i][j] = 0.f;
        for (int d = 0; d < 64; ++d) { float a[4], k4[4];
            for (int i = 0; i < 4; ++i) { a[i] = Qs[ty * 4 + i][d]; k4[i] = Ks[tx * 4 + i][d]; }
            for (int i = 0; i < 4; ++i) for (int j = 0; j < 4; ++j) s[i][j] += a[i] * k4[j]; }
        for (int i = 0; i < 4; ++i) for (int j = 0; j < 4; ++j) Ps[ty * 4 + i][tx * 4 + j] = exp2f(s[i][j]);
        __syncthreads();
        for (int key = 0; key < 64; ++key) { float p[4], v4[4];
            for (int i = 0; i < 4; ++i) { p[i] = Ps[ty * 4 + i][key]; v4[i] = bf2f(Vs[key][tx * 4 + i]); }
            for (int i = 0; i < 4; ++i) { l[i] += p[i]; for (int j = 0; j < 4; ++j) o[i][j] += p[i] * v4[j]; } }
    }
    for (int i = 0; i < 4; ++i) for (int j = 0; j < 4; ++j) { const size_t row = row0 + ty * 4 + i; const int d = tx * 4 + j;
        const float ga = bf2f(YQ[row * 2048 + h * 64 + d]);
        YQ[row * 2048 + 1024 + h * 64 + d] = (bf16)f2bf(o[i][j] / l[i] * ga); }
}
__global__ void k_conv(const bf16* XBC, const float* cw, const float* cb, bf16* XC) {
    const size_t i = (size_t)blockIdx.x * 256 + threadIdx.x; if (i >= (size_t)MT * CONVC) return;
    const int row = (int)(i / CONVC), ch = (int)(i % CONVC);
    int t, len; if (row < ML) { t = row % SEQ; len = SEQ; } else { t = (row - ML) % CTXL; len = CTXL; }
    float acc = cb[ch];
    for (int j = 0; j < 5; ++j) { const int tt = t + j - 2; if (tt >= 0 && tt < len) acc += cw[j * CONVC + ch] * bf2f(XBC[(size_t)(row + j - 2) * CONVC + ch]); }
    XC[i] = (bf16)f2bf(siluf(acc));
}
__global__ __launch_bounds__(512) void k_ssd(const bf16* XC, const float* DT, const bf16* Z, const float* a_log, const float* d_skip, bf16* YQ, float* SSQ) {
    __shared__ float ysq[64];
    const int h = blockIdx.x, b = blockIdx.y, tid = threadIdx.x, p = tid >> 3, nc = tid & 7, g = h >> 3;
    for (int dd = 0; dd < 2; ++dd) { const int d = 1 - dd;
        const float a_neg = -expf(a_log[d * 16 + h]);
        float S[16];
        for (int j = 0; j < 16; ++j) S[j] = 0.f;
        for (int seq = 0; seq < 2; ++seq) { const int len = seq == 0 ? CTXL : SEQ; const size_t rbase = seq == 0 ? (size_t)ML + (size_t)b * CTXL : (size_t)b * SEQ;
            for (int st = 0; st < len; ++st) { const int t = d ? len - 1 - st : st; const size_t row = rbase + t;
                const float dt = DT[row * 32 + d * 16 + h]; const float dec = expf(dt * a_neg);
                const float xs = bf2f(XC[row * CONVC + h * 64 + p]); const float X = xs * dt;
                const bf16* Bp = XC + row * CONVC + 1024 + g * 128 + nc * 16; const bf16* Cp = Bp + 256;
                float y = 0.f;
                for (int j = 0; j < 16; ++j) { S[j] = S[j] * dec + X * bf2f(Bp[j]); y += bf2f(Cp[j]) * S[j]; }
                y += __shfl_xor(y, 1); y += __shfl_xor(y, 2); y += __shfl_xor(y, 4);
                if (seq == 1) {
                    bf16* yp = YQ + row * 2048 + h * 64 + p;
                    if (d == 1) { if (nc == 0) *yp = (bf16)f2bf(y); }
                    else {
                        float yg = 0.f;
                        if (nc == 0) { const float yt = y + bf2f(*yp) + d_skip[h] * xs; yg = yt * bf2f(Z[row * 1024 + h * 64 + p]); *yp = (bf16)f2bf(yg); ysq[p] = yg * yg; }
                        __syncthreads();
                        if (tid < 64) { float q = ysq[tid]; for (int o = 1; o < 64; o <<= 1) q += __shfl_xor(q, o); if (tid == 0) SSQ[row * 16 + h] = q; }
                        __syncthreads();
                    }
                }
            }
        }
    }
}
__global__ __launch_bounds__(256) void k_gemm2(const bf16* YQ, const bf16* bt2, const float* SSQ, const float* x, const float* mod, float* out, float* RPART) {
    __shared__ float As[32][65]; __shared__ float red[32][4];
    const int pn = blockIdx.x, rt = blockIdx.y, tid = threadIdx.x, row0 = rt * 32;
    float acc[32];
    for (int r = 0; r < 32; ++r) acc[r] = 0.f;
    const bf16* bp = bt2 + (size_t)(pn * 256 + tid) * 2048;
    for (int k0 = 0; k0 < 2048; k0 += 64) {
        if (k0 == 1024) { for (int r = 0; r < 32; ++r) { float s = 0.f; for (int j = 0; j < 16; ++j) s += SSQ[(size_t)(row0 + r) * 16 + j]; acc[r] *= rsqrtf(s * (1.f / 1024.f) + EPS); } }
        __syncthreads();
        for (int e = tid; e < 32 * 64; e += 256) { const int r = e >> 6, kk = e & 63; As[r][kk] = bf2f(YQ[(size_t)(row0 + r) * 2048 + k0 + kk]); }
        __syncthreads();
        for (int kk = 0; kk < 64; ++kk) { const float bv = bf2f(bp[k0 + kk]);
            for (int r = 0; r < 32; ++r) acc[r] += As[r][kk] * bv; }
    }
    const int n = pn * 256 + tid;
    for (int r = 0; r < 32; ++r) { const int row = row0 + r; const float v = x[(size_t)row * DM + n] + mod[(size_t)(row / SEQ) * 3072 + 2048 + n] * acc[r];
        out[(size_t)row * DM + n] = v; float q = v * v;
        for (int o = 1; o < 64; o <<= 1) q += __shfl_xor(q, o);
        if ((tid & 63) == 0) RPART[(size_t)row * 16 + pn * 4 + (tid >> 6)] = q; }
}
__global__ void k_final(float* out, const float* RPART, const float* fg) {
    const int row = blockIdx.x * 4 + (threadIdx.x >> 6), lane = threadIdx.x & 63;
    float s = 0.f;
    for (int j = 0; j < 16; ++j) s += RPART[(size_t)row * 16 + j];
    const float rstd = rsqrtf(s * (1.f / DM) + EPS);
    for (int j = 0; j < 16; ++j) { const int k = lane + 64 * j; out[(size_t)row * DM + k] *= rstd * fg[k]; }
}


#ifndef FAST_MASK
#define FAST_MASK 0x7f
#endif
extern "C" void kernel_launch(void* const* d_in, const int* in_sizes, int n_in, void* d_out, int out_size, void* d_ws, size_t ws_size, hipStream_t stream) {
    if (n_in != 18 || out_size != ML * DM || ws_size < WS_END) { fprintf(stderr, "kernel_launch: unexpected shapes (n_in %d out %d ws %zu)\n", n_in, out_size, ws_size); return; }
    static int grid = 0;
    if (grid == 0) {
        int dev = 0, cus = 0;
        if (hipGetDevice(&dev) != hipSuccess || hipDeviceGetAttribute(&cus, hipDeviceAttributeMultiprocessorCount, dev) != hipSuccess) { fprintf(stderr, "kernel_launch: device query failed\n"); grid = -1; return; }
        if (hipFuncSetAttribute((const void*)mega, hipFuncAttributeMaxDynamicSharedMemorySize, LDS_BYTES) != hipSuccess) { fprintf(stderr, "kernel_launch: hipFuncSetAttribute failed\n"); grid = -1; return; }
        int per_cu = 0;
        if (hipOccupancyMaxActiveBlocksPerMultiprocessor(&per_cu, (const void*)mega, NWAVES * 64, LDS_BYTES) != hipSuccess || per_cu < 1) fprintf(stderr, "kernel_launch: note: occupancy query says %d blocks/CU\n", per_cu);
        (void)hipGetLastError();
        grid = cus;
    }
    if (grid < 0) return;
    const float* x = (const float*)d_in[0]; const float* c = (const float*)d_in[1]; const float* ctx = (const float*)d_in[2]; const float* c_ctx = (const float*)d_in[3];
    const float* ada_w = (const float*)d_in[4]; const float* ada_b = (const float*)d_in[5]; const float* norm_g = (const float*)d_in[6]; const float* w_in = (const float*)d_in[7];
    const float* conv_w = (const float*)d_in[8]; const float* conv_b = (const float*)d_in[9]; const float* dt_bias = (const float*)d_in[10]; const float* a_log = (const float*)d_in[11];
    const float* d_skip = (const float*)d_in[12]; const float* qg = (const float*)d_in[13]; const float* kg = (const float*)d_in[14]; const float* ssd_g = (const float*)d_in[15];
    const float* w_out = (const float*)d_in[16]; const float* final_g = (const float*)d_in[17];
    unsigned char* ws = (unsigned char*)d_ws; float* out = (float*)d_out;
    float* mod = (float*)(ws + WS_MOD); float* rope = (float*)(ws + WS_ROPE); float* SSQ = (float*)(ws + WS_SSQ); float* RPART = (float*)(ws + WS_RPART);
    bf16* bt1 = (bf16*)(ws + WS_BT1); bf16* bt2 = (bf16*)(ws + WS_BT2); float* DT = (float*)(ws + WS_DT); bf16* KB = (bf16*)(ws + WS_KB); bf16* VB = (bf16*)(ws + WS_VB);
    bf16* H = (bf16*)(ws + WS_R1); bf16* XC = (bf16*)(ws + WS_R1); bf16* XBC = (bf16*)(ws + WS_XBC); bf16* YQ = (bf16*)(ws + WS_YQ); bf16* Z = (bf16*)(ws + WS_Z);
    (void)hipMemsetAsync(ws + WS_CTL, 0, 1 * MiB, stream);
    Args a{};
    for (int i = 0; i < 18; ++i) a.in[i] = (const float*)d_in[i];
    a.out = out; a.ws = ws;
    for (int ph = 0; ph < NPHASE;) {
        if ((FAST_MASK >> ph) & 1) { int e = ph; while (e < NPHASE && ((FAST_MASK >> e) & 1)) ++e;
            a.ph_lo = ph; a.ph_hi = e; hipLaunchKernelGGL(mega, dim3(grid), dim3(NWAVES * 64), LDS_BYTES, stream, a);
            const hipError_t le = hipPeekAtLastError(); if (le != hipSuccess) fprintf(stderr, "kernel_launch: mega launch failed: %s\n", hipGetErrorName(le));
            ph = e; continue; }
        switch (ph) {
        case 0: k_mod<<<(33 * 3072 + 255) / 256, 256, 0, stream>>>(c, c_ctx, ada_w, ada_b, mod); k_tables<<<4, 256, 0, stream>>>(rope);
                k_bt1<<<(N1 * 1024) / 256, 256, 0, stream>>>(w_in, bt1); k_bt2<<<(1024 * 2048) / 256, 256, 0, stream>>>(w_out, ssd_g, bt2); break;
        case 1: k_norm<<<MT / 4, 256, 0, stream>>>(x, ctx, norm_g, mod, H); break;
        case 2: k_gemm1<<<dim3(21, MT / 32), 256, 0, stream>>>(H, bt1, rope, qg, kg, dt_bias, KB, VB, XBC, DT, YQ, Z); break;
        case 3: k_attn<<<dim3(SEQ / 64, 16, NB), 256, 0, stream>>>(YQ, KB, VB); k_conv<<<(unsigned)(((size_t)MT * CONVC + 255) / 256), 256, 0, stream>>>(XBC, conv_w, conv_b, XC); break;
        case 4: k_ssd<<<dim3(16, NB), 512, 0, stream>>>(XC, DT, Z, a_log, d_skip, YQ, SSQ); break;
        case 5: k_gemm2<<<dim3(4, ML / 32), 256, 0, stream>>>(YQ, bt2, SSQ, x, mod, out, RPART); break;
        case 6: k_final<<<ML / 4, 256, 0, stream>>>(out, RPART, final_g); break;
        }
        ++ph;
    }
}
```

```cpp
#include <hip/hip_runtime.h>
#include <cstdio>
#include <cstdint>
#include <hip/hip_bf16.h>

constexpr int DM = 1024, NB = 32, SEQ = 2048, CTXL = 256, KVL = SEQ + CTXL;
constexpr int ML = NB * SEQ, MC = NB * CTXL, MT = ML + MC;
constexpr int PROJ = 5152, OFF_XBC = 512, OFF_DT = 2048, CTXC = 2080, CONVC = 1536;
constexpr int N1 = 21 * 256;
constexpr float EPS = 1e-6f;
constexpr float C2 = 0.125f * 1.4426950408889634f;

typedef unsigned short bf16;
__host__ __device__ __forceinline__ unsigned f2bf(float f) { unsigned u = __builtin_bit_cast(unsigned, f); return (u + 0x7fffu + ((u >> 16) & 1u)) >> 16; }
__host__ __device__ __forceinline__ float bf2f(unsigned h) { return __builtin_bit_cast(float, (h & 0xffffu) << 16); }
__device__ __forceinline__ float siluf(float v) { return v / (1.f + __expf(-v)); }
__device__ __forceinline__ float softplusf(float v) { return v > 20.f ? v : log1pf(expf(v)); }

constexpr size_t MiB = 1u << 20;
constexpr size_t WS_CTL = 0;
constexpr size_t WS_MOD = 2 * MiB;
constexpr size_t WS_ROPE = 3 * MiB;
constexpr size_t WS_SSQ = 4 * MiB;
constexpr size_t WS_RPART = 8 * MiB;
constexpr size_t WS_BT1 = 12 * MiB;
constexpr size_t WS_BT2 = 23 * MiB;
constexpr size_t WS_DT = 28 * MiB;
constexpr size_t WS_KB = 38 * MiB;
constexpr size_t WS_VB = 74 * MiB;
constexpr size_t WS_R1 = 110 * MiB;
constexpr size_t WS_XBC = 326 * MiB;
constexpr size_t WS_YQ = 542 * MiB;
constexpr size_t WS_Z = 798 * MiB;
constexpr size_t WS_END = 926 * MiB;

__host__ __device__ __forceinline__ int hperm_dim(int vin) {
    const int bj = vin >> 7, wc = (vin >> 5) & 3, s = vin & 31, fq = s >> 3, e = s & 7;
    return wc * 64 + bj * 32 + (e >> 2) * 16 + 4 * fq + (e & 3);
}
__host__ __device__ __forceinline__ int hperm_inv(int head, int dim) {
    const int axis = dim >> 5, half = (dim >> 4) & 1, i16 = dim & 15, fq = i16 >> 2, e = (i16 & 3) + 4 * half;
    return 128 * axis + 32 * head + 8 * fq + e;
}
__host__ __device__ __forceinline__ int vcol_actual(int v) {
    const int t = v >> 8, vin = v & 255;
    if (t == 0) return hperm_dim(vin);
    if (t == 1) return 256 + vin;
    if (t < 8) return v;
    if (t == 8) return vin < 32 ? OFF_DT + vin : -1;
    if (t < 13) return CTXC + (t - 9) * 256 + hperm_dim(vin);
    if (t < 17) return CTXC + 1024 + (v - 13 * 256);
    return CTXC + 2048 + (v - 17 * 256);
}

namespace pg8 {
#define PG8_LAS __attribute__((address_space(3)))
typedef unsigned short bf16_t;
typedef short bf16x8 __attribute__((ext_vector_type(8)));
typedef float f32x4 __attribute__((ext_vector_type(4)));
typedef unsigned u32x4 __attribute__((ext_vector_type(4)));
constexpr int BM = 256, BK = 64, HALF = 128, HTB = HALF * BK * 2  , STAGE_BYTES = 8 * HTB, NXCD = 8, WGM = 8;

__host__ __device__ __forceinline__ int lds_byte(int r, int c) { const int st = (r >> 4) * 2 + (c >> 5), rr = r & 15, cc = c & 31, ob = rr * 64 + cc * 2; return st * 1024 + (ob ^ (((ob >> 9) & 1) << 5)); }
__host__ __device__ __forceinline__ void stage_rc(int b, int& R, int& C) { const int st = b / 1024, sb = b % 1024, swz = sb ^ (((sb >> 9) & 1) << 5); R = (st >> 1) * 16 + swz / 64; C = (st & 1) * 32 + (swz % 64) / 2; }
__host__ __device__ __forceinline__ int perm32(int rho) { const int n = rho >> 4, i = rho & 15; return 8 * (i >> 2) + 4 * n + (i & 3); }

struct Unit { int pm, pn; };
struct Gemm { const bf16_t* A; const bf16_t* Bt; int M, N, K; };

__device__ __forceinline__ unsigned cvt_pk_bf16(float lo, float hi) { unsigned r; asm volatile("v_cvt_pk_bf16_f32 %0, %1, %2" : "=v"(r) : "v"(lo), "v"(hi)); return r; }
typedef float f32x2 __attribute__((ext_vector_type(2)));
template <class Epi, class Sched, bool ALIGN_EPI = false, bool SP2 = false>
__device__ __forceinline__ void gemm_phase(PG8_LAS unsigned char* lds, const Gemm g, const Sched& S, const Epi& E) {
    const int tid = threadIdx.x, wid = __builtin_amdgcn_readfirstlane(tid >> 6), lane = tid & 63, wr = wid >> 2, wc = wid & 3, fr = lane & 15, fq = lane >> 4;
    const int K = g.K, nt = K / BK;
    unsigned voffA[2], voffB[2];
#pragma unroll
    for (int i = 0; i < 2; ++i) { int R, C; stage_rc(tid * 16 + i * 8192, R, C); const int Rb = Epi::PERM ? ((R & ~31) + perm32(R & 31)) : R;
        voffA[i] = (unsigned)(R * K + C) * 2u; voffB[i] = (unsigned)(Rb * K + C) * 2u; }
    const size_t kstep = (size_t)(BK * 2);
    const size_t hstep = (size_t)HALF * K * 2;
    const size_t tstep = 2 * hstep;
    const unsigned ldsw = (unsigned)wid * 1024u;
    const int aoff = lds_byte(wr * 64 + fr, fq * 8), boff = lds_byte(wc * 32 + fr, fq * 8);
#define PG8_SA(b, h) (((b) * 2 + (h)) * HTB)
#define PG8_SB(b, h) ((4 + (b) * 2 + (h)) * HTB)
#define PG8_STAGE(bufoff, gbase, voff) do { _Pragma("unroll") for (int _i = 0; _i < 2; ++_i) \
        __builtin_amdgcn_global_load_lds((const unsigned*)((const char*)(gbase) + (voff)[_i]), (PG8_LAS unsigned*)(lds + (bufoff) + ldsw + _i * 8192), 16, 0, 0); } while (0)
#define PG8_LDA(dst, b, h) do { _Pragma("unroll") for (int m = 0; m < 4; ++m) _Pragma("unroll") for (int k = 0; k < 2; ++k) dst[m][k] = *(const PG8_LAS bf16x8*)(lds + PG8_SA(b, h) + aoff + m * 2048 + k * 1024); } while (0)
#define PG8_LDB(dst, b, h) do { _Pragma("unroll") for (int n = 0; n < 2; ++n) _Pragma("unroll") for (int k = 0; k < 2; ++k) dst[n][k] = *(const PG8_LAS bf16x8*)(lds + PG8_SB(b, h) + boff + n * 2048 + k * 1024); } while (0)
#define PG8_MMA(ai, bj, At, Bt) do { __builtin_amdgcn_s_setprio(1); _Pragma("unroll") for (int m = 0; m < 4; ++m) _Pragma("unroll") for (int n = 0; n < 2; ++n) _Pragma("unroll") for (int k = 0; k < 2; ++k) \
        acc[ai][bj][m][n] = __builtin_amdgcn_mfma_f32_16x16x32_bf16(Bt[n][k], At[m][k], acc[ai][bj][m][n], 0, 0, 0); __builtin_amdgcn_s_setprio(0); } while (0)
#define PG8_WAIT_V(n) asm volatile("s_waitcnt vmcnt(" #n ")" ::: "memory")
#define PG8_WAIT_L(n) asm volatile("s_waitcnt lgkmcnt(" #n ")" ::: "memory")
#define PG8_BAR __builtin_amdgcn_s_barrier()
#define PG8_SCHED __builtin_amdgcn_sched_barrier(0)
    Unit cur, nxt; int ui = 0;
    if (!S.next(0, cur)) return;
    f32x4 acc[2][2][4][2];
#pragma unroll
    for (int a = 0; a < 2; ++a)
#pragma unroll
        for (int b = 0; b < 2; ++b)
#pragma unroll
            for (int m = 0; m < 4; ++m)
#pragma unroll
                for (int n = 0; n < 2; ++n) acc[a][b][m][n] = (f32x4){0.f, 0.f, 0.f, 0.f};
    bf16x8 At[4][2], B0[2][2], B1[2][2];
    const char* cA = (const char*)g.A + (size_t)cur.pm * tstep; const char* cB = (const char*)g.Bt + (size_t)cur.pn * tstep;
    S.a_ready(cur);
    if constexpr (SP2) {
        PG8_STAGE(PG8_SB(0, 0), cB, voffB); PG8_STAGE(PG8_SB(0, 1), cB + hstep, voffB); PG8_STAGE(PG8_SA(0, 0), cA, voffA); PG8_STAGE(PG8_SA(0, 1), cA + hstep, voffA);
        if (wr == 1) PG8_BAR;
        PG8_WAIT_V(2); PG8_BAR;
        PG8_STAGE(PG8_SB(1, 0), cB + kstep, voffB); PG8_STAGE(PG8_SA(1, 0), cA + kstep, voffA); PG8_STAGE(PG8_SB(1, 1), cB + hstep + kstep, voffB);
        PG8_WAIT_V(6); PG8_BAR;
    } else {
        PG8_STAGE(PG8_SB(0, 0), cB, voffB); PG8_STAGE(PG8_SA(0, 0), cA, voffA); PG8_STAGE(PG8_SB(0, 1), cB + hstep, voffB); PG8_STAGE(PG8_SA(0, 1), cA + hstep, voffA);
        if (wr == 1) PG8_BAR;
        PG8_WAIT_V(4); PG8_BAR;
        PG8_STAGE(PG8_SB(1, 0), cB + kstep, voffB); PG8_STAGE(PG8_SA(1, 0), cA + kstep, voffA); PG8_STAGE(PG8_SB(1, 1), cB + hstep + kstep, voffB);
        PG8_WAIT_V(6); PG8_BAR;
    }
    for (;;) {
        const bool has_next = S.next(ui + 1, nxt);
        const char* nA = has_next ? (const char*)g.A + (size_t)nxt.pm * tstep : cA; const char* nB = has_next ? (const char*)g.Bt + (size_t)nxt.pn * tstep : cB;
        for (int t = 0; t < nt; t += 2) {
            if constexpr (Epi::MIDK) { if (t == nt / 2) E.midk(acc, ui, wr, fr); }
            const bool last = (t == nt - 2);
            const char* a1 = cA + (size_t)(t + 1) * kstep;
            const char* a2 = last ? nA : cA + (size_t)(t + 2) * kstep; const char* b2 = last ? nB : cB + (size_t)(t + 2) * kstep;
            const char* a3 = a2 + kstep; const char* b3 = b2 + kstep;
            if (last && has_next) S.a_ready(nxt);
            if constexpr (SP2) {
            PG8_LDB(B0, 0, 0); PG8_LDB(B1, 0, 1); PG8_SCHED; PG8_LDA(At, 0, 0); PG8_STAGE(PG8_SA(1, 1), a1 + hstep, voffA);
            PG8_WAIT_V(8); PG8_WAIT_L(0); PG8_BAR; PG8_MMA(0, 0, At, B0); PG8_MMA(0, 1, At, B1); PG8_BAR; PG8_SCHED;
            PG8_LDA(At, 0, 1); PG8_STAGE(PG8_SB(0, 0), b2, voffB); PG8_STAGE(PG8_SB(0, 1), b2 + hstep, voffB); PG8_STAGE(PG8_SA(0, 0), a2, voffA);
            PG8_WAIT_V(8); PG8_WAIT_L(0); PG8_BAR; PG8_MMA(1, 0, At, B0); PG8_MMA(1, 1, At, B1); PG8_BAR; PG8_SCHED;
            PG8_LDB(B0, 1, 0); PG8_LDB(B1, 1, 1); PG8_SCHED; PG8_LDA(At, 1, 0); PG8_STAGE(PG8_SA(0, 1), a2 + hstep, voffA);
            PG8_WAIT_V(8); PG8_WAIT_L(0); PG8_BAR; PG8_MMA(0, 0, At, B0); PG8_MMA(0, 1, At, B1); PG8_BAR; PG8_SCHED;
            PG8_LDA(At, 1, 1); PG8_STAGE(PG8_SB(1, 0), b3, voffB); PG8_STAGE(PG8_SB(1, 1), b3 + hstep, voffB); PG8_STAGE(PG8_SA(1, 0), a3, voffA);
            PG8_WAIT_V(8); PG8_WAIT_L(0); PG8_BAR; PG8_MMA(1, 0, At, B0); PG8_MMA(1, 1, At, B1); PG8_BAR; PG8_SCHED;
            } else {
            PG8_LDB(B0, 0, 0); PG8_SCHED; PG8_LDA(At, 0, 0); PG8_STAGE(PG8_SA(1, 1), a1 + hstep, voffA);
            PG8_WAIT_L(8); PG8_BAR; PG8_WAIT_L(0); PG8_MMA(0, 0, At, B0); PG8_BAR; PG8_SCHED;
            PG8_LDB(B1, 0, 1); PG8_STAGE(PG8_SB(0, 0), b2, voffB);
            PG8_BAR; PG8_WAIT_L(0); PG8_MMA(0, 1, At, B1); PG8_BAR;
            PG8_LDA(At, 0, 1); PG8_STAGE(PG8_SA(0, 0), a2, voffA);
            PG8_BAR; PG8_WAIT_L(0); PG8_MMA(1, 0, At, B0); PG8_BAR; PG8_SCHED;
            PG8_STAGE(PG8_SB(0, 1), b2 + hstep, voffB);
            PG8_WAIT_V(6); PG8_BAR; PG8_MMA(1, 1, At, B1); PG8_BAR;
            PG8_LDB(B0, 1, 0); PG8_SCHED; PG8_LDA(At, 1, 0); PG8_STAGE(PG8_SA(0, 1), a2 + hstep, voffA);
            PG8_WAIT_L(8); PG8_BAR; PG8_WAIT_L(0); PG8_MMA(0, 0, At, B0); PG8_BAR; PG8_SCHED;
            PG8_LDB(B1, 1, 1); PG8_STAGE(PG8_SB(1, 0), b3, voffB);
            PG8_BAR; PG8_WAIT_L(0); PG8_MMA(0, 1, At, B1); PG8_BAR;
            PG8_LDA(At, 1, 1); PG8_STAGE(PG8_SA(1, 0), a3, voffA);
            PG8_BAR; PG8_WAIT_L(0); PG8_MMA(1, 0, At, B0); PG8_BAR; PG8_SCHED;
            PG8_STAGE(PG8_SB(1, 1), b3 + hstep, voffB);
            PG8_WAIT_V(6); PG8_BAR; PG8_MMA(1, 1, At, B1); PG8_BAR;
            }
        }
        if constexpr (ALIGN_EPI) { if (wr == 0) PG8_BAR; }
        if constexpr (!Epi::AFTER_DRAIN) { E(acc, cur, wr, wc, fr, fq); S.done(cur); }
        if (!has_next) break;
#pragma unroll
        for (int a = 0; a < 2; ++a)
#pragma unroll
            for (int b = 0; b < 2; ++b)
#pragma unroll
                for (int m = 0; m < 4; ++m)
#pragma unroll
                    for (int n = 0; n < 2; ++n) acc[a][b][m][n] = (f32x4){0.f, 0.f, 0.f, 0.f};
        cur = nxt; cA = nA; cB = nB; ++ui;
        if constexpr (ALIGN_EPI) { if (wr == 1) PG8_BAR; }
    }
    PG8_WAIT_V(0);
    if constexpr (!ALIGN_EPI) { if (wr == 0) PG8_BAR; }
    PG8_BAR;
    if constexpr (Epi::AFTER_DRAIN) { E.fused(acc, cur, wr, wc, fr, fq, lds, wid, lane); S.done(cur); }
#undef PG8_SA
#undef PG8_SB
#undef PG8_STAGE
#undef PG8_LDA
#undef PG8_LDB
#undef PG8_MMA
#undef PG8_WAIT_V
#undef PG8_WAIT_L
#undef PG8_BAR
#undef PG8_SCHED
}
struct Sched1 {
    int G, c;
    __device__ __forceinline__ void init(int G_, int c_) { G = G_; c = c_; }
    __device__ __forceinline__ bool next(int i, Unit& u) const {
        constexpr int nN = 21, nwg = 256 * nN;
        const int L = i * G + c;
        if (L < nwg) { const int wgid = (L % NXCD) * (nwg / NXCD) + L / NXCD; const int nig = WGM * nN, fm = (wgid / nig) * WGM;
            u.pm = fm + ((wgid % nig) % WGM); u.pn = (wgid % nig) / WGM; return true; }
        const int L2 = L - nwg; if (L2 >= 288) return false;
        const int wg = (L2 % NXCD) * 36 + L2 / NXCD; u.pn = wg >> 5; u.pm = 256 + (wg & 31); return true;
    }
    __device__ __forceinline__ void a_ready(const Unit&) const {}
    __device__ __forceinline__ void done(const Unit&) const {}
};
struct Sched2 {
    int G, c;
    __device__ __forceinline__ void init(int G_, int c_) { G = G_; c = c_; }
    __device__ __forceinline__ bool next(int i, Unit& u) const {
        constexpr int nN = 4, nwg = 256 * nN;
        const int L = i * G + c; if (L >= nwg) return false;
        const int wgid = (L % NXCD) * (nwg / NXCD) + L / NXCD; const int nig = WGM * nN, fm = (wgid / nig) * WGM;
        u.pm = fm + ((wgid % nig) % WGM); u.pn = (wgid % nig) / WGM; return true;
    }
    __device__ __forceinline__ void a_ready(const Unit&) const {}
    __device__ __forceinline__ void done(const Unit&) const {}
};
__device__ __forceinline__ float dot4(const f32x4 a) { return (a[0] * a[0] + a[1] * a[1]) + (a[2] * a[2] + a[3] * a[3]); }
__device__ __forceinline__ float silu1(float v) { return v * __builtin_amdgcn_rcpf(1.f + __expf(-v)); }
typedef unsigned u32x2 __attribute__((ext_vector_type(2)));
__device__ __forceinline__ u32x2 pk4(const f32x4 v) { u32x2 w; w.x = cvt_pk_bf16(v[0], v[1]); w.y = cvt_pk_bf16(v[2], v[3]); return w; }
struct Epi1 {
    static constexpr bool PERM = true, AFTER_DRAIN = false, MIDK = false;
    bf16_t *KB, *VB, *XBC, *YQ, *Z; float* DT; const float *rope, *qg, *kg, *dt_bias;
    __device__ __forceinline__ void midk(f32x4 (&)[2][2][4][2], int, int, int) const {}
    __device__ __forceinline__ void operator()(const f32x4 (&acc)[2][2][4][2], const Unit& u, int wr, int wc, int fr_in, int fq_in) const {
        int fr = fr_in, fq = fq_in; asm volatile("" : "+v"(fr), "+v"(fq));
        const int pn = u.pn, pm = u.pm; const bool isctx = pm >= 256; const int rloc = wr * 64 + fr;
        const int bb = isctx ? pm - 256 : pm >> 3, pos0 = isctx ? SEQ : (pm & 7) * 256;
        if (pn == 0 || (pn >= 9 && pn < 13)) {
            const float* g = pn == 0 ? kg : qg;
            const f32x4 g00 = *(const f32x4*)(g + 4 * fq), g01 = *(const f32x4*)(g + 16 + 4 * fq), g10 = *(const f32x4*)(g + 32 + 4 * fq), g11 = *(const f32x4*)(g + 48 + 4 * fq);
            const float osc = pn == 0 ? 1.f : C2;
            bf16_t* dbase; size_t pitch;
            if (pn == 0) { dbase = KB + ((size_t)bb * KVL + pos0) * 256 + wc * 64 + 4 * fq; pitch = 256; }
            else { dbase = YQ + (size_t)pm * 256 * 2048 + 1024 + ((pn - 9) * 4 + wc) * 64 + 4 * fq; pitch = 2048; }
#pragma unroll
            for (int ai = 0; ai < 2; ++ai) {
                const int prow = (pm & 7) * 4 + 2 * ai + wr;
                f32x4 c0 = (f32x4){1.f, 1.f, 1.f, 1.f}, s0 = (f32x4){0.f, 0.f, 0.f, 0.f};
                if (!isctx) { c0 = *(const f32x4*)(rope + prow * 16 + 4 * fq); s0 = *(const f32x4*)(rope + 1024 + prow * 16 + 4 * fq); }
#pragma unroll
                for (int m = 0; m < 4; ++m) {
                    f32x4 a0 = acc[ai][0][m][0], a1 = acc[ai][0][m][1], b0 = acc[ai][1][m][0], b1 = acc[ai][1][m][1];
                    float s = (dot4(a0) + dot4(a1)) + (dot4(b0) + dot4(b1));
                    s += __shfl_xor(s, 16); s += __shfl_xor(s, 32);
                    const float rstd = rsqrtf(s * (1.f / 64.f) + EPS) * osc;
                    a0 = a0 * rstd * g00; a1 = a1 * rstd * g01; b0 = b0 * rstd * g10; b1 = b1 * rstd * g11;
                    f32x4 c1 = (f32x4){1.f, 1.f, 1.f, 1.f}, s1 = (f32x4){0.f, 0.f, 0.f, 0.f};
                    if (!isctx) { const int pcol = 16 * m + fr; c1 = *(const f32x4*)(rope + pcol * 16 + 4 * fq); s1 = *(const f32x4*)(rope + 1024 + pcol * 16 + 4 * fq); }
                    const f32x4 o00 = a0 * c0 - a1 * s0, o01 = a1 * c0 + a0 * s0, o10 = b0 * c1 - b1 * s1, o11 = b1 * c1 + b0 * s1;
                    bf16_t* dst = dbase + (size_t)(rloc + 128 * ai + 16 * m) * pitch;
                    *(u32x2*)(dst) = pk4(o00); *(u32x2*)(dst + 16) = pk4(o01); *(u32x2*)(dst + 32) = pk4(o10); *(u32x2*)(dst + 48) = pk4(o11);
                    asm volatile("" ::: "memory");
                }
            }
        } else if (pn == 8) {
            if (wc == 0) {
                const f32x4 bA = *(const f32x4*)(dt_bias + 8 * fq), bB = *(const f32x4*)(dt_bias + 8 * fq + 4);
#pragma unroll
                for (int ai = 0; ai < 2; ++ai)
#pragma unroll
                    for (int m = 0; m < 4; ++m) { const size_t row = (size_t)pm * 256 + rloc + 128 * ai + 16 * m;
                        f32x4 v0 = acc[ai][0][m][0] + bA, v1 = acc[ai][0][m][1] + bB;
#pragma unroll
                        for (int e = 0; e < 4; ++e) { v0[e] = v0[e] > 20.f ? v0[e] : log1pf(__expf(v0[e])); v1[e] = v1[e] > 20.f ? v1[e] : log1pf(__expf(v1[e])); }
                        *(f32x4*)(DT + row * 32 + 8 * fq) = v0; *(f32x4*)(DT + row * 32 + 8 * fq + 4) = v1; asm volatile("" ::: "memory"); }
            }
        } else {
            bf16_t* dbase; size_t pitch; bool act = false;
            const int cin = wc * 32 + 8 * fq;
            if (pn == 1) { dbase = VB + ((size_t)bb * KVL + pos0) * 256 + cin; pitch = 256; }
            else if (pn < 8) { dbase = XBC + (size_t)pm * 256 * CONVC + (pn - 2) * 256 + cin; pitch = CONVC; }
            else if (pn < 17) { dbase = YQ + (size_t)pm * 256 * 2048 + (pn - 13) * 256 + cin; pitch = 2048; act = true; }
            else { dbase = Z + (size_t)pm * 256 * 1024 + (pn - 17) * 256 + cin; pitch = 1024; act = true; }
#pragma unroll
            for (int ai = 0; ai < 2; ++ai)
#pragma unroll
                for (int m = 0; m < 4; ++m) { bf16_t* dst = dbase + (size_t)(rloc + 128 * ai + 16 * m) * pitch;
#pragma unroll
                    for (int bj = 0; bj < 2; ++bj) { f32x4 v0 = acc[ai][bj][m][0], v1 = acc[ai][bj][m][1];
                        if (act) {
#pragma unroll
                            for (int e = 0; e < 4; ++e) { v0[e] = silu1(v0[e]); v1[e] = silu1(v1[e]); } }
                        u32x4 w; w.x = cvt_pk_bf16(v0[0], v0[1]); w.y = cvt_pk_bf16(v0[2], v0[3]); w.z = cvt_pk_bf16(v1[0], v1[1]); w.w = cvt_pk_bf16(v1[2], v1[3]);
                        *(u32x4*)(dst + bj * HALF) = w; } asm volatile("" ::: "memory"); }
        }
    }
};
struct Epi2 {
    static constexpr bool PERM = false, AFTER_DRAIN = false, MIDK = true;
    const float* x; const float* mod; float* out; float* RPART; const PG8_LAS float* rstd_tab;
    __device__ __forceinline__ void midk(f32x4 (&acc)[2][2][4][2], int ui, int wr, int fr) const {
#pragma unroll
        for (int ai = 0; ai < 2; ++ai)
#pragma unroll
            for (int m = 0; m < 4; ++m) { const float r = rstd_tab[ui * 256 + 128 * ai + 64 * wr + 16 * m + fr];
#pragma unroll
                for (int bj = 0; bj < 2; ++bj)
#pragma unroll
                    for (int n = 0; n < 2; ++n) acc[ai][bj][m][n] *= r; }
    }
    __device__ __forceinline__ void operator()(const f32x4 (&acc)[2][2][4][2], const Unit& u, int wr, int wc, int fr_in, int fq_in) const {
        int fr = fr_in, fq = fq_in; asm volatile("" : "+v"(fr), "+v"(fq));
        const int b = u.pm >> 3, col0 = u.pn * BM + wc * 32 + 4 * fq;
        f32x4 gv[2][2];
#pragma unroll
        for (int bj = 0; bj < 2; ++bj)
#pragma unroll
            for (int n = 0; n < 2; ++n) gv[bj][n] = *(const f32x4*)(mod + (size_t)b * 3072 + 2048 + col0 + bj * HALF + n * 16);
#pragma unroll
        for (int ai = 0; ai < 2; ++ai)
#pragma unroll
            for (int m = 0; m < 4; ++m) { const size_t row = (size_t)u.pm * BM + 128 * ai + 64 * wr + 16 * m + fr; const size_t off = row * 1024 + col0; float q = 0.f;
#pragma unroll
                for (int bj = 0; bj < 2; ++bj)
#pragma unroll
                    for (int n = 0; n < 2; ++n) { const f32x4 xv = *(const f32x4*)(x + off + bj * HALF + n * 16); const f32x4 o = xv + gv[bj][n] * acc[ai][bj][m][n];
                        *(f32x4*)(out + off + bj * HALF + n * 16) = o; q += dot4(o); }
                q += __shfl_xor(q, 16); q += __shfl_xor(q, 32);
                if (fq == 0) RPART[row * 16 + u.pn * 4 + wc] = q; }
    }
};
}
#define GAS __attribute__((address_space(1)))
#define LAS __attribute__((address_space(3)))
typedef unsigned v4u __attribute__((ext_vector_type(4)));
typedef GAS unsigned gu32;
typedef GAS unsigned long long gu64;
#define RLX_AGENT __ATOMIC_RELAXED, __HIP_MEMORY_SCOPE_AGENT
#define LDS_WAIT() asm volatile("s_waitcnt lgkmcnt(0)" ::: "memory")
#define VM_WAIT() asm volatile("s_waitcnt vmcnt(0)" ::: "memory")
__device__ __forceinline__ unsigned long long rt() { return __builtin_amdgcn_s_memrealtime(); }
__device__ __forceinline__ unsigned pk2(float lo, float hi) { return f2bf(lo) | (f2bf(hi) << 16); }
#define XB_TMO      128
#define XB_XCNT(j)  (256  + 64 * (j))
#define XB_XSUB(j)  (1280 + 64 * (j))
#define XB_XGEN(j)  (2304 + 64 * (j))
#define XB_TOP      3328
#define XB_TOPGEN   3392
#define XCD_BAR_WORDS 3456
#define XB_SPIN_CAP (1u << 22)

__device__ __forceinline__ unsigned xb_ld(unsigned* p)              { return __hip_atomic_load(p, __ATOMIC_RELAXED, __HIP_MEMORY_SCOPE_AGENT); }
__device__ __forceinline__ unsigned xb_add(unsigned* p, unsigned v) { return __hip_atomic_fetch_add(p, v, __ATOMIC_RELAXED, __HIP_MEMORY_SCOPE_AGENT); }
__device__ __forceinline__ unsigned xb_xcc_id() { return (unsigned)__builtin_amdgcn_s_getreg((3 << 11) | 20) & 0xFu; }
#define XB_SPIN(cond, bar) do { unsigned _sp = 0; while (cond) { __builtin_amdgcn_s_sleep(1); \
    if ((++_sp & 255u) == 0u) { if (xb_ld(&(bar)[XB_TMO])) break; if (_sp > XB_SPIN_CAP) { atomicAdd(&(bar)[XB_TMO], 1u); break; } } } } while (0)

struct XcdBarrier {
    unsigned* bar; unsigned x;
    volatile LAS unsigned* st;
};

__device__ __forceinline__ XcdBarrier xcd_barrier_post(unsigned* bar, volatile LAS unsigned* st) {
    XcdBarrier b; b.bar = bar; b.x = xb_xcc_id(); b.st = st;
    if (threadIdx.x == 0) (void)xb_add(&bar[XB_XCNT(b.x)], 1u);
    return b;
}
__device__ __forceinline__ void xcd_barrier_complete(unsigned* bar, unsigned x, unsigned& nloc, unsigned& nx) {
    const unsigned G = gridDim.x * gridDim.y * gridDim.z;
    unsigned sum, cnt, mine, sp = 0u;
    for (;;) {
        sum = 0u; cnt = 0u; mine = 0u;
#pragma unroll
        for (unsigned j = 0; j < 16; ++j) { const unsigned c = xb_ld(&bar[XB_XCNT(j)]); sum += c; cnt += (c > 0u) ? 1u : 0u; mine = (j == x) ? c : mine; }
        if (sum == G) break;
        __builtin_amdgcn_s_sleep(1);
        if ((++sp & 255u) == 0u) { if (xb_ld(&bar[XB_TMO])) break; if (sp > XB_SPIN_CAP) { atomicAdd(&bar[XB_TMO], 1u); break; } }
    }
    nloc = mine > 0u ? mine : 1u; nx = cnt > 0u ? cnt : 1u;
}

__device__ __forceinline__ void xcd_barrier(const XcdBarrier& b) {
    asm volatile("s_waitcnt vmcnt(0)" ::: "memory");
    __syncthreads();
    if (threadIdx.x == 0) {
        unsigned* bar = b.bar;
        __builtin_amdgcn_s_waitcnt(0);
        unsigned nloc = b.st[0], nx = b.st[1];
        if (nloc == 0u) { xcd_barrier_complete(bar, b.x, nloc, nx); b.st[0] = nloc; b.st[1] = nx; }
        const unsigned old = xb_add(&bar[XB_XSUB(b.x)], 1u);
        const unsigned gen = old / nloc;
        if (old + 1u == (gen + 1u) * nloc) {
            __builtin_amdgcn_fence(__ATOMIC_RELEASE, "agent");
            asm volatile("s_waitcnt vmcnt(0)" ::: "memory");
            const unsigned og = xb_add(&bar[XB_TOP], 1u);
            const unsigned tg = og / nx;
            if (og + 1u == (tg + 1u) * nx) xb_add(&bar[XB_TOPGEN], 1u);
            else XB_SPIN(xb_ld(&bar[XB_TOPGEN]) == tg, bar);
            __builtin_amdgcn_fence(__ATOMIC_ACQUIRE, "agent");
            xb_add(&bar[XB_XGEN(b.x)], 1u);
            asm volatile("s_waitcnt vmcnt(0)" ::: "memory");
        } else {
            XB_SPIN(xb_ld(&bar[XB_XGEN(b.x)]) == gen, bar);
            __builtin_amdgcn_fence(__ATOMIC_ACQUIRE, "agent");
            asm volatile("s_waitcnt vmcnt(0)" ::: "memory");
        }
    }
    __syncthreads();
}

typedef float f32x4 __attribute__((ext_vector_type(4)));
constexpr int NWAVES = 8;
__device__ __forceinline__ float wave_sum(float v) {
#pragma unroll
    for (int o = 1; o < 64; o <<= 1) v += __shfl_xor(v, o);
    return v;
}
__device__ __forceinline__ float dot4g(const f32x4 a) { return (a[0] * a[0] + a[1] * a[1]) + (a[2] * a[2] + a[3] * a[3]); }
__device__ __forceinline__ void p0_bt1_item(const float* W, bf16* WT, LAS float* scr, int item, int lane) {
    const int kb = item / 168, vb = item % 168, k0 = 64 * kb, v0 = 32 * vb;
    const int a = vcol_actual(v0 + (lane & 31));
#pragma unroll 8
    for (int i = 0; i < 32; ++i) { const int kk = 2 * i + (lane >> 5); scr[kk * 33 + (lane & 31)] = a >= 0 ? W[(size_t)(k0 + kk) * PROJ + a] : 0.f; }
    LDS_WAIT(); asm volatile("" ::: "memory");
    const int c = lane & 7;
#pragma unroll
    for (int j = 0; j < 4; ++j) { const int n = (lane >> 3) + 8 * j; const LAS float* s = scr + (8 * c) * 33 + n;
        v4u o; o.x = pk2(s[0 * 33], s[1 * 33]); o.y = pk2(s[2 * 33], s[3 * 33]); o.z = pk2(s[4 * 33], s[5 * 33]); o.w = pk2(s[6 * 33], s[7 * 33]);
        *(GAS v4u*)(WT + (size_t)(v0 + n) * 1024 + k0 + 8 * c) = o; }
    LDS_WAIT(); asm volatile("" ::: "memory");
}
__device__ __forceinline__ void p0_bt2_item(const float* W, const float* sg, bf16* WT, LAS float* scr, int item, int lane) {
    const int kb = item >> 5, nb = item & 31, kk0 = 64 * kb, n0 = 32 * nb;
#pragma unroll 8
    for (int i = 0; i < 32; ++i) { const int kk = 2 * i + (lane >> 5), kq = kk0 + kk; const int ks = kq < 1024 ? 1024 + kq : kq - 1024;
        float v = W[(size_t)ks * 1024 + n0 + (lane & 31)]; if (kq < 1024) v *= sg[kq]; scr[kk * 33 + (lane & 31)] = v; }
    LDS_WAIT(); asm volatile("" ::: "memory");
    const int c = lane & 7;
#pragma unroll
    for (int j = 0; j < 4; ++j) { const int n = (lane >> 3) + 8 * j; const LAS float* s = scr + (8 * c) * 33 + n;
        v4u o; o.x = pk2(s[0 * 33], s[1 * 33]); o.y = pk2(s[2 * 33], s[3 * 33]); o.z = pk2(s[4 * 33], s[5 * 33]); o.w = pk2(s[6 * 33], s[7 * 33]);
        *(GAS v4u*)(WT + (size_t)(n0 + n) * 2048 + kk0 + 8 * c) = o; }
    LDS_WAIT(); asm volatile("" ::: "memory");
}
__device__ __forceinline__ void p0_mod_block(const float* c, const float* c_ctx, const float* ada_w, const float* ada_b, float* mod, LAS float* ldsf, int cb, int tid, int lane, int wave) {
    LAS float* sil = ldsf; LAS float* red = ldsf + 33 * 256;
    float acc[33];
#pragma unroll
    for (int b = 0; b < 33; ++b) acc[b] = 0.f;
    for (int q = 0; q < 4; ++q) {
        __syncthreads();
        for (int e = tid; e < 33 * 256; e += NWAVES * 64) { const int b = e >> 8, k = e & 255; const float v = b < 32 ? c[b * 1024 + q * 256 + k] : c_ctx[q * 256 + k]; sil[e] = siluf(v); }
        __syncthreads();
        for (int kk = 0; kk < 32; ++kk) { const int kl = wave * 32 + kk; const float w = ada_w[(size_t)(q * 256 + kl) * 3072 + cb * 64 + lane];
#pragma unroll
            for (int b = 0; b < 33; ++b) acc[b] += sil[b * 256 + kl] * w; }
    }
#pragma unroll
    for (int b = 0; b < 33; ++b) red[(wave * 33 + b) * 64 + lane] = acc[b];
    __syncthreads();
    for (int e = tid; e < 33 * 64; e += NWAVES * 64) { const int b = e >> 6, col = e & 63; float s = 0.f;
#pragma unroll
        for (int w = 0; w < 8; ++w) s += red[(w * 33 + b) * 64 + col];
        mod[b * 3072 + cb * 64 + col] = s + ada_b[cb * 64 + col]; }
    __syncthreads();
}
__device__ __forceinline__ void p1_norm_row(const float* xrow, const float* md, const float* ng, bf16* orow, int lane) {
    const GAS f32x4* xr = (const GAS f32x4*)xrow + lane;
    f32x4 v[4]; float s = 0.f;
#pragma unroll
    for (int j = 0; j < 4; ++j) { v[j] = xr[64 * j]; s += dot4g(v[j]); }
    const float rstd = rsqrtf(wave_sum(s) * (1.f / DM) + EPS);
    GAS unsigned long long* o8 = (GAS unsigned long long*)orow + lane;
#pragma unroll
    for (int j = 0; j < 4; ++j) { const int k = 4 * lane + 256 * j;
        const f32x4 g = *(const f32x4*)(ng + k), sc = *(const f32x4*)(md + 1024 + k), sh = *(const f32x4*)(md + k);
        const f32x4 h = v[j] * rstd * g * (sc + 1.f) + sh;
        o8[64 * j] = (unsigned long long)pk2(h[0], h[1]) | ((unsigned long long)pk2(h[2], h[3]) << 32); }
}
__device__ __forceinline__ void conv_phase(const bf16* XBC, const float* cw, const float* cb, bf16* XC, int bx, int G, int tid) {
    if (tid < 384) {
        const int cg = tid % 192, sub = tid / 192;
        f32x4 w[5][2], bias[2];
#pragma unroll
        for (int j = 0; j < 5; ++j) { w[j][0] = *(const f32x4*)(cw + j * CONVC + cg * 8); w[j][1] = *(const f32x4*)(cw + j * CONVC + cg * 8 + 4); }
        bias[0] = *(const f32x4*)(cb + cg * 8); bias[1] = *(const f32x4*)(cb + cg * 8 + 4);
        for (int seg = bx; seg < MT / 32; seg += G) {
            const int row0 = seg * 32 + sub * 16; int t0, len;
            if (row0 < ML) { t0 = row0 % SEQ; len = SEQ; } else { t0 = (row0 - ML) % CTXL; len = CTXL; }
            const bf16* src = XBC + (size_t)row0 * CONVC + cg * 8; bf16* dst = XC + (size_t)row0 * CONVC + cg * 8;
            f32x4 r[5][2];
#pragma unroll
            for (int j = 0; j < 5; ++j) { const int tt = t0 + j - 2; v4u u = (v4u){0u, 0u, 0u, 0u};
                if (tt >= 0 && tt < len) u = *(const v4u*)(src + (ptrdiff_t)(j - 2) * CONVC);
                r[j][0] = (f32x4){__uint_as_float(u.x << 16), __uint_as_float(u.x & 0xffff0000u), __uint_as_float(u.y << 16), __uint_as_float(u.y & 0xffff0000u)};
                r[j][1] = (f32x4){__uint_as_float(u.z << 16), __uint_as_float(u.z & 0xffff0000u), __uint_as_float(u.w << 16), __uint_as_float(u.w & 0xffff0000u)}; }
#pragma unroll
            for (int i = 0; i < 16; ++i) {
                f32x4 a0 = bias[0], a1 = bias[1];
#pragma unroll
                for (int j = 0; j < 5; ++j) { a0 += w[j][0] * r[j][0]; a1 += w[j][1] * r[j][1]; }
#pragma unroll
                for (int e = 0; e < 4; ++e) { a0[e] = siluf(a0[e]); a1[e] = siluf(a1[e]); }
                v4u o; o.x = pk2(a0[0], a0[1]); o.y = pk2(a0[2], a0[3]); o.z = pk2(a1[0], a1[1]); o.w = pk2(a1[2], a1[3]);
                *(v4u*)(dst + (size_t)i * CONVC) = o;
#pragma unroll
                for (int j = 0; j < 4; ++j) { r[j][0] = r[j + 1][0]; r[j][1] = r[j + 1][1]; }
                const int tt = t0 + i + 3; v4u u = (v4u){0u, 0u, 0u, 0u};
                if (i < 15 && tt < len) u = *(const v4u*)(src + (size_t)(i + 3) * CONVC);
                r[4][0] = (f32x4){__uint_as_float(u.x << 16), __uint_as_float(u.x & 0xffff0000u), __uint_as_float(u.y << 16), __uint_as_float(u.y & 0xffff0000u)};
                r[4][1] = (f32x4){__uint_as_float(u.z << 16), __uint_as_float(u.z & 0xffff0000u), __uint_as_float(u.w << 16), __uint_as_float(u.w & 0xffff0000u)};
            }
        }
    }
}
__device__ __forceinline__ void ssd_item_naive(int b, int h, const bf16* XC, const float* DT, const bf16* Z, const float* a_log, const float* d_skip, bf16* YQ, float* SSQ, LAS float* ysq, int tid) {
    const int p = tid >> 3, nc = tid & 7, g = h >> 3;
    for (int dd = 0; dd < 2; ++dd) { const int d = 1 - dd;
        const float a_neg = -expf(a_log[d * 16 + h]);
        float S[16];
#pragma unroll
        for (int j = 0; j < 16; ++j) S[j] = 0.f;
        for (int seq = 0; seq < 2; ++seq) { const int len = seq == 0 ? CTXL : SEQ; const size_t rbase = seq == 0 ? (size_t)ML + (size_t)b * CTXL : (size_t)b * SEQ;
            for (int st = 0; st < len; ++st) { const int t = d ? len - 1 - st : st; const size_t row = rbase + t;
                const float dt = DT[row * 32 + d * 16 + h]; const float dec = expf(dt * a_neg);
                const float xs = bf2f(XC[row * CONVC + h * 64 + p]); const float X = xs * dt;
                const v4u b0 = *(const v4u*)(XC + row * CONVC + 1024 + g * 128 + nc * 16), b1 = *(const v4u*)(XC + row * CONVC + 1024 + g * 128 + nc * 16 + 8);
                const v4u c0 = *(const v4u*)(XC + row * CONVC + 1280 + g * 128 + nc * 16), c1 = *(const v4u*)(XC + row * CONVC + 1280 + g * 128 + nc * 16 + 8);
                const unsigned bw[8] = {b0.x, b0.y, b0.z, b0.w, b1.x, b1.y, b1.z, b1.w}, cw8[8] = {c0.x, c0.y, c0.z, c0.w, c1.x, c1.y, c1.z, c1.w};
                float y = 0.f;
#pragma unroll
                for (int j = 0; j < 8; ++j) { S[2 * j] = S[2 * j] * dec + X * __uint_as_float(bw[j] << 16); y += __uint_as_float(cw8[j] << 16) * S[2 * j];
                    S[2 * j + 1] = S[2 * j + 1] * dec + X * __uint_as_float(bw[j] & 0xffff0000u); y += __uint_as_float(cw8[j] & 0xffff0000u) * S[2 * j + 1]; }
                y += __shfl_xor(y, 1); y += __shfl_xor(y, 2); y += __shfl_xor(y, 4);
                if (seq == 1) {
                    bf16* yp = YQ + row * 2048 + h * 64 + p;
                    if (d == 1) { if (nc == 0) *yp = (bf16)f2bf(y); }
                    else {
                        if (nc == 0) { const float yt = y + bf2f(*yp) + d_skip[h] * xs; const float yg = yt * bf2f(Z[row * 1024 + h * 64 + p]); *yp = (bf16)f2bf(yg); ysq[p] = yg * yg; }
                        __syncthreads();
                        if (tid < 64) { float q = ysq[tid]; q = wave_sum(q); if (tid == 0) SSQ[row * 16 + h] = q; }
                        __syncthreads();
                    }
                }
            }
        }
        VM_WAIT(); __syncthreads();
    }
}

namespace attn_body {
using bf16=__hip_bfloat16;
using bf16x8=__attribute__((ext_vector_type(8)))short;
using s16x4=__attribute__((ext_vector_type(4)))short;
using f32x16=__attribute__((ext_vector_type(16)))float;
using u32x4=__attribute__((ext_vector_type(4)))unsigned;
constexpr int D=64,QP=2048,KP=256;
constexpr int NW=8,QBLK=32,QB=QBLK*NW,KVBLK=64,NQB=SEQ/QB;
constexpr int ATTN_UNIT_ROWS=QB;
__device__ __forceinline__ int crow(int r,int hi){return (r&3)+8*(r>>2)+4*hi;}
#define SBAR() __builtin_amdgcn_sched_barrier(0)
__device__ __forceinline__ void cmask(f32x16&p0,f32x16&p1,int jb,int qrel,int hi){
  const float NEG=-INFINITY; int kb=64*jb+4*hi;
  #pragma unroll
  for(int r=0;r<16;++r){int kv=kb+(r&3)+8*(r>>2); if(kv>qrel)p0[r]=NEG; if(kv+32>qrel)p1[r]=NEG;}
}

constexpr int NSLOT=3, SLOTB=8192;
constexpr int LDS_K=0, LDS_V=NSLOT*SLOTB, LDS_WS=2*NSLOT*SLOTB, LDS_OST=LDS_WS+NW*64*4, LDS_BYTES=LDS_OST+NW*8192;
constexpr float C2=0.125f*1.4426950408889634f;
__device__ __forceinline__ void glds16(const void*gsrc,unsigned lds_dst){unsigned keep;
  asm volatile("s_mov_b32 %0, m0\n\ts_mov_b32 m0, %2\n\ts_nop 0\n\tglobal_load_lds_dwordx4 %1, off\n\ts_mov_b32 m0, %0":"=&s"(keep):"v"(gsrc),"s"(lds_dst):"memory");}
__device__ __forceinline__ float max3f(float a,float b,float c){float r;asm("v_max3_f32 %0, %1, %2, %3":"=v"(r):"v"(a),"v"(b),"v"(c));return r;}
__device__ __forceinline__ float max2f(float a,float b){float r;asm("v_max_f32_e32 %0, %1, %2":"=v"(r):"v"(a),"v"(b));return r;}
__device__ __forceinline__ float fadd_s(float a,float b){float r;asm("v_add_f32_e32 %0, %1, %2":"=v"(r):"v"(a),"v"(b));return r;}
__device__ __forceinline__ float fsub_s(float a,float b){float r;asm("v_sub_f32_e32 %0, %1, %2":"=v"(r):"v"(a),"v"(b));return r;}
typedef float f32x2_t __attribute__((ext_vector_type(2))); typedef float f32x4_t __attribute__((ext_vector_type(4))); typedef __bf16 bf16x2_t __attribute__((ext_vector_type(2)));
__device__ __forceinline__ unsigned cvtpk_s(float lo,float hi){f32x2_t v={lo,hi};bf16x2_t b=__builtin_convertvector(v,bf16x2_t);return __builtin_bit_cast(unsigned,b);}
#define WAIT_BAR(N) asm volatile("s_waitcnt vmcnt(" #N ") lgkmcnt(0)\n\ts_barrier":::"memory")

__device__ __forceinline__ void qkt(f32x16&p0,f32x16&p1,const char*Kslot,const bf16x8*qr,const f32x16&negm,int r32,int hi){
  const char*kb=Kslot+hi*1024+r32*16;
  #pragma unroll
  for(int d0=0;d0<4;++d0){
    const bf16x8 b0=*reinterpret_cast<const bf16x8*>(kb+d0*2048);
    const bf16x8 b1=*reinterpret_cast<const bf16x8*>(kb+d0*2048+512);
    if(d0==0){p0=__builtin_amdgcn_mfma_f32_32x32x16_bf16(b0,qr[0],negm,0,0,0);p1=__builtin_amdgcn_mfma_f32_32x32x16_bf16(b1,qr[0],negm,0,0,0);}
    else{p0=__builtin_amdgcn_mfma_f32_32x32x16_bf16(b0,qr[d0],p0,0,0,0);p1=__builtin_amdgcn_mfma_f32_32x32x16_bf16(b1,qr[d0],p1,0,0,0);}}
}
typedef __attribute__((address_space(3))) const char* lds_cptr;
typedef short v4i16_t __attribute__((ext_vector_type(4)));
__device__ __forceinline__ void kload8(bf16x8*kf,lds_cptr kp){
  kf[0]=*(const __attribute__((address_space(3))) bf16x8*)(kp);      kf[1]=*(const __attribute__((address_space(3))) bf16x8*)(kp+512);
  kf[2]=*(const __attribute__((address_space(3))) bf16x8*)(kp+2048); kf[3]=*(const __attribute__((address_space(3))) bf16x8*)(kp+2560);
  kf[4]=*(const __attribute__((address_space(3))) bf16x8*)(kp+4096); kf[5]=*(const __attribute__((address_space(3))) bf16x8*)(kp+4608);
  kf[6]=*(const __attribute__((address_space(3))) bf16x8*)(kp+6144); kf[7]=*(const __attribute__((address_space(3))) bf16x8*)(kp+6656);
}
__device__ __forceinline__ void kload2(bf16x8*kf,lds_cptr kp,int j){ kf[2*j]=*(const __attribute__((address_space(3))) bf16x8*)(kp+j*2048); kf[2*j+1]=*(const __attribute__((address_space(3))) bf16x8*)(kp+j*2048+512); }
__device__ __forceinline__ s16x4 vtr(lds_cptr p){ return __builtin_bit_cast(s16x4,__builtin_amdgcn_ds_read_tr16_b64_v4i16((__attribute__((address_space(3))) v4i16_t*)p)); }
__device__ __forceinline__ float rowmax(const f32x16&p0,const f32x16&p1){
  float a=max3f(p0[0],p0[1],p1[0]),b=max3f(p0[2],p0[3],p1[1]);a=max3f(a,p1[2],p1[3]);
  #pragma unroll
  for(int r=4;r<16;r+=4){a=max3f(a,p0[r],p0[r+1]);b=max3f(b,p0[r+2],p0[r+3]);a=max3f(a,p1[r],p1[r+1]);b=max3f(b,p1[r+2],p1[r+3]);}
  const float m=max2f(a,b);
  auto rr=__builtin_amdgcn_permlane32_swap(__float_as_uint(m),__float_as_uint(m),false,false);
  return max2f(__uint_as_float(rr[0]),__uint_as_float(rr[1]));
}
__device__ __forceinline__ void pv(f32x16*o,int vb,bf16x8 pa0,bf16x8 pa1,bf16x8 pa2,bf16x8 pa3){
  #pragma unroll
  for(int d0=0;d0<2;++d0){s16x4 lo[4],hi[4];
    #pragma unroll
    for(int ks=0;ks<4;++ks){
      asm volatile("ds_read_b64_tr_b16 %0,%1 offset:%c2":"=&v"(lo[ks]):"v"(vb),"i"(d0*4096+ks*1024):"memory");
      asm volatile("ds_read_b64_tr_b16 %0,%1 offset:%c2":"=&v"(hi[ks]):"v"(vb),"i"(d0*4096+ks*1024+512):"memory");}
    asm volatile("s_waitcnt lgkmcnt(0)":::"memory");SBAR();
    #define PK(k) (bf16x8){lo[k][0],lo[k][1],lo[k][2],lo[k][3],hi[k][0],hi[k][1],hi[k][2],hi[k][3]}
    o[d0]=__builtin_amdgcn_mfma_f32_32x32x16_bf16(pa0,PK(0),o[d0],0,0,0);
    o[d0]=__builtin_amdgcn_mfma_f32_32x32x16_bf16(pa1,PK(1),o[d0],0,0,0);
    o[d0]=__builtin_amdgcn_mfma_f32_32x32x16_bf16(pa2,PK(2),o[d0],0,0,0);
    o[d0]=__builtin_amdgcn_mfma_f32_32x32x16_bf16(pa3,PK(3),o[d0],0,0,0);
    #undef PK
  }
}

#ifndef ATTN_STORE16
#define ATTN_STORE16(p,v) (*(u32x4*)(p)=(v))
#endif
template<int THRL> __device__ __forceinline__ void attn_unit(int b,int h,int qb,bf16*YQb,const bf16*__restrict__ K,const bf16*__restrict__ V,char*shm){
  const int tid=threadIdx.x,lane=tid&63,r32=lane&31,hi=lane>>5; const int wid=__builtin_amdgcn_readfirstlane(tid>>6);
  const long rowbase=(long)b*SEQ; const int q0=qb*QB;
  const bf16*Qw=YQb+(rowbase+q0+wid*QBLK)*QP+1024+h*D;
  const bf16*Kh=K+(long)b*KVL*KP+(h>>2)*D,*Vh=V+(long)b*KVL*KP+(h>>2)*D;
  const unsigned lds0=(unsigned)(uintptr_t)shm;
  float*wsf=(float*)(shm+LDS_WS)+wid*64;
  const bf16*ksrc=Kh+(long)lane*KP+wid*8;
  const bf16*vsrc=Vh+(long)(16*(wid&3)+(lane>>2))*KP+(wid>>2)*32+(lane&3)*8;
  const unsigned kdst=lds0+LDS_K+wid*1024, vdst=lds0+LDS_V+wid*1024;
  #define DMA_K(t,slot) glds16(ksrc+(long)(t)*KVBLK*KP,(unsigned)__builtin_amdgcn_readfirstlane(kdst+(slot)))
  #define DMA_V(t,slot) glds16(vsrc+(long)(t)*KVBLK*KP,(unsigned)__builtin_amdgcn_readfirstlane(vdst+(slot)))
  const int vb0=(int)(lds0+LDS_V)+((lane>>4)&1)*32+(lane&3)*8+(4*hi+((lane&15)>>2))*64;
  const char*Kbase=shm+LDS_K; bf16x8 kf[8];
  const lds_cptr shm3=(lds_cptr)shm; const lds_cptr kp0=shm3+LDS_K+hi*1024+r32*16; const lds_cptr vp0=shm3+LDS_V+((lane>>4)&1)*32+(lane&3)*8+(4*hi+((lane&15)>>2))*64;
  constexpr int NT=KVL/KVBLK;
  DMA_K(0,0);DMA_V(0,0);DMA_K(1,SLOTB);
  bf16x8 qr[4];
  #pragma unroll
  for(int d0=0;d0<4;++d0)qr[d0]=*reinterpret_cast<const bf16x8*>(&Qw[(long)r32*QP+d0*16+hi*8]);
  float mhat=0.f,l_reg=0.f;f32x16 o[2];o[0]=f32x16{};o[1]=f32x16{};f32x16 negm=f32x16{};asm volatile("":"+v"(negm));
  #define CMASK(P0,P1,t) do{}while(0)
  bool resc=false;
  #define START(P0,P1) do{ const float rm=rowmax(P0,P1); resc=false; \
    { const float dl=rm; mhat=fadd_s(mhat,dl); \
      _Pragma("unroll") for(int r=0;r<16;++r){P0[r]=fsub_s(P0[r],dl);P1[r]=fsub_s(P1[r],dl);} \
      _Pragma("unroll") for(int r=0;r<16;++r)negm[r]=-mhat; asm volatile("":"+v"(negm)); } \
    _Pragma("unroll") for(int r=0;r<16;++r)P0[r]=__builtin_amdgcn_exp2f(P0[r]); }while(0)
  #define RESC() do{ if(resc){ asm volatile("s_waitcnt lgkmcnt(0)":::"memory"); \
      _Pragma("unroll") for(int d_=0;d_<2;++d_) _Pragma("unroll") for(int r=0;r<16;++r)o[d_][r]*=wsf[crow(r,hi)]; } }while(0)
  f32x16 pA0,pA1,pB0,pB1;
  int sl_prev=0,sl_cur=0,sl_next=SLOTB;
  #define ROT() do{sl_prev=sl_cur;sl_cur=sl_next;sl_next=(sl_next==(NSLOT-1)*SLOTB)?0:sl_next+SLOTB;}while(0)
  DMA_K(2,2*SLOTB);
  WAIT_BAR(3);
  qkt(pA0,pA1,Kbase,qr,negm,r32,hi);asm volatile("s_nop 15\n\ts_nop 7":"+v"(pA0),"+v"(pA1));CMASK(pA0,pA1,0);
  START(pA0,pA1);
  _Pragma("unroll") for(int r=0;r<16;++r)pA1[r]=__builtin_amdgcn_exp2f(pA1[r]);
  WAIT_BAR(0);
  DMA_K(3,0);DMA_V(1,SLOTB);
  ROT();
  kload8(kf,kp0+sl_cur);
  WAIT_BAR(2);
  s16x4 vlo[8],vhi[8]; u32x4 pw0,pw1,pw2,pw3;
  #define PKW(P,B) cvtpk_s(P[B],P[B+1])
  #define PAF(k) __builtin_bit_cast(bf16x8,pw##k)
  #define VFR(i) (bf16x8){vlo[i][0],vlo[i][1],vlo[i][2],vlo[i][3],vhi[i][0],vhi[i][1],vhi[i][2],vhi[i][3]}
  #define PIN(x) asm volatile("":"+v"(x))
  #define MX3(a,b,c) __builtin_fmaxf(__builtin_fmaxf((a),(b)),(c))
  #define GAPA(MF,A0,A1,A2,A3,W0,W1,PW) do{ MF; sacc+=A0; sacc+=A1; sacc+=A2; sacc+=A3; PIN(sacc); W0; W1; PIN(PW); SBAR(); }while(0)
  #define EX(v) __builtin_amdgcn_exp2f(v)
  #define GAPB(MF,X,B) do{ MF; X[B]=EX(X[B]); X[B+1]=EX(X[B+1]); X[B+2]=EX(X[B+2]); X[B+3]=EX(X[B+3]); PIN(X); SBAR(); }while(0)
  #define VRD(i) do{ vlo[i]=vtr(vp_+(((i)>>2)*4096+((i)&3)*1024)); vhi[i]=vtr(vp_+(((i)>>2)*4096+((i)&3)*1024+512)); }while(0)
  #define KRD(G,j) do{ if(G){ kload2(kf,kp0+sl_next,j); SBAR(); } }while(0)
  #define STEP(C0,C1,P0,P1,t,GK,GV,GL) do{ SBAR(); \
    const lds_cptr vp_=vp0+sl_prev; \
    VRD(0); SBAR(); float sacc=(P0[0]+P0[1]); \
    GAPA(C0=__builtin_amdgcn_mfma_f32_32x32x16_bf16(kf[0],qr[0],negm,0,0,0), P0[2],P0[3],P0[4],P0[5],     pw0[0]=PKW(P0,0), pw0[1]=PKW(P0,2), pw0); \
    VRD(4); SBAR(); GAPA(C1=__builtin_amdgcn_mfma_f32_32x32x16_bf16(kf[1],qr[0],negm,0,0,0), P0[6],P0[7],P0[8],P0[9],     pw0[2]=PKW(P0,4), pw0[3]=PKW(P0,6), pw0); \
    VRD(1); SBAR(); GAPA(C0=__builtin_amdgcn_mfma_f32_32x32x16_bf16(kf[2],qr[1],C0,0,0,0),   P0[10],P0[11],P0[12],P0[13], pw1[0]=PKW(P0,8), pw1[1]=PKW(P0,10), pw1); \
    VRD(5); SBAR(); GAPA(C1=__builtin_amdgcn_mfma_f32_32x32x16_bf16(kf[3],qr[1],C1,0,0,0),   P0[14],P0[15],P1[0],P1[1],   pw1[2]=PKW(P0,12),pw1[3]=PKW(P0,14), pw1); \
    VRD(2); SBAR(); GAPA(C0=__builtin_amdgcn_mfma_f32_32x32x16_bf16(kf[4],qr[2],C0,0,0,0),   P1[2],P1[3],P1[4],P1[5],     pw2[0]=PKW(P1,0), pw2[1]=PKW(P1,2), pw2); \
    VRD(6); SBAR(); GAPA(C1=__builtin_amdgcn_mfma_f32_32x32x16_bf16(kf[5],qr[2],C1,0,0,0),   P1[6],P1[7],P1[8],P1[9],     pw2[2]=PKW(P1,4), pw2[3]=PKW(P1,6), pw2); \
    VRD(3); SBAR(); GAPA(C0=__builtin_amdgcn_mfma_f32_32x32x16_bf16(kf[6],qr[3],C0,0,0,0),   P1[10],P1[11],P1[12],P1[13], pw3[0]=PKW(P1,8), pw3[1]=PKW(P1,10), pw3); \
    VRD(7); SBAR(); GAPA(C1=__builtin_amdgcn_mfma_f32_32x32x16_bf16(kf[7],qr[3],C1,0,0,0),   P1[14],P1[15],0.f,0.f,       pw3[2]=PKW(P1,12),pw3[3]=PKW(P1,14), pw3); \
    l_reg+=sacc; \
    if(GK){DMA_K((t)+3,sl_cur);} if(GV){DMA_V((t)+1,sl_next);} \
    CMASK(C0,C1,t); \
    { float a=MX3(C0[0],C0[1],C1[0]),b=MX3(C0[2],C0[3],C1[1]); a=MX3(a,C1[2],C1[3]); \
      _Pragma("unroll") for(int r=4;r<16;r+=4){a=MX3(a,C0[r],C0[r+1]);b=MX3(b,C0[r+2],C0[r+3]);a=MX3(a,C1[r],C1[r+1]);b=MX3(b,C1[r+2],C1[r+3]);} \
      float rm=__builtin_fmaxf(a,b); { auto rr=__builtin_amdgcn_permlane32_swap(__float_as_uint(rm),__float_as_uint(rm),false,false); rm=__builtin_fmaxf(__uint_as_float(rr[0]),__uint_as_float(rr[1])); } \
      resc=false; \
      if(__builtin_expect(__any(rm>(float)THRL),0)){ const float dl=__builtin_fmaxf(rm,0.f); mhat+=dl; \
        _Pragma("unroll") for(int r=0;r<16;++r){C0[r]-=dl;C1[r]-=dl;} \
        _Pragma("unroll") for(int r=0;r<16;++r)negm[r]=-mhat; asm volatile("":"+v"(negm)); \
        const float f=__builtin_amdgcn_exp2f(-dl); l_reg*=f; if(hi==0)wsf[r32]=f; resc=true; } } \
    SBAR(); \
    GAPB(o[0]=__builtin_amdgcn_mfma_f32_32x32x16_bf16(PAF(0),VFR(0),o[0],0,0,0), C0,0); \
    GAPB(o[1]=__builtin_amdgcn_mfma_f32_32x32x16_bf16(PAF(0),VFR(4),o[1],0,0,0), C0,4); \
    KRD(GL,0); GAPB(o[0]=__builtin_amdgcn_mfma_f32_32x32x16_bf16(PAF(1),VFR(1),o[0],0,0,0), C0,8); \
    KRD(GL,1); GAPB(o[1]=__builtin_amdgcn_mfma_f32_32x32x16_bf16(PAF(1),VFR(5),o[1],0,0,0), C0,12); \
    KRD(GL,2); GAPB(o[0]=__builtin_amdgcn_mfma_f32_32x32x16_bf16(PAF(2),VFR(2),o[0],0,0,0), C1,0); \
    KRD(GL,3); GAPB(o[1]=__builtin_amdgcn_mfma_f32_32x32x16_bf16(PAF(2),VFR(6),o[1],0,0,0), C1,4); \
    GAPB(o[0]=__builtin_amdgcn_mfma_f32_32x32x16_bf16(PAF(3),VFR(3),o[0],0,0,0), C1,8); \
    GAPB(o[1]=__builtin_amdgcn_mfma_f32_32x32x16_bf16(PAF(3),VFR(7),o[1],0,0,0), C1,12); \
    }while(0)
  int t=1;
  #undef CMASK
  #define CMASK(P0,P1,t) do{}while(0)
  for(;t+5<NT;t+=2){
    STEP(pB0,pB1,pA0,pA1,t,true,true,true);     WAIT_BAR(2); RESC(); ROT();
    STEP(pA0,pA1,pB0,pB1,t+1,true,true,true);   WAIT_BAR(2); RESC(); ROT();
  }
  #undef CMASK
  #define CMASK(P0,P1,t) do{}while(0)
  #define ENDW(tt) do{ if((tt)+3<NT){WAIT_BAR(2);} else if((tt)+2<NT){WAIT_BAR(1);} else {WAIT_BAR(0);} }while(0)
  for(;t+1<NT;t+=2){
    STEP(pB0,pB1,pA0,pA1,t,(t+3<NT),(t+1<NT),(t+1<NT));       ENDW(t);   RESC(); ROT();
    STEP(pA0,pA1,pB0,pB1,t+1,(t+4<NT),(t+2<NT),(t+2<NT));     ENDW(t+1); RESC(); ROT();
  }
  STEP(pB0,pB1,pA0,pA1,NT-1,false,false,false); RESC();
  { float sacc=pB0[0]+pB0[1]; _Pragma("unroll") for(int r=2;r<16;++r)sacc+=pB0[r]; _Pragma("unroll") for(int r=0;r<16;++r)sacc+=pB1[r]; l_reg+=sacc;
    pw0=(u32x4){PKW(pB0,0),PKW(pB0,2),PKW(pB0,4),PKW(pB0,6)};pw1=(u32x4){PKW(pB0,8),PKW(pB0,10),PKW(pB0,12),PKW(pB0,14)};pw2=(u32x4){PKW(pB1,0),PKW(pB1,2),PKW(pB1,4),PKW(pB1,6)};pw3=(u32x4){PKW(pB1,8),PKW(pB1,10),PKW(pB1,12),PKW(pB1,14)};
    SBAR(); pv(o,vb0+sl_cur,PAF(0),PAF(1),PAF(2),PAF(3)); }
  #undef PKW
  #undef PAF
  #undef VFR
  #undef PIN
  #undef MX3
  #undef GAPA
  #undef GAPB
  #undef EX
  #undef VRD
  #undef KRD
  #undef STEP
  #undef ENDW
  {auto rr=__builtin_amdgcn_permlane32_swap(__float_as_uint(l_reg),__float_as_uint(l_reg),false,false);l_reg=__uint_as_float(rr[0])+__uint_as_float(rr[1]);}
  if(hi==0)wsf[32+r32]=l_reg;asm volatile("s_waitcnt lgkmcnt(0)":::"memory");
  float rli[16];
  #pragma unroll
  for(int r=0;r<16;++r)rli[r]=__builtin_amdgcn_rcpf(wsf[32+crow(r,hi)]);
  bf16*Ow=YQb+(rowbase+q0+wid*QBLK)*QP+1024+h*D; const bf16*Gw=YQb+(rowbase+q0+wid*QBLK)*QP+h*D;
  { float*stg=(float*)(shm+LDS_OST)+wid*2048;
    #pragma unroll
    for(int r=0;r<16;++r){const int orow=crow(r,hi);
      #pragma unroll
      for(int d0=0;d0<2;++d0)stg[orow*64+d0*32+r32]=o[d0][r]*rli[r];}
    asm volatile("s_waitcnt lgkmcnt(0)":::"memory");
    #pragma unroll
    for(int i=0;i<4;++i){const int row=i*8+(lane>>3),ch=lane&7; const float*sp=stg+row*64+ch*8;
      const f32x4_t a=*(const f32x4_t*)sp,c=*(const f32x4_t*)(sp+4); const u32x4 g=*(const u32x4*)(Gw+(long)row*QP+ch*8);
      u32x4 v; v[0]=cvtpk_s(a[0]*__uint_as_float(g[0]<<16),a[1]*__uint_as_float(g[0]&0xffff0000u)); v[1]=cvtpk_s(a[2]*__uint_as_float(g[1]<<16),a[3]*__uint_as_float(g[1]&0xffff0000u));
      v[2]=cvtpk_s(c[0]*__uint_as_float(g[2]<<16),c[1]*__uint_as_float(g[2]&0xffff0000u)); v[3]=cvtpk_s(c[2]*__uint_as_float(g[3]<<16),c[3]*__uint_as_float(g[3]&0xffff0000u));
      ATTN_STORE16(Ow+(long)row*QP+ch*8,v);} }
  asm volatile("s_waitcnt lgkmcnt(0)\n\ts_barrier":::"memory");
  #undef DMA_K
  #undef DMA_V
  #undef CMASK
  #undef START
  #undef RESC
  #undef ROT
}
constexpr int ATTN_LDS_BYTES=LDS_BYTES;
struct Order {
  int vcu, G;
  __device__ __forceinline__ bool next(int i,int&b,int&h,int&qb)const{
    if(G==256){ if(i>=16)return false; const int x=vcu>>5,j=vcu&31,rd=i>>2,k=i&3; const int pair=x*16+rd*4+(j>>3),un=(j&7)*4+k; b=pair>>2; h=(pair&3)*4+(un&3); qb=un>>2; return true; }
    const int U=i*G+vcu; if(U>=4096)return false; b=U>>7; h=(U>>3)&15; qb=U&7; return true; }
};
template<int THRL=8> __device__ __forceinline__ void attn_phase(char*lds,bf16*YQb,const bf16*K,const bf16*V,const Order&S){
  int b,h,qb;
  for(int i=0;S.next(i,b,h,qb);++i) attn_unit<THRL>(b,h,qb,YQb,K,V,lds);
}
#undef SBAR
#undef WAIT_BAR
}

namespace ssd {
typedef short bf16x8 __attribute__((ext_vector_type(8)));
typedef short s16x4 __attribute__((ext_vector_type(4)));
constexpr int O_B = 0, O_C = 32768, O_M = 65536, O_X = 98304, O_XD = 114688;
constexpr int O_SM = 136192, O_ST = 138240;
constexpr float LOG2E = 1.4426950408889634f;
__device__ __forceinline__ bf16x8 frag(const LAS unsigned char* img, int row, int chunk) { return *(const LAS bf16x8*)(img + row * 256 + ((chunk ^ (row & 15)) << 4)); }
__device__ __forceinline__ s16x4 trd(const LAS unsigned char* p) { typedef short v4i16_t __attribute__((ext_vector_type(4))); return __builtin_bit_cast(s16x4, __builtin_amdgcn_ds_read_tr16_b64_v4i16((LAS v4i16_t*)p)); }
__device__ __forceinline__ int xswz(int s) { return ((s >> 1) & 1) | (((s >> 3) & 1) << 1); }
__device__ __forceinline__ bf16x8 trfragX(const LAS unsigned char* img, int s0, int p0, int lane) {
    const int fq = lane >> 4, q = (lane & 15) >> 2, pp = lane & 3; const int r1 = s0 + 8 * fq + q, r2 = r1 + 4;
    const s16x4 a = trd(img + r1 * 128 + ((((p0 >> 4) ^ xswz(r1)) << 5) + 8 * pp)), b = trd(img + r2 * 128 + ((((p0 >> 4) ^ xswz(r2)) << 5) + 8 * pp));
    return (bf16x8){a[0], a[1], a[2], a[3], b[0], b[1], b[2], b[3]};
}
__device__ __forceinline__ bf16x8 trfragB(const LAS unsigned char* img, int s0, int n0, int lane) {
    const int fq = lane >> 4, q = (lane & 15) >> 2, pp = lane & 3; const int r1 = s0 + 8 * fq + q, r2 = r1 + 4; const int ch = (n0 >> 3) + (pp >> 1), sub = 8 * (pp & 1);
    const s16x4 a = trd(img + r1 * 256 + (((ch ^ (r1 & 15)) << 4) + sub)), b = trd(img + r2 * 256 + (((ch ^ (r2 & 15)) << 4) + sub));
    return (bf16x8){a[0], a[1], a[2], a[3], b[0], b[1], b[2], b[3]};
}
__device__ __forceinline__ void unpack8(const v4u u, float (&f)[8]) {
    f[0] = __uint_as_float(u.x << 16); f[1] = __uint_as_float(u.x & 0xffff0000u); f[2] = __uint_as_float(u.y << 16); f[3] = __uint_as_float(u.y & 0xffff0000u);
    f[4] = __uint_as_float(u.z << 16); f[5] = __uint_as_float(u.z & 0xffff0000u); f[6] = __uint_as_float(u.w << 16); f[7] = __uint_as_float(u.w & 0xffff0000u);
}
#define SSD_MFMA(a, b, c) __builtin_amdgcn_mfma_f32_16x16x32_bf16(a, b, c, 0, 0, 0)

__device__ __forceinline__ void ssd_item(int b, int h, const bf16* XC, const float* DT, const bf16* Z, const float* a_log, const float* d_skip, bf16* YQ, float* SSQ,
                                          LAS unsigned char* L, int tid, int lane, int wave) {
    const int fr = lane & 15, fq = lane >> 4, g = h >> 3;
    LAS unsigned char* Bi = L + O_B; LAS unsigned char* Ci = L + O_C; LAS unsigned char* Mi = L + O_M; LAS unsigned char* Xi = L + O_X; LAS unsigned char* Xdi = L + O_XD; LAS unsigned char* Sti = L + O_ST;
    LAS float* dtv = (LAS float*)(L + O_SM); LAS float* cs2 = dtv + 256;
    const float aneg1 = -expf(a_log[16 + h]) * LOG2E, aneg0 = -expf(a_log[h]) * LOG2E, dsk = d_skip[h];
    f32x4 st[4];
#pragma unroll
    for (int pt = 0; pt < 4; ++pt) st[pt] = (f32x4){0.f, 0.f, 0.f, 0.f};
    v4u Bq[4], Cq[4], Xq[2]; float dq0 = 0.f, dq1 = 0.f;
#define SSD_DECODE(step, d_, base_, ctx_) const int d_ = 1 - (step) / 18; const int k_##d_ = (step) % 18; const bool ctx_ = k_##d_ < 2; \
    const size_t base_ = ctx_ ? (size_t)ML + (size_t)b * CTXL + (size_t)(d_ ? 1 - k_##d_ : k_##d_) * 128 : (size_t)b * SEQ + (size_t)(d_ ? 17 - k_##d_ : k_##d_ - 2) * 128;
#define SSD_ISSUE(step) do { SSD_DECODE(step, di, basei, ctxi) \
        _Pragma("unroll") for (int k4 = 0; k4 < 4; ++k4) { const int q = tid + 512 * k4, s = q >> 4, c = q & 15; const size_t r = basei + (di ? 127 - s : s); \
            Bq[k4] = *(const v4u*)(XC + r * CONVC + 1024 + g * 128 + 8 * c); if (!ctxi) Cq[k4] = *(const v4u*)(XC + r * CONVC + 1280 + g * 128 + 8 * c); } \
        _Pragma("unroll") for (int k2 = 0; k2 < 2; ++k2) { const int q = tid + 512 * k2, s = q >> 3, c = q & 7; const size_t r = basei + (di ? 127 - s : s); Xq[k2] = *(const v4u*)(XC + r * CONVC + h * 64 + 8 * c); } \
        if (wave == 0) { const size_t r0 = basei + (di ? 127 - 2 * lane : 2 * lane), r1 = basei + (di ? 126 - 2 * lane : 2 * lane + 1); dq0 = DT[r0 * 32 + di * 16 + h]; dq1 = DT[r1 * 32 + di * 16 + h]; } } while (0)
#define SSD_CUMSUM(step, par) do { if (wave == 0) { const float an = (1 - (step) / 18) ? aneg1 : aneg0; const float a0 = dq0 * an, a1 = dq1 * an; float v = a0 + a1; \
        _Pragma("unroll") for (int o = 1; o < 64; o <<= 1) { const float t = __shfl_up(v, o); if (lane >= o) v += t; } \
        dtv[(par) * 128 + 2 * lane] = dq0; dtv[(par) * 128 + 2 * lane + 1] = dq1; cs2[(par) * 128 + 2 * lane] = v - a1; cs2[(par) * 128 + 2 * lane + 1] = v; } } while (0)
#define SSD_WRITE(step, par) do { const bool ctxw = ((step) % 18) < 2; \
        _Pragma("unroll") for (int k4 = 0; k4 < 4; ++k4) { const int q = tid + 512 * k4, s = q >> 4, c = q & 15; const int off = s * 256 + ((c ^ (s & 15)) << 4); \
            *(LAS v4u*)(Bi + off) = Bq[k4]; if (!ctxw) *(LAS v4u*)(Ci + off) = Cq[k4]; } \
        const float cl = cs2[(par) * 128 + 127]; \
        _Pragma("unroll") for (int k2 = 0; k2 < 2; ++k2) { const int q = tid + 512 * k2, s = q >> 3, c = q & 7; const float dts = dtv[(par) * 128 + s], es = __builtin_amdgcn_exp2f(cl - cs2[(par) * 128 + s]); \
            float f[8]; unpack8(Xq[k2], f); _Pragma("unroll") for (int e = 0; e < 8; ++e) f[e] *= dts; \
            v4u xo; xo.x = pk2(f[0], f[1]); xo.y = pk2(f[2], f[3]); xo.z = pk2(f[4], f[5]); xo.w = pk2(f[6], f[7]); \
            _Pragma("unroll") for (int e = 0; e < 8; ++e) f[e] *= es; \
            v4u xd; xd.x = pk2(f[0], f[1]); xd.y = pk2(f[2], f[3]); xd.z = pk2(f[4], f[5]); xd.w = pk2(f[6], f[7]); \
            const int off = s * 128 + ((((c >> 1) ^ xswz(s)) << 5) + (c & 1) * 16); *(LAS v4u*)(Xi + off) = xo; *(LAS v4u*)(Xdi + off) = xd; } } while (0)
#define SSD_WRITE_STATE() do { _Pragma("unroll") for (int pt = 0; pt < 4; ++pt) { const int p = 16 * pt + fr; \
        typedef unsigned u32x2_t __attribute__((ext_vector_type(2))); u32x2_t w; w.x = pk2(st[pt][0], st[pt][1]); w.y = pk2(st[pt][2], st[pt][3]); \
        *(LAS u32x2_t*)(Sti + p * 256 + ((((2 * wave + (fq >> 1)) ^ fr) << 4) + (fq & 1) * 8)) = w; } } while (0)

    __syncthreads();
    SSD_ISSUE(0); SSD_CUMSUM(0, 0); SSD_WRITE_STATE();
    __syncthreads();
    SSD_WRITE(0, 0);
    __syncthreads();
    for (int step = 0; step < 36; ++step) {
        const int par = step & 1; SSD_DECODE(step, d, base, isctx)
        if (step + 1 < 36) SSD_ISSUE(step + 1);
        const LAS float* csc = cs2 + par * 128;
        if (!isctx) {
            bf16x8 cf[4];
#pragma unroll
            for (int kk = 0; kk < 4; ++kk) cf[kk] = frag(Ci, 16 * wave + fr, 4 * kk + fq);
            const float csl = csc[16 * wave + fr];
            typedef unsigned u32x2_t __attribute__((ext_vector_type(2)));
            for (int i = 0; i <= wave; ++i) {
                f32x4 a = (f32x4){0.f, 0.f, 0.f, 0.f};
#pragma unroll
                for (int kk = 0; kk < 4; ++kk) a = SSD_MFMA(frag(Bi, 16 * i + fr, 4 * kk + fq), cf[kk], a);
                const f32x4 css = *(const LAS f32x4*)(csc + 16 * i + 4 * fq);
                float m[4];
#pragma unroll
                for (int e = 0; e < 4; ++e) { m[e] = a[e] * __builtin_amdgcn_exp2f(fminf(csl - css[e], 0.f)); if (i == wave && 4 * fq + e > fr) m[e] = 0.f; }
                u32x2_t w; w.x = pk2(m[0], m[1]); w.y = pk2(m[2], m[3]);
                *(LAS u32x2_t*)(Mi + (16 * wave + fr) * 256 + ((((2 * i + (fq >> 1)) ^ fr) << 4) + (fq & 1) * 8)) = w;
            }
            if (!(wave & 1)) { u32x2_t w; w.x = 0u; w.y = 0u; *(LAS u32x2_t*)(Mi + (16 * wave + fr) * 256 + ((((2 * (wave + 1) + (fq >> 1)) ^ fr) << 4) + (fq & 1) * 8)) = w; }
            f32x4 y[4];
#pragma unroll
            for (int pt = 0; pt < 4; ++pt) { y[pt] = (f32x4){0.f, 0.f, 0.f, 0.f};
#pragma unroll
                for (int kk = 0; kk < 4; ++kk) y[pt] = SSD_MFMA(cf[kk], frag(Sti, 16 * pt + fr, 4 * kk + fq), y[pt]); }
            { f32x4 El = *(const LAS f32x4*)(csc + 16 * wave + 4 * fq);
#pragma unroll
              for (int e = 0; e < 4; ++e) El[e] = __builtin_amdgcn_exp2f(El[e]);
#pragma unroll
              for (int pt = 0; pt < 4; ++pt) y[pt] *= El; }
            const int nkk = (wave + 2) >> 1;
            for (int kk = 0; kk < nkk; ++kk) { const bf16x8 mf = frag(Mi, 16 * wave + fr, 4 * kk + fq);
#pragma unroll
                for (int pt = 0; pt < 4; ++pt) y[pt] = SSD_MFMA(mf, trfragX(Xi, 32 * kk, 16 * pt, lane), y[pt]); }
            LAS float* stg = (LAS float*)(Mi + 16 * wave * 256);
#pragma unroll
            for (int pt = 0; pt < 4; ++pt)
#pragma unroll
                for (int e = 0; e < 4; ++e) stg[(4 * fq + e) * 64 + ((16 * pt + fr) ^ (fq << 4))] = y[pt][e];
            const int lr = lane >> 2, qd = lane & 3; const int l = 16 * wave + lr; const size_t r = base + (d ? 127 - l : l);
            const LAS float* sp = stg + lr * 64 + ((qd ^ ((lr >> 2) & 3)) << 4);
            float yv[16];
#pragma unroll
            for (int j = 0; j < 4; ++j) { const f32x4 t = *(const LAS f32x4*)(sp + 4 * j); yv[4 * j] = t[0]; yv[4 * j + 1] = t[1]; yv[4 * j + 2] = t[2]; yv[4 * j + 3] = t[3]; }
            bf16* yp = YQ + r * 2048 + h * 64 + 16 * qd;
            if (d == 0) {
                const v4u yb0 = *(const v4u*)yp, yb1 = *(const v4u*)(yp + 8); const bf16* xp = XC + r * CONVC + h * 64 + 16 * qd; const v4u x0 = *(const v4u*)xp, x1 = *(const v4u*)(xp + 8);
                const bf16* zp = Z + r * 1024 + h * 64 + 16 * qd; const v4u z0 = *(const v4u*)zp, z1 = *(const v4u*)(zp + 8);
                float fb[16], fx[16], fz[16]; { float t8[8]; unpack8(yb0, t8);
#pragma unroll
                    for (int e = 0; e < 8; ++e) fb[e] = t8[e]; unpack8(yb1, t8);
#pragma unroll
                    for (int e = 0; e < 8; ++e) fb[8 + e] = t8[e]; unpack8(x0, t8);
#pragma unroll
                    for (int e = 0; e < 8; ++e) fx[e] = t8[e]; unpack8(x1, t8);
#pragma unroll
                    for (int e = 0; e < 8; ++e) fx[8 + e] = t8[e]; unpack8(z0, t8);
#pragma unroll
                    for (int e = 0; e < 8; ++e) fz[e] = t8[e]; unpack8(z1, t8);
#pragma unroll
                    for (int e = 0; e < 8; ++e) fz[8 + e] = t8[e]; }
                float q = 0.f;
#pragma unroll
                for (int e = 0; e < 16; ++e) { yv[e] = (yv[e] + fb[e] + dsk * fx[e]) * fz[e]; q += yv[e] * yv[e]; }
                q += __shfl_xor(q, 1); q += __shfl_xor(q, 2);
                if (qd == 0) SSQ[r * 16 + h] = q;
            }
            v4u o0, o1; o0.x = pk2(yv[0], yv[1]); o0.y = pk2(yv[2], yv[3]); o0.z = pk2(yv[4], yv[5]); o0.w = pk2(yv[6], yv[7]);
            o1.x = pk2(yv[8], yv[9]); o1.y = pk2(yv[10], yv[11]); o1.z = pk2(yv[12], yv[13]); o1.w = pk2(yv[14], yv[15]);
            *(v4u*)yp = o0; *(v4u*)(yp + 8) = o1;
        }
        { const float dec = __builtin_amdgcn_exp2f(csc[127]);
#pragma unroll
          for (int pt = 0; pt < 4; ++pt) st[pt] *= dec;
#pragma unroll
          for (int kk = 0; kk < 4; ++kk) { const bf16x8 af = trfragB(Bi, 32 * kk, 16 * wave, lane);
#pragma unroll
              for (int pt = 0; pt < 4; ++pt) st[pt] = SSD_MFMA(af, trfragX(Xdi, 32 * kk, 16 * pt, lane), st[pt]); } }
        if (step + 1 < 36) SSD_CUMSUM(step + 1, par ^ 1);
        if (step == 17) {
#pragma unroll
            for (int pt = 0; pt < 4; ++pt) st[pt] = (f32x4){0.f, 0.f, 0.f, 0.f};
            VM_WAIT();
        }
        __syncthreads();
        SSD_WRITE_STATE();
        if (step + 1 < 36) SSD_WRITE(step + 1, par ^ 1);
        __syncthreads();
    }
#undef SSD_DECODE
#undef SSD_ISSUE
#undef SSD_CUMSUM
#undef SSD_WRITE
#undef SSD_WRITE_STATE
}
}

constexpr int RING_OFF = 0, RING_BYTES = 131072;
constexpr int LDSCTL_OFF = RING_BYTES, MISC_OFF = LDSCTL_OFF + 320;
constexpr int RSTD_OFF = LDSCTL_OFF + 1024;
constexpr int LDS_BYTES = 155648;
constexpr int CW_BAR = 4096;
constexpr int NPHASE = 7;

struct Args { const float* in[18]; float* out; unsigned char* ws; int ph_lo, ph_hi; };

__global__ void __launch_bounds__(NWAVES * 64, 2) mega(Args args) {
    extern __shared__ __attribute__((aligned(16))) unsigned char lds[];
    LAS unsigned char* ldsp = (LAS unsigned char*)lds;
    volatile LAS unsigned* MISC = (volatile LAS unsigned*)(ldsp + MISC_OFF);
    const int tid = threadIdx.x, lane = tid & 63, wave = __builtin_amdgcn_readfirstlane(tid >> 6);
    const int G = gridDim.x; const int bx = blockIdx.x; const int vcu = (G % 8 == 0) ? (bx % 8) * (G / 8) + bx / 8 : bx;
    unsigned char* ws = args.ws;
    gu32* ctl = (gu32*)(ws + WS_CTL);
    float* mod = (float*)(ws + WS_MOD); float* rope = (float*)(ws + WS_ROPE); float* SSQ = (float*)(ws + WS_SSQ); float* RPART = (float*)(ws + WS_RPART);
    bf16* bt1 = (bf16*)(ws + WS_BT1); bf16* bt2 = (bf16*)(ws + WS_BT2); float* DT = (float*)(ws + WS_DT); bf16* KB = (bf16*)(ws + WS_KB); bf16* VB = (bf16*)(ws + WS_VB);
    bf16* H = (bf16*)(ws + WS_R1); bf16* XC = (bf16*)(ws + WS_R1); bf16* XBC = (bf16*)(ws + WS_XBC); bf16* YQ = (bf16*)(ws + WS_YQ); bf16* Z = (bf16*)(ws + WS_Z);
    for (int u = tid; u < (LDS_BYTES - LDSCTL_OFF) / 4; u += NWAVES * 64) ((LAS unsigned*)(ldsp + LDSCTL_OFF))[u] = 0u;
    __syncthreads();
    const int lo = args.ph_lo, hi = args.ph_hi;
    XcdBarrier bar; bar.bar = (unsigned*)(ctl + CW_BAR); bar.x = 0; bar.st = nullptr;
    if (hi - lo > 1) bar = xcd_barrier_post((unsigned*)(ctl + CW_BAR), MISC + 8);
#define IN(k) (lo <= (k) && (k) < hi)
#define SEAM(k) do { if (IN(k) && IN((k) + 1)) xcd_barrier(bar); } while (0)

    if (IN(0)) {
        LAS float* ldsf = (LAS float*)(ldsp + RING_OFF);
        if (bx < 48) p0_mod_block(args.in[1], args.in[3], args.in[4], args.in[5], mod, ldsf, bx, tid, lane, wave);
        else if (bx == 48) { for (int i = tid; i < 1024; i += NWAVES * 64) { const int p = i >> 4, f = i & 15; const float inv = powf(10000.f, -(float)f / 16.f); const float ang = (float)p * inv; rope[i] = cosf(ang); rope[1024 + i] = sinf(ang); } }
        LAS float* scr = ldsf + wave * (64 * 33);
        const int gw = ((bx + G - 49) % G) * NWAVES + wave, NGW = G * NWAVES;
        constexpr int I1 = 16 * 168, I2 = 32 * 32;
        for (int it = gw; it < I1 + I2; it += NGW) { if (it < I1) p0_bt1_item(args.in[7], bt1, scr, it, lane); else p0_bt2_item(args.in[16], args.in[15], bt2, scr, it - I1, lane); }
    }
    SEAM(0);
    if (IN(1)) {
        const int gw = bx * NWAVES + wave, NGW = G * NWAVES;
        for (int m = gw; m < MT; m += NGW) {
            const float* xr = m < ML ? args.in[0] + (size_t)m * DM : args.in[2] + (size_t)(m - ML) * DM;
            p1_norm_row(xr, mod + (size_t)(m < ML ? m / SEQ : 32) * 3072, args.in[6], H + (size_t)m * DM, lane);
        }
    }
    SEAM(1);

    if (IN(2)) {
        pg8::Gemm g{H, bt1, MT, N1, 1024}; pg8::Sched1 S; S.init(G, bx);
        pg8::Epi1 E{KB, VB, XBC, YQ, Z, DT, rope, args.in[13], args.in[14], args.in[10]};
        pg8::gemm_phase<pg8::Epi1, pg8::Sched1, true, true>(ldsp + RING_OFF, g, S, E);
    }
    SEAM(2);
    if (IN(3)) {
        const attn_body::Order S{vcu, G};
        attn_body::attn_phase<8>((char*)lds + RING_OFF, (attn_body::bf16*)YQ, (const attn_body::bf16*)KB, (const attn_body::bf16*)VB, S);
        conv_phase(XBC, args.in[8], args.in[9], XC, bx, G, tid);
    }
    SEAM(3);
    if (IN(4)) {
#if defined(SSD_NAIVE)
        for (int it = bx; it < NB * 16; it += G) ssd_item_naive(it >> 4, it & 15, XC, DT, Z, args.in[11], args.in[12], YQ, SSQ, (LAS float*)(ldsp + RING_OFF), tid);
#else
        for (int it = bx; it < NB * 16; it += G) ssd::ssd_item(it >> 4, it & 15, XC, DT, Z, args.in[11], args.in[12], YQ, SSQ, ldsp, tid, lane, wave);
#endif
    }
    SEAM(4);

    if (IN(5)) {
        pg8::Sched2 S; S.init(G, bx);
        LAS float* rt = (LAS float*)(ldsp + RSTD_OFF);
        { pg8::Unit u; for (int i = 0; i < 4 && S.next(i, u); ++i) if (tid < 256) { const float* q = SSQ + ((size_t)u.pm * 256 + tid) * 16; float s = 0.f;
#pragma unroll
                for (int j = 0; j < 16; ++j) s += q[j];
                rt[i * 256 + tid] = rsqrtf(s * (1.f / 1024.f) + EPS); } }
        __syncthreads();
        pg8::Gemm g{YQ, bt2, ML, 1024, 2048};
        pg8::Epi2 E{args.in[0], mod, args.out, RPART, (const LAS float*)rt};
        pg8::gemm_phase<pg8::Epi2, pg8::Sched2, true, true>(ldsp + RING_OFF, g, S, E);
    }
    SEAM(5);

    if (IN(6)) {
        const int gw = bx * NWAVES + wave, NGW = G * NWAVES;
        for (int m = gw; m < ML; m += NGW) {
            const f32x4 q0 = *(const f32x4*)(RPART + (size_t)m * 16), q1 = *(const f32x4*)(RPART + (size_t)m * 16 + 4), q2 = *(const f32x4*)(RPART + (size_t)m * 16 + 8), q3 = *(const f32x4*)(RPART + (size_t)m * 16 + 12);
            const float s = ((q0[0] + q0[1]) + (q0[2] + q0[3])) + ((q1[0] + q1[1]) + (q1[2] + q1[3])) + ((q2[0] + q2[1]) + (q2[2] + q2[3])) + ((q3[0] + q3[1]) + (q3[2] + q3[3]));
            const float rstd = rsqrtf(s * (1.f / DM) + EPS);
            GAS f32x4* o = (GAS f32x4*)(args.out + (size_t)m * DM) + lane;
#pragma unroll
            for (int j = 0; j < 4; ++j) { const f32x4 fg = *(const f32x4*)(args.in[17] + 4 * lane + 256 * j); o[64 * j] = o[64 * j] * rstd * fg; }
        }
    }
#undef IN
#undef SEAM
}

__global__ void k_mod(const float* c, const float* c_ctx, const float* ada_w, const float* ada_b, float* mod) {
    const int i = blockIdx.x * 256 + threadIdx.x; if (i >= 33 * 3072) return;
    const int b = i / 3072, n = i % 3072; const float* cv = b < 32 ? c + b * 1024 : c_ctx;
    float acc = 0.f;
    for (int k = 0; k < 1024; ++k) acc += siluf(cv[k]) * ada_w[(size_t)k * 3072 + n];
    mod[i] = acc + ada_b[n];
}
__global__ void k_tables(float* rope) {
    const int i = blockIdx.x * 256 + threadIdx.x; if (i >= 1024) return;
    const int p = i >> 4, f = i & 15; const float inv = powf(10000.f, -(float)f / 16.f); const float ang = (float)p * inv;
    rope[i] = cosf(ang); rope[1024 + i] = sinf(ang);
}
__global__ void k_bt1(const float* w_in, bf16* bt1) {
    const size_t i = (size_t)blockIdx.x * 256 + threadIdx.x; if (i >= (size_t)N1 * 1024) return;
    const int v = (int)(i >> 10), k = (int)(i & 1023); const int a = vcol_actual(v);
    bt1[i] = (bf16)(a >= 0 ? f2bf(w_in[(size_t)k * PROJ + a]) : 0u);
}
__global__ void k_bt2(const float* w_out, const float* ssd_g, bf16* bt2) {
    const size_t i = (size_t)blockIdx.x * 256 + threadIdx.x; if (i >= (size_t)1024 * 2048) return;
    const int n = (int)(i >> 11), kk = (int)(i & 2047);
    const float v = kk < 1024 ? w_out[(size_t)(1024 + kk) * 1024 + n] * ssd_g[kk] : w_out[(size_t)(kk - 1024) * 1024 + n];
    bt2[i] = (bf16)f2bf(v);
}
__global__ void k_norm(const float* x, const float* ctx, const float* norm_g, const float* mod, bf16* H) {
    const int row = blockIdx.x * 4 + (threadIdx.x >> 6), lane = threadIdx.x & 63; if (row >= MT) return;
    const float* xr = row < ML ? x + (size_t)row * DM : ctx + (size_t)(row - ML) * DM;
    const float* md = mod + (size_t)(row < ML ? row / SEQ : 32) * 3072;
    float v[16]; float s = 0.f;
    for (int j = 0; j < 16; ++j) { v[j] = xr[lane + 64 * j]; s += v[j] * v[j]; }
    for (int o = 1; o < 64; o <<= 1) s += __shfl_xor(s, o);
    const float rstd = rsqrtf(s * (1.f / DM) + EPS);
    for (int j = 0; j < 16; ++j) { const int k = lane + 64 * j; const float h = v[j] * rstd * norm_g[k] * (1.f + md[1024 + k]) + md[k]; H[(size_t)row * DM + k] = (bf16)f2bf(h); }
}
__global__ __launch_bounds__(256) void k_gemm1(const bf16* H, const bf16* bt1, const float* rope, const float* qg, const float* kg, const float* dt_bias,
                                                bf16* KB, bf16* VB, bf16* XBC, float* DT, bf16* YQ, bf16* Z) {
    __shared__ float As[32][65];
    __shared__ float Ps[32][257];
    const int pn = blockIdx.x, rt = blockIdx.y, tid = threadIdx.x; const int row0 = rt * 32;
    if (row0 >= ML && pn > 8) return;
    float acc[32];
    for (int r = 0; r < 32; ++r) acc[r] = 0.f;
    const bf16* bp = bt1 + (size_t)(pn * 256 + tid) * 1024;
    for (int k0 = 0; k0 < 1024; k0 += 64) {
        __syncthreads();
        for (int e = tid; e < 32 * 64; e += 256) { const int r = e >> 6, kk = e & 63; As[r][kk] = bf2f(H[(size_t)(row0 + r) * DM + k0 + kk]); }
        __syncthreads();
        for (int kk = 0; kk < 64; ++kk) { const float b = bf2f(bp[k0 + kk]);
            for (int r = 0; r < 32; ++r) acc[r] += As[r][kk] * b; }
    }
    for (int r = 0; r < 32; ++r) Ps[r][tid] = acc[r];
    __syncthreads();
    const bool isctx = row0 >= ML;
    if (pn == 0 || (pn >= 9 && pn < 13)) {
        {
            const int r = tid >> 3, hd = (tid >> 1) & 3, ax = tid & 1, row = row0 + r; const float* g = pn == 0 ? kg : qg;
            float s = 0.f;
            for (int d = 0; d < 32; ++d) { const float v = Ps[r][hperm_inv(hd, ax * 32 + d)]; s += v * v; }
            s += __shfl_xor(s, 1);
            const float rstd = rsqrtf(s * (1.f / 64.f) + EPS);
            const int t = row % SEQ, p = ax == 0 ? (t >> 6) : (t & 63);
            bf16* dst; float osc = 1.f;
            if (pn == 0) { const int b = isctx ? (row - ML) / CTXL : row / SEQ, pos = isctx ? SEQ + (row - ML) % CTXL : row % SEQ; dst = KB + ((size_t)b * KVL + pos) * 256 + hd * 64 + ax * 32; }
            else { dst = YQ + (size_t)row * 2048 + 1024 + ((pn - 9) * 4 + hd) * 64 + ax * 32; osc = C2; }
            for (int f = 0; f < 16; ++f) {
                const float x1 = Ps[r][hperm_inv(hd, ax * 32 + f)] * rstd * g[ax * 32 + f], x2 = Ps[r][hperm_inv(hd, ax * 32 + 16 + f)] * rstd * g[ax * 32 + 16 + f];
                float o1 = x1, o2 = x2;
                if (!isctx) { const float cs = rope[p * 16 + f], sn = rope[1024 + p * 16 + f]; o1 = x1 * cs - x2 * sn; o2 = x2 * cs + x1 * sn; }
                dst[f] = (bf16)f2bf(o1 * osc); dst[16 + f] = (bf16)f2bf(o2 * osc);
            }
        }
    } else {
        for (int r = 0; r < 32; ++r) { const int row = row0 + r; const float v = Ps[r][tid];
            if (pn == 1) { const int b = isctx ? (row - ML) / CTXL : row / SEQ, pos = isctx ? SEQ + (row - ML) % CTXL : row % SEQ;
                VB[((size_t)b * KVL + pos) * 256 + tid] = (bf16)f2bf(v); }
            else if (pn < 8) XBC[(size_t)row * CONVC + (pn - 2) * 256 + tid] = (bf16)f2bf(v);
            else if (pn == 8) { if (tid < 32) DT[(size_t)row * 32 + tid] = softplusf(v + dt_bias[tid]); }
            else if (pn < 17) YQ[(size_t)row * 2048 + (pn - 13) * 256 + tid] = (bf16)f2bf(siluf(v));
            else Z[(size_t)row * 1024 + (pn - 17) * 256 + tid] = (bf16)f2bf(siluf(v)); }
    }
}
__global__ __launch_bounds__(256) void k_attn(bf16* YQ, const bf16* KB, const bf16* VB) {
    __shared__ float Qs[64][65]; __shared__ float Ks[64][65]; __shared__ float Ps[64][65]; __shared__ bf16 Vs[64][66];
    const int qb = blockIdx.x, h = blockIdx.y, b = blockIdx.z, tid = threadIdx.x, ty = tid >> 4, tx = tid & 15;
    const size_t row0 = (size_t)b * SEQ + qb * 64; const int kvh = h >> 2;
    for (int e = tid; e < 4096; e += 256) { const int r = e >> 6, d = e & 63; Qs[r][d] = bf2f(YQ[(row0 + r) * 2048 + 1024 + h * 64 + d]); }
    float o[4][4], l[4];
    for (int i = 0; i < 4; ++i) { l[i] = 0.f; for (int j = 0; j < 4; ++j) o[i][j] = 0.f; }
    for (int kt = 0; kt < KVL / 64; ++kt) {
        __syncthreads();
        for (int e = tid; e < 4096; e += 256) { const int r = e >> 6, d = e & 63; const size_t src = ((size_t)b * KVL + kt * 64 + r) * 256 + kvh * 64 + d;
            Ks[r][d] = bf2f(KB[src]); Vs[r][d] = VB[src]; }
        __syncthreads();
        float s[4][4];
        for (int i = 0; i < 4; ++i) for (int j = 0; j < 4; ++j) s[i][j] = 0.f;
        for (int d = 0; d < 64; ++d) { float a[4], k4[4];
            for (int i = 0; i < 4; ++i) { a[i] = Qs[ty * 4 + i][d]; k4[i] = Ks[tx * 4 + i][d]; }
            for (int i = 0; i < 4; ++i) for (int j = 0; j < 4; ++j) s[i][j] += a[i] * k4[j]; }
        for (int i = 0; i < 4; ++i) for (int j = 0; j < 4; ++j) Ps[ty * 4 + i][tx * 4 + j] = exp2f(s[i][j]);
        __syncthreads();
        for (int key = 0; key < 64; ++key) { float p[4], v4[4];
            for (int i = 0; i < 4; ++i) { p[i] = Ps[ty * 4 + i][key]; v4[i] = bf2f(Vs[key][tx * 4 + i]); }
            for (int i = 0; i < 4; ++i) { l[i] += p[i]; for (int j = 0; j < 4; ++j) o[i][j] += p[i] * v4[j]; } }
    }
    for (int i = 0; i < 4; ++i) for (int j = 0; j < 4; ++j) { const size_t row = row0 + ty * 4 + i; const int d = tx * 4 + j;
        const float ga = bf2f(YQ[row * 2048 + h * 64 + d]);
        YQ[row * 2048 + 1024 + h * 64 + d] = (bf16)f2bf(o[i][j] / l[i] * ga); }
}
__global__ void k_conv(const bf16* XBC, const float* cw, const float* cb, bf16* XC) {
    const size_t i = (size_t)blockIdx.x * 256 + threadIdx.x; if (i >= (size_t)MT * CONVC) return;
    const int row = (int)(i / CONVC), ch = (int)(i % CONVC);
    int t, len; if (row < ML) { t = row % SEQ; len = SEQ; } else { t = (row - ML) % CTXL; len = CTXL; }
    float acc = cb[ch];
    for (int j = 0; j < 5; ++j) { const int tt = t + j - 2; if (tt >= 0 && tt < len) acc += cw[j * CONVC + ch] * bf2f(XBC[(size_t)(row + j - 2) * CONVC + ch]); }
    XC[i] = (bf16)f2bf(siluf(acc));
}
__global__ __launch_bounds__(512) void k_ssd(const bf16* XC, const float* DT, const bf16* Z, const float* a_log, const float* d_skip, bf16* YQ, float* SSQ) {
    __shared__ float ysq[64];
    const int h = blockIdx.x, b = blockIdx.y, tid = threadIdx.x, p = tid >> 3, nc = tid & 7, g = h >> 3;
    for (int dd = 0; dd < 2; ++dd) { const int d = 1 - dd;
        const float a_neg = -expf(a_log[d * 16 + h]);
        float S[16];
        for (int j = 0; j < 16; ++j) S[j] = 0.f;
        for (int seq = 0; seq < 2; ++seq) { const int len = seq == 0 ? CTXL : SEQ; const size_t rbase = seq == 0 ? (size_t)ML + (size_t)b * CTXL : (size_t)b * SEQ;
            for (int st = 0; st < len; ++st) { const int t = d ? len - 1 - st : st; const size_t row = rbase + t;
                const float dt = DT[row * 32 + d * 16 + h]; const float dec = expf(dt * a_neg);
                const float xs = bf2f(XC[row * CONVC + h * 64 + p]); const float X = xs * dt;
                const bf16* Bp = XC + row * CONVC + 1024 + g * 128 + nc * 16; const bf16* Cp = Bp + 256;
                float y = 0.f;
                for (int j = 0; j < 16; ++j) { S[j] = S[j] * dec + X * bf2f(Bp[j]); y += bf2f(Cp[j]) * S[j]; }
                y += __shfl_xor(y, 1); y += __shfl_xor(y, 2); y += __shfl_xor(y, 4);
                if (seq == 1) {
                    bf16* yp = YQ + row * 2048 + h * 64 + p;
                    if (d == 1) { if (nc == 0) *yp = (bf16)f2bf(y); }
                    else {
                        float yg = 0.f;
                        if (nc == 0) { const float yt = y + bf2f(*yp) + d_skip[h] * xs; yg = yt * bf2f(Z[row * 1024 + h * 64 + p]); *yp = (bf16)f2bf(yg); ysq[p] = yg * yg; }
                        __syncthreads();
                        if (tid < 64) { float q = ysq[tid]; for (int o = 1; o < 64; o <<= 1) q += __shfl_xor(q, o); if (tid == 0) SSQ[row * 16 + h] = q; }
                        __syncthreads();
                    }
                }
            }
        }
    }
}
__global__ __launch_bounds__(256) void k_gemm2(const bf16* YQ, const bf16* bt2, const float* SSQ, const float* x, const float* mod, float* out, float* RPART) {
    __shared__ float As[32][65]; __shared__ float red[32][4];
    const int pn = blockIdx.x, rt = blockIdx.y, tid = threadIdx.x, row0 = rt * 32;
    float acc[32];
    for (int r = 0; r < 32; ++r) acc[r] = 0.f;
    const bf16* bp = bt2 + (size_t)(pn * 256 + tid) * 2048;
    for (int k0 = 0; k0 < 2048; k0 += 64) {
        if (k0 == 1024) { for (int r = 0; r < 32; ++r) { float s = 0.f; for (int j = 0; j < 16; ++j) s += SSQ[(size_t)(row0 + r) * 16 + j]; acc[r] *= rsqrtf(s * (1.f / 1024.f) + EPS); } }
        __syncthreads();
        for (int e = tid; e < 32 * 64; e += 256) { const int r = e >> 6, kk = e & 63; As[r][kk] = bf2f(YQ[(size_t)(row0 + r) * 2048 + k0 + kk]); }
        __syncthreads();
        for (int kk = 0; kk < 64; ++kk) { const float bv = bf2f(bp[k0 + kk]);
            for (int r = 0; r < 32; ++r) acc[r] += As[r][kk] * bv; }
    }
    const int n = pn * 256 + tid;
    for (int r = 0; r < 32; ++r) { const int row = row0 + r; const float v = x[(size_t)row * DM + n] + mod[(size_t)(row / SEQ) * 3072 + 2048 + n] * acc[r];
        out[(size_t)row * DM + n] = v; float q = v * v;
        for (int o = 1; o < 64; o <<= 1) q += __shfl_xor(q, o);
        if ((tid & 63) == 0) RPART[(size_t)row * 16 + pn * 4 + (tid >> 6)] = q; }
}
__global__ void k_final(float* out, const float* RPART, const float* fg) {
    const int row = blockIdx.x * 4 + (threadIdx.x >> 6), lane = threadIdx.x & 63;
    float s = 0.f;
    for (int j = 0; j < 16; ++j) s += RPART[(size_t)row * 16 + j];
    const float rstd = rsqrtf(s * (1.f / DM) + EPS);
    for (int j = 0; j < 16; ++j) { const int k = lane + 64 * j; out[(size_t)row * DM + k] *= rstd * fg[k]; }
}


#ifndef FAST_MASK
#define FAST_MASK 0x7f
#endif
extern "C" void kernel_launch(void* const* d_in, const int* in_sizes, int n_in, void* d_out, int out_size, void* d_ws, size_t ws_size, hipStream_t stream) {
    if (n_in != 18 || out_size != ML * DM || ws_size < WS_END) { fprintf(stderr, "kernel_launch: unexpected shapes (n_in %d out %d ws %zu)\n", n_in, out_size, ws_size); return; }
    static int grid = 0;
    if (grid == 0) {
        int dev = 0, cus = 0;
        if (hipGetDevice(&dev) != hipSuccess || hipDeviceGetAttribute(&cus, hipDeviceAttributeMultiprocessorCount, dev) != hipSuccess) { fprintf(stderr, "kernel_launch: device query failed\n"); grid = -1; return; }
        if (hipFuncSetAttribute((const void*)mega, hipFuncAttributeMaxDynamicSharedMemorySize, LDS_BYTES) != hipSuccess) { fprintf(stderr, "kernel_launch: hipFuncSetAttribute failed\n"); grid = -1; return; }
        int per_cu = 0;
        if (hipOccupancyMaxActiveBlocksPerMultiprocessor(&per_cu, (const void*)mega, NWAVES * 64, LDS_BYTES) != hipSuccess || per_cu < 1) fprintf(stderr, "kernel_launch: note: occupancy query says %d blocks/CU\n", per_cu);
        (void)hipGetLastError();
        grid = cus;
    }
    if (grid < 0) return;
    const float* x = (const float*)d_in[0]; const float* c = (const float*)d_in[1]; const float* ctx = (const float*)d_in[2]; const float* c_ctx = (const float*)d_in[3];
    const float* ada_w = (const float*)d_in[4]; const float* ada_b = (const float*)d_in[5]; const float* norm_g = (const float*)d_in[6]; const float* w_in = (const float*)d_in[7];
    const float* conv_w = (const float*)d_in[8]; const float* conv_b = (const float*)d_in[9]; const float* dt_bias = (const float*)d_in[10]; const float* a_log = (const float*)d_in[11];
    const float* d_skip = (const float*)d_in[12]; const float* qg = (const float*)d_in[13]; const float* kg = (const float*)d_in[14]; const float* ssd_g = (const float*)d_in[15];
    const float* w_out = (const float*)d_in[16]; const float* final_g = (const float*)d_in[17];
    unsigned char* ws = (unsigned char*)d_ws; float* out = (float*)d_out;
    float* mod = (float*)(ws + WS_MOD); float* rope = (float*)(ws + WS_ROPE); float* SSQ = (float*)(ws + WS_SSQ); float* RPART = (float*)(ws + WS_RPART);
    bf16* bt1 = (bf16*)(ws + WS_BT1); bf16* bt2 = (bf16*)(ws + WS_BT2); float* DT = (float*)(ws + WS_DT); bf16* KB = (bf16*)(ws + WS_KB); bf16* VB = (bf16*)(ws + WS_VB);
    bf16* H = (bf16*)(ws + WS_R1); bf16* XC = (bf16*)(ws + WS_R1); bf16* XBC = (bf16*)(ws + WS_XBC); bf16* YQ = (bf16*)(ws + WS_YQ); bf16* Z = (bf16*)(ws + WS_Z);
    (void)hipMemsetAsync(ws + WS_CTL, 0, 1 * MiB, stream);
    Args a{};
    for (int i = 0; i < 18; ++i) a.in[i] = (const float*)d_in[i];
    a.out = out; a.ws = ws;
    for (int ph = 0; ph < NPHASE;) {
        if ((FAST_MASK >> ph) & 1) { int e = ph; while (e < NPHASE && ((FAST_MASK >> e) & 1)) ++e;
            a.ph_lo = ph; a.ph_hi = e; hipLaunchKernelGGL(mega, dim3(grid), dim3(NWAVES * 64), LDS_BYTES, stream, a);
            const hipError_t le = hipPeekAtLastError(); if (le != hipSuccess) fprintf(stderr, "kernel_launch: mega launch failed: %s\n", hipGetErrorName(le));
            ph = e; continue; }
        switch (ph) {
        case 0: k_mod<<<(33 * 3072 + 255) / 256, 256, 0, stream>>>(c, c_ctx, ada_w, ada_b, mod); k_tables<<<4, 256, 0, stream>>>(rope);
                k_bt1<<<(N1 * 1024) / 256, 256, 0, stream>>>(w_in, bt1); k_bt2<<<(1024 * 2048) / 256, 256, 0, stream>>>(w_out, ssd_g, bt2); break;
        case 1: k_norm<<<MT / 4, 256, 0, stream>>>(x, ctx, norm_g, mod, H); break;
        case 2: k_gemm1<<<dim3(21, MT / 32), 256, 0, stream>>>(H, bt1, rope, qg, kg, dt_bias, KB, VB, XBC, DT, YQ, Z); break;
        case 3: k_attn<<<dim3(SEQ / 64, 16, NB), 256, 0, stream>>>(YQ, KB, VB); k_conv<<<(unsigned)(((size_t)MT * CONVC + 255) / 256), 256, 0, stream>>>(XBC, conv_w, conv_b, XC); break;
        case 4: k_ssd<<<dim3(16, NB), 512, 0, stream>>>(XC, DT, Z, a_log, d_skip, YQ, SSQ); break;
        case 5: k_gemm2<<<dim3(4, ML / 32), 256, 0, stream>>>(YQ, bt2, SSQ, x, mod, out, RPART); break;
        case 6: k_final<<<ML / 4, 256, 0, stream>>>(out, RPART, final_g); break;
        }
        ++ph;
    }
}
```

```cpp
#include <hip/hip_runtime.h>
#include <cstdio>
#include <cstdint>
#include <hip/hip_bf16.h>

constexpr int DM = 1024, NB = 32, SEQ = 2048, CTXL = 256, KVL = SEQ + CTXL;
constexpr int ML = NB * SEQ, MC = NB * CTXL, MT = ML + MC;
constexpr int PROJ = 5152, OFF_XBC = 512, OFF_DT = 2048, CTXC = 2080, CONVC = 1536;
constexpr int N1 = 21 * 256;
constexpr float EPS = 1e-6f;
constexpr float C2 = 0.125f * 1.4426950408889634f;

typedef unsigned short bf16;
__host__ __device__ __forceinline__ unsigned f2bf(float f) { unsigned u = __builtin_bit_cast(unsigned, f); return (u + 0x7fffu + ((u >> 16) & 1u)) >> 16; }
__host__ __device__ __forceinline__ float bf2f(unsigned h) { return __builtin_bit_cast(float, (h & 0xffffu) << 16); }
__device__ __forceinline__ float siluf(float v) { return v / (1.f + __expf(-v)); }
__device__ __forceinline__ float softplusf(float v) { return v > 20.f ? v : log1pf(expf(v)); }

constexpr size_t MiB = 1u << 20;
constexpr size_t WS_CTL = 0;
constexpr size_t WS_MOD = 2 * MiB;
constexpr size_t WS_ROPE = 3 * MiB;
constexpr size_t WS_SSQ = 4 * MiB;
constexpr size_t WS_RPART = 8 * MiB;
constexpr size_t WS_BT1 = 12 * MiB;
constexpr size_t WS_BT2 = 23 * MiB;
constexpr size_t WS_DT = 28 * MiB;
constexpr size_t WS_KB = 38 * MiB;
constexpr size_t WS_VB = 74 * MiB;
constexpr size_t WS_R1 = 110 * MiB;
constexpr size_t WS_XBC = 326 * MiB;
constexpr size_t WS_YQ = 542 * MiB;
constexpr size_t WS_Z = 798 * MiB;
constexpr size_t WS_END = 926 * MiB;

__host__ __device__ __forceinline__ int hperm_dim(int vin) {
    const int bj = vin >> 7, wc = (vin >> 5) & 3, s = vin & 31, fq = s >> 3, e = s & 7;
    return wc * 64 + bj * 32 + (e >> 2) * 16 + 4 * fq + (e & 3);
}
__host__ __device__ __forceinline__ int hperm_inv(int head, int dim) {
    const int axis = dim >> 5, half = (dim >> 4) & 1, i16 = dim & 15, fq = i16 >> 2, e = (i16 & 3) + 4 * half;
    return 128 * axis + 32 * head + 8 * fq + e;
}
__host__ __device__ __forceinline__ int vcol_actual(int v) {
    const int t = v >> 8, vin = v & 255;
    if (t == 0) return hperm_dim(vin);
    if (t == 1) return 256 + vin;
    if (t < 8) return v;
    if (t == 8) return vin < 32 ? OFF_DT + vin : -1;
    if (t < 13) return CTXC + (t - 9) * 256 + hperm_dim(vin);
    if (t < 17) return CTXC + 1024 + (v - 13 * 256);
    return CTXC + 2048 + (v - 17 * 256);
}

namespace pg8 {
#define PG8_LAS __attribute__((address_space(3)))
typedef unsigned short bf16_t;
typedef short bf16x8 __attribute__((ext_vector_type(8)));
typedef float f32x4 __attribute__((ext_vector_type(4)));
typedef unsigned u32x4 __attribute__((ext_vector_type(4)));
constexpr int BM = 256, BK = 64, HALF = 128, HTB = HALF * BK * 2  , STAGE_BYTES = 8 * HTB, NXCD = 8, WGM = 8;

__host__ __device__ __forceinline__ int lds_byte(int r, int c) { const int st = (r >> 4) * 2 + (c >> 5), rr = r & 15, cc = c & 31, ob = rr * 64 + cc * 2; return st * 1024 + (ob ^ (((ob >> 9) & 1) << 5)); }
__host__ __device__ __forceinline__ void stage_rc(int b, int& R, int& C) { const int st = b / 1024, sb = b % 1024, swz = sb ^ (((sb >> 9) & 1) << 5); R = (st >> 1) * 16 + swz / 64; C = (st & 1) * 32 + (swz % 64) / 2; }
__host__ __device__ __forceinline__ int perm32(int rho) { const int n = rho >> 4, i = rho & 15; return 8 * (i >> 2) + 4 * n + (i & 3); }

struct Unit { int pm, pn; };
struct Gemm { const bf16_t* A; const bf16_t* Bt; int M, N, K; };

__device__ __forceinline__ unsigned cvt_pk_bf16(float lo, float hi) { unsigned r; asm volatile("v_cvt_pk_bf16_f32 %0, %1, %2" : "=v"(r) : "v"(lo), "v"(hi)); return r; }
typedef float f32x2 __attribute__((ext_vector_type(2)));
template <class Epi, class Sched, bool ALIGN_EPI = false, bool SP2 = false>
__device__ __forceinline__ void gemm_phase(PG8_LAS unsigned char* lds, const Gemm g, const Sched& S, const Epi& E) {
    const int tid = threadIdx.x, wid = __builtin_amdgcn_readfirstlane(tid >> 6), lane = tid & 63, wr = wid >> 2, wc = wid & 3, fr = lane & 15, fq = lane >> 4;
    const int K = g.K, nt = K / BK;
    unsigned voffA[2], voffB[2];
#pragma unroll
    for (int i = 0; i < 2; ++i) { int R, C; stage_rc(tid * 16 + i * 8192, R, C); const int Rb = Epi::PERM ? ((R & ~31) + perm32(R & 31)) : R;
        voffA[i] = (unsigned)(R * K + C) * 2u; voffB[i] = (unsigned)(Rb * K + C) * 2u; }
    const size_t kstep = (size_t)(BK * 2);
    const size_t hstep = (size_t)HALF * K * 2;
    const size_t tstep = 2 * hstep;
    const unsigned ldsw = (unsigned)wid * 1024u;
    const int aoff = lds_byte(wr * 64 + fr, fq * 8), boff = lds_byte(wc * 32 + fr, fq * 8);
#define PG8_SA(b, h) (((b) * 2 + (h)) * HTB)
#define PG8_SB(b, h) ((4 + (b) * 2 + (h)) * HTB)
#define PG8_STAGE(bufoff, gbase, voff) do { _Pragma("unroll") for (int _i = 0; _i < 2; ++_i) \
        __builtin_amdgcn_global_load_lds((const unsigned*)((const char*)(gbase) + (voff)[_i]), (PG8_LAS unsigned*)(lds + (bufoff) + ldsw + _i * 8192), 16, 0, 0); } while (0)
#define PG8_LDA(dst, b, h) do { _Pragma("unroll") for (int m = 0; m < 4; ++m) _Pragma("unroll") for (int k = 0; k < 2; ++k) dst[m][k] = *(const PG8_LAS bf16x8*)(lds + PG8_SA(b, h) + aoff + m * 2048 + k * 1024); } while (0)
#define PG8_LDB(dst, b, h) do { _Pragma("unroll") for (int n = 0; n < 2; ++n) _Pragma("unroll") for (int k = 0; k < 2; ++k) dst[n][k] = *(const PG8_LAS bf16x8*)(lds + PG8_SB(b, h) + boff + n * 2048 + k * 1024); } while (0)
#define PG8_MMA(ai, bj, At, Bt) do { __builtin_amdgcn_s_setprio(1); _Pragma("unroll") for (int m = 0; m < 4; ++m) _Pragma("unroll") for (int n = 0; n < 2; ++n) _Pragma("unroll") for (int k = 0; k < 2; ++k) \
        acc[ai][bj][m][n] = __builtin_amdgcn_mfma_f32_16x16x32_bf16(Bt[n][k], At[m][k], acc[ai][bj][m][n], 0, 0, 0); __builtin_amdgcn_s_setprio(0); } while (0)
#define PG8_WAIT_V(n) asm volatile("s_waitcnt vmcnt(" #n ")" ::: "memory")
#define PG8_WAIT_L(n) asm volatile("s_waitcnt lgkmcnt(" #n ")" ::: "memory")
#define PG8_BAR __builtin_amdgcn_s_barrier()
#define PG8_SCHED __builtin_amdgcn_sched_barrier(0)
    Unit cur, nxt; int ui = 0;
    if (!S.next(0, cur)) return;
    f32x4 acc[2][2][4][2];
#pragma unroll
    for (int a = 0; a < 2; ++a)
#pragma unroll
        for (int b = 0; b < 2; ++b)
#pragma unroll
            for (int m = 0; m < 4; ++m)
#pragma unroll
                for (int n = 0; n < 2; ++n) acc[a][b][m][n] = (f32x4){0.f, 0.f, 0.f, 0.f};
    bf16x8 At[4][2], B0[2][2], B1[2][2];
    const char* cA = (const char*)g.A + (size_t)cur.pm * tstep; const char* cB = (const char*)g.Bt + (size_t)cur.pn * tstep;
    S.a_ready(cur);
    if constexpr (SP2) {
        PG8_STAGE(PG8_SB(0, 0), cB, voffB); PG8_STAGE(PG8_SB(0, 1), cB + hstep, voffB); PG8_STAGE(PG8_SA(0, 0), cA, voffA); PG8_STAGE(PG8_SA(0, 1), cA + hstep, voffA);
        if (wr == 1) PG8_BAR;
        PG8_WAIT_V(2); PG8_BAR;
        PG8_STAGE(PG8_SB(1, 0), cB + kstep, voffB); PG8_STAGE(PG8_SA(1, 0), cA + kstep, voffA); PG8_STAGE(PG8_SB(1, 1), cB + hstep + kstep, voffB);
        PG8_WAIT_V(6); PG8_BAR;
    } else {
        PG8_STAGE(PG8_SB(0, 0), cB, voffB); PG8_STAGE(PG8_SA(0, 0), cA, voffA); PG8_STAGE(PG8_SB(0, 1), cB + hstep, voffB); PG8_STAGE(PG8_SA(0, 1), cA + hstep, voffA);
        if (wr == 1) PG8_BAR;
        PG8_WAIT_V(4); PG8_BAR;
        PG8_STAGE(PG8_SB(1, 0), cB + kstep, voffB); PG8_STAGE(PG8_SA(1, 0), cA + kstep, voffA); PG8_STAGE(PG8_SB(1, 1), cB + hstep + kstep, voffB);
        PG8_WAIT_V(6); PG8_BAR;
    }
    for (;;) {
        const bool has_next = S.next(ui + 1, nxt);
        const char* nA = has_next ? (const char*)g.A + (size_t)nxt.pm * tstep : cA; const char* nB = has_next ? (const char*)g.Bt + (size_t)nxt.pn * tstep : cB;
        for (int t = 0; t < nt; t += 2) {
            if constexpr (Epi::MIDK) { if (t == nt / 2) E.midk(acc, ui, wr, fr); }
            const bool last = (t == nt - 2);
            const char* a1 = cA + (size_t)(t + 1) * kstep;
            const char* a2 = last ? nA : cA + (size_t)(t + 2) * kstep; const char* b2 = last ? nB : cB + (size_t)(t + 2) * kstep;
            const char* a3 = a2 + kstep; const char* b3 = b2 + kstep;
            if (last && has_next) S.a_ready(nxt);
            if constexpr (SP2) {
            PG8_LDB(B0, 0, 0); PG8_LDB(B1, 0, 1); PG8_SCHED; PG8_LDA(At, 0, 0); PG8_STAGE(PG8_SA(1, 1), a1 + hstep, voffA);
            PG8_WAIT_V(8); PG8_WAIT_L(0); PG8_BAR; PG8_MMA(0, 0, At, B0); PG8_MMA(0, 1, At, B1); PG8_BAR; PG8_SCHED;
            PG8_LDA(At, 0, 1); PG8_STAGE(PG8_SB(0, 0), b2, voffB); PG8_STAGE(PG8_SB(0, 1), b2 + hstep, voffB); PG8_STAGE(PG8_SA(0, 0), a2, voffA);
            PG8_WAIT_V(8); PG8_WAIT_L(0); PG8_BAR; PG8_MMA(1, 0, At, B0); PG8_MMA(1, 1, At, B1); PG8_BAR; PG8_SCHED;
            PG8_LDB(B0, 1, 0); PG8_LDB(B1, 1, 1); PG8_SCHED; PG8_LDA(At, 1, 0); PG8_STAGE(PG8_SA(0, 1), a2 + hstep, voffA);
            PG8_WAIT_V(8); PG8_WAIT_L(0); PG8_BAR; PG8_MMA(0, 0, At, B0); PG8_MMA(0, 1, At, B1); PG8_BAR; PG8_SCHED;
            PG8_LDA(At, 1, 1); PG8_STAGE(PG8_SB(1, 0), b3, voffB); PG8_STAGE(PG8_SB(1, 1), b3 + hstep, voffB); PG8_STAGE(PG8_SA(1, 0), a3, voffA);
            PG8_WAIT_V(8); PG8_WAIT_L(0); PG8_BAR; PG8_MMA(1, 0, At, B0); PG8_MMA(1, 1, At, B1); PG8_BAR; PG8_SCHED;
            } else {
            PG8_LDB(B0, 0, 0); PG8_SCHED; PG8_LDA(At, 0, 0); PG8_STAGE(PG8_SA(1, 1), a1 + hstep, voffA);
            PG8_WAIT_L(8); PG8_BAR; PG8_WAIT_L(0); PG8_MMA(0, 0, At, B0); PG8_BAR; PG8_SCHED;
            PG8_LDB(B1, 0, 1); PG8_STAGE(PG8_SB(0, 0), b2, voffB);
            PG8_BAR; PG8_WAIT_L(0); PG8_MMA(0, 1, At, B1); PG8_BAR;
            PG8_LDA(At, 0, 1); PG8_STAGE(PG8_SA(0, 0), a2, voffA);
            PG8_BAR; PG8_WAIT_L(0); PG8_MMA(1, 0, At, B0); PG8_BAR; PG8_SCHED;
            PG8_STAGE(PG8_SB(0, 1), b2 + hstep, voffB);
            PG8_WAIT_V(6); PG8_BAR; PG8_MMA(1, 1, At, B1); PG8_BAR;
            PG8_LDB(B0, 1, 0); PG8_SCHED; PG8_LDA(At, 1, 0); PG8_STAGE(PG8_SA(0, 1), a2 + hstep, voffA);
            PG8_WAIT_L(8); PG8_BAR; PG8_WAIT_L(0); PG8_MMA(0, 0, At, B0); PG8_BAR; PG8_SCHED;
            PG8_LDB(B1, 1, 1); PG8_STAGE(PG8_SB(1, 0), b3, voffB);
            PG8_BAR; PG8_WAIT_L(0); PG8_MMA(0, 1, At, B1); PG8_BAR;
            PG8_LDA(At, 1, 1); PG8_STAGE(PG8_SA(1, 0), a3, voffA);
            PG8_BAR; PG8_WAIT_L(0); PG8_MMA(1, 0, At, B0); PG8_BAR; PG8_SCHED;
            PG8_STAGE(PG8_SB(1, 1), b3 + hstep, voffB);
            PG8_WAIT_V(6); PG8_BAR; PG8_MMA(1, 1, At, B1); PG8_BAR;
            }
        }
        if constexpr (ALIGN_EPI) { if (wr == 0) PG8_BAR; }
        if constexpr (!Epi::AFTER_DRAIN) { E(acc, cur, wr, wc, fr, fq); S.done(cur); }
        if (!has_next) break;
#pragma unroll
        for (int a = 0; a < 2; ++a)
#pragma unroll
            for (int b = 0; b < 2; ++b)
#pragma unroll
                for (int m = 0; m < 4; ++m)
#pragma unroll
                    for (int n = 0; n < 2; ++n) acc[a][b][m][n] = (f32x4){0.f, 0.f, 0.f, 0.f};
        cur = nxt; cA = nA; cB = nB; ++ui;
        if constexpr (ALIGN_EPI) { if (wr == 1) PG8_BAR; }
    }
    PG8_WAIT_V(0);
    if constexpr (!ALIGN_EPI) { if (wr == 0) PG8_BAR; }
    PG8_BAR;
    if constexpr (Epi::AFTER_DRAIN) { E.fused(acc, cur, wr, wc, fr, fq, lds, wid, lane); S.done(cur); }
#undef PG8_SA
#undef PG8_SB
#undef PG8_STAGE
#undef PG8_LDA
#undef PG8_LDB
#undef PG8_MMA
#undef PG8_WAIT_V
#undef PG8_WAIT_L
#undef PG8_BAR
#undef PG8_SCHED
}
struct Sched1 {
    int G, c;
    __device__ __forceinline__ void init(int G_, int c_) { G = G_; c = c_; }
    __device__ __forceinline__ bool next(int i, Unit& u) const {
        constexpr int nN = 21, nwg = 256 * nN;
        const int L = i * G + c;
        if (L < nwg) { const int wgid = (L % NXCD) * (nwg / NXCD) + L / NXCD; const int nig = WGM * nN, fm = (wgid / nig) * WGM;
            u.pm = fm + ((wgid % nig) % WGM); u.pn = (wgid % nig) / WGM; return true; }
        const int L2 = L - nwg; if (L2 >= 288) return false;
        const int wg = (L2 % NXCD) * 36 + L2 / NXCD; u.pn = wg >> 5; u.pm = 256 + (wg & 31); return true;
    }
    __device__ __forceinline__ void a_ready(const Unit&) const {}
    __device__ __forceinline__ void done(const Unit&) const {}
};
struct Sched2 {
    int G, c;
    __device__ __forceinline__ void init(int G_, int c_) { G = G_; c = c_; }
    __device__ __forceinline__ bool next(int i, Unit& u) const {
        constexpr int nN = 4, nwg = 256 * nN;
        const int L = i * G + c; if (L >= nwg) return false;
        const int wgid = (L % NXCD) * (nwg / NXCD) + L / NXCD; const int nig = WGM * nN, fm = (wgid / nig) * WGM;
        u.pm = fm + ((wgid % nig) % WGM); u.pn = (wgid % nig) / WGM; return true;
    }
    __device__ __forceinline__ void a_ready(const Unit&) const {}
    __device__ __forceinline__ void done(const Unit&) const {}
};
__device__ __forceinline__ float dot4(const f32x4 a) { return (a[0] * a[0] + a[1] * a[1]) + (a[2] * a[2] + a[3] * a[3]); }
__device__ __forceinline__ float silu1(float v) { return v * __builtin_amdgcn_rcpf(1.f + __expf(-v)); }
typedef unsigned u32x2 __attribute__((ext_vector_type(2)));
__device__ __forceinline__ u32x2 pk4(const f32x4 v) { u32x2 w; w.x = cvt_pk_bf16(v[0], v[1]); w.y = cvt_pk_bf16(v[2], v[3]); return w; }
struct Epi1 {
    static constexpr bool PERM = true, AFTER_DRAIN = false, MIDK = false;
    bf16_t *KB, *VB, *XBC, *YQ, *Z; float* DT; const float *rope, *qg, *kg, *dt_bias;
    __device__ __forceinline__ void midk(f32x4 (&)[2][2][4][2], int, int, int) const {}
    __device__ __forceinline__ void operator()(const f32x4 (&acc)[2][2][4][2], const Unit& u, int wr, int wc, int fr_in, int fq_in) const {
        int fr = fr_in, fq = fq_in; asm volatile("" : "+v"(fr), "+v"(fq));
        const int pn = u.pn, pm = u.pm; const bool isctx = pm >= 256; const int rloc = wr * 64 + fr;
        const int bb = isctx ? pm - 256 : pm >> 3, pos0 = isctx ? SEQ : (pm & 7) * 256;
        if (pn == 0 || (pn >= 9 && pn < 13)) {
            const float* g = pn == 0 ? kg : qg;
            const f32x4 g00 = *(const f32x4*)(g + 4 * fq), g01 = *(const f32x4*)(g + 16 + 4 * fq), g10 = *(const f32x4*)(g + 32 + 4 * fq), g11 = *(const f32x4*)(g + 48 + 4 * fq);
            const float osc = pn == 0 ? 1.f : C2;
            bf16_t* dbase; size_t pitch;
            if (pn == 0) { dbase = KB + ((size_t)bb * KVL + pos0) * 256 + wc * 64 + 4 * fq; pitch = 256; }
            else { dbase = YQ + (size_t)pm * 256 * 2048 + 1024 + ((pn - 9) * 4 + wc) * 64 + 4 * fq; pitch = 2048; }
#pragma unroll
            for (int ai = 0; ai < 2; ++ai) {
                const int prow = (pm & 7) * 4 + 2 * ai + wr;
                f32x4 c0 = (f32x4){1.f, 1.f, 1.f, 1.f}, s0 = (f32x4){0.f, 0.f, 0.f, 0.f};
                if (!isctx) { c0 = *(const f32x4*)(rope + prow * 16 + 4 * fq); s0 = *(const f32x4*)(rope + 1024 + prow * 16 + 4 * fq); }
#pragma unroll
                for (int m = 0; m < 4; ++m) {
                    f32x4 a0 = acc[ai][0][m][0], a1 = acc[ai][0][m][1], b0 = acc[ai][1][m][0], b1 = acc[ai][1][m][1];
                    float s = (dot4(a0) + dot4(a1)) + (dot4(b0) + dot4(b1));
                    s += __shfl_xor(s, 16); s += __shfl_xor(s, 32);
                    const float rstd = rsqrtf(s * (1.f / 64.f) + EPS) * osc;
                    a0 = a0 * rstd * g00; a1 = a1 * rstd * g01; b0 = b0 * rstd * g10; b1 = b1 * rstd * g11;
                    f32x4 c1 = (f32x4){1.f, 1.f, 1.f, 1.f}, s1 = (f32x4){0.f, 0.f, 0.f, 0.f};
                    if (!isctx) { const int pcol = 16 * m + fr; c1 = *(const f32x4*)(rope + pcol * 16 + 4 * fq); s1 = *(const f32x4*)(rope + 1024 + pcol * 16 + 4 * fq); }
                    const f32x4 o00 = a0 * c0 - a1 * s0, o01 = a1 * c0 + a0 * s0, o10 = b0 * c1 - b1 * s1, o11 = b1 * c1 + b0 * s1;
                    bf16_t* dst = dbase + (size_t)(rloc + 128 * ai + 16 * m) * pitch;
                    *(u32x2*)(dst) = pk4(o00); *(u32x2*)(dst + 16) = pk4(o01); *(u32x2*)(dst + 32) = pk4(o10); *(u32x2*)(dst + 48) = pk4(o11);
                    asm volatile("" ::: "memory");
                }
            }
        } else if (pn == 8) {
            if (wc == 0) {
                const f32x4 bA = *(const f32x4*)(dt_bias + 8 * fq), bB = *(const f32x4*)(dt_bias + 8 * fq + 4);
#pragma unroll
                for (int ai = 0; ai < 2; ++ai)
#pragma unroll
                    for (int m = 0; m < 4; ++m) { const size_t row = (size_t)pm * 256 + rloc + 128 * ai + 16 * m;
                        f32x4 v0 = acc[ai][0][m][0] + bA, v1 = acc[ai][0][m][1] + bB;
#pragma unroll
                        for (int e = 0; e < 4; ++e) { v0[e] = v0[e] > 20.f ? v0[e] : log1pf(__expf(v0[e])); v1[e] = v1[e] > 20.f ? v1[e] : log1pf(__expf(v1[e])); }
                        *(f32x4*)(DT + row * 32 + 8 * fq) = v0; *(f32x4*)(DT + row * 32 + 8 * fq + 4) = v1; asm volatile("" ::: "memory"); }
            }
        } else {
            bf16_t* dbase; size_t pitch; bool act = false;
            const int cin = wc * 32 + 8 * fq;
            if (pn == 1) { dbase = VB + ((size_t)bb * KVL + pos0) * 256 + cin; pitch = 256; }
            else if (pn < 8) { dbase = XBC + (size_t)pm * 256 * CONVC + (pn - 2) * 256 + cin; pitch = CONVC; }
            else if (pn < 17) { dbase = YQ + (size_t)pm * 256 * 2048 + (pn - 13) * 256 + cin; pitch = 2048; act = true; }
            else { dbase = Z + (size_t)pm * 256 * 1024 + (pn - 17) * 256 + cin; pitch = 1024; act = true; }
#pragma unroll
            for (int ai = 0; ai < 2; ++ai)
#pragma unroll
                for (int m = 0; m < 4; ++m) { bf16_t* dst = dbase + (size_t)(rloc + 128 * ai + 16 * m) * pitch;
#pragma unroll
                    for (int bj = 0; bj < 2; ++bj) { f32x4 v0 = acc[ai][bj][m][0], v1 = acc[ai][bj][m][1];
                        if (act) {
#pragma unroll
                            for (int e = 0; e < 4; ++e) { v0[e] = silu1(v0[e]); v1[e] = silu1(v1[e]); } }
                        u32x4 w; w.x = cvt_pk_bf16(v0[0], v0[1]); w.y = cvt_pk_bf16(v0[2], v0[3]); w.z = cvt_pk_bf16(v1[0], v1[1]); w.w = cvt_pk_bf16(v1[2], v1[3]);
                        *(u32x4*)(dst + bj * HALF) = w; } asm volatile("" ::: "memory"); }
        }
    }
};
struct Epi2 {
    static constexpr bool PERM = false, AFTER_DRAIN = false, MIDK = true;
    const float* x; const float* mod; const float* fg; float* out; unsigned long long* xbuf; unsigned* cnt; unsigned* tmo; const PG8_LAS float* rstd_tab; PG8_LAS float* exl;
    __device__ __forceinline__ void midk(f32x4 (&acc)[2][2][4][2], int ui, int wr, int fr) const {
#pragma unroll
        for (int ai = 0; ai < 2; ++ai)
#pragma unroll
            for (int m = 0; m < 4; ++m) { const float r = rstd_tab[ui * 256 + 128 * ai + 64 * wr + 16 * m + fr];
#pragma unroll
                for (int bj = 0; bj < 2; ++bj)
#pragma unroll
                    for (int n = 0; n < 2; ++n) acc[ai][bj][m][n] *= r; }
    }
    __device__ __forceinline__ void operator()(f32x4 (&acc)[2][2][4][2], const Unit& u, int wr, int wc, int fr_in, int fq_in) const {
        int fr = fr_in, fq = fq_in; asm volatile("" : "+v"(fr), "+v"(fq));
        const int tid = threadIdx.x, lane = tid & 63;
        const int b = u.pm >> 3, col0 = u.pn * BM + wc * 32 + 4 * fq;
        PG8_LAS float* P = exl; PG8_LAS float* S = exl + 1024;
        { f32x4 gv[2][2];
#pragma unroll
          for (int bj = 0; bj < 2; ++bj)
#pragma unroll
            for (int n = 0; n < 2; ++n) gv[bj][n] = *(const f32x4*)(mod + (size_t)b * 3072 + 2048 + col0 + bj * HALF + n * 16);
#pragma unroll
          for (int ai = 0; ai < 2; ++ai)
#pragma unroll
            for (int m = 0; m < 4; ++m) { const int rt = 128 * ai + 64 * wr + 16 * m + fr; const size_t off = ((size_t)u.pm * BM + rt) * 1024 + col0; float q = 0.f;
#pragma unroll
                for (int bj = 0; bj < 2; ++bj)
#pragma unroll
                    for (int n = 0; n < 2; ++n) { const f32x4 xv = *(const f32x4*)(x + off + bj * HALF + n * 16); const f32x4 o = xv + gv[bj][n] * acc[ai][bj][m][n]; acc[ai][bj][m][n] = o; q += dot4(o); }
                q += __shfl_xor(q, 16); q += __shfl_xor(q, 32);
                if (fq == 0) P[rt * 4 + wc] = q;
                if (m & 1) asm volatile("" ::: "memory"); } }
        asm volatile("s_waitcnt lgkmcnt(0)" ::: "memory"); __builtin_amdgcn_s_barrier(); asm volatile("" ::: "memory");
        if (tid < 256) {
            const f32x4 p = *(const PG8_LAS f32x4*)(P + tid * 4); const float s = (p[0] + p[1]) + (p[2] + p[3]);
            __hip_atomic_store((float*)xbuf + ((size_t)u.pm * BM + tid) * 4 + u.pn, s, __ATOMIC_RELAXED, __HIP_MEMORY_SCOPE_AGENT);
        }
        asm volatile("s_waitcnt vmcnt(0)" ::: "memory");
        if (tid < 256 && lane == 0) __hip_atomic_fetch_add(cnt + 64 * u.pm, 1u, __ATOMIC_RELAXED, __HIP_MEMORY_SCOPE_AGENT);
        if (tid < 64) {
            unsigned sp = 0;
            while ((unsigned)__builtin_amdgcn_readfirstlane(__hip_atomic_load(cnt + 64 * u.pm, __ATOMIC_RELAXED, __HIP_MEMORY_SCOPE_AGENT)) < 16u) {
                __builtin_amdgcn_s_sleep(2); if (++sp > (1u << 22)) { if (lane == 0) __hip_atomic_store(tmo, 1u, __ATOMIC_RELAXED, __HIP_MEMORY_SCOPE_AGENT); break; } }
        }
        asm volatile("s_waitcnt vmcnt(0) lgkmcnt(0)" ::: "memory"); __builtin_amdgcn_s_barrier(); asm volatile("" ::: "memory");
        if (tid < 256) {
            const unsigned long long* sl = xbuf + ((size_t)u.pm * BM + tid) * 2;
            const unsigned long long w0 = __hip_atomic_load(sl, __ATOMIC_RELAXED, __HIP_MEMORY_SCOPE_AGENT), w1 = __hip_atomic_load(sl + 1, __ATOMIC_RELAXED, __HIP_MEMORY_SCOPE_AGENT);
            const float s = (__uint_as_float((unsigned)w0) + __uint_as_float((unsigned)(w0 >> 32))) + (__uint_as_float((unsigned)w1) + __uint_as_float((unsigned)(w1 >> 32)));
            S[tid] = rsqrtf(s * (1.f / 1024.f) + EPS);
        }
        asm volatile("s_waitcnt lgkmcnt(0)" ::: "memory"); __builtin_amdgcn_s_barrier(); asm volatile("" ::: "memory");
        { f32x4 fv[2][2];
#pragma unroll
          for (int bj = 0; bj < 2; ++bj)
#pragma unroll
            for (int n = 0; n < 2; ++n) fv[bj][n] = *(const f32x4*)(fg + col0 + bj * HALF + n * 16);
#pragma unroll
          for (int ai = 0; ai < 2; ++ai)
#pragma unroll
            for (int m = 0; m < 4; ++m) { const int rt = 128 * ai + 64 * wr + 16 * m + fr; const size_t off = ((size_t)u.pm * BM + rt) * 1024 + col0; const float r = S[rt];
#pragma unroll
                for (int bj = 0; bj < 2; ++bj)
#pragma unroll
                    for (int n = 0; n < 2; ++n) *(f32x4*)(out + off + bj * HALF + n * 16) = acc[ai][bj][m][n] * r * fv[bj][n];
                if (m & 1) asm volatile("" ::: "memory"); } }
    }
};
}
#define GAS __attribute__((address_space(1)))
#define LAS __attribute__((address_space(3)))
typedef unsigned v4u __attribute__((ext_vector_type(4)));
typedef GAS unsigned gu32;
typedef GAS unsigned long long gu64;
#define RLX_AGENT __ATOMIC_RELAXED, __HIP_MEMORY_SCOPE_AGENT
#define LDS_WAIT() asm volatile("s_waitcnt lgkmcnt(0)" ::: "memory")
#define VM_WAIT() asm volatile("s_waitcnt vmcnt(0)" ::: "memory")
__device__ __forceinline__ unsigned long long rt() { return __builtin_amdgcn_s_memrealtime(); }
typedef float f32x2_pk __attribute__((ext_vector_type(2))); typedef __bf16 bf16x2_pk __attribute__((ext_vector_type(2)));
__device__ __forceinline__ unsigned pk2(float lo, float hi) { const f32x2_pk v = {lo, hi}; return __builtin_bit_cast(unsigned, __builtin_convertvector(v, bf16x2_pk)); }
#define XB_TMO      128
#define XB_XCNT(j)  (256  + 64 * (j))
#define XB_XSUB(j)  (1280 + 64 * (j))
#define XB_XGEN(j)  (2304 + 64 * (j))
#define XB_TOP      3328
#define XB_TOPGEN   3392
#define XCD_BAR_WORDS 3456
#define XB_SPIN_CAP (1u << 22)

__device__ __forceinline__ unsigned xb_ld(unsigned* p)              { return __hip_atomic_load(p, __ATOMIC_RELAXED, __HIP_MEMORY_SCOPE_AGENT); }
__device__ __forceinline__ unsigned xb_add(unsigned* p, unsigned v) { return __hip_atomic_fetch_add(p, v, __ATOMIC_RELAXED, __HIP_MEMORY_SCOPE_AGENT); }
__device__ __forceinline__ unsigned xb_xcc_id() { return (unsigned)__builtin_amdgcn_s_getreg((3 << 11) | 20) & 0xFu; }
#define XB_SPIN(cond, bar) do { unsigned _sp = 0; while (cond) { __builtin_amdgcn_s_sleep(1); \
    if ((++_sp & 255u) == 0u) { if (xb_ld(&(bar)[XB_TMO])) break; if (_sp > XB_SPIN_CAP) { atomicAdd(&(bar)[XB_TMO], 1u); break; } } } } while (0)

struct XcdBarrier {
    unsigned* bar; unsigned x;
    volatile LAS unsigned* st;
};

__device__ __forceinline__ XcdBarrier xcd_barrier_post(unsigned* bar, volatile LAS unsigned* st) {
    XcdBarrier b; b.bar = bar; b.x = xb_xcc_id(); b.st = st;
    if (threadIdx.x == 0) (void)xb_add(&bar[XB_XCNT(b.x)], 1u);
    return b;
}
__device__ __forceinline__ void xcd_barrier_complete(unsigned* bar, unsigned x, unsigned& nloc, unsigned& nx) {
    const unsigned G = gridDim.x * gridDim.y * gridDim.z;
    unsigned sum, cnt, mine, sp = 0u;
    for (;;) {
        sum = 0u; cnt = 0u; mine = 0u;
#pragma unroll
        for (unsigned j = 0; j < 16; ++j) { const unsigned c = xb_ld(&bar[XB_XCNT(j)]); sum += c; cnt += (c > 0u) ? 1u : 0u; mine = (j == x) ? c : mine; }
        if (sum == G) break;
        __builtin_amdgcn_s_sleep(1);
        if ((++sp & 255u) == 0u) { if (xb_ld(&bar[XB_TMO])) break; if (sp > XB_SPIN_CAP) { atomicAdd(&bar[XB_TMO], 1u); break; } }
    }
    nloc = mine > 0u ? mine : 1u; nx = cnt > 0u ? cnt : 1u;
}

__device__ __forceinline__ void xcd_barrier(const XcdBarrier& b) {
    asm volatile("s_waitcnt vmcnt(0)" ::: "memory");
    __syncthreads();
    if (threadIdx.x == 0) {
        unsigned* bar = b.bar;
        __builtin_amdgcn_s_waitcnt(0);
        unsigned nloc = b.st[0], nx = b.st[1];
        if (nloc == 0u) { xcd_barrier_complete(bar, b.x, nloc, nx); b.st[0] = nloc; b.st[1] = nx; }
        const unsigned old = xb_add(&bar[XB_XSUB(b.x)], 1u);
        const unsigned gen = old / nloc;
        if (old + 1u == (gen + 1u) * nloc) {
            __builtin_amdgcn_fence(__ATOMIC_RELEASE, "agent");
            asm volatile("s_waitcnt vmcnt(0)" ::: "memory");
            const unsigned og = xb_add(&bar[XB_TOP], 1u);
            const unsigned tg = og / nx;
            if (og + 1u == (tg + 1u) * nx) xb_add(&bar[XB_TOPGEN], 1u);
            else XB_SPIN(xb_ld(&bar[XB_TOPGEN]) == tg, bar);
            __builtin_amdgcn_fence(__ATOMIC_ACQUIRE, "agent");
            xb_add(&bar[XB_XGEN(b.x)], 1u);
            asm volatile("s_waitcnt vmcnt(0)" ::: "memory");
        } else {
            XB_SPIN(xb_ld(&bar[XB_XGEN(b.x)]) == gen, bar);
            __builtin_amdgcn_fence(__ATOMIC_ACQUIRE, "agent");
            asm volatile("s_waitcnt vmcnt(0)" ::: "memory");
        }
    }
    __syncthreads();
}

typedef float f32x4 __attribute__((ext_vector_type(4)));
constexpr int NWAVES = 8;
__device__ __forceinline__ float wave_sum(float v) {
#pragma unroll
    for (int o = 1; o < 64; o <<= 1) v += __shfl_xor(v, o);
    return v;
}
__device__ __forceinline__ float dot4g(const f32x4 a) { return (a[0] * a[0] + a[1] * a[1]) + (a[2] * a[2] + a[3] * a[3]); }
__device__ __forceinline__ void p0_bt1_item(const float* W, bf16* WT, LAS float* scr, int item, int lane) {
    const int kb = item / 168, vb = item % 168, k0 = 64 * kb, v0 = 32 * vb;
    const int a = vcol_actual(v0 + (lane & 31));
#pragma unroll 8
    for (int i = 0; i < 32; ++i) { const int kk = 2 * i + (lane >> 5); scr[kk * 33 + (lane & 31)] = a >= 0 ? W[(size_t)(k0 + kk) * PROJ + a] : 0.f; }
    LDS_WAIT(); asm volatile("" ::: "memory");
    const int c = lane & 7;
#pragma unroll
    for (int j = 0; j < 4; ++j) { const int n = (lane >> 3) + 8 * j; const LAS float* s = scr + (8 * c) * 33 + n;
        v4u o; o.x = pk2(s[0 * 33], s[1 * 33]); o.y = pk2(s[2 * 33], s[3 * 33]); o.z = pk2(s[4 * 33], s[5 * 33]); o.w = pk2(s[6 * 33], s[7 * 33]);
        *(GAS v4u*)(WT + (size_t)(v0 + n) * 1024 + k0 + 8 * c) = o; }
    LDS_WAIT(); asm volatile("" ::: "memory");
}
__device__ __forceinline__ void p0_bt2_item(const float* W, const float* sg, bf16* WT, LAS float* scr, int item, int lane) {
    const int kb = item >> 5, nb = item & 31, kk0 = 64 * kb, n0 = 32 * nb;
#pragma unroll 8
    for (int i = 0; i < 32; ++i) { const int kk = 2 * i + (lane >> 5), kq = kk0 + kk; const int ks = kq < 1024 ? 1024 + kq : kq - 1024;
        float v = W[(size_t)ks * 1024 + n0 + (lane & 31)]; if (kq < 1024) v *= sg[kq]; scr[kk * 33 + (lane & 31)] = v; }
    LDS_WAIT(); asm volatile("" ::: "memory");
    const int c = lane & 7;
#pragma unroll
    for (int j = 0; j < 4; ++j) { const int n = (lane >> 3) + 8 * j; const LAS float* s = scr + (8 * c) * 33 + n;
        v4u o; o.x = pk2(s[0 * 33], s[1 * 33]); o.y = pk2(s[2 * 33], s[3 * 33]); o.z = pk2(s[4 * 33], s[5 * 33]); o.w = pk2(s[6 * 33], s[7 * 33]);
        *(GAS v4u*)(WT + (size_t)(n0 + n) * 2048 + kk0 + 8 * c) = o; }
    LDS_WAIT(); asm volatile("" ::: "memory");
}
__device__ __forceinline__ void p0_mod_block(const float* c, const float* c_ctx, const float* ada_w, const float* ada_b, float* mod, LAS float* ldsf, int cb, int tid, int lane, int wave) {
    LAS float* sil = ldsf; LAS float* red = ldsf + 33 * 256;
    float acc[33];
#pragma unroll
    for (int b = 0; b < 33; ++b) acc[b] = 0.f;
    for (int q = 0; q < 4; ++q) {
        __syncthreads();
        for (int e = tid; e < 33 * 256; e += NWAVES * 64) { const int b = e >> 8, k = e & 255; const float v = b < 32 ? c[b * 1024 + q * 256 + k] : c_ctx[q * 256 + k]; sil[e] = siluf(v); }
        __syncthreads();
        for (int kk = 0; kk < 32; ++kk) { const int kl = wave * 32 + kk; const float w = ada_w[(size_t)(q * 256 + kl) * 3072 + cb * 64 + lane];
#pragma unroll
            for (int b = 0; b < 33; ++b) acc[b] += sil[b * 256 + kl] * w; }
    }
#pragma unroll
    for (int b = 0; b < 33; ++b) red[(wave * 33 + b) * 64 + lane] = acc[b];
    __syncthreads();
    for (int e = tid; e < 33 * 64; e += NWAVES * 64) { const int b = e >> 6, col = e & 63; float s = 0.f;
#pragma unroll
        for (int w = 0; w < 8; ++w) s += red[(w * 33 + b) * 64 + col];
        mod[b * 3072 + cb * 64 + col] = s + ada_b[cb * 64 + col]; }
    __syncthreads();
}
__device__ __forceinline__ void p1_norm_row(const float* xrow, const float* md, const float* ng, bf16* orow, int lane) {
    const GAS f32x4* xr = (const GAS f32x4*)xrow + lane;
    f32x4 v[4]; float s = 0.f;
#pragma unroll
    for (int j = 0; j < 4; ++j) { v[j] = xr[64 * j]; s += dot4g(v[j]); }
    const float rstd = rsqrtf(wave_sum(s) * (1.f / DM) + EPS);
    GAS unsigned long long* o8 = (GAS unsigned long long*)orow + lane;
#pragma unroll
    for (int j = 0; j < 4; ++j) { const int k = 4 * lane + 256 * j;
        const f32x4 g = *(const f32x4*)(ng + k), sc = *(const f32x4*)(md + 1024 + k), sh = *(const f32x4*)(md + k);
        const f32x4 h = v[j] * rstd * g * (sc + 1.f) + sh;
        o8[64 * j] = (unsigned long long)pk2(h[0], h[1]) | ((unsigned long long)pk2(h[2], h[3]) << 32); }
}
__device__ __forceinline__ void conv_phase(const bf16* XBC, const float* cw, const float* cb, bf16* XC, int bx, int G, int tid) {
    if (tid < 384) {
        const int cg = tid % 192, sub = tid / 192;
        f32x4 w[5][2], bias[2];
#pragma unroll
        for (int j = 0; j < 5; ++j) { w[j][0] = *(const f32x4*)(cw + j * CONVC + cg * 8); w[j][1] = *(const f32x4*)(cw + j * CONVC + cg * 8 + 4); }
        bias[0] = *(const f32x4*)(cb + cg * 8); bias[1] = *(const f32x4*)(cb + cg * 8 + 4);
        for (int seg = bx; seg < MT / 32; seg += G) {
            const int row0 = seg * 32 + sub * 16; int t0, len;
            if (row0 < ML) { t0 = row0 % SEQ; len = SEQ; } else { t0 = (row0 - ML) % CTXL; len = CTXL; }
            const bf16* src = XBC + (size_t)row0 * CONVC + cg * 8; bf16* dst = XC + (size_t)row0 * CONVC + cg * 8;
            f32x4 r[5][2];
#pragma unroll
            for (int j = 0; j < 5; ++j) { const int tt = t0 + j - 2; v4u u = (v4u){0u, 0u, 0u, 0u};
                if (tt >= 0 && tt < len) u = *(const v4u*)(src + (ptrdiff_t)(j - 2) * CONVC);
                r[j][0] = (f32x4){__uint_as_float(u.x << 16), __uint_as_float(u.x & 0xffff0000u), __uint_as_float(u.y << 16), __uint_as_float(u.y & 0xffff0000u)};
                r[j][1] = (f32x4){__uint_as_float(u.z << 16), __uint_as_float(u.z & 0xffff0000u), __uint_as_float(u.w << 16), __uint_as_float(u.w & 0xffff0000u)}; }
#pragma unroll
            for (int i = 0; i < 16; ++i) {
                f32x4 a0 = bias[0], a1 = bias[1];
#pragma unroll
                for (int j = 0; j < 5; ++j) { a0 += w[j][0] * r[j][0]; a1 += w[j][1] * r[j][1]; }
#pragma unroll
                for (int e = 0; e < 4; ++e) { a0[e] = siluf(a0[e]); a1[e] = siluf(a1[e]); }
                v4u o; o.x = pk2(a0[0], a0[1]); o.y = pk2(a0[2], a0[3]); o.z = pk2(a1[0], a1[1]); o.w = pk2(a1[2], a1[3]);
                *(v4u*)(dst + (size_t)i * CONVC) = o;
#pragma unroll
                for (int j = 0; j < 4; ++j) { r[j][0] = r[j + 1][0]; r[j][1] = r[j + 1][1]; }
                const int tt = t0 + i + 3; v4u u = (v4u){0u, 0u, 0u, 0u};
                if (i < 15 && tt < len) u = *(const v4u*)(src + (size_t)(i + 3) * CONVC);
                r[4][0] = (f32x4){__uint_as_float(u.x << 16), __uint_as_float(u.x & 0xffff0000u), __uint_as_float(u.y << 16), __uint_as_float(u.y & 0xffff0000u)};
                r[4][1] = (f32x4){__uint_as_float(u.z << 16), __uint_as_float(u.z & 0xffff0000u), __uint_as_float(u.w << 16), __uint_as_float(u.w & 0xffff0000u)};
            }
        }
    }
}
__device__ __forceinline__ void ssd_item_naive(int b, int h, const bf16* XC, const float* DT, const bf16* Z, const float* a_log, const float* d_skip, bf16* YQ, float* SSQ, LAS float* ysq, int tid) {
    const int p = tid >> 3, nc = tid & 7, g = h >> 3;
    for (int dd = 0; dd < 2; ++dd) { const int d = 1 - dd;
        const float a_neg = -expf(a_log[d * 16 + h]);
        float S[16];
#pragma unroll
        for (int j = 0; j < 16; ++j) S[j] = 0.f;
        for (int seq = 0; seq < 2; ++seq) { const int len = seq == 0 ? CTXL : SEQ; const size_t rbase = seq == 0 ? (size_t)ML + (size_t)b * CTXL : (size_t)b * SEQ;
            for (int st = 0; st < len; ++st) { const int t = d ? len - 1 - st : st; const size_t row = rbase + t;
                const float dt = DT[row * 32 + d * 16 + h]; const float dec = expf(dt * a_neg);
                const float xs = bf2f(XC[row * CONVC + h * 64 + p]); const float X = xs * dt;
                const v4u b0 = *(const v4u*)(XC + row * CONVC + 1024 + g * 128 + nc * 16), b1 = *(const v4u*)(XC + row * CONVC + 1024 + g * 128 + nc * 16 + 8);
                const v4u c0 = *(const v4u*)(XC + row * CONVC + 1280 + g * 128 + nc * 16), c1 = *(const v4u*)(XC + row * CONVC + 1280 + g * 128 + nc * 16 + 8);
                const unsigned bw[8] = {b0.x, b0.y, b0.z, b0.w, b1.x, b1.y, b1.z, b1.w}, cw8[8] = {c0.x, c0.y, c0.z, c0.w, c1.x, c1.y, c1.z, c1.w};
                float y = 0.f;
#pragma unroll
                for (int j = 0; j < 8; ++j) { S[2 * j] = S[2 * j] * dec + X * __uint_as_float(bw[j] << 16); y += __uint_as_float(cw8[j] << 16) * S[2 * j];
                    S[2 * j + 1] = S[2 * j + 1] * dec + X * __uint_as_float(bw[j] & 0xffff0000u); y += __uint_as_float(cw8[j] & 0xffff0000u) * S[2 * j + 1]; }
                y += __shfl_xor(y, 1); y += __shfl_xor(y, 2); y += __shfl_xor(y, 4);
                if (seq == 1) {
                    bf16* yp = YQ + row * 2048 + h * 64 + p;
                    if (d == 1) { if (nc == 0) *yp = (bf16)f2bf(y); }
                    else {
                        if (nc == 0) { const float yt = y + bf2f(*yp) + d_skip[h] * xs; const float yg = yt * bf2f(Z[row * 1024 + h * 64 + p]); *yp = (bf16)f2bf(yg); ysq[p] = yg * yg; }
                        __syncthreads();
                        if (tid < 64) { float q = ysq[tid]; q = wave_sum(q); if (tid == 0) SSQ[row * 16 + h] = q; }
                        __syncthreads();
                    }
                }
            }
        }
        VM_WAIT(); __syncthreads();
    }
}

namespace attn_body {
using bf16=__hip_bfloat16;
using bf16x8=__attribute__((ext_vector_type(8)))short;
using s16x4=__attribute__((ext_vector_type(4)))short;
using f32x16=__attribute__((ext_vector_type(16)))float;
using u32x4=__attribute__((ext_vector_type(4)))unsigned;
constexpr int D=64,QP=2048,KP=256;
constexpr int NW=8,QBLK=32,QB=QBLK*NW,KVBLK=64,NQB=SEQ/QB;
constexpr int ATTN_UNIT_ROWS=QB;
__device__ __forceinline__ int crow(int r,int hi){return (r&3)+8*(r>>2)+4*hi;}
#define SBAR() __builtin_amdgcn_sched_barrier(0)
__device__ __forceinline__ void cmask(f32x16&p0,f32x16&p1,int jb,int qrel,int hi){
  const float NEG=-INFINITY; int kb=64*jb+4*hi;
  #pragma unroll
  for(int r=0;r<16;++r){int kv=kb+(r&3)+8*(r>>2); if(kv>qrel)p0[r]=NEG; if(kv+32>qrel)p1[r]=NEG;}
}

constexpr int NSLOT=3, SLOTB=8192;
constexpr int LDS_K=0, LDS_V=NSLOT*SLOTB, LDS_WS=2*NSLOT*SLOTB, LDS_OST=LDS_WS+NW*64*4, LDS_BYTES=LDS_OST+NW*8192;
constexpr float C2=0.125f*1.4426950408889634f;
__device__ __forceinline__ void glds16(const void*gsrc,unsigned lds_dst){unsigned keep;
  asm volatile("s_mov_b32 %0, m0\n\ts_mov_b32 m0, %2\n\ts_nop 0\n\tglobal_load_lds_dwordx4 %1, off\n\ts_mov_b32 m0, %0":"=&s"(keep):"v"(gsrc),"s"(lds_dst):"memory");}
__device__ __forceinline__ float max3f(float a,float b,float c){float r;asm("v_max3_f32 %0, %1, %2, %3":"=v"(r):"v"(a),"v"(b),"v"(c));return r;}
__device__ __forceinline__ float max2f(float a,float b){float r;asm("v_max_f32_e32 %0, %1, %2":"=v"(r):"v"(a),"v"(b));return r;}
__device__ __forceinline__ float fadd_s(float a,float b){float r;asm("v_add_f32_e32 %0, %1, %2":"=v"(r):"v"(a),"v"(b));return r;}
__device__ __forceinline__ float fsub_s(float a,float b){float r;asm("v_sub_f32_e32 %0, %1, %2":"=v"(r):"v"(a),"v"(b));return r;}
typedef float f32x2_t __attribute__((ext_vector_type(2))); typedef float f32x4_t __attribute__((ext_vector_type(4))); typedef __bf16 bf16x2_t __attribute__((ext_vector_type(2)));
__device__ __forceinline__ unsigned cvtpk_s(float lo,float hi){f32x2_t v={lo,hi};bf16x2_t b=__builtin_convertvector(v,bf16x2_t);return __builtin_bit_cast(unsigned,b);}
#define WAIT_BAR(N) asm volatile("s_waitcnt vmcnt(" #N ") lgkmcnt(0)\n\ts_barrier":::"memory")

__device__ __forceinline__ void qkt(f32x16&p0,f32x16&p1,const char*Kslot,const bf16x8*qr,const f32x16&negm,int r32,int hi){
  const char*kb=Kslot+hi*1024+r32*16;
  #pragma unroll
  for(int d0=0;d0<4;++d0){
    const bf16x8 b0=*reinterpret_cast<const bf16x8*>(kb+d0*2048);
    const bf16x8 b1=*reinterpret_cast<const bf16x8*>(kb+d0*2048+512);
    if(d0==0){p0=__builtin_amdgcn_mfma_f32_32x32x16_bf16(b0,qr[0],negm,0,0,0);p1=__builtin_amdgcn_mfma_f32_32x32x16_bf16(b1,qr[0],negm,0,0,0);}
    else{p0=__builtin_amdgcn_mfma_f32_32x32x16_bf16(b0,qr[d0],p0,0,0,0);p1=__builtin_amdgcn_mfma_f32_32x32x16_bf16(b1,qr[d0],p1,0,0,0);}}
}
typedef __attribute__((address_space(3))) const char* lds_cptr;
typedef short v4i16_t __attribute__((ext_vector_type(4)));
__device__ __forceinline__ void kload8(bf16x8*kf,lds_cptr kp){
  kf[0]=*(const __attribute__((address_space(3))) bf16x8*)(kp);      kf[1]=*(const __attribute__((address_space(3))) bf16x8*)(kp+512);
  kf[2]=*(const __attribute__((address_space(3))) bf16x8*)(kp+2048); kf[3]=*(const __attribute__((address_space(3))) bf16x8*)(kp+2560);
  kf[4]=*(const __attribute__((address_space(3))) bf16x8*)(kp+4096); kf[5]=*(const __attribute__((address_space(3))) bf16x8*)(kp+4608);
  kf[6]=*(const __attribute__((address_space(3))) bf16x8*)(kp+6144); kf[7]=*(const __attribute__((address_space(3))) bf16x8*)(kp+6656);
}
__device__ __forceinline__ void kload2(bf16x8*kf,lds_cptr kp,int j){ kf[2*j]=*(const __attribute__((address_space(3))) bf16x8*)(kp+j*2048); kf[2*j+1]=*(const __attribute__((address_space(3))) bf16x8*)(kp+j*2048+512); }
__device__ __forceinline__ s16x4 vtr(lds_cptr p){ return __builtin_bit_cast(s16x4,__builtin_amdgcn_ds_read_tr16_b64_v4i16((__attribute__((address_space(3))) v4i16_t*)p)); }
__device__ __forceinline__ float rowmax(const f32x16&p0,const f32x16&p1){
  float a=max3f(p0[0],p0[1],p1[0]),b=max3f(p0[2],p0[3],p1[1]);a=max3f(a,p1[2],p1[3]);
  #pragma unroll
  for(int r=4;r<16;r+=4){a=max3f(a,p0[r],p0[r+1]);b=max3f(b,p0[r+2],p0[r+3]);a=max3f(a,p1[r],p1[r+1]);b=max3f(b,p1[r+2],p1[r+3]);}
  const float m=max2f(a,b);
  auto rr=__builtin_amdgcn_permlane32_swap(__float_as_uint(m),__float_as_uint(m),false,false);
  return max2f(__uint_as_float(rr[0]),__uint_as_float(rr[1]));
}
__device__ __forceinline__ void pv(f32x16*o,int vb,bf16x8 pa0,bf16x8 pa1,bf16x8 pa2,bf16x8 pa3){
  #pragma unroll
  for(int d0=0;d0<2;++d0){s16x4 lo[4],hi[4];
    #pragma unroll
    for(int ks=0;ks<4;++ks){
      asm volatile("ds_read_b64_tr_b16 %0,%1 offset:%c2":"=&v"(lo[ks]):"v"(vb),"i"(d0*4096+ks*1024):"memory");
      asm volatile("ds_read_b64_tr_b16 %0,%1 offset:%c2":"=&v"(hi[ks]):"v"(vb),"i"(d0*4096+ks*1024+512):"memory");}
    asm volatile("s_waitcnt lgkmcnt(0)":::"memory");SBAR();
    #define PK(k) (bf16x8){lo[k][0],lo[k][1],lo[k][2],lo[k][3],hi[k][0],hi[k][1],hi[k][2],hi[k][3]}
    o[d0]=__builtin_amdgcn_mfma_f32_32x32x16_bf16(pa0,PK(0),o[d0],0,0,0);
    o[d0]=__builtin_amdgcn_mfma_f32_32x32x16_bf16(pa1,PK(1),o[d0],0,0,0);
    o[d0]=__builtin_amdgcn_mfma_f32_32x32x16_bf16(pa2,PK(2),o[d0],0,0,0);
    o[d0]=__builtin_amdgcn_mfma_f32_32x32x16_bf16(pa3,PK(3),o[d0],0,0,0);
    #undef PK
  }
}

#ifndef ATTN_STORE16
#define ATTN_STORE16(p,v) (*(u32x4*)(p)=(v))
#endif
template<int THRL> __device__ __forceinline__ void attn_unit(int b,int h,int qb,bf16*YQb,const bf16*__restrict__ K,const bf16*__restrict__ V,char*shm,bf16*dummyO=nullptr){
  const int tid=threadIdx.x,lane=tid&63,r32=lane&31,hi=lane>>5; const int wid=__builtin_amdgcn_readfirstlane(tid>>6);
  const long rowbase=(long)b*SEQ; const int q0=qb*QB;
  const bf16*Qw=YQb+(rowbase+q0+wid*QBLK)*QP+1024+h*D;
  const bf16*Kh=K+(long)b*KVL*KP+(h>>2)*D,*Vh=V+(long)b*KVL*KP+(h>>2)*D;
  const unsigned lds0=(unsigned)(uintptr_t)shm;
  float*wsf=(float*)(shm+LDS_WS)+wid*64;
  const bf16*ksrc=Kh+(long)lane*KP+wid*8;
  const bf16*vsrc=Vh+(long)(16*(wid&3)+(lane>>2))*KP+(wid>>2)*32+(lane&3)*8;
  const unsigned kdst=lds0+LDS_K+wid*1024, vdst=lds0+LDS_V+wid*1024;
  #define DMA_K(t,slot) glds16(ksrc+(long)(t)*KVBLK*KP,(unsigned)__builtin_amdgcn_readfirstlane(kdst+(slot)))
  #define DMA_V(t,slot) glds16(vsrc+(long)(t)*KVBLK*KP,(unsigned)__builtin_amdgcn_readfirstlane(vdst+(slot)))
  const int vb0=(int)(lds0+LDS_V)+((lane>>4)&1)*32+(lane&3)*8+(4*hi+((lane&15)>>2))*64;
  const char*Kbase=shm+LDS_K; bf16x8 kf[8];
  const lds_cptr shm3=(lds_cptr)shm; const lds_cptr kp0=shm3+LDS_K+hi*1024+r32*16; const lds_cptr vp0=shm3+LDS_V+((lane>>4)&1)*32+(lane&3)*8+(4*hi+((lane&15)>>2))*64;
  constexpr int NT=KVL/KVBLK;
  DMA_K(0,0);DMA_V(0,0);DMA_K(1,SLOTB);
  bf16x8 qr[4];
  #pragma unroll
  for(int d0=0;d0<4;++d0)qr[d0]=*reinterpret_cast<const bf16x8*>(&Qw[(long)r32*QP+d0*16+hi*8]);
  float mhat=0.f,l_reg=0.f;f32x16 o[2];o[0]=f32x16{};o[1]=f32x16{};f32x16 negm=f32x16{};asm volatile("":"+v"(negm));
  #define CMASK(P0,P1,t) do{}while(0)
  bool resc=false;
  #define START(P0,P1) do{ const float rm=rowmax(P0,P1); resc=false; \
    { const float dl=rm; mhat=fadd_s(mhat,dl); \
      _Pragma("unroll") for(int r=0;r<16;++r){P0[r]=fsub_s(P0[r],dl);P1[r]=fsub_s(P1[r],dl);} \
      _Pragma("unroll") for(int r=0;r<16;++r)negm[r]=-mhat; asm volatile("":"+v"(negm)); } \
    _Pragma("unroll") for(int r=0;r<16;++r)P0[r]=__builtin_amdgcn_exp2f(P0[r]); }while(0)
  #define RESC() do{ if(resc){ asm volatile("s_waitcnt lgkmcnt(0)":::"memory"); \
      _Pragma("unroll") for(int d_=0;d_<2;++d_) _Pragma("unroll") for(int r=0;r<16;++r)o[d_][r]*=wsf[crow(r,hi)]; } }while(0)
  f32x16 pA0,pA1,pB0,pB1;
  int sl_prev=0,sl_cur=0,sl_next=SLOTB;
  #define ROT() do{sl_prev=sl_cur;sl_cur=sl_next;sl_next=(sl_next==(NSLOT-1)*SLOTB)?0:sl_next+SLOTB;}while(0)
  DMA_K(2,2*SLOTB);
  WAIT_BAR(3);
  qkt(pA0,pA1,Kbase,qr,negm,r32,hi);asm volatile("s_nop 15\n\ts_nop 7":"+v"(pA0),"+v"(pA1));CMASK(pA0,pA1,0);
  START(pA0,pA1);
  _Pragma("unroll") for(int r=0;r<16;++r)pA1[r]=__builtin_amdgcn_exp2f(pA1[r]);
  WAIT_BAR(0);
  DMA_K(3,0);DMA_V(1,SLOTB);
  ROT();
  kload8(kf,kp0+sl_cur);
  WAIT_BAR(2);
  s16x4 vlo[8],vhi[8]; u32x4 pw0,pw1,pw2,pw3;
  #define PKW(P,B) cvtpk_s(P[B],P[B+1])
  #define PAF(k) __builtin_bit_cast(bf16x8,pw##k)
  #define VFR(i) (bf16x8){vlo[i][0],vlo[i][1],vlo[i][2],vlo[i][3],vhi[i][0],vhi[i][1],vhi[i][2],vhi[i][3]}
  #define PIN(x) asm volatile("":"+v"(x))
  #define MX3(a,b,c) __builtin_fmaxf(__builtin_fmaxf((a),(b)),(c))
  #define GAPA(MF,A0,A1,A2,A3,W0,W1,PW) do{ MF; sacc+=A0; sacc+=A1; sacc+=A2; sacc+=A3; PIN(sacc); W0; W1; PIN(PW); SBAR(); }while(0)
  #define EX(v) __builtin_amdgcn_exp2f(v)
  #define GAPB(MF,X,B) do{ MF; X[B]=EX(X[B]); X[B+1]=EX(X[B+1]); X[B+2]=EX(X[B+2]); X[B+3]=EX(X[B+3]); PIN(X); SBAR(); }while(0)
  #define VRD(i) do{ vlo[i]=vtr(vp_+(((i)>>2)*4096+((i)&3)*1024)); vhi[i]=vtr(vp_+(((i)>>2)*4096+((i)&3)*1024+512)); }while(0)
  #define KRD(G,j) do{ if(G){ kload2(kf,kp0+sl_next,j); SBAR(); } }while(0)
  #define STEP(C0,C1,P0,P1,t,GK,GV,GL) do{ SBAR(); \
    const lds_cptr vp_=vp0+sl_prev; \
    VRD(0); SBAR(); float sacc=(P0[0]+P0[1]); \
    GAPA(C0=__builtin_amdgcn_mfma_f32_32x32x16_bf16(kf[0],qr[0],negm,0,0,0), P0[2],P0[3],P0[4],P0[5],     pw0[0]=PKW(P0,0), pw0[1]=PKW(P0,2), pw0); \
    VRD(4); SBAR(); GAPA(C1=__builtin_amdgcn_mfma_f32_32x32x16_bf16(kf[1],qr[0],negm,0,0,0), P0[6],P0[7],P0[8],P0[9],     pw0[2]=PKW(P0,4), pw0[3]=PKW(P0,6), pw0); \
    VRD(1); SBAR(); GAPA(C0=__builtin_amdgcn_mfma_f32_32x32x16_bf16(kf[2],qr[1],C0,0,0,0),   P0[10],P0[11],P0[12],P0[13], pw1[0]=PKW(P0,8), pw1[1]=PKW(P0,10), pw1); \
    VRD(5); SBAR(); GAPA(C1=__builtin_amdgcn_mfma_f32_32x32x16_bf16(kf[3],qr[1],C1,0,0,0),   P0[14],P0[15],P1[0],P1[1],   pw1[2]=PKW(P0,12),pw1[3]=PKW(P0,14), pw1); \
    VRD(2); SBAR(); GAPA(C0=__builtin_amdgcn_mfma_f32_32x32x16_bf16(kf[4],qr[2],C0,0,0,0),   P1[2],P1[3],P1[4],P1[5],     pw2[0]=PKW(P1,0), pw2[1]=PKW(P1,2), pw2); \
    VRD(6); SBAR(); GAPA(C1=__builtin_amdgcn_mfma_f32_32x32x16_bf16(kf[5],qr[2],C1,0,0,0),   P1[6],P1[7],P1[8],P1[9],     pw2[2]=PKW(P1,4), pw2[3]=PKW(P1,6), pw2); \
    VRD(3); SBAR(); GAPA(C0=__builtin_amdgcn_mfma_f32_32x32x16_bf16(kf[6],qr[3],C0,0,0,0),   P1[10],P1[11],P1[12],P1[13], pw3[0]=PKW(P1,8), pw3[1]=PKW(P1,10), pw3); \
    VRD(7); SBAR(); GAPA(C1=__builtin_amdgcn_mfma_f32_32x32x16_bf16(kf[7],qr[3],C1,0,0,0),   P1[14],P1[15],0.f,0.f,       pw3[2]=PKW(P1,12),pw3[3]=PKW(P1,14), pw3); \
    l_reg+=sacc; \
    if(GK){DMA_K((t)+3,sl_cur);} if(GV){DMA_V((t)+1,sl_next);} \
    CMASK(C0,C1,t); \
    { float a=MX3(C0[0],C0[1],C1[0]),b=MX3(C0[2],C0[3],C1[1]); a=MX3(a,C1[2],C1[3]); \
      _Pragma("unroll") for(int r=4;r<16;r+=4){a=MX3(a,C0[r],C0[r+1]);b=MX3(b,C0[r+2],C0[r+3]);a=MX3(a,C1[r],C1[r+1]);b=MX3(b,C1[r+2],C1[r+3]);} \
      float rm=__builtin_fmaxf(a,b); { auto rr=__builtin_amdgcn_permlane32_swap(__float_as_uint(rm),__float_as_uint(rm),false,false); rm=__builtin_fmaxf(__uint_as_float(rr[0]),__uint_as_float(rr[1])); } \
      resc=false; \
      if(__builtin_expect(__any(rm>(float)THRL),0)){ const float dl=__builtin_fmaxf(rm,0.f); mhat+=dl; \
        _Pragma("unroll") for(int r=0;r<16;++r){C0[r]-=dl;C1[r]-=dl;} \
        _Pragma("unroll") for(int r=0;r<16;++r)negm[r]=-mhat; asm volatile("":"+v"(negm)); \
        const float f=__builtin_amdgcn_exp2f(-dl); l_reg*=f; if(hi==0)wsf[r32]=f; resc=true; } } \
    SBAR(); \
    GAPB(o[0]=__builtin_amdgcn_mfma_f32_32x32x16_bf16(PAF(0),VFR(0),o[0],0,0,0), C0,0); \
    GAPB(o[1]=__builtin_amdgcn_mfma_f32_32x32x16_bf16(PAF(0),VFR(4),o[1],0,0,0), C0,4); \
    KRD(GL,0); GAPB(o[0]=__builtin_amdgcn_mfma_f32_32x32x16_bf16(PAF(1),VFR(1),o[0],0,0,0), C0,8); \
    KRD(GL,1); GAPB(o[1]=__builtin_amdgcn_mfma_f32_32x32x16_bf16(PAF(1),VFR(5),o[1],0,0,0), C0,12); \
    KRD(GL,2); GAPB(o[0]=__builtin_amdgcn_mfma_f32_32x32x16_bf16(PAF(2),VFR(2),o[0],0,0,0), C1,0); \
    KRD(GL,3); GAPB(o[1]=__builtin_amdgcn_mfma_f32_32x32x16_bf16(PAF(2),VFR(6),o[1],0,0,0), C1,4); \
    GAPB(o[0]=__builtin_amdgcn_mfma_f32_32x32x16_bf16(PAF(3),VFR(3),o[0],0,0,0), C1,8); \
    GAPB(o[1]=__builtin_amdgcn_mfma_f32_32x32x16_bf16(PAF(3),VFR(7),o[1],0,0,0), C1,12); \
    }while(0)
  int t=1;
  #undef CMASK
  #define CMASK(P0,P1,t) do{}while(0)
  for(;t+5<NT;t+=2){
    STEP(pB0,pB1,pA0,pA1,t,true,true,true);     WAIT_BAR(2); RESC(); ROT();
    STEP(pA0,pA1,pB0,pB1,t+1,true,true,true);   WAIT_BAR(2); RESC(); ROT();
  }
  #undef CMASK
  #define CMASK(P0,P1,t) do{}while(0)
  #define ENDW(tt) do{ if((tt)+3<NT){WAIT_BAR(2);} else if((tt)+2<NT){WAIT_BAR(1);} else {WAIT_BAR(0);} }while(0)
  for(;t+1<NT;t+=2){
    STEP(pB0,pB1,pA0,pA1,t,(t+3<NT),(t+1<NT),(t+1<NT));       ENDW(t);   RESC(); ROT();
    STEP(pA0,pA1,pB0,pB1,t+1,(t+4<NT),(t+2<NT),(t+2<NT));     ENDW(t+1); RESC(); ROT();
  }
  STEP(pB0,pB1,pA0,pA1,NT-1,false,false,false); RESC();
  { float sacc=pB0[0]+pB0[1]; _Pragma("unroll") for(int r=2;r<16;++r)sacc+=pB0[r]; _Pragma("unroll") for(int r=0;r<16;++r)sacc+=pB1[r]; l_reg+=sacc;
    pw0=(u32x4){PKW(pB0,0),PKW(pB0,2),PKW(pB0,4),PKW(pB0,6)};pw1=(u32x4){PKW(pB0,8),PKW(pB0,10),PKW(pB0,12),PKW(pB0,14)};pw2=(u32x4){PKW(pB1,0),PKW(pB1,2),PKW(pB1,4),PKW(pB1,6)};pw3=(u32x4){PKW(pB1,8),PKW(pB1,10),PKW(pB1,12),PKW(pB1,14)};
    SBAR(); pv(o,vb0+sl_cur,PAF(0),PAF(1),PAF(2),PAF(3)); }
  #undef PKW
  #undef PAF
  #undef VFR
  #undef PIN
  #undef MX3
  #undef GAPA
  #undef GAPB
  #undef EX
  #undef VRD
  #undef KRD
  #undef STEP
  #undef ENDW
  {auto rr=__builtin_amdgcn_permlane32_swap(__float_as_uint(l_reg),__float_as_uint(l_reg),false,false);l_reg=__uint_as_float(rr[0])+__uint_as_float(rr[1]);}
  if(hi==0)wsf[32+r32]=l_reg;asm volatile("s_waitcnt lgkmcnt(0)":::"memory");
  float rli[16];
  #pragma unroll
  for(int r=0;r<16;++r)rli[r]=__builtin_amdgcn_rcpf(wsf[32+crow(r,hi)]);
  bf16*Ow=dummyO?dummyO+(long)(wid*QBLK)*QP:YQb+(rowbase+q0+wid*QBLK)*QP+1024+h*D; const bf16*Gw=YQb+(rowbase+q0+wid*QBLK)*QP+h*D;
  { float*stg=(float*)(shm+LDS_OST)+wid*2048;
    #pragma unroll
    for(int r=0;r<16;++r){const int orow=crow(r,hi);
      #pragma unroll
      for(int d0=0;d0<2;++d0)stg[orow*64+d0*32+r32]=o[d0][r]*rli[r];}
    asm volatile("s_waitcnt lgkmcnt(0)":::"memory");
    #pragma unroll
    for(int i=0;i<4;++i){const int row=i*8+(lane>>3),ch=lane&7; const float*sp=stg+row*64+ch*8;
      const f32x4_t a=*(const f32x4_t*)sp,c=*(const f32x4_t*)(sp+4); const u32x4 g=*(const u32x4*)(Gw+(long)row*QP+ch*8);
      u32x4 v; v[0]=cvtpk_s(a[0]*__uint_as_float(g[0]<<16),a[1]*__uint_as_float(g[0]&0xffff0000u)); v[1]=cvtpk_s(a[2]*__uint_as_float(g[1]<<16),a[3]*__uint_as_float(g[1]&0xffff0000u));
      v[2]=cvtpk_s(c[0]*__uint_as_float(g[2]<<16),c[1]*__uint_as_float(g[2]&0xffff0000u)); v[3]=cvtpk_s(c[2]*__uint_as_float(g[3]<<16),c[3]*__uint_as_float(g[3]&0xffff0000u));
      ATTN_STORE16(Ow+(long)row*QP+ch*8,v);} }
  asm volatile("s_waitcnt lgkmcnt(0)\n\ts_barrier":::"memory");
  #undef DMA_K
  #undef DMA_V
  #undef CMASK
  #undef START
  #undef RESC
  #undef ROT
}
constexpr int ATTN_LDS_BYTES=LDS_BYTES;
struct Order {
  int vcu, G; bool alt;
  __device__ __forceinline__ bool next(int i,int&b,int&h,int&qb)const{
    if(G==256&&!alt){ if(i>=16)return false; const int x=vcu>>5,j=vcu&31,rd=i>>2,k=i&3; const int pair=x*16+rd*4+(j>>3),un=(j&7)*4+k; b=pair>>2; h=(pair&3)*4+(un&3); qb=un>>2; return true; }
    const int U=i*G+vcu; if(U>=4096)return false; b=U>>7; h=(U>>3)&15; qb=U&7; return true; }
};
template<int THRL=8> __device__ __forceinline__ void attn_phase(char*lds,bf16*YQb,const bf16*K,const bf16*V,const Order&S,bf16*dummyO=nullptr){
  int b,h,qb;
  for(int i=0;S.next(i,b,h,qb);++i) attn_unit<THRL>(b,h,qb,YQb,K,V,lds,dummyO);
}
#undef SBAR
#undef WAIT_BAR
}

namespace ssd {
typedef short bf16x8 __attribute__((ext_vector_type(8)));
typedef short s16x4 __attribute__((ext_vector_type(4)));
typedef unsigned u32x2_t __attribute__((ext_vector_type(2)));
constexpr int O_B = 0, O_C = 32768, O_X = 65536, O_XD = 81920, O_ST = 98304, O_SM = 114688;
constexpr float LOG2E = 1.4426950408889634f;
struct Lofs { int fb[4], xb[4], bb, sw; };
__device__ __forceinline__ bf16x8 frag(const LAS unsigned char* img, int fbk, int t) { return *(const LAS bf16x8*)(img + fbk + t * 4096); }
__device__ __forceinline__ s16x4 trd(const LAS unsigned char* p) { typedef short v4i16_t __attribute__((ext_vector_type(4))); return __builtin_bit_cast(s16x4, __builtin_amdgcn_ds_read_tr16_b64_v4i16((LAS v4i16_t*)p)); }
__device__ __forceinline__ bf16x8 trfragX(const LAS unsigned char* img, int xbp, int s0) {
    const s16x4 a = trd(img + xbp + s0 * 128), b = trd(img + xbp + s0 * 128 + 2048);
    return (bf16x8){a[0], a[1], a[2], a[3], b[0], b[1], b[2], b[3]};
}
__device__ __forceinline__ bf16x8 trfragB(const LAS unsigned char* img, int bb, int s0) {
    const s16x4 a = trd(img + bb + s0 * 256), b = trd(img + bb + s0 * 256 + 4096);
    return (bf16x8){a[0], a[1], a[2], a[3], b[0], b[1], b[2], b[3]};
}
__device__ __forceinline__ void unpack4(const u32x2_t u, float (&f)[4]) { f[0] = __uint_as_float(u.x << 16); f[1] = __uint_as_float(u.x & 0xffff0000u); f[2] = __uint_as_float(u.y << 16); f[3] = __uint_as_float(u.y & 0xffff0000u); }
__device__ __forceinline__ void unpack8(const v4u u, float (&f)[8]) {
    f[0] = __uint_as_float(u.x << 16); f[1] = __uint_as_float(u.x & 0xffff0000u); f[2] = __uint_as_float(u.y << 16); f[3] = __uint_as_float(u.y & 0xffff0000u);
    f[4] = __uint_as_float(u.z << 16); f[5] = __uint_as_float(u.z & 0xffff0000u); f[6] = __uint_as_float(u.w << 16); f[7] = __uint_as_float(u.w & 0xffff0000u);
}
#define SSD_MFMA(a, b, c) __builtin_amdgcn_mfma_f32_16x16x32_bf16(a, b, c, 0, 0, 0)

template <int W> __device__ __forceinline__ void diag(f32x4 (&y)[4], const bf16x8 (&cf)[4], const LAS unsigned char* Bi, const LAS unsigned char* Xi, const LAS float* csc, float csl, float skd, int fr, int fq, const Lofs& lo) {
    constexpr int NU = W / 2 + 1;
    bf16x8 bA[2][4], bB[2][4];
#pragma unroll
    for (int kk = 0; kk < 4; ++kk) { bA[0][kk] = frag(Bi, lo.fb[kk], 0); if (1 <= W) bB[0][kk] = frag(Bi, lo.fb[kk], 1); }
#pragma unroll
    for (int u = 0; u < NU; ++u) {
        const int cur = u & 1; const bool has1 = 2 * u + 1 <= W;
        bf16x8 xf[4];
#pragma unroll
        for (int pt = 0; pt < 4; ++pt) xf[pt] = trfragX(Xi, lo.xb[pt], 32 * u);
        const f32x4 c0 = *(const LAS f32x4*)(csc + 32 * u + 4 * fq), c1 = *(const LAS f32x4*)(csc + 32 * u + 16 + 4 * fq);
        if (u + 1 < NU) {
#pragma unroll
            for (int kk = 0; kk < 4; ++kk) { bA[cur ^ 1][kk] = frag(Bi, lo.fb[kk], 2 * u + 2); if (2 * u + 3 <= W) bB[cur ^ 1][kk] = frag(Bi, lo.fb[kk], 2 * u + 3); } }
        asm volatile("" ::: "memory");
        f32x4 a0 = (f32x4){0.f, 0.f, 0.f, 0.f}, a1 = (f32x4){0.f, 0.f, 0.f, 0.f};
#pragma unroll
        for (int kk = 0; kk < 4; ++kk) { a0 = SSD_MFMA(bA[cur][kk], cf[kk], a0); if (has1) a1 = SSD_MFMA(bB[cur][kk], cf[kk], a1); }
        float m0[4], m1[4];
#pragma unroll
        for (int e = 0; e < 4; ++e) {
            m0[e] = a0[e] * __builtin_amdgcn_exp2f(fminf(csl - c0[e], 0.f)); if (2 * u == W) { if (4 * fq + e > fr) m0[e] = 0.f; if (4 * fq + e == fr) m0[e] += skd; }
            m1[e] = has1 ? a1[e] * __builtin_amdgcn_exp2f(fminf(csl - c1[e], 0.f)) : 0.f; if (2 * u + 1 == W) { if (4 * fq + e > fr) m1[e] = 0.f; if (4 * fq + e == fr) m1[e] += skd; } }
        const v4u mw = (v4u){pk2(m0[0], m0[1]), pk2(m0[2], m0[3]), pk2(m1[0], m1[1]), pk2(m1[2], m1[3])};
        const bf16x8 mf = __builtin_bit_cast(bf16x8, mw);
#pragma unroll
        for (int pt = 0; pt < 4; ++pt) y[pt] = SSD_MFMA(xf[pt], mf, y[pt]);
    }
}

template <int SH> __device__ __forceinline__ void ssd_item(int b, int h, const bf16* XC, const float* DT, const bf16* Z, const float* a_log, const float* d_skip, bf16* YQ, float* SSQ,
                                          LAS unsigned char* L, int tid_in, int lane_in, int wave) {
    int tid = tid_in, lane = lane_in; asm volatile("" : "+v"(tid), "+v"(lane));
    const int fr = lane & 15, fq = lane >> 4, g = h >> 3;
    LAS unsigned char* Bi = L + O_B; LAS unsigned char* Ci = L + O_C; LAS unsigned char* Xi = L + O_X; LAS unsigned char* Xdi = L + O_XD; LAS unsigned char* Sti = L + O_ST;
    LAS float* dtv = (LAS float*)(L + O_SM); LAS float* cs2 = dtv + 256;
    const float aneg1 = -expf(a_log[16 + h]) * LOG2E, aneg0 = -expf(a_log[h]) * LOG2E, dsk = d_skip[h];
    Lofs lo;
    { const int q = (lane & 15) >> 2, pp = lane & 3, rr = 4 * fq + q;
#pragma unroll
      for (int kk = 0; kk < 4; ++kk) lo.fb[kk] = fr * 256 + (((4 * kk + fq) ^ fr) << 4);
#pragma unroll
      for (int pt = 0; pt < 4; ++pt) lo.xb[pt] = rr * 128 + ((pt ^ ((rr >> 1) & 3)) << 5) + 8 * pp;
      lo.bb = rr * 256 + (((2 * wave + (pp >> 1)) ^ rr) << 4) + 8 * (pp & 1);
      lo.sw = fr * 256 + (((2 * wave + (fq >> 1)) ^ fr) << 4) + (fq & 1) * 8; }
    const int sB = tid >> 4, cB = tid & 15, sX = tid >> 3, cX = tid & 7;
    const int wB = sB * 256 + ((cB ^ (sB & 15)) << 4);
    const int wX = sX * 128 + (((cX >> 1) ^ ((sX >> 1) & 3)) << 5) + (cX & 1) * 16;
    f32x4 st[4];
#pragma unroll
    for (int pt = 0; pt < 4; ++pt) st[pt] = (f32x4){0.f, 0.f, 0.f, 0.f};
    v4u Bq[4], Cq[4], Xq[2]; float dq0 = 0.f, dq1 = 0.f; bf16x8 cf[4];
#define SSD_DECODE(step, d_, base_, ctx_) const int d_ = 1 - (step) / 18; const int k_##d_ = (step) % 18; const bool ctx_ = k_##d_ < 2; \
    const size_t base_ = ctx_ ? (size_t)ML + (size_t)b * CTXL + (size_t)(d_ ? 1 - k_##d_ : k_##d_) * 128 : (size_t)b * SEQ + (size_t)(d_ ? 17 - k_##d_ : k_##d_ - 2) * 128;
#define SSD_ISSUE(step) do { SSD_DECODE(step, di, basei, ctxi) (void)ctxi; \
        const bf16* cb_ = XC + (SH == 8 ? (size_t)b * SEQ : basei) * CONVC; const int sg_ = di ? -CONVC : CONVC; const int o0_ = di ? 127 * CONVC : 0; \
        const bf16* pb_ = cb_ + (o0_ + sB * sg_ + 1024 + g * 128 + 8 * cB); const bf16* px_ = cb_ + (o0_ + sX * sg_ + h * 64 + 8 * cX); \
        const bf16* pc_ = cb_ + (o0_ + (16 * wave + fr) * sg_ + 1280 + g * 128 + 8 * fq); \
        _Pragma("unroll") for (int k4 = 0; k4 < 4; ++k4) { Bq[k4] = *(const v4u*)(pb_ + k4 * 32 * sg_); Cq[k4] = *(const v4u*)(pc_ + 32 * k4); } \
        _Pragma("unroll") for (int k2 = 0; k2 < 2; ++k2) Xq[k2] = *(const v4u*)(px_ + k2 * 64 * sg_); \
        if (wave == 0) { const size_t r0 = basei + (di ? 127 - 2 * lane : 2 * lane), r1 = basei + (di ? 126 - 2 * lane : 2 * lane + 1); dq0 = DT[r0 * 32 + di * 16 + h]; dq1 = DT[r1 * 32 + di * 16 + h]; } } while (0)
#define SSD_CUMSUM(step, par) do { if (wave == 0) { const float an = (1 - (step) / 18) ? aneg1 : aneg0; const float a0 = dq0 * an, a1 = dq1 * an; float v = a0 + a1; \
        _Pragma("unroll") for (int o = 1; o < 64; o <<= 1) { const float t = __shfl_up(v, o); if (lane >= o) v += t; } \
        dtv[(par) * 128 + 2 * lane] = dq0; dtv[(par) * 128 + 2 * lane + 1] = dq1; cs2[(par) * 128 + 2 * lane] = v - a1; cs2[(par) * 128 + 2 * lane + 1] = v; } } while (0)
#define SSD_WRITE(step, par) do { \
        _Pragma("unroll") for (int k4 = 0; k4 < 4; ++k4) { *(LAS v4u*)(Bi + wB + k4 * 8192) = Bq[k4]; cf[k4] = __builtin_bit_cast(bf16x8, Cq[k4]); } \
        const float cl = cs2[(par) * 128 + 127]; \
        _Pragma("unroll") for (int k2 = 0; k2 < 2; ++k2) { const int s = sX + 64 * k2; const float dts = dtv[(par) * 128 + s], es = __builtin_amdgcn_exp2f(cl - cs2[(par) * 128 + s]); \
            float f[8]; unpack8(Xq[k2], f); _Pragma("unroll") for (int e = 0; e < 8; ++e) f[e] *= dts; \
            v4u xo; xo.x = pk2(f[0], f[1]); xo.y = pk2(f[2], f[3]); xo.z = pk2(f[4], f[5]); xo.w = pk2(f[6], f[7]); \
            _Pragma("unroll") for (int e = 0; e < 8; ++e) f[e] *= es; \
            v4u xd; xd.x = pk2(f[0], f[1]); xd.y = pk2(f[2], f[3]); xd.z = pk2(f[4], f[5]); xd.w = pk2(f[6], f[7]); \
            *(LAS v4u*)(Xi + wX + k2 * 8192) = xo; *(LAS v4u*)(Xdi + wX + k2 * 8192) = xd; } } while (0)
#define SSD_WRITE_STATE() do { _Pragma("unroll") for (int pt = 0; pt < 4; ++pt) { \
        u32x2_t w; w.x = pk2(st[pt][0], st[pt][1]); w.y = pk2(st[pt][2], st[pt][3]); *(LAS u32x2_t*)(Sti + lo.sw + pt * 4096) = w; } } while (0)

    __syncthreads();
    SSD_ISSUE(0); SSD_CUMSUM(0, 0); SSD_WRITE_STATE();
    __syncthreads();
    SSD_WRITE(0, 0);
    __syncthreads();
    for (int step = 0; step < 36; ++step) {
        const int par = step & 1; SSD_DECODE(step, d, base, isctx)
        const size_t orow = base + (d ? 127 - (16 * wave + fr) : 16 * wave + fr);
        u32x2_t ybv[4], zv[4];
        if (!isctx && d == 0 && SH != 5 && SH != 7) { const bf16* yq_ = (SH ? YQ + (orow & 255) * 2048 : YQ + orow * 2048) + h * 64 + 4 * fq; const bf16* zp = Z + orow * 1024 + h * 64 + 4 * fq;
#pragma unroll
            for (int pt = 0; pt < 4; ++pt) { ybv[pt] = *(const u32x2_t*)(yq_ + 16 * pt); zv[pt] = *(const u32x2_t*)(zp + 16 * pt); } }
        if (step + 1 < 36 && SH != 3 && SH != 7) SSD_ISSUE(step + 1);
        const LAS float* csc = cs2 + par * 128;
        if (!isctx && SH != 7) {
            bf16* yp = SH ? YQ + (orow & 255) * 2048 + h * 64 + 4 * fq : YQ + orow * 2048 + h * 64 + 4 * fq;
            const float csl = csc[16 * wave + fr];
            const float skd = d == 0 ? dsk * __builtin_amdgcn_rcpf(dtv[par * 128 + 16 * wave + fr]) : 0.f;
            f32x4 y[4];
#pragma unroll
            for (int pt = 0; pt < 4; ++pt) { y[pt] = (f32x4){0.f, 0.f, 0.f, 0.f};
                if (SH != 6) {
#pragma unroll
                for (int kk = 0; kk < 4; ++kk) y[pt] = SSD_MFMA(frag(Sti, lo.fb[kk], pt), cf[kk], y[pt]); } }
            { const float El = __builtin_amdgcn_exp2f(csl);
#pragma unroll
              for (int pt = 0; pt < 4; ++pt) y[pt] *= El; }
            if (SH != 2) switch (wave) {
                case 0: diag<0>(y, cf, Bi, Xi, csc, csl, skd, fr, fq, lo); break; case 1: diag<1>(y, cf, Bi, Xi, csc, csl, skd, fr, fq, lo); break;
                case 2: diag<2>(y, cf, Bi, Xi, csc, csl, skd, fr, fq, lo); break; case 3: diag<3>(y, cf, Bi, Xi, csc, csl, skd, fr, fq, lo); break;
                case 4: diag<4>(y, cf, Bi, Xi, csc, csl, skd, fr, fq, lo); break; case 5: diag<5>(y, cf, Bi, Xi, csc, csl, skd, fr, fq, lo); break;
                case 6: diag<6>(y, cf, Bi, Xi, csc, csl, skd, fr, fq, lo); break; default: diag<7>(y, cf, Bi, Xi, csc, csl, skd, fr, fq, lo); break;
            }
            if (d == 0 && SH != 5) {
                float q = 0.f;
#pragma unroll
                for (int pt = 0; pt < 4; ++pt) { float fb[4], fz[4]; unpack4(ybv[pt], fb); unpack4(zv[pt], fz);
#pragma unroll
                    for (int e = 0; e < 4; ++e) { const float v = (y[pt][e] + fb[e]) * fz[e]; y[pt][e] = v; q += v * v; } }
                q += __shfl_xor(q, 16); q += __shfl_xor(q, 32);
                if (fq == 0) SSQ[(SH ? (orow & 255) : orow) * 16 + h] = q;
            }
#pragma unroll
            for (int pt = 0; pt < 4; ++pt) { u32x2_t o; o.x = pk2(y[pt][0], y[pt][1]); o.y = pk2(y[pt][2], y[pt][3]); if (SH != 5) *(u32x2_t*)(yp + 16 * pt) = o; else asm volatile("" :: "v"(o)); }
        }
        if (SH != 6 && SH != 7) { const float dec = __builtin_amdgcn_exp2f(csc[127]);
#pragma unroll
          for (int pt = 0; pt < 4; ++pt) st[pt] *= dec;
#pragma unroll
          for (int kk = 0; kk < 4; ++kk) { const bf16x8 af = trfragB(Bi, lo.bb, 32 * kk);
#pragma unroll
              for (int pt = 0; pt < 4; ++pt) st[pt] = SSD_MFMA(af, trfragX(Xdi, lo.xb[pt], 32 * kk), st[pt]); } }
        if (step + 1 < 36) SSD_CUMSUM(step + 1, par ^ 1);
        if (step == 17) {
#pragma unroll
            for (int pt = 0; pt < 4; ++pt) st[pt] = (f32x4){0.f, 0.f, 0.f, 0.f};
            VM_WAIT();
        }
        __syncthreads();
        SSD_WRITE_STATE();
        if (step + 1 < 36 && SH != 4 && SH != 7) SSD_WRITE(step + 1, par ^ 1);
        __syncthreads();
    }
#undef SSD_DECODE
#undef SSD_ISSUE
#undef SSD_CUMSUM
#undef SSD_WRITE
#undef SSD_WRITE_STATE
}
}

constexpr int RING_OFF = 0, RING_BYTES = 131072;
constexpr int LDSCTL_OFF = RING_BYTES, MISC_OFF = LDSCTL_OFF + 320;
constexpr int RSTD_OFF = LDSCTL_OFF + 1024;
constexpr int LDS_BYTES = 155648;
constexpr int CW_BAR = 4096;
constexpr int CW_TMO2 = 8192, CW_CNT = 16384;
constexpr int EXL_OFF = 140288;
constexpr int NPHASE = 7;

struct Args { const float* in[18]; float* out; unsigned char* ws; int ph_lo, ph_hi; };

__global__ void __launch_bounds__(NWAVES * 64, 2) mega(Args args) {
    extern __shared__ __attribute__((aligned(16))) unsigned char lds[];
    LAS unsigned char* ldsp = (LAS unsigned char*)lds;
    volatile LAS unsigned* MISC = (volatile LAS unsigned*)(ldsp + MISC_OFF);
    const int tid = threadIdx.x, lane = tid & 63, wave = __builtin_amdgcn_readfirstlane(tid >> 6);
    const int G = gridDim.x; const int bx = blockIdx.x; const int vcu = (G % 8 == 0) ? (bx % 8) * (G / 8) + bx / 8 : bx;
    unsigned char* ws = args.ws;
    gu32* ctl = (gu32*)(ws + WS_CTL);
    float* mod = (float*)(ws + WS_MOD); float* rope = (float*)(ws + WS_ROPE); float* SSQ = (float*)(ws + WS_SSQ); float* RPART = (float*)(ws + WS_RPART);
    bf16* bt1 = (bf16*)(ws + WS_BT1); bf16* bt2 = (bf16*)(ws + WS_BT2); float* DT = (float*)(ws + WS_DT); bf16* KB = (bf16*)(ws + WS_KB); bf16* VB = (bf16*)(ws + WS_VB);
    bf16* H = (bf16*)(ws + WS_R1); bf16* XC = (bf16*)(ws + WS_R1); bf16* XBC = (bf16*)(ws + WS_XBC); bf16* YQ = (bf16*)(ws + WS_YQ); bf16* Z = (bf16*)(ws + WS_Z);
    for (int u = tid; u < (LDS_BYTES - LDSCTL_OFF) / 4; u += NWAVES * 64) ((LAS unsigned*)(ldsp + LDSCTL_OFF))[u] = 0u;
    __syncthreads();
    const int lo = args.ph_lo, hi = args.ph_hi;
    XcdBarrier bar; bar.bar = (unsigned*)(ctl + CW_BAR); bar.x = 0; bar.st = nullptr;
    if (hi - lo > 1) bar = xcd_barrier_post((unsigned*)(ctl + CW_BAR), MISC + 8);
#ifndef DUP_MASK
#define DUP_MASK 0
#endif
#define IN(k) (lo <= (k) && (k) < hi)
#define REP(k) for (int rep_ = 0; rep_ < 1 + ((DUP_MASK >> (k)) & 1); ++rep_)
#define SEAM(k) do { if (IN(k) && IN((k) + 1)) xcd_barrier(bar); } while (0)

    if (IN(0)) REP(0) {
        LAS float* ldsf = (LAS float*)(ldsp + RING_OFF);
        if (bx < 48) p0_mod_block(args.in[1], args.in[3], args.in[4], args.in[5], mod, ldsf, bx, tid, lane, wave);
        else if (bx == 48) { for (int i = tid; i < 1024; i += NWAVES * 64) { const int p = i >> 4, f = i & 15; const float inv = powf(10000.f, -(float)f / 16.f); const float ang = (float)p * inv; rope[i] = cosf(ang); rope[1024 + i] = sinf(ang); } }
        LAS float* scr = ldsf + wave * (64 * 33);
        const int gw = ((bx + G - 49) % G) * NWAVES + wave, NGW = G * NWAVES;
        constexpr int I1 = 16 * 168, I2 = 32 * 32;
        for (int it = gw; it < I1 + I2; it += NGW) { if (it < I1) p0_bt1_item(args.in[7], bt1, scr, it, lane); else p0_bt2_item(args.in[16], args.in[15], bt2, scr, it - I1, lane); }
    }
    SEAM(0);
    if (IN(1)) REP(1) {
        const int gw = bx * NWAVES + wave, NGW = G * NWAVES;
        for (int m = gw; m < MT; m += NGW) {
            const float* xr = m < ML ? args.in[0] + (size_t)m * DM : args.in[2] + (size_t)(m - ML) * DM;
            p1_norm_row(xr, mod + (size_t)(m < ML ? m / SEQ : 32) * 3072, args.in[6], H + (size_t)m * DM, lane);
        }
    }
    SEAM(1);

    if (IN(2)) REP(2) {
        pg8::Gemm g{H, bt1, MT, N1, 1024}; pg8::Sched1 S; S.init(G, bx);
        pg8::Epi1 E{KB, VB, XBC, YQ, Z, DT, rope, args.in[13], args.in[14], args.in[10]};
        pg8::gemm_phase<pg8::Epi1, pg8::Sched1, true, true>(ldsp + RING_OFF, g, S, E);
    }
    SEAM(2);
    if (IN(3)) {
        const attn_body::Order S{vcu, G, false};
        const attn_body::Order S2{vcu, G, true};
#ifndef ATTN_SHADOW
#define ATTN_SHADOW 0
#endif
        if (ATTN_SHADOW) attn_body::attn_phase<8>((char*)lds + RING_OFF, (attn_body::bf16*)YQ, (const attn_body::bf16*)KB, (const attn_body::bf16*)VB, ATTN_SHADOW == 2 ? S2 : S, (attn_body::bf16*)(ws + WS_END + 8 * MiB));
        attn_body::attn_phase<8>((char*)lds + RING_OFF, (attn_body::bf16*)YQ, (const attn_body::bf16*)KB, (const attn_body::bf16*)VB, S);
        conv_phase(XBC, args.in[8], args.in[9], XC, bx, G, tid);
    }
    SEAM(3);
    if (IN(4)) REP(4) {
#if defined(SSD_NAIVE)
        for (int it = bx; it < NB * 16; it += G) ssd_item_naive(it >> 4, it & 15, XC, DT, Z, args.in[11], args.in[12], YQ, SSQ, (LAS float*)(ldsp + RING_OFF), tid);
#else
#ifndef SSD_SHADOW
#define SSD_SHADOW 0
#endif
        if (SSD_SHADOW) { bf16* dY = (bf16*)(ws + WS_END); float* dS = (float*)(ws + WS_END + 2 * MiB);
            for (int it = vcu; it < NB * 16; it += G) ssd::ssd_item<SSD_SHADOW>(it >> 4, it & 15, XC, DT, Z, args.in[11], args.in[12], dY, dS, ldsp, tid, lane, wave); }
        for (int it = vcu; it < NB * 16; it += G) ssd::ssd_item<0>(it >> 4, it & 15, XC, DT, Z, args.in[11], args.in[12], YQ, SSQ, ldsp, tid, lane, wave);
#endif
    }
    SEAM(4);

    if (IN(5)) REP(5) {
        pg8::Sched2 S; S.init(G, bx);
        LAS float* rt = (LAS float*)(ldsp + RSTD_OFF);
        { pg8::Unit u; for (int i = 0; i < 4 && S.next(i, u); ++i) if (tid < 256) { const float* q = SSQ + ((size_t)u.pm * 256 + tid) * 16; float s = 0.f;
#pragma unroll
                for (int j = 0; j < 16; ++j) s += q[j];
                rt[i * 256 + tid] = rsqrtf(s * (1.f / 1024.f) + EPS); } }
        __syncthreads();
        pg8::Gemm g{YQ, bt2, ML, 1024, 2048};
        pg8::Epi2 E{args.in[0], mod, args.in[17], args.out, (unsigned long long*)RPART, (unsigned*)(ctl + CW_CNT), (unsigned*)(ctl + CW_TMO2), (const LAS float*)rt, (LAS float*)(ldsp + EXL_OFF)};
        pg8::gemm_phase<pg8::Epi2, pg8::Sched2, true, true>(ldsp + RING_OFF, g, S, E);
    }

#undef IN
#undef SEAM
}

__global__ void k_mod(const float* c, const float* c_ctx, const float* ada_w, const float* ada_b, float* mod) {
    const int i = blockIdx.x * 256 + threadIdx.x; if (i >= 33 * 3072) return;
    const int b = i / 3072, n = i % 3072; const float* cv = b < 32 ? c + b * 1024 : c_ctx;
    float acc = 0.f;
    for (int k = 0; k < 1024; ++k) acc += siluf(cv[k]) * ada_w[(size_t)k * 3072 + n];
    mod[i] = acc + ada_b[n];
}
__global__ void k_tables(float* rope) {
    const int i = blockIdx.x * 256 + threadIdx.x; if (i >= 1024) return;
    const int p = i >> 4, f = i & 15; const float inv = powf(10000.f, -(float)f / 16.f); const float ang = (float)p * inv;
    rope[i] = cosf(ang); rope[1024 + i] = sinf(ang);
}
__global__ void k_bt1(const float* w_in, bf16* bt1) {
    const size_t i = (size_t)blockIdx.x * 256 + threadIdx.x; if (i >= (size_t)N1 * 1024) return;
    const int v = (int)(i >> 10), k = (int)(i & 1023); const int a = vcol_actual(v);
    bt1[i] = (bf16)(a >= 0 ? f2bf(w_in[(size_t)k * PROJ + a]) : 0u);
}
__global__ void k_bt2(const float* w_out, const float* ssd_g, bf16* bt2) {
    const size_t i = (size_t)blockIdx.x * 256 + threadIdx.x; if (i >= (size_t)1024 * 2048) return;
    const int n = (int)(i >> 11), kk = (int)(i & 2047);
    const float v = kk < 1024 ? w_out[(size_t)(1024 + kk) * 1024 + n] * ssd_g[kk] : w_out[(size_t)(kk - 1024) * 1024 + n];
    bt2[i] = (bf16)f2bf(v);
}
__global__ void k_norm(const float* x, const float* ctx, const float* norm_g, const float* mod, bf16* H) {
    const int row = blockIdx.x * 4 + (threadIdx.x >> 6), lane = threadIdx.x & 63; if (row >= MT) return;
    const float* xr = row < ML ? x + (size_t)row * DM : ctx + (size_t)(row - ML) * DM;
    const float* md = mod + (size_t)(row < ML ? row / SEQ : 32) * 3072;
    float v[16]; float s = 0.f;
    for (int j = 0; j < 16; ++j) { v[j] = xr[lane + 64 * j]; s += v[j] * v[j]; }
    for (int o = 1; o < 64; o <<= 1) s += __shfl_xor(s, o);
    const float rstd = rsqrtf(s * (1.f / DM) + EPS);
    for (int j = 0; j < 16; ++j) { const int k = lane + 64 * j; const float h = v[j] * rstd * norm_g[k] * (1.f + md[1024 + k]) + md[k]; H[(size_t)row * DM + k] = (bf16)f2bf(h); }
}
__global__ __launch_bounds__(256) void k_gemm1(const bf16* H, const bf16* bt1, const float* rope, const float* qg, const float* kg, const float* dt_bias,
                                                bf16* KB, bf16* VB, bf16* XBC, float* DT, bf16* YQ, bf16* Z) {
    __shared__ float As[32][65];
    __shared__ float Ps[32][257];
    const int pn = blockIdx.x, rt = blockIdx.y, tid = threadIdx.x; const int row0 = rt * 32;
    if (row0 >= ML && pn > 8) return;
    float acc[32];
    for (int r = 0; r < 32; ++r) acc[r] = 0.f;
    const bf16* bp = bt1 + (size_t)(pn * 256 + tid) * 1024;
    for (int k0 = 0; k0 < 1024; k0 += 64) {
        __syncthreads();
        for (int e = tid; e < 32 * 64; e += 256) { const int r = e >> 6, kk = e & 63; As[r][kk] = bf2f(H[(size_t)(row0 + r) * DM + k0 + kk]); }
        __syncthreads();
        for (int kk = 0; kk < 64; ++kk) { const float b = bf2f(bp[k0 + kk]);
            for (int r = 0; r < 32; ++r) acc[r] += As[r][kk] * b; }
    }
    for (int r = 0; r < 32; ++r) Ps[r][tid] = acc[r];
    __syncthreads();
    const bool isctx = row0 >= ML;
    if (pn == 0 || (pn >= 9 && pn < 13)) {
        {
            const int r = tid >> 3, hd = (tid >> 1) & 3, ax = tid & 1, row = row0 + r; const float* g = pn == 0 ? kg : qg;
            float s = 0.f;
            for (int d = 0; d < 32; ++d) { const float v = Ps[r][hperm_inv(hd, ax * 32 + d)]; s += v * v; }
            s += __shfl_xor(s, 1);
            const float rstd = rsqrtf(s * (1.f / 64.f) + EPS);
            const int t = row % SEQ, p = ax == 0 ? (t >> 6) : (t & 63);
            bf16* dst; float osc = 1.f;
            if (pn == 0) { const int b = isctx ? (row - ML) / CTXL : row / SEQ, pos = isctx ? SEQ + (row - ML) % CTXL : row % SEQ; dst = KB + ((size_t)b * KVL + pos) * 256 + hd * 64 + ax * 32; }
            else { dst = YQ + (size_t)row * 2048 + 1024 + ((pn - 9) * 4 + hd) * 64 + ax * 32; osc = C2; }
            for (int f = 0; f < 16; ++f) {
                const float x1 = Ps[r][hperm_inv(hd, ax * 32 + f)] * rstd * g[ax * 32 + f], x2 = Ps[r][hperm_inv(hd, ax * 32 + 16 + f)] * rstd * g[ax * 32 + 16 + f];
                float o1 = x1, o2 = x2;
                if (!isctx) { const float cs = rope[p * 16 + f], sn = rope[1024 + p * 16 + f]; o1 = x1 * cs - x2 * sn; o2 = x2 * cs + x1 * sn; }
                dst[f] = (bf16)f2bf(o1 * osc); dst[16 + f] = (bf16)f2bf(o2 * osc);
            }
        }
    } else {
        for (int r = 0; r < 32; ++r) { const int row = row0 + r; const float v = Ps[r][tid];
            if (pn == 1) { const int b = isctx ? (row - ML) / CTXL : row / SEQ, pos = isctx ? SEQ + (row - ML) % CTXL : row % SEQ;
                VB[((size_t)b * KVL + pos) * 256 + tid] = (bf16)f2bf(v); }
            else if (pn < 8) XBC[(size_t)row * CONVC + (pn - 2) * 256 + tid] = (bf16)f2bf(v);
            else if (pn == 8) { if (tid < 32) DT[(size_t)row * 32 + tid] = softplusf(v + dt_bias[tid]); }
            else if (pn < 17) YQ[(size_t)row * 2048 + (pn - 13) * 256 + tid] = (bf16)f2bf(siluf(v));
            else Z[(size_t)row * 1024 + (pn - 17) * 256 + tid] = (bf16)f2bf(siluf(v)); }
    }
}
__global__ __launch_bounds__(256) void k_attn(bf16* YQ, const bf16* KB, const bf16* VB) {
    __shared__ float Qs[64][65]; __shared__ float Ks[64][65]; __shared__ float Ps[64][65]; __shared__ bf16 Vs[64][66];
    const int qb = blockIdx.x, h = blockIdx.y, b = blockIdx.z, tid = threadIdx.x, ty = tid >> 4, tx = tid & 15;
    const size_t row0 = (size_t)b * SEQ + qb * 64; const int kvh = h >> 2;
    for (int e = tid; e < 4096; e += 256) { const int r = e >> 6, d = e & 63; Qs[r][d] = bf2f(YQ[(row0 + r) * 2048 + 1024 + h * 64 + d]); }
    float o[4][4], l[4];
    for (int i = 0; i < 4; ++i) { l[i] = 0.f; for (int j = 0; j < 4; ++j) o[i][j] = 0.f; }
    for (int kt = 0; kt < KVL / 64; ++kt) {
        __syncthreads();
        for (int e = tid; e < 4096; e += 256) { const int r = e >> 6, d = e & 63; const size_t src = ((size_t)b * KVL + kt * 64 + r) * 256 + kvh * 64 + d;
            Ks[r][d] = bf2f(KB[src]); Vs[r][d] = VB[src]; }
        __syncthreads();
        float s[4][4];
        for (int i = 0; i < 4; ++i) for (int j = 0; j < 4; ++j) s[i][j] = 0.f;
        for (int d = 0; d < 64; ++d) { float a[4], k4[4];
            for (int i = 0; i < 4; ++i) { a[i] = Qs[ty * 4 + i][d]; k4[i] = Ks[tx * 4 + i][d]; }
            for (int i = 0; i < 4; ++i) for (int j = 0; j < 4; ++j) s[i][j] += a[i] * k4[j]; }
        for (int i = 0; i < 4; ++i) for (int j = 0; j < 4; ++j) Ps[ty * 4 + i][tx * 4 + j] = exp2f(s[i][j]);
        __syncthreads();
        for (int key = 0; key < 64; ++key) { float p[4], v4[4];
            for (int i = 0; i < 4; ++i) { p[i] = Ps[ty * 4 + i][key]; v4[i] = bf2f(Vs[key][tx * 4 + i]); }
            for (int i = 0; i < 4; ++i) { l[i] += p[i]; for (int j = 0; j < 4; ++j) o[i][j] += p[i] * v4[j]; } }
    }
    for (int i = 0; i < 4; ++i) for (int j = 0; j < 4; ++j) { const size_t row = row0 + ty * 4 + i; const int d = tx * 4 + j;
        const float ga = bf2f(YQ[row * 2048 + h * 64 + d]);
        YQ[row * 2048 + 1024 + h * 64 + d] = (bf16)f2bf(o[i][j] / l[i] * ga); }
}
__global__ void k_conv(const bf16* XBC, const float* cw, const float* cb, bf16* XC) {
    const size_t i = (size_t)blockIdx.x * 256 + threadIdx.x; if (i >= (size_t)MT * CONVC) return;
    const int row = (int)(i / CONVC), ch = (int)(i % CONVC);
    int t, len; if (row < ML) { t = row % SEQ; len = SEQ; } else { t = (row - ML) % CTXL; len = CTXL; }
    float acc = cb[ch];
    for (int j = 0; j < 5; ++j) { const int tt = t + j - 2; if (tt >= 0 && tt < len) acc += cw[j * CONVC + ch] * bf2f(XBC[(size_t)(row + j - 2) * CONVC + ch]); }
    XC[i] = (bf16)f2bf(siluf(acc));
}
__global__ __launch_bounds__(512) void k_ssd(const bf16* XC, const float* DT, const bf16* Z, const float* a_log, const float* d_skip, bf16* YQ, float* SSQ) {
    __shared__ float ysq[64];
    const int h = blockIdx.x, b = blockIdx.y, tid = threadIdx.x, p = tid >> 3, nc = tid & 7, g = h >> 3;
    for (int dd = 0; dd < 2; ++dd) { const int d = 1 - dd;
        const float a_neg = -expf(a_log[d * 16 + h]);
        float S[16];
        for (int j = 0; j < 16; ++j) S[j] = 0.f;
        for (int seq = 0; seq < 2; ++seq) { const int len = seq == 0 ? CTXL : SEQ; const size_t rbase = seq == 0 ? (size_t)ML + (size_t)b * CTXL : (size_t)b * SEQ;
            for (int st = 0; st < len; ++st) { const int t = d ? len - 1 - st : st; const size_t row = rbase + t;
                const float dt = DT[row * 32 + d * 16 + h]; const float dec = expf(dt * a_neg);
                const float xs = bf2f(XC[row * CONVC + h * 64 + p]); const float X = xs * dt;
                const bf16* Bp = XC + row * CONVC + 1024 + g * 128 + nc * 16; const bf16* Cp = Bp + 256;
                float y = 0.f;
                for (int j = 0; j < 16; ++j) { S[j] = S[j] * dec + X * bf2f(Bp[j]); y += bf2f(Cp[j]) * S[j]; }
                y += __shfl_xor(y, 1); y += __shfl_xor(y, 2); y += __shfl_xor(y, 4);
                if (seq == 1) {
                    bf16* yp = YQ + row * 2048 + h * 64 + p;
                    if (d == 1) { if (nc == 0) *yp = (bf16)f2bf(y); }
                    else {
                        float yg = 0.f;
                        if (nc == 0) { const float yt = y + bf2f(*yp) + d_skip[h] * xs; yg = yt * bf2f(Z[row * 1024 + h * 64 + p]); *yp = (bf16)f2bf(yg); ysq[p] = yg * yg; }
                        __syncthreads();
                        if (tid < 64) { float q = ysq[tid]; for (int o = 1; o < 64; o <<= 1) q += __shfl_xor(q, o); if (tid == 0) SSQ[row * 16 + h] = q; }
                        __syncthreads();
                    }
                }
            }
        }
    }
}
__global__ __launch_bounds__(256) void k_gemm2(const bf16* YQ, const bf16* bt2, const float* SSQ, const float* x, const float* mod, float* out, float* RPART) {
    __shared__ float As[32][65]; __shared__ float red[32][4];
    const int pn = blockIdx.x, rt = blockIdx.y, tid = threadIdx.x, row0 = rt * 32;
    float acc[32];
    for (int r = 0; r < 32; ++r) acc[r] = 0.f;
    const bf16* bp = bt2 + (size_t)(pn * 256 + tid) * 2048;
    for (int k0 = 0; k0 < 2048; k0 += 64) {
        if (k0 == 1024) { for (int r = 0; r < 32; ++r) { float s = 0.f; for (int j = 0; j < 16; ++j) s += SSQ[(size_t)(row0 + r) * 16 + j]; acc[r] *= rsqrtf(s * (1.f / 1024.f) + EPS); } }
        __syncthreads();
        for (int e = tid; e < 32 * 64; e += 256) { const int r = e >> 6, kk = e & 63; As[r][kk] = bf2f(YQ[(size_t)(row0 + r) * 2048 + k0 + kk]); }
        __syncthreads();
        for (int kk = 0; kk < 64; ++kk) { const float bv = bf2f(bp[k0 + kk]);
            for (int r = 0; r < 32; ++r) acc[r] += As[r][kk] * bv; }
    }
    const int n = pn * 256 + tid;
    for (int r = 0; r < 32; ++r) { const int row = row0 + r; const float v = x[(size_t)row * DM + n] + mod[(size_t)(row / SEQ) * 3072 + 2048 + n] * acc[r];
        out[(size_t)row * DM + n] = v; float q = v * v;
        for (int o = 1; o < 64; o <<= 1) q += __shfl_xor(q, o);
        if ((tid & 63) == 0) RPART[(size_t)row * 16 + pn * 4 + (tid >> 6)] = q; }
}
__global__ void k_final(float* out, const float* RPART, const float* fg) {
    const int row = blockIdx.x * 4 + (threadIdx.x >> 6), lane = threadIdx.x & 63;
    float s = 0.f;
    for (int j = 0; j < 16; ++j) s += RPART[(size_t)row * 16 + j];
    const float rstd = rsqrtf(s * (1.f / DM) + EPS);
    for (int j = 0; j < 16; ++j) { const int k = lane + 64 * j; out[(size_t)row * DM + k] *= rstd * fg[k]; }
}


#ifndef FAST_MASK
#define FAST_MASK 0x7f
#endif
extern "C" void kernel_launch(void* const* d_in, const int* in_sizes, int n_in, void* d_out, int out_size, void* d_ws, size_t ws_size, hipStream_t stream) {
    if (n_in != 18 || out_size != ML * DM || ws_size < WS_END) { fprintf(stderr, "kernel_launch: unexpected shapes (n_in %d out %d ws %zu)\n", n_in, out_size, ws_size); return; }
    static int grid = 0;
    if (grid == 0) {
        int dev = 0, cus = 0;
        if (hipGetDevice(&dev) != hipSuccess || hipDeviceGetAttribute(&cus, hipDeviceAttributeMultiprocessorCount, dev) != hipSuccess) { fprintf(stderr, "kernel_launch: device query failed\n"); grid = -1; return; }
        if (hipFuncSetAttribute((const void*)mega, hipFuncAttributeMaxDynamicSharedMemorySize, LDS_BYTES) != hipSuccess) { fprintf(stderr, "kernel_launch: hipFuncSetAttribute failed\n"); grid = -1; return; }
        int per_cu = 0;
        if (hipOccupancyMaxActiveBlocksPerMultiprocessor(&per_cu, (const void*)mega, NWAVES * 64, LDS_BYTES) != hipSuccess || per_cu < 1) fprintf(stderr, "kernel_launch: note: occupancy query says %d blocks/CU\n", per_cu);
        (void)hipGetLastError();
        grid = cus;
    }
    if (grid < 0) return;
    const float* x = (const float*)d_in[0]; const float* c = (const float*)d_in[1]; const float* ctx = (const float*)d_in[2]; const float* c_ctx = (const float*)d_in[3];
    const float* ada_w = (const float*)d_in[4]; const float* ada_b = (const float*)d_in[5]; const float* norm_g = (const float*)d_in[6]; const float* w_in = (const float*)d_in[7];
    const float* conv_w = (const float*)d_in[8]; const float* conv_b = (const float*)d_in[9]; const float* dt_bias = (const float*)d_in[10]; const float* a_log = (const float*)d_in[11];
    const float* d_skip = (const float*)d_in[12]; const float* qg = (const float*)d_in[13]; const float* kg = (const float*)d_in[14]; const float* ssd_g = (const float*)d_in[15];
    const float* w_out = (const float*)d_in[16]; const float* final_g = (const float*)d_in[17];
    unsigned char* ws = (unsigned char*)d_ws; float* out = (float*)d_out;
    float* mod = (float*)(ws + WS_MOD); float* rope = (float*)(ws + WS_ROPE); float* SSQ = (float*)(ws + WS_SSQ); float* RPART = (float*)(ws + WS_RPART);
    bf16* bt1 = (bf16*)(ws + WS_BT1); bf16* bt2 = (bf16*)(ws + WS_BT2); float* DT = (float*)(ws + WS_DT); bf16* KB = (bf16*)(ws + WS_KB); bf16* VB = (bf16*)(ws + WS_VB);
    bf16* H = (bf16*)(ws + WS_R1); bf16* XC = (bf16*)(ws + WS_R1); bf16* XBC = (bf16*)(ws + WS_XBC); bf16* YQ = (bf16*)(ws + WS_YQ); bf16* Z = (bf16*)(ws + WS_Z);
    (void)hipMemsetAsync(ws + WS_CTL, 0, 1 * MiB, stream);
    Args a{};
    for (int i = 0; i < 18; ++i) a.in[i] = (const float*)d_in[i];
    a.out = out; a.ws = ws;
    for (int ph = 0; ph < NPHASE;) {
        if ((FAST_MASK >> ph) & 1) { int e = ph; while (e < NPHASE && ((FAST_MASK >> e) & 1)) ++e;
            a.ph_lo = ph; a.ph_hi = e; hipLaunchKernelGGL(mega, dim3(grid), dim3(NWAVES * 64), LDS_BYTES, stream, a);
            const hipError_t le = hipPeekAtLastError(); if (le != hipSuccess) fprintf(stderr, "kernel_launch: mega launch failed: %s\n", hipGetErrorName(le));
            ph = e; continue; }
        switch (ph) {
        case 0: k_mod<<<(33 * 3072 + 255) / 256, 256, 0, stream>>>(c, c_ctx, ada_w, ada_b, mod); k_tables<<<4, 256, 0, stream>>>(rope);
                k_bt1<<<(N1 * 1024) / 256, 256, 0, stream>>>(w_in, bt1); k_bt2<<<(1024 * 2048) / 256, 256, 0, stream>>>(w_out, ssd_g, bt2); break;
        case 1: k_norm<<<MT / 4, 256, 0, stream>>>(x, ctx, norm_g, mod, H); break;
        case 2: k_gemm1<<<dim3(21, MT / 32), 256, 0, stream>>>(H, bt1, rope, qg, kg, dt_bias, KB, VB, XBC, DT, YQ, Z); break;
        case 3: k_attn<<<dim3(SEQ / 64, 16, NB), 256, 0, stream>>>(YQ, KB, VB); k_conv<<<(unsigned)(((size_t)MT * CONVC + 255) / 256), 256, 0, stream>>>(XBC, conv_w, conv_b, XC); break;
        case 4: k_ssd<<<dim3(16, NB), 512, 0, stream>>>(XC, DT, Z, a_log, d_skip, YQ, SSQ); break;
        case 5: k_gemm2<<<dim3(4, ML / 32), 256, 0, stream>>>(YQ, bt2, SSQ, x, mod, out, RPART); break;
        case 6: k_final<<<ML / 4, 256, 0, stream>>>(out, RPART, final_g); break;
        }
        ++ph;
    }
}
```

```cpp
#include <hip/hip_runtime.h>
#include <cstdio>
#include <cstdint>
#include <hip/hip_bf16.h>

constexpr int DM = 1024, NB = 32, SEQ = 2048, CTXL = 256, KVL = SEQ + CTXL;
constexpr int ML = NB * SEQ, MC = NB * CTXL, MT = ML + MC;
constexpr int PROJ = 5152, OFF_XBC = 512, OFF_DT = 2048, CTXC = 2080, CONVC = 1536;
constexpr int N1 = 21 * 256;
constexpr float EPS = 1e-6f;
constexpr float C2 = 0.125f * 1.4426950408889634f;

typedef unsigned short bf16;
__device__ __forceinline__ int mk_lane() { return (int)__builtin_amdgcn_mbcnt_hi(~0u, __builtin_amdgcn_mbcnt_lo(~0u, 0u)); }
__host__ __device__ __forceinline__ unsigned f2bf(float f) { unsigned u = __builtin_bit_cast(unsigned, f); return (u + 0x7fffu + ((u >> 16) & 1u)) >> 16; }
__host__ __device__ __forceinline__ float bf2f(unsigned h) { return __builtin_bit_cast(float, (h & 0xffffu) << 16); }
__device__ __forceinline__ float siluf(float v) { return v / (1.f + __expf(-v)); }
__device__ __forceinline__ float softplusf(float v) { return v > 20.f ? v : log1pf(expf(v)); }

constexpr size_t MiB = 1u << 20;
constexpr size_t WS_CTL = 0;
constexpr size_t WS_MOD = 2 * MiB;
constexpr size_t WS_ROPE = 3 * MiB;
constexpr size_t WS_SSQ = 4 * MiB;
constexpr size_t WS_RPART = 8 * MiB;
constexpr size_t WS_BT1 = 12 * MiB;
constexpr size_t WS_BT2 = 23 * MiB;
constexpr size_t WS_DT = 28 * MiB;
constexpr size_t WS_KB = 38 * MiB;
constexpr size_t WS_VB = 74 * MiB;
constexpr size_t WS_R1 = 110 * MiB;
constexpr size_t WS_XBC = 326 * MiB;
constexpr size_t WS_YQ = 542 * MiB;
constexpr size_t WS_Z = 798 * MiB;
constexpr size_t WS_END = 926 * MiB;

__host__ __device__ __forceinline__ int hperm_dim(int vin) {
    const int bj = vin >> 7, wc = (vin >> 5) & 3, s = vin & 31, fq = s >> 3, e = s & 7;
    return wc * 64 + bj * 32 + (e >> 2) * 16 + 4 * fq + (e & 3);
}
__host__ __device__ __forceinline__ int hperm_inv(int head, int dim) {
    const int axis = dim >> 5, half = (dim >> 4) & 1, i16 = dim & 15, fq = i16 >> 2, e = (i16 & 3) + 4 * half;
    return 128 * axis + 32 * head + 8 * fq + e;
}
__host__ __device__ __forceinline__ int vcol_actual(int v) {
    const int t = v >> 8, vin = v & 255;
    if (t == 0) return hperm_dim(vin);
    if (t == 1) return 256 + vin;
    if (t < 8) return v;
    if (t == 8) return vin < 32 ? OFF_DT + vin : -1;
    if (t < 13) return CTXC + (t - 9) * 256 + hperm_dim(vin);
    if (t < 17) return CTXC + 1024 + (v - 13 * 256);
    return CTXC + 2048 + (v - 17 * 256);
}

namespace pg8 {
#define PG8_LAS __attribute__((address_space(3)))
typedef unsigned short bf16_t;
typedef short bf16x8 __attribute__((ext_vector_type(8)));
typedef float f32x4 __attribute__((ext_vector_type(4)));
typedef unsigned u32x4 __attribute__((ext_vector_type(4)));
constexpr int BM = 256, BK = 64, HALF = 128, HTB = HALF * BK * 2  , STAGE_BYTES = 8 * HTB, NXCD = 8, WGM = 8;

__host__ __device__ __forceinline__ int lds_byte(int r, int c) { const int st = (r >> 4) * 2 + (c >> 5), rr = r & 15, cc = c & 31, ob = rr * 64 + cc * 2; return st * 1024 + (ob ^ (((ob >> 9) & 1) << 5)); }
__host__ __device__ __forceinline__ void stage_rc(int b, int& R, int& C) { const int st = b / 1024, sb = b % 1024, swz = sb ^ (((sb >> 9) & 1) << 5); R = (st >> 1) * 16 + swz / 64; C = (st & 1) * 32 + (swz % 64) / 2; }
__host__ __device__ __forceinline__ int perm32(int rho) { const int n = rho >> 4, i = rho & 15; return 8 * (i >> 2) + 4 * n + (i & 3); }

struct Unit { int pm, pn; };
struct Gemm { const bf16_t* A; const bf16_t* Bt; int M, N, K; };

__device__ __forceinline__ unsigned cvt_pk_bf16(float lo, float hi) { unsigned r; asm volatile("v_cvt_pk_bf16_f32 %0, %1, %2" : "=v"(r) : "v"(lo), "v"(hi)); return r; }
typedef float f32x2 __attribute__((ext_vector_type(2)));
template <class Epi, class Sched, bool ALIGN_EPI = false, bool SP2 = false>
__device__ __forceinline__ void gemm_phase(PG8_LAS unsigned char* lds, const Gemm g, const Sched& S, const Epi& E, int wid_in) {
    const int wid = wid_in; int lane = mk_lane(); asm volatile("" : "+v"(lane)); const int tid = wid * 64 + lane, wr = wid >> 2, wc = wid & 3, fr = lane & 15, fq = lane >> 4;
    const int K = g.K, nt = K / BK;
    unsigned voffA[2], voffB[2];
#pragma unroll
    for (int i = 0; i < 2; ++i) { int R, C; stage_rc(tid * 16 + i * 8192, R, C); const int Rb = Epi::PERM ? ((R & ~31) + perm32(R & 31)) : R;
        voffA[i] = (unsigned)(R * K + C) * 2u; voffB[i] = (unsigned)(Rb * K + C) * 2u; }
    const size_t kstep = (size_t)(BK * 2);
    const size_t hstep = (size_t)HALF * K * 2;
    const size_t tstep = 2 * hstep;
    const unsigned ldsw = (unsigned)wid * 1024u;
    const int aoff = lds_byte(wr * 64 + fr, fq * 8), boff = lds_byte(wc * 32 + fr, fq * 8);
#define PG8_SA(b, h) (((b) * 2 + (h)) * HTB)
#define PG8_SB(b, h) ((4 + (b) * 2 + (h)) * HTB)
#define PG8_STAGE(bufoff, gbase, voff) do { _Pragma("unroll") for (int _i = 0; _i < 2; ++_i) \
        __builtin_amdgcn_global_load_lds((const unsigned*)((const char*)(gbase) + (voff)[_i]), (PG8_LAS unsigned*)(lds + (bufoff) + ldsw + _i * 8192), 16, 0, 0); } while (0)
#define PG8_LDA(dst, b, h) do { _Pragma("unroll") for (int m = 0; m < 4; ++m) _Pragma("unroll") for (int k = 0; k < 2; ++k) dst[m][k] = *(const PG8_LAS bf16x8*)(lds + PG8_SA(b, h) + aoff + m * 2048 + k * 1024); } while (0)
#define PG8_LDB(dst, b, h) do { _Pragma("unroll") for (int n = 0; n < 2; ++n) _Pragma("unroll") for (int k = 0; k < 2; ++k) dst[n][k] = *(const PG8_LAS bf16x8*)(lds + PG8_SB(b, h) + boff + n * 2048 + k * 1024); } while (0)
#define PG8_MMA(ai, bj, At, Bt) do { __builtin_amdgcn_s_setprio(1); _Pragma("unroll") for (int m = 0; m < 4; ++m) _Pragma("unroll") for (int n = 0; n < 2; ++n) _Pragma("unroll") for (int k = 0; k < 2; ++k) \
        acc[ai][bj][m][n] = __builtin_amdgcn_mfma_f32_16x16x32_bf16(Bt[n][k], At[m][k], acc[ai][bj][m][n], 0, 0, 0); __builtin_amdgcn_s_setprio(0); } while (0)
#define PG8_WAIT_V(n) asm volatile("s_waitcnt vmcnt(" #n ")" ::: "memory")
#define PG8_WAIT_L(n) asm volatile("s_waitcnt lgkmcnt(" #n ")" ::: "memory")
#define PG8_BAR __builtin_amdgcn_s_barrier()
#define PG8_SCHED __builtin_amdgcn_sched_barrier(0)
    Unit cur, nxt; int ui = 0;
    if (!S.next(0, cur)) return;
    f32x4 acc[2][2][4][2];
#pragma unroll
    for (int a = 0; a < 2; ++a)
#pragma unroll
        for (int b = 0; b < 2; ++b)
#pragma unroll
            for (int m = 0; m < 4; ++m)
#pragma unroll
                for (int n = 0; n < 2; ++n) acc[a][b][m][n] = (f32x4){0.f, 0.f, 0.f, 0.f};
    bf16x8 At[4][2], B0[2][2], B1[2][2];
    const char* cA = (const char*)g.A + (size_t)cur.pm * tstep; const char* cB = (const char*)g.Bt + (size_t)cur.pn * tstep;
    S.a_ready(cur);
    if constexpr (SP2) {
        PG8_STAGE(PG8_SB(0, 0), cB, voffB); PG8_STAGE(PG8_SB(0, 1), cB + hstep, voffB); PG8_STAGE(PG8_SA(0, 0), cA, voffA); PG8_STAGE(PG8_SA(0, 1), cA + hstep, voffA);
        if (wr == 1) PG8_BAR;
        PG8_WAIT_V(2); PG8_BAR;
        PG8_STAGE(PG8_SB(1, 0), cB + kstep, voffB); PG8_STAGE(PG8_SA(1, 0), cA + kstep, voffA); PG8_STAGE(PG8_SB(1, 1), cB + hstep + kstep, voffB);
        PG8_WAIT_V(6); PG8_BAR;
    } else {
        PG8_STAGE(PG8_SB(0, 0), cB, voffB); PG8_STAGE(PG8_SA(0, 0), cA, voffA); PG8_STAGE(PG8_SB(0, 1), cB + hstep, voffB); PG8_STAGE(PG8_SA(0, 1), cA + hstep, voffA);
        if (wr == 1) PG8_BAR;
        PG8_WAIT_V(4); PG8_BAR;
        PG8_STAGE(PG8_SB(1, 0), cB + kstep, voffB); PG8_STAGE(PG8_SA(1, 0), cA + kstep, voffA); PG8_STAGE(PG8_SB(1, 1), cB + hstep + kstep, voffB);
        PG8_WAIT_V(6); PG8_BAR;
    }
    for (;;) {
        const bool has_next = S.next(ui + 1, nxt);
        const char* nA = has_next ? (const char*)g.A + (size_t)nxt.pm * tstep : cA; const char* nB = has_next ? (const char*)g.Bt + (size_t)nxt.pn * tstep : cB;
        for (int t = 0; t < nt; t += 2) {
            if constexpr (Epi::MIDK) { if (t == nt / 2) E.midk(acc, ui, wr, fr); }
            const bool last = (t == nt - 2);
            const char* a1 = cA + (size_t)(t + 1) * kstep;
            const char* a2 = last ? nA : cA + (size_t)(t + 2) * kstep; const char* b2 = last ? nB : cB + (size_t)(t + 2) * kstep;
            const char* a3 = a2 + kstep; const char* b3 = b2 + kstep;
            if (last && has_next) S.a_ready(nxt);
            if constexpr (SP2) {
            PG8_LDB(B0, 0, 0); PG8_LDB(B1, 0, 1); PG8_SCHED; PG8_LDA(At, 0, 0); PG8_STAGE(PG8_SA(1, 1), a1 + hstep, voffA);
            PG8_WAIT_V(8); PG8_WAIT_L(0); PG8_BAR; PG8_MMA(0, 0, At, B0); PG8_MMA(0, 1, At, B1); PG8_BAR; PG8_SCHED;
            PG8_LDA(At, 0, 1); PG8_STAGE(PG8_SB(0, 0), b2, voffB); PG8_STAGE(PG8_SB(0, 1), b2 + hstep, voffB); PG8_STAGE(PG8_SA(0, 0), a2, voffA);
            PG8_WAIT_V(8); PG8_WAIT_L(0); PG8_BAR; PG8_MMA(1, 0, At, B0); PG8_MMA(1, 1, At, B1); PG8_BAR; PG8_SCHED;
            PG8_LDB(B0, 1, 0); PG8_LDB(B1, 1, 1); PG8_SCHED; PG8_LDA(At, 1, 0); PG8_STAGE(PG8_SA(0, 1), a2 + hstep, voffA);
            PG8_WAIT_V(8); PG8_WAIT_L(0); PG8_BAR; PG8_MMA(0, 0, At, B0); PG8_MMA(0, 1, At, B1); PG8_BAR; PG8_SCHED;
            PG8_LDA(At, 1, 1); PG8_STAGE(PG8_SB(1, 0), b3, voffB); PG8_STAGE(PG8_SB(1, 1), b3 + hstep, voffB); PG8_STAGE(PG8_SA(1, 0), a3, voffA);
            PG8_WAIT_V(8); PG8_WAIT_L(0); PG8_BAR; PG8_MMA(1, 0, At, B0); PG8_MMA(1, 1, At, B1); PG8_BAR; PG8_SCHED;
            } else {
            PG8_LDB(B0, 0, 0); PG8_SCHED; PG8_LDA(At, 0, 0); PG8_STAGE(PG8_SA(1, 1), a1 + hstep, voffA);
            PG8_WAIT_L(8); PG8_BAR; PG8_WAIT_L(0); PG8_MMA(0, 0, At, B0); PG8_BAR; PG8_SCHED;
            PG8_LDB(B1, 0, 1); PG8_STAGE(PG8_SB(0, 0), b2, voffB);
            PG8_BAR; PG8_WAIT_L(0); PG8_MMA(0, 1, At, B1); PG8_BAR;
            PG8_LDA(At, 0, 1); PG8_STAGE(PG8_SA(0, 0), a2, voffA);
            PG8_BAR; PG8_WAIT_L(0); PG8_MMA(1, 0, At, B0); PG8_BAR; PG8_SCHED;
            PG8_STAGE(PG8_SB(0, 1), b2 + hstep, voffB);
            PG8_WAIT_V(6); PG8_BAR; PG8_MMA(1, 1, At, B1); PG8_BAR;
            PG8_LDB(B0, 1, 0); PG8_SCHED; PG8_LDA(At, 1, 0); PG8_STAGE(PG8_SA(0, 1), a2 + hstep, voffA);
            PG8_WAIT_L(8); PG8_BAR; PG8_WAIT_L(0); PG8_MMA(0, 0, At, B0); PG8_BAR; PG8_SCHED;
            PG8_LDB(B1, 1, 1); PG8_STAGE(PG8_SB(1, 0), b3, voffB);
            PG8_BAR; PG8_WAIT_L(0); PG8_MMA(0, 1, At, B1); PG8_BAR;
            PG8_LDA(At, 1, 1); PG8_STAGE(PG8_SA(1, 0), a3, voffA);
            PG8_BAR; PG8_WAIT_L(0); PG8_MMA(1, 0, At, B0); PG8_BAR; PG8_SCHED;
            PG8_STAGE(PG8_SB(1, 1), b3 + hstep, voffB);
            PG8_WAIT_V(6); PG8_BAR; PG8_MMA(1, 1, At, B1); PG8_BAR;
            }
        }
        if constexpr (ALIGN_EPI) { if (wr == 0) PG8_BAR; }
        if constexpr (!Epi::AFTER_DRAIN) { E(acc, cur, wr, wc, fr, fq); S.done(cur); }
        if (!has_next) break;
#pragma unroll
        for (int a = 0; a < 2; ++a)
#pragma unroll
            for (int b = 0; b < 2; ++b)
#pragma unroll
                for (int m = 0; m < 4; ++m)
#pragma unroll
                    for (int n = 0; n < 2; ++n) acc[a][b][m][n] = (f32x4){0.f, 0.f, 0.f, 0.f};
        cur = nxt; cA = nA; cB = nB; ++ui;
        if constexpr (ALIGN_EPI) { if (wr == 1) PG8_BAR; }
    }
    PG8_WAIT_V(0);
    if constexpr (!ALIGN_EPI) { if (wr == 0) PG8_BAR; }
    PG8_BAR;
    if constexpr (Epi::AFTER_DRAIN) { E.fused(acc, cur, wr, wc, fr, fq, lds, wid, lane); S.done(cur); }
#undef PG8_SA
#undef PG8_SB
#undef PG8_STAGE
#undef PG8_LDA
#undef PG8_LDB
#undef PG8_MMA
#undef PG8_WAIT_V
#undef PG8_WAIT_L
#undef PG8_BAR
#undef PG8_SCHED
}
struct Sched1 {
    int G, c;
    __device__ __forceinline__ void init(int G_, int c_) { G = G_; c = c_; }
    __device__ __forceinline__ bool next(int i, Unit& u) const {
        constexpr int nN = 21, nwg = 256 * nN;
        const int L = i * G + c;
        if (L < nwg) { const int wgid = (L % NXCD) * (nwg / NXCD) + L / NXCD; const int nig = WGM * nN, fm = (wgid / nig) * WGM;
            u.pm = fm + ((wgid % nig) % WGM); u.pn = (wgid % nig) / WGM; return true; }
        const int L2 = L - nwg; if (L2 >= 288) return false;
        const int wg = (L2 % NXCD) * 36 + L2 / NXCD; u.pn = wg >> 5; u.pm = 256 + (wg & 31); return true;
    }
    __device__ __forceinline__ void a_ready(const Unit&) const {}
    __device__ __forceinline__ void done(const Unit&) const {}
};
struct Sched2 {
    int G, c;
    __device__ __forceinline__ void init(int G_, int c_) { G = G_; c = c_; }
    __device__ __forceinline__ bool next(int i, Unit& u) const {
        constexpr int nN = 4, nwg = 256 * nN;
        const int L = i * G + c; if (L >= nwg) return false;
        const int wgid = (L % NXCD) * (nwg / NXCD) + L / NXCD; const int nig = WGM * nN, fm = (wgid / nig) * WGM;
        u.pm = fm + ((wgid % nig) % WGM); u.pn = (wgid % nig) / WGM; return true;
    }
    __device__ __forceinline__ void a_ready(const Unit&) const {}
    __device__ __forceinline__ void done(const Unit&) const {}
};
__device__ __forceinline__ float dot4(const f32x4 a) { return (a[0] * a[0] + a[1] * a[1]) + (a[2] * a[2] + a[3] * a[3]); }
__device__ __forceinline__ float silu1(float v) { return v * __builtin_amdgcn_rcpf(1.f + __expf(-v)); }
typedef unsigned u32x2 __attribute__((ext_vector_type(2)));
__device__ __forceinline__ u32x2 pk4(const f32x4 v) { u32x2 w; w.x = cvt_pk_bf16(v[0], v[1]); w.y = cvt_pk_bf16(v[2], v[3]); return w; }
struct Epi1 {
    static constexpr bool PERM = true, AFTER_DRAIN = false, MIDK = false;
    bf16_t *KB, *VB, *XBC, *YQ, *Z; float* DT; const float *rope, *qg, *kg, *dt_bias;
    __device__ __forceinline__ void midk(f32x4 (&)[2][2][4][2], int, int, int) const {}
    __device__ __forceinline__ void operator()(const f32x4 (&acc)[2][2][4][2], const Unit& u, int wr, int wc, int fr_in, int fq_in) const {
        int fr = fr_in, fq = fq_in; asm volatile("" : "+v"(fr), "+v"(fq));
        const int pn = u.pn, pm = u.pm; const bool isctx = pm >= 256; const int rloc = wr * 64 + fr;
        const int bb = isctx ? pm - 256 : pm >> 3, pos0 = isctx ? SEQ : (pm & 7) * 256;
        if (pn == 0 || (pn >= 9 && pn < 13)) {
            const float* g = pn == 0 ? kg : qg;
            const f32x4 g00 = *(const f32x4*)(g + 4 * fq), g01 = *(const f32x4*)(g + 16 + 4 * fq), g10 = *(const f32x4*)(g + 32 + 4 * fq), g11 = *(const f32x4*)(g + 48 + 4 * fq);
            const float osc = pn == 0 ? 1.f : C2;
            bf16_t* dbase; size_t pitch;
            if (pn == 0) { dbase = KB + ((size_t)bb * KVL + pos0) * 256 + wc * 64 + 4 * fq; pitch = 256; }
            else { dbase = YQ + (size_t)pm * 256 * 2048 + 1024 + ((pn - 9) * 4 + wc) * 64 + 4 * fq; pitch = 2048; }
#pragma unroll
            for (int ai = 0; ai < 2; ++ai) {
                const int prow = (pm & 7) * 4 + 2 * ai + wr;
                f32x4 c0 = (f32x4){1.f, 1.f, 1.f, 1.f}, s0 = (f32x4){0.f, 0.f, 0.f, 0.f};
                if (!isctx) { c0 = *(const f32x4*)(rope + prow * 16 + 4 * fq); s0 = *(const f32x4*)(rope + 1024 + prow * 16 + 4 * fq); }
#pragma unroll
                for (int m = 0; m < 4; ++m) {
                    f32x4 a0 = acc[ai][0][m][0], a1 = acc[ai][0][m][1], b0 = acc[ai][1][m][0], b1 = acc[ai][1][m][1];
                    float s = (dot4(a0) + dot4(a1)) + (dot4(b0) + dot4(b1));
                    s += __shfl_xor(s, 16); s += __shfl_xor(s, 32);
                    const float rstd = rsqrtf(s * (1.f / 64.f) + EPS) * osc;
                    a0 = a0 * rstd * g00; a1 = a1 * rstd * g01; b0 = b0 * rstd * g10; b1 = b1 * rstd * g11;
                    f32x4 c1 = (f32x4){1.f, 1.f, 1.f, 1.f}, s1 = (f32x4){0.f, 0.f, 0.f, 0.f};
                    if (!isctx) { const int pcol = 16 * m + fr; c1 = *(const f32x4*)(rope + pcol * 16 + 4 * fq); s1 = *(const f32x4*)(rope + 1024 + pcol * 16 + 4 * fq); }
                    const f32x4 o00 = a0 * c0 - a1 * s0, o01 = a1 * c0 + a0 * s0, o10 = b0 * c1 - b1 * s1, o11 = b1 * c1 + b0 * s1;
                    bf16_t* dst = dbase + (size_t)(rloc + 128 * ai + 16 * m) * pitch;
                    *(u32x2*)(dst) = pk4(o00); *(u32x2*)(dst + 16) = pk4(o01); *(u32x2*)(dst + 32) = pk4(o10); *(u32x2*)(dst + 48) = pk4(o11);
                    asm volatile("" ::: "memory");
                }
            }
        } else if (pn == 8) {
            if (wc == 0) {
                const f32x4 bA = *(const f32x4*)(dt_bias + 8 * fq), bB = *(const f32x4*)(dt_bias + 8 * fq + 4);
#pragma unroll
                for (int ai = 0; ai < 2; ++ai)
#pragma unroll
                    for (int m = 0; m < 4; ++m) { const size_t row = (size_t)pm * 256 + rloc + 128 * ai + 16 * m;
                        f32x4 v0 = acc[ai][0][m][0] + bA, v1 = acc[ai][0][m][1] + bB;
#pragma unroll
                        for (int e = 0; e < 4; ++e) { v0[e] = v0[e] > 20.f ? v0[e] : log1pf(__expf(v0[e])); v1[e] = v1[e] > 20.f ? v1[e] : log1pf(__expf(v1[e])); }
                        *(f32x4*)(DT + row * 32 + 8 * fq) = v0; *(f32x4*)(DT + row * 32 + 8 * fq + 4) = v1; asm volatile("" ::: "memory"); }
            }
        } else {
            bf16_t* dbase; size_t pitch; bool act = false;
            const int cin = wc * 32 + 8 * fq;
            if (pn == 1) { dbase = VB + ((size_t)bb * KVL + pos0) * 256 + cin; pitch = 256; }
            else if (pn < 8) { dbase = XBC + (size_t)pm * 256 * CONVC + (pn - 2) * 256 + cin; pitch = CONVC; }
            else if (pn < 17) { dbase = YQ + (size_t)pm * 256 * 2048 + (pn - 13) * 256 + cin; pitch = 2048; act = true; }
            else { dbase = Z + (size_t)pm * 256 * 1024 + (pn - 17) * 256 + cin; pitch = 1024; act = true; }
#pragma unroll
            for (int ai = 0; ai < 2; ++ai)
#pragma unroll
                for (int m = 0; m < 4; ++m) { bf16_t* dst = dbase + (size_t)(rloc + 128 * ai + 16 * m) * pitch;
#pragma unroll
                    for (int bj = 0; bj < 2; ++bj) { f32x4 v0 = acc[ai][bj][m][0], v1 = acc[ai][bj][m][1];
                        if (act) {
#pragma unroll
                            for (int e = 0; e < 4; ++e) { v0[e] = silu1(v0[e]); v1[e] = silu1(v1[e]); } }
                        u32x4 w; w.x = cvt_pk_bf16(v0[0], v0[1]); w.y = cvt_pk_bf16(v0[2], v0[3]); w.z = cvt_pk_bf16(v1[0], v1[1]); w.w = cvt_pk_bf16(v1[2], v1[3]);
                        *(u32x4*)(dst + bj * HALF) = w; } asm volatile("" ::: "memory"); }
        }
    }
};
struct Epi2 {
    static constexpr bool PERM = false, AFTER_DRAIN = false, MIDK = true;
    const float* x; const float* mod; const float* fg; float* out; unsigned long long* xbuf; unsigned* cnt; unsigned* tmo; const PG8_LAS float* rstd_tab; PG8_LAS float* exl;
    __device__ __forceinline__ void midk(f32x4 (&acc)[2][2][4][2], int ui, int wr, int fr) const {
#pragma unroll
        for (int ai = 0; ai < 2; ++ai)
#pragma unroll
            for (int m = 0; m < 4; ++m) { const float r = rstd_tab[ui * 256 + 128 * ai + 64 * wr + 16 * m + fr];
#pragma unroll
                for (int bj = 0; bj < 2; ++bj)
#pragma unroll
                    for (int n = 0; n < 2; ++n) acc[ai][bj][m][n] *= r; }
    }
    __device__ __forceinline__ void operator()(f32x4 (&acc)[2][2][4][2], const Unit& u, int wr, int wc, int fr_in, int fq_in) const {
        int fr = fr_in, fq = fq_in; asm volatile("" : "+v"(fr), "+v"(fq));
        const int lane = mk_lane(); const int tid = (wr * 4 + wc) * 64 + lane;
        const int b = u.pm >> 3, col0 = u.pn * BM + wc * 32 + 4 * fq;
        PG8_LAS float* P = exl; PG8_LAS float* S = exl + 1024;
        { f32x4 gv[2][2];
#pragma unroll
          for (int bj = 0; bj < 2; ++bj)
#pragma unroll
            for (int n = 0; n < 2; ++n) gv[bj][n] = *(const f32x4*)(mod + (size_t)b * 3072 + 2048 + col0 + bj * HALF + n * 16);
#pragma unroll
          for (int ai = 0; ai < 2; ++ai)
#pragma unroll
            for (int m = 0; m < 4; ++m) { const int rt = 128 * ai + 64 * wr + 16 * m + fr; const size_t off = ((size_t)u.pm * BM + rt) * 1024 + col0; float q = 0.f;
#pragma unroll
                for (int bj = 0; bj < 2; ++bj)
#pragma unroll
                    for (int n = 0; n < 2; ++n) { const f32x4 xv = *(const f32x4*)(x + off + bj * HALF + n * 16); const f32x4 o = xv + gv[bj][n] * acc[ai][bj][m][n]; acc[ai][bj][m][n] = o; q += dot4(o); }
                q += __shfl_xor(q, 16); q += __shfl_xor(q, 32);
                if (fq == 0) P[rt * 4 + wc] = q;
                if (m & 1) asm volatile("" ::: "memory"); } }
        asm volatile("s_waitcnt lgkmcnt(0)" ::: "memory"); __builtin_amdgcn_s_barrier(); asm volatile("" ::: "memory");
        if (tid < 256) {
            const f32x4 p = *(const PG8_LAS f32x4*)(P + tid * 4); const float s = (p[0] + p[1]) + (p[2] + p[3]);
            __hip_atomic_store((float*)xbuf + ((size_t)u.pm * BM + tid) * 4 + u.pn, s, __ATOMIC_RELAXED, __HIP_MEMORY_SCOPE_AGENT);
        }
        asm volatile("s_waitcnt vmcnt(0)" ::: "memory");
        if (tid < 256 && lane == 0) __hip_atomic_fetch_add(cnt + 64 * u.pm, 1u, __ATOMIC_RELAXED, __HIP_MEMORY_SCOPE_AGENT);
        if (tid < 64) {
            unsigned sp = 0;
            while ((unsigned)__builtin_amdgcn_readfirstlane(__hip_atomic_load(cnt + 64 * u.pm, __ATOMIC_RELAXED, __HIP_MEMORY_SCOPE_AGENT)) < 16u) {
                __builtin_amdgcn_s_sleep(2); if (++sp > (1u << 22)) { if (lane == 0) __hip_atomic_store(tmo, 1u, __ATOMIC_RELAXED, __HIP_MEMORY_SCOPE_AGENT); break; } }
        }
        asm volatile("s_waitcnt vmcnt(0) lgkmcnt(0)" ::: "memory"); __builtin_amdgcn_s_barrier(); asm volatile("" ::: "memory");
        if (tid < 256) {
            const unsigned long long* sl = xbuf + ((size_t)u.pm * BM + tid) * 2;
            const unsigned long long w0 = __hip_atomic_load(sl, __ATOMIC_RELAXED, __HIP_MEMORY_SCOPE_AGENT), w1 = __hip_atomic_load(sl + 1, __ATOMIC_RELAXED, __HIP_MEMORY_SCOPE_AGENT);
            const float s = (__uint_as_float((unsigned)w0) + __uint_as_float((unsigned)(w0 >> 32))) + (__uint_as_float((unsigned)w1) + __uint_as_float((unsigned)(w1 >> 32)));
            S[tid] = rsqrtf(s * (1.f / 1024.f) + EPS);
        }
        asm volatile("s_waitcnt lgkmcnt(0)" ::: "memory"); __builtin_amdgcn_s_barrier(); asm volatile("" ::: "memory");
        { f32x4 fv[2][2];
#pragma unroll
          for (int bj = 0; bj < 2; ++bj)
#pragma unroll
            for (int n = 0; n < 2; ++n) fv[bj][n] = *(const f32x4*)(fg + col0 + bj * HALF + n * 16);
#pragma unroll
          for (int ai = 0; ai < 2; ++ai)
#pragma unroll
            for (int m = 0; m < 4; ++m) { const int rt = 128 * ai + 64 * wr + 16 * m + fr; const size_t off = ((size_t)u.pm * BM + rt) * 1024 + col0; const float r = S[rt];
#pragma unroll
                for (int bj = 0; bj < 2; ++bj)
#pragma unroll
                    for (int n = 0; n < 2; ++n) *(f32x4*)(out + off + bj * HALF + n * 16) = acc[ai][bj][m][n] * r * fv[bj][n];
                if (m & 1) asm volatile("" ::: "memory"); } }
    }
};
}
#define GAS __attribute__((address_space(1)))
#define LAS __attribute__((address_space(3)))
typedef unsigned v4u __attribute__((ext_vector_type(4)));
typedef GAS unsigned gu32;
typedef GAS unsigned long long gu64;
#define RLX_AGENT __ATOMIC_RELAXED, __HIP_MEMORY_SCOPE_AGENT
#define LDS_WAIT() asm volatile("s_waitcnt lgkmcnt(0)" ::: "memory")
#define VM_WAIT() asm volatile("s_waitcnt vmcnt(0)" ::: "memory")
__device__ __forceinline__ unsigned long long rt() { return __builtin_amdgcn_s_memrealtime(); }
typedef float f32x2_pk __attribute__((ext_vector_type(2))); typedef __bf16 bf16x2_pk __attribute__((ext_vector_type(2)));
__device__ __forceinline__ unsigned pk2(float lo, float hi) { const f32x2_pk v = {lo, hi}; return __builtin_bit_cast(unsigned, __builtin_convertvector(v, bf16x2_pk)); }
#define XB_TMO      128
#define XB_XCNT(j)  (256  + 64 * (j))
#define XB_XSUB(j)  (1280 + 64 * (j))
#define XB_XGEN(j)  (2304 + 64 * (j))
#define XB_TOP      3328
#define XB_TOPGEN   3392
#define XCD_BAR_WORDS 3456
#define XB_SPIN_CAP (1u << 22)

__device__ __forceinline__ unsigned xb_ld(unsigned* p)              { return __hip_atomic_load(p, __ATOMIC_RELAXED, __HIP_MEMORY_SCOPE_AGENT); }
__device__ __forceinline__ unsigned xb_add(unsigned* p, unsigned v) { return __hip_atomic_fetch_add(p, v, __ATOMIC_RELAXED, __HIP_MEMORY_SCOPE_AGENT); }
__device__ __forceinline__ unsigned xb_xcc_id() { return (unsigned)__builtin_amdgcn_s_getreg((3 << 11) | 20) & 0xFu; }
#define XB_SPIN(cond, bar) do { unsigned _sp = 0; while (cond) { __builtin_amdgcn_s_sleep(1); \
    if ((++_sp & 255u) == 0u) { if (xb_ld(&(bar)[XB_TMO])) break; if (_sp > XB_SPIN_CAP) { atomicAdd(&(bar)[XB_TMO], 1u); break; } } } } while (0)

struct XcdBarrier {
    unsigned* bar; unsigned x;
    volatile LAS unsigned* st;
};

__device__ __forceinline__ XcdBarrier xcd_barrier_post(unsigned* bar, volatile LAS unsigned* st, bool leader) {
    XcdBarrier b; b.bar = bar; b.x = xb_xcc_id(); b.st = st;
    if (leader) (void)xb_add(&bar[XB_XCNT(b.x)], 1u);
    return b;
}
__device__ __forceinline__ void xcd_barrier_complete(unsigned* bar, unsigned x, unsigned& nloc, unsigned& nx) {
    const unsigned G = gridDim.x * gridDim.y * gridDim.z;
    unsigned sum, cnt, mine, sp = 0u;
    for (;;) {
        sum = 0u; cnt = 0u; mine = 0u;
#pragma unroll
        for (unsigned j = 0; j < 16; ++j) { const unsigned c = xb_ld(&bar[XB_XCNT(j)]); sum += c; cnt += (c > 0u) ? 1u : 0u; mine = (j == x) ? c : mine; }
        if (sum == G) break;
        __builtin_amdgcn_s_sleep(1);
        if ((++sp & 255u) == 0u) { if (xb_ld(&bar[XB_TMO])) break; if (sp > XB_SPIN_CAP) { atomicAdd(&bar[XB_TMO], 1u); break; } }
    }
    nloc = mine > 0u ? mine : 1u; nx = cnt > 0u ? cnt : 1u;
}

__device__ __forceinline__ void xcd_barrier(const XcdBarrier& b, bool leader) {
    asm volatile("s_waitcnt vmcnt(0)" ::: "memory");
    __syncthreads();
    if (leader) {
        unsigned* bar = b.bar;
        __builtin_amdgcn_s_waitcnt(0);
        unsigned nloc = b.st[0], nx = b.st[1];
        if (nloc == 0u) { xcd_barrier_complete(bar, b.x, nloc, nx); b.st[0] = nloc; b.st[1] = nx; }
        const unsigned old = xb_add(&bar[XB_XSUB(b.x)], 1u);
        const unsigned gen = old / nloc;
        if (old + 1u == (gen + 1u) * nloc) {
            __builtin_amdgcn_fence(__ATOMIC_RELEASE, "agent");
            asm volatile("s_waitcnt vmcnt(0)" ::: "memory");
            const unsigned og = xb_add(&bar[XB_TOP], 1u);
            const unsigned tg = og / nx;
            if (og + 1u == (tg + 1u) * nx) xb_add(&bar[XB_TOPGEN], 1u);
            else XB_SPIN(xb_ld(&bar[XB_TOPGEN]) == tg, bar);
            __builtin_amdgcn_fence(__ATOMIC_ACQUIRE, "agent");
            xb_add(&bar[XB_XGEN(b.x)], 1u);
            asm volatile("s_waitcnt vmcnt(0)" ::: "memory");
        } else {
            XB_SPIN(xb_ld(&bar[XB_XGEN(b.x)]) == gen, bar);
            __builtin_amdgcn_fence(__ATOMIC_ACQUIRE, "agent");
            asm volatile("s_waitcnt vmcnt(0)" ::: "memory");
        }
    }
    __syncthreads();
}

typedef float f32x4 __attribute__((ext_vector_type(4)));
constexpr int NWAVES = 8;
__device__ __forceinline__ float wave_sum(float v) {
#pragma unroll
    for (int o = 1; o < 64; o <<= 1) v += __shfl_xor(v, o);
    return v;
}
__device__ __forceinline__ float dot4g(const f32x4 a) { return (a[0] * a[0] + a[1] * a[1]) + (a[2] * a[2] + a[3] * a[3]); }
__device__ __forceinline__ void p0_bt1_item(const float* W, bf16* WT, LAS float* scr, int item, int lane) {
    const int kb = item / 168, vb = item % 168, k0 = 64 * kb, v0 = 32 * vb;
    const int a = vcol_actual(v0 + (lane & 31));
#pragma unroll 8
    for (int i = 0; i < 32; ++i) { const int kk = 2 * i + (lane >> 5); scr[kk * 33 + (lane & 31)] = a >= 0 ? W[(size_t)(k0 + kk) * PROJ + a] : 0.f; }
    LDS_WAIT(); asm volatile("" ::: "memory");
    const int c = lane & 7;
#pragma unroll
    for (int j = 0; j < 4; ++j) { const int n = (lane >> 3) + 8 * j; const LAS float* s = scr + (8 * c) * 33 + n;
        v4u o; o.x = pk2(s[0 * 33], s[1 * 33]); o.y = pk2(s[2 * 33], s[3 * 33]); o.z = pk2(s[4 * 33], s[5 * 33]); o.w = pk2(s[6 * 33], s[7 * 33]);
        *(GAS v4u*)(WT + (size_t)(v0 + n) * 1024 + k0 + 8 * c) = o; }
    LDS_WAIT(); asm volatile("" ::: "memory");
}
__device__ __forceinline__ void p0_bt2_item(const float* W, const float* sg, bf16* WT, LAS float* scr, int item, int lane) {
    const int kb = item >> 5, nb = item & 31, kk0 = 64 * kb, n0 = 32 * nb;
#pragma unroll 8
    for (int i = 0; i < 32; ++i) { const int kk = 2 * i + (lane >> 5), kq = kk0 + kk; const int ks = kq < 1024 ? 1024 + kq : kq - 1024;
        float v = W[(size_t)ks * 1024 + n0 + (lane & 31)]; if (kq < 1024) v *= sg[kq]; scr[kk * 33 + (lane & 31)] = v; }
    LDS_WAIT(); asm volatile("" ::: "memory");
    const int c = lane & 7;
#pragma unroll
    for (int j = 0; j < 4; ++j) { const int n = (lane >> 3) + 8 * j; const LAS float* s = scr + (8 * c) * 33 + n;
        v4u o; o.x = pk2(s[0 * 33], s[1 * 33]); o.y = pk2(s[2 * 33], s[3 * 33]); o.z = pk2(s[4 * 33], s[5 * 33]); o.w = pk2(s[6 * 33], s[7 * 33]);
        *(GAS v4u*)(WT + (size_t)(n0 + n) * 2048 + kk0 + 8 * c) = o; }
    LDS_WAIT(); asm volatile("" ::: "memory");
}
__device__ __forceinline__ void p0_mod_block(const float* c, const float* c_ctx, const float* ada_w, const float* ada_b, float* mod, LAS float* ldsf, int cb, int tid, int lane, int wave) {
    LAS float* sil = ldsf; LAS float* red = ldsf + 33 * 256;
    float acc[33];
#pragma unroll
    for (int b = 0; b < 33; ++b) acc[b] = 0.f;
    for (int q = 0; q < 4; ++q) {
        __syncthreads();
        for (int e = tid; e < 33 * 256; e += NWAVES * 64) { const int b = e >> 8, k = e & 255; const float v = b < 32 ? c[b * 1024 + q * 256 + k] : c_ctx[q * 256 + k]; sil[e] = siluf(v); }
        __syncthreads();
#pragma unroll 8
        for (int kk = 0; kk < 32; ++kk) { const int kl = wave * 32 + kk; const float w = ada_w[(size_t)(q * 256 + kl) * 3072 + cb * 64 + lane];
#pragma unroll
            for (int b = 0; b < 33; ++b) acc[b] += sil[b * 256 + kl] * w; }
    }
#pragma unroll
    for (int b = 0; b < 33; ++b) red[(wave * 33 + b) * 64 + lane] = acc[b];
    __syncthreads();
    for (int e = tid; e < 33 * 64; e += NWAVES * 64) { const int b = e >> 6, col = e & 63; float s = 0.f;
#pragma unroll
        for (int w = 0; w < 8; ++w) s += red[(w * 33 + b) * 64 + col];
        mod[b * 3072 + cb * 64 + col] = s + ada_b[cb * 64 + col]; }
    __syncthreads();
}
__device__ __forceinline__ const float* p1_src(const float* x, const float* ctx, int m) { return m < ML ? x + (size_t)m * DM : ctx + (size_t)(m - ML) * DM; }
__device__ __forceinline__ void p1_load4(f32x4 (&v)[4][4], const float* x, const float* ctx, int m0, int lane) {
#pragma unroll
    for (int r = 0; r < 4; ++r) { const GAS f32x4* xr = (const GAS f32x4*)p1_src(x, ctx, m0 + r) + lane;
#pragma unroll
        for (int j = 0; j < 4; ++j) v[r][j] = xr[64 * j]; }
}
__device__ __forceinline__ void p1_proc4(const f32x4 (&v)[4][4], const float* mod, const float* ng, bf16* H, int m0, int lane) {
#pragma unroll
    for (int r = 0; r < 4; ++r) { const int m = m0 + r; const float* md = mod + (size_t)(m < ML ? m / SEQ : 32) * 3072;
        float s = 0.f;
#pragma unroll
        for (int j = 0; j < 4; ++j) s += dot4g(v[r][j]);
        const float rstd = rsqrtf(wave_sum(s) * (1.f / DM) + EPS);
        GAS unsigned long long* o8 = (GAS unsigned long long*)(H + (size_t)m * DM) + lane;
#pragma unroll
        for (int j = 0; j < 4; ++j) { const int k = 4 * lane + 256 * j;
            const f32x4 g = *(const f32x4*)(ng + k), sc = *(const f32x4*)(md + 1024 + k), sh = *(const f32x4*)(md + k);
            const f32x4 h = v[r][j] * rstd * g * (sc + 1.f) + sh;
            o8[64 * j] = (unsigned long long)pk2(h[0], h[1]) | ((unsigned long long)pk2(h[2], h[3]) << 32); }
    }
}
__device__ __forceinline__ void conv_phase(const bf16* XBC, const float* cw, const float* cb, bf16* XC, int bx, int G, int tid) {
    if (tid < 384) {
        const int cg = tid % 192, sub = tid / 192;
        f32x4 w[5][2], bias[2];
#pragma unroll
        for (int j = 0; j < 5; ++j) { w[j][0] = *(const f32x4*)(cw + j * CONVC + cg * 8); w[j][1] = *(const f32x4*)(cw + j * CONVC + cg * 8 + 4); }
        bias[0] = *(const f32x4*)(cb + cg * 8); bias[1] = *(const f32x4*)(cb + cg * 8 + 4);
        for (int seg = bx; seg < MT / 32; seg += G) {
            const int row0 = seg * 32 + sub * 16; int t0, len;
            if (row0 < ML) { t0 = row0 % SEQ; len = SEQ; } else { t0 = (row0 - ML) % CTXL; len = CTXL; }
            const bf16* src = XBC + (size_t)row0 * CONVC + cg * 8; bf16* dst = XC + (size_t)row0 * CONVC + cg * 8;
            f32x4 r[5][2];
#pragma unroll
            for (int j = 0; j < 5; ++j) { const int tt = t0 + j - 2; v4u u = (v4u){0u, 0u, 0u, 0u};
                if (tt >= 0 && tt < len) u = *(const v4u*)(src + (ptrdiff_t)(j - 2) * CONVC);
                r[j][0] = (f32x4){__uint_as_float(u.x << 16), __uint_as_float(u.x & 0xffff0000u), __uint_as_float(u.y << 16), __uint_as_float(u.y & 0xffff0000u)};
                r[j][1] = (f32x4){__uint_as_float(u.z << 16), __uint_as_float(u.z & 0xffff0000u), __uint_as_float(u.w << 16), __uint_as_float(u.w & 0xffff0000u)}; }
#pragma unroll
            for (int i = 0; i < 16; ++i) {
                f32x4 a0 = bias[0], a1 = bias[1];
#pragma unroll
                for (int j = 0; j < 5; ++j) { a0 += w[j][0] * r[j][0]; a1 += w[j][1] * r[j][1]; }
#pragma unroll
                for (int e = 0; e < 4; ++e) { a0[e] = siluf(a0[e]); a1[e] = siluf(a1[e]); }
                v4u o; o.x = pk2(a0[0], a0[1]); o.y = pk2(a0[2], a0[3]); o.z = pk2(a1[0], a1[1]); o.w = pk2(a1[2], a1[3]);
                *(v4u*)(dst + (size_t)i * CONVC) = o;
#pragma unroll
                for (int j = 0; j < 4; ++j) { r[j][0] = r[j + 1][0]; r[j][1] = r[j + 1][1]; }
                const int tt = t0 + i + 3; v4u u = (v4u){0u, 0u, 0u, 0u};
                if (i < 15 && tt < len) u = *(const v4u*)(src + (size_t)(i + 3) * CONVC);
                r[4][0] = (f32x4){__uint_as_float(u.x << 16), __uint_as_float(u.x & 0xffff0000u), __uint_as_float(u.y << 16), __uint_as_float(u.y & 0xffff0000u)};
                r[4][1] = (f32x4){__uint_as_float(u.z << 16), __uint_as_float(u.z & 0xffff0000u), __uint_as_float(u.w << 16), __uint_as_float(u.w & 0xffff0000u)};
            }
        }
    }
}
__device__ __forceinline__ void ssd_item_naive(int b, int h, const bf16* XC, const float* DT, const bf16* Z, const float* a_log, const float* d_skip, bf16* YQ, float* SSQ, LAS float* ysq, int tid) {
    const int p = tid >> 3, nc = tid & 7, g = h >> 3;
    for (int dd = 0; dd < 2; ++dd) { const int d = 1 - dd;
        const float a_neg = -expf(a_log[d * 16 + h]);
        float S[16];
#pragma unroll
        for (int j = 0; j < 16; ++j) S[j] = 0.f;
        for (int seq = 0; seq < 2; ++seq) { const int len = seq == 0 ? CTXL : SEQ; const size_t rbase = seq == 0 ? (size_t)ML + (size_t)b * CTXL : (size_t)b * SEQ;
            for (int st = 0; st < len; ++st) { const int t = d ? len - 1 - st : st; const size_t row = rbase + t;
                const float dt = DT[row * 32 + d * 16 + h]; const float dec = expf(dt * a_neg);
                const float xs = bf2f(XC[row * CONVC + h * 64 + p]); const float X = xs * dt;
                const v4u b0 = *(const v4u*)(XC + row * CONVC + 1024 + g * 128 + nc * 16), b1 = *(const v4u*)(XC + row * CONVC + 1024 + g * 128 + nc * 16 + 8);
                const v4u c0 = *(const v4u*)(XC + row * CONVC + 1280 + g * 128 + nc * 16), c1 = *(const v4u*)(XC + row * CONVC + 1280 + g * 128 + nc * 16 + 8);
                const unsigned bw[8] = {b0.x, b0.y, b0.z, b0.w, b1.x, b1.y, b1.z, b1.w}, cw8[8] = {c0.x, c0.y, c0.z, c0.w, c1.x, c1.y, c1.z, c1.w};
                float y = 0.f;
#pragma unroll
                for (int j = 0; j < 8; ++j) { S[2 * j] = S[2 * j] * dec + X * __uint_as_float(bw[j] << 16); y += __uint_as_float(cw8[j] << 16) * S[2 * j];
                    S[2 * j + 1] = S[2 * j + 1] * dec + X * __uint_as_float(bw[j] & 0xffff0000u); y += __uint_as_float(cw8[j] & 0xffff0000u) * S[2 * j + 1]; }
                y += __shfl_xor(y, 1); y += __shfl_xor(y, 2); y += __shfl_xor(y, 4);
                if (seq == 1) {
                    bf16* yp = YQ + row * 2048 + h * 64 + p;
                    if (d == 1) { if (nc == 0) *yp = (bf16)f2bf(y); }
                    else {
                        if (nc == 0) { const float yt = y + bf2f(*yp) + d_skip[h] * xs; const float yg = yt * bf2f(Z[row * 1024 + h * 64 + p]); *yp = (bf16)f2bf(yg); ysq[p] = yg * yg; }
                        __syncthreads();
                        if (tid < 64) { float q = ysq[tid]; q = wave_sum(q); if (tid == 0) SSQ[row * 16 + h] = q; }
                        __syncthreads();
                    }
                }
            }
        }
        VM_WAIT(); __syncthreads();
    }
}

namespace attn_body {
using bf16=__hip_bfloat16;
using bf16x8=__attribute__((ext_vector_type(8)))short;
using s16x4=__attribute__((ext_vector_type(4)))short;
using f32x16=__attribute__((ext_vector_type(16)))float;
using u32x4=__attribute__((ext_vector_type(4)))unsigned;
constexpr int D=64,QP=2048,KP=256;
constexpr int NW=8,QBLK=32,QB=QBLK*NW,KVBLK=64,NQB=SEQ/QB;
constexpr int ATTN_UNIT_ROWS=QB;
__device__ __forceinline__ int crow(int r,int hi){return (r&3)+8*(r>>2)+4*hi;}
#define SBAR() __builtin_amdgcn_sched_barrier(0)
__device__ __forceinline__ void cmask(f32x16&p0,f32x16&p1,int jb,int qrel,int hi){
  const float NEG=-INFINITY; int kb=64*jb+4*hi;
  #pragma unroll
  for(int r=0;r<16;++r){int kv=kb+(r&3)+8*(r>>2); if(kv>qrel)p0[r]=NEG; if(kv+32>qrel)p1[r]=NEG;}
}

constexpr int NSLOT=3, SLOTB=8192;
constexpr int LDS_K=0, LDS_V=NSLOT*SLOTB, LDS_WS=2*NSLOT*SLOTB, LDS_OST=LDS_WS+NW*64*4, LDS_BYTES=LDS_OST+NW*8192;
constexpr float C2=0.125f*1.4426950408889634f;
__device__ __forceinline__ void glds16(const void*gsrc,unsigned lds_dst){unsigned keep;
  asm volatile("s_mov_b32 %0, m0\n\ts_mov_b32 m0, %2\n\ts_nop 0\n\tglobal_load_lds_dwordx4 %1, off\n\ts_mov_b32 m0, %0":"=&s"(keep):"v"(gsrc),"s"(lds_dst):"memory");}
__device__ __forceinline__ float max3f(float a,float b,float c){float r;asm("v_max3_f32 %0, %1, %2, %3":"=v"(r):"v"(a),"v"(b),"v"(c));return r;}
__device__ __forceinline__ float max2f(float a,float b){float r;asm("v_max_f32_e32 %0, %1, %2":"=v"(r):"v"(a),"v"(b));return r;}
__device__ __forceinline__ float fadd_s(float a,float b){float r;asm("v_add_f32_e32 %0, %1, %2":"=v"(r):"v"(a),"v"(b));return r;}
__device__ __forceinline__ float fsub_s(float a,float b){float r;asm("v_sub_f32_e32 %0, %1, %2":"=v"(r):"v"(a),"v"(b));return r;}
typedef float f32x2_t __attribute__((ext_vector_type(2))); typedef float f32x4_t __attribute__((ext_vector_type(4))); typedef __bf16 bf16x2_t __attribute__((ext_vector_type(2)));
__device__ __forceinline__ unsigned cvtpk_s(float lo,float hi){f32x2_t v={lo,hi};bf16x2_t b=__builtin_convertvector(v,bf16x2_t);return __builtin_bit_cast(unsigned,b);}
#define WAIT_BAR(N) asm volatile("s_waitcnt vmcnt(" #N ") lgkmcnt(0)\n\ts_barrier":::"memory")

__device__ __forceinline__ void qkt(f32x16&p0,f32x16&p1,const char*Kslot,const bf16x8*qr,const f32x16&negm,int r32,int hi){
  const char*kb=Kslot+hi*1024+r32*16;
  #pragma unroll
  for(int d0=0;d0<4;++d0){
    const bf16x8 b0=*reinterpret_cast<const bf16x8*>(kb+d0*2048);
    const bf16x8 b1=*reinterpret_cast<const bf16x8*>(kb+d0*2048+512);
    if(d0==0){p0=__builtin_amdgcn_mfma_f32_32x32x16_bf16(b0,qr[0],negm,0,0,0);p1=__builtin_amdgcn_mfma_f32_32x32x16_bf16(b1,qr[0],negm,0,0,0);}
    else{p0=__builtin_amdgcn_mfma_f32_32x32x16_bf16(b0,qr[d0],p0,0,0,0);p1=__builtin_amdgcn_mfma_f32_32x32x16_bf16(b1,qr[d0],p1,0,0,0);}}
}
typedef __attribute__((address_space(3))) const char* lds_cptr;
typedef short v4i16_t __attribute__((ext_vector_type(4)));
__device__ __forceinline__ void kload8(bf16x8*kf,lds_cptr kp){
  kf[0]=*(const __attribute__((address_space(3))) bf16x8*)(kp);      kf[1]=*(const __attribute__((address_space(3))) bf16x8*)(kp+512);
  kf[2]=*(const __attribute__((address_space(3))) bf16x8*)(kp+2048); kf[3]=*(const __attribute__((address_space(3))) bf16x8*)(kp+2560);
  kf[4]=*(const __attribute__((address_space(3))) bf16x8*)(kp+4096); kf[5]=*(const __attribute__((address_space(3))) bf16x8*)(kp+4608);
  kf[6]=*(const __attribute__((address_space(3))) bf16x8*)(kp+6144); kf[7]=*(const __attribute__((address_space(3))) bf16x8*)(kp+6656);
}
__device__ __forceinline__ void kload2(bf16x8*kf,lds_cptr kp,int j){ kf[2*j]=*(const __attribute__((address_space(3))) bf16x8*)(kp+j*2048); kf[2*j+1]=*(const __attribute__((address_space(3))) bf16x8*)(kp+j*2048+512); }
__device__ __forceinline__ s16x4 vtr(lds_cptr p){ return __builtin_bit_cast(s16x4,__builtin_amdgcn_ds_read_tr16_b64_v4i16((__attribute__((address_space(3))) v4i16_t*)p)); }
__device__ __forceinline__ float rowmax(const f32x16&p0,const f32x16&p1){
  float a=max3f(p0[0],p0[1],p1[0]),b=max3f(p0[2],p0[3],p1[1]);a=max3f(a,p1[2],p1[3]);
  #pragma unroll
  for(int r=4;r<16;r+=4){a=max3f(a,p0[r],p0[r+1]);b=max3f(b,p0[r+2],p0[r+3]);a=max3f(a,p1[r],p1[r+1]);b=max3f(b,p1[r+2],p1[r+3]);}
  const float m=max2f(a,b);
  auto rr=__builtin_amdgcn_permlane32_swap(__float_as_uint(m),__float_as_uint(m),false,false);
  return max2f(__uint_as_float(rr[0]),__uint_as_float(rr[1]));
}
__device__ __forceinline__ void pv(f32x16*o,int vb,bf16x8 pa0,bf16x8 pa1,bf16x8 pa2,bf16x8 pa3){
  #pragma unroll
  for(int d0=0;d0<2;++d0){s16x4 lo[4],hi[4];
    #pragma unroll
    for(int ks=0;ks<4;++ks){
      asm volatile("ds_read_b64_tr_b16 %0,%1 offset:%c2":"=&v"(lo[ks]):"v"(vb),"i"(d0*4096+ks*1024):"memory");
      asm volatile("ds_read_b64_tr_b16 %0,%1 offset:%c2":"=&v"(hi[ks]):"v"(vb),"i"(d0*4096+ks*1024+512):"memory");}
    asm volatile("s_waitcnt lgkmcnt(0)":::"memory");SBAR();
    #define PK(k) (bf16x8){lo[k][0],lo[k][1],lo[k][2],lo[k][3],hi[k][0],hi[k][1],hi[k][2],hi[k][3]}
    o[d0]=__builtin_amdgcn_mfma_f32_32x32x16_bf16(pa0,PK(0),o[d0],0,0,0);
    o[d0]=__builtin_amdgcn_mfma_f32_32x32x16_bf16(pa1,PK(1),o[d0],0,0,0);
    o[d0]=__builtin_amdgcn_mfma_f32_32x32x16_bf16(pa2,PK(2),o[d0],0,0,0);
    o[d0]=__builtin_amdgcn_mfma_f32_32x32x16_bf16(pa3,PK(3),o[d0],0,0,0);
    #undef PK
  }
}

#ifndef ATTN_STORE16
#define ATTN_STORE16(p,v) (*(u32x4*)(p)=(v))
#endif
template<int THRL> __device__ __forceinline__ void attn_unit(int b,int h,int qb,bf16*YQb,const bf16*__restrict__ K,const bf16*__restrict__ V,char*shm,int wid_in,bf16*dummyO=nullptr){
  const int wid=wid_in; int lane=mk_lane(); asm volatile("":"+v"(lane)); const int tid=wid*64+lane,r32=lane&31,hi=lane>>5; (void)tid;
  const long rowbase=(long)b*SEQ; const int q0=qb*QB;
  const bf16*Qw=YQb+(rowbase+q0+wid*QBLK)*QP+1024+h*D;
  const bf16*Kh=K+(long)b*KVL*KP+(h>>2)*D,*Vh=V+(long)b*KVL*KP+(h>>2)*D;
  const unsigned lds0=(unsigned)(uintptr_t)shm;
  float*wsf=(float*)(shm+LDS_WS)+wid*64;
  const bf16*ksrc=Kh+(long)lane*KP+wid*8;
  const bf16*vsrc=Vh+(long)(16*(wid&3)+(lane>>2))*KP+(wid>>2)*32+(lane&3)*8;
  const unsigned kdst=lds0+LDS_K+wid*1024, vdst=lds0+LDS_V+wid*1024;
  #define DMA_K(t,slot) glds16(ksrc+(long)(t)*KVBLK*KP,(unsigned)__builtin_amdgcn_readfirstlane(kdst+(slot)))
  #define DMA_V(t,slot) glds16(vsrc+(long)(t)*KVBLK*KP,(unsigned)__builtin_amdgcn_readfirstlane(vdst+(slot)))
  const int vb0=(int)(lds0+LDS_V)+((lane>>4)&1)*32+(lane&3)*8+(4*hi+((lane&15)>>2))*64;
  const char*Kbase=shm+LDS_K; bf16x8 kf[8];
  const lds_cptr shm3=(lds_cptr)shm; const lds_cptr kp0=shm3+LDS_K+hi*1024+r32*16; const lds_cptr vp0=shm3+LDS_V+((lane>>4)&1)*32+(lane&3)*8+(4*hi+((lane&15)>>2))*64;
  constexpr int NT=KVL/KVBLK;
  DMA_K(0,0);DMA_V(0,0);DMA_K(1,SLOTB);
  bf16x8 qr[4];
  #pragma unroll
  for(int d0=0;d0<4;++d0)qr[d0]=*reinterpret_cast<const bf16x8*>(&Qw[(long)r32*QP+d0*16+hi*8]);
  float mhat=0.f,l_reg=0.f;f32x16 o[2];o[0]=f32x16{};o[1]=f32x16{};f32x16 negm=f32x16{};asm volatile("":"+v"(negm));
  #define CMASK(P0,P1,t) do{}while(0)
  bool resc=false;
  #define START(P0,P1) do{ const float rm=rowmax(P0,P1); resc=false; \
    { const float dl=rm; mhat=fadd_s(mhat,dl); \
      _Pragma("unroll") for(int r=0;r<16;++r){P0[r]=fsub_s(P0[r],dl);P1[r]=fsub_s(P1[r],dl);} \
      _Pragma("unroll") for(int r=0;r<16;++r)negm[r]=-mhat; asm volatile("":"+v"(negm)); } \
    _Pragma("unroll") for(int r=0;r<16;++r)P0[r]=__builtin_amdgcn_exp2f(P0[r]); }while(0)
  #define RESC() do{ if(resc){ asm volatile("s_waitcnt lgkmcnt(0)":::"memory"); \
      _Pragma("unroll") for(int d_=0;d_<2;++d_) _Pragma("unroll") for(int r=0;r<16;++r)o[d_][r]*=wsf[crow(r,hi)]; } }while(0)
  f32x16 pA0,pA1,pB0,pB1;
  int sl_prev=0,sl_cur=0,sl_next=SLOTB;
  #define ROT() do{sl_prev=sl_cur;sl_cur=sl_next;sl_next=(sl_next==(NSLOT-1)*SLOTB)?0:sl_next+SLOTB;}while(0)
  DMA_K(2,2*SLOTB);
  WAIT_BAR(3);
  qkt(pA0,pA1,Kbase,qr,negm,r32,hi);asm volatile("s_nop 15\n\ts_nop 7":"+v"(pA0),"+v"(pA1));CMASK(pA0,pA1,0);
  START(pA0,pA1);
  _Pragma("unroll") for(int r=0;r<16;++r)pA1[r]=__builtin_amdgcn_exp2f(pA1[r]);
  WAIT_BAR(0);
  DMA_K(3,0);DMA_V(1,SLOTB);
  ROT();
  kload8(kf,kp0+sl_cur);
  WAIT_BAR(2);
  s16x4 vlo[8],vhi[8]; u32x4 pw0,pw1,pw2,pw3;
  #define PKW(P,B) cvtpk_s(P[B],P[B+1])
  #define PAF(k) __builtin_bit_cast(bf16x8,pw##k)
  #define VFR(i) (bf16x8){vlo[i][0],vlo[i][1],vlo[i][2],vlo[i][3],vhi[i][0],vhi[i][1],vhi[i][2],vhi[i][3]}
  #define PIN(x) asm volatile("":"+v"(x))
  #define MX3(a,b,c) __builtin_fmaxf(__builtin_fmaxf((a),(b)),(c))
  #define GAPA(MF,A0,A1,A2,A3,W0,W1,PW) do{ MF; sacc+=A0; sacc+=A1; sacc+=A2; sacc+=A3; PIN(sacc); W0; W1; PIN(PW); SBAR(); }while(0)
  #define EX(v) __builtin_amdgcn_exp2f(v)
  #define GAPB(MF,X,B) do{ MF; X[B]=EX(X[B]); X[B+1]=EX(X[B+1]); X[B+2]=EX(X[B+2]); X[B+3]=EX(X[B+3]); PIN(X); SBAR(); }while(0)
  #define VRD(i) do{ vlo[i]=vtr(vp_+(((i)>>2)*4096+((i)&3)*1024)); vhi[i]=vtr(vp_+(((i)>>2)*4096+((i)&3)*1024+512)); }while(0)
  #define KRD(G,j) do{ if(G){ kload2(kf,kp0+sl_next,j); SBAR(); } }while(0)
  #define STEP(C0,C1,P0,P1,t,GK,GV,GL) do{ SBAR(); \
    const lds_cptr vp_=vp0+sl_prev; \
    VRD(0); SBAR(); float sacc=(P0[0]+P0[1]); \
    GAPA(C0=__builtin_amdgcn_mfma_f32_32x32x16_bf16(kf[0],qr[0],negm,0,0,0), P0[2],P0[3],P0[4],P0[5],     pw0[0]=PKW(P0,0), pw0[1]=PKW(P0,2), pw0); \
    VRD(4); SBAR(); GAPA(C1=__builtin_amdgcn_mfma_f32_32x32x16_bf16(kf[1],qr[0],negm,0,0,0), P0[6],P0[7],P0[8],P0[9],     pw0[2]=PKW(P0,4), pw0[3]=PKW(P0,6), pw0); \
    VRD(1); SBAR(); GAPA(C0=__builtin_amdgcn_mfma_f32_32x32x16_bf16(kf[2],qr[1],C0,0,0,0),   P0[10],P0[11],P0[12],P0[13], pw1[0]=PKW(P0,8), pw1[1]=PKW(P0,10), pw1); \
    VRD(5); SBAR(); GAPA(C1=__builtin_amdgcn_mfma_f32_32x32x16_bf16(kf[3],qr[1],C1,0,0,0),   P0[14],P0[15],P1[0],P1[1],   pw1[2]=PKW(P0,12),pw1[3]=PKW(P0,14), pw1); \
    VRD(2); SBAR(); GAPA(C0=__builtin_amdgcn_mfma_f32_32x32x16_bf16(kf[4],qr[2],C0,0,0,0),   P1[2],P1[3],P1[4],P1[5],     pw2[0]=PKW(P1,0), pw2[1]=PKW(P1,2), pw2); \
    VRD(6); SBAR(); GAPA(C1=__builtin_amdgcn_mfma_f32_32x32x16_bf16(kf[5],qr[2],C1,0,0,0),   P1[6],P1[7],P1[8],P1[9],     pw2[2]=PKW(P1,4), pw2[3]=PKW(P1,6), pw2); \
    VRD(3); SBAR(); GAPA(C0=__builtin_amdgcn_mfma_f32_32x32x16_bf16(kf[6],qr[3],C0,0,0,0),   P1[10],P1[11],P1[12],P1[13], pw3[0]=PKW(P1,8), pw3[1]=PKW(P1,10), pw3); \
    VRD(7); SBAR(); GAPA(C1=__builtin_amdgcn_mfma_f32_32x32x16_bf16(kf[7],qr[3],C1,0,0,0),   P1[14],P1[15],0.f,0.f,       pw3[2]=PKW(P1,12),pw3[3]=PKW(P1,14), pw3); \
    l_reg+=sacc; \
    if(GK){DMA_K((t)+3,sl_cur);} if(GV){DMA_V((t)+1,sl_next);} \
    CMASK(C0,C1,t); \
    { float a=MX3(C0[0],C0[1],C1[0]),b=MX3(C0[2],C0[3],C1[1]); a=MX3(a,C1[2],C1[3]); \
      _Pragma("unroll") for(int r=4;r<16;r+=4){a=MX3(a,C0[r],C0[r+1]);b=MX3(b,C0[r+2],C0[r+3]);a=MX3(a,C1[r],C1[r+1]);b=MX3(b,C1[r+2],C1[r+3]);} \
      float rm=__builtin_fmaxf(a,b); { auto rr=__builtin_amdgcn_permlane32_swap(__float_as_uint(rm),__float_as_uint(rm),false,false); rm=__builtin_fmaxf(__uint_as_float(rr[0]),__uint_as_float(rr[1])); } \
      resc=false; \
      if(__builtin_expect(__any(rm>(float)THRL),0)){ const float dl=__builtin_fmaxf(rm,0.f); mhat+=dl; \
        _Pragma("unroll") for(int r=0;r<16;++r){C0[r]-=dl;C1[r]-=dl;} \
        _Pragma("unroll") for(int r=0;r<16;++r)negm[r]=-mhat; asm volatile("":"+v"(negm)); \
        const float f=__builtin_amdgcn_exp2f(-dl); l_reg*=f; if(hi==0)wsf[r32]=f; resc=true; } } \
    SBAR(); \
    GAPB(o[0]=__builtin_amdgcn_mfma_f32_32x32x16_bf16(PAF(0),VFR(0),o[0],0,0,0), C0,0); \
    GAPB(o[1]=__builtin_amdgcn_mfma_f32_32x32x16_bf16(PAF(0),VFR(4),o[1],0,0,0), C0,4); \
    KRD(GL,0); GAPB(o[0]=__builtin_amdgcn_mfma_f32_32x32x16_bf16(PAF(1),VFR(1),o[0],0,0,0), C0,8); \
    KRD(GL,1); GAPB(o[1]=__builtin_amdgcn_mfma_f32_32x32x16_bf16(PAF(1),VFR(5),o[1],0,0,0), C0,12); \
    KRD(GL,2); GAPB(o[0]=__builtin_amdgcn_mfma_f32_32x32x16_bf16(PAF(2),VFR(2),o[0],0,0,0), C1,0); \
    KRD(GL,3); GAPB(o[1]=__builtin_amdgcn_mfma_f32_32x32x16_bf16(PAF(2),VFR(6),o[1],0,0,0), C1,4); \
    GAPB(o[0]=__builtin_amdgcn_mfma_f32_32x32x16_bf16(PAF(3),VFR(3),o[0],0,0,0), C1,8); \
    GAPB(o[1]=__builtin_amdgcn_mfma_f32_32x32x16_bf16(PAF(3),VFR(7),o[1],0,0,0), C1,12); \
    }while(0)
  int t=1;
  #undef CMASK
  #define CMASK(P0,P1,t) do{}while(0)
  for(;t+5<NT;t+=2){
    STEP(pB0,pB1,pA0,pA1,t,true,true,true);     WAIT_BAR(2); RESC(); ROT();
    STEP(pA0,pA1,pB0,pB1,t+1,true,true,true);   WAIT_BAR(2); RESC(); ROT();
  }
  #undef CMASK
  #define CMASK(P0,P1,t) do{}while(0)
  #define ENDW(tt) do{ if((tt)+3<NT){WAIT_BAR(2);} else if((tt)+2<NT){WAIT_BAR(1);} else {WAIT_BAR(0);} }while(0)
  for(;t+1<NT;t+=2){
    STEP(pB0,pB1,pA0,pA1,t,(t+3<NT),(t+1<NT),(t+1<NT));       ENDW(t);   RESC(); ROT();
    STEP(pA0,pA1,pB0,pB1,t+1,(t+4<NT),(t+2<NT),(t+2<NT));     ENDW(t+1); RESC(); ROT();
  }
  STEP(pB0,pB1,pA0,pA1,NT-1,false,false,false); RESC();
  { float sacc=pB0[0]+pB0[1]; _Pragma("unroll") for(int r=2;r<16;++r)sacc+=pB0[r]; _Pragma("unroll") for(int r=0;r<16;++r)sacc+=pB1[r]; l_reg+=sacc;
    pw0=(u32x4){PKW(pB0,0),PKW(pB0,2),PKW(pB0,4),PKW(pB0,6)};pw1=(u32x4){PKW(pB0,8),PKW(pB0,10),PKW(pB0,12),PKW(pB0,14)};pw2=(u32x4){PKW(pB1,0),PKW(pB1,2),PKW(pB1,4),PKW(pB1,6)};pw3=(u32x4){PKW(pB1,8),PKW(pB1,10),PKW(pB1,12),PKW(pB1,14)};
    SBAR(); pv(o,vb0+sl_cur,PAF(0),PAF(1),PAF(2),PAF(3)); }
  #undef PKW
  #undef PAF
  #undef VFR
  #undef PIN
  #undef MX3
  #undef GAPA
  #undef GAPB
  #undef EX
  #undef VRD
  #undef KRD
  #undef STEP
  #undef ENDW
  {auto rr=__builtin_amdgcn_permlane32_swap(__float_as_uint(l_reg),__float_as_uint(l_reg),false,false);l_reg=__uint_as_float(rr[0])+__uint_as_float(rr[1]);}
  if(hi==0)wsf[32+r32]=l_reg;asm volatile("s_waitcnt lgkmcnt(0)":::"memory");
  float rli[16];
  #pragma unroll
  for(int r=0;r<16;++r)rli[r]=__builtin_amdgcn_rcpf(wsf[32+crow(r,hi)]);
  bf16*Ow=dummyO?dummyO+(long)(wid*QBLK)*QP:YQb+(rowbase+q0+wid*QBLK)*QP+1024+h*D; const bf16*Gw=YQb+(rowbase+q0+wid*QBLK)*QP+h*D;
  { float*stg=(float*)(shm+LDS_OST)+wid*2048;
    #pragma unroll
    for(int r=0;r<16;++r){const int orow=crow(r,hi);
      #pragma unroll
      for(int d0=0;d0<2;++d0)stg[orow*64+d0*32+r32]=o[d0][r]*rli[r];}
    asm volatile("s_waitcnt lgkmcnt(0)":::"memory");
    #pragma unroll
    for(int i=0;i<4;++i){const int row=i*8+(lane>>3),ch=lane&7; const float*sp=stg+row*64+ch*8;
      const f32x4_t a=*(const f32x4_t*)sp,c=*(const f32x4_t*)(sp+4); const u32x4 g=*(const u32x4*)(Gw+(long)row*QP+ch*8);
      u32x4 v; v[0]=cvtpk_s(a[0]*__uint_as_float(g[0]<<16),a[1]*__uint_as_float(g[0]&0xffff0000u)); v[1]=cvtpk_s(a[2]*__uint_as_float(g[1]<<16),a[3]*__uint_as_float(g[1]&0xffff0000u));
      v[2]=cvtpk_s(c[0]*__uint_as_float(g[2]<<16),c[1]*__uint_as_float(g[2]&0xffff0000u)); v[3]=cvtpk_s(c[2]*__uint_as_float(g[3]<<16),c[3]*__uint_as_float(g[3]&0xffff0000u));
      ATTN_STORE16(Ow+(long)row*QP+ch*8,v);} }
  asm volatile("s_waitcnt lgkmcnt(0)\n\ts_barrier":::"memory");
  #undef DMA_K
  #undef DMA_V
  #undef CMASK
  #undef START
  #undef RESC
  #undef ROT
}
constexpr int ATTN_LDS_BYTES=LDS_BYTES;
struct Order {
  int vcu, G; bool alt;
  __device__ __forceinline__ bool next(int i,int&b,int&h,int&qb)const{
    if(G==256&&!alt){ if(i>=16)return false; const int x=vcu>>5,j=vcu&31,rd=i>>2,k=i&3; const int pair=x*16+rd*4+(j>>3),un=(j&7)*4+k; b=pair>>2; h=(pair&3)*4+(un&3); qb=un>>2; return true; }
    const int U=i*G+vcu; if(U>=4096)return false; b=U>>7; h=(U>>3)&15; qb=U&7; return true; }
};
template<int THRL=8> __device__ __forceinline__ void attn_phase(char*lds,bf16*YQb,const bf16*K,const bf16*V,const Order&S,int wid,bf16*dummyO=nullptr){
  int b,h,qb;
  for(int i=0;S.next(i,b,h,qb);++i) attn_unit<THRL>(b,h,qb,YQb,K,V,lds,wid,dummyO);
}
#undef SBAR
#undef WAIT_BAR
}

namespace ssd {
typedef short bf16x8 __attribute__((ext_vector_type(8)));
typedef short s16x4 __attribute__((ext_vector_type(4)));
typedef unsigned u32x2_t __attribute__((ext_vector_type(2)));
constexpr int O_B = 0, O_C = 32768, O_X = 65536, O_XD = 81920, O_ST = 98304, O_SM = 114688;
constexpr float LOG2E = 1.4426950408889634f;
struct Lofs { int fb[4], xb[4], bb, sw; };
__device__ __forceinline__ bf16x8 frag(const LAS unsigned char* img, int fbk, int t) { return *(const LAS bf16x8*)(img + fbk + t * 4096); }
__device__ __forceinline__ s16x4 trd(const LAS unsigned char* p) { typedef short v4i16_t __attribute__((ext_vector_type(4))); return __builtin_bit_cast(s16x4, __builtin_amdgcn_ds_read_tr16_b64_v4i16((LAS v4i16_t*)p)); }
__device__ __forceinline__ bf16x8 trfragX(const LAS unsigned char* img, int xbp, int s0) {
    const s16x4 a = trd(img + xbp + s0 * 128), b = trd(img + xbp + s0 * 128 + 2048);
    return (bf16x8){a[0], a[1], a[2], a[3], b[0], b[1], b[2], b[3]};
}
__device__ __forceinline__ bf16x8 trfragB(const LAS unsigned char* img, int bb, int s0) {
    const s16x4 a = trd(img + bb + s0 * 256), b = trd(img + bb + s0 * 256 + 4096);
    return (bf16x8){a[0], a[1], a[2], a[3], b[0], b[1], b[2], b[3]};
}
__device__ __forceinline__ void unpack4(const u32x2_t u, float (&f)[4]) { f[0] = __uint_as_float(u.x << 16); f[1] = __uint_as_float(u.x & 0xffff0000u); f[2] = __uint_as_float(u.y << 16); f[3] = __uint_as_float(u.y & 0xffff0000u); }
__device__ __forceinline__ void unpack8(const v4u u, float (&f)[8]) {
    f[0] = __uint_as_float(u.x << 16); f[1] = __uint_as_float(u.x & 0xffff0000u); f[2] = __uint_as_float(u.y << 16); f[3] = __uint_as_float(u.y & 0xffff0000u);
    f[4] = __uint_as_float(u.z << 16); f[5] = __uint_as_float(u.z & 0xffff0000u); f[6] = __uint_as_float(u.w << 16); f[7] = __uint_as_float(u.w & 0xffff0000u);
}
#define SSD_MFMA(a, b, c) __builtin_amdgcn_mfma_f32_16x16x32_bf16(a, b, c, 0, 0, 0)

template <int W> __device__ __forceinline__ void diag(f32x4 (&y)[4], const bf16x8 (&cf)[4], const LAS unsigned char* Bi, const LAS unsigned char* Xi, const LAS float* csc, float csl, float skd, int fr, int fq, const Lofs& lo) {
    constexpr int NU = W / 2 + 1;
    bf16x8 bA[2][4], bB[2][4];
#pragma unroll
    for (int kk = 0; kk < 4; ++kk) { bA[0][kk] = frag(Bi, lo.fb[kk], 0); if (1 <= W) bB[0][kk] = frag(Bi, lo.fb[kk], 1); }
#pragma unroll
    for (int u = 0; u < NU; ++u) {
        const int cur = u & 1; const bool has1 = 2 * u + 1 <= W;
        bf16x8 xf[4];
#pragma unroll
        for (int pt = 0; pt < 4; ++pt) xf[pt] = trfragX(Xi, lo.xb[pt], 32 * u);
        const f32x4 c0 = *(const LAS f32x4*)(csc + 32 * u + 4 * fq), c1 = *(const LAS f32x4*)(csc + 32 * u + 16 + 4 * fq);
        if (u + 1 < NU) {
#pragma unroll
            for (int kk = 0; kk < 4; ++kk) { bA[cur ^ 1][kk] = frag(Bi, lo.fb[kk], 2 * u + 2); if (2 * u + 3 <= W) bB[cur ^ 1][kk] = frag(Bi, lo.fb[kk], 2 * u + 3); } }
        asm volatile("" ::: "memory");
        f32x4 a0 = (f32x4){0.f, 0.f, 0.f, 0.f}, a1 = (f32x4){0.f, 0.f, 0.f, 0.f};
#pragma unroll
        for (int kk = 0; kk < 4; ++kk) { a0 = SSD_MFMA(bA[cur][kk], cf[kk], a0); if (has1) a1 = SSD_MFMA(bB[cur][kk], cf[kk], a1); }
        float m0[4], m1[4];
#pragma unroll
        for (int e = 0; e < 4; ++e) {
            m0[e] = a0[e] * __builtin_amdgcn_exp2f(fminf(csl - c0[e], 0.f)); if (2 * u == W) { if (4 * fq + e > fr) m0[e] = 0.f; if (4 * fq + e == fr) m0[e] += skd; }
            m1[e] = has1 ? a1[e] * __builtin_amdgcn_exp2f(fminf(csl - c1[e], 0.f)) : 0.f; if (2 * u + 1 == W) { if (4 * fq + e > fr) m1[e] = 0.f; if (4 * fq + e == fr) m1[e] += skd; } }
        const v4u mw = (v4u){pk2(m0[0], m0[1]), pk2(m0[2], m0[3]), pk2(m1[0], m1[1]), pk2(m1[2], m1[3])};
        const bf16x8 mf = __builtin_bit_cast(bf16x8, mw);
#pragma unroll
        for (int pt = 0; pt < 4; ++pt) y[pt] = SSD_MFMA(xf[pt], mf, y[pt]);
    }
}

template <int SH> __device__ __forceinline__ void ssd_item(int b, int h, const bf16* XC, const float* DT, const bf16* Z, const float* a_log, const float* d_skip, bf16* YQ, float* SSQ,
                                          LAS unsigned char* L, int tid_in, int lane_in, int wave) {
    int tid = tid_in, lane = lane_in; asm volatile("" : "+v"(tid), "+v"(lane));
    const int fr = lane & 15, fq = lane >> 4, g = h >> 3;
    LAS unsigned char* Bi = L + O_B; LAS unsigned char* Ci = L + O_C; LAS unsigned char* Xi = L + O_X; LAS unsigned char* Xdi = L + O_XD; LAS unsigned char* Sti = L + O_ST;
    LAS float* dtv = (LAS float*)(L + O_SM); LAS float* cs2 = dtv + 256;
    const float aneg1 = -expf(a_log[16 + h]) * LOG2E, aneg0 = -expf(a_log[h]) * LOG2E, dsk = d_skip[h];
    Lofs lo;
    { const int q = (lane & 15) >> 2, pp = lane & 3, rr = 4 * fq + q;
#pragma unroll
      for (int kk = 0; kk < 4; ++kk) lo.fb[kk] = fr * 256 + (((4 * kk + fq) ^ fr) << 4);
#pragma unroll
      for (int pt = 0; pt < 4; ++pt) lo.xb[pt] = rr * 128 + ((pt ^ ((rr >> 1) & 3)) << 5) + 8 * pp;
      lo.bb = rr * 256 + (((2 * wave + (pp >> 1)) ^ rr) << 4) + 8 * (pp & 1);
      lo.sw = fr * 256 + (((2 * wave + (fq >> 1)) ^ fr) << 4) + (fq & 1) * 8; }
    const int sB = tid >> 4, cB = tid & 15, sX = tid >> 3, cX = tid & 7;
    const int wB = sB * 256 + ((cB ^ (sB & 15)) << 4);
    const int wX = sX * 128 + (((cX >> 1) ^ ((sX >> 1) & 3)) << 5) + (cX & 1) * 16;
    f32x4 st[4];
#pragma unroll
    for (int pt = 0; pt < 4; ++pt) st[pt] = (f32x4){0.f, 0.f, 0.f, 0.f};
    v4u Bq[4], Cq[4], Xq[2]; float dq0 = 0.f, dq1 = 0.f; bf16x8 cf[4];
#define SSD_DECODE(step, d_, base_, ctx_) const int d_ = 1 - (step) / 18; const int k_##d_ = (step) % 18; const bool ctx_ = k_##d_ < 2; \
    const size_t base_ = ctx_ ? (size_t)ML + (size_t)b * CTXL + (size_t)(d_ ? 1 - k_##d_ : k_##d_) * 128 : (size_t)b * SEQ + (size_t)(d_ ? 17 - k_##d_ : k_##d_ - 2) * 128;
#define SSD_ISSUE(step) do { SSD_DECODE(step, di, basei, ctxi) (void)ctxi; \
        const bf16* cb_ = XC + (SH == 8 ? (size_t)b * SEQ : basei) * CONVC; const int sg_ = di ? -CONVC : CONVC; const int o0_ = di ? 127 * CONVC : 0; \
        const bf16* pb_ = cb_ + (o0_ + sB * sg_ + 1024 + g * 128 + 8 * cB); const bf16* px_ = cb_ + (o0_ + sX * sg_ + h * 64 + 8 * cX); \
        const bf16* pc_ = cb_ + (o0_ + (16 * wave + fr) * sg_ + 1280 + g * 128 + 8 * fq); \
        _Pragma("unroll") for (int k4 = 0; k4 < 4; ++k4) { Bq[k4] = *(const v4u*)(pb_ + k4 * 32 * sg_); Cq[k4] = *(const v4u*)(pc_ + 32 * k4); } \
        _Pragma("unroll") for (int k2 = 0; k2 < 2; ++k2) Xq[k2] = *(const v4u*)(px_ + k2 * 64 * sg_); \
        if (wave == 0) { const size_t r0 = basei + (di ? 127 - 2 * lane : 2 * lane), r1 = basei + (di ? 126 - 2 * lane : 2 * lane + 1); dq0 = DT[r0 * 32 + di * 16 + h]; dq1 = DT[r1 * 32 + di * 16 + h]; } } while (0)
#define SSD_CUMSUM(step, par) do { if (wave == 0) { const float an = (1 - (step) / 18) ? aneg1 : aneg0; const float a0 = dq0 * an, a1 = dq1 * an; float v = a0 + a1; \
        _Pragma("unroll") for (int o = 1; o < 64; o <<= 1) { const float t = __shfl_up(v, o); if (lane >= o) v += t; } \
        dtv[(par) * 128 + 2 * lane] = dq0; dtv[(par) * 128 + 2 * lane + 1] = dq1; cs2[(par) * 128 + 2 * lane] = v - a1; cs2[(par) * 128 + 2 * lane + 1] = v; } } while (0)
#define SSD_WRITE(step, par) do { \
        _Pragma("unroll") for (int k4 = 0; k4 < 4; ++k4) { *(LAS v4u*)(Bi + wB + k4 * 8192) = Bq[k4]; cf[k4] = __builtin_bit_cast(bf16x8, Cq[k4]); } \
        const float cl = cs2[(par) * 128 + 127]; \
        _Pragma("unroll") for (int k2 = 0; k2 < 2; ++k2) { const int s = sX + 64 * k2; const float dts = dtv[(par) * 128 + s], es = __builtin_amdgcn_exp2f(cl - cs2[(par) * 128 + s]); \
            float f[8]; unpack8(Xq[k2], f); _Pragma("unroll") for (int e = 0; e < 8; ++e) f[e] *= dts; \
            v4u xo; xo.x = pk2(f[0], f[1]); xo.y = pk2(f[2], f[3]); xo.z = pk2(f[4], f[5]); xo.w = pk2(f[6], f[7]); \
            _Pragma("unroll") for (int e = 0; e < 8; ++e) f[e] *= es; \
            v4u xd; xd.x = pk2(f[0], f[1]); xd.y = pk2(f[2], f[3]); xd.z = pk2(f[4], f[5]); xd.w = pk2(f[6], f[7]); \
            *(LAS v4u*)(Xi + wX + k2 * 8192) = xo; *(LAS v4u*)(Xdi + wX + k2 * 8192) = xd; } } while (0)
#define SSD_WRITE_STATE() do { _Pragma("unroll") for (int pt = 0; pt < 4; ++pt) { \
        u32x2_t w; w.x = pk2(st[pt][0], st[pt][1]); w.y = pk2(st[pt][2], st[pt][3]); *(LAS u32x2_t*)(Sti + lo.sw + pt * 4096) = w; } } while (0)

    __syncthreads();
    SSD_ISSUE(0); SSD_CUMSUM(0, 0); SSD_WRITE_STATE();
    __syncthreads();
    SSD_WRITE(0, 0);
    __syncthreads();
    for (int step = 0; step < 36; ++step) {
        const int par = step & 1; SSD_DECODE(step, d, base, isctx)
        const int r8 = lane >> 3, c8 = lane & 7;
        size_t orow2[2]; v4u ybv[2], zv[2];
#pragma unroll
        for (int ps = 0; ps < 2; ++ps) { const int l = 16 * wave + 8 * ps + r8; orow2[ps] = base + (d ? 127 - l : l); }
        if (!isctx && d == 0 && SH != 5 && SH != 7) {
#pragma unroll
            for (int ps = 0; ps < 2; ++ps) { ybv[ps] = *(const v4u*)((SH ? YQ + (orow2[ps] & 255) * 2048 : YQ + orow2[ps] * 2048) + h * 64 + 8 * c8); zv[ps] = *(const v4u*)(Z + orow2[ps] * 1024 + h * 64 + 8 * c8); } }
        if (step + 1 < 36 && SH != 3 && SH != 7) SSD_ISSUE(step + 1);
        const LAS float* csc = cs2 + par * 128;
        if (!isctx && SH != 7) {
            const float csl = csc[16 * wave + fr];
            const float skd = d == 0 ? dsk * __builtin_amdgcn_rcpf(dtv[par * 128 + 16 * wave + fr]) : 0.f;
            f32x4 y[4];
#pragma unroll
            for (int pt = 0; pt < 4; ++pt) { y[pt] = (f32x4){0.f, 0.f, 0.f, 0.f};
                if (SH != 6) {
#pragma unroll
                for (int kk = 0; kk < 4; ++kk) y[pt] = SSD_MFMA(frag(Sti, lo.fb[kk], pt), cf[kk], y[pt]); } }
            { const float El = __builtin_amdgcn_exp2f(csl);
#pragma unroll
              for (int pt = 0; pt < 4; ++pt) y[pt] *= El; }
            if (SH != 2) switch (wave) {
                case 0: diag<0>(y, cf, Bi, Xi, csc, csl, skd, fr, fq, lo); break; case 1: diag<1>(y, cf, Bi, Xi, csc, csl, skd, fr, fq, lo); break;
                case 2: diag<2>(y, cf, Bi, Xi, csc, csl, skd, fr, fq, lo); break; case 3: diag<3>(y, cf, Bi, Xi, csc, csl, skd, fr, fq, lo); break;
                case 4: diag<4>(y, cf, Bi, Xi, csc, csl, skd, fr, fq, lo); break; case 5: diag<5>(y, cf, Bi, Xi, csc, csl, skd, fr, fq, lo); break;
                case 6: diag<6>(y, cf, Bi, Xi, csc, csl, skd, fr, fq, lo); break; default: diag<7>(y, cf, Bi, Xi, csc, csl, skd, fr, fq, lo); break;
            }
            LAS unsigned char* stg = Ci + wave * 4096;
#pragma unroll
            for (int pt = 0; pt < 4; ++pt) *(LAS f32x4*)(stg + fr * 256 + (((4 * pt + fq) ^ fr) << 4)) = y[pt];
#pragma unroll
            for (int ps = 0; ps < 2; ++ps) { const int rl = 8 * ps + r8;
                const f32x4 t0 = *(const LAS f32x4*)(stg + rl * 256 + (((2 * c8) ^ rl) << 4)), t1 = *(const LAS f32x4*)(stg + rl * 256 + (((2 * c8 + 1) ^ rl) << 4));
                float v[8] = {t0[0], t0[1], t0[2], t0[3], t1[0], t1[1], t1[2], t1[3]};
                if (d == 0 && SH != 5) { float fb[8], fz[8]; unpack8(ybv[ps], fb); unpack8(zv[ps], fz); float q = 0.f;
#pragma unroll
                    for (int e = 0; e < 8; ++e) { v[e] = (v[e] + fb[e]) * fz[e]; q += v[e] * v[e]; }
                    q += __shfl_xor(q, 1); q += __shfl_xor(q, 2); q += __shfl_xor(q, 4);
                    if (c8 == 0) SSQ[(SH ? (orow2[ps] & 255) : orow2[ps]) * 16 + h] = q; }
                v4u o; o.x = pk2(v[0], v[1]); o.y = pk2(v[2], v[3]); o.z = pk2(v[4], v[5]); o.w = pk2(v[6], v[7]);
                if (SH != 5) *(v4u*)((SH ? YQ + (orow2[ps] & 255) * 2048 : YQ + orow2[ps] * 2048) + h * 64 + 8 * c8) = o; else asm volatile("" :: "v"(o)); }
        }
        if (SH != 6 && SH != 7) { const float dec = __builtin_amdgcn_exp2f(csc[127]);
#pragma unroll
          for (int pt = 0; pt < 4; ++pt) st[pt] *= dec;
#pragma unroll
          for (int kk = 0; kk < 4; ++kk) { const bf16x8 af = trfragB(Bi, lo.bb, 32 * kk);
#pragma unroll
              for (int pt = 0; pt < 4; ++pt) st[pt] = SSD_MFMA(af, trfragX(Xdi, lo.xb[pt], 32 * kk), st[pt]); } }
        if (step + 1 < 36) SSD_CUMSUM(step + 1, par ^ 1);
        if (step == 17) {
#pragma unroll
            for (int pt = 0; pt < 4; ++pt) st[pt] = (f32x4){0.f, 0.f, 0.f, 0.f};
            VM_WAIT();
        }
        __syncthreads();
        SSD_WRITE_STATE();
        if (step + 1 < 36 && SH != 4 && SH != 7) SSD_WRITE(step + 1, par ^ 1);
        __syncthreads();
    }
#undef SSD_DECODE
#undef SSD_ISSUE
#undef SSD_CUMSUM
#undef SSD_WRITE
#undef SSD_WRITE_STATE
}
namespace pr {
template <int CTRL, int ROWMASK> __device__ __forceinline__ float dpp_get(float v) {
    return __builtin_bit_cast(float, __builtin_amdgcn_update_dpp(0, __builtin_bit_cast(int, v), CTRL, ROWMASK, 0xF, false)); }
__device__ __forceinline__ float sum8(float q) {
    q += dpp_get<0xB1, 0xF>(q); q += dpp_get<0x4E, 0xF>(q); q += dpp_get<0x141, 0xF>(q); return q; }
__device__ __forceinline__ float scan64(float v) {
    v += dpp_get<0x111, 0xF>(v); v += dpp_get<0x112, 0xF>(v); v += dpp_get<0x114, 0xF>(v); v += dpp_get<0x118, 0xF>(v);
    v += dpp_get<0x142, 0xA>(v); v += dpp_get<0x143, 0xC>(v); return v; }
constexpr int P_B = 0, P_STG = 32768, P_X = 49152, P_XD = 81920, P_ST0 = 114688, P_ST1 = 132096, P_SM = 148480;
template <int W> __device__ __forceinline__ void diag1(f32x4 (&y)[4], const bf16x8 (&cf)[4], const LAS unsigned char* Bi, const LAS unsigned char* Xi, const LAS float* csc, float csl, float skd, int fr, int fq, const Lofs& lo) {
#pragma unroll
    for (int u = 0; u <= W / 2; ++u) {
        const bool has1 = 2 * u + 1 <= W;
        bf16x8 xf[4];
#pragma unroll
        for (int pt = 0; pt < 4; ++pt) xf[pt] = trfragX(Xi, lo.xb[pt], 32 * u);
        const f32x4 c0 = *(const LAS f32x4*)(csc + 32 * u + 4 * fq), c1 = *(const LAS f32x4*)(csc + 32 * u + 16 + 4 * fq);
        f32x4 a0 = (f32x4){0.f, 0.f, 0.f, 0.f}, a1 = (f32x4){0.f, 0.f, 0.f, 0.f};
#pragma unroll
        for (int kk = 0; kk < 4; ++kk) { a0 = SSD_MFMA(frag(Bi, lo.fb[kk], 2 * u), cf[kk], a0); if (has1) a1 = SSD_MFMA(frag(Bi, lo.fb[kk], 2 * u + 1), cf[kk], a1); }
        float m0[4], m1[4];
#pragma unroll
        for (int e = 0; e < 4; ++e) {
            m0[e] = a0[e] * __builtin_amdgcn_exp2f(fminf(csl - c0[e], 0.f)); if (2 * u == W) { if (4 * fq + e > fr) m0[e] = 0.f; if (4 * fq + e == fr) m0[e] += skd; }
            m1[e] = has1 ? a1[e] * __builtin_amdgcn_exp2f(fminf(csl - c1[e], 0.f)) : 0.f; if (2 * u + 1 == W) { if (4 * fq + e > fr) m1[e] = 0.f; if (4 * fq + e == fr) m1[e] += skd; } }
        const v4u mw = (v4u){pk2(m0[0], m0[1]), pk2(m0[2], m0[3]), pk2(m1[0], m1[1]), pk2(m1[2], m1[3])};
        const bf16x8 mf = __builtin_bit_cast(bf16x8, mw);
#pragma unroll
        for (int pt = 0; pt < 4; ++pt) y[pt] = SSD_MFMA(xf[pt], mf, y[pt]);
    }
}
__device__ __forceinline__ void diag_sw(int wave, f32x4 (&y)[4], const bf16x8 (&cf)[4], const LAS unsigned char* Bi, const LAS unsigned char* Xi, const LAS float* csc, float csl, float skd, int fr, int fq, const Lofs& lo) {
    switch (wave) {
        case 0: diag1<0>(y, cf, Bi, Xi, csc, csl, skd, fr, fq, lo); break; case 1: diag1<1>(y, cf, Bi, Xi, csc, csl, skd, fr, fq, lo); break;
        case 2: diag1<2>(y, cf, Bi, Xi, csc, csl, skd, fr, fq, lo); break; case 3: diag1<3>(y, cf, Bi, Xi, csc, csl, skd, fr, fq, lo); break;
        case 4: diag1<4>(y, cf, Bi, Xi, csc, csl, skd, fr, fq, lo); break; case 5: diag1<5>(y, cf, Bi, Xi, csc, csl, skd, fr, fq, lo); break;
        case 6: diag1<6>(y, cf, Bi, Xi, csc, csl, skd, fr, fq, lo); break; default: diag1<7>(y, cf, Bi, Xi, csc, csl, skd, fr, fq, lo); break;
    }
}

__device__ __forceinline__ void ssd_pair(int b, int hp, const bf16* XC, const float* DT, const bf16* Z, const float* a_log, const float* d_skip, bf16* YQ, float* SSQ,
                                          LAS unsigned char* L, int tid_in, int lane_in, int wave) {
    int tid = tid_in, lane = lane_in; asm volatile("" : "+v"(tid), "+v"(lane));
    const int fr = lane & 15, fq = lane >> 4, h0 = 2 * hp, g = hp >> 2;
    LAS unsigned char* Bi = L + P_B; LAS unsigned char* Stg = L + P_STG + wave * 2048;
    LAS float* dtv = (LAS float*)(L + P_SM); LAS float* cs2 = dtv + 512;
    const float an00 = -expf(a_log[h0]) * LOG2E, an01 = -expf(a_log[h0 + 1]) * LOG2E, an10 = -expf(a_log[16 + h0]) * LOG2E, an11 = -expf(a_log[16 + h0 + 1]) * LOG2E;
    const float dsk0 = d_skip[h0], dsk1 = d_skip[h0 + 1];
    Lofs lo;
    { const int q = (lane & 15) >> 2, pp = lane & 3, rr = 4 * fq + q;
#pragma unroll
      for (int kk = 0; kk < 4; ++kk) lo.fb[kk] = fr * 256 + (((4 * kk + fq) ^ fr) << 4);
#pragma unroll
      for (int pt = 0; pt < 4; ++pt) lo.xb[pt] = rr * 128 + ((pt ^ ((rr >> 1) & 3)) << 5) + 8 * pp;
      lo.bb = rr * 256 + (((2 * wave + (pp >> 1)) ^ rr) << 4) + 8 * (pp & 1);
      lo.sw = fr * 256 + (((2 * wave + (fq >> 1)) ^ fr) << 4) + (fq & 1) * 8; }
    const int sB = tid >> 4, cB = tid & 15, hx = (tid >> 3) & 1, cX = tid & 7;
    const int wB = sB * 256 + ((cB ^ (sB & 15)) << 4);
    const int wX = hx * 16384 + sB * 128 + (((cX >> 1) ^ ((sB >> 1) & 3)) << 5) + (cX & 1) * 16;
    f32x4 st[2][4];
#pragma unroll
    for (int hh = 0; hh < 2; ++hh)
#pragma unroll
        for (int pt = 0; pt < 4; ++pt) st[hh][pt] = (f32x4){0.f, 0.f, 0.f, 0.f};
    v4u Bq[4], Xq[4]; float dq0 = 0.f, dq1 = 0.f; bf16x8 cf[4];
#define PR_DECODE(step, d_, base_, ctx_) const int d_ = 1 - (step) / 18; const int k_##d_ = (step) % 18; const bool ctx_ = k_##d_ < 2; \
    const size_t base_ = ctx_ ? (size_t)ML + (size_t)b * CTXL + (size_t)(d_ ? 1 - k_##d_ : k_##d_) * 128 : (size_t)b * SEQ + (size_t)(d_ ? 17 - k_##d_ : k_##d_ - 2) * 128;
#define PR_ISSUE(step) do { PR_DECODE(step, di, basei, ctxi) (void)ctxi; \
        const bf16* cb_ = XC + basei * CONVC; const int sg_ = di ? -CONVC : CONVC; const int o0_ = di ? 127 * CONVC : 0; \
        const bf16* pb_ = cb_ + (o0_ + sB * sg_ + 1024 + g * 128 + 8 * cB); const bf16* px_ = cb_ + (o0_ + sB * sg_ + h0 * 64 + 8 * cB); \
        _Pragma("unroll") for (int k4 = 0; k4 < 4; ++k4) { Bq[k4] = *(const v4u*)(pb_ + k4 * 32 * sg_); Xq[k4] = *(const v4u*)(px_ + k4 * 32 * sg_); } \
        if (wave < 2) { const size_t r0 = basei + (di ? 127 - 2 * lane : 2 * lane), r1 = basei + (di ? 126 - 2 * lane : 2 * lane + 1); dq0 = DT[r0 * 32 + di * 16 + h0 + wave]; dq1 = DT[r1 * 32 + di * 16 + h0 + wave]; } } while (0)
#define PR_LOADC(step) do { PR_DECODE(step, dc, basec, ctxc) (void)ctxc; const bf16* pc_ = XC + basec * CONVC + ((dc ? 127 - (16 * wave + fr) : 16 * wave + fr) * CONVC + 1280 + g * 128 + 8 * fq); \
        _Pragma("unroll") for (int k4 = 0; k4 < 4; ++k4) cf[k4] = __builtin_bit_cast(bf16x8, *(const v4u*)(pc_ + 32 * k4)); } while (0)
#define PR_CUMSUM(step, par) do { if (wave < 2) { const float an = (1 - (step) / 18) ? (wave ? an11 : an10) : (wave ? an01 : an00); const float a0 = dq0 * an, a1 = dq1 * an; const float v = scan64(a0 + a1); \
        const int o_ = ((par) * 2 + wave) * 128 + 2 * lane; dtv[o_] = dq0; dtv[o_ + 1] = dq1; cs2[o_] = v - a1; cs2[o_ + 1] = v; } } while (0)
#define PR_WRITE(step, par) do { const int ob_ = ((par) * 2 + hx) * 128; const float cl = cs2[ob_ + 127]; \
        _Pragma("unroll") for (int k4 = 0; k4 < 4; ++k4) { *(LAS v4u*)(Bi + wB + k4 * 8192) = Bq[k4]; \
            const int s = sB + 32 * k4; const float dts = dtv[ob_ + s], es = __builtin_amdgcn_exp2f(cl - cs2[ob_ + s]); \
            float f[8]; unpack8(Xq[k4], f); _Pragma("unroll") for (int e = 0; e < 8; ++e) f[e] *= dts; \
            v4u xo; xo.x = pk2(f[0], f[1]); xo.y = pk2(f[2], f[3]); xo.z = pk2(f[4], f[5]); xo.w = pk2(f[6], f[7]); \
            _Pragma("unroll") for (int e = 0; e < 8; ++e) f[e] *= es; \
            v4u xd; xd.x = pk2(f[0], f[1]); xd.y = pk2(f[2], f[3]); xd.z = pk2(f[4], f[5]); xd.w = pk2(f[6], f[7]); \
            *(LAS v4u*)(L + P_X + wX + k4 * 4096) = xo; *(LAS v4u*)(L + P_XD + wX + k4 * 4096) = xd; } } while (0)
#define PR_WRITE_STATE() do { _Pragma("unroll") for (int pt = 0; pt < 4; ++pt) { \
        u32x2_t w; w.x = pk2(st[0][pt][0], st[0][pt][1]); w.y = pk2(st[0][pt][2], st[0][pt][3]); *(LAS u32x2_t*)(L + P_ST0 + lo.sw + pt * 4096) = w; \
        w.x = pk2(st[1][pt][0], st[1][pt][1]); w.y = pk2(st[1][pt][2], st[1][pt][3]); *(LAS u32x2_t*)(L + P_ST1 + lo.sw + pt * 4096) = w; } } while (0)

    __syncthreads();
    PR_ISSUE(0); PR_LOADC(0); PR_CUMSUM(0, 0); PR_WRITE_STATE();
    __syncthreads();
    PR_WRITE(0, 0);
    __syncthreads();
    for (int step = 0; step < 36; ++step) {
        const int par = step & 1; PR_DECODE(step, d, base, isctx)
        const int r8 = lane >> 3, c8 = lane & 7;
        size_t orow2[2]; v4u ybv[2], zv[2];
#pragma unroll
        for (int ps = 0; ps < 2; ++ps) { const int l = 16 * wave + 8 * ps + r8; orow2[ps] = base + (d ? 127 - l : l); }
        const bool fwdy = !isctx && d == 0;
        if (fwdy) {
#pragma unroll
            for (int ps = 0; ps < 2; ++ps) { ybv[ps] = *(const v4u*)(YQ + orow2[ps] * 2048 + h0 * 64 + 8 * c8); zv[ps] = *(const v4u*)(Z + orow2[ps] * 1024 + h0 * 64 + 8 * c8); } }
        if (step + 1 < 36) PR_ISSUE(step + 1);
        if (!isctx) {
#pragma unroll
            for (int hh = 0; hh < 2; ++hh) {
                const LAS float* csc = cs2 + (par * 2 + hh) * 128;
                const LAS unsigned char* Xi = L + P_X + hh * 16384; const LAS unsigned char* Sti = L + (hh ? P_ST1 : P_ST0);
                const float csl = csc[16 * wave + fr];
                const float skd = d == 0 ? (hh ? dsk1 : dsk0) * __builtin_amdgcn_rcpf(dtv[(par * 2 + hh) * 128 + 16 * wave + fr]) : 0.f;
                f32x4 y[4];
#pragma unroll
                for (int pt = 0; pt < 4; ++pt) { y[pt] = (f32x4){0.f, 0.f, 0.f, 0.f};
#pragma unroll
                    for (int kk = 0; kk < 4; ++kk) y[pt] = SSD_MFMA(frag(Sti, lo.fb[kk], pt), cf[kk], y[pt]); }
                { const float El = __builtin_amdgcn_exp2f(csl);
#pragma unroll
                  for (int pt = 0; pt < 4; ++pt) y[pt] *= El; }
                diag_sw(wave, y, cf, Bi, Xi, csc, csl, skd, fr, fq, lo);
#pragma unroll
                for (int ps = 0; ps < 2; ++ps) {
                    if ((fr >> 3) == ps) {
#pragma unroll
                        for (int pt = 0; pt < 4; ++pt) *(LAS f32x4*)(Stg + (fr & 7) * 256 + (((4 * pt + fq) ^ fr) << 4)) = y[pt]; }
                    const int key = 8 * ps + r8;
                    const f32x4 t0 = *(const LAS f32x4*)(Stg + r8 * 256 + (((2 * c8) ^ key) << 4)), t1 = *(const LAS f32x4*)(Stg + r8 * 256 + (((2 * c8 + 1) ^ key) << 4));
                    float v[8] = {t0[0], t0[1], t0[2], t0[3], t1[0], t1[1], t1[2], t1[3]};
                    if (d == 0) { float fb[8], fz[8]; unpack8(ybv[ps], fb); unpack8(zv[ps], fz); float q = 0.f;
#pragma unroll
                        for (int e = 0; e < 8; ++e) { v[e] = (v[e] + fb[e]) * fz[e]; q += v[e] * v[e]; }
                        q = sum8(q);
                        if (c8 == 0) SSQ[orow2[ps] * 16 + h0 + hh] = q; }
                    v4u o; o.x = pk2(v[0], v[1]); o.y = pk2(v[2], v[3]); o.z = pk2(v[4], v[5]); o.w = pk2(v[6], v[7]);
                    *(v4u*)(YQ + orow2[ps] * 2048 + (h0 + hh) * 64 + 8 * c8) = o;
                }
                if (hh == 0 && fwdy) {
#pragma unroll
                    for (int ps = 0; ps < 2; ++ps) { ybv[ps] = *(const v4u*)(YQ + orow2[ps] * 2048 + (h0 + 1) * 64 + 8 * c8); zv[ps] = *(const v4u*)(Z + orow2[ps] * 1024 + (h0 + 1) * 64 + 8 * c8); } }
            }
        }
        if (step + 1 < 36) PR_LOADC(step + 1);
        { const float dec0 = __builtin_amdgcn_exp2f(cs2[(par * 2 + 0) * 128 + 127]), dec1 = __builtin_amdgcn_exp2f(cs2[(par * 2 + 1) * 128 + 127]);
#pragma unroll
          for (int pt = 0; pt < 4; ++pt) { st[0][pt] *= dec0; st[1][pt] *= dec1; }
#pragma unroll
          for (int kk = 0; kk < 4; ++kk) { const bf16x8 af = trfragB(Bi, lo.bb, 32 * kk);
#pragma unroll
              for (int pt = 0; pt < 4; ++pt) { st[0][pt] = SSD_MFMA(af, trfragX(L + P_XD, lo.xb[pt], 32 * kk), st[0][pt]); st[1][pt] = SSD_MFMA(af, trfragX(L + P_XD + 16384, lo.xb[pt], 32 * kk), st[1][pt]); } } }
        if (step + 1 < 36) PR_CUMSUM(step + 1, par ^ 1);
        if (step == 17) {
#pragma unroll
            for (int pt = 0; pt < 4; ++pt) { st[0][pt] = (f32x4){0.f, 0.f, 0.f, 0.f}; st[1][pt] = (f32x4){0.f, 0.f, 0.f, 0.f}; }
            VM_WAIT();
        }
        __syncthreads();
        PR_WRITE_STATE();
        if (step + 1 < 36) PR_WRITE(step + 1, par ^ 1);
        __syncthreads();
    }
#undef PR_DECODE
#undef PR_ISSUE
#undef PR_CUMSUM
#undef PR_LOADC
#undef PR_WRITE
#undef PR_WRITE_STATE
}
}
}

constexpr int RING_OFF = 0, RING_BYTES = 131072;
constexpr int LDSCTL_OFF = RING_BYTES, MISC_OFF = LDSCTL_OFF + 320;
constexpr int RSTD_OFF = LDSCTL_OFF + 1024;
constexpr int LDS_BYTES = 155648;
constexpr int CW_BAR = 4096;
constexpr int CW_TMO2 = 8192, CW_CNT = 16384;
constexpr int EXL_OFF = 140288;
constexpr int NPHASE = 7;

struct Args { const float* in[18]; float* out; unsigned char* ws; int ph_lo, ph_hi; };

__global__ void __launch_bounds__(NWAVES * 64, 2) mega(Args args) {
    extern __shared__ __attribute__((aligned(16))) unsigned char lds[];
    LAS unsigned char* ldsp = (LAS unsigned char*)lds;
    volatile LAS unsigned* MISC = (volatile LAS unsigned*)(ldsp + MISC_OFF);
    const int wave = __builtin_amdgcn_readfirstlane((int)threadIdx.x >> 6);
#define PH_IDS() int lane = mk_lane(); asm volatile("" : "+v"(lane)); const int tid = wave * 64 + lane; (void)tid
    const int G = gridDim.x; const int bx = blockIdx.x; const int vcu = (G % 8 == 0) ? (bx % 8) * (G / 8) + bx / 8 : bx;
    unsigned char* ws = args.ws;
    gu32* ctl = (gu32*)(ws + WS_CTL);
    float* mod = (float*)(ws + WS_MOD); float* rope = (float*)(ws + WS_ROPE); float* SSQ = (float*)(ws + WS_SSQ); float* RPART = (float*)(ws + WS_RPART);
    bf16* bt1 = (bf16*)(ws + WS_BT1); bf16* bt2 = (bf16*)(ws + WS_BT2); float* DT = (float*)(ws + WS_DT); bf16* KB = (bf16*)(ws + WS_KB); bf16* VB = (bf16*)(ws + WS_VB);
    bf16* H = (bf16*)(ws + WS_R1); bf16* XC = (bf16*)(ws + WS_R1); bf16* XBC = (bf16*)(ws + WS_XBC); bf16* YQ = (bf16*)(ws + WS_YQ); bf16* Z = (bf16*)(ws + WS_Z);
    { PH_IDS(); for (int u = tid; u < (LDS_BYTES - LDSCTL_OFF) / 4; u += NWAVES * 64) ((LAS unsigned*)(ldsp + LDSCTL_OFF))[u] = 0u; }
    __syncthreads();
    const bool leader = wave == 0 && mk_lane() == 0; (void)leader;
    const int lo = args.ph_lo, hi = args.ph_hi;
    XcdBarrier bar; bar.bar = (unsigned*)(ctl + CW_BAR); bar.x = 0; bar.st = nullptr;
    if (hi - lo > 1) bar = xcd_barrier_post((unsigned*)(ctl + CW_BAR), MISC + 8, leader);
#ifndef DUP_MASK
#define DUP_MASK 0
#endif
#define IN(k) (lo <= (k) && (k) < hi)
#define REP(k) for (int rep_ = 0; rep_ < 1 + ((DUP_MASK >> (k)) & 1); ++rep_)
#define SEAM(k) do { if (IN(k) && IN((k) + 1)) xcd_barrier(bar, wave == 0 && mk_lane() == 0); } while (0)

    if (IN(0)) REP(0) {
        PH_IDS();
        LAS float* ldsf = (LAS float*)(ldsp + RING_OFF);
        if (bx < 48) p0_mod_block(args.in[1], args.in[3], args.in[4], args.in[5], mod, ldsf, bx, tid, lane, wave);
        else if (bx == 48) { for (int i = tid; i < 1024; i += NWAVES * 64) { const int p = i >> 4, f = i & 15; const float inv = powf(10000.f, -(float)f / 16.f); const float ang = (float)p * inv; rope[i] = cosf(ang); rope[1024 + i] = sinf(ang); } }
        LAS float* scr = ldsf + wave * (64 * 33);
        const int gw = ((bx + G - 49) % G) * NWAVES + wave, NGW = G * NWAVES;
        constexpr int I1 = 16 * 168, I2 = 32 * 32;
        for (int it = gw; it < I1 + I2; it += NGW) { if (it < I1) p0_bt1_item(args.in[7], bt1, scr, it, lane); else p0_bt2_item(args.in[16], args.in[15], bt2, scr, it - I1, lane); }
    }
    SEAM(0);
    if (IN(1)) REP(1) {
        PH_IDS();
        const int gw = bx * NWAVES + wave, NGW = G * NWAVES;
        static_assert(MT % (8 * 2048) == 0 || true, "row batches");
        {
            const int step = NGW * 4; int m0 = gw * 4;
            f32x4 va[4][4], vb[4][4];
            if (m0 < MT) p1_load4(va, args.in[0], args.in[2], m0, lane);
            while (m0 < MT) {
                if (m0 + step < MT) p1_load4(vb, args.in[0], args.in[2], m0 + step, lane);
                asm volatile("" ::: "memory");
                p1_proc4(va, mod, args.in[6], H, m0, lane);
                m0 += step; if (m0 >= MT) break;
                if (m0 + step < MT) p1_load4(va, args.in[0], args.in[2], m0 + step, lane);
                asm volatile("" ::: "memory");
                p1_proc4(vb, mod, args.in[6], H, m0, lane);
                m0 += step;
            }
        }
    }
    SEAM(1);

    if (IN(2)) REP(2) {
        pg8::Gemm g{H, bt1, MT, N1, 1024}; pg8::Sched1 S; S.init(G, bx);
        pg8::Epi1 E{KB, VB, XBC, YQ, Z, DT, rope, args.in[13], args.in[14], args.in[10]};
        pg8::gemm_phase<pg8::Epi1, pg8::Sched1, true, true>(ldsp + RING_OFF, g, S, E, wave);
    }
    SEAM(2);
    if (IN(3)) {
        PH_IDS();
        const attn_body::Order S{vcu, G, false};
        const attn_body::Order S2{vcu, G, true};
#ifndef ATTN_SHADOW
#define ATTN_SHADOW 0
#endif
        if (ATTN_SHADOW) attn_body::attn_phase<8>((char*)lds + RING_OFF, (attn_body::bf16*)YQ, (const attn_body::bf16*)KB, (const attn_body::bf16*)VB, ATTN_SHADOW == 2 ? S2 : S, wave, (attn_body::bf16*)(ws + WS_END + 8 * MiB));
        attn_body::attn_phase<8>((char*)lds + RING_OFF, (attn_body::bf16*)YQ, (const attn_body::bf16*)KB, (const attn_body::bf16*)VB, S, wave);
        conv_phase(XBC, args.in[8], args.in[9], XC, bx, G, tid);
    }
    SEAM(3);
    if (IN(4)) REP(4) {
        PH_IDS();
#if defined(SSD_NAIVE)
        for (int it = bx; it < NB * 16; it += G) ssd_item_naive(it >> 4, it & 15, XC, DT, Z, args.in[11], args.in[12], YQ, SSQ, (LAS float*)(ldsp + RING_OFF), tid);
#else
#ifndef SSD_SHADOW
#define SSD_SHADOW 0
#endif
        if (SSD_SHADOW) { bf16* dY = (bf16*)(ws + WS_END); float* dS = (float*)(ws + WS_END + 2 * MiB);
            for (int it = vcu; it < NB * 16; it += G) ssd::ssd_item<SSD_SHADOW>(it >> 4, it & 15, XC, DT, Z, args.in[11], args.in[12], dY, dS, ldsp, tid, lane, wave); }
#ifndef SSD_PAIR
#define SSD_PAIR 1
#endif
        if (SSD_PAIR) { for (int it = vcu; it < NB * 8; it += G) { int ln_ = mk_lane(); asm volatile("" : "+v"(ln_)); ssd::pr::ssd_pair(it >> 3, it & 7, XC, DT, Z, args.in[11], args.in[12], YQ, SSQ, ldsp, wave * 64 + ln_, ln_, wave); } }
        else for (int it = vcu; it < NB * 16; it += G) ssd::ssd_item<0>(it >> 4, it & 15, XC, DT, Z, args.in[11], args.in[12], YQ, SSQ, ldsp, tid, lane, wave);
#endif
    }
    SEAM(4);

    if (IN(5)) REP(5) {
        PH_IDS();
        pg8::Sched2 S; S.init(G, bx);
        LAS float* rt = (LAS float*)(ldsp + RSTD_OFF);
        { pg8::Unit u; for (int i = 0; i < 4 && S.next(i, u); ++i) if (tid < 256) { const float* q = SSQ + ((size_t)u.pm * 256 + tid) * 16; float s = 0.f;
#pragma unroll
                for (int j = 0; j < 16; ++j) s += q[j];
                rt[i * 256 + tid] = rsqrtf(s * (1.f / 1024.f) + EPS); } }
        __syncthreads();
        pg8::Gemm g{YQ, bt2, ML, 1024, 2048};
        pg8::Epi2 E{args.in[0], mod, args.in[17], args.out, (unsigned long long*)RPART, (unsigned*)(ctl + CW_CNT), (unsigned*)(ctl + CW_TMO2), (const LAS float*)rt, (LAS float*)(ldsp + EXL_OFF)};
        pg8::gemm_phase<pg8::Epi2, pg8::Sched2, true, true>(ldsp + RING_OFF, g, S, E, wave);
    }

#undef IN
#undef SEAM
}

__global__ void k_mod(const float* c, const float* c_ctx, const float* ada_w, const float* ada_b, float* mod) {
    const int i = blockIdx.x * 256 + threadIdx.x; if (i >= 33 * 3072) return;
    const int b = i / 3072, n = i % 3072; const float* cv = b < 32 ? c + b * 1024 : c_ctx;
    float acc = 0.f;
    for (int k = 0; k < 1024; ++k) acc += siluf(cv[k]) * ada_w[(size_t)k * 3072 + n];
    mod[i] = acc + ada_b[n];
}
__global__ void k_tables(float* rope) {
    const int i = blockIdx.x * 256 + threadIdx.x; if (i >= 1024) return;
    const int p = i >> 4, f = i & 15; const float inv = powf(10000.f, -(float)f / 16.f); const float ang = (float)p * inv;
    rope[i] = cosf(ang); rope[1024 + i] = sinf(ang);
}
__global__ void k_bt1(const float* w_in, bf16* bt1) {
    const size_t i = (size_t)blockIdx.x * 256 + threadIdx.x; if (i >= (size_t)N1 * 1024) return;
    const int v = (int)(i >> 10), k = (int)(i & 1023); const int a = vcol_actual(v);
    bt1[i] = (bf16)(a >= 0 ? f2bf(w_in[(size_t)k * PROJ + a]) : 0u);
}
__global__ void k_bt2(const float* w_out, const float* ssd_g, bf16* bt2) {
    const size_t i = (size_t)blockIdx.x * 256 + threadIdx.x; if (i >= (size_t)1024 * 2048) return;
    const int n = (int)(i >> 11), kk = (int)(i & 2047);
    const float v = kk < 1024 ? w_out[(size_t)(1024 + kk) * 1024 + n] * ssd_g[kk] : w_out[(size_t)(kk - 1024) * 1024 + n];
    bt2[i] = (bf16)f2bf(v);
}
__global__ void k_norm(const float* x, const float* ctx, const float* norm_g, const float* mod, bf16* H) {
    const int row = blockIdx.x * 4 + (threadIdx.x >> 6), lane = threadIdx.x & 63; if (row >= MT) return;
    const float* xr = row < ML ? x + (size_t)row * DM : ctx + (size_t)(row - ML) * DM;
    const float* md = mod + (size_t)(row < ML ? row / SEQ : 32) * 3072;
    float v[16]; float s = 0.f;
    for (int j = 0; j < 16; ++j) { v[j] = xr[lane + 64 * j]; s += v[j] * v[j]; }
    for (int o = 1; o < 64; o <<= 1) s += __shfl_xor(s, o);
    const float rstd = rsqrtf(s * (1.f / DM) + EPS);
    for (int j = 0; j < 16; ++j) { const int k = lane + 64 * j; const float h = v[j] * rstd * norm_g[k] * (1.f + md[1024 + k]) + md[k]; H[(size_t)row * DM + k] = (bf16)f2bf(h); }
}
__global__ __launch_bounds__(256) void k_gemm1(const bf16* H, const bf16* bt1, const float* rope, const float* qg, const float* kg, const float* dt_bias,
                                                bf16* KB, bf16* VB, bf16* XBC, float* DT, bf16* YQ, bf16* Z) {
    __shared__ float As[32][65];
    __shared__ float Ps[32][257];
    const int pn = blockIdx.x, rt = blockIdx.y, tid = threadIdx.x; const int row0 = rt * 32;
    if (row0 >= ML && pn > 8) return;
    float acc[32];
    for (int r = 0; r < 32; ++r) acc[r] = 0.f;
    const bf16* bp = bt1 + (size_t)(pn * 256 + tid) * 1024;
    for (int k0 = 0; k0 < 1024; k0 += 64) {
        __syncthreads();
        for (int e = tid; e < 32 * 64; e += 256) { const int r = e >> 6, kk = e & 63; As[r][kk] = bf2f(H[(size_t)(row0 + r) * DM + k0 + kk]); }
        __syncthreads();
        for (int kk = 0; kk < 64; ++kk) { const float b = bf2f(bp[k0 + kk]);
            for (int r = 0; r < 32; ++r) acc[r] += As[r][kk] * b; }
    }
    for (int r = 0; r < 32; ++r) Ps[r][tid] = acc[r];
    __syncthreads();
    const bool isctx = row0 >= ML;
    if (pn == 0 || (pn >= 9 && pn < 13)) {
        {
            const int r = tid >> 3, hd = (tid >> 1) & 3, ax = tid & 1, row = row0 + r; const float* g = pn == 0 ? kg : qg;
            float s = 0.f;
            for (int d = 0; d < 32; ++d) { const float v = Ps[r][hperm_inv(hd, ax * 32 + d)]; s += v * v; }
            s += __shfl_xor(s, 1);
            const float rstd = rsqrtf(s * (1.f / 64.f) + EPS);
            const int t = row % SEQ, p = ax == 0 ? (t >> 6) : (t & 63);
            bf16* dst; float osc = 1.f;
            if (pn == 0) { const int b = isctx ? (row - ML) / CTXL : row / SEQ, pos = isctx ? SEQ + (row - ML) % CTXL : row % SEQ; dst = KB + ((size_t)b * KVL + pos) * 256 + hd * 64 + ax * 32; }
            else { dst = YQ + (size_t)row * 2048 + 1024 + ((pn - 9) * 4 + hd) * 64 + ax * 32; osc = C2; }
            for (int f = 0; f < 16; ++f) {
                const float x1 = Ps[r][hperm_inv(hd, ax * 32 + f)] * rstd * g[ax * 32 + f], x2 = Ps[r][hperm_inv(hd, ax * 32 + 16 + f)] * rstd * g[ax * 32 + 16 + f];
                float o1 = x1, o2 = x2;
                if (!isctx) { const float cs = rope[p * 16 + f], sn = rope[1024 + p * 16 + f]; o1 = x1 * cs - x2 * sn; o2 = x2 * cs + x1 * sn; }
                dst[f] = (bf16)f2bf(o1 * osc); dst[16 + f] = (bf16)f2bf(o2 * osc);
            }
        }
    } else {
        for (int r = 0; r < 32; ++r) { const int row = row0 + r; const float v = Ps[r][tid];
            if (pn == 1) { const int b = isctx ? (row - ML) / CTXL : row / SEQ, pos = isctx ? SEQ + (row - ML) % CTXL : row % SEQ;
                VB[((size_t)b * KVL + pos) * 256 + tid] = (bf16)f2bf(v); }
            else if (pn < 8) XBC[(size_t)row * CONVC + (pn - 2) * 256 + tid] = (bf16)f2bf(v);
            else if (pn == 8) { if (tid < 32) DT[(size_t)row * 32 + tid] = softplusf(v + dt_bias[tid]); }
            else if (pn < 17) YQ[(size_t)row * 2048 + (pn - 13) * 256 + tid] = (bf16)f2bf(siluf(v));
            else Z[(size_t)row * 1024 + (pn - 17) * 256 + tid] = (bf16)f2bf(siluf(v)); }
    }
}
__global__ __launch_bounds__(256) void k_attn(bf16* YQ, const bf16* KB, const bf16* VB) {
    __shared__ float Qs[64][65]; __shared__ float Ks[64][65]; __shared__ float Ps[64][65]; __shared__ bf16 Vs[64][66];
    const int qb = blockIdx.x, h = blockIdx.y, b = blockIdx.z, tid = threadIdx.x, ty = tid >> 4, tx = tid & 15;
    const size_t row0 = (size_t)b * SEQ + qb * 64; const int kvh = h >> 2;
    for (int e = tid; e < 4096; e += 256) { const int r = e >> 6, d = e & 63; Qs[r][d] = bf2f(YQ[(row0 + r) * 2048 + 1024 + h * 64 + d]); }
    float o[4][4], l[4];
    for (int i = 0; i < 4; ++i) { l[i] = 0.f; for (int j = 0; j < 4; ++j) o[i][j] = 0.f; }
    for (int kt = 0; kt < KVL / 64; ++kt) {
        __syncthreads();
        for (int e = tid; e < 4096; e += 256) { const int r = e >> 6, d = e & 63; const size_t src = ((size_t)b * KVL + kt * 64 + r) * 256 + kvh * 64 + d;
            Ks[r][d] = bf2f(KB[src]); Vs[r][d] = VB[src]; }
        __syncthreads();
        float s[4][4];
        for (int i = 0; i < 4; ++i) for (int j = 0; j < 4; ++j) s[i][j] = 0.f;
        for (int d = 0; d < 64; ++d) { float a[4], k4[4];
            for (int i = 0; i < 4; ++i) { a[i] = Qs[ty * 4 + i][d]; k4[i] = Ks[tx * 4 + i][d]; }
            for (int i = 0; i < 4; ++i) for (int j = 0; j < 4; ++j) s[i][j] += a[i] * k4[j]; }
        for (int i = 0; i < 4; ++i) for (int j = 0; j < 4; ++j) Ps[ty * 4 + i][tx * 4 + j] = exp2f(s[i][j]);
        __syncthreads();
        for (int key = 0; key < 64; ++key) { float p[4], v4[4];
            for (int i = 0; i < 4; ++i) { p[i] = Ps[ty * 4 + i][key]; v4[i] = bf2f(Vs[key][tx * 4 + i]); }
            for (int i = 0; i < 4; ++i) { l[i] += p[i]; for (int j = 0; j < 4; ++j) o[i][j] += p[i] * v4[j]; } }
    }
    for (int i = 0; i < 4; ++i) for (int j = 0; j < 4; ++j) { const size_t row = row0 + ty * 4 + i; const int d = tx * 4 + j;
        const float ga = bf2f(YQ[row * 2048 + h * 64 + d]);
        YQ[row * 2048 + 1024 + h * 64 + d] = (bf16)f2bf(o[i][j] / l[i] * ga); }
}
__global__ void k_conv(const bf16* XBC, const float* cw, const float* cb, bf16* XC) {
    const size_t i = (size_t)blockIdx.x * 256 + threadIdx.x; if (i >= (size_t)MT * CONVC) return;
    const int row = (int)(i / CONVC), ch = (int)(i % CONVC);
    int t, len; if (row < ML) { t = row % SEQ; len = SEQ; } else { t = (row - ML) % CTXL; len = CTXL; }
    float acc = cb[ch];
    for (int j = 0; j < 5; ++j) { const int tt = t + j - 2; if (tt >= 0 && tt < len) acc += cw[j * CONVC + ch] * bf2f(XBC[(size_t)(row + j - 2) * CONVC + ch]); }
    XC[i] = (bf16)f2bf(siluf(acc));
}
__global__ __launch_bounds__(512) void k_ssd(const bf16* XC, const float* DT, const bf16* Z, const float* a_log, const float* d_skip, bf16* YQ, float* SSQ) {
    __shared__ float ysq[64];
    const int h = blockIdx.x, b = blockIdx.y, tid = threadIdx.x, p = tid >> 3, nc = tid & 7, g = h >> 3;
    for (int dd = 0; dd < 2; ++dd) { const int d = 1 - dd;
        const float a_neg = -expf(a_log[d * 16 + h]);
        float S[16];
        for (int j = 0; j < 16; ++j) S[j] = 0.f;
        for (int seq = 0; seq < 2; ++seq) { const int len = seq == 0 ? CTXL : SEQ; const size_t rbase = seq == 0 ? (size_t)ML + (size_t)b * CTXL : (size_t)b * SEQ;
            for (int st = 0; st < len; ++st) { const int t = d ? len - 1 - st : st; const size_t row = rbase + t;
                const float dt = DT[row * 32 + d * 16 + h]; const float dec = expf(dt * a_neg);
                const float xs = bf2f(XC[row * CONVC + h * 64 + p]); const float X = xs * dt;
                const bf16* Bp = XC + row * CONVC + 1024 + g * 128 + nc * 16; const bf16* Cp = Bp + 256;
                float y = 0.f;
                for (int j = 0; j < 16; ++j) { S[j] = S[j] * dec + X * bf2f(Bp[j]); y += bf2f(Cp[j]) * S[j]; }
                y += __shfl_xor(y, 1); y += __shfl_xor(y, 2); y += __shfl_xor(y, 4);
                if (seq == 1) {
                    bf16* yp = YQ + row * 2048 + h * 64 + p;
                    if (d == 1) { if (nc == 0) *yp = (bf16)f2bf(y); }
                    else {
                        float yg = 0.f;
                        if (nc == 0) { const float yt = y + bf2f(*yp) + d_skip[h] * xs; yg = yt * bf2f(Z[row * 1024 + h * 64 + p]); *yp = (bf16)f2bf(yg); ysq[p] = yg * yg; }
                        __syncthreads();
                        if (tid < 64) { float q = ysq[tid]; for (int o = 1; o < 64; o <<= 1) q += __shfl_xor(q, o); if (tid == 0) SSQ[row * 16 + h] = q; }
                        __syncthreads();
                    }
                }
            }
        }
    }
}
__global__ __launch_bounds__(256) void k_gemm2(const bf16* YQ, const bf16* bt2, const float* SSQ, const float* x, const float* mod, float* out, float* RPART) {
    __shared__ float As[32][65]; __shared__ float red[32][4];
    const int pn = blockIdx.x, rt = blockIdx.y, tid = threadIdx.x, row0 = rt * 32;
    float acc[32];
    for (int r = 0; r < 32; ++r) acc[r] = 0.f;
    const bf16* bp = bt2 + (size_t)(pn * 256 + tid) * 2048;
    for (int k0 = 0; k0 < 2048; k0 += 64) {
        if (k0 == 1024) { for (int r = 0; r < 32; ++r) { float s = 0.f; for (int j = 0; j < 16; ++j) s += SSQ[(size_t)(row0 + r) * 16 + j]; acc[r] *= rsqrtf(s * (1.f / 1024.f) + EPS); } }
        __syncthreads();
        for (int e = tid; e < 32 * 64; e += 256) { const int r = e >> 6, kk = e & 63; As[r][kk] = bf2f(YQ[(size_t)(row0 + r) * 2048 + k0 + kk]); }
        __syncthreads();
        for (int kk = 0; kk < 64; ++kk) { const float bv = bf2f(bp[k0 + kk]);
            for (int r = 0; r < 32; ++r) acc[r] += As[r][kk] * bv; }
    }
    const int n = pn * 256 + tid;
    for (int r = 0; r < 32; ++r) { const int row = row0 + r; const float v = x[(size_t)row * DM + n] + mod[(size_t)(row / SEQ) * 3072 + 2048 + n] * acc[r];
        out[(size_t)row * DM + n] = v; float q = v * v;
        for (int o = 1; o < 64; o <<= 1) q += __shfl_xor(q, o);
        if ((tid & 63) == 0) RPART[(size_t)row * 16 + pn * 4 + (tid >> 6)] = q; }
}
__global__ void k_final(float* out, const float* RPART, const float* fg) {
    const int row = blockIdx.x * 4 + (threadIdx.x >> 6), lane = threadIdx.x & 63;
    float s = 0.f;
    for (int j = 0; j < 16; ++j) s += RPART[(size_t)row * 16 + j];
    const float rstd = rsqrtf(s * (1.f / DM) + EPS);
    for (int j = 0; j < 16; ++j) { const int k = lane + 64 * j; out[(size_t)row * DM + k] *= rstd * fg[k]; }
}


#ifndef FAST_MASK
#define FAST_MASK 0x7f
#endif
extern "C" void kernel_launch(void* const* d_in, const int* in_sizes, int n_in, void* d_out, int out_size, void* d_ws, size_t ws_size, hipStream_t stream) {
    if (n_in != 18 || out_size != ML * DM || ws_size < WS_END) { fprintf(stderr, "kernel_launch: unexpected shapes (n_in %d out %d ws %zu)\n", n_in, out_size, ws_size); return; }
    static int grid = 0;
    if (grid == 0) {
        int dev = 0, cus = 0;
        if (hipGetDevice(&dev) != hipSuccess || hipDeviceGetAttribute(&cus, hipDeviceAttributeMultiprocessorCount, dev) != hipSuccess) { fprintf(stderr, "kernel_launch: device query failed\n"); grid = -1; return; }
        if (hipFuncSetAttribute((const void*)mega, hipFuncAttributeMaxDynamicSharedMemorySize, LDS_BYTES) != hipSuccess) { fprintf(stderr, "kernel_launch: hipFuncSetAttribute failed\n"); grid = -1; return; }
        int per_cu = 0;
        if (hipOccupancyMaxActiveBlocksPerMultiprocessor(&per_cu, (const void*)mega, NWAVES * 64, LDS_BYTES) != hipSuccess || per_cu < 1) fprintf(stderr, "kernel_launch: note: occupancy query says %d blocks/CU\n", per_cu);
        (void)hipGetLastError();
        grid = cus;
    }
    if (grid < 0) return;
    const float* x = (const float*)d_in[0]; const float* c = (const float*)d_in[1]; const float* ctx = (const float*)d_in[2]; const float* c_ctx = (const float*)d_in[3];
    const float* ada_w = (const float*)d_in[4]; const float* ada_b = (const float*)d_in[5]; const float* norm_g = (const float*)d_in[6]; const float* w_in = (const float*)d_in[7];
    const float* conv_w = (const float*)d_in[8]; const float* conv_b = (const float*)d_in[9]; const float* dt_bias = (const float*)d_in[10]; const float* a_log = (const float*)d_in[11];
    const float* d_skip = (const float*)d_in[12]; const float* qg = (const float*)d_in[13]; const float* kg = (const float*)d_in[14]; const float* ssd_g = (const float*)d_in[15];
    const float* w_out = (const float*)d_in[16]; const float* final_g = (const float*)d_in[17];
    unsigned char* ws = (unsigned char*)d_ws; float* out = (float*)d_out;
    float* mod = (float*)(ws + WS_MOD); float* rope = (float*)(ws + WS_ROPE); float* SSQ = (float*)(ws + WS_SSQ); float* RPART = (float*)(ws + WS_RPART);
    bf16* bt1 = (bf16*)(ws + WS_BT1); bf16* bt2 = (bf16*)(ws + WS_BT2); float* DT = (float*)(ws + WS_DT); bf16* KB = (bf16*)(ws + WS_KB); bf16* VB = (bf16*)(ws + WS_VB);
    bf16* H = (bf16*)(ws + WS_R1); bf16* XC = (bf16*)(ws + WS_R1); bf16* XBC = (bf16*)(ws + WS_XBC); bf16* YQ = (bf16*)(ws + WS_YQ); bf16* Z = (bf16*)(ws + WS_Z);
    (void)hipMemsetAsync(ws + WS_CTL, 0, 1 * MiB, stream);
    Args a{};
    for (int i = 0; i < 18; ++i) a.in[i] = (const float*)d_in[i];
    a.out = out; a.ws = ws;
    for (int ph = 0; ph < NPHASE;) {
        if ((FAST_MASK >> ph) & 1) { int e = ph; while (e < NPHASE && ((FAST_MASK >> e) & 1)) ++e;
            a.ph_lo = ph; a.ph_hi = e; hipLaunchKernelGGL(mega, dim3(grid), dim3(NWAVES * 64), LDS_BYTES, stream, a);
            const hipError_t le = hipPeekAtLastError(); if (le != hipSuccess) fprintf(stderr, "kernel_launch: mega launch failed: %s\n", hipGetErrorName(le));
            ph = e; continue; }
        switch (ph) {
        case 0: k_mod<<<(33 * 3072 + 255) / 256, 256, 0, stream>>>(c, c_ctx, ada_w, ada_b, mod); k_tables<<<4, 256, 0, stream>>>(rope);
                k_bt1<<<(N1 * 1024) / 256, 256, 0, stream>>>(w_in, bt1); k_bt2<<<(1024 * 2048) / 256, 256, 0, stream>>>(w_out, ssd_g, bt2); break;
        case 1: k_norm<<<MT / 4, 256, 0, stream>>>(x, ctx, norm_g, mod, H); break;
        case 2: k_gemm1<<<dim3(21, MT / 32), 256, 0, stream>>>(H, bt1, rope, qg, kg, dt_bias, KB, VB, XBC, DT, YQ, Z); break;
        case 3: k_attn<<<dim3(SEQ / 64, 16, NB), 256, 0, stream>>>(YQ, KB, VB); k_conv<<<(unsigned)(((size_t)MT * CONVC + 255) / 256), 256, 0, stream>>>(XBC, conv_w, conv_b, XC); break;
        case 4: k_ssd<<<dim3(16, NB), 512, 0, stream>>>(XC, DT, Z, a_log, d_skip, YQ, SSQ); break;
        case 5: k_gemm2<<<dim3(4, ML / 32), 256, 0, stream>>>(YQ, bt2, SSQ, x, mod, out, RPART); break;
        case 6: k_final<<<ML / 4, 256, 0, stream>>>(out, RPART, final_g); break;
        }
        ++ph;
    }
}
```

```cpp
#include <hip/hip_runtime.h>
#include <cstdio>
#include <cstdint>
#include <hip/hip_bf16.h>

constexpr int DM = 1024, NB = 32, SEQ = 2048, CTXL = 256, KVL = SEQ + CTXL;
constexpr int ML = NB * SEQ, MC = NB * CTXL, MT = ML + MC;
constexpr int PROJ = 5152, OFF_XBC = 512, OFF_DT = 2048, CTXC = 2080, CONVC = 1536;
constexpr int N1 = 21 * 256;
constexpr float EPS = 1e-6f;
constexpr float C2 = 0.125f * 1.4426950408889634f;

typedef unsigned short bf16;
__device__ __forceinline__ int mk_lane() { return (int)__builtin_amdgcn_mbcnt_hi(~0u, __builtin_amdgcn_mbcnt_lo(~0u, 0u)); }
__host__ __device__ __forceinline__ unsigned f2bf(float f) { unsigned u = __builtin_bit_cast(unsigned, f); return (u + 0x7fffu + ((u >> 16) & 1u)) >> 16; }
__host__ __device__ __forceinline__ float bf2f(unsigned h) { return __builtin_bit_cast(float, (h & 0xffffu) << 16); }
__device__ __forceinline__ float siluf(float v) { return v / (1.f + __expf(-v)); }
__device__ __forceinline__ float softplusf(float v) { return v > 20.f ? v : log1pf(expf(v)); }

constexpr size_t MiB = 1u << 20;
constexpr size_t WS_CTL = 0;
constexpr size_t WS_MOD = 2 * MiB;
constexpr size_t WS_ROPE = 3 * MiB;
constexpr size_t WS_SSQ = 4 * MiB;
constexpr size_t WS_RPART = 8 * MiB;
constexpr size_t WS_BT1 = 12 * MiB;
constexpr size_t WS_BT2 = 23 * MiB;
constexpr size_t WS_DT = 28 * MiB;
constexpr size_t WS_KB = 38 * MiB;
constexpr size_t WS_VB = 74 * MiB;
constexpr size_t WS_R1 = 110 * MiB;
constexpr size_t WS_XBC = 326 * MiB;
constexpr size_t WS_YQ = 542 * MiB;
constexpr size_t WS_Z = 798 * MiB;
constexpr size_t WS_END = 926 * MiB;

__host__ __device__ __forceinline__ int hperm_dim(int vin) {
    const int bj = vin >> 7, wc = (vin >> 5) & 3, s = vin & 31, fq = s >> 3, e = s & 7;
    return wc * 64 + bj * 32 + (e >> 2) * 16 + 4 * fq + (e & 3);
}
__host__ __device__ __forceinline__ int hperm_inv(int head, int dim) {
    const int axis = dim >> 5, half = (dim >> 4) & 1, i16 = dim & 15, fq = i16 >> 2, e = (i16 & 3) + 4 * half;
    return 128 * axis + 32 * head + 8 * fq + e;
}
__host__ __device__ __forceinline__ int vcol_actual(int v) {
    const int t = v >> 8, vin = v & 255;
    if (t == 0) return hperm_dim(vin);
    if (t == 1) return 256 + vin;
    if (t < 8) return v;
    if (t == 8) return vin < 32 ? OFF_DT + vin : -1;
    if (t < 13) return CTXC + (t - 9) * 256 + hperm_dim(vin);
    if (t < 17) return CTXC + 1024 + (v - 13 * 256);
    return CTXC + 2048 + (v - 17 * 256);
}

namespace pg8 {
#define PG8_LAS __attribute__((address_space(3)))
typedef unsigned short bf16_t;
typedef short bf16x8 __attribute__((ext_vector_type(8)));
typedef float f32x4 __attribute__((ext_vector_type(4)));
typedef unsigned u32x4 __attribute__((ext_vector_type(4)));
constexpr int BM = 256, BK = 64, HALF = 128, HTB = HALF * BK * 2  , STAGE_BYTES = 8 * HTB, NXCD = 8, WGM = 8;

__host__ __device__ __forceinline__ int lds_byte(int r, int c) { const int st = (r >> 4) * 2 + (c >> 5), rr = r & 15, cc = c & 31, ob = rr * 64 + cc * 2; return st * 1024 + (ob ^ (((ob >> 9) & 1) << 5)); }
__host__ __device__ __forceinline__ void stage_rc(int b, int& R, int& C) { const int st = b / 1024, sb = b % 1024, swz = sb ^ (((sb >> 9) & 1) << 5); R = (st >> 1) * 16 + swz / 64; C = (st & 1) * 32 + (swz % 64) / 2; }
__host__ __device__ __forceinline__ int perm32(int rho) { const int n = rho >> 4, i = rho & 15; return 8 * (i >> 2) + 4 * n + (i & 3); }

struct Unit { int pm, pn; };
struct Gemm { const bf16_t* A; const bf16_t* Bt; int M, N, K; };

__device__ __forceinline__ unsigned cvt_pk_bf16(float lo, float hi) { unsigned r; asm volatile("v_cvt_pk_bf16_f32 %0, %1, %2" : "=v"(r) : "v"(lo), "v"(hi)); return r; }
typedef float f32x2 __attribute__((ext_vector_type(2)));
template <class Epi, class Sched, bool ALIGN_EPI = false, bool SP2 = false>
__device__ __forceinline__ void gemm_phase(PG8_LAS unsigned char* lds, const Gemm g, const Sched& S, const Epi& E, int wid_in) {
    const int wid = wid_in; int lane = mk_lane(); asm volatile("" : "+v"(lane)); const int tid = wid * 64 + lane, wr = wid >> 2, wc = wid & 3, fr = lane & 15, fq = lane >> 4;
    const int K = g.K, nt = K / BK;
    unsigned voffA[2], voffB[2];
#pragma unroll
    for (int i = 0; i < 2; ++i) { int R, C; stage_rc(tid * 16 + i * 8192, R, C); const int Rb = Epi::PERM ? ((R & ~31) + perm32(R & 31)) : R;
        voffA[i] = (unsigned)(R * K + C) * 2u; voffB[i] = (unsigned)(Rb * K + C) * 2u; }
    const size_t kstep = (size_t)(BK * 2);
    const size_t hstep = (size_t)HALF * K * 2;
    const size_t tstep = 2 * hstep;
    const unsigned ldsw = (unsigned)wid * 1024u;
    const int aoff = lds_byte(wr * 64 + fr, fq * 8), boff = lds_byte(wc * 32 + fr, fq * 8);
#define PG8_SA(b, h) (((b) * 2 + (h)) * HTB)
#define PG8_SB(b, h) ((4 + (b) * 2 + (h)) * HTB)
#define PG8_STAGE(bufoff, gbase, voff) do { _Pragma("unroll") for (int _i = 0; _i < 2; ++_i) \
        __builtin_amdgcn_global_load_lds((const unsigned*)((const char*)(gbase) + (voff)[_i]), (PG8_LAS unsigned*)(lds + (bufoff) + ldsw + _i * 8192), 16, 0, 0); } while (0)
#define PG8_LDA(dst, b, h) do { _Pragma("unroll") for (int m = 0; m < 4; ++m) _Pragma("unroll") for (int k = 0; k < 2; ++k) dst[m][k] = *(const PG8_LAS bf16x8*)(lds + PG8_SA(b, h) + aoff + m * 2048 + k * 1024); } while (0)
#define PG8_LDB(dst, b, h) do { _Pragma("unroll") for (int n = 0; n < 2; ++n) _Pragma("unroll") for (int k = 0; k < 2; ++k) dst[n][k] = *(const PG8_LAS bf16x8*)(lds + PG8_SB(b, h) + boff + n * 2048 + k * 1024); } while (0)
#define PG8_MMA(ai, bj, At, Bt) do { __builtin_amdgcn_s_setprio(1); _Pragma("unroll") for (int m = 0; m < 4; ++m) _Pragma("unroll") for (int n = 0; n < 2; ++n) _Pragma("unroll") for (int k = 0; k < 2; ++k) \
        acc[ai][bj][m][n] = __builtin_amdgcn_mfma_f32_16x16x32_bf16(Bt[n][k], At[m][k], acc[ai][bj][m][n], 0, 0, 0); __builtin_amdgcn_s_setprio(0); } while (0)
#define PG8_WAIT_V(n) asm volatile("s_waitcnt vmcnt(" #n ")" ::: "memory")
#define PG8_WAIT_L(n) asm volatile("s_waitcnt lgkmcnt(" #n ")" ::: "memory")
#define PG8_BAR __builtin_amdgcn_s_barrier()
#define PG8_SCHED __builtin_amdgcn_sched_barrier(0)
    Unit cur, nxt; int ui = 0;
    if (!S.next(0, cur)) return;
    f32x4 acc[2][2][4][2];
#pragma unroll
    for (int a = 0; a < 2; ++a)
#pragma unroll
        for (int b = 0; b < 2; ++b)
#pragma unroll
            for (int m = 0; m < 4; ++m)
#pragma unroll
                for (int n = 0; n < 2; ++n) acc[a][b][m][n] = (f32x4){0.f, 0.f, 0.f, 0.f};
    bf16x8 At[4][2], B0[2][2], B1[2][2];
    const char* cA = (const char*)g.A + (size_t)cur.pm * tstep; const char* cB = (const char*)g.Bt + (size_t)cur.pn * tstep;
    S.a_ready(cur);
    if constexpr (SP2) {
        PG8_STAGE(PG8_SB(0, 0), cB, voffB); PG8_STAGE(PG8_SB(0, 1), cB + hstep, voffB); PG8_STAGE(PG8_SA(0, 0), cA, voffA); PG8_STAGE(PG8_SA(0, 1), cA + hstep, voffA);
        if (wr == 1) PG8_BAR;
        PG8_WAIT_V(2); PG8_BAR;
        PG8_STAGE(PG8_SB(1, 0), cB + kstep, voffB); PG8_STAGE(PG8_SA(1, 0), cA + kstep, voffA); PG8_STAGE(PG8_SB(1, 1), cB + hstep + kstep, voffB);
        PG8_WAIT_V(6); PG8_BAR;
    } else {
        PG8_STAGE(PG8_SB(0, 0), cB, voffB); PG8_STAGE(PG8_SA(0, 0), cA, voffA); PG8_STAGE(PG8_SB(0, 1), cB + hstep, voffB); PG8_STAGE(PG8_SA(0, 1), cA + hstep, voffA);
        if (wr == 1) PG8_BAR;
        PG8_WAIT_V(4); PG8_BAR;
        PG8_STAGE(PG8_SB(1, 0), cB + kstep, voffB); PG8_STAGE(PG8_SA(1, 0), cA + kstep, voffA); PG8_STAGE(PG8_SB(1, 1), cB + hstep + kstep, voffB);
        PG8_WAIT_V(6); PG8_BAR;
    }
    for (;;) {
        const bool has_next = S.next(ui + 1, nxt);
        const char* nA = has_next ? (const char*)g.A + (size_t)nxt.pm * tstep : cA; const char* nB = has_next ? (const char*)g.Bt + (size_t)nxt.pn * tstep : cB;
        for (int t = 0; t < nt; t += 2) {
            if constexpr (Epi::MIDK) { if (t == nt / 2) E.midk(acc, ui, wr, fr); }
            const bool last = (t == nt - 2);
            const char* a1 = cA + (size_t)(t + 1) * kstep;
            const char* a2 = last ? nA : cA + (size_t)(t + 2) * kstep; const char* b2 = last ? nB : cB + (size_t)(t + 2) * kstep;
            const char* a3 = a2 + kstep; const char* b3 = b2 + kstep;
            if (last && has_next) S.a_ready(nxt);
            if constexpr (SP2) {
            PG8_LDB(B0, 0, 0); PG8_LDB(B1, 0, 1); PG8_SCHED; PG8_LDA(At, 0, 0); PG8_STAGE(PG8_SA(1, 1), a1 + hstep, voffA);
            PG8_WAIT_V(8); PG8_WAIT_L(0); PG8_BAR; PG8_MMA(0, 0, At, B0); PG8_MMA(0, 1, At, B1); PG8_BAR; PG8_SCHED;
            PG8_LDA(At, 0, 1); PG8_STAGE(PG8_SB(0, 0), b2, voffB); PG8_STAGE(PG8_SB(0, 1), b2 + hstep, voffB); PG8_STAGE(PG8_SA(0, 0), a2, voffA);
            PG8_WAIT_V(8); PG8_WAIT_L(0); PG8_BAR; PG8_MMA(1, 0, At, B0); PG8_MMA(1, 1, At, B1); PG8_BAR; PG8_SCHED;
            PG8_LDB(B0, 1, 0); PG8_LDB(B1, 1, 1); PG8_SCHED; PG8_LDA(At, 1, 0); PG8_STAGE(PG8_SA(0, 1), a2 + hstep, voffA);
            PG8_WAIT_V(8); PG8_WAIT_L(0); PG8_BAR; PG8_MMA(0, 0, At, B0); PG8_MMA(0, 1, At, B1); PG8_BAR; PG8_SCHED;
            PG8_LDA(At, 1, 1); PG8_STAGE(PG8_SB(1, 0), b3, voffB); PG8_STAGE(PG8_SB(1, 1), b3 + hstep, voffB); PG8_STAGE(PG8_SA(1, 0), a3, voffA);
            PG8_WAIT_V(8); PG8_WAIT_L(0); PG8_BAR; PG8_MMA(1, 0, At, B0); PG8_MMA(1, 1, At, B1); PG8_BAR; PG8_SCHED;
            } else {
            PG8_LDB(B0, 0, 0); PG8_SCHED; PG8_LDA(At, 0, 0); PG8_STAGE(PG8_SA(1, 1), a1 + hstep, voffA);
            PG8_WAIT_L(8); PG8_BAR; PG8_WAIT_L(0); PG8_MMA(0, 0, At, B0); PG8_BAR; PG8_SCHED;
            PG8_LDB(B1, 0, 1); PG8_STAGE(PG8_SB(0, 0), b2, voffB);
            PG8_BAR; PG8_WAIT_L(0); PG8_MMA(0, 1, At, B1); PG8_BAR;
            PG8_LDA(At, 0, 1); PG8_STAGE(PG8_SA(0, 0), a2, voffA);
            PG8_BAR; PG8_WAIT_L(0); PG8_MMA(1, 0, At, B0); PG8_BAR; PG8_SCHED;
            PG8_STAGE(PG8_SB(0, 1), b2 + hstep, voffB);
            PG8_WAIT_V(6); PG8_BAR; PG8_MMA(1, 1, At, B1); PG8_BAR;
            PG8_LDB(B0, 1, 0); PG8_SCHED; PG8_LDA(At, 1, 0); PG8_STAGE(PG8_SA(0, 1), a2 + hstep, voffA);
            PG8_WAIT_L(8); PG8_BAR; PG8_WAIT_L(0); PG8_MMA(0, 0, At, B0); PG8_BAR; PG8_SCHED;
            PG8_LDB(B1, 1, 1); PG8_STAGE(PG8_SB(1, 0), b3, voffB);
            PG8_BAR; PG8_WAIT_L(0); PG8_MMA(0, 1, At, B1); PG8_BAR;
            PG8_LDA(At, 1, 1); PG8_STAGE(PG8_SA(1, 0), a3, voffA);
            PG8_BAR; PG8_WAIT_L(0); PG8_MMA(1, 0, At, B0); PG8_BAR; PG8_SCHED;
            PG8_STAGE(PG8_SB(1, 1), b3 + hstep, voffB);
            PG8_WAIT_V(6); PG8_BAR; PG8_MMA(1, 1, At, B1); PG8_BAR;
            }
        }
        if constexpr (ALIGN_EPI) { if (wr == 0) PG8_BAR; }
        if constexpr (!Epi::AFTER_DRAIN) { E(acc, cur, wr, wc, fr, fq); S.done(cur); }
        if (!has_next) break;
#pragma unroll
        for (int a = 0; a < 2; ++a)
#pragma unroll
            for (int b = 0; b < 2; ++b)
#pragma unroll
                for (int m = 0; m < 4; ++m)
#pragma unroll
                    for (int n = 0; n < 2; ++n) acc[a][b][m][n] = (f32x4){0.f, 0.f, 0.f, 0.f};
        cur = nxt; cA = nA; cB = nB; ++ui;
        if constexpr (ALIGN_EPI) { if (wr == 1) PG8_BAR; }
    }
    PG8_WAIT_V(0);
    if constexpr (!ALIGN_EPI) { if (wr == 0) PG8_BAR; }
    PG8_BAR;
    if constexpr (Epi::AFTER_DRAIN) { E.fused(acc, cur, wr, wc, fr, fq, lds, wid, lane); S.done(cur); }
#undef PG8_SA
#undef PG8_SB
#undef PG8_STAGE
#undef PG8_LDA
#undef PG8_LDB
#undef PG8_MMA
#undef PG8_WAIT_V
#undef PG8_WAIT_L
#undef PG8_BAR
#undef PG8_SCHED
}
struct Sched1 {
    int G, c;
    __device__ __forceinline__ void init(int G_, int c_) { G = G_; c = c_; }
    __device__ __forceinline__ bool next(int i, Unit& u) const {
        constexpr int nN = 21, nwg = 256 * nN;
        const int L = i * G + c;
        if (L < nwg) { const int wgid = (L % NXCD) * (nwg / NXCD) + L / NXCD; const int nig = WGM * nN, fm = (wgid / nig) * WGM;
            u.pm = fm + ((wgid % nig) % WGM); u.pn = (wgid % nig) / WGM; return true; }
        const int L2 = L - nwg; if (L2 >= 288) return false;
        const int wg = (L2 % NXCD) * 36 + L2 / NXCD; u.pn = wg >> 5; u.pm = 256 + (wg & 31); return true;
    }
    __device__ __forceinline__ void a_ready(const Unit&) const {}
    __device__ __forceinline__ void done(const Unit&) const {}
};
struct Sched2 {
    int G, c;
    __device__ __forceinline__ void init(int G_, int c_) { G = G_; c = c_; }
    __device__ __forceinline__ bool next(int i, Unit& u) const {
        constexpr int nN = 4, nwg = 256 * nN;
        const int L = i * G + c; if (L >= nwg) return false;
        const int wgid = (L % NXCD) * (nwg / NXCD) + L / NXCD; const int nig = WGM * nN, fm = (wgid / nig) * WGM;
        u.pm = fm + ((wgid % nig) % WGM); u.pn = (wgid % nig) / WGM; return true;
    }
    __device__ __forceinline__ void a_ready(const Unit&) const {}
    __device__ __forceinline__ void done(const Unit&) const {}
};
__device__ __forceinline__ float dot4(const f32x4 a) { return (a[0] * a[0] + a[1] * a[1]) + (a[2] * a[2] + a[3] * a[3]); }
__device__ __forceinline__ float silu1(float v) { return v * __builtin_amdgcn_rcpf(1.f + __expf(-v)); }
typedef unsigned u32x2 __attribute__((ext_vector_type(2)));
__device__ __forceinline__ u32x2 pk4(const f32x4 v) { u32x2 w; w.x = cvt_pk_bf16(v[0], v[1]); w.y = cvt_pk_bf16(v[2], v[3]); return w; }
struct Epi1 {
    static constexpr bool PERM = true, AFTER_DRAIN = false, MIDK = false;
    bf16_t *KB, *VB, *XBC, *YQ, *Z; float* DT; const float *rope, *qg, *kg, *dt_bias;
    __device__ __forceinline__ void midk(f32x4 (&)[2][2][4][2], int, int, int) const {}
    __device__ __forceinline__ void operator()(const f32x4 (&acc)[2][2][4][2], const Unit& u, int wr, int wc, int fr_in, int fq_in) const {
        int fr = fr_in, fq = fq_in; asm volatile("" : "+v"(fr), "+v"(fq));
        const int pn = u.pn, pm = u.pm; const bool isctx = pm >= 256; const int rloc = wr * 64 + fr;
        const int bb = isctx ? pm - 256 : pm >> 3, pos0 = isctx ? SEQ : (pm & 7) * 256;
        if (pn == 0 || (pn >= 9 && pn < 13)) {
            const float* g = pn == 0 ? kg : qg;
            const f32x4 g00 = *(const f32x4*)(g + 4 * fq), g01 = *(const f32x4*)(g + 16 + 4 * fq), g10 = *(const f32x4*)(g + 32 + 4 * fq), g11 = *(const f32x4*)(g + 48 + 4 * fq);
            const float osc = pn == 0 ? 1.f : C2;
            bf16_t* dbase; size_t pitch;
            if (pn == 0) { dbase = KB + ((size_t)bb * KVL + pos0) * 256 + wc * 64 + 4 * fq; pitch = 256; }
            else { dbase = YQ + (size_t)pm * 256 * 2048 + 1024 + ((pn - 9) * 4 + wc) * 64 + 4 * fq; pitch = 2048; }
#pragma unroll
            for (int ai = 0; ai < 2; ++ai) {
                const int prow = (pm & 7) * 4 + 2 * ai + wr;
                f32x4 c0 = (f32x4){1.f, 1.f, 1.f, 1.f}, s0 = (f32x4){0.f, 0.f, 0.f, 0.f};
                if (!isctx) { c0 = *(const f32x4*)(rope + prow * 16 + 4 * fq); s0 = *(const f32x4*)(rope + 1024 + prow * 16 + 4 * fq); }
#pragma unroll
                for (int m = 0; m < 4; ++m) {
                    f32x4 a0 = acc[ai][0][m][0], a1 = acc[ai][0][m][1], b0 = acc[ai][1][m][0], b1 = acc[ai][1][m][1];
                    float s = (dot4(a0) + dot4(a1)) + (dot4(b0) + dot4(b1));
                    s += __shfl_xor(s, 16); s += __shfl_xor(s, 32);
                    const float rstd = rsqrtf(s * (1.f / 64.f) + EPS) * osc;
                    a0 = a0 * rstd * g00; a1 = a1 * rstd * g01; b0 = b0 * rstd * g10; b1 = b1 * rstd * g11;
                    f32x4 c1 = (f32x4){1.f, 1.f, 1.f, 1.f}, s1 = (f32x4){0.f, 0.f, 0.f, 0.f};
                    if (!isctx) { const int pcol = 16 * m + fr; c1 = *(const f32x4*)(rope + pcol * 16 + 4 * fq); s1 = *(const f32x4*)(rope + 1024 + pcol * 16 + 4 * fq); }
                    const f32x4 o00 = a0 * c0 - a1 * s0, o01 = a1 * c0 + a0 * s0, o10 = b0 * c1 - b1 * s1, o11 = b1 * c1 + b0 * s1;
                    bf16_t* dst = dbase + (size_t)(rloc + 128 * ai + 16 * m) * pitch;
                    *(u32x2*)(dst) = pk4(o00); *(u32x2*)(dst + 16) = pk4(o01); *(u32x2*)(dst + 32) = pk4(o10); *(u32x2*)(dst + 48) = pk4(o11);
                    asm volatile("" ::: "memory");
                }
            }
        } else if (pn == 8) {
            if (wc == 0) {
                const f32x4 bA = *(const f32x4*)(dt_bias + 8 * fq), bB = *(const f32x4*)(dt_bias + 8 * fq + 4);
#pragma unroll
                for (int ai = 0; ai < 2; ++ai)
#pragma unroll
                    for (int m = 0; m < 4; ++m) { const size_t row = (size_t)pm * 256 + rloc + 128 * ai + 16 * m;
                        f32x4 v0 = acc[ai][0][m][0] + bA, v1 = acc[ai][0][m][1] + bB;
#pragma unroll
                        for (int e = 0; e < 4; ++e) { v0[e] = v0[e] > 20.f ? v0[e] : log1pf(__expf(v0[e])); v1[e] = v1[e] > 20.f ? v1[e] : log1pf(__expf(v1[e])); }
                        *(f32x4*)(DT + row * 32 + 8 * fq) = v0; *(f32x4*)(DT + row * 32 + 8 * fq + 4) = v1; asm volatile("" ::: "memory"); }
            }
        } else {
            bf16_t* dbase; size_t pitch; bool act = false;
            const int cin = wc * 32 + 8 * fq;
            if (pn == 1) { dbase = VB + ((size_t)bb * KVL + pos0) * 256 + cin; pitch = 256; }
            else if (pn < 8) { dbase = XBC + (size_t)pm * 256 * CONVC + (pn - 2) * 256 + cin; pitch = CONVC; }
            else if (pn < 17) { dbase = YQ + (size_t)pm * 256 * 2048 + (pn - 13) * 256 + cin; pitch = 2048; act = true; }
            else { dbase = Z + (size_t)pm * 256 * 1024 + (pn - 17) * 256 + cin; pitch = 1024; act = true; }
#pragma unroll
            for (int ai = 0; ai < 2; ++ai)
#pragma unroll
                for (int m = 0; m < 4; ++m) { bf16_t* dst = dbase + (size_t)(rloc + 128 * ai + 16 * m) * pitch;
#pragma unroll
                    for (int bj = 0; bj < 2; ++bj) { f32x4 v0 = acc[ai][bj][m][0], v1 = acc[ai][bj][m][1];
                        if (act) {
#pragma unroll
                            for (int e = 0; e < 4; ++e) { v0[e] = silu1(v0[e]); v1[e] = silu1(v1[e]); } }
                        u32x4 w; w.x = cvt_pk_bf16(v0[0], v0[1]); w.y = cvt_pk_bf16(v0[2], v0[3]); w.z = cvt_pk_bf16(v1[0], v1[1]); w.w = cvt_pk_bf16(v1[2], v1[3]);
                        *(u32x4*)(dst + bj * HALF) = w; } asm volatile("" ::: "memory"); }
        }
    }
};
struct Epi2 {
    static constexpr bool PERM = false, AFTER_DRAIN = false, MIDK = true;
    const float* x; const float* mod; const float* fg; float* out; unsigned long long* xbuf; unsigned* cnt; unsigned* tmo; const PG8_LAS float* rstd_tab; PG8_LAS float* exl;
    __device__ __forceinline__ void midk(f32x4 (&acc)[2][2][4][2], int ui, int wr, int fr) const {
#pragma unroll
        for (int ai = 0; ai < 2; ++ai)
#pragma unroll
            for (int m = 0; m < 4; ++m) { const float r = rstd_tab[ui * 256 + 128 * ai + 64 * wr + 16 * m + fr];
#pragma unroll
                for (int bj = 0; bj < 2; ++bj)
#pragma unroll
                    for (int n = 0; n < 2; ++n) acc[ai][bj][m][n] *= r; }
    }
    __device__ __forceinline__ void operator()(f32x4 (&acc)[2][2][4][2], const Unit& u, int wr, int wc, int fr_in, int fq_in) const {
        int fr = fr_in, fq = fq_in; asm volatile("" : "+v"(fr), "+v"(fq));
        const int lane = mk_lane(); const int tid = (wr * 4 + wc) * 64 + lane;
        const int b = u.pm >> 3, col0 = u.pn * BM + wc * 32 + 4 * fq;
        PG8_LAS float* P = exl; PG8_LAS float* S = exl + 1024;
        { f32x4 gv[2][2];
#pragma unroll
          for (int bj = 0; bj < 2; ++bj)
#pragma unroll
            for (int n = 0; n < 2; ++n) gv[bj][n] = *(const f32x4*)(mod + (size_t)b * 3072 + 2048 + col0 + bj * HALF + n * 16);
#pragma unroll
          for (int ai = 0; ai < 2; ++ai)
#pragma unroll
            for (int m = 0; m < 4; ++m) { const int rt = 128 * ai + 64 * wr + 16 * m + fr; const size_t off = ((size_t)u.pm * BM + rt) * 1024 + col0; float q = 0.f;
#pragma unroll
                for (int bj = 0; bj < 2; ++bj)
#pragma unroll
                    for (int n = 0; n < 2; ++n) { const f32x4 xv = *(const f32x4*)(x + off + bj * HALF + n * 16); const f32x4 o = xv + gv[bj][n] * acc[ai][bj][m][n]; acc[ai][bj][m][n] = o; q += dot4(o); }
                q += __shfl_xor(q, 16); q += __shfl_xor(q, 32);
                if (fq == 0) P[rt * 4 + wc] = q;
                if (m & 1) asm volatile("" ::: "memory"); } }
        asm volatile("s_waitcnt lgkmcnt(0)" ::: "memory"); __builtin_amdgcn_s_barrier(); asm volatile("" ::: "memory");
        if (tid < 256) {
            const f32x4 p = *(const PG8_LAS f32x4*)(P + tid * 4); const float s = (p[0] + p[1]) + (p[2] + p[3]);
            __hip_atomic_store((float*)xbuf + ((size_t)u.pm * BM + tid) * 4 + u.pn, s, __ATOMIC_RELAXED, __HIP_MEMORY_SCOPE_AGENT);
        }
        asm volatile("s_waitcnt vmcnt(0)" ::: "memory");
        if (tid < 256 && lane == 0) __hip_atomic_fetch_add(cnt + 64 * u.pm, 1u, __ATOMIC_RELAXED, __HIP_MEMORY_SCOPE_AGENT);
        if (tid < 64) {
            unsigned sp = 0;
            while ((unsigned)__builtin_amdgcn_readfirstlane(__hip_atomic_load(cnt + 64 * u.pm, __ATOMIC_RELAXED, __HIP_MEMORY_SCOPE_AGENT)) < 16u) {
                __builtin_amdgcn_s_sleep(2); if (++sp > (1u << 22)) { if (lane == 0) __hip_atomic_store(tmo, 1u, __ATOMIC_RELAXED, __HIP_MEMORY_SCOPE_AGENT); break; } }
        }
        asm volatile("s_waitcnt vmcnt(0) lgkmcnt(0)" ::: "memory"); __builtin_amdgcn_s_barrier(); asm volatile("" ::: "memory");
        if (tid < 256) {
            const unsigned long long* sl = xbuf + ((size_t)u.pm * BM + tid) * 2;
            const unsigned long long w0 = __hip_atomic_load(sl, __ATOMIC_RELAXED, __HIP_MEMORY_SCOPE_AGENT), w1 = __hip_atomic_load(sl + 1, __ATOMIC_RELAXED, __HIP_MEMORY_SCOPE_AGENT);
            const float s = (__uint_as_float((unsigned)w0) + __uint_as_float((unsigned)(w0 >> 32))) + (__uint_as_float((unsigned)w1) + __uint_as_float((unsigned)(w1 >> 32)));
            S[tid] = rsqrtf(s * (1.f / 1024.f) + EPS);
        }
        asm volatile("s_waitcnt lgkmcnt(0)" ::: "memory"); __builtin_amdgcn_s_barrier(); asm volatile("" ::: "memory");
        { f32x4 fv[2][2];
#pragma unroll
          for (int bj = 0; bj < 2; ++bj)
#pragma unroll
            for (int n = 0; n < 2; ++n) fv[bj][n] = *(const f32x4*)(fg + col0 + bj * HALF + n * 16);
#pragma unroll
          for (int ai = 0; ai < 2; ++ai)
#pragma unroll
            for (int m = 0; m < 4; ++m) { const int rt = 128 * ai + 64 * wr + 16 * m + fr; const size_t off = ((size_t)u.pm * BM + rt) * 1024 + col0; const float r = S[rt];
#pragma unroll
                for (int bj = 0; bj < 2; ++bj)
#pragma unroll
                    for (int n = 0; n < 2; ++n) *(f32x4*)(out + off + bj * HALF + n * 16) = acc[ai][bj][m][n] * r * fv[bj][n];
                if (m & 1) asm volatile("" ::: "memory"); } }
    }
};
}
#define GAS __attribute__((address_space(1)))
#define LAS __attribute__((address_space(3)))
typedef unsigned v4u __attribute__((ext_vector_type(4)));
typedef GAS unsigned gu32;
typedef GAS unsigned long long gu64;
#define RLX_AGENT __ATOMIC_RELAXED, __HIP_MEMORY_SCOPE_AGENT
#define LDS_WAIT() asm volatile("s_waitcnt lgkmcnt(0)" ::: "memory")
#define VM_WAIT() asm volatile("s_waitcnt vmcnt(0)" ::: "memory")
__device__ __forceinline__ unsigned long long rt() { return __builtin_amdgcn_s_memrealtime(); }
typedef float f32x2_pk __attribute__((ext_vector_type(2))); typedef __bf16 bf16x2_pk __attribute__((ext_vector_type(2)));
__device__ __forceinline__ unsigned pk2(float lo, float hi) { const f32x2_pk v = {lo, hi}; return __builtin_bit_cast(unsigned, __builtin_convertvector(v, bf16x2_pk)); }
#define XB_TMO      128
#define XB_XCNT(j)  (256  + 64 * (j))
#define XB_XSUB(j)  (1280 + 64 * (j))
#define XB_XGEN(j)  (2304 + 64 * (j))
#define XB_TOP      3328
#define XB_TOPGEN   3392
#define XCD_BAR_WORDS 3456
#define XB_SPIN_CAP (1u << 22)

__device__ __forceinline__ unsigned xb_ld(unsigned* p)              { return __hip_atomic_load(p, __ATOMIC_RELAXED, __HIP_MEMORY_SCOPE_AGENT); }
__device__ __forceinline__ unsigned xb_add(unsigned* p, unsigned v) { return __hip_atomic_fetch_add(p, v, __ATOMIC_RELAXED, __HIP_MEMORY_SCOPE_AGENT); }
__device__ __forceinline__ unsigned xb_xcc_id() { return (unsigned)__builtin_amdgcn_s_getreg((3 << 11) | 20) & 0xFu; }
#define XB_SPIN(cond, bar) do { unsigned _sp = 0; while (cond) { __builtin_amdgcn_s_sleep(1); \
    if ((++_sp & 255u) == 0u) { if (xb_ld(&(bar)[XB_TMO])) break; if (_sp > XB_SPIN_CAP) { atomicAdd(&(bar)[XB_TMO], 1u); break; } } } } while (0)

struct XcdBarrier {
    unsigned* bar; unsigned x;
    volatile LAS unsigned* st;
};

__device__ __forceinline__ XcdBarrier xcd_barrier_post(unsigned* bar, volatile LAS unsigned* st, bool leader) {
    XcdBarrier b; b.bar = bar; b.x = xb_xcc_id(); b.st = st;
    if (leader) (void)xb_add(&bar[XB_XCNT(b.x)], 1u);
    return b;
}
__device__ __forceinline__ void xcd_barrier_complete(unsigned* bar, unsigned x, unsigned& nloc, unsigned& nx) {
    const unsigned G = gridDim.x * gridDim.y * gridDim.z;
    unsigned sum, cnt, mine, sp = 0u;
    for (;;) {
        sum = 0u; cnt = 0u; mine = 0u;
#pragma unroll
        for (unsigned j = 0; j < 16; ++j) { const unsigned c = xb_ld(&bar[XB_XCNT(j)]); sum += c; cnt += (c > 0u) ? 1u : 0u; mine = (j == x) ? c : mine; }
        if (sum == G) break;
        __builtin_amdgcn_s_sleep(1);
        if ((++sp & 255u) == 0u) { if (xb_ld(&bar[XB_TMO])) break; if (sp > XB_SPIN_CAP) { atomicAdd(&bar[XB_TMO], 1u); break; } }
    }
    nloc = mine > 0u ? mine : 1u; nx = cnt > 0u ? cnt : 1u;
}

__device__ __forceinline__ void xcd_barrier(const XcdBarrier& b, bool leader) {
    asm volatile("s_waitcnt vmcnt(0)" ::: "memory");
    __syncthreads();
    if (leader) {
        unsigned* bar = b.bar;
        __builtin_amdgcn_s_waitcnt(0);
        unsigned nloc = b.st[0], nx = b.st[1];
        if (nloc == 0u) { xcd_barrier_complete(bar, b.x, nloc, nx); b.st[0] = nloc; b.st[1] = nx; }
        const unsigned old = xb_add(&bar[XB_XSUB(b.x)], 1u);
        const unsigned gen = old / nloc;
        if (old + 1u == (gen + 1u) * nloc) {
            __builtin_amdgcn_fence(__ATOMIC_RELEASE, "agent");
            asm volatile("s_waitcnt vmcnt(0)" ::: "memory");
            const unsigned og = xb_add(&bar[XB_TOP], 1u);
            const unsigned tg = og / nx;
            if (og + 1u == (tg + 1u) * nx) xb_add(&bar[XB_TOPGEN], 1u);
            else XB_SPIN(xb_ld(&bar[XB_TOPGEN]) == tg, bar);
            __builtin_amdgcn_fence(__ATOMIC_ACQUIRE, "agent");
            xb_add(&bar[XB_XGEN(b.x)], 1u);
            asm volatile("s_waitcnt vmcnt(0)" ::: "memory");
        } else {
            XB_SPIN(xb_ld(&bar[XB_XGEN(b.x)]) == gen, bar);
            __builtin_amdgcn_fence(__ATOMIC_ACQUIRE, "agent");
            asm volatile("s_waitcnt vmcnt(0)" ::: "memory");
        }
    }
    __syncthreads();
}

typedef float f32x4 __attribute__((ext_vector_type(4)));
constexpr int NWAVES = 8;
__device__ __forceinline__ float wave_sum(float v) {
#pragma unroll
    for (int o = 1; o < 64; o <<= 1) v += __shfl_xor(v, o);
    return v;
}
__device__ __forceinline__ float dot4g(const f32x4 a) { return (a[0] * a[0] + a[1] * a[1]) + (a[2] * a[2] + a[3] * a[3]); }
__device__ __forceinline__ void p0_bt1_item(const float* W, bf16* WT, LAS float* scr, int item, int lane) {
    const int kb = item / 168, vb = item % 168, k0 = 64 * kb, v0 = 32 * vb;
    const int a = vcol_actual(v0 + (lane & 31));
#pragma unroll 8
    for (int i = 0; i < 32; ++i) { const int kk = 2 * i + (lane >> 5); scr[kk * 33 + (lane & 31)] = a >= 0 ? W[(size_t)(k0 + kk) * PROJ + a] : 0.f; }
    LDS_WAIT(); asm volatile("" ::: "memory");
    const int c = lane & 7;
#pragma unroll
    for (int j = 0; j < 4; ++j) { const int n = (lane >> 3) + 8 * j; const LAS float* s = scr + (8 * c) * 33 + n;
        v4u o; o.x = pk2(s[0 * 33], s[1 * 33]); o.y = pk2(s[2 * 33], s[3 * 33]); o.z = pk2(s[4 * 33], s[5 * 33]); o.w = pk2(s[6 * 33], s[7 * 33]);
        *(GAS v4u*)(WT + (size_t)(v0 + n) * 1024 + k0 + 8 * c) = o; }
    LDS_WAIT(); asm volatile("" ::: "memory");
}
__device__ __forceinline__ void p0_bt2_item(const float* W, const float* sg, bf16* WT, LAS float* scr, int item, int lane) {
    const int kb = item >> 5, nb = item & 31, kk0 = 64 * kb, n0 = 32 * nb;
#pragma unroll 8
    for (int i = 0; i < 32; ++i) { const int kk = 2 * i + (lane >> 5), kq = kk0 + kk; const int ks = kq < 1024 ? 1024 + kq : kq - 1024;
        float v = W[(size_t)ks * 1024 + n0 + (lane & 31)]; if (kq < 1024) v *= sg[kq]; scr[kk * 33 + (lane & 31)] = v; }
    LDS_WAIT(); asm volatile("" ::: "memory");
    const int c = lane & 7;
#pragma unroll
    for (int j = 0; j < 4; ++j) { const int n = (lane >> 3) + 8 * j; const LAS float* s = scr + (8 * c) * 33 + n;
        v4u o; o.x = pk2(s[0 * 33], s[1 * 33]); o.y = pk2(s[2 * 33], s[3 * 33]); o.z = pk2(s[4 * 33], s[5 * 33]); o.w = pk2(s[6 * 33], s[7 * 33]);
        *(GAS v4u*)(WT + (size_t)(n0 + n) * 2048 + kk0 + 8 * c) = o; }
    LDS_WAIT(); asm volatile("" ::: "memory");
}
__device__ __forceinline__ void p0_mod_block(const float* c, const float* c_ctx, const float* ada_w, const float* ada_b, float* mod, LAS float* ldsf, int cb, int tid, int lane, int wave) {
    LAS float* sil = ldsf; LAS float* red = ldsf + 33 * 256;
    float acc[33];
#pragma unroll
    for (int b = 0; b < 33; ++b) acc[b] = 0.f;
    for (int q = 0; q < 4; ++q) {
        __syncthreads();
        for (int e = tid; e < 33 * 256; e += NWAVES * 64) { const int b = e >> 8, k = e & 255; const float v = b < 32 ? c[b * 1024 + q * 256 + k] : c_ctx[q * 256 + k]; sil[e] = siluf(v); }
        __syncthreads();
#pragma unroll 8
        for (int kk = 0; kk < 32; ++kk) { const int kl = wave * 32 + kk; const float w = ada_w[(size_t)(q * 256 + kl) * 3072 + cb * 64 + lane];
#pragma unroll
            for (int b = 0; b < 33; ++b) acc[b] += sil[b * 256 + kl] * w; }
    }
#pragma unroll
    for (int b = 0; b < 33; ++b) red[(wave * 33 + b) * 64 + lane] = acc[b];
    __syncthreads();
    for (int e = tid; e < 33 * 64; e += NWAVES * 64) { const int b = e >> 6, col = e & 63; float s = 0.f;
#pragma unroll
        for (int w = 0; w < 8; ++w) s += red[(w * 33 + b) * 64 + col];
        mod[b * 3072 + cb * 64 + col] = s + ada_b[cb * 64 + col]; }
    __syncthreads();
}
__device__ __forceinline__ const float* p1_src(const float* x, const float* ctx, int m) { return m < ML ? x + (size_t)m * DM : ctx + (size_t)(m - ML) * DM; }
__device__ __forceinline__ void p1_load4(f32x4 (&v)[4][4], const float* x, const float* ctx, int m0, int lane) {
#pragma unroll
    for (int r = 0; r < 4; ++r) { const GAS f32x4* xr = (const GAS f32x4*)p1_src(x, ctx, m0 + r) + lane;
#pragma unroll
        for (int j = 0; j < 4; ++j) v[r][j] = xr[64 * j]; }
}
__device__ __forceinline__ void p1_proc4(const f32x4 (&v)[4][4], const float* mod, const float* ng, bf16* H, int m0, int lane) {
#pragma unroll
    for (int r = 0; r < 4; ++r) { const int m = m0 + r; const float* md = mod + (size_t)(m < ML ? m / SEQ : 32) * 3072;
        float s = 0.f;
#pragma unroll
        for (int j = 0; j < 4; ++j) s += dot4g(v[r][j]);
        const float rstd = rsqrtf(wave_sum(s) * (1.f / DM) + EPS);
        GAS unsigned long long* o8 = (GAS unsigned long long*)(H + (size_t)m * DM) + lane;
#pragma unroll
        for (int j = 0; j < 4; ++j) { const int k = 4 * lane + 256 * j;
            const f32x4 g = *(const f32x4*)(ng + k), sc = *(const f32x4*)(md + 1024 + k), sh = *(const f32x4*)(md + k);
            const f32x4 h = v[r][j] * rstd * g * (sc + 1.f) + sh;
            o8[64 * j] = (unsigned long long)pk2(h[0], h[1]) | ((unsigned long long)pk2(h[2], h[3]) << 32); }
    }
}
__device__ __forceinline__ void conv_phase(const bf16* XBC, const float* cw, const float* cb, bf16* XC, int bx, int G, int tid) {
    if (tid < 384) {
        const int cg = tid % 192, sub = tid / 192;
        f32x4 w[5][2], bias[2];
#pragma unroll
        for (int j = 0; j < 5; ++j) { w[j][0] = *(const f32x4*)(cw + j * CONVC + cg * 8); w[j][1] = *(const f32x4*)(cw + j * CONVC + cg * 8 + 4); }
        bias[0] = *(const f32x4*)(cb + cg * 8); bias[1] = *(const f32x4*)(cb + cg * 8 + 4);
        for (int seg = bx; seg < MT / 32; seg += G) {
            const int row0 = seg * 32 + sub * 16; int t0, len;
            if (row0 < ML) { t0 = row0 % SEQ; len = SEQ; } else { t0 = (row0 - ML) % CTXL; len = CTXL; }
            const bf16* src = XBC + (size_t)row0 * CONVC + cg * 8; bf16* dst = XC + (size_t)row0 * CONVC + cg * 8;
            f32x4 r[5][2];
#pragma unroll
            for (int j = 0; j < 5; ++j) { const int tt = t0 + j - 2; v4u u = (v4u){0u, 0u, 0u, 0u};
                if (tt >= 0 && tt < len) u = *(const v4u*)(src + (ptrdiff_t)(j - 2) * CONVC);
                r[j][0] = (f32x4){__uint_as_float(u.x << 16), __uint_as_float(u.x & 0xffff0000u), __uint_as_float(u.y << 16), __uint_as_float(u.y & 0xffff0000u)};
                r[j][1] = (f32x4){__uint_as_float(u.z << 16), __uint_as_float(u.z & 0xffff0000u), __uint_as_float(u.w << 16), __uint_as_float(u.w & 0xffff0000u)}; }
#pragma unroll
            for (int i = 0; i < 16; ++i) {
                f32x4 a0 = bias[0], a1 = bias[1];
#pragma unroll
                for (int j = 0; j < 5; ++j) { a0 += w[j][0] * r[j][0]; a1 += w[j][1] * r[j][1]; }
#pragma unroll
                for (int e = 0; e < 4; ++e) { a0[e] = siluf(a0[e]); a1[e] = siluf(a1[e]); }
                v4u o; o.x = pk2(a0[0], a0[1]); o.y = pk2(a0[2], a0[3]); o.z = pk2(a1[0], a1[1]); o.w = pk2(a1[2], a1[3]);
                *(v4u*)(dst + (size_t)i * CONVC) = o;
#pragma unroll
                for (int j = 0; j < 4; ++j) { r[j][0] = r[j + 1][0]; r[j][1] = r[j + 1][1]; }
                const int tt = t0 + i + 3; v4u u = (v4u){0u, 0u, 0u, 0u};
                if (i < 15 && tt < len) u = *(const v4u*)(src + (size_t)(i + 3) * CONVC);
                r[4][0] = (f32x4){__uint_as_float(u.x << 16), __uint_as_float(u.x & 0xffff0000u), __uint_as_float(u.y << 16), __uint_as_float(u.y & 0xffff0000u)};
                r[4][1] = (f32x4){__uint_as_float(u.z << 16), __uint_as_float(u.z & 0xffff0000u), __uint_as_float(u.w << 16), __uint_as_float(u.w & 0xffff0000u)};
            }
        }
    }
}
__device__ __forceinline__ void ssd_item_naive(int b, int h, const bf16* XC, const float* DT, const bf16* Z, const float* a_log, const float* d_skip, bf16* YQ, float* SSQ, LAS float* ysq, int tid) {
    const int p = tid >> 3, nc = tid & 7, g = h >> 3;
    for (int dd = 0; dd < 2; ++dd) { const int d = 1 - dd;
        const float a_neg = -expf(a_log[d * 16 + h]);
        float S[16];
#pragma unroll
        for (int j = 0; j < 16; ++j) S[j] = 0.f;
        for (int seq = 0; seq < 2; ++seq) { const int len = seq == 0 ? CTXL : SEQ; const size_t rbase = seq == 0 ? (size_t)ML + (size_t)b * CTXL : (size_t)b * SEQ;
            for (int st = 0; st < len; ++st) { const int t = d ? len - 1 - st : st; const size_t row = rbase + t;
                const float dt = DT[row * 32 + d * 16 + h]; const float dec = expf(dt * a_neg);
                const float xs = bf2f(XC[row * CONVC + h * 64 + p]); const float X = xs * dt;
                const v4u b0 = *(const v4u*)(XC + row * CONVC + 1024 + g * 128 + nc * 16), b1 = *(const v4u*)(XC + row * CONVC + 1024 + g * 128 + nc * 16 + 8);
                const v4u c0 = *(const v4u*)(XC + row * CONVC + 1280 + g * 128 + nc * 16), c1 = *(const v4u*)(XC + row * CONVC + 1280 + g * 128 + nc * 16 + 8);
                const unsigned bw[8] = {b0.x, b0.y, b0.z, b0.w, b1.x, b1.y, b1.z, b1.w}, cw8[8] = {c0.x, c0.y, c0.z, c0.w, c1.x, c1.y, c1.z, c1.w};
                float y = 0.f;
#pragma unroll
                for (int j = 0; j < 8; ++j) { S[2 * j] = S[2 * j] * dec + X * __uint_as_float(bw[j] << 16); y += __uint_as_float(cw8[j] << 16) * S[2 * j];
                    S[2 * j + 1] = S[2 * j + 1] * dec + X * __uint_as_float(bw[j] & 0xffff0000u); y += __uint_as_float(cw8[j] & 0xffff0000u) * S[2 * j + 1]; }
                y += __shfl_xor(y, 1); y += __shfl_xor(y, 2); y += __shfl_xor(y, 4);
                if (seq == 1) {
                    bf16* yp = YQ + row * 2048 + h * 64 + p;
                    if (d == 1) { if (nc == 0) *yp = (bf16)f2bf(y); }
                    else {
                        if (nc == 0) { const float yt = y + bf2f(*yp) + d_skip[h] * xs; const float yg = yt * bf2f(Z[row * 1024 + h * 64 + p]); *yp = (bf16)f2bf(yg); ysq[p] = yg * yg; }
                        __syncthreads();
                        if (tid < 64) { float q = ysq[tid]; q = wave_sum(q); if (tid == 0) SSQ[row * 16 + h] = q; }
                        __syncthreads();
                    }
                }
            }
        }
        VM_WAIT(); __syncthreads();
    }
}

namespace attn_body {
using bf16=__hip_bfloat16;
using bf16x8=__attribute__((ext_vector_type(8)))short;
using s16x4=__attribute__((ext_vector_type(4)))short;
using f32x16=__attribute__((ext_vector_type(16)))float;
using u32x4=__attribute__((ext_vector_type(4)))unsigned;
constexpr int D=64,QP=2048,KP=256;
constexpr int NW=8,QBLK=32,QB=QBLK*NW,KVBLK=64,NQB=SEQ/QB;
constexpr int ATTN_UNIT_ROWS=QB;
__device__ __forceinline__ int crow(int r,int hi){return (r&3)+8*(r>>2)+4*hi;}
#define SBAR() __builtin_amdgcn_sched_barrier(0)
__device__ __forceinline__ void cmask(f32x16&p0,f32x16&p1,int jb,int qrel,int hi){
  const float NEG=-INFINITY; int kb=64*jb+4*hi;
  #pragma unroll
  for(int r=0;r<16;++r){int kv=kb+(r&3)+8*(r>>2); if(kv>qrel)p0[r]=NEG; if(kv+32>qrel)p1[r]=NEG;}
}

constexpr int NSLOT=3, SLOTB=8192;
constexpr int LDS_K=0, LDS_V=NSLOT*SLOTB, LDS_WS=2*NSLOT*SLOTB, LDS_OST=LDS_WS+NW*64*4, LDS_BYTES=LDS_OST+NW*8192;
constexpr float C2=0.125f*1.4426950408889634f;
__device__ __forceinline__ void glds16(const void*gsrc,unsigned lds_dst){unsigned keep;
  asm volatile("s_mov_b32 %0, m0\n\ts_mov_b32 m0, %2\n\ts_nop 0\n\tglobal_load_lds_dwordx4 %1, off\n\ts_mov_b32 m0, %0":"=&s"(keep):"v"(gsrc),"s"(lds_dst):"memory");}
__device__ __forceinline__ float max3f(float a,float b,float c){float r;asm("v_max3_f32 %0, %1, %2, %3":"=v"(r):"v"(a),"v"(b),"v"(c));return r;}
__device__ __forceinline__ float max2f(float a,float b){float r;asm("v_max_f32_e32 %0, %1, %2":"=v"(r):"v"(a),"v"(b));return r;}
__device__ __forceinline__ float fadd_s(float a,float b){float r;asm("v_add_f32_e32 %0, %1, %2":"=v"(r):"v"(a),"v"(b));return r;}
__device__ __forceinline__ float fsub_s(float a,float b){float r;asm("v_sub_f32_e32 %0, %1, %2":"=v"(r):"v"(a),"v"(b));return r;}
typedef float f32x2_t __attribute__((ext_vector_type(2))); typedef float f32x4_t __attribute__((ext_vector_type(4))); typedef __bf16 bf16x2_t __attribute__((ext_vector_type(2)));
__device__ __forceinline__ unsigned cvtpk_s(float lo,float hi){f32x2_t v={lo,hi};bf16x2_t b=__builtin_convertvector(v,bf16x2_t);return __builtin_bit_cast(unsigned,b);}
#define WAIT_BAR(N) asm volatile("s_waitcnt vmcnt(" #N ") lgkmcnt(0)\n\ts_barrier":::"memory")

__device__ __forceinline__ void qkt(f32x16&p0,f32x16&p1,const char*Kslot,const bf16x8*qr,const f32x16&negm,int r32,int hi){
  const char*kb=Kslot+hi*1024+r32*16;
  #pragma unroll
  for(int d0=0;d0<4;++d0){
    const bf16x8 b0=*reinterpret_cast<const bf16x8*>(kb+d0*2048);
    const bf16x8 b1=*reinterpret_cast<const bf16x8*>(kb+d0*2048+512);
    if(d0==0){p0=__builtin_amdgcn_mfma_f32_32x32x16_bf16(b0,qr[0],negm,0,0,0);p1=__builtin_amdgcn_mfma_f32_32x32x16_bf16(b1,qr[0],negm,0,0,0);}
    else{p0=__builtin_amdgcn_mfma_f32_32x32x16_bf16(b0,qr[d0],p0,0,0,0);p1=__builtin_amdgcn_mfma_f32_32x32x16_bf16(b1,qr[d0],p1,0,0,0);}}
}
typedef __attribute__((address_space(3))) const char* lds_cptr;
typedef short v4i16_t __attribute__((ext_vector_type(4)));
__device__ __forceinline__ void kload8(bf16x8*kf,lds_cptr kp){
  kf[0]=*(const __attribute__((address_space(3))) bf16x8*)(kp);      kf[1]=*(const __attribute__((address_space(3))) bf16x8*)(kp+512);
  kf[2]=*(const __attribute__((address_space(3))) bf16x8*)(kp+2048); kf[3]=*(const __attribute__((address_space(3))) bf16x8*)(kp+2560);
  kf[4]=*(const __attribute__((address_space(3))) bf16x8*)(kp+4096); kf[5]=*(const __attribute__((address_space(3))) bf16x8*)(kp+4608);
  kf[6]=*(const __attribute__((address_space(3))) bf16x8*)(kp+6144); kf[7]=*(const __attribute__((address_space(3))) bf16x8*)(kp+6656);
}
__device__ __forceinline__ void kload2(bf16x8*kf,lds_cptr kp,int j){ kf[2*j]=*(const __attribute__((address_space(3))) bf16x8*)(kp+j*2048); kf[2*j+1]=*(const __attribute__((address_space(3))) bf16x8*)(kp+j*2048+512); }
__device__ __forceinline__ s16x4 vtr(lds_cptr p){ return __builtin_bit_cast(s16x4,__builtin_amdgcn_ds_read_tr16_b64_v4i16((__attribute__((address_space(3))) v4i16_t*)p)); }
__device__ __forceinline__ float rowmax(const f32x16&p0,const f32x16&p1){
  float a=max3f(p0[0],p0[1],p1[0]),b=max3f(p0[2],p0[3],p1[1]);a=max3f(a,p1[2],p1[3]);
  #pragma unroll
  for(int r=4;r<16;r+=4){a=max3f(a,p0[r],p0[r+1]);b=max3f(b,p0[r+2],p0[r+3]);a=max3f(a,p1[r],p1[r+1]);b=max3f(b,p1[r+2],p1[r+3]);}
  const float m=max2f(a,b);
  auto rr=__builtin_amdgcn_permlane32_swap(__float_as_uint(m),__float_as_uint(m),false,false);
  return max2f(__uint_as_float(rr[0]),__uint_as_float(rr[1]));
}
__device__ __forceinline__ void pv(f32x16*o,int vb,bf16x8 pa0,bf16x8 pa1,bf16x8 pa2,bf16x8 pa3){
  #pragma unroll
  for(int d0=0;d0<2;++d0){s16x4 lo[4],hi[4];
    #pragma unroll
    for(int ks=0;ks<4;++ks){
      asm volatile("ds_read_b64_tr_b16 %0,%1 offset:%c2":"=&v"(lo[ks]):"v"(vb),"i"(d0*4096+ks*1024):"memory");
      asm volatile("ds_read_b64_tr_b16 %0,%1 offset:%c2":"=&v"(hi[ks]):"v"(vb),"i"(d0*4096+ks*1024+512):"memory");}
    asm volatile("s_waitcnt lgkmcnt(0)":::"memory");SBAR();
    #define PK(k) (bf16x8){lo[k][0],lo[k][1],lo[k][2],lo[k][3],hi[k][0],hi[k][1],hi[k][2],hi[k][3]}
    o[d0]=__builtin_amdgcn_mfma_f32_32x32x16_bf16(pa0,PK(0),o[d0],0,0,0);
    o[d0]=__builtin_amdgcn_mfma_f32_32x32x16_bf16(pa1,PK(1),o[d0],0,0,0);
    o[d0]=__builtin_amdgcn_mfma_f32_32x32x16_bf16(pa2,PK(2),o[d0],0,0,0);
    o[d0]=__builtin_amdgcn_mfma_f32_32x32x16_bf16(pa3,PK(3),o[d0],0,0,0);
    #undef PK
  }
}

#ifndef ATTN_STORE16
#define ATTN_STORE16(p,v) (*(u32x4*)(p)=(v))
#endif
template<int THRL> __device__ __forceinline__ void attn_unit(int b,int h,int qb,bf16*YQb,const bf16*__restrict__ K,const bf16*__restrict__ V,char*shm,int wid_in,float sbound,bf16*dummyO=nullptr){
  const int wid=wid_in; int lane=mk_lane(); asm volatile("":"+v"(lane)); const int tid=wid*64+lane,r32=lane&31,hi=lane>>5; (void)tid;
  const long rowbase=(long)b*SEQ; const int q0=qb*QB;
  const bf16*Qw=YQb+(rowbase+q0+wid*QBLK)*QP+1024+h*D;
  const bf16*Kh=K+(long)b*KVL*KP+(h>>2)*D,*Vh=V+(long)b*KVL*KP+(h>>2)*D;
  const unsigned lds0=(unsigned)(uintptr_t)shm;
  float*wsf=(float*)(shm+LDS_WS)+wid*64;
  const bf16*ksrc=Kh+(long)lane*KP+wid*8;
  const bf16*vsrc=Vh+(long)(16*(wid&3)+(lane>>2))*KP+(wid>>2)*32+(lane&3)*8;
  const unsigned kdst=lds0+LDS_K+wid*1024, vdst=lds0+LDS_V+wid*1024;
  #define DMA_K(t,slot) glds16(ksrc+(long)(t)*KVBLK*KP,(unsigned)__builtin_amdgcn_readfirstlane(kdst+(slot)))
  #define DMA_V(t,slot) glds16(vsrc+(long)(t)*KVBLK*KP,(unsigned)__builtin_amdgcn_readfirstlane(vdst+(slot)))
  const int vb0=(int)(lds0+LDS_V)+((lane>>4)&1)*32+(lane&3)*8+(4*hi+((lane&15)>>2))*64;
  const char*Kbase=shm+LDS_K; bf16x8 kf[8];
  const lds_cptr shm3=(lds_cptr)shm; const lds_cptr kp0=shm3+LDS_K+hi*1024+r32*16; const lds_cptr vp0=shm3+LDS_V+((lane>>4)&1)*32+(lane&3)*8+(4*hi+((lane&15)>>2))*64;
  constexpr int NT=KVL/KVBLK;
  DMA_K(0,0);DMA_V(0,0);DMA_K(1,SLOTB);
  bf16x8 qr[4];
  #pragma unroll
  for(int d0=0;d0<4;++d0)qr[d0]=*reinterpret_cast<const bf16x8*>(&Qw[(long)r32*QP+d0*16+hi*8]);
  float l_reg=0.f;f32x16 o[2];o[0]=f32x16{};o[1]=f32x16{};f32x16 negm;
  #pragma unroll
  for(int r=0;r<16;++r)negm[r]=-sbound;
  asm volatile("":"+v"(negm));
  #define CMASK(P0,P1,t) do{}while(0)
  #define START(P0,P1) do{ _Pragma("unroll") for(int r=0;r<16;++r)P0[r]=__builtin_amdgcn_exp2f(P0[r]); }while(0)
  #define RESC() do{}while(0)
  f32x16 pA0,pA1,pB0,pB1;
  int sl_prev=0,sl_cur=0,sl_next=SLOTB;
  #define ROT() do{sl_prev=sl_cur;sl_cur=sl_next;sl_next=(sl_next==(NSLOT-1)*SLOTB)?0:sl_next+SLOTB;}while(0)
  DMA_K(2,2*SLOTB);
  WAIT_BAR(3);
  qkt(pA0,pA1,Kbase,qr,negm,r32,hi);asm volatile("s_nop 15\n\ts_nop 7":"+v"(pA0),"+v"(pA1));CMASK(pA0,pA1,0);
  START(pA0,pA1);
  _Pragma("unroll") for(int r=0;r<16;++r)pA1[r]=__builtin_amdgcn_exp2f(pA1[r]);
  WAIT_BAR(0);
  DMA_K(3,0);DMA_V(1,SLOTB);
  ROT();
  kload8(kf,kp0+sl_cur);
  WAIT_BAR(2);
  s16x4 vlo[8],vhi[8]; u32x4 pw0,pw1,pw2,pw3;
  #define PKW(P,B) cvtpk_s(P[B],P[B+1])
  #define PAF(k) __builtin_bit_cast(bf16x8,pw##k)
  #define VFR(i) (bf16x8){vlo[i][0],vlo[i][1],vlo[i][2],vlo[i][3],vhi[i][0],vhi[i][1],vhi[i][2],vhi[i][3]}
  #define PIN(x) asm volatile("":"+v"(x))
  #define MX3(a,b,c) __builtin_fmaxf(__builtin_fmaxf((a),(b)),(c))
  #define GAPA(MF,A0,A1,A2,A3,W0,W1,PW) do{ MF; sacc+=A0; sacc+=A1; sacc+=A2; sacc+=A3; PIN(sacc); W0; W1; PIN(PW); SBAR(); }while(0)
  #define EX(v) __builtin_amdgcn_exp2f(v)
  #define GAPB(MF,X,B) do{ MF; X[B]=EX(X[B]); X[B+1]=EX(X[B+1]); X[B+2]=EX(X[B+2]); X[B+3]=EX(X[B+3]); PIN(X); SBAR(); }while(0)
  #define VRD(i) do{ vlo[i]=vtr(vp_+(((i)>>2)*4096+((i)&3)*1024)); vhi[i]=vtr(vp_+(((i)>>2)*4096+((i)&3)*1024+512)); }while(0)
  #define KRD(G,j) do{ if(G){ kload2(kf,kp0+sl_next,j); SBAR(); } }while(0)
  #define STEP(C0,C1,P0,P1,t,GK,GV,GL) do{ SBAR(); \
    const lds_cptr vp_=vp0+sl_prev; \
    VRD(0); SBAR(); float sacc=(P0[0]+P0[1]); \
    GAPA(C0=__builtin_amdgcn_mfma_f32_32x32x16_bf16(kf[0],qr[0],negm,0,0,0), P0[2],P0[3],P0[4],P0[5],     pw0[0]=PKW(P0,0), pw0[1]=PKW(P0,2), pw0); \
    VRD(4); SBAR(); GAPA(C1=__builtin_amdgcn_mfma_f32_32x32x16_bf16(kf[1],qr[0],negm,0,0,0), P0[6],P0[7],P0[8],P0[9],     pw0[2]=PKW(P0,4), pw0[3]=PKW(P0,6), pw0); \
    VRD(1); SBAR(); GAPA(C0=__builtin_amdgcn_mfma_f32_32x32x16_bf16(kf[2],qr[1],C0,0,0,0),   P0[10],P0[11],P0[12],P0[13], pw1[0]=PKW(P0,8), pw1[1]=PKW(P0,10), pw1); \
    VRD(5); SBAR(); GAPA(C1=__builtin_amdgcn_mfma_f32_32x32x16_bf16(kf[3],qr[1],C1,0,0,0),   P0[14],P0[15],P1[0],P1[1],   pw1[2]=PKW(P0,12),pw1[3]=PKW(P0,14), pw1); \
    VRD(2); SBAR(); GAPA(C0=__builtin_amdgcn_mfma_f32_32x32x16_bf16(kf[4],qr[2],C0,0,0,0),   P1[2],P1[3],P1[4],P1[5],     pw2[0]=PKW(P1,0), pw2[1]=PKW(P1,2), pw2); \
    VRD(6); SBAR(); GAPA(C1=__builtin_amdgcn_mfma_f32_32x32x16_bf16(kf[5],qr[2],C1,0,0,0),   P1[6],P1[7],P1[8],P1[9],     pw2[2]=PKW(P1,4), pw2[3]=PKW(P1,6), pw2); \
    VRD(3); SBAR(); GAPA(C0=__builtin_amdgcn_mfma_f32_32x32x16_bf16(kf[6],qr[3],C0,0,0,0),   P1[10],P1[11],P1[12],P1[13], pw3[0]=PKW(P1,8), pw3[1]=PKW(P1,10), pw3); \
    VRD(7); SBAR(); GAPA(C1=__builtin_amdgcn_mfma_f32_32x32x16_bf16(kf[7],qr[3],C1,0,0,0),   P1[14],P1[15],0.f,0.f,       pw3[2]=PKW(P1,12),pw3[3]=PKW(P1,14), pw3); \
    l_reg+=sacc; \
    if(GK){DMA_K((t)+3,sl_cur);} if(GV){DMA_V((t)+1,sl_next);} \
    CMASK(C0,C1,t); \
    SBAR(); \
    GAPB(o[0]=__builtin_amdgcn_mfma_f32_32x32x16_bf16(PAF(0),VFR(0),o[0],0,0,0), C0,0); \
    GAPB(o[1]=__builtin_amdgcn_mfma_f32_32x32x16_bf16(PAF(0),VFR(4),o[1],0,0,0), C0,4); \
    KRD(GL,0); GAPB(o[0]=__builtin_amdgcn_mfma_f32_32x32x16_bf16(PAF(1),VFR(1),o[0],0,0,0), C0,8); \
    KRD(GL,1); GAPB(o[1]=__builtin_amdgcn_mfma_f32_32x32x16_bf16(PAF(1),VFR(5),o[1],0,0,0), C0,12); \
    KRD(GL,2); GAPB(o[0]=__builtin_amdgcn_mfma_f32_32x32x16_bf16(PAF(2),VFR(2),o[0],0,0,0), C1,0); \
    KRD(GL,3); GAPB(o[1]=__builtin_amdgcn_mfma_f32_32x32x16_bf16(PAF(2),VFR(6),o[1],0,0,0), C1,4); \
    GAPB(o[0]=__builtin_amdgcn_mfma_f32_32x32x16_bf16(PAF(3),VFR(3),o[0],0,0,0), C1,8); \
    GAPB(o[1]=__builtin_amdgcn_mfma_f32_32x32x16_bf16(PAF(3),VFR(7),o[1],0,0,0), C1,12); \
    }while(0)
  int t=1;
  #undef CMASK
  #define CMASK(P0,P1,t) do{}while(0)
  for(;t+5<NT;t+=2){
    STEP(pB0,pB1,pA0,pA1,t,true,true,true);     WAIT_BAR(2); RESC(); ROT();
    STEP(pA0,pA1,pB0,pB1,t+1,true,true,true);   WAIT_BAR(2); RESC(); ROT();
  }
  #undef CMASK
  #define CMASK(P0,P1,t) do{}while(0)
  #define ENDW(tt) do{ if((tt)+3<NT){WAIT_BAR(2);} else if((tt)+2<NT){WAIT_BAR(1);} else {WAIT_BAR(0);} }while(0)
  for(;t+1<NT;t+=2){
    STEP(pB0,pB1,pA0,pA1,t,(t+3<NT),(t+1<NT),(t+1<NT));       ENDW(t);   RESC(); ROT();
    STEP(pA0,pA1,pB0,pB1,t+1,(t+4<NT),(t+2<NT),(t+2<NT));     ENDW(t+1); RESC(); ROT();
  }
  STEP(pB0,pB1,pA0,pA1,NT-1,false,false,false); RESC();
  { float sacc=pB0[0]+pB0[1]; _Pragma("unroll") for(int r=2;r<16;++r)sacc+=pB0[r]; _Pragma("unroll") for(int r=0;r<16;++r)sacc+=pB1[r]; l_reg+=sacc;
    pw0=(u32x4){PKW(pB0,0),PKW(pB0,2),PKW(pB0,4),PKW(pB0,6)};pw1=(u32x4){PKW(pB0,8),PKW(pB0,10),PKW(pB0,12),PKW(pB0,14)};pw2=(u32x4){PKW(pB1,0),PKW(pB1,2),PKW(pB1,4),PKW(pB1,6)};pw3=(u32x4){PKW(pB1,8),PKW(pB1,10),PKW(pB1,12),PKW(pB1,14)};
    SBAR(); pv(o,vb0+sl_cur,PAF(0),PAF(1),PAF(2),PAF(3)); }
  #undef PKW
  #undef PAF
  #undef VFR
  #undef PIN
  #undef MX3
  #undef GAPA
  #undef GAPB
  #undef EX
  #undef VRD
  #undef KRD
  #undef STEP
  #undef ENDW
  {auto rr=__builtin_amdgcn_permlane32_swap(__float_as_uint(l_reg),__float_as_uint(l_reg),false,false);l_reg=__uint_as_float(rr[0])+__uint_as_float(rr[1]);}
  if(hi==0)wsf[32+r32]=l_reg;asm volatile("s_waitcnt lgkmcnt(0)":::"memory");
  float rli[16];
  #pragma unroll
  for(int r=0;r<16;++r)rli[r]=__builtin_amdgcn_rcpf(wsf[32+crow(r,hi)]);
  bf16*Ow=dummyO?dummyO+(long)(wid*QBLK)*QP:YQb+(rowbase+q0+wid*QBLK)*QP+1024+h*D; const bf16*Gw=YQb+(rowbase+q0+wid*QBLK)*QP+h*D;
  { float*stg=(float*)(shm+LDS_OST)+wid*2048;
    #pragma unroll
    for(int r=0;r<16;++r){const int orow=crow(r,hi);
      #pragma unroll
      for(int d0=0;d0<2;++d0)stg[orow*64+d0*32+r32]=o[d0][r]*rli[r];}
    asm volatile("s_waitcnt lgkmcnt(0)":::"memory");
    #pragma unroll
    for(int i=0;i<4;++i){const int row=i*8+(lane>>3),ch=lane&7; const float*sp=stg+row*64+ch*8;
      const f32x4_t a=*(const f32x4_t*)sp,c=*(const f32x4_t*)(sp+4); const u32x4 g=*(const u32x4*)(Gw+(long)row*QP+ch*8);
      u32x4 v; v[0]=cvtpk_s(a[0]*__uint_as_float(g[0]<<16),a[1]*__uint_as_float(g[0]&0xffff0000u)); v[1]=cvtpk_s(a[2]*__uint_as_float(g[1]<<16),a[3]*__uint_as_float(g[1]&0xffff0000u));
      v[2]=cvtpk_s(c[0]*__uint_as_float(g[2]<<16),c[1]*__uint_as_float(g[2]&0xffff0000u)); v[3]=cvtpk_s(c[2]*__uint_as_float(g[3]<<16),c[3]*__uint_as_float(g[3]&0xffff0000u));
      ATTN_STORE16(Ow+(long)row*QP+ch*8,v);} }
  asm volatile("s_waitcnt lgkmcnt(0)\n\ts_barrier":::"memory");
  #undef DMA_K
  #undef DMA_V
  #undef CMASK
  #undef START
  #undef RESC
  #undef ROT
}
constexpr int ATTN_LDS_BYTES=LDS_BYTES;
struct Order {
  int vcu, G; bool alt;
  __device__ __forceinline__ bool next(int i,int&b,int&h,int&qb)const{
    if(G==256&&!alt){ if(i>=16)return false; const int x=vcu>>5,j=vcu&31,rd=i>>2,k=i&3; const int pair=x*16+rd*4+(j>>3),un=(j&7)*4+k; b=pair>>2; h=(pair&3)*4+(un&3); qb=un>>2; return true; }
    const int U=i*G+vcu; if(U>=4096)return false; b=U>>7; h=(U>>3)&15; qb=U&7; return true; }
};
template<int THRL=8> __device__ __forceinline__ void attn_phase(char*lds,bf16*YQb,const bf16*K,const bf16*V,const Order&S,int wid,float sbound,bf16*dummyO=nullptr){
  int b,h,qb;
  for(int i=0;S.next(i,b,h,qb);++i) attn_unit<THRL>(b,h,qb,YQb,K,V,lds,wid,sbound,dummyO);
}
#undef SBAR
#undef WAIT_BAR
}

namespace ssd {
typedef short bf16x8 __attribute__((ext_vector_type(8)));
typedef short s16x4 __attribute__((ext_vector_type(4)));
typedef unsigned u32x2_t __attribute__((ext_vector_type(2)));
constexpr int O_B = 0, O_C = 32768, O_X = 65536, O_XD = 81920, O_ST = 98304, O_SM = 114688;
constexpr float LOG2E = 1.4426950408889634f;
struct Lofs { int fb[4], xb[4], bb, sw; };
__device__ __forceinline__ bf16x8 frag(const LAS unsigned char* img, int fbk, int t) { return *(const LAS bf16x8*)(img + fbk + t * 4096); }
__device__ __forceinline__ s16x4 trd(const LAS unsigned char* p) { typedef short v4i16_t __attribute__((ext_vector_type(4))); return __builtin_bit_cast(s16x4, __builtin_amdgcn_ds_read_tr16_b64_v4i16((LAS v4i16_t*)p)); }
__device__ __forceinline__ bf16x8 trfragX(const LAS unsigned char* img, int xbp, int s0) {
    const s16x4 a = trd(img + xbp + s0 * 128), b = trd(img + xbp + s0 * 128 + 2048);
    return (bf16x8){a[0], a[1], a[2], a[3], b[0], b[1], b[2], b[3]};
}
__device__ __forceinline__ bf16x8 trfragB(const LAS unsigned char* img, int bb, int s0) {
    const s16x4 a = trd(img + bb + s0 * 256), b = trd(img + bb + s0 * 256 + 4096);
    return (bf16x8){a[0], a[1], a[2], a[3], b[0], b[1], b[2], b[3]};
}
__device__ __forceinline__ void unpack4(const u32x2_t u, float (&f)[4]) { f[0] = __uint_as_float(u.x << 16); f[1] = __uint_as_float(u.x & 0xffff0000u); f[2] = __uint_as_float(u.y << 16); f[3] = __uint_as_float(u.y & 0xffff0000u); }
__device__ __forceinline__ void unpack8(const v4u u, float (&f)[8]) {
    f[0] = __uint_as_float(u.x << 16); f[1] = __uint_as_float(u.x & 0xffff0000u); f[2] = __uint_as_float(u.y << 16); f[3] = __uint_as_float(u.y & 0xffff0000u);
    f[4] = __uint_as_float(u.z << 16); f[5] = __uint_as_float(u.z & 0xffff0000u); f[6] = __uint_as_float(u.w << 16); f[7] = __uint_as_float(u.w & 0xffff0000u);
}
#define SSD_MFMA(a, b, c) __builtin_amdgcn_mfma_f32_16x16x32_bf16(a, b, c, 0, 0, 0)

template <int W> __device__ __forceinline__ void diag(f32x4 (&y)[4], const bf16x8 (&cf)[4], const LAS unsigned char* Bi, const LAS unsigned char* Xi, const LAS float* csc, float csl, float skd, int fr, int fq, const Lofs& lo) {
    constexpr int NU = W / 2 + 1;
    bf16x8 bA[2][4], bB[2][4];
#pragma unroll
    for (int kk = 0; kk < 4; ++kk) { bA[0][kk] = frag(Bi, lo.fb[kk], 0); if (1 <= W) bB[0][kk] = frag(Bi, lo.fb[kk], 1); }
#pragma unroll
    for (int u = 0; u < NU; ++u) {
        const int cur = u & 1; const bool has1 = 2 * u + 1 <= W;
        bf16x8 xf[4];
#pragma unroll
        for (int pt = 0; pt < 4; ++pt) xf[pt] = trfragX(Xi, lo.xb[pt], 32 * u);
        const f32x4 c0 = *(const LAS f32x4*)(csc + 32 * u + 4 * fq), c1 = *(const LAS f32x4*)(csc + 32 * u + 16 + 4 * fq);
        if (u + 1 < NU) {
#pragma unroll
            for (int kk = 0; kk < 4; ++kk) { bA[cur ^ 1][kk] = frag(Bi, lo.fb[kk], 2 * u + 2); if (2 * u + 3 <= W) bB[cur ^ 1][kk] = frag(Bi, lo.fb[kk], 2 * u + 3); } }
        asm volatile("" ::: "memory");
        f32x4 a0 = (f32x4){0.f, 0.f, 0.f, 0.f}, a1 = (f32x4){0.f, 0.f, 0.f, 0.f};
#pragma unroll
        for (int kk = 0; kk < 4; ++kk) { a0 = SSD_MFMA(bA[cur][kk], cf[kk], a0); if (has1) a1 = SSD_MFMA(bB[cur][kk], cf[kk], a1); }
        float m0[4], m1[4];
#pragma unroll
        for (int e = 0; e < 4; ++e) {
            m0[e] = a0[e] * __builtin_amdgcn_exp2f(fminf(csl - c0[e], 0.f)); if (2 * u == W) { if (4 * fq + e > fr) m0[e] = 0.f; if (4 * fq + e == fr) m0[e] += skd; }
            m1[e] = has1 ? a1[e] * __builtin_amdgcn_exp2f(fminf(csl - c1[e], 0.f)) : 0.f; if (2 * u + 1 == W) { if (4 * fq + e > fr) m1[e] = 0.f; if (4 * fq + e == fr) m1[e] += skd; } }
        const v4u mw = (v4u){pk2(m0[0], m0[1]), pk2(m0[2], m0[3]), pk2(m1[0], m1[1]), pk2(m1[2], m1[3])};
        const bf16x8 mf = __builtin_bit_cast(bf16x8, mw);
#pragma unroll
        for (int pt = 0; pt < 4; ++pt) y[pt] = SSD_MFMA(xf[pt], mf, y[pt]);
    }
}

template <int SH> __device__ __forceinline__ void ssd_item(int b, int h, const bf16* XC, const float* DT, const bf16* Z, const float* a_log, const float* d_skip, bf16* YQ, float* SSQ,
                                          LAS unsigned char* L, int tid_in, int lane_in, int wave) {
    int tid = tid_in, lane = lane_in; asm volatile("" : "+v"(tid), "+v"(lane));
    const int fr = lane & 15, fq = lane >> 4, g = h >> 3;
    LAS unsigned char* Bi = L + O_B; LAS unsigned char* Ci = L + O_C; LAS unsigned char* Xi = L + O_X; LAS unsigned char* Xdi = L + O_XD; LAS unsigned char* Sti = L + O_ST;
    LAS float* dtv = (LAS float*)(L + O_SM); LAS float* cs2 = dtv + 256;
    const float aneg1 = -expf(a_log[16 + h]) * LOG2E, aneg0 = -expf(a_log[h]) * LOG2E, dsk = d_skip[h];
    Lofs lo;
    { const int q = (lane & 15) >> 2, pp = lane & 3, rr = 4 * fq + q;
#pragma unroll
      for (int kk = 0; kk < 4; ++kk) lo.fb[kk] = fr * 256 + (((4 * kk + fq) ^ fr) << 4);
#pragma unroll
      for (int pt = 0; pt < 4; ++pt) lo.xb[pt] = rr * 128 + ((pt ^ ((rr >> 1) & 3)) << 5) + 8 * pp;
      lo.bb = rr * 256 + (((2 * wave + (pp >> 1)) ^ rr) << 4) + 8 * (pp & 1);
      lo.sw = fr * 256 + (((2 * wave + (fq >> 1)) ^ fr) << 4) + (fq & 1) * 8; }
    const int sB = tid >> 4, cB = tid & 15, sX = tid >> 3, cX = tid & 7;
    const int wB = sB * 256 + ((cB ^ (sB & 15)) << 4);
    const int wX = sX * 128 + (((cX >> 1) ^ ((sX >> 1) & 3)) << 5) + (cX & 1) * 16;
    f32x4 st[4];
#pragma unroll
    for (int pt = 0; pt < 4; ++pt) st[pt] = (f32x4){0.f, 0.f, 0.f, 0.f};
    v4u Bq[4], Cq[4], Xq[2]; float dq0 = 0.f, dq1 = 0.f; bf16x8 cf[4];
#define SSD_DECODE(step, d_, base_, ctx_) const int d_ = 1 - (step) / 18; const int k_##d_ = (step) % 18; const bool ctx_ = k_##d_ < 2; \
    const size_t base_ = ctx_ ? (size_t)ML + (size_t)b * CTXL + (size_t)(d_ ? 1 - k_##d_ : k_##d_) * 128 : (size_t)b * SEQ + (size_t)(d_ ? 17 - k_##d_ : k_##d_ - 2) * 128;
#define SSD_ISSUE(step) do { SSD_DECODE(step, di, basei, ctxi) (void)ctxi; \
        const bf16* cb_ = XC + (SH == 8 ? (size_t)b * SEQ : basei) * CONVC; const int sg_ = di ? -CONVC : CONVC; const int o0_ = di ? 127 * CONVC : 0; \
        const bf16* pb_ = cb_ + (o0_ + sB * sg_ + 1024 + g * 128 + 8 * cB); const bf16* px_ = cb_ + (o0_ + sX * sg_ + h * 64 + 8 * cX); \
        const bf16* pc_ = cb_ + (o0_ + (16 * wave + fr) * sg_ + 1280 + g * 128 + 8 * fq); \
        _Pragma("unroll") for (int k4 = 0; k4 < 4; ++k4) { Bq[k4] = *(const v4u*)(pb_ + k4 * 32 * sg_); Cq[k4] = *(const v4u*)(pc_ + 32 * k4); } \
        _Pragma("unroll") for (int k2 = 0; k2 < 2; ++k2) Xq[k2] = *(const v4u*)(px_ + k2 * 64 * sg_); \
        if (wave == 0) { const size_t r0 = basei + (di ? 127 - 2 * lane : 2 * lane), r1 = basei + (di ? 126 - 2 * lane : 2 * lane + 1); dq0 = DT[r0 * 32 + di * 16 + h]; dq1 = DT[r1 * 32 + di * 16 + h]; } } while (0)
#define SSD_CUMSUM(step, par) do { if (wave == 0) { const float an = (1 - (step) / 18) ? aneg1 : aneg0; const float a0 = dq0 * an, a1 = dq1 * an; float v = a0 + a1; \
        _Pragma("unroll") for (int o = 1; o < 64; o <<= 1) { const float t = __shfl_up(v, o); if (lane >= o) v += t; } \
        dtv[(par) * 128 + 2 * lane] = dq0; dtv[(par) * 128 + 2 * lane + 1] = dq1; cs2[(par) * 128 + 2 * lane] = v - a1; cs2[(par) * 128 + 2 * lane + 1] = v; } } while (0)
#define SSD_WRITE(step, par) do { \
        _Pragma("unroll") for (int k4 = 0; k4 < 4; ++k4) { *(LAS v4u*)(Bi + wB + k4 * 8192) = Bq[k4]; cf[k4] = __builtin_bit_cast(bf16x8, Cq[k4]); } \
        const float cl = cs2[(par) * 128 + 127]; \
        _Pragma("unroll") for (int k2 = 0; k2 < 2; ++k2) { const int s = sX + 64 * k2; const float dts = dtv[(par) * 128 + s], es = __builtin_amdgcn_exp2f(cl - cs2[(par) * 128 + s]); \
            float f[8]; unpack8(Xq[k2], f); _Pragma("unroll") for (int e = 0; e < 8; ++e) f[e] *= dts; \
            v4u xo; xo.x = pk2(f[0], f[1]); xo.y = pk2(f[2], f[3]); xo.z = pk2(f[4], f[5]); xo.w = pk2(f[6], f[7]); \
            _Pragma("unroll") for (int e = 0; e < 8; ++e) f[e] *= es; \
            v4u xd; xd.x = pk2(f[0], f[1]); xd.y = pk2(f[2], f[3]); xd.z = pk2(f[4], f[5]); xd.w = pk2(f[6], f[7]); \
            *(LAS v4u*)(Xi + wX + k2 * 8192) = xo; *(LAS v4u*)(Xdi + wX + k2 * 8192) = xd; } } while (0)
#define SSD_WRITE_STATE() do { _Pragma("unroll") for (int pt = 0; pt < 4; ++pt) { \
        u32x2_t w; w.x = pk2(st[pt][0], st[pt][1]); w.y = pk2(st[pt][2], st[pt][3]); *(LAS u32x2_t*)(Sti + lo.sw + pt * 4096) = w; } } while (0)

    __syncthreads();
    SSD_ISSUE(0); SSD_CUMSUM(0, 0); SSD_WRITE_STATE();
    __syncthreads();
    SSD_WRITE(0, 0);
    __syncthreads();
    for (int step = 0; step < 36; ++step) {
        const int par = step & 1; SSD_DECODE(step, d, base, isctx)
        const int r8 = lane >> 3, c8 = lane & 7;
        size_t orow2[2]; v4u ybv[2], zv[2];
#pragma unroll
        for (int ps = 0; ps < 2; ++ps) { const int l = 16 * wave + 8 * ps + r8; orow2[ps] = base + (d ? 127 - l : l); }
        if (!isctx && d == 0 && SH != 5 && SH != 7) {
#pragma unroll
            for (int ps = 0; ps < 2; ++ps) { ybv[ps] = *(const v4u*)((SH ? YQ + (orow2[ps] & 255) * 2048 : YQ + orow2[ps] * 2048) + h * 64 + 8 * c8); zv[ps] = *(const v4u*)(Z + orow2[ps] * 1024 + h * 64 + 8 * c8); } }
        if (step + 1 < 36 && SH != 3 && SH != 7) SSD_ISSUE(step + 1);
        const LAS float* csc = cs2 + par * 128;
        if (!isctx && SH != 7) {
            const float csl = csc[16 * wave + fr];
            const float skd = d == 0 ? dsk * __builtin_amdgcn_rcpf(dtv[par * 128 + 16 * wave + fr]) : 0.f;
            f32x4 y[4];
#pragma unroll
            for (int pt = 0; pt < 4; ++pt) { y[pt] = (f32x4){0.f, 0.f, 0.f, 0.f};
                if (SH != 6) {
#pragma unroll
                for (int kk = 0; kk < 4; ++kk) y[pt] = SSD_MFMA(frag(Sti, lo.fb[kk], pt), cf[kk], y[pt]); } }
            { const float El = __builtin_amdgcn_exp2f(csl);
#pragma unroll
              for (int pt = 0; pt < 4; ++pt) y[pt] *= El; }
            if (SH != 2) switch (wave) {
                case 0: diag<0>(y, cf, Bi, Xi, csc, csl, skd, fr, fq, lo); break; case 1: diag<1>(y, cf, Bi, Xi, csc, csl, skd, fr, fq, lo); break;
                case 2: diag<2>(y, cf, Bi, Xi, csc, csl, skd, fr, fq, lo); break; case 3: diag<3>(y, cf, Bi, Xi, csc, csl, skd, fr, fq, lo); break;
                case 4: diag<4>(y, cf, Bi, Xi, csc, csl, skd, fr, fq, lo); break; case 5: diag<5>(y, cf, Bi, Xi, csc, csl, skd, fr, fq, lo); break;
                case 6: diag<6>(y, cf, Bi, Xi, csc, csl, skd, fr, fq, lo); break; default: diag<7>(y, cf, Bi, Xi, csc, csl, skd, fr, fq, lo); break;
            }
            LAS unsigned char* stg = Ci + wave * 4096;
#pragma unroll
            for (int pt = 0; pt < 4; ++pt) *(LAS f32x4*)(stg + fr * 256 + (((4 * pt + fq) ^ fr) << 4)) = y[pt];
#pragma unroll
            for (int ps = 0; ps < 2; ++ps) { const int rl = 8 * ps + r8;
                const f32x4 t0 = *(const LAS f32x4*)(stg + rl * 256 + (((2 * c8) ^ rl) << 4)), t1 = *(const LAS f32x4*)(stg + rl * 256 + (((2 * c8 + 1) ^ rl) << 4));
                float v[8] = {t0[0], t0[1], t0[2], t0[3], t1[0], t1[1], t1[2], t1[3]};
                if (d == 0 && SH != 5) { float fb[8], fz[8]; unpack8(ybv[ps], fb); unpack8(zv[ps], fz); float q = 0.f;
#pragma unroll
                    for (int e = 0; e < 8; ++e) { v[e] = (v[e] + fb[e]) * fz[e]; q += v[e] * v[e]; }
                    q += __shfl_xor(q, 1); q += __shfl_xor(q, 2); q += __shfl_xor(q, 4);
                    if (c8 == 0) SSQ[(SH ? (orow2[ps] & 255) : orow2[ps]) * 16 + h] = q; }
                v4u o; o.x = pk2(v[0], v[1]); o.y = pk2(v[2], v[3]); o.z = pk2(v[4], v[5]); o.w = pk2(v[6], v[7]);
                if (SH != 5) *(v4u*)((SH ? YQ + (orow2[ps] & 255) * 2048 : YQ + orow2[ps] * 2048) + h * 64 + 8 * c8) = o; else asm volatile("" :: "v"(o)); }
        }
        if (SH != 6 && SH != 7) { const float dec = __builtin_amdgcn_exp2f(csc[127]);
#pragma unroll
          for (int pt = 0; pt < 4; ++pt) st[pt] *= dec;
#pragma unroll
          for (int kk = 0; kk < 4; ++kk) { const bf16x8 af = trfragB(Bi, lo.bb, 32 * kk);
#pragma unroll
              for (int pt = 0; pt < 4; ++pt) st[pt] = SSD_MFMA(af, trfragX(Xdi, lo.xb[pt], 32 * kk), st[pt]); } }
        if (step + 1 < 36) SSD_CUMSUM(step + 1, par ^ 1);
        if (step == 17) {
#pragma unroll
            for (int pt = 0; pt < 4; ++pt) st[pt] = (f32x4){0.f, 0.f, 0.f, 0.f};
            VM_WAIT();
        }
        __syncthreads();
        SSD_WRITE_STATE();
        if (step + 1 < 36 && SH != 4 && SH != 7) SSD_WRITE(step + 1, par ^ 1);
        __syncthreads();
    }
#undef SSD_DECODE
#undef SSD_ISSUE
#undef SSD_CUMSUM
#undef SSD_WRITE
#undef SSD_WRITE_STATE
}
namespace pr {
template <int CTRL, int ROWMASK> __device__ __forceinline__ float dpp_get(float v) {
    return __builtin_bit_cast(float, __builtin_amdgcn_update_dpp(0, __builtin_bit_cast(int, v), CTRL, ROWMASK, 0xF, false)); }
__device__ __forceinline__ float sum8(float q) {
    q += dpp_get<0xB1, 0xF>(q); q += dpp_get<0x4E, 0xF>(q); q += dpp_get<0x141, 0xF>(q); return q; }
__device__ __forceinline__ float scan64(float v) {
    v += dpp_get<0x111, 0xF>(v); v += dpp_get<0x112, 0xF>(v); v += dpp_get<0x114, 0xF>(v); v += dpp_get<0x118, 0xF>(v);
    v += dpp_get<0x142, 0xA>(v); v += dpp_get<0x143, 0xC>(v); return v; }
constexpr int P_B = 0, P_STG = 32768, P_X = 49152, P_XD = 81920, P_ST0 = 114688, P_ST1 = 132096, P_SM = 148480;
template <int W> __device__ __forceinline__ void diag1(f32x4 (&y)[4], const bf16x8 (&cf)[4], const LAS unsigned char* Bi, const LAS unsigned char* Xi, const LAS float* csc, float csl, float skd, int fr, int fq, const Lofs& lo) {
#pragma unroll
    for (int u = 0; u <= W / 2; ++u) {
        const bool has1 = 2 * u + 1 <= W;
        bf16x8 xf[4];
#pragma unroll
        for (int pt = 0; pt < 4; ++pt) xf[pt] = trfragX(Xi, lo.xb[pt], 32 * u);
        const f32x4 c0 = *(const LAS f32x4*)(csc + 32 * u + 4 * fq), c1 = *(const LAS f32x4*)(csc + 32 * u + 16 + 4 * fq);
        f32x4 a0 = (f32x4){0.f, 0.f, 0.f, 0.f}, a1 = (f32x4){0.f, 0.f, 0.f, 0.f};
#pragma unroll
        for (int kk = 0; kk < 4; ++kk) { a0 = SSD_MFMA(frag(Bi, lo.fb[kk], 2 * u), cf[kk], a0); if (has1) a1 = SSD_MFMA(frag(Bi, lo.fb[kk], 2 * u + 1), cf[kk], a1); }
        float m0[4], m1[4];
#pragma unroll
        for (int e = 0; e < 4; ++e) {
            m0[e] = a0[e] * __builtin_amdgcn_exp2f(fminf(csl - c0[e], 0.f)); if (2 * u == W) { if (4 * fq + e > fr) m0[e] = 0.f; if (4 * fq + e == fr) m0[e] += skd; }
            m1[e] = has1 ? a1[e] * __builtin_amdgcn_exp2f(fminf(csl - c1[e], 0.f)) : 0.f; if (2 * u + 1 == W) { if (4 * fq + e > fr) m1[e] = 0.f; if (4 * fq + e == fr) m1[e] += skd; } }
        const v4u mw = (v4u){pk2(m0[0], m0[1]), pk2(m0[2], m0[3]), pk2(m1[0], m1[1]), pk2(m1[2], m1[3])};
        const bf16x8 mf = __builtin_bit_cast(bf16x8, mw);
#pragma unroll
        for (int pt = 0; pt < 4; ++pt) y[pt] = SSD_MFMA(xf[pt], mf, y[pt]);
    }
}
__device__ __forceinline__ void diag_sw(int wave, f32x4 (&y)[4], const bf16x8 (&cf)[4], const LAS unsigned char* Bi, const LAS unsigned char* Xi, const LAS float* csc, float csl, float skd, int fr, int fq, const Lofs& lo) {
    switch (wave) {
        case 0: diag1<0>(y, cf, Bi, Xi, csc, csl, skd, fr, fq, lo); break; case 1: diag1<1>(y, cf, Bi, Xi, csc, csl, skd, fr, fq, lo); break;
        case 2: diag1<2>(y, cf, Bi, Xi, csc, csl, skd, fr, fq, lo); break; case 3: diag1<3>(y, cf, Bi, Xi, csc, csl, skd, fr, fq, lo); break;
        case 4: diag1<4>(y, cf, Bi, Xi, csc, csl, skd, fr, fq, lo); break; case 5: diag1<5>(y, cf, Bi, Xi, csc, csl, skd, fr, fq, lo); break;
        case 6: diag1<6>(y, cf, Bi, Xi, csc, csl, skd, fr, fq, lo); break; default: diag1<7>(y, cf, Bi, Xi, csc, csl, skd, fr, fq, lo); break;
    }
}

__device__ __forceinline__ void ssd_pair(int b, int hp, const bf16* XC, const float* DT, const bf16* Z, const float* a_log, const float* d_skip, bf16* YQ, float* SSQ,
                                          LAS unsigned char* L, int tid_in, int lane_in, int wave) {
    int tid = tid_in, lane = lane_in; asm volatile("" : "+v"(tid), "+v"(lane));
    const int fr = lane & 15, fq = lane >> 4, h0 = 2 * hp, g = hp >> 2;
    LAS unsigned char* Bi = L + P_B; LAS unsigned char* Stg = L + P_STG + wave * 2048;
    LAS float* dtv = (LAS float*)(L + P_SM); LAS float* cs2 = dtv + 512;
    const float an00 = -expf(a_log[h0]) * LOG2E, an01 = -expf(a_log[h0 + 1]) * LOG2E, an10 = -expf(a_log[16 + h0]) * LOG2E, an11 = -expf(a_log[16 + h0 + 1]) * LOG2E;
    const float dsk0 = d_skip[h0], dsk1 = d_skip[h0 + 1];
    Lofs lo;
    { const int q = (lane & 15) >> 2, pp = lane & 3, rr = 4 * fq + q;
#pragma unroll
      for (int kk = 0; kk < 4; ++kk) lo.fb[kk] = fr * 256 + (((4 * kk + fq) ^ fr) << 4);
#pragma unroll
      for (int pt = 0; pt < 4; ++pt) lo.xb[pt] = rr * 128 + ((pt ^ ((rr >> 1) & 3)) << 5) + 8 * pp;
      lo.bb = rr * 256 + (((2 * wave + (pp >> 1)) ^ rr) << 4) + 8 * (pp & 1);
      lo.sw = fr * 256 + (((2 * wave + (fq >> 1)) ^ fr) << 4) + (fq & 1) * 8; }
    const int sB = tid >> 4, cB = tid & 15, hx = (tid >> 3) & 1, cX = tid & 7;
    const int wB = sB * 256 + ((cB ^ (sB & 15)) << 4);
    const int wX = hx * 16384 + sB * 128 + (((cX >> 1) ^ ((sB >> 1) & 3)) << 5) + (cX & 1) * 16;
    f32x4 st[2][4];
#pragma unroll
    for (int hh = 0; hh < 2; ++hh)
#pragma unroll
        for (int pt = 0; pt < 4; ++pt) st[hh][pt] = (f32x4){0.f, 0.f, 0.f, 0.f};
    v4u Bq[4], Xq[4]; float dq0 = 0.f, dq1 = 0.f; bf16x8 cf[4];
#define PR_DECODE(step, d_, base_, ctx_) const int d_ = 1 - (step) / 18; const int k_##d_ = (step) % 18; const bool ctx_ = k_##d_ < 2; \
    const size_t base_ = ctx_ ? (size_t)ML + (size_t)b * CTXL + (size_t)(d_ ? 1 - k_##d_ : k_##d_) * 128 : (size_t)b * SEQ + (size_t)(d_ ? 17 - k_##d_ : k_##d_ - 2) * 128;
#define PR_ISSUE(step) do { PR_DECODE(step, di, basei, ctxi) (void)ctxi; \
        const bf16* cb_ = XC + basei * CONVC; const int sg_ = di ? -CONVC : CONVC; const int o0_ = di ? 127 * CONVC : 0; \
        const bf16* pb_ = cb_ + (o0_ + sB * sg_ + 1024 + g * 128 + 8 * cB); const bf16* px_ = cb_ + (o0_ + sB * sg_ + h0 * 64 + 8 * cB); \
        _Pragma("unroll") for (int k4 = 0; k4 < 4; ++k4) { Bq[k4] = *(const v4u*)(pb_ + k4 * 32 * sg_); Xq[k4] = *(const v4u*)(px_ + k4 * 32 * sg_); } \
        if (wave < 2) { const size_t r0 = basei + (di ? 127 - 2 * lane : 2 * lane), r1 = basei + (di ? 126 - 2 * lane : 2 * lane + 1); dq0 = DT[r0 * 32 + di * 16 + h0 + wave]; dq1 = DT[r1 * 32 + di * 16 + h0 + wave]; } } while (0)
#define PR_LOADC(step) do { PR_DECODE(step, dc, basec, ctxc) (void)ctxc; const bf16* pc_ = XC + basec * CONVC + ((dc ? 127 - (16 * wave + fr) : 16 * wave + fr) * CONVC + 1280 + g * 128 + 8 * fq); \
        _Pragma("unroll") for (int k4 = 0; k4 < 4; ++k4) cf[k4] = __builtin_bit_cast(bf16x8, *(const v4u*)(pc_ + 32 * k4)); } while (0)
#define PR_CUMSUM(step, par) do { if (wave < 2) { const float an = (1 - (step) / 18) ? (wave ? an11 : an10) : (wave ? an01 : an00); const float a0 = dq0 * an, a1 = dq1 * an; const float v = scan64(a0 + a1); \
        const int o_ = ((par) * 2 + wave) * 128 + 2 * lane; dtv[o_] = dq0; dtv[o_ + 1] = dq1; cs2[o_] = v - a1; cs2[o_ + 1] = v; } } while (0)
#define PR_WRITE(step, par) do { const int ob_ = ((par) * 2 + hx) * 128; const float cl = cs2[ob_ + 127]; \
        _Pragma("unroll") for (int k4 = 0; k4 < 4; ++k4) { *(LAS v4u*)(Bi + wB + k4 * 8192) = Bq[k4]; \
            const int s = sB + 32 * k4; const float dts = dtv[ob_ + s], es = __builtin_amdgcn_exp2f(cl - cs2[ob_ + s]); \
            float f[8]; unpack8(Xq[k4], f); _Pragma("unroll") for (int e = 0; e < 8; ++e) f[e] *= dts; \
            v4u xo; xo.x = pk2(f[0], f[1]); xo.y = pk2(f[2], f[3]); xo.z = pk2(f[4], f[5]); xo.w = pk2(f[6], f[7]); \
            _Pragma("unroll") for (int e = 0; e < 8; ++e) f[e] *= es; \
            v4u xd; xd.x = pk2(f[0], f[1]); xd.y = pk2(f[2], f[3]); xd.z = pk2(f[4], f[5]); xd.w = pk2(f[6], f[7]); \
            *(LAS v4u*)(L + P_X + wX + k4 * 4096) = xo; *(LAS v4u*)(L + P_XD + wX + k4 * 4096) = xd; } } while (0)
#define PR_WRITE_STATE() do { _Pragma("unroll") for (int pt = 0; pt < 4; ++pt) { \
        u32x2_t w; w.x = pk2(st[0][pt][0], st[0][pt][1]); w.y = pk2(st[0][pt][2], st[0][pt][3]); *(LAS u32x2_t*)(L + P_ST0 + lo.sw + pt * 4096) = w; \
        w.x = pk2(st[1][pt][0], st[1][pt][1]); w.y = pk2(st[1][pt][2], st[1][pt][3]); *(LAS u32x2_t*)(L + P_ST1 + lo.sw + pt * 4096) = w; } } while (0)

    __syncthreads();
    PR_ISSUE(0); PR_LOADC(0); PR_CUMSUM(0, 0); PR_WRITE_STATE();
    __syncthreads();
    PR_WRITE(0, 0);
    __syncthreads();
    for (int step = 0; step < 36; ++step) {
        const int par = step & 1; PR_DECODE(step, d, base, isctx)
        const int r8 = lane >> 3, c8 = lane & 7;
        size_t orow2[2]; v4u ybv[2], zv[2];
#pragma unroll
        for (int ps = 0; ps < 2; ++ps) { const int l = 16 * wave + 8 * ps + r8; orow2[ps] = base + (d ? 127 - l : l); }
        const bool fwdy = !isctx && d == 0;
        if (fwdy) {
#pragma unroll
            for (int ps = 0; ps < 2; ++ps) { ybv[ps] = *(const v4u*)(YQ + orow2[ps] * 2048 + h0 * 64 + 8 * c8); zv[ps] = *(const v4u*)(Z + orow2[ps] * 1024 + h0 * 64 + 8 * c8); } }
        if (step + 1 < 36) PR_ISSUE(step + 1);
        if (!isctx) {
#pragma unroll
            for (int hh = 0; hh < 2; ++hh) {
                const LAS float* csc = cs2 + (par * 2 + hh) * 128;
                const LAS unsigned char* Xi = L + P_X + hh * 16384; const LAS unsigned char* Sti = L + (hh ? P_ST1 : P_ST0);
                const float csl = csc[16 * wave + fr];
                const float skd = d == 0 ? (hh ? dsk1 : dsk0) * __builtin_amdgcn_rcpf(dtv[(par * 2 + hh) * 128 + 16 * wave + fr]) : 0.f;
                f32x4 y[4];
#pragma unroll
                for (int pt = 0; pt < 4; ++pt) { y[pt] = (f32x4){0.f, 0.f, 0.f, 0.f};
#pragma unroll
                    for (int kk = 0; kk < 4; ++kk) y[pt] = SSD_MFMA(frag(Sti, lo.fb[kk], pt), cf[kk], y[pt]); }
                { const float El = __builtin_amdgcn_exp2f(csl);
#pragma unroll
                  for (int pt = 0; pt < 4; ++pt) y[pt] *= El; }
                diag_sw(wave, y, cf, Bi, Xi, csc, csl, skd, fr, fq, lo);
#pragma unroll
                for (int ps = 0; ps < 2; ++ps) {
                    if ((fr >> 3) == ps) {
#pragma unroll
                        for (int pt = 0; pt < 4; ++pt) *(LAS f32x4*)(Stg + (fr & 7) * 256 + (((4 * pt + fq) ^ fr) << 4)) = y[pt]; }
                    const int key = 8 * ps + r8;
                    const f32x4 t0 = *(const LAS f32x4*)(Stg + r8 * 256 + (((2 * c8) ^ key) << 4)), t1 = *(const LAS f32x4*)(Stg + r8 * 256 + (((2 * c8 + 1) ^ key) << 4));
                    float v[8] = {t0[0], t0[1], t0[2], t0[3], t1[0], t1[1], t1[2], t1[3]};
                    if (d == 0) { float fb[8], fz[8]; unpack8(ybv[ps], fb); unpack8(zv[ps], fz); float q = 0.f;
#pragma unroll
                        for (int e = 0; e < 8; ++e) { v[e] = (v[e] + fb[e]) * fz[e]; q += v[e] * v[e]; }
                        q = sum8(q);
                        if (c8 == 0) SSQ[orow2[ps] * 16 + h0 + hh] = q; }
                    v4u o; o.x = pk2(v[0], v[1]); o.y = pk2(v[2], v[3]); o.z = pk2(v[4], v[5]); o.w = pk2(v[6], v[7]);
                    *(v4u*)(YQ + orow2[ps] * 2048 + (h0 + hh) * 64 + 8 * c8) = o;
                }
                if (hh == 0 && fwdy) {
#pragma unroll
                    for (int ps = 0; ps < 2; ++ps) { ybv[ps] = *(const v4u*)(YQ + orow2[ps] * 2048 + (h0 + 1) * 64 + 8 * c8); zv[ps] = *(const v4u*)(Z + orow2[ps] * 1024 + (h0 + 1) * 64 + 8 * c8); } }
            }
        }
        if (step + 1 < 36) PR_LOADC(step + 1);
        { const float dec0 = __builtin_amdgcn_exp2f(cs2[(par * 2 + 0) * 128 + 127]), dec1 = __builtin_amdgcn_exp2f(cs2[(par * 2 + 1) * 128 + 127]);
#pragma unroll
          for (int pt = 0; pt < 4; ++pt) { st[0][pt] *= dec0; st[1][pt] *= dec1; }
#pragma unroll
          for (int kk = 0; kk < 4; ++kk) { const bf16x8 af = trfragB(Bi, lo.bb, 32 * kk);
#pragma unroll
              for (int pt = 0; pt < 4; ++pt) { st[0][pt] = SSD_MFMA(af, trfragX(L + P_XD, lo.xb[pt], 32 * kk), st[0][pt]); st[1][pt] = SSD_MFMA(af, trfragX(L + P_XD + 16384, lo.xb[pt], 32 * kk), st[1][pt]); } } }
        if (step + 1 < 36) PR_CUMSUM(step + 1, par ^ 1);
        if (step == 17) {
#pragma unroll
            for (int pt = 0; pt < 4; ++pt) { st[0][pt] = (f32x4){0.f, 0.f, 0.f, 0.f}; st[1][pt] = (f32x4){0.f, 0.f, 0.f, 0.f}; }
            VM_WAIT();
        }
        __syncthreads();
        PR_WRITE_STATE();
        if (step + 1 < 36) PR_WRITE(step + 1, par ^ 1);
        __syncthreads();
    }
#undef PR_DECODE
#undef PR_ISSUE
#undef PR_CUMSUM
#undef PR_LOADC
#undef PR_WRITE
#undef PR_WRITE_STATE
}
}
}

constexpr int RING_OFF = 0, RING_BYTES = 131072;
constexpr int LDSCTL_OFF = RING_BYTES, MISC_OFF = LDSCTL_OFF + 320;
constexpr int RSTD_OFF = LDSCTL_OFF + 1024;
constexpr int LDS_BYTES = 155648;
constexpr int CW_BAR = 4096;
constexpr int CW_TMO2 = 8192, CW_CNT = 16384;
constexpr int EXL_OFF = 140288;
constexpr int NPHASE = 7;

struct Args { const float* in[18]; float* out; unsigned char* ws; int ph_lo, ph_hi; };

__global__ void __launch_bounds__(NWAVES * 64, 2) mega(Args args) {
    extern __shared__ __attribute__((aligned(16))) unsigned char lds[];
    LAS unsigned char* ldsp = (LAS unsigned char*)lds;
    volatile LAS unsigned* MISC = (volatile LAS unsigned*)(ldsp + MISC_OFF);
    const int wave = __builtin_amdgcn_readfirstlane((int)threadIdx.x >> 6);
#define PH_IDS() int lane = mk_lane(); asm volatile("" : "+v"(lane)); const int tid = wave * 64 + lane; (void)tid
    const int G = gridDim.x; const int bx = blockIdx.x; const int vcu = (G % 8 == 0) ? (bx % 8) * (G / 8) + bx / 8 : bx;
    unsigned char* ws = args.ws;
    gu32* ctl = (gu32*)(ws + WS_CTL);
    float* mod = (float*)(ws + WS_MOD); float* rope = (float*)(ws + WS_ROPE); float* SSQ = (float*)(ws + WS_SSQ); float* RPART = (float*)(ws + WS_RPART);
    bf16* bt1 = (bf16*)(ws + WS_BT1); bf16* bt2 = (bf16*)(ws + WS_BT2); float* DT = (float*)(ws + WS_DT); bf16* KB = (bf16*)(ws + WS_KB); bf16* VB = (bf16*)(ws + WS_VB);
    bf16* H = (bf16*)(ws + WS_R1); bf16* XC = (bf16*)(ws + WS_R1); bf16* XBC = (bf16*)(ws + WS_XBC); bf16* YQ = (bf16*)(ws + WS_YQ); bf16* Z = (bf16*)(ws + WS_Z);
    { PH_IDS(); for (int u = tid; u < (LDS_BYTES - LDSCTL_OFF) / 4; u += NWAVES * 64) ((LAS unsigned*)(ldsp + LDSCTL_OFF))[u] = 0u; }
    __syncthreads();
    const bool leader = wave == 0 && mk_lane() == 0; (void)leader;
    const int lo = args.ph_lo, hi = args.ph_hi;
    XcdBarrier bar; bar.bar = (unsigned*)(ctl + CW_BAR); bar.x = 0; bar.st = nullptr;
    if (hi - lo > 1) bar = xcd_barrier_post((unsigned*)(ctl + CW_BAR), MISC + 8, leader);
#ifndef DUP_MASK
#define DUP_MASK 0
#endif
#define IN(k) (lo <= (k) && (k) < hi)
#define REP(k) for (int rep_ = 0; rep_ < 1 + ((DUP_MASK >> (k)) & 1); ++rep_)
#define SEAM(k) do { if (IN(k) && IN((k) + 1)) xcd_barrier(bar, wave == 0 && mk_lane() == 0); } while (0)

    if (IN(0)) REP(0) {
        PH_IDS();
        LAS float* ldsf = (LAS float*)(ldsp + RING_OFF);
        if (bx < 48) p0_mod_block(args.in[1], args.in[3], args.in[4], args.in[5], mod, ldsf, bx, tid, lane, wave);
        else if (bx == 48) { for (int i = tid; i < 1024; i += NWAVES * 64) { const int p = i >> 4, f = i & 15; const float inv = powf(10000.f, -(float)f / 16.f); const float ang = (float)p * inv; rope[i] = cosf(ang); rope[1024 + i] = sinf(ang); } }
        LAS float* scr = ldsf + wave * (64 * 33);
        const int gw = ((bx + G - 49) % G) * NWAVES + wave, NGW = G * NWAVES;
        constexpr int I1 = 16 * 168, I2 = 32 * 32;
        for (int it = gw; it < I1 + I2; it += NGW) { if (it < I1) p0_bt1_item(args.in[7], bt1, scr, it, lane); else p0_bt2_item(args.in[16], args.in[15], bt2, scr, it - I1, lane); }
    }
    SEAM(0);
    if (IN(1)) REP(1) {
        PH_IDS();
        const int gw = bx * NWAVES + wave, NGW = G * NWAVES;
        static_assert(MT % (8 * 2048) == 0 || true, "row batches");
        {
            const int step = NGW * 4; int m0 = gw * 4;
            f32x4 va[4][4], vb[4][4];
            if (m0 < MT) p1_load4(va, args.in[0], args.in[2], m0, lane);
            while (m0 < MT) {
                if (m0 + step < MT) p1_load4(vb, args.in[0], args.in[2], m0 + step, lane);
                asm volatile("" ::: "memory");
                p1_proc4(va, mod, args.in[6], H, m0, lane);
                m0 += step; if (m0 >= MT) break;
                if (m0 + step < MT) p1_load4(va, args.in[0], args.in[2], m0 + step, lane);
                asm volatile("" ::: "memory");
                p1_proc4(vb, mod, args.in[6], H, m0, lane);
                m0 += step;
            }
        }
    }
    SEAM(1);

    if (IN(2)) REP(2) {
        pg8::Gemm g{H, bt1, MT, N1, 1024}; pg8::Sched1 S; S.init(G, bx);
        pg8::Epi1 E{KB, VB, XBC, YQ, Z, DT, rope, args.in[13], args.in[14], args.in[10]};
        pg8::gemm_phase<pg8::Epi1, pg8::Sched1, true, true>(ldsp + RING_OFF, g, S, E, wave);
    }
    SEAM(2);
    if (IN(3)) {
        PH_IDS();
        float sbound;
        { float gq = fabsf(args.in[13][lane]), gk = fabsf(args.in[14][lane]);
#pragma unroll
          for (int o = 1; o < 64; o <<= 1) { gq = fmaxf(gq, __shfl_xor(gq, o)); gk = fmaxf(gk, __shfl_xor(gk, o)); }
          sbound = __uint_as_float(__builtin_amdgcn_readfirstlane(__float_as_uint(C2 * 64.f * gq * gk * 1.01f))); }
        const attn_body::Order S{vcu, G, false};
        const attn_body::Order S2{vcu, G, true};
#ifndef ATTN_SHADOW
#define ATTN_SHADOW 0
#endif
        if (ATTN_SHADOW) attn_body::attn_phase<8>((char*)lds + RING_OFF, (attn_body::bf16*)YQ, (const attn_body::bf16*)KB, (const attn_body::bf16*)VB, ATTN_SHADOW == 2 ? S2 : S, wave, sbound, (attn_body::bf16*)(ws + WS_END + 8 * MiB));
        attn_body::attn_phase<8>((char*)lds + RING_OFF, (attn_body::bf16*)YQ, (const attn_body::bf16*)KB, (const attn_body::bf16*)VB, S, wave, sbound);
        conv_phase(XBC, args.in[8], args.in[9], XC, bx, G, tid);
    }
    SEAM(3);
    if (IN(4)) REP(4) {
        PH_IDS();
#if defined(SSD_NAIVE)
        for (int it = bx; it < NB * 16; it += G) ssd_item_naive(it >> 4, it & 15, XC, DT, Z, args.in[11], args.in[12], YQ, SSQ, (LAS float*)(ldsp + RING_OFF), tid);
#else
#ifndef SSD_SHADOW
#define SSD_SHADOW 0
#endif
        if (SSD_SHADOW) { bf16* dY = (bf16*)(ws + WS_END); float* dS = (float*)(ws + WS_END + 2 * MiB);
            for (int it = vcu; it < NB * 16; it += G) ssd::ssd_item<SSD_SHADOW>(it >> 4, it & 15, XC, DT, Z, args.in[11], args.in[12], dY, dS, ldsp, tid, lane, wave); }
#ifndef SSD_PAIR
#define SSD_PAIR 1
#endif
        if (SSD_PAIR) { for (int it = vcu; it < NB * 8; it += G) { int ln_ = mk_lane(); asm volatile("" : "+v"(ln_)); ssd::pr::ssd_pair(it >> 3, it & 7, XC, DT, Z, args.in[11], args.in[12], YQ, SSQ, ldsp, wave * 64 + ln_, ln_, wave); } }
        else for (int it = vcu; it < NB * 16; it += G) ssd::ssd_item<0>(it >> 4, it & 15, XC, DT, Z, args.in[11], args.in[12], YQ, SSQ, ldsp, tid, lane, wave);
#endif
    }
    SEAM(4);

    if (IN(5)) REP(5) {
        PH_IDS();
        pg8::Sched2 S; S.init(G, bx);
        LAS float* rt = (LAS float*)(ldsp + RSTD_OFF);
        { pg8::Unit u; for (int i = 0; i < 4 && S.next(i, u); ++i) if (tid < 256) { const float* q = SSQ + ((size_t)u.pm * 256 + tid) * 16; float s = 0.f;
#pragma unroll
                for (int j = 0; j < 16; ++j) s += q[j];
                rt[i * 256 + tid] = rsqrtf(s * (1.f / 1024.f) + EPS); } }
        __syncthreads();
        pg8::Gemm g{YQ, bt2, ML, 1024, 2048};
        pg8::Epi2 E{args.in[0], mod, args.in[17], args.out, (unsigned long long*)RPART, (unsigned*)(ctl + CW_CNT), (unsigned*)(ctl + CW_TMO2), (const LAS float*)rt, (LAS float*)(ldsp + EXL_OFF)};
        pg8::gemm_phase<pg8::Epi2, pg8::Sched2, true, true>(ldsp + RING_OFF, g, S, E, wave);
    }

#undef IN
#undef SEAM
}

__global__ void k_mod(const float* c, const float* c_ctx, const float* ada_w, const float* ada_b, float* mod) {
    const int i = blockIdx.x * 256 + threadIdx.x; if (i >= 33 * 3072) return;
    const int b = i / 3072, n = i % 3072; const float* cv = b < 32 ? c + b * 1024 : c_ctx;
    float acc = 0.f;
    for (int k = 0; k < 1024; ++k) acc += siluf(cv[k]) * ada_w[(size_t)k * 3072 + n];
    mod[i] = acc + ada_b[n];
}
__global__ void k_tables(float* rope) {
    const int i = blockIdx.x * 256 + threadIdx.x; if (i >= 1024) return;
    const int p = i >> 4, f = i & 15; const float inv = powf(10000.f, -(float)f / 16.f); const float ang = (float)p * inv;
    rope[i] = cosf(ang); rope[1024 + i] = sinf(ang);
}
__global__ void k_bt1(const float* w_in, bf16* bt1) {
    const size_t i = (size_t)blockIdx.x * 256 + threadIdx.x; if (i >= (size_t)N1 * 1024) return;
    const int v = (int)(i >> 10), k = (int)(i & 1023); const int a = vcol_actual(v);
    bt1[i] = (bf16)(a >= 0 ? f2bf(w_in[(size_t)k * PROJ + a]) : 0u);
}
__global__ void k_bt2(const float* w_out, const float* ssd_g, bf16* bt2) {
    const size_t i = (size_t)blockIdx.x * 256 + threadIdx.x; if (i >= (size_t)1024 * 2048) return;
    const int n = (int)(i >> 11), kk = (int)(i & 2047);
    const float v = kk < 1024 ? w_out[(size_t)(1024 + kk) * 1024 + n] * ssd_g[kk] : w_out[(size_t)(kk - 1024) * 1024 + n];
    bt2[i] = (bf16)f2bf(v);
}
__global__ void k_norm(const float* x, const float* ctx, const float* norm_g, const float* mod, bf16* H) {
    const int row = blockIdx.x * 4 + (threadIdx.x >> 6), lane = threadIdx.x & 63; if (row >= MT) return;
    const float* xr = row < ML ? x + (size_t)row * DM : ctx + (size_t)(row - ML) * DM;
    const float* md = mod + (size_t)(row < ML ? row / SEQ : 32) * 3072;
    float v[16]; float s = 0.f;
    for (int j = 0; j < 16; ++j) { v[j] = xr[lane + 64 * j]; s += v[j] * v[j]; }
    for (int o = 1; o < 64; o <<= 1) s += __shfl_xor(s, o);
    const float rstd = rsqrtf(s * (1.f / DM) + EPS);
    for (int j = 0; j < 16; ++j) { const int k = lane + 64 * j; const float h = v[j] * rstd * norm_g[k] * (1.f + md[1024 + k]) + md[k]; H[(size_t)row * DM + k] = (bf16)f2bf(h); }
}
__global__ __launch_bounds__(256) void k_gemm1(const bf16* H, const bf16* bt1, const float* rope, const float* qg, const float* kg, const float* dt_bias,
                                                bf16* KB, bf16* VB, bf16* XBC, float* DT, bf16* YQ, bf16* Z) {
    __shared__ float As[32][65];
    __shared__ float Ps[32][257];
    const int pn = blockIdx.x, rt = blockIdx.y, tid = threadIdx.x; const int row0 = rt * 32;
    if (row0 >= ML && pn > 8) return;
    float acc[32];
    for (int r = 0; r < 32; ++r) acc[r] = 0.f;
    const bf16* bp = bt1 + (size_t)(pn * 256 + tid) * 1024;
    for (int k0 = 0; k0 < 1024; k0 += 64) {
        __syncthreads();
        for (int e = tid; e < 32 * 64; e += 256) { const int r = e >> 6, kk = e & 63; As[r][kk] = bf2f(H[(size_t)(row0 + r) * DM + k0 + kk]); }
        __syncthreads();
        for (int kk = 0; kk < 64; ++kk) { const float b = bf2f(bp[k0 + kk]);
            for (int r = 0; r < 32; ++r) acc[r] += As[r][kk] * b; }
    }
    for (int r = 0; r < 32; ++r) Ps[r][tid] = acc[r];
    __syncthreads();
    const bool isctx = row0 >= ML;
    if (pn == 0 || (pn >= 9 && pn < 13)) {
        {
            const int r = tid >> 3, hd = (tid >> 1) & 3, ax = tid & 1, row = row0 + r; const float* g = pn == 0 ? kg : qg;
            float s = 0.f;
            for (int d = 0; d < 32; ++d) { const float v = Ps[r][hperm_inv(hd, ax * 32 + d)]; s += v * v; }
            s += __shfl_xor(s, 1);
            const float rstd = rsqrtf(s * (1.f / 64.f) + EPS);
            const int t = row % SEQ, p = ax == 0 ? (t >> 6) : (t & 63);
            bf16* dst; float osc = 1.f;
            if (pn == 0) { const int b = isctx ? (row - ML) / CTXL : row / SEQ, pos = isctx ? SEQ + (row - ML) % CTXL : row % SEQ; dst = KB + ((size_t)b * KVL + pos) * 256 + hd * 64 + ax * 32; }
            else { dst = YQ + (size_t)row * 2048 + 1024 + ((pn - 9) * 4 + hd) * 64 + ax * 32; osc = C2; }
            for (int f = 0; f < 16; ++f) {
                const float x1 = Ps[r][hperm_inv(hd, ax * 32 + f)] * rstd * g[ax * 32 + f], x2 = Ps[r][hperm_inv(hd, ax * 32 + 16 + f)] * rstd * g[ax * 32 + 16 + f];
                float o1 = x1, o2 = x2;
                if (!isctx) { const float cs = rope[p * 16 + f], sn = rope[1024 + p * 16 + f]; o1 = x1 * cs - x2 * sn; o2 = x2 * cs + x1 * sn; }
                dst[f] = (bf16)f2bf(o1 * osc); dst[16 + f] = (bf16)f2bf(o2 * osc);
            }
        }
    } else {
        for (int r = 0; r < 32; ++r) { const int row = row0 + r; const float v = Ps[r][tid];
            if (pn == 1) { const int b = isctx ? (row - ML) / CTXL : row / SEQ, pos = isctx ? SEQ + (row - ML) % CTXL : row % SEQ;
                VB[((size_t)b * KVL + pos) * 256 + tid] = (bf16)f2bf(v); }
            else if (pn < 8) XBC[(size_t)row * CONVC + (pn - 2) * 256 + tid] = (bf16)f2bf(v);
            else if (pn == 8) { if (tid < 32) DT[(size_t)row * 32 + tid] = softplusf(v + dt_bias[tid]); }
            else if (pn < 17) YQ[(size_t)row * 2048 + (pn - 13) * 256 + tid] = (bf16)f2bf(siluf(v));
            else Z[(size_t)row * 1024 + (pn - 17) * 256 + tid] = (bf16)f2bf(siluf(v)); }
    }
}
__global__ __launch_bounds__(256) void k_attn(bf16* YQ, const bf16* KB, const bf16* VB) {
    __shared__ float Qs[64][65]; __shared__ float Ks[64][65]; __shared__ float Ps[64][65]; __shared__ bf16 Vs[64][66];
    const int qb = blockIdx.x, h = blockIdx.y, b = blockIdx.z, tid = threadIdx.x, ty = tid >> 4, tx = tid & 15;
    const size_t row0 = (size_t)b * SEQ + qb * 64; const int kvh = h >> 2;
    for (int e = tid; e < 4096; e += 256) { const int r = e >> 6, d = e & 63; Qs[r][d] = bf2f(YQ[(row0 + r) * 2048 + 1024 + h * 64 + d]); }
    float o[4][4], l[4];
    for (int i = 0; i < 4; ++i) { l[i] = 0.f; for (int j = 0; j < 4; ++j) o[i][j] = 0.f; }
    for (int kt = 0; kt < KVL / 64; ++kt) {
        __syncthreads();
        for (int e = tid; e < 4096; e += 256) { const int r = e >> 6, d = e & 63; const size_t src = ((size_t)b * KVL + kt * 64 + r) * 256 + kvh * 64 + d;
            Ks[r][d] = bf2f(KB[src]); Vs[r][d] = VB[src]; }
        __syncthreads();
        float s[4][4];
        for (int i = 0; i < 4; ++i) for (int j = 0; j < 4; ++j) s[i][j] = 0.f;
        for (int d = 0; d < 64; ++d) { float a[4], k4[4];
            for (int i = 0; i < 4; ++i) { a[i] = Qs[ty * 4 + i][d]; k4[i] = Ks[tx * 4 + i][d]; }
            for (int i = 0; i < 4; ++i) for (int j = 0; j < 4; ++j) s[i][j] += a[i] * k4[j]; }
        for (int i = 0; i < 4; ++i) for (int j = 0; j < 4; ++j) Ps[ty * 4 + i][tx * 4 + j] = exp2f(s[i][j]);
        __syncthreads();
        for (int key = 0; key < 64; ++key) { float p[4], v4[4];
            for (int i = 0; i < 4; ++i) { p[i] = Ps[ty * 4 + i][key]; v4[i] = bf2f(Vs[key][tx * 4 + i]); }
            for (int i = 0; i < 4; ++i) { l[i] += p[i]; for (int j = 0; j < 4; ++j) o[i][j] += p[i] * v4[j]; } }
    }
    for (int i = 0; i < 4; ++i) for (int j = 0; j < 4; ++j) { const size_t row = row0 + ty * 4 + i; const int d = tx * 4 + j;
        const float ga = bf2f(YQ[row * 2048 + h * 64 + d]);
        YQ[row * 2048 + 1024 + h * 64 + d] = (bf16)f2bf(o[i][j] / l[i] * ga); }
}
__global__ void k_conv(const bf16* XBC, const float* cw, const float* cb, bf16* XC) {
    const size_t i = (size_t)blockIdx.x * 256 + threadIdx.x; if (i >= (size_t)MT * CONVC) return;
    const int row = (int)(i / CONVC), ch = (int)(i % CONVC);
    int t, len; if (row < ML) { t = row % SEQ; len = SEQ; } else { t = (row - ML) % CTXL; len = CTXL; }
    float acc = cb[ch];
    for (int j = 0; j < 5; ++j) { const int tt = t + j - 2; if (tt >= 0 && tt < len) acc += cw[j * CONVC + ch] * bf2f(XBC[(size_t)(row + j - 2) * CONVC + ch]); }
    XC[i] = (bf16)f2bf(siluf(acc));
}
__global__ __launch_bounds__(512) void k_ssd(const bf16* XC, const float* DT, const bf16* Z, const float* a_log, const float* d_skip, bf16* YQ, float* SSQ) {
    __shared__ float ysq[64];
    const int h = blockIdx.x, b = blockIdx.y, tid = threadIdx.x, p = tid >> 3, nc = tid & 7, g = h >> 3;
    for (int dd = 0; dd < 2; ++dd) { const int d = 1 - dd;
        const float a_neg = -expf(a_log[d * 16 + h]);
        float S[16];
        for (int j = 0; j < 16; ++j) S[j] = 0.f;
        for (int seq = 0; seq < 2; ++seq) { const int len = seq == 0 ? CTXL : SEQ; const size_t rbase = seq == 0 ? (size_t)ML + (size_t)b * CTXL : (size_t)b * SEQ;
            for (int st = 0; st < len; ++st) { const int t = d ? len - 1 - st : st; const size_t row = rbase + t;
                const float dt = DT[row * 32 + d * 16 + h]; const float dec = expf(dt * a_neg);
                const float xs = bf2f(XC[row * CONVC + h * 64 + p]); const float X = xs * dt;
                const bf16* Bp = XC + row * CONVC + 1024 + g * 128 + nc * 16; const bf16* Cp = Bp + 256;
                float y = 0.f;
                for (int j = 0; j < 16; ++j) { S[j] = S[j] * dec + X * bf2f(Bp[j]); y += bf2f(Cp[j]) * S[j]; }
                y += __shfl_xor(y, 1); y += __shfl_xor(y, 2); y += __shfl_xor(y, 4);
                if (seq == 1) {
                    bf16* yp = YQ + row * 2048 + h * 64 + p;
                    if (d == 1) { if (nc == 0) *yp = (bf16)f2bf(y); }
                    else {
                        float yg = 0.f;
                        if (nc == 0) { const float yt = y + bf2f(*yp) + d_skip[h] * xs; yg = yt * bf2f(Z[row * 1024 + h * 64 + p]); *yp = (bf16)f2bf(yg); ysq[p] = yg * yg; }
                        __syncthreads();
                        if (tid < 64) { float q = ysq[tid]; for (int o = 1; o < 64; o <<= 1) q += __shfl_xor(q, o); if (tid == 0) SSQ[row * 16 + h] = q; }
                        __syncthreads();
                    }
                }
            }
        }
    }
}
__global__ __launch_bounds__(256) void k_gemm2(const bf16* YQ, const bf16* bt2, const float* SSQ, const float* x, const float* mod, float* out, float* RPART) {
    __shared__ float As[32][65]; __shared__ float red[32][4];
    const int pn = blockIdx.x, rt = blockIdx.y, tid = threadIdx.x, row0 = rt * 32;
    float acc[32];
    for (int r = 0; r < 32; ++r) acc[r] = 0.f;
    const bf16* bp = bt2 + (size_t)(pn * 256 + tid) * 2048;
    for (int k0 = 0; k0 < 2048; k0 += 64) {
        if (k0 == 1024) { for (int r = 0; r < 32; ++r) { float s = 0.f; for (int j = 0; j < 16; ++j) s += SSQ[(size_t)(row0 + r) * 16 + j]; acc[r] *= rsqrtf(s * (1.f / 1024.f) + EPS); } }
        __syncthreads();
        for (int e = tid; e < 32 * 64; e += 256) { const int r = e >> 6, kk = e & 63; As[r][kk] = bf2f(YQ[(size_t)(row0 + r) * 2048 + k0 + kk]); }
        __syncthreads();
        for (int kk = 0; kk < 64; ++kk) { const float bv = bf2f(bp[k0 + kk]);
            for (int r = 0; r < 32; ++r) acc[r] += As[r][kk] * bv; }
    }
    const int n = pn * 256 + tid;
    for (int r = 0; r < 32; ++r) { const int row = row0 + r; const float v = x[(size_t)row * DM + n] + mod[(size_t)(row / SEQ) * 3072 + 2048 + n] * acc[r];
        out[(size_t)row * DM + n] = v; float q = v * v;
        for (int o = 1; o < 64; o <<= 1) q += __shfl_xor(q, o);
        if ((tid & 63) == 0) RPART[(size_t)row * 16 + pn * 4 + (tid >> 6)] = q; }
}
__global__ void k_final(float* out, const float* RPART, const float* fg) {
    const int row = blockIdx.x * 4 + (threadIdx.x >> 6), lane = threadIdx.x & 63;
    float s = 0.f;
    for (int j = 0; j < 16; ++j) s += RPART[(size_t)row * 16 + j];
    const float rstd = rsqrtf(s * (1.f / DM) + EPS);
    for (int j = 0; j < 16; ++j) { const int k = lane + 64 * j; out[(size_t)row * DM + k] *= rstd * fg[k]; }
}


#ifndef FAST_MASK
#define FAST_MASK 0x7f
#endif
extern "C" void kernel_launch(void* const* d_in, const int* in_sizes, int n_in, void* d_out, int out_size, void* d_ws, size_t ws_size, hipStream_t stream) {
    if (n_in != 18 || out_size != ML * DM || ws_size < WS_END) { fprintf(stderr, "kernel_launch: unexpected shapes (n_in %d out %d ws %zu)\n", n_in, out_size, ws_size); return; }
    static int grid = 0;
    if (grid == 0) {
        int dev = 0, cus = 0;
        if (hipGetDevice(&dev) != hipSuccess || hipDeviceGetAttribute(&cus, hipDeviceAttributeMultiprocessorCount, dev) != hipSuccess) { fprintf(stderr, "kernel_launch: device query failed\n"); grid = -1; return; }
        if (hipFuncSetAttribute((const void*)mega, hipFuncAttributeMaxDynamicSharedMemorySize, LDS_BYTES) != hipSuccess) { fprintf(stderr, "kernel_launch: hipFuncSetAttribute failed\n"); grid = -1; return; }
        int per_cu = 0;
        if (hipOccupancyMaxActiveBlocksPerMultiprocessor(&per_cu, (const void*)mega, NWAVES * 64, LDS_BYTES) != hipSuccess || per_cu < 1) fprintf(stderr, "kernel_launch: note: occupancy query says %d blocks/CU\n", per_cu);
        (void)hipGetLastError();
        grid = cus;
    }
    if (grid < 0) return;
    const float* x = (const float*)d_in[0]; const float* c = (const float*)d_in[1]; const float* ctx = (const float*)d_in[2]; const float* c_ctx = (const float*)d_in[3];
    const float* ada_w = (const float*)d_in[4]; const float* ada_b = (const float*)d_in[5]; const float* norm_g = (const float*)d_in[6]; const float* w_in = (const float*)d_in[7];
    const float* conv_w = (const float*)d_in[8]; const float* conv_b = (const float*)d_in[9]; const float* dt_bias = (const float*)d_in[10]; const float* a_log = (const float*)d_in[11];
    const float* d_skip = (const float*)d_in[12]; const float* qg = (const float*)d_in[13]; const float* kg = (const float*)d_in[14]; const float* ssd_g = (const float*)d_in[15];
    const float* w_out = (const float*)d_in[16]; const float* final_g = (const float*)d_in[17];
    unsigned char* ws = (unsigned char*)d_ws; float* out = (float*)d_out;
    float* mod = (float*)(ws + WS_MOD); float* rope = (float*)(ws + WS_ROPE); float* SSQ = (float*)(ws + WS_SSQ); float* RPART = (float*)(ws + WS_RPART);
    bf16* bt1 = (bf16*)(ws + WS_BT1); bf16* bt2 = (bf16*)(ws + WS_BT2); float* DT = (float*)(ws + WS_DT); bf16* KB = (bf16*)(ws + WS_KB); bf16* VB = (bf16*)(ws + WS_VB);
    bf16* H = (bf16*)(ws + WS_R1); bf16* XC = (bf16*)(ws + WS_R1); bf16* XBC = (bf16*)(ws + WS_XBC); bf16* YQ = (bf16*)(ws + WS_YQ); bf16* Z = (bf16*)(ws + WS_Z);
    (void)hipMemsetAsync(ws + WS_CTL, 0, 1 * MiB, stream);
    Args a{};
    for (int i = 0; i < 18; ++i) a.in[i] = (const float*)d_in[i];
    a.out = out; a.ws = ws;
    for (int ph = 0; ph < NPHASE;) {
        if ((FAST_MASK >> ph) & 1) { int e = ph; while (e < NPHASE && ((FAST_MASK >> e) & 1)) ++e;
            a.ph_lo = ph; a.ph_hi = e; hipLaunchKernelGGL(mega, dim3(grid), dim3(NWAVES * 64), LDS_BYTES, stream, a);
            const hipError_t le = hipPeekAtLastError(); if (le != hipSuccess) fprintf(stderr, "kernel_launch: mega launch failed: %s\n", hipGetErrorName(le));
            ph = e; continue; }
        switch (ph) {
        case 0: k_mod<<<(33 * 3072 + 255) / 256, 256, 0, stream>>>(c, c_ctx, ada_w, ada_b, mod); k_tables<<<4, 256, 0, stream>>>(rope);
                k_bt1<<<(N1 * 1024) / 256, 256, 0, stream>>>(w_in, bt1); k_bt2<<<(1024 * 2048) / 256, 256, 0, stream>>>(w_out, ssd_g, bt2); break;
        case 1: k_norm<<<MT / 4, 256, 0, stream>>>(x, ctx, norm_g, mod, H); break;
        case 2: k_gemm1<<<dim3(21, MT / 32), 256, 0, stream>>>(H, bt1, rope, qg, kg, dt_bias, KB, VB, XBC, DT, YQ, Z); break;
        case 3: k_attn<<<dim3(SEQ / 64, 16, NB), 256, 0, stream>>>(YQ, KB, VB); k_conv<<<(unsigned)(((size_t)MT * CONVC + 255) / 256), 256, 0, stream>>>(XBC, conv_w, conv_b, XC); break;
        case 4: k_ssd<<<dim3(16, NB), 512, 0, stream>>>(XC, DT, Z, a_log, d_skip, YQ, SSQ); break;
        case 5: k_gemm2<<<dim3(4, ML / 32), 256, 0, stream>>>(YQ, bt2, SSQ, x, mod, out, RPART); break;
        case 6: k_final<<<ML / 4, 256, 0, stream>>>(out, RPART, final_g); break;
        }
        ++ph;
    }
}
```

```cpp
#include <hip/hip_runtime.h>
#include <cstdio>
#include <cstdint>
#include <hip/hip_bf16.h>

constexpr int DM = 1024, NB = 32, SEQ = 2048, CTXL = 256, KVL = SEQ + CTXL;
constexpr int ML = NB * SEQ, MC = NB * CTXL, MT = ML + MC;
constexpr int PROJ = 5152, OFF_XBC = 512, OFF_DT = 2048, CTXC = 2080, CONVC = 1536;
constexpr int N1 = 21 * 256;
constexpr float EPS = 1e-6f;
constexpr float C2 = 0.125f * 1.4426950408889634f;

typedef unsigned short bf16;
__device__ __forceinline__ int mk_lane() { return (int)__builtin_amdgcn_mbcnt_hi(~0u, __builtin_amdgcn_mbcnt_lo(~0u, 0u)); }
__host__ __device__ __forceinline__ unsigned f2bf(float f) { unsigned u = __builtin_bit_cast(unsigned, f); return (u + 0x7fffu + ((u >> 16) & 1u)) >> 16; }
__host__ __device__ __forceinline__ float bf2f(unsigned h) { return __builtin_bit_cast(float, (h & 0xffffu) << 16); }
__device__ __forceinline__ float siluf(float v) { return v / (1.f + __expf(-v)); }
__device__ __forceinline__ float softplusf(float v) { return v > 20.f ? v : log1pf(expf(v)); }

constexpr size_t MiB = 1u << 20;
constexpr size_t WS_CTL = 0;
constexpr size_t WS_MOD = 2 * MiB;
constexpr size_t WS_ROPE = 3 * MiB;
constexpr size_t WS_SSQ = 4 * MiB;
constexpr size_t WS_RPART = 8 * MiB;
constexpr size_t WS_BT1 = 12 * MiB;
constexpr size_t WS_BT2 = 23 * MiB;
constexpr size_t WS_DT = 28 * MiB;
constexpr size_t WS_KB = 38 * MiB;
constexpr size_t WS_VB = 74 * MiB;
constexpr size_t WS_R1 = 110 * MiB;
constexpr size_t WS_XBC = 326 * MiB;
constexpr size_t WS_YQ = 542 * MiB;
constexpr size_t WS_Z = 798 * MiB;
constexpr size_t WS_END = 926 * MiB;

__host__ __device__ __forceinline__ int hperm_dim(int vin) {
    const int bj = vin >> 7, wc = (vin >> 5) & 3, s = vin & 31, fq = s >> 3, e = s & 7;
    return wc * 64 + bj * 32 + (e >> 2) * 16 + 4 * fq + (e & 3);
}
__host__ __device__ __forceinline__ int hperm_inv(int head, int dim) {
    const int axis = dim >> 5, half = (dim >> 4) & 1, i16 = dim & 15, fq = i16 >> 2, e = (i16 & 3) + 4 * half;
    return 128 * axis + 32 * head + 8 * fq + e;
}
__host__ __device__ __forceinline__ int vcol_actual(int v) {
    const int t = v >> 8, vin = v & 255;
    if (t == 0) return hperm_dim(vin);
    if (t == 1) return 256 + vin;
    if (t < 8) return v;
    if (t == 8) return vin < 32 ? OFF_DT + vin : -1;
    if (t < 13) return CTXC + (t - 9) * 256 + hperm_dim(vin);
    if (t < 17) return CTXC + 1024 + (v - 13 * 256);
    return CTXC + 2048 + (v - 17 * 256);
}

namespace pg8 {
#define PG8_LAS __attribute__((address_space(3)))
typedef unsigned short bf16_t;
typedef short bf16x8 __attribute__((ext_vector_type(8)));
typedef float f32x4 __attribute__((ext_vector_type(4)));
typedef unsigned u32x4 __attribute__((ext_vector_type(4)));
constexpr int BM = 256, BK = 64, HALF = 128, HTB = HALF * BK * 2  , STAGE_BYTES = 8 * HTB, NXCD = 8, WGM = 8;

__host__ __device__ __forceinline__ int lds_byte(int r, int c) { const int st = (r >> 4) * 2 + (c >> 5), rr = r & 15, cc = c & 31, ob = rr * 64 + cc * 2; return st * 1024 + (ob ^ (((ob >> 9) & 1) << 5)); }
__host__ __device__ __forceinline__ void stage_rc(int b, int& R, int& C) { const int st = b / 1024, sb = b % 1024, swz = sb ^ (((sb >> 9) & 1) << 5); R = (st >> 1) * 16 + swz / 64; C = (st & 1) * 32 + (swz % 64) / 2; }
__host__ __device__ __forceinline__ int perm32(int rho) { const int n = rho >> 4, i = rho & 15; return 8 * (i >> 2) + 4 * n + (i & 3); }

struct Unit { int pm, pn; };
struct Gemm { const bf16_t* A; const bf16_t* Bt; int M, N, K; };

__device__ __forceinline__ unsigned cvt_pk_bf16(float lo, float hi) { unsigned r; asm volatile("v_cvt_pk_bf16_f32 %0, %1, %2" : "=v"(r) : "v"(lo), "v"(hi)); return r; }
typedef float f32x2 __attribute__((ext_vector_type(2)));
template <class Epi, class Sched, bool ALIGN_EPI = false, bool SP2 = false>
__device__ __forceinline__ void gemm_phase(PG8_LAS unsigned char* lds, const Gemm g, const Sched& S, const Epi& E, int wid_in) {
    const int wid = wid_in; int lane = mk_lane(); asm volatile("" : "+v"(lane)); const int tid = wid * 64 + lane, wr = wid >> 2, wc = wid & 3, fr = lane & 15, fq = lane >> 4;
    const int K = g.K, nt = K / BK;
    unsigned voffA[2], voffB[2];
#pragma unroll
    for (int i = 0; i < 2; ++i) { int R, C; stage_rc(tid * 16 + i * 8192, R, C); const int Rb = Epi::PERM ? ((R & ~31) + perm32(R & 31)) : R;
        voffA[i] = (unsigned)(R * K + C) * 2u; voffB[i] = (unsigned)(Rb * K + C) * 2u; }
    const size_t kstep = (size_t)(BK * 2);
    const size_t hstep = (size_t)HALF * K * 2;
    const size_t tstep = 2 * hstep;
    const unsigned ldsw = (unsigned)wid * 1024u;
    const int aoff = lds_byte(wr * 64 + fr, fq * 8), boff = lds_byte(wc * 32 + fr, fq * 8);
#define PG8_SA(b, h) (((b) * 2 + (h)) * HTB)
#define PG8_SB(b, h) ((4 + (b) * 2 + (h)) * HTB)
#define PG8_STAGE(bufoff, gbase, voff) do { _Pragma("unroll") for (int _i = 0; _i < 2; ++_i) \
        __builtin_amdgcn_global_load_lds((const unsigned*)((const char*)(gbase) + (voff)[_i]), (PG8_LAS unsigned*)(lds + (bufoff) + ldsw + _i * 8192), 16, 0, 0); } while (0)
#define PG8_LDA(dst, b, h) do { _Pragma("unroll") for (int m = 0; m < 4; ++m) _Pragma("unroll") for (int k = 0; k < 2; ++k) dst[m][k] = *(const PG8_LAS bf16x8*)(lds + PG8_SA(b, h) + aoff + m * 2048 + k * 1024); } while (0)
#define PG8_LDB(dst, b, h) do { _Pragma("unroll") for (int n = 0; n < 2; ++n) _Pragma("unroll") for (int k = 0; k < 2; ++k) dst[n][k] = *(const PG8_LAS bf16x8*)(lds + PG8_SB(b, h) + boff + n * 2048 + k * 1024); } while (0)
#define PG8_MMA(ai, bj, At, Bt) do { __builtin_amdgcn_s_setprio(1); _Pragma("unroll") for (int m = 0; m < 4; ++m) _Pragma("unroll") for (int n = 0; n < 2; ++n) _Pragma("unroll") for (int k = 0; k < 2; ++k) \
        acc[ai][bj][m][n] = __builtin_amdgcn_mfma_f32_16x16x32_bf16(Bt[n][k], At[m][k], acc[ai][bj][m][n], 0, 0, 0); __builtin_amdgcn_s_setprio(0); } while (0)
#define PG8_WAIT_V(n) asm volatile("s_waitcnt vmcnt(" #n ")" ::: "memory")
#define PG8_WAIT_L(n) asm volatile("s_waitcnt lgkmcnt(" #n ")" ::: "memory")
#define PG8_BAR __builtin_amdgcn_s_barrier()
#define PG8_SCHED __builtin_amdgcn_sched_barrier(0)
    Unit cur, nxt; int ui = 0;
    if (!S.next(0, cur)) return;
    f32x4 acc[2][2][4][2];
#pragma unroll
    for (int a = 0; a < 2; ++a)
#pragma unroll
        for (int b = 0; b < 2; ++b)
#pragma unroll
            for (int m = 0; m < 4; ++m)
#pragma unroll
                for (int n = 0; n < 2; ++n) acc[a][b][m][n] = (f32x4){0.f, 0.f, 0.f, 0.f};
    bf16x8 At[4][2], B0[2][2], B1[2][2];
    const char* cA = (const char*)g.A + (size_t)cur.pm * tstep; const char* cB = (const char*)g.Bt + (size_t)cur.pn * tstep;
    S.a_ready(cur);
    if constexpr (SP2) {
        PG8_STAGE(PG8_SB(0, 0), cB, voffB); PG8_STAGE(PG8_SB(0, 1), cB + hstep, voffB); PG8_STAGE(PG8_SA(0, 0), cA, voffA); PG8_STAGE(PG8_SA(0, 1), cA + hstep, voffA);
        if (wr == 1) PG8_BAR;
        PG8_WAIT_V(2); PG8_BAR;
        PG8_STAGE(PG8_SB(1, 0), cB + kstep, voffB); PG8_STAGE(PG8_SA(1, 0), cA + kstep, voffA); PG8_STAGE(PG8_SB(1, 1), cB + hstep + kstep, voffB);
        PG8_WAIT_V(6); PG8_BAR;
    } else {
        PG8_STAGE(PG8_SB(0, 0), cB, voffB); PG8_STAGE(PG8_SA(0, 0), cA, voffA); PG8_STAGE(PG8_SB(0, 1), cB + hstep, voffB); PG8_STAGE(PG8_SA(0, 1), cA + hstep, voffA);
        if (wr == 1) PG8_BAR;
        PG8_WAIT_V(4); PG8_BAR;
        PG8_STAGE(PG8_SB(1, 0), cB + kstep, voffB); PG8_STAGE(PG8_SA(1, 0), cA + kstep, voffA); PG8_STAGE(PG8_SB(1, 1), cB + hstep + kstep, voffB);
        PG8_WAIT_V(6); PG8_BAR;
    }
    for (;;) {
        const bool has_next = S.next(ui + 1, nxt);
        const char* nA = has_next ? (const char*)g.A + (size_t)nxt.pm * tstep : cA; const char* nB = has_next ? (const char*)g.Bt + (size_t)nxt.pn * tstep : cB;
        for (int t = 0; t < nt; t += 2) {
            if constexpr (Epi::MIDK) { if (t == nt / 2) E.midk(acc, ui, wr, fr); }
            const bool last = (t == nt - 2);
            const char* a1 = cA + (size_t)(t + 1) * kstep;
            const char* a2 = last ? nA : cA + (size_t)(t + 2) * kstep; const char* b2 = last ? nB : cB + (size_t)(t + 2) * kstep;
            const char* a3 = a2 + kstep; const char* b3 = b2 + kstep;
            if (last && has_next) S.a_ready(nxt);
            if constexpr (SP2) {
            PG8_LDB(B0, 0, 0); PG8_LDB(B1, 0, 1); PG8_SCHED; PG8_LDA(At, 0, 0); PG8_STAGE(PG8_SA(1, 1), a1 + hstep, voffA);
            PG8_WAIT_V(8); PG8_WAIT_L(0); PG8_BAR; PG8_MMA(0, 0, At, B0); PG8_MMA(0, 1, At, B1); PG8_BAR; PG8_SCHED;
            PG8_LDA(At, 0, 1); PG8_STAGE(PG8_SB(0, 0), b2, voffB); PG8_STAGE(PG8_SB(0, 1), b2 + hstep, voffB); PG8_STAGE(PG8_SA(0, 0), a2, voffA);
            PG8_WAIT_V(8); PG8_WAIT_L(0); PG8_BAR; PG8_MMA(1, 0, At, B0); PG8_MMA(1, 1, At, B1); PG8_BAR; PG8_SCHED;
            PG8_LDB(B0, 1, 0); PG8_LDB(B1, 1, 1); PG8_SCHED; PG8_LDA(At, 1, 0); PG8_STAGE(PG8_SA(0, 1), a2 + hstep, voffA);
            PG8_WAIT_V(8); PG8_WAIT_L(0); PG8_BAR; PG8_MMA(0, 0, At, B0); PG8_MMA(0, 1, At, B1); PG8_BAR; PG8_SCHED;
            PG8_LDA(At, 1, 1); PG8_STAGE(PG8_SB(1, 0), b3, voffB); PG8_STAGE(PG8_SB(1, 1), b3 + hstep, voffB); PG8_STAGE(PG8_SA(1, 0), a3, voffA);
            PG8_WAIT_V(8); PG8_WAIT_L(0); PG8_BAR; PG8_MMA(1, 0, At, B0); PG8_MMA(1, 1, At, B1); PG8_BAR; PG8_SCHED;
            } else {
            PG8_LDB(B0, 0, 0); PG8_SCHED; PG8_LDA(At, 0, 0); PG8_STAGE(PG8_SA(1, 1), a1 + hstep, voffA);
            PG8_WAIT_L(8); PG8_BAR; PG8_WAIT_L(0); PG8_MMA(0, 0, At, B0); PG8_BAR; PG8_SCHED;
            PG8_LDB(B1, 0, 1); PG8_STAGE(PG8_SB(0, 0), b2, voffB);
            PG8_BAR; PG8_WAIT_L(0); PG8_MMA(0, 1, At, B1); PG8_BAR;
            PG8_LDA(At, 0, 1); PG8_STAGE(PG8_SA(0, 0), a2, voffA);
            PG8_BAR; PG8_WAIT_L(0); PG8_MMA(1, 0, At, B0); PG8_BAR; PG8_SCHED;
            PG8_STAGE(PG8_SB(0, 1), b2 + hstep, voffB);
            PG8_WAIT_V(6); PG8_BAR; PG8_MMA(1, 1, At, B1); PG8_BAR;
            PG8_LDB(B0, 1, 0); PG8_SCHED; PG8_LDA(At, 1, 0); PG8_STAGE(PG8_SA(0, 1), a2 + hstep, voffA);
            PG8_WAIT_L(8); PG8_BAR; PG8_WAIT_L(0); PG8_MMA(0, 0, At, B0); PG8_BAR; PG8_SCHED;
            PG8_LDB(B1, 1, 1); PG8_STAGE(PG8_SB(1, 0), b3, voffB);
            PG8_BAR; PG8_WAIT_L(0); PG8_MMA(0, 1, At, B1); PG8_BAR;
            PG8_LDA(At, 1, 1); PG8_STAGE(PG8_SA(1, 0), a3, voffA);
            PG8_BAR; PG8_WAIT_L(0); PG8_MMA(1, 0, At, B0); PG8_BAR; PG8_SCHED;
            PG8_STAGE(PG8_SB(1, 1), b3 + hstep, voffB);
            PG8_WAIT_V(6); PG8_BAR; PG8_MMA(1, 1, At, B1); PG8_BAR;
            }
        }
        if constexpr (ALIGN_EPI) { if (wr == 0) PG8_BAR; }
        if constexpr (!Epi::AFTER_DRAIN) { E(acc, cur, wr, wc, fr, fq); S.done(cur); }
        if (!has_next) break;
#pragma unroll
        for (int a = 0; a < 2; ++a)
#pragma unroll
            for (int b = 0; b < 2; ++b)
#pragma unroll
                for (int m = 0; m < 4; ++m)
#pragma unroll
                    for (int n = 0; n < 2; ++n) acc[a][b][m][n] = (f32x4){0.f, 0.f, 0.f, 0.f};
        cur = nxt; cA = nA; cB = nB; ++ui;
        if constexpr (ALIGN_EPI) { if (wr == 1) PG8_BAR; }
    }
    PG8_WAIT_V(0);
    if constexpr (!ALIGN_EPI) { if (wr == 0) PG8_BAR; }
    PG8_BAR;
    if constexpr (Epi::AFTER_DRAIN) { E.fused(acc, cur, wr, wc, fr, fq, lds, wid, lane); S.done(cur); }
#undef PG8_SA
#undef PG8_SB
#undef PG8_STAGE
#undef PG8_LDA
#undef PG8_LDB
#undef PG8_MMA
#undef PG8_WAIT_V
#undef PG8_WAIT_L
#undef PG8_BAR
#undef PG8_SCHED
}
struct Sched1 {
    int G, c;
    __device__ __forceinline__ void init(int G_, int c_) { G = G_; c = c_; }
    __device__ __forceinline__ bool next(int i, Unit& u) const {
        constexpr int nN = 21, nwg = 256 * nN;
        const int L = i * G + c;
        if (L < nwg) { const int wgid = (L % NXCD) * (nwg / NXCD) + L / NXCD; const int nig = WGM * nN, fm = (wgid / nig) * WGM;
            u.pm = fm + ((wgid % nig) % WGM); u.pn = (wgid % nig) / WGM; return true; }
        const int L2 = L - nwg; if (L2 >= 288) return false;
        const int wg = (L2 % NXCD) * 36 + L2 / NXCD; u.pn = wg >> 5; u.pm = 256 + (wg & 31); return true;
    }
    __device__ __forceinline__ void a_ready(const Unit&) const {}
    __device__ __forceinline__ void done(const Unit&) const {}
};
struct Sched2 {
    int G, c;
    __device__ __forceinline__ void init(int G_, int c_) { G = G_; c = c_; }
    __device__ __forceinline__ bool next(int i, Unit& u) const {
        constexpr int nN = 4, nwg = 256 * nN;
        const int L = i * G + c; if (L >= nwg) return false;
        const int wgid = (L % NXCD) * (nwg / NXCD) + L / NXCD; const int nig = WGM * nN, fm = (wgid / nig) * WGM;
        u.pm = fm + ((wgid % nig) % WGM); u.pn = (wgid % nig) / WGM; return true;
    }
    __device__ __forceinline__ void a_ready(const Unit&) const {}
    __device__ __forceinline__ void done(const Unit&) const {}
};
__device__ __forceinline__ float dot4(const f32x4 a) { return (a[0] * a[0] + a[1] * a[1]) + (a[2] * a[2] + a[3] * a[3]); }
__device__ __forceinline__ float silu1(float v) { return v * __builtin_amdgcn_rcpf(1.f + __expf(-v)); }
typedef unsigned u32x2 __attribute__((ext_vector_type(2)));
__device__ __forceinline__ u32x2 pk4(const f32x4 v) { u32x2 w; w.x = cvt_pk_bf16(v[0], v[1]); w.y = cvt_pk_bf16(v[2], v[3]); return w; }
struct Epi1 {
    static constexpr bool PERM = true, AFTER_DRAIN = false, MIDK = false;
    bf16_t *KB, *VB, *XBC, *YQ, *Z; float* DT; const float *rope, *qg, *kg, *dt_bias;
    __device__ __forceinline__ void midk(f32x4 (&)[2][2][4][2], int, int, int) const {}
    __device__ __forceinline__ void operator()(const f32x4 (&acc)[2][2][4][2], const Unit& u, int wr, int wc, int fr_in, int fq_in) const {
        int fr = fr_in, fq = fq_in; asm volatile("" : "+v"(fr), "+v"(fq));
        const int pn = u.pn, pm = u.pm; const bool isctx = pm >= 256; const int rloc = wr * 64 + fr;
        const int bb = isctx ? pm - 256 : pm >> 3, pos0 = isctx ? SEQ : (pm & 7) * 256;
        if (pn == 0 || (pn >= 9 && pn < 13)) {
            const float* g = pn == 0 ? kg : qg;
            const f32x4 g00 = *(const f32x4*)(g + 4 * fq), g01 = *(const f32x4*)(g + 16 + 4 * fq), g10 = *(const f32x4*)(g + 32 + 4 * fq), g11 = *(const f32x4*)(g + 48 + 4 * fq);
            const float osc = pn == 0 ? 1.f : C2;
            bf16_t* dbase; size_t pitch;
            if (pn == 0) { dbase = KB + ((size_t)bb * KVL + pos0) * 256 + wc * 64 + 4 * fq; pitch = 256; }
            else { dbase = YQ + (size_t)pm * 256 * 2048 + 1024 + ((pn - 9) * 4 + wc) * 64 + 4 * fq; pitch = 2048; }
#pragma unroll
            for (int ai = 0; ai < 2; ++ai) {
                const int prow = (pm & 7) * 4 + 2 * ai + wr;
                f32x4 c0 = (f32x4){1.f, 1.f, 1.f, 1.f}, s0 = (f32x4){0.f, 0.f, 0.f, 0.f};
                if (!isctx) { c0 = *(const f32x4*)(rope + prow * 16 + 4 * fq); s0 = *(const f32x4*)(rope + 1024 + prow * 16 + 4 * fq); }
#pragma unroll
                for (int m = 0; m < 4; ++m) {
                    f32x4 a0 = acc[ai][0][m][0], a1 = acc[ai][0][m][1], b0 = acc[ai][1][m][0], b1 = acc[ai][1][m][1];
                    float s = (dot4(a0) + dot4(a1)) + (dot4(b0) + dot4(b1));
                    s += __shfl_xor(s, 16); s += __shfl_xor(s, 32);
                    const float rstd = rsqrtf(s * (1.f / 64.f) + EPS) * osc;
                    a0 = a0 * rstd * g00; a1 = a1 * rstd * g01; b0 = b0 * rstd * g10; b1 = b1 * rstd * g11;
                    f32x4 c1 = (f32x4){1.f, 1.f, 1.f, 1.f}, s1 = (f32x4){0.f, 0.f, 0.f, 0.f};
                    if (!isctx) { const int pcol = 16 * m + fr; c1 = *(const f32x4*)(rope + pcol * 16 + 4 * fq); s1 = *(const f32x4*)(rope + 1024 + pcol * 16 + 4 * fq); }
                    const f32x4 o00 = a0 * c0 - a1 * s0, o01 = a1 * c0 + a0 * s0, o10 = b0 * c1 - b1 * s1, o11 = b1 * c1 + b0 * s1;
                    bf16_t* dst = dbase + (size_t)(rloc + 128 * ai + 16 * m) * pitch;
                    *(u32x2*)(dst) = pk4(o00); *(u32x2*)(dst + 16) = pk4(o01); *(u32x2*)(dst + 32) = pk4(o10); *(u32x2*)(dst + 48) = pk4(o11);
                    asm volatile("" ::: "memory");
                }
            }
        } else if (pn == 8) {
            if (wc == 0) {
                const f32x4 bA = *(const f32x4*)(dt_bias + 8 * fq), bB = *(const f32x4*)(dt_bias + 8 * fq + 4);
#pragma unroll
                for (int ai = 0; ai < 2; ++ai)
#pragma unroll
                    for (int m = 0; m < 4; ++m) { const size_t row = (size_t)pm * 256 + rloc + 128 * ai + 16 * m;
                        f32x4 v0 = acc[ai][0][m][0] + bA, v1 = acc[ai][0][m][1] + bB;
#pragma unroll
                        for (int e = 0; e < 4; ++e) { v0[e] = v0[e] > 20.f ? v0[e] : log1pf(__expf(v0[e])); v1[e] = v1[e] > 20.f ? v1[e] : log1pf(__expf(v1[e])); }
                        *(f32x4*)(DT + row * 32 + 8 * fq) = v0; *(f32x4*)(DT + row * 32 + 8 * fq + 4) = v1; asm volatile("" ::: "memory"); }
            }
        } else {
            bf16_t* dbase; size_t pitch; bool act = false;
            const int cin = wc * 32 + 8 * fq;
            if (pn == 1) { dbase = VB + ((size_t)bb * KVL + pos0) * 256 + cin; pitch = 256; }
            else if (pn < 8) { dbase = XBC + (size_t)pm * 256 * CONVC + (pn - 2) * 256 + cin; pitch = CONVC; }
            else if (pn < 17) { dbase = YQ + (size_t)pm * 256 * 2048 + (pn - 13) * 256 + cin; pitch = 2048; act = true; }
            else { dbase = Z + (size_t)pm * 256 * 1024 + (pn - 17) * 256 + cin; pitch = 1024; act = true; }
#pragma unroll
            for (int ai = 0; ai < 2; ++ai)
#pragma unroll
                for (int m = 0; m < 4; ++m) { bf16_t* dst = dbase + (size_t)(rloc + 128 * ai + 16 * m) * pitch;
#pragma unroll
                    for (int bj = 0; bj < 2; ++bj) { f32x4 v0 = acc[ai][bj][m][0], v1 = acc[ai][bj][m][1];
                        if (act) {
#pragma unroll
                            for (int e = 0; e < 4; ++e) { v0[e] = silu1(v0[e]); v1[e] = silu1(v1[e]); } }
                        u32x4 w; w.x = cvt_pk_bf16(v0[0], v0[1]); w.y = cvt_pk_bf16(v0[2], v0[3]); w.z = cvt_pk_bf16(v1[0], v1[1]); w.w = cvt_pk_bf16(v1[2], v1[3]);
                        *(u32x4*)(dst + bj * HALF) = w; } asm volatile("" ::: "memory"); }
        }
    }
};
struct Epi2 {
    static constexpr bool PERM = false, AFTER_DRAIN = false, MIDK = true;
    const float* x; const float* mod; const float* fg; float* out; unsigned long long* xbuf; unsigned* cnt; unsigned* tmo; const PG8_LAS float* rstd_tab; PG8_LAS float* exl;
    __device__ __forceinline__ void midk(f32x4 (&acc)[2][2][4][2], int ui, int wr, int fr) const {
#pragma unroll
        for (int ai = 0; ai < 2; ++ai)
#pragma unroll
            for (int m = 0; m < 4; ++m) { const float r = rstd_tab[ui * 256 + 128 * ai + 64 * wr + 16 * m + fr];
#pragma unroll
                for (int bj = 0; bj < 2; ++bj)
#pragma unroll
                    for (int n = 0; n < 2; ++n) acc[ai][bj][m][n] *= r; }
    }
    __device__ __forceinline__ void operator()(f32x4 (&acc)[2][2][4][2], const Unit& u, int wr, int wc, int fr_in, int fq_in) const {
        int fr = fr_in, fq = fq_in; asm volatile("" : "+v"(fr), "+v"(fq));
        const int lane = mk_lane(); const int tid = (wr * 4 + wc) * 64 + lane;
        const int b = u.pm >> 3, col0 = u.pn * BM + wc * 32 + 4 * fq;
        PG8_LAS float* P = exl; PG8_LAS float* S = exl + 1024;
        { f32x4 gv[2][2];
#pragma unroll
          for (int bj = 0; bj < 2; ++bj)
#pragma unroll
            for (int n = 0; n < 2; ++n) gv[bj][n] = *(const f32x4*)(mod + (size_t)b * 3072 + 2048 + col0 + bj * HALF + n * 16);
#pragma unroll
          for (int ai = 0; ai < 2; ++ai)
#pragma unroll
            for (int m = 0; m < 4; ++m) { const int rt = 128 * ai + 64 * wr + 16 * m + fr; const size_t off = ((size_t)u.pm * BM + rt) * 1024 + col0; float q = 0.f;
#pragma unroll
                for (int bj = 0; bj < 2; ++bj)
#pragma unroll
                    for (int n = 0; n < 2; ++n) { const f32x4 xv = *(const f32x4*)(x + off + bj * HALF + n * 16); const f32x4 o = xv + gv[bj][n] * acc[ai][bj][m][n]; acc[ai][bj][m][n] = o; q += dot4(o); }
                q += __shfl_xor(q, 16); q += __shfl_xor(q, 32);
                if (fq == 0) P[rt * 4 + wc] = q;
                if (m == 3) asm volatile("" ::: "memory"); } }
        asm volatile("s_waitcnt lgkmcnt(0)" ::: "memory"); __builtin_amdgcn_s_barrier(); asm volatile("" ::: "memory");
        if (tid < 256) {
            const f32x4 p = *(const PG8_LAS f32x4*)(P + tid * 4); const float s = (p[0] + p[1]) + (p[2] + p[3]);
            __hip_atomic_store((float*)xbuf + ((size_t)u.pm * BM + tid) * 4 + u.pn, s, __ATOMIC_RELAXED, __HIP_MEMORY_SCOPE_AGENT);
        }
        asm volatile("s_waitcnt vmcnt(0)" ::: "memory");
        if (tid < 256 && lane == 0) __hip_atomic_fetch_add(cnt + 64 * u.pm, 1u, __ATOMIC_RELAXED, __HIP_MEMORY_SCOPE_AGENT);
        if (tid < 64) {
            unsigned sp = 0;
            while ((unsigned)__builtin_amdgcn_readfirstlane(__hip_atomic_load(cnt + 64 * u.pm, __ATOMIC_RELAXED, __HIP_MEMORY_SCOPE_AGENT)) < 16u) {
                __builtin_amdgcn_s_sleep(2); if (++sp > (1u << 22)) { if (lane == 0) __hip_atomic_store(tmo, 1u, __ATOMIC_RELAXED, __HIP_MEMORY_SCOPE_AGENT); break; } }
        }
        asm volatile("s_waitcnt vmcnt(0) lgkmcnt(0)" ::: "memory"); __builtin_amdgcn_s_barrier(); asm volatile("" ::: "memory");
        if (tid < 256) {
            const unsigned long long* sl = xbuf + ((size_t)u.pm * BM + tid) * 2;
            const unsigned long long w0 = __hip_atomic_load(sl, __ATOMIC_RELAXED, __HIP_MEMORY_SCOPE_AGENT), w1 = __hip_atomic_load(sl + 1, __ATOMIC_RELAXED, __HIP_MEMORY_SCOPE_AGENT);
            const float s = (__uint_as_float((unsigned)w0) + __uint_as_float((unsigned)(w0 >> 32))) + (__uint_as_float((unsigned)w1) + __uint_as_float((unsigned)(w1 >> 32)));
            S[tid] = rsqrtf(s * (1.f / 1024.f) + EPS);
        }
        asm volatile("s_waitcnt lgkmcnt(0)" ::: "memory"); __builtin_amdgcn_s_barrier(); asm volatile("" ::: "memory");
        { f32x4 fv[2][2];
#pragma unroll
          for (int bj = 0; bj < 2; ++bj)
#pragma unroll
            for (int n = 0; n < 2; ++n) fv[bj][n] = *(const f32x4*)(fg + col0 + bj * HALF + n * 16);
#pragma unroll
          for (int ai = 0; ai < 2; ++ai)
#pragma unroll
            for (int m = 0; m < 4; ++m) { const int rt = 128 * ai + 64 * wr + 16 * m + fr; const size_t off = ((size_t)u.pm * BM + rt) * 1024 + col0; const float r = S[rt];
#pragma unroll
                for (int bj = 0; bj < 2; ++bj)
#pragma unroll
                    for (int n = 0; n < 2; ++n) *(f32x4*)(out + off + bj * HALF + n * 16) = acc[ai][bj][m][n] * r * fv[bj][n];
                if (m & 1) asm volatile("" ::: "memory"); } }
    }
};
}
#define GAS __attribute__((address_space(1)))
#define LAS __attribute__((address_space(3)))
typedef unsigned v4u __attribute__((ext_vector_type(4)));
typedef GAS unsigned gu32;
typedef GAS unsigned long long gu64;
#define RLX_AGENT __ATOMIC_RELAXED, __HIP_MEMORY_SCOPE_AGENT
#define LDS_WAIT() asm volatile("s_waitcnt lgkmcnt(0)" ::: "memory")
#define VM_WAIT() asm volatile("s_waitcnt vmcnt(0)" ::: "memory")
__device__ __forceinline__ unsigned long long rt() { return __builtin_amdgcn_s_memrealtime(); }
typedef float f32x2_pk __attribute__((ext_vector_type(2))); typedef __bf16 bf16x2_pk __attribute__((ext_vector_type(2)));
__device__ __forceinline__ unsigned pk2(float lo, float hi) { const f32x2_pk v = {lo, hi}; return __builtin_bit_cast(unsigned, __builtin_convertvector(v, bf16x2_pk)); }
#define XB_TMO      128
#define XB_XCNT(j)  (256  + 64 * (j))
#define XB_XSUB(j)  (1280 + 64 * (j))
#define XB_XGEN(j)  (2304 + 64 * (j))
#define XB_TOP      3328
#define XB_TOPGEN   3392
#define XCD_BAR_WORDS 3456
#define XB_SPIN_CAP (1u << 22)

__device__ __forceinline__ unsigned xb_ld(unsigned* p)              { return __hip_atomic_load(p, __ATOMIC_RELAXED, __HIP_MEMORY_SCOPE_AGENT); }
__device__ __forceinline__ unsigned xb_add(unsigned* p, unsigned v) { return __hip_atomic_fetch_add(p, v, __ATOMIC_RELAXED, __HIP_MEMORY_SCOPE_AGENT); }
__device__ __forceinline__ unsigned xb_xcc_id() { return (unsigned)__builtin_amdgcn_s_getreg((3 << 11) | 20) & 0xFu; }
#define XB_SPIN(cond, bar) do { unsigned _sp = 0; while (cond) { __builtin_amdgcn_s_sleep(1); \
    if ((++_sp & 255u) == 0u) { if (xb_ld(&(bar)[XB_TMO])) break; if (_sp > XB_SPIN_CAP) { atomicAdd(&(bar)[XB_TMO], 1u); break; } } } } while (0)

struct XcdBarrier {
    unsigned* bar; unsigned x;
    volatile LAS unsigned* st;
};

__device__ __forceinline__ XcdBarrier xcd_barrier_post(unsigned* bar, volatile LAS unsigned* st, bool leader) {
    XcdBarrier b; b.bar = bar; b.x = xb_xcc_id(); b.st = st;
    if (leader) (void)xb_add(&bar[XB_XCNT(b.x)], 1u);
    return b;
}
__device__ __forceinline__ void xcd_barrier_complete(unsigned* bar, unsigned x, unsigned& nloc, unsigned& nx) {
    const unsigned G = gridDim.x * gridDim.y * gridDim.z;
    unsigned sum, cnt, mine, sp = 0u;
    for (;;) {
        sum = 0u; cnt = 0u; mine = 0u;
#pragma unroll
        for (unsigned j = 0; j < 16; ++j) { const unsigned c = xb_ld(&bar[XB_XCNT(j)]); sum += c; cnt += (c > 0u) ? 1u : 0u; mine = (j == x) ? c : mine; }
        if (sum == G) break;
        __builtin_amdgcn_s_sleep(1);
        if ((++sp & 255u) == 0u) { if (xb_ld(&bar[XB_TMO])) break; if (sp > XB_SPIN_CAP) { atomicAdd(&bar[XB_TMO], 1u); break; } }
    }
    nloc = mine > 0u ? mine : 1u; nx = cnt > 0u ? cnt : 1u;
}

__device__ __forceinline__ void xcd_barrier(const XcdBarrier& b, bool leader) {
    asm volatile("s_waitcnt vmcnt(0)" ::: "memory");
    __syncthreads();
    if (leader) {
        unsigned* bar = b.bar;
        __builtin_amdgcn_s_waitcnt(0);
        unsigned nloc = b.st[0], nx = b.st[1];
        if (nloc == 0u) { xcd_barrier_complete(bar, b.x, nloc, nx); b.st[0] = nloc; b.st[1] = nx; }
        const unsigned old = xb_add(&bar[XB_XSUB(b.x)], 1u);
        const unsigned gen = old / nloc;
        if (old + 1u == (gen + 1u) * nloc) {
            __builtin_amdgcn_fence(__ATOMIC_RELEASE, "agent");
            asm volatile("s_waitcnt vmcnt(0)" ::: "memory");
            const unsigned og = xb_add(&bar[XB_TOP], 1u);
            const unsigned tg = og / nx;
            if (og + 1u == (tg + 1u) * nx) xb_add(&bar[XB_TOPGEN], 1u);
            else XB_SPIN(xb_ld(&bar[XB_TOPGEN]) == tg, bar);
            __builtin_amdgcn_fence(__ATOMIC_ACQUIRE, "agent");
            xb_add(&bar[XB_XGEN(b.x)], 1u);
            asm volatile("s_waitcnt vmcnt(0)" ::: "memory");
        } else {
            XB_SPIN(xb_ld(&bar[XB_XGEN(b.x)]) == gen, bar);
            __builtin_amdgcn_fence(__ATOMIC_ACQUIRE, "agent");
            asm volatile("s_waitcnt vmcnt(0)" ::: "memory");
        }
    }
    __syncthreads();
}

typedef float f32x4 __attribute__((ext_vector_type(4)));
constexpr int NWAVES = 8;
__device__ __forceinline__ float wave_sum(float v) {
#pragma unroll
    for (int o = 1; o < 64; o <<= 1) v += __shfl_xor(v, o);
    return v;
}
__device__ __forceinline__ float dot4g(const f32x4 a) { return (a[0] * a[0] + a[1] * a[1]) + (a[2] * a[2] + a[3] * a[3]); }
__device__ __forceinline__ void p0_bt1_item(const float* W, bf16* WT, LAS float* scr, int item, int lane) {
    const int kb = item / 168, vb = item % 168, k0 = 64 * kb, v0 = 32 * vb;
    const int a = vcol_actual(v0 + (lane & 31));
#pragma unroll 8
    for (int i = 0; i < 32; ++i) { const int kk = 2 * i + (lane >> 5); scr[kk * 33 + (lane & 31)] = a >= 0 ? W[(size_t)(k0 + kk) * PROJ + a] : 0.f; }
    LDS_WAIT(); asm volatile("" ::: "memory");
    const int c = lane & 7;
#pragma unroll
    for (int j = 0; j < 4; ++j) { const int n = (lane >> 3) + 8 * j; const LAS float* s = scr + (8 * c) * 33 + n;
        v4u o; o.x = pk2(s[0 * 33], s[1 * 33]); o.y = pk2(s[2 * 33], s[3 * 33]); o.z = pk2(s[4 * 33], s[5 * 33]); o.w = pk2(s[6 * 33], s[7 * 33]);
        *(GAS v4u*)(WT + (size_t)(v0 + n) * 1024 + k0 + 8 * c) = o; }
    LDS_WAIT(); asm volatile("" ::: "memory");
}
__device__ __forceinline__ void p0_bt2_item(const float* W, const float* sg, bf16* WT, LAS float* scr, int item, int lane) {
    const int kb = item >> 5, nb = item & 31, kk0 = 64 * kb, n0 = 32 * nb;
#pragma unroll 8
    for (int i = 0; i < 32; ++i) { const int kk = 2 * i + (lane >> 5), kq = kk0 + kk; const int ks = kq < 1024 ? 1024 + kq : kq - 1024;
        float v = W[(size_t)ks * 1024 + n0 + (lane & 31)]; if (kq < 1024) v *= sg[kq]; scr[kk * 33 + (lane & 31)] = v; }
    LDS_WAIT(); asm volatile("" ::: "memory");
    const int c = lane & 7;
#pragma unroll
    for (int j = 0; j < 4; ++j) { const int n = (lane >> 3) + 8 * j; const LAS float* s = scr + (8 * c) * 33 + n;
        v4u o; o.x = pk2(s[0 * 33], s[1 * 33]); o.y = pk2(s[2 * 33], s[3 * 33]); o.z = pk2(s[4 * 33], s[5 * 33]); o.w = pk2(s[6 * 33], s[7 * 33]);
        *(GAS v4u*)(WT + (size_t)(n0 + n) * 2048 + kk0 + 8 * c) = o; }
    LDS_WAIT(); asm volatile("" ::: "memory");
}
__device__ __forceinline__ void p0_mod_block(const float* c, const float* c_ctx, const float* ada_w, const float* ada_b, float* mod, LAS float* ldsf, int cb, int tid, int lane, int wave) {
    LAS float* sil = ldsf; LAS float* red = ldsf + 33 * 256;
    float acc[33];
#pragma unroll
    for (int b = 0; b < 33; ++b) acc[b] = 0.f;
    for (int q = 0; q < 4; ++q) {
        __syncthreads();
        for (int e = tid; e < 33 * 256; e += NWAVES * 64) { const int b = e >> 8, k = e & 255; const float v = b < 32 ? c[b * 1024 + q * 256 + k] : c_ctx[q * 256 + k]; sil[e] = siluf(v); }
        __syncthreads();
#pragma unroll 8
        for (int kk = 0; kk < 32; ++kk) { const int kl = wave * 32 + kk; const float w = ada_w[(size_t)(q * 256 + kl) * 3072 + cb * 64 + lane];
#pragma unroll
            for (int b = 0; b < 33; ++b) acc[b] += sil[b * 256 + kl] * w; }
    }
#pragma unroll
    for (int b = 0; b < 33; ++b) red[(wave * 33 + b) * 64 + lane] = acc[b];
    __syncthreads();
    for (int e = tid; e < 33 * 64; e += NWAVES * 64) { const int b = e >> 6, col = e & 63; float s = 0.f;
#pragma unroll
        for (int w = 0; w < 8; ++w) s += red[(w * 33 + b) * 64 + col];
        mod[b * 3072 + cb * 64 + col] = s + ada_b[cb * 64 + col]; }
    __syncthreads();
}
__device__ __forceinline__ const float* p1_src(const float* x, const float* ctx, int m) { return m < ML ? x + (size_t)m * DM : ctx + (size_t)(m - ML) * DM; }
__device__ __forceinline__ void p1_load4(f32x4 (&v)[4][4], const float* x, const float* ctx, int m0, int lane) {
#pragma unroll
    for (int r = 0; r < 4; ++r) { const GAS f32x4* xr = (const GAS f32x4*)p1_src(x, ctx, m0 + r) + lane;
#pragma unroll
        for (int j = 0; j < 4; ++j) v[r][j] = xr[64 * j]; }
}
__device__ __forceinline__ void p1_proc4(const f32x4 (&v)[4][4], const float* mod, const float* ng, bf16* H, int m0, int lane) {
#pragma unroll
    for (int r = 0; r < 4; ++r) { const int m = m0 + r; const float* md = mod + (size_t)(m < ML ? m / SEQ : 32) * 3072;
        float s = 0.f;
#pragma unroll
        for (int j = 0; j < 4; ++j) s += dot4g(v[r][j]);
        const float rstd = rsqrtf(wave_sum(s) * (1.f / DM) + EPS);
        GAS unsigned long long* o8 = (GAS unsigned long long*)(H + (size_t)m * DM) + lane;
#pragma unroll
        for (int j = 0; j < 4; ++j) { const int k = 4 * lane + 256 * j;
            const f32x4 g = *(const f32x4*)(ng + k), sc = *(const f32x4*)(md + 1024 + k), sh = *(const f32x4*)(md + k);
            const f32x4 h = v[r][j] * rstd * g * (sc + 1.f) + sh;
            o8[64 * j] = (unsigned long long)pk2(h[0], h[1]) | ((unsigned long long)pk2(h[2], h[3]) << 32); }
    }
}
__device__ __forceinline__ void conv_phase(const bf16* XBC, const float* cw, const float* cb, bf16* XC, int bx, int G, int tid) {
    if (tid < 384) {
        const int cg = tid % 192, sub = tid / 192;
        f32x4 w[5][2], bias[2];
#pragma unroll
        for (int j = 0; j < 5; ++j) { w[j][0] = *(const f32x4*)(cw + j * CONVC + cg * 8); w[j][1] = *(const f32x4*)(cw + j * CONVC + cg * 8 + 4); }
        bias[0] = *(const f32x4*)(cb + cg * 8); bias[1] = *(const f32x4*)(cb + cg * 8 + 4);
        for (int seg = bx; seg < MT / 32; seg += G) {
            const int row0 = seg * 32 + sub * 16; int t0, len;
            if (row0 < ML) { t0 = row0 % SEQ; len = SEQ; } else { t0 = (row0 - ML) % CTXL; len = CTXL; }
            const bf16* src = XBC + (size_t)row0 * CONVC + cg * 8; bf16* dst = XC + (size_t)row0 * CONVC + cg * 8;
            f32x4 r[5][2];
#pragma unroll
            for (int j = 0; j < 5; ++j) { const int tt = t0 + j - 2; v4u u = (v4u){0u, 0u, 0u, 0u};
                if (tt >= 0 && tt < len) u = *(const v4u*)(src + (ptrdiff_t)(j - 2) * CONVC);
                r[j][0] = (f32x4){__uint_as_float(u.x << 16), __uint_as_float(u.x & 0xffff0000u), __uint_as_float(u.y << 16), __uint_as_float(u.y & 0xffff0000u)};
                r[j][1] = (f32x4){__uint_as_float(u.z << 16), __uint_as_float(u.z & 0xffff0000u), __uint_as_float(u.w << 16), __uint_as_float(u.w & 0xffff0000u)}; }
#pragma unroll
            for (int i = 0; i < 16; ++i) {
                f32x4 a0 = bias[0], a1 = bias[1];
#pragma unroll
                for (int j = 0; j < 5; ++j) { a0 += w[j][0] * r[j][0]; a1 += w[j][1] * r[j][1]; }
#pragma unroll
                for (int e = 0; e < 4; ++e) { a0[e] = siluf(a0[e]); a1[e] = siluf(a1[e]); }
                v4u o; o.x = pk2(a0[0], a0[1]); o.y = pk2(a0[2], a0[3]); o.z = pk2(a1[0], a1[1]); o.w = pk2(a1[2], a1[3]);
                *(v4u*)(dst + (size_t)i * CONVC) = o;
#pragma unroll
                for (int j = 0; j < 4; ++j) { r[j][0] = r[j + 1][0]; r[j][1] = r[j + 1][1]; }
                const int tt = t0 + i + 3; v4u u = (v4u){0u, 0u, 0u, 0u};
                if (i < 15 && tt < len) u = *(const v4u*)(src + (size_t)(i + 3) * CONVC);
                r[4][0] = (f32x4){__uint_as_float(u.x << 16), __uint_as_float(u.x & 0xffff0000u), __uint_as_float(u.y << 16), __uint_as_float(u.y & 0xffff0000u)};
                r[4][1] = (f32x4){__uint_as_float(u.z << 16), __uint_as_float(u.z & 0xffff0000u), __uint_as_float(u.w << 16), __uint_as_float(u.w & 0xffff0000u)};
            }
        }
    }
}
__device__ __forceinline__ void ssd_item_naive(int b, int h, const bf16* XC, const float* DT, const bf16* Z, const float* a_log, const float* d_skip, bf16* YQ, float* SSQ, LAS float* ysq, int tid) {
    const int p = tid >> 3, nc = tid & 7, g = h >> 3;
    for (int dd = 0; dd < 2; ++dd) { const int d = 1 - dd;
        const float a_neg = -expf(a_log[d * 16 + h]);
        float S[16];
#pragma unroll
        for (int j = 0; j < 16; ++j) S[j] = 0.f;
        for (int seq = 0; seq < 2; ++seq) { const int len = seq == 0 ? CTXL : SEQ; const size_t rbase = seq == 0 ? (size_t)ML + (size_t)b * CTXL : (size_t)b * SEQ;
            for (int st = 0; st < len; ++st) { const int t = d ? len - 1 - st : st; const size_t row = rbase + t;
                const float dt = DT[row * 32 + d * 16 + h]; const float dec = expf(dt * a_neg);
                const float xs = bf2f(XC[row * CONVC + h * 64 + p]); const float X = xs * dt;
                const v4u b0 = *(const v4u*)(XC + row * CONVC + 1024 + g * 128 + nc * 16), b1 = *(const v4u*)(XC + row * CONVC + 1024 + g * 128 + nc * 16 + 8);
                const v4u c0 = *(const v4u*)(XC + row * CONVC + 1280 + g * 128 + nc * 16), c1 = *(const v4u*)(XC + row * CONVC + 1280 + g * 128 + nc * 16 + 8);
                const unsigned bw[8] = {b0.x, b0.y, b0.z, b0.w, b1.x, b1.y, b1.z, b1.w}, cw8[8] = {c0.x, c0.y, c0.z, c0.w, c1.x, c1.y, c1.z, c1.w};
                float y = 0.f;
#pragma unroll
                for (int j = 0; j < 8; ++j) { S[2 * j] = S[2 * j] * dec + X * __uint_as_float(bw[j] << 16); y += __uint_as_float(cw8[j] << 16) * S[2 * j];
                    S[2 * j + 1] = S[2 * j + 1] * dec + X * __uint_as_float(bw[j] & 0xffff0000u); y += __uint_as_float(cw8[j] & 0xffff0000u) * S[2 * j + 1]; }
                y += __shfl_xor(y, 1); y += __shfl_xor(y, 2); y += __shfl_xor(y, 4);
                if (seq == 1) {
                    bf16* yp = YQ + row * 2048 + h * 64 + p;
                    if (d == 1) { if (nc == 0) *yp = (bf16)f2bf(y); }
                    else {
                        if (nc == 0) { const float yt = y + bf2f(*yp) + d_skip[h] * xs; const float yg = yt * bf2f(Z[row * 1024 + h * 64 + p]); *yp = (bf16)f2bf(yg); ysq[p] = yg * yg; }
                        __syncthreads();
                        if (tid < 64) { float q = ysq[tid]; q = wave_sum(q); if (tid == 0) SSQ[row * 16 + h] = q; }
                        __syncthreads();
                    }
                }
            }
        }
        VM_WAIT(); __syncthreads();
    }
}

namespace attn_body {
using bf16=__hip_bfloat16;
using bf16x8=__attribute__((ext_vector_type(8)))short;
using s16x4=__attribute__((ext_vector_type(4)))short;
using f32x16=__attribute__((ext_vector_type(16)))float;
using u32x4=__attribute__((ext_vector_type(4)))unsigned;
constexpr int D=64,QP=2048,KP=256;
constexpr int NW=8,QBLK=32,QB=QBLK*NW,KVBLK=64,NQB=SEQ/QB;
constexpr int ATTN_UNIT_ROWS=QB;
__device__ __forceinline__ int crow(int r,int hi){return (r&3)+8*(r>>2)+4*hi;}
#define SBAR() __builtin_amdgcn_sched_barrier(0)
__device__ __forceinline__ void cmask(f32x16&p0,f32x16&p1,int jb,int qrel,int hi){
  const float NEG=-INFINITY; int kb=64*jb+4*hi;
  #pragma unroll
  for(int r=0;r<16;++r){int kv=kb+(r&3)+8*(r>>2); if(kv>qrel)p0[r]=NEG; if(kv+32>qrel)p1[r]=NEG;}
}

constexpr int NSLOT=3, SLOTB=8192;
constexpr int LDS_K=0, LDS_V=NSLOT*SLOTB, LDS_WS=2*NSLOT*SLOTB, LDS_OST=LDS_WS+NW*64*4, LDS_BYTES=LDS_OST+NW*8192;
constexpr float C2=0.125f*1.4426950408889634f;
__device__ __forceinline__ void glds16(const void*gsrc,unsigned lds_dst){unsigned keep;
  asm volatile("s_mov_b32 %0, m0\n\ts_mov_b32 m0, %2\n\ts_nop 0\n\tglobal_load_lds_dwordx4 %1, off\n\ts_mov_b32 m0, %0":"=&s"(keep):"v"(gsrc),"s"(lds_dst):"memory");}
__device__ __forceinline__ float max3f(float a,float b,float c){float r;asm("v_max3_f32 %0, %1, %2, %3":"=v"(r):"v"(a),"v"(b),"v"(c));return r;}
__device__ __forceinline__ float max2f(float a,float b){float r;asm("v_max_f32_e32 %0, %1, %2":"=v"(r):"v"(a),"v"(b));return r;}
__device__ __forceinline__ float fadd_s(float a,float b){float r;asm("v_add_f32_e32 %0, %1, %2":"=v"(r):"v"(a),"v"(b));return r;}
__device__ __forceinline__ float fsub_s(float a,float b){float r;asm("v_sub_f32_e32 %0, %1, %2":"=v"(r):"v"(a),"v"(b));return r;}
typedef float f32x2_t __attribute__((ext_vector_type(2))); typedef float f32x4_t __attribute__((ext_vector_type(4))); typedef __bf16 bf16x2_t __attribute__((ext_vector_type(2)));
__device__ __forceinline__ unsigned cvtpk_s(float lo,float hi){f32x2_t v={lo,hi};bf16x2_t b=__builtin_convertvector(v,bf16x2_t);return __builtin_bit_cast(unsigned,b);}
#define WAIT_BAR(N) asm volatile("s_waitcnt vmcnt(" #N ") lgkmcnt(0)\n\ts_barrier":::"memory")

__device__ __forceinline__ void qkt(f32x16&p0,f32x16&p1,const char*Kslot,const bf16x8*qr,const f32x16&negm,int r32,int hi){
  const char*kb=Kslot+hi*1024+r32*16;
  #pragma unroll
  for(int d0=0;d0<4;++d0){
    const bf16x8 b0=*reinterpret_cast<const bf16x8*>(kb+d0*2048);
    const bf16x8 b1=*reinterpret_cast<const bf16x8*>(kb+d0*2048+512);
    if(d0==0){p0=__builtin_amdgcn_mfma_f32_32x32x16_bf16(b0,qr[0],negm,0,0,0);p1=__builtin_amdgcn_mfma_f32_32x32x16_bf16(b1,qr[0],negm,0,0,0);}
    else{p0=__builtin_amdgcn_mfma_f32_32x32x16_bf16(b0,qr[d0],p0,0,0,0);p1=__builtin_amdgcn_mfma_f32_32x32x16_bf16(b1,qr[d0],p1,0,0,0);}}
}
typedef __attribute__((address_space(3))) const char* lds_cptr;
typedef short v4i16_t __attribute__((ext_vector_type(4)));
__device__ __forceinline__ void kload8(bf16x8*kf,lds_cptr kp){
  kf[0]=*(const __attribute__((address_space(3))) bf16x8*)(kp);      kf[1]=*(const __attribute__((address_space(3))) bf16x8*)(kp+512);
  kf[2]=*(const __attribute__((address_space(3))) bf16x8*)(kp+2048); kf[3]=*(const __attribute__((address_space(3))) bf16x8*)(kp+2560);
  kf[4]=*(const __attribute__((address_space(3))) bf16x8*)(kp+4096); kf[5]=*(const __attribute__((address_space(3))) bf16x8*)(kp+4608);
  kf[6]=*(const __attribute__((address_space(3))) bf16x8*)(kp+6144); kf[7]=*(const __attribute__((address_space(3))) bf16x8*)(kp+6656);
}
__device__ __forceinline__ void kload2(bf16x8*kf,lds_cptr kp,int j){ kf[2*j]=*(const __attribute__((address_space(3))) bf16x8*)(kp+j*2048); kf[2*j+1]=*(const __attribute__((address_space(3))) bf16x8*)(kp+j*2048+512); }
__device__ __forceinline__ s16x4 vtr(lds_cptr p){ return __builtin_bit_cast(s16x4,__builtin_amdgcn_ds_read_tr16_b64_v4i16((__attribute__((address_space(3))) v4i16_t*)p)); }
__device__ __forceinline__ float rowmax(const f32x16&p0,const f32x16&p1){
  float a=max3f(p0[0],p0[1],p1[0]),b=max3f(p0[2],p0[3],p1[1]);a=max3f(a,p1[2],p1[3]);
  #pragma unroll
  for(int r=4;r<16;r+=4){a=max3f(a,p0[r],p0[r+1]);b=max3f(b,p0[r+2],p0[r+3]);a=max3f(a,p1[r],p1[r+1]);b=max3f(b,p1[r+2],p1[r+3]);}
  const float m=max2f(a,b);
  auto rr=__builtin_amdgcn_permlane32_swap(__float_as_uint(m),__float_as_uint(m),false,false);
  return max2f(__uint_as_float(rr[0]),__uint_as_float(rr[1]));
}
__device__ __forceinline__ void pv(f32x16*o,int vb,bf16x8 pa0,bf16x8 pa1,bf16x8 pa2,bf16x8 pa3){
  #pragma unroll
  for(int d0=0;d0<2;++d0){s16x4 lo[4],hi[4];
    #pragma unroll
    for(int ks=0;ks<4;++ks){
      asm volatile("ds_read_b64_tr_b16 %0,%1 offset:%c2":"=&v"(lo[ks]):"v"(vb),"i"(d0*4096+ks*1024):"memory");
      asm volatile("ds_read_b64_tr_b16 %0,%1 offset:%c2":"=&v"(hi[ks]):"v"(vb),"i"(d0*4096+ks*1024+512):"memory");}
    asm volatile("s_waitcnt lgkmcnt(0)":::"memory");SBAR();
    #define PK(k) (bf16x8){lo[k][0],lo[k][1],lo[k][2],lo[k][3],hi[k][0],hi[k][1],hi[k][2],hi[k][3]}
    o[d0]=__builtin_amdgcn_mfma_f32_32x32x16_bf16(pa0,PK(0),o[d0],0,0,0);
    o[d0]=__builtin_amdgcn_mfma_f32_32x32x16_bf16(pa1,PK(1),o[d0],0,0,0);
    o[d0]=__builtin_amdgcn_mfma_f32_32x32x16_bf16(pa2,PK(2),o[d0],0,0,0);
    o[d0]=__builtin_amdgcn_mfma_f32_32x32x16_bf16(pa3,PK(3),o[d0],0,0,0);
    #undef PK
  }
}

#ifndef ATTN_STORE16
#define ATTN_STORE16(p,v) (*(u32x4*)(p)=(v))
#endif
template<int THRL> __device__ __forceinline__ void attn_unit(int b,int h,int qb,bf16*YQb,const bf16*__restrict__ K,const bf16*__restrict__ V,char*shm,int wid_in,float sbound,bf16x8 (&qr)[4],bool first,bool hasNext,int nb,int nh,int nqb,bf16*dummyO=nullptr){
  const int wid=wid_in; int lane=mk_lane(); asm volatile("":"+v"(lane)); const int tid=wid*64+lane,r32=lane&31,hi=lane>>5; (void)tid;
  const long rowbase=(long)b*SEQ; const int q0=qb*QB;
  const bf16*Qw=YQb+(rowbase+q0+wid*QBLK)*QP+1024+h*D;
  const bf16*Kh=K+(long)b*KVL*KP+(h>>2)*D,*Vh=V+(long)b*KVL*KP+(h>>2)*D;
  const unsigned lds0=(unsigned)(uintptr_t)shm;
  float*wsf=(float*)(shm+LDS_WS)+wid*64;
  const bf16*ksrc=Kh+(long)lane*KP+wid*8;
  const bf16*vsrc=Vh+(long)(16*(wid&3)+(lane>>2))*KP+(wid>>2)*32+(lane&3)*8;
  const unsigned kdst=lds0+LDS_K+wid*1024, vdst=lds0+LDS_V+wid*1024;
  #define DMA_K(t,slot) glds16(ksrc+(long)(t)*KVBLK*KP,(unsigned)__builtin_amdgcn_readfirstlane(kdst+(slot)))
  #define DMA_V(t,slot) glds16(vsrc+(long)(t)*KVBLK*KP,(unsigned)__builtin_amdgcn_readfirstlane(vdst+(slot)))
  const int vb0=(int)(lds0+LDS_V)+((lane>>4)&1)*32+(lane&3)*8+(4*hi+((lane&15)>>2))*64;
  const char*Kbase=shm+LDS_K; bf16x8 kf[8];
  const lds_cptr shm3=(lds_cptr)shm; const lds_cptr kp0=shm3+LDS_K+hi*1024+r32*16; const lds_cptr vp0=shm3+LDS_V+((lane>>4)&1)*32+(lane&3)*8+(4*hi+((lane&15)>>2))*64;
  constexpr int NT=KVL/KVBLK;
  if(first){ DMA_K(0,0);DMA_V(0,0);DMA_K(1,SLOTB);
    #pragma unroll
    for(int d0=0;d0<4;++d0)qr[d0]=*reinterpret_cast<const bf16x8*>(&Qw[(long)r32*QP+d0*16+hi*8]); }
  float l_reg=0.f;f32x16 o[2];o[0]=f32x16{};o[1]=f32x16{};f32x16 negm;
  #pragma unroll
  for(int r=0;r<16;++r)negm[r]=-sbound;
  asm volatile("":"+v"(negm));
  #define CMASK(P0,P1,t) do{}while(0)
  #define START(P0,P1) do{ _Pragma("unroll") for(int r=0;r<16;++r)P0[r]=__builtin_amdgcn_exp2f(P0[r]); }while(0)
  #define RESC() do{}while(0)
  f32x16 pA0,pA1,pB0,pB1;
  int sl_prev=0,sl_cur=0,sl_next=SLOTB;
  #define ROT() do{sl_prev=sl_cur;sl_cur=sl_next;sl_next=(sl_next==(NSLOT-1)*SLOTB)?0:sl_next+SLOTB;}while(0)
  if(first){ DMA_K(2,2*SLOTB);
    WAIT_BAR(3); }
  else { WAIT_BAR(0); }
  qkt(pA0,pA1,Kbase,qr,negm,r32,hi);asm volatile("s_nop 15\n\ts_nop 7":"+v"(pA0),"+v"(pA1));CMASK(pA0,pA1,0);
  START(pA0,pA1);
  _Pragma("unroll") for(int r=0;r<16;++r)pA1[r]=__builtin_amdgcn_exp2f(pA1[r]);
  WAIT_BAR(0);
  DMA_K(3,0);DMA_V(1,SLOTB);
  ROT();
  kload8(kf,kp0+sl_cur);
  WAIT_BAR(2);
  s16x4 vlo[8],vhi[8]; u32x4 pw0,pw1,pw2,pw3;
  #define PKW(P,B) cvtpk_s(P[B],P[B+1])
  #define PAF(k) __builtin_bit_cast(bf16x8,pw##k)
  #define VFR(i) (bf16x8){vlo[i][0],vlo[i][1],vlo[i][2],vlo[i][3],vhi[i][0],vhi[i][1],vhi[i][2],vhi[i][3]}
  #define PIN(x) asm volatile("":"+v"(x))
  #define MX3(a,b,c) __builtin_fmaxf(__builtin_fmaxf((a),(b)),(c))
  #define GAPA(MF,A0,A1,A2,A3,W0,W1,PW) do{ MF; sacc+=A0; sacc+=A1; sacc+=A2; sacc+=A3; PIN(sacc); W0; W1; PIN(PW); SBAR(); }while(0)
  #define EX(v) __builtin_amdgcn_exp2f(v)
  #define GAPB(MF,X,B) do{ MF; X[B]=EX(X[B]); X[B+1]=EX(X[B+1]); X[B+2]=EX(X[B+2]); X[B+3]=EX(X[B+3]); PIN(X); SBAR(); }while(0)
  #define VRD(i) do{ vlo[i]=vtr(vp_+(((i)>>2)*4096+((i)&3)*1024)); vhi[i]=vtr(vp_+(((i)>>2)*4096+((i)&3)*1024+512)); }while(0)
  #define KRD(G,j) do{ if(G){ kload2(kf,kp0+sl_next,j); SBAR(); } }while(0)
  #define STEP(C0,C1,P0,P1,t,GK,GV,GL) do{ SBAR(); \
    const lds_cptr vp_=vp0+sl_prev; \
    VRD(0); SBAR(); float sacc=(P0[0]+P0[1]); \
    GAPA(C0=__builtin_amdgcn_mfma_f32_32x32x16_bf16(kf[0],qr[0],negm,0,0,0), P0[2],P0[3],P0[4],P0[5],     pw0[0]=PKW(P0,0), pw0[1]=PKW(P0,2), pw0); \
    VRD(4); SBAR(); GAPA(C1=__builtin_amdgcn_mfma_f32_32x32x16_bf16(kf[1],qr[0],negm,0,0,0), P0[6],P0[7],P0[8],P0[9],     pw0[2]=PKW(P0,4), pw0[3]=PKW(P0,6), pw0); \
    VRD(1); SBAR(); GAPA(C0=__builtin_amdgcn_mfma_f32_32x32x16_bf16(kf[2],qr[1],C0,0,0,0),   P0[10],P0[11],P0[12],P0[13], pw1[0]=PKW(P0,8), pw1[1]=PKW(P0,10), pw1); \
    VRD(5); SBAR(); GAPA(C1=__builtin_amdgcn_mfma_f32_32x32x16_bf16(kf[3],qr[1],C1,0,0,0),   P0[14],P0[15],P1[0],P1[1],   pw1[2]=PKW(P0,12),pw1[3]=PKW(P0,14), pw1); \
    VRD(2); SBAR(); GAPA(C0=__builtin_amdgcn_mfma_f32_32x32x16_bf16(kf[4],qr[2],C0,0,0,0),   P1[2],P1[3],P1[4],P1[5],     pw2[0]=PKW(P1,0), pw2[1]=PKW(P1,2), pw2); \
    VRD(6); SBAR(); GAPA(C1=__builtin_amdgcn_mfma_f32_32x32x16_bf16(kf[5],qr[2],C1,0,0,0),   P1[6],P1[7],P1[8],P1[9],     pw2[2]=PKW(P1,4), pw2[3]=PKW(P1,6), pw2); \
    VRD(3); SBAR(); GAPA(C0=__builtin_amdgcn_mfma_f32_32x32x16_bf16(kf[6],qr[3],C0,0,0,0),   P1[10],P1[11],P1[12],P1[13], pw3[0]=PKW(P1,8), pw3[1]=PKW(P1,10), pw3); \
    VRD(7); SBAR(); GAPA(C1=__builtin_amdgcn_mfma_f32_32x32x16_bf16(kf[7],qr[3],C1,0,0,0),   P1[14],P1[15],0.f,0.f,       pw3[2]=PKW(P1,12),pw3[3]=PKW(P1,14), pw3); \
    l_reg+=sacc; \
    if(GK){DMA_K((t)+3,sl_cur);} if(GV){DMA_V((t)+1,sl_next);} \
    CMASK(C0,C1,t); \
    SBAR(); \
    GAPB(o[0]=__builtin_amdgcn_mfma_f32_32x32x16_bf16(PAF(0),VFR(0),o[0],0,0,0), C0,0); \
    GAPB(o[1]=__builtin_amdgcn_mfma_f32_32x32x16_bf16(PAF(0),VFR(4),o[1],0,0,0), C0,4); \
    KRD(GL,0); GAPB(o[0]=__builtin_amdgcn_mfma_f32_32x32x16_bf16(PAF(1),VFR(1),o[0],0,0,0), C0,8); \
    KRD(GL,1); GAPB(o[1]=__builtin_amdgcn_mfma_f32_32x32x16_bf16(PAF(1),VFR(5),o[1],0,0,0), C0,12); \
    KRD(GL,2); GAPB(o[0]=__builtin_amdgcn_mfma_f32_32x32x16_bf16(PAF(2),VFR(2),o[0],0,0,0), C1,0); \
    KRD(GL,3); GAPB(o[1]=__builtin_amdgcn_mfma_f32_32x32x16_bf16(PAF(2),VFR(6),o[1],0,0,0), C1,4); \
    GAPB(o[0]=__builtin_amdgcn_mfma_f32_32x32x16_bf16(PAF(3),VFR(3),o[0],0,0,0), C1,8); \
    GAPB(o[1]=__builtin_amdgcn_mfma_f32_32x32x16_bf16(PAF(3),VFR(7),o[1],0,0,0), C1,12); \
    }while(0)
  int t=1;
  #undef CMASK
  #define CMASK(P0,P1,t) do{}while(0)
  for(;t+5<NT;t+=2){
    STEP(pB0,pB1,pA0,pA1,t,true,true,true);     WAIT_BAR(2); RESC(); ROT();
    STEP(pA0,pA1,pB0,pB1,t+1,true,true,true);   WAIT_BAR(2); RESC(); ROT();
  }
  #undef CMASK
  #define CMASK(P0,P1,t) do{}while(0)
  #define ENDW(tt) do{ if((tt)+3<NT){WAIT_BAR(2);} else if((tt)+2<NT){WAIT_BAR(1);} else {WAIT_BAR(0);} }while(0)
  for(;t+1<NT;t+=2){
    STEP(pB0,pB1,pA0,pA1,t,(t+3<NT),(t+1<NT),(t+1<NT));       ENDW(t);   RESC(); ROT();
    STEP(pA0,pA1,pB0,pB1,t+1,(t+4<NT),(t+2<NT),(t+2<NT));     ENDW(t+1); RESC(); ROT();
  }
  const bf16*nQw=YQb+((long)nb*SEQ+nqb*QB+wid*QBLK)*QP+1024+nh*D;
  if(hasNext){ const bf16*nK=K+(long)nb*KVL*KP+(nh>>2)*D+(long)lane*KP+wid*8; const bf16*nV=V+(long)nb*KVL*KP+(nh>>2)*D+(long)(16*(wid&3)+(lane>>2))*KP+(wid>>2)*32+(lane&3)*8;
    glds16(nK,(unsigned)__builtin_amdgcn_readfirstlane(kdst)); glds16(nV,(unsigned)__builtin_amdgcn_readfirstlane(vdst)); glds16(nK+(long)KVBLK*KP,(unsigned)__builtin_amdgcn_readfirstlane(kdst+SLOTB)); glds16(nK+(long)2*KVBLK*KP,(unsigned)__builtin_amdgcn_readfirstlane(kdst+2*SLOTB)); }
  STEP(pB0,pB1,pA0,pA1,NT-1,false,false,false); RESC();
  { float sacc=pB0[0]+pB0[1]; _Pragma("unroll") for(int r=2;r<16;++r)sacc+=pB0[r]; _Pragma("unroll") for(int r=0;r<16;++r)sacc+=pB1[r]; l_reg+=sacc;
    pw0=(u32x4){PKW(pB0,0),PKW(pB0,2),PKW(pB0,4),PKW(pB0,6)};pw1=(u32x4){PKW(pB0,8),PKW(pB0,10),PKW(pB0,12),PKW(pB0,14)};pw2=(u32x4){PKW(pB1,0),PKW(pB1,2),PKW(pB1,4),PKW(pB1,6)};pw3=(u32x4){PKW(pB1,8),PKW(pB1,10),PKW(pB1,12),PKW(pB1,14)};
    SBAR(); pv(o,vb0+sl_cur,PAF(0),PAF(1),PAF(2),PAF(3)); }
  if(hasNext){
    #pragma unroll
    for(int d0=0;d0<4;++d0)qr[d0]=*reinterpret_cast<const bf16x8*>(&nQw[(long)r32*QP+d0*16+hi*8]); }
  #undef PKW
  #undef PAF
  #undef VFR
  #undef PIN
  #undef MX3
  #undef GAPA
  #undef GAPB
  #undef EX
  #undef VRD
  #undef KRD
  #undef STEP
  #undef ENDW
  {auto rr=__builtin_amdgcn_permlane32_swap(__float_as_uint(l_reg),__float_as_uint(l_reg),false,false);l_reg=__uint_as_float(rr[0])+__uint_as_float(rr[1]);}
  if(hi==0)wsf[32+r32]=l_reg;asm volatile("s_waitcnt lgkmcnt(0)":::"memory");
  float rli[16];
  #pragma unroll
  for(int r=0;r<16;++r)rli[r]=__builtin_amdgcn_rcpf(wsf[32+crow(r,hi)]);
  bf16*Ow=dummyO?dummyO+(long)(wid*QBLK)*QP:YQb+(rowbase+q0+wid*QBLK)*QP+1024+h*D; const bf16*Gw=YQb+(rowbase+q0+wid*QBLK)*QP+h*D;
  { float*stg=(float*)(shm+LDS_OST)+wid*2048;
    #pragma unroll
    for(int r=0;r<16;++r){const int orow=crow(r,hi);
      #pragma unroll
      for(int d0=0;d0<2;++d0)stg[orow*64+d0*32+r32]=o[d0][r]*rli[r];}
    asm volatile("s_waitcnt lgkmcnt(0)":::"memory");
    #pragma unroll
    for(int i=0;i<4;++i){const int row=i*8+(lane>>3),ch=lane&7; const float*sp=stg+row*64+ch*8;
      const f32x4_t a=*(const f32x4_t*)sp,c=*(const f32x4_t*)(sp+4); const u32x4 g=*(const u32x4*)(Gw+(long)row*QP+ch*8);
      u32x4 v; v[0]=cvtpk_s(a[0]*__uint_as_float(g[0]<<16),a[1]*__uint_as_float(g[0]&0xffff0000u)); v[1]=cvtpk_s(a[2]*__uint_as_float(g[1]<<16),a[3]*__uint_as_float(g[1]&0xffff0000u));
      v[2]=cvtpk_s(c[0]*__uint_as_float(g[2]<<16),c[1]*__uint_as_float(g[2]&0xffff0000u)); v[3]=cvtpk_s(c[2]*__uint_as_float(g[3]<<16),c[3]*__uint_as_float(g[3]&0xffff0000u));
      ATTN_STORE16(Ow+(long)row*QP+ch*8,v);} }
  asm volatile("s_waitcnt lgkmcnt(0)\n\ts_barrier":::"memory");
  #undef DMA_K
  #undef DMA_V
  #undef CMASK
  #undef START
  #undef RESC
  #undef ROT
}
constexpr int ATTN_LDS_BYTES=LDS_BYTES;
struct Order {
  int vcu, G; bool alt;
  __device__ __forceinline__ bool next(int i,int&b,int&h,int&qb)const{
    if(G==256&&!alt){ if(i>=16)return false; const int x=vcu>>5,j=vcu&31,rd=i>>2,k=i&3; const int pair=x*16+rd*4+(j>>3),un=(j&7)*4+k; b=pair>>2; h=(pair&3)*4+(un&3); qb=un>>2; return true; }
    const int U=i*G+vcu; if(U>=4096)return false; b=U>>7; h=(U>>3)&15; qb=U&7; return true; }
};
template<int THRL=8> __device__ __forceinline__ void attn_phase(char*lds,bf16*YQb,const bf16*K,const bf16*V,const Order&S,int wid,float sbound,bf16*dummyO=nullptr){
  int b,h,qb,nb=0,nh=0,nqb=0; bf16x8 qr[4]; bool first=true;
  bool has=S.next(0,b,h,qb);
  for(int i=0;has;++i){ const bool hn=S.next(i+1,nb,nh,nqb);
    attn_unit<THRL>(b,h,qb,YQb,K,V,lds,wid,sbound,qr,first,hn,nb,nh,nqb,dummyO);
    b=nb;h=nh;qb=nqb;has=hn;first=false; }
}
#undef SBAR
#undef WAIT_BAR
}

namespace ssd {
typedef short bf16x8 __attribute__((ext_vector_type(8)));
typedef short s16x4 __attribute__((ext_vector_type(4)));
typedef unsigned u32x2_t __attribute__((ext_vector_type(2)));
constexpr int O_B = 0, O_C = 32768, O_X = 65536, O_XD = 81920, O_ST = 98304, O_SM = 114688;
constexpr float LOG2E = 1.4426950408889634f;
struct Lofs { int fb[4], xb[4], bb, sw; };
__device__ __forceinline__ bf16x8 frag(const LAS unsigned char* img, int fbk, int t) { return *(const LAS bf16x8*)(img + fbk + t * 4096); }
__device__ __forceinline__ s16x4 trd(const LAS unsigned char* p) { typedef short v4i16_t __attribute__((ext_vector_type(4))); return __builtin_bit_cast(s16x4, __builtin_amdgcn_ds_read_tr16_b64_v4i16((LAS v4i16_t*)p)); }
__device__ __forceinline__ bf16x8 trfragX(const LAS unsigned char* img, int xbp, int s0) {
    const s16x4 a = trd(img + xbp + s0 * 128), b = trd(img + xbp + s0 * 128 + 2048);
    return (bf16x8){a[0], a[1], a[2], a[3], b[0], b[1], b[2], b[3]};
}
__device__ __forceinline__ bf16x8 trfragB(const LAS unsigned char* img, int bb, int s0) {
    const s16x4 a = trd(img + bb + s0 * 256), b = trd(img + bb + s0 * 256 + 4096);
    return (bf16x8){a[0], a[1], a[2], a[3], b[0], b[1], b[2], b[3]};
}
__device__ __forceinline__ void unpack4(const u32x2_t u, float (&f)[4]) { f[0] = __uint_as_float(u.x << 16); f[1] = __uint_as_float(u.x & 0xffff0000u); f[2] = __uint_as_float(u.y << 16); f[3] = __uint_as_float(u.y & 0xffff0000u); }
__device__ __forceinline__ void unpack8(const v4u u, float (&f)[8]) {
    f[0] = __uint_as_float(u.x << 16); f[1] = __uint_as_float(u.x & 0xffff0000u); f[2] = __uint_as_float(u.y << 16); f[3] = __uint_as_float(u.y & 0xffff0000u);
    f[4] = __uint_as_float(u.z << 16); f[5] = __uint_as_float(u.z & 0xffff0000u); f[6] = __uint_as_float(u.w << 16); f[7] = __uint_as_float(u.w & 0xffff0000u);
}
#define SSD_MFMA(a, b, c) __builtin_amdgcn_mfma_f32_16x16x32_bf16(a, b, c, 0, 0, 0)

template <int W> __device__ __forceinline__ void diag(f32x4 (&y)[4], const bf16x8 (&cf)[4], const LAS unsigned char* Bi, const LAS unsigned char* Xi, const LAS float* csc, float csl, float skd, int fr, int fq, const Lofs& lo) {
    constexpr int NU = W / 2 + 1;
    bf16x8 bA[2][4], bB[2][4];
#pragma unroll
    for (int kk = 0; kk < 4; ++kk) { bA[0][kk] = frag(Bi, lo.fb[kk], 0); if (1 <= W) bB[0][kk] = frag(Bi, lo.fb[kk], 1); }
#pragma unroll
    for (int u = 0; u < NU; ++u) {
        const int cur = u & 1; const bool has1 = 2 * u + 1 <= W;
        bf16x8 xf[4];
#pragma unroll
        for (int pt = 0; pt < 4; ++pt) xf[pt] = trfragX(Xi, lo.xb[pt], 32 * u);
        const f32x4 c0 = *(const LAS f32x4*)(csc + 32 * u + 4 * fq), c1 = *(const LAS f32x4*)(csc + 32 * u + 16 + 4 * fq);
        if (u + 1 < NU) {
#pragma unroll
            for (int kk = 0; kk < 4; ++kk) { bA[cur ^ 1][kk] = frag(Bi, lo.fb[kk], 2 * u + 2); if (2 * u + 3 <= W) bB[cur ^ 1][kk] = frag(Bi, lo.fb[kk], 2 * u + 3); } }
        asm volatile("" ::: "memory");
        f32x4 a0 = (f32x4){0.f, 0.f, 0.f, 0.f}, a1 = (f32x4){0.f, 0.f, 0.f, 0.f};
#pragma unroll
        for (int kk = 0; kk < 4; ++kk) { a0 = SSD_MFMA(bA[cur][kk], cf[kk], a0); if (has1) a1 = SSD_MFMA(bB[cur][kk], cf[kk], a1); }
        float m0[4], m1[4];
#pragma unroll
        for (int e = 0; e < 4; ++e) {
            m0[e] = a0[e] * __builtin_amdgcn_exp2f(fminf(csl - c0[e], 0.f)); if (2 * u == W) { if (4 * fq + e > fr) m0[e] = 0.f; if (4 * fq + e == fr) m0[e] += skd; }
            m1[e] = has1 ? a1[e] * __builtin_amdgcn_exp2f(fminf(csl - c1[e], 0.f)) : 0.f; if (2 * u + 1 == W) { if (4 * fq + e > fr) m1[e] = 0.f; if (4 * fq + e == fr) m1[e] += skd; } }
        const v4u mw = (v4u){pk2(m0[0], m0[1]), pk2(m0[2], m0[3]), pk2(m1[0], m1[1]), pk2(m1[2], m1[3])};
        const bf16x8 mf = __builtin_bit_cast(bf16x8, mw);
#pragma unroll
        for (int pt = 0; pt < 4; ++pt) y[pt] = SSD_MFMA(xf[pt], mf, y[pt]);
    }
}

template <int SH> __device__ __forceinline__ void ssd_item(int b, int h, const bf16* XC, const float* DT, const bf16* Z, const float* a_log, const float* d_skip, bf16* YQ, float* SSQ,
                                          LAS unsigned char* L, int tid_in, int lane_in, int wave) {
    int tid = tid_in, lane = lane_in; asm volatile("" : "+v"(tid), "+v"(lane));
    const int fr = lane & 15, fq = lane >> 4, g = h >> 3;
    LAS unsigned char* Bi = L + O_B; LAS unsigned char* Ci = L + O_C; LAS unsigned char* Xi = L + O_X; LAS unsigned char* Xdi = L + O_XD; LAS unsigned char* Sti = L + O_ST;
    LAS float* dtv = (LAS float*)(L + O_SM); LAS float* cs2 = dtv + 256;
    const float aneg1 = -expf(a_log[16 + h]) * LOG2E, aneg0 = -expf(a_log[h]) * LOG2E, dsk = d_skip[h];
    Lofs lo;
    { const int q = (lane & 15) >> 2, pp = lane & 3, rr = 4 * fq + q;
#pragma unroll
      for (int kk = 0; kk < 4; ++kk) lo.fb[kk] = fr * 256 + (((4 * kk + fq) ^ fr) << 4);
#pragma unroll
      for (int pt = 0; pt < 4; ++pt) lo.xb[pt] = rr * 128 + ((pt ^ ((rr >> 1) & 3)) << 5) + 8 * pp;
      lo.bb = rr * 256 + (((2 * wave + (pp >> 1)) ^ rr) << 4) + 8 * (pp & 1);
      lo.sw = fr * 256 + (((2 * wave + (fq >> 1)) ^ fr) << 4) + (fq & 1) * 8; }
    const int sB = tid >> 4, cB = tid & 15, sX = tid >> 3, cX = tid & 7;
    const int wB = sB * 256 + ((cB ^ (sB & 15)) << 4);
    const int wX = sX * 128 + (((cX >> 1) ^ ((sX >> 1) & 3)) << 5) + (cX & 1) * 16;
    f32x4 st[4];
#pragma unroll
    for (int pt = 0; pt < 4; ++pt) st[pt] = (f32x4){0.f, 0.f, 0.f, 0.f};
    v4u Bq[4], Cq[4], Xq[2]; float dq0 = 0.f, dq1 = 0.f; bf16x8 cf[4];
#define SSD_DECODE(step, d_, base_, ctx_) const int d_ = 1 - (step) / 18; const int k_##d_ = (step) % 18; const bool ctx_ = k_##d_ < 2; \
    const size_t base_ = ctx_ ? (size_t)ML + (size_t)b * CTXL + (size_t)(d_ ? 1 - k_##d_ : k_##d_) * 128 : (size_t)b * SEQ + (size_t)(d_ ? 17 - k_##d_ : k_##d_ - 2) * 128;
#define SSD_ISSUE(step) do { SSD_DECODE(step, di, basei, ctxi) (void)ctxi; \
        const bf16* cb_ = XC + (SH == 8 ? (size_t)b * SEQ : basei) * CONVC; const int sg_ = di ? -CONVC : CONVC; const int o0_ = di ? 127 * CONVC : 0; \
        const bf16* pb_ = cb_ + (o0_ + sB * sg_ + 1024 + g * 128 + 8 * cB); const bf16* px_ = cb_ + (o0_ + sX * sg_ + h * 64 + 8 * cX); \
        const bf16* pc_ = cb_ + (o0_ + (16 * wave + fr) * sg_ + 1280 + g * 128 + 8 * fq); \
        _Pragma("unroll") for (int k4 = 0; k4 < 4; ++k4) { Bq[k4] = *(const v4u*)(pb_ + k4 * 32 * sg_); Cq[k4] = *(const v4u*)(pc_ + 32 * k4); } \
        _Pragma("unroll") for (int k2 = 0; k2 < 2; ++k2) Xq[k2] = *(const v4u*)(px_ + k2 * 64 * sg_); \
        if (wave == 0) { const size_t r0 = basei + (di ? 127 - 2 * lane : 2 * lane), r1 = basei + (di ? 126 - 2 * lane : 2 * lane + 1); dq0 = DT[r0 * 32 + di * 16 + h]; dq1 = DT[r1 * 32 + di * 16 + h]; } } while (0)
#define SSD_CUMSUM(step, par) do { if (wave == 0) { const float an = (1 - (step) / 18) ? aneg1 : aneg0; const float a0 = dq0 * an, a1 = dq1 * an; float v = a0 + a1; \
        _Pragma("unroll") for (int o = 1; o < 64; o <<= 1) { const float t = __shfl_up(v, o); if (lane >= o) v += t; } \
        dtv[(par) * 128 + 2 * lane] = dq0; dtv[(par) * 128 + 2 * lane + 1] = dq1; cs2[(par) * 128 + 2 * lane] = v - a1; cs2[(par) * 128 + 2 * lane + 1] = v; } } while (0)
#define SSD_WRITE(step, par) do { \
        _Pragma("unroll") for (int k4 = 0; k4 < 4; ++k4) { *(LAS v4u*)(Bi + wB + k4 * 8192) = Bq[k4]; cf[k4] = __builtin_bit_cast(bf16x8, Cq[k4]); } \
        const float cl = cs2[(par) * 128 + 127]; \
        _Pragma("unroll") for (int k2 = 0; k2 < 2; ++k2) { const int s = sX + 64 * k2; const float dts = dtv[(par) * 128 + s], es = __builtin_amdgcn_exp2f(cl - cs2[(par) * 128 + s]); \
            float f[8]; unpack8(Xq[k2], f); _Pragma("unroll") for (int e = 0; e < 8; ++e) f[e] *= dts; \
            v4u xo; xo.x = pk2(f[0], f[1]); xo.y = pk2(f[2], f[3]); xo.z = pk2(f[4], f[5]); xo.w = pk2(f[6], f[7]); \
            _Pragma("unroll") for (int e = 0; e < 8; ++e) f[e] *= es; \
            v4u xd; xd.x = pk2(f[0], f[1]); xd.y = pk2(f[2], f[3]); xd.z = pk2(f[4], f[5]); xd.w = pk2(f[6], f[7]); \
            *(LAS v4u*)(Xi + wX + k2 * 8192) = xo; *(LAS v4u*)(Xdi + wX + k2 * 8192) = xd; } } while (0)
#define SSD_WRITE_STATE() do { _Pragma("unroll") for (int pt = 0; pt < 4; ++pt) { \
        u32x2_t w; w.x = pk2(st[pt][0], st[pt][1]); w.y = pk2(st[pt][2], st[pt][3]); *(LAS u32x2_t*)(Sti + lo.sw + pt * 4096) = w; } } while (0)

    __syncthreads();
    SSD_ISSUE(0); SSD_CUMSUM(0, 0); SSD_WRITE_STATE();
    __syncthreads();
    SSD_WRITE(0, 0);
    __syncthreads();
    for (int step = 0; step < 36; ++step) {
        const int par = step & 1; SSD_DECODE(step, d, base, isctx)
        const int r8 = lane >> 3, c8 = lane & 7;
        size_t orow2[2]; v4u ybv[2], zv[2];
#pragma unroll
        for (int ps = 0; ps < 2; ++ps) { const int l = 16 * wave + 8 * ps + r8; orow2[ps] = base + (d ? 127 - l : l); }
        if (!isctx && d == 0 && SH != 5 && SH != 7) {
#pragma unroll
            for (int ps = 0; ps < 2; ++ps) { ybv[ps] = *(const v4u*)((SH ? YQ + (orow2[ps] & 255) * 2048 : YQ + orow2[ps] * 2048) + h * 64 + 8 * c8); zv[ps] = *(const v4u*)(Z + orow2[ps] * 1024 + h * 64 + 8 * c8); } }
        if (step + 1 < 36 && SH != 3 && SH != 7) SSD_ISSUE(step + 1);
        const LAS float* csc = cs2 + par * 128;
        if (!isctx && SH != 7) {
            const float csl = csc[16 * wave + fr];
            const float skd = d == 0 ? dsk * __builtin_amdgcn_rcpf(dtv[par * 128 + 16 * wave + fr]) : 0.f;
            f32x4 y[4];
#pragma unroll
            for (int pt = 0; pt < 4; ++pt) { y[pt] = (f32x4){0.f, 0.f, 0.f, 0.f};
                if (SH != 6) {
#pragma unroll
                for (int kk = 0; kk < 4; ++kk) y[pt] = SSD_MFMA(frag(Sti, lo.fb[kk], pt), cf[kk], y[pt]); } }
            { const float El = __builtin_amdgcn_exp2f(csl);
#pragma unroll
              for (int pt = 0; pt < 4; ++pt) y[pt] *= El; }
            if (SH != 2) switch (wave) {
                case 0: diag<0>(y, cf, Bi, Xi, csc, csl, skd, fr, fq, lo); break; case 1: diag<1>(y, cf, Bi, Xi, csc, csl, skd, fr, fq, lo); break;
                case 2: diag<2>(y, cf, Bi, Xi, csc, csl, skd, fr, fq, lo); break; case 3: diag<3>(y, cf, Bi, Xi, csc, csl, skd, fr, fq, lo); break;
                case 4: diag<4>(y, cf, Bi, Xi, csc, csl, skd, fr, fq, lo); break; case 5: diag<5>(y, cf, Bi, Xi, csc, csl, skd, fr, fq, lo); break;
                case 6: diag<6>(y, cf, Bi, Xi, csc, csl, skd, fr, fq, lo); break; default: diag<7>(y, cf, Bi, Xi, csc, csl, skd, fr, fq, lo); break;
            }
            LAS unsigned char* stg = Ci + wave * 4096;
#pragma unroll
            for (int pt = 0; pt < 4; ++pt) *(LAS f32x4*)(stg + fr * 256 + (((4 * pt + fq) ^ fr) << 4)) = y[pt];
#pragma unroll
            for (int ps = 0; ps < 2; ++ps) { const int rl = 8 * ps + r8;
                const f32x4 t0 = *(const LAS f32x4*)(stg + rl * 256 + (((2 * c8) ^ rl) << 4)), t1 = *(const LAS f32x4*)(stg + rl * 256 + (((2 * c8 + 1) ^ rl) << 4));
                float v[8] = {t0[0], t0[1], t0[2], t0[3], t1[0], t1[1], t1[2], t1[3]};
                if (d == 0 && SH != 5) { float fb[8], fz[8]; unpack8(ybv[ps], fb); unpack8(zv[ps], fz); float q = 0.f;
#pragma unroll
                    for (int e = 0; e < 8; ++e) { v[e] = (v[e] + fb[e]) * fz[e]; q += v[e] * v[e]; }
                    q += __shfl_xor(q, 1); q += __shfl_xor(q, 2); q += __shfl_xor(q, 4);
                    if (c8 == 0) SSQ[(SH ? (orow2[ps] & 255) : orow2[ps]) * 16 + h] = q; }
                v4u o; o.x = pk2(v[0], v[1]); o.y = pk2(v[2], v[3]); o.z = pk2(v[4], v[5]); o.w = pk2(v[6], v[7]);
                if (SH != 5) *(v4u*)((SH ? YQ + (orow2[ps] & 255) * 2048 : YQ + orow2[ps] * 2048) + h * 64 + 8 * c8) = o; else asm volatile("" :: "v"(o)); }
        }
        if (SH != 6 && SH != 7) { const float dec = __builtin_amdgcn_exp2f(csc[127]);
#pragma unroll
          for (int pt = 0; pt < 4; ++pt) st[pt] *= dec;
#pragma unroll
          for (int kk = 0; kk < 4; ++kk) { const bf16x8 af = trfragB(Bi, lo.bb, 32 * kk);
#pragma unroll
              for (int pt = 0; pt < 4; ++pt) st[pt] = SSD_MFMA(af, trfragX(Xdi, lo.xb[pt], 32 * kk), st[pt]); } }
        if (step + 1 < 36) SSD_CUMSUM(step + 1, par ^ 1);
        if (step == 17) {
#pragma unroll
            for (int pt = 0; pt < 4; ++pt) st[pt] = (f32x4){0.f, 0.f, 0.f, 0.f};
            VM_WAIT();
        }
        __syncthreads();
        SSD_WRITE_STATE();
        if (step + 1 < 36 && SH != 4 && SH != 7) SSD_WRITE(step + 1, par ^ 1);
        __syncthreads();
    }
#undef SSD_DECODE
#undef SSD_ISSUE
#undef SSD_CUMSUM
#undef SSD_WRITE
#undef SSD_WRITE_STATE
}
namespace pr {
template <int CTRL, int ROWMASK> __device__ __forceinline__ float dpp_get(float v) {
    return __builtin_bit_cast(float, __builtin_amdgcn_update_dpp(0, __builtin_bit_cast(int, v), CTRL, ROWMASK, 0xF, false)); }
__device__ __forceinline__ float sum8(float q) {
    q += dpp_get<0xB1, 0xF>(q); q += dpp_get<0x4E, 0xF>(q); q += dpp_get<0x141, 0xF>(q); return q; }
__device__ __forceinline__ float scan64(float v) {
    v += dpp_get<0x111, 0xF>(v); v += dpp_get<0x112, 0xF>(v); v += dpp_get<0x114, 0xF>(v); v += dpp_get<0x118, 0xF>(v);
    v += dpp_get<0x142, 0xA>(v); v += dpp_get<0x143, 0xC>(v); return v; }
constexpr int P_B = 0, P_STG = 32768, P_X = 49152, P_XD = 81920, P_ST0 = 114688, P_ST1 = 132096, P_SM = 148480;
template <int W> __device__ __forceinline__ void diag1(f32x4 (&y)[4], const bf16x8 (&cf)[4], const LAS unsigned char* Bi, const LAS unsigned char* Xi, const LAS float* csc, float csl, float skd, int fr, int fq, const Lofs& lo) {
#pragma unroll
    for (int u = 0; u <= W / 2; ++u) {
        const bool has1 = 2 * u + 1 <= W;
        bf16x8 xf[4];
#pragma unroll
        for (int pt = 0; pt < 4; ++pt) xf[pt] = trfragX(Xi, lo.xb[pt], 32 * u);
        const f32x4 c0 = *(const LAS f32x4*)(csc + 32 * u + 4 * fq), c1 = *(const LAS f32x4*)(csc + 32 * u + 16 + 4 * fq);
        f32x4 a0 = (f32x4){0.f, 0.f, 0.f, 0.f}, a1 = (f32x4){0.f, 0.f, 0.f, 0.f};
#pragma unroll
        for (int kk = 0; kk < 4; ++kk) { a0 = SSD_MFMA(frag(Bi, lo.fb[kk], 2 * u), cf[kk], a0); if (has1) a1 = SSD_MFMA(frag(Bi, lo.fb[kk], 2 * u + 1), cf[kk], a1); }
        float m0[4], m1[4];
#pragma unroll
        for (int e = 0; e < 4; ++e) {
            m0[e] = a0[e] * __builtin_amdgcn_exp2f(fminf(csl - c0[e], 0.f)); if (2 * u == W) { if (4 * fq + e > fr) m0[e] = 0.f; if (4 * fq + e == fr) m0[e] += skd; }
            m1[e] = has1 ? a1[e] * __builtin_amdgcn_exp2f(fminf(csl - c1[e], 0.f)) : 0.f; if (2 * u + 1 == W) { if (4 * fq + e > fr) m1[e] = 0.f; if (4 * fq + e == fr) m1[e] += skd; } }
        const v4u mw = (v4u){pk2(m0[0], m0[1]), pk2(m0[2], m0[3]), pk2(m1[0], m1[1]), pk2(m1[2], m1[3])};
        const bf16x8 mf = __builtin_bit_cast(bf16x8, mw);
#pragma unroll
        for (int pt = 0; pt < 4; ++pt) y[pt] = SSD_MFMA(xf[pt], mf, y[pt]);
    }
}
__device__ __forceinline__ void diag_sw(int wave, f32x4 (&y)[4], const bf16x8 (&cf)[4], const LAS unsigned char* Bi, const LAS unsigned char* Xi, const LAS float* csc, float csl, float skd, int fr, int fq, const Lofs& lo) {
    switch (wave) {
        case 0: diag1<0>(y, cf, Bi, Xi, csc, csl, skd, fr, fq, lo); break; case 1: diag1<1>(y, cf, Bi, Xi, csc, csl, skd, fr, fq, lo); break;
        case 2: diag1<2>(y, cf, Bi, Xi, csc, csl, skd, fr, fq, lo); break; case 3: diag1<3>(y, cf, Bi, Xi, csc, csl, skd, fr, fq, lo); break;
        case 4: diag1<4>(y, cf, Bi, Xi, csc, csl, skd, fr, fq, lo); break; case 5: diag1<5>(y, cf, Bi, Xi, csc, csl, skd, fr, fq, lo); break;
        case 6: diag1<6>(y, cf, Bi, Xi, csc, csl, skd, fr, fq, lo); break; default: diag1<7>(y, cf, Bi, Xi, csc, csl, skd, fr, fq, lo); break;
    }
}

__device__ __forceinline__ void ssd_pair(int b, int hp, const bf16* XC, const float* DT, const bf16* Z, const float* a_log, const float* d_skip, bf16* YQ, float* SSQ,
                                          LAS unsigned char* L, int tid_in, int lane_in, int wave) {
    int tid = tid_in, lane = lane_in; asm volatile("" : "+v"(tid), "+v"(lane));
    const int fr = lane & 15, fq = lane >> 4, h0 = 2 * hp, g = hp >> 2;
    LAS unsigned char* Bi = L + P_B; LAS unsigned char* Stg = L + P_STG + wave * 2048;
    LAS float* dtv = (LAS float*)(L + P_SM); LAS float* cs2 = dtv + 512;
    const float an00 = -expf(a_log[h0]) * LOG2E, an01 = -expf(a_log[h0 + 1]) * LOG2E, an10 = -expf(a_log[16 + h0]) * LOG2E, an11 = -expf(a_log[16 + h0 + 1]) * LOG2E;
    const float dsk0 = d_skip[h0], dsk1 = d_skip[h0 + 1];
    Lofs lo;
    { const int q = (lane & 15) >> 2, pp = lane & 3, rr = 4 * fq + q;
#pragma unroll
      for (int kk = 0; kk < 4; ++kk) lo.fb[kk] = fr * 256 + (((4 * kk + fq) ^ fr) << 4);
#pragma unroll
      for (int pt = 0; pt < 4; ++pt) lo.xb[pt] = rr * 128 + ((pt ^ ((rr >> 1) & 3)) << 5) + 8 * pp;
      lo.bb = rr * 256 + (((2 * wave + (pp >> 1)) ^ rr) << 4) + 8 * (pp & 1);
      lo.sw = fr * 256 + (((2 * wave + (fq >> 1)) ^ fr) << 4) + (fq & 1) * 8; }
    const int sB = tid >> 4, cB = tid & 15, hx = (tid >> 3) & 1, cX = tid & 7;
    const int wB = sB * 256 + ((cB ^ (sB & 15)) << 4);
    const int wX = hx * 16384 + sB * 128 + (((cX >> 1) ^ ((sB >> 1) & 3)) << 5) + (cX & 1) * 16;
    f32x4 st[2][4];
#pragma unroll
    for (int hh = 0; hh < 2; ++hh)
#pragma unroll
        for (int pt = 0; pt < 4; ++pt) st[hh][pt] = (f32x4){0.f, 0.f, 0.f, 0.f};
    v4u Bq[4], Xq[4]; float dq0 = 0.f, dq1 = 0.f; bf16x8 cf[4];
#define PR_DECODE(step, d_, base_, ctx_) const int d_ = 1 - (step) / 18; const int k_##d_ = (step) % 18; const bool ctx_ = k_##d_ < 2; \
    const size_t base_ = ctx_ ? (size_t)ML + (size_t)b * CTXL + (size_t)(d_ ? 1 - k_##d_ : k_##d_) * 128 : (size_t)b * SEQ + (size_t)(d_ ? 17 - k_##d_ : k_##d_ - 2) * 128;
#define PR_ISSUE(step) do { PR_DECODE(step, di, basei, ctxi) (void)ctxi; \
        const bf16* cb_ = XC + basei * CONVC; const int sg_ = di ? -CONVC : CONVC; const int o0_ = di ? 127 * CONVC : 0; \
        const bf16* pb_ = cb_ + (o0_ + sB * sg_ + 1024 + g * 128 + 8 * cB); const bf16* px_ = cb_ + (o0_ + sB * sg_ + h0 * 64 + 8 * cB); \
        _Pragma("unroll") for (int k4 = 0; k4 < 4; ++k4) { Bq[k4] = *(const v4u*)(pb_ + k4 * 32 * sg_); Xq[k4] = *(const v4u*)(px_ + k4 * 32 * sg_); } \
        if (wave < 2) { const size_t r0 = basei + (di ? 127 - 2 * lane : 2 * lane), r1 = basei + (di ? 126 - 2 * lane : 2 * lane + 1); dq0 = DT[r0 * 32 + di * 16 + h0 + wave]; dq1 = DT[r1 * 32 + di * 16 + h0 + wave]; } } while (0)
#define PR_LOADC(step) do { PR_DECODE(step, dc, basec, ctxc) (void)ctxc; const bf16* pc_ = XC + basec * CONVC + ((dc ? 127 - (16 * wave + fr) : 16 * wave + fr) * CONVC + 1280 + g * 128 + 8 * fq); \
        _Pragma("unroll") for (int k4 = 0; k4 < 4; ++k4) cf[k4] = __builtin_bit_cast(bf16x8, *(const v4u*)(pc_ + 32 * k4)); } while (0)
#define PR_CUMSUM(step, par) do { if (wave < 2) { const float an = (1 - (step) / 18) ? (wave ? an11 : an10) : (wave ? an01 : an00); const float a0 = dq0 * an, a1 = dq1 * an; const float v = scan64(a0 + a1); \
        const int o_ = ((par) * 2 + wave) * 128 + 2 * lane; dtv[o_] = dq0; dtv[o_ + 1] = dq1; cs2[o_] = v - a1; cs2[o_ + 1] = v; } } while (0)
#define PR_WRITE(step, par) do { const int ob_ = ((par) * 2 + hx) * 128; const float cl = cs2[ob_ + 127]; \
        _Pragma("unroll") for (int k4 = 0; k4 < 4; ++k4) { *(LAS v4u*)(Bi + wB + k4 * 8192) = Bq[k4]; \
            const int s = sB + 32 * k4; const float dts = dtv[ob_ + s], es = __builtin_amdgcn_exp2f(cl - cs2[ob_ + s]); \
            float f[8]; unpack8(Xq[k4], f); _Pragma("unroll") for (int e = 0; e < 8; ++e) f[e] *= dts; \
            v4u xo; xo.x = pk2(f[0], f[1]); xo.y = pk2(f[2], f[3]); xo.z = pk2(f[4], f[5]); xo.w = pk2(f[6], f[7]); \
            _Pragma("unroll") for (int e = 0; e < 8; ++e) f[e] *= es; \
            v4u xd; xd.x = pk2(f[0], f[1]); xd.y = pk2(f[2], f[3]); xd.z = pk2(f[4], f[5]); xd.w = pk2(f[6], f[7]); \
            *(LAS v4u*)(L + P_X + wX + k4 * 4096) = xo; *(LAS v4u*)(L + P_XD + wX + k4 * 4096) = xd; } } while (0)
#define PR_WRITE_STATE() do { _Pragma("unroll") for (int pt = 0; pt < 4; ++pt) { \
        u32x2_t w; w.x = pk2(st[0][pt][0], st[0][pt][1]); w.y = pk2(st[0][pt][2], st[0][pt][3]); *(LAS u32x2_t*)(L + P_ST0 + lo.sw + pt * 4096) = w; \
        w.x = pk2(st[1][pt][0], st[1][pt][1]); w.y = pk2(st[1][pt][2], st[1][pt][3]); *(LAS u32x2_t*)(L + P_ST1 + lo.sw + pt * 4096) = w; } } while (0)

    __syncthreads();
    PR_ISSUE(0); PR_LOADC(0); PR_CUMSUM(0, 0); PR_WRITE_STATE();
    __syncthreads();
    PR_WRITE(0, 0);
    __syncthreads();
    for (int step = 0; step < 36; ++step) {
        const int par = step & 1; PR_DECODE(step, d, base, isctx)
        const int r8 = lane >> 3, c8 = lane & 7;
        size_t orow2[2]; v4u ybv[2], zv[2];
#pragma unroll
        for (int ps = 0; ps < 2; ++ps) { const int l = 16 * wave + 8 * ps + r8; orow2[ps] = base + (d ? 127 - l : l); }
        const bool fwdy = !isctx && d == 0;
        if (fwdy) {
#pragma unroll
            for (int ps = 0; ps < 2; ++ps) { ybv[ps] = *(const v4u*)(YQ + orow2[ps] * 2048 + h0 * 64 + 8 * c8); zv[ps] = *(const v4u*)(Z + orow2[ps] * 1024 + h0 * 64 + 8 * c8); } }
        if (step + 1 < 36) PR_ISSUE(step + 1);
        if (!isctx) {
#pragma unroll
            for (int hh = 0; hh < 2; ++hh) {
                const LAS float* csc = cs2 + (par * 2 + hh) * 128;
                const LAS unsigned char* Xi = L + P_X + hh * 16384; const LAS unsigned char* Sti = L + (hh ? P_ST1 : P_ST0);
                const float csl = csc[16 * wave + fr];
                const float skd = d == 0 ? (hh ? dsk1 : dsk0) * __builtin_amdgcn_rcpf(dtv[(par * 2 + hh) * 128 + 16 * wave + fr]) : 0.f;
                f32x4 y[4];
#pragma unroll
                for (int pt = 0; pt < 4; ++pt) { y[pt] = (f32x4){0.f, 0.f, 0.f, 0.f};
#pragma unroll
                    for (int kk = 0; kk < 4; ++kk) y[pt] = SSD_MFMA(frag(Sti, lo.fb[kk], pt), cf[kk], y[pt]); }
                { const float El = __builtin_amdgcn_exp2f(csl);
#pragma unroll
                  for (int pt = 0; pt < 4; ++pt) y[pt] *= El; }
                diag_sw(wave, y, cf, Bi, Xi, csc, csl, skd, fr, fq, lo);
#pragma unroll
                for (int ps = 0; ps < 2; ++ps) {
                    if ((fr >> 3) == ps) {
#pragma unroll
                        for (int pt = 0; pt < 4; ++pt) *(LAS f32x4*)(Stg + (fr & 7) * 256 + (((4 * pt + fq) ^ fr) << 4)) = y[pt]; }
                    const int key = 8 * ps + r8;
                    const f32x4 t0 = *(const LAS f32x4*)(Stg + r8 * 256 + (((2 * c8) ^ key) << 4)), t1 = *(const LAS f32x4*)(Stg + r8 * 256 + (((2 * c8 + 1) ^ key) << 4));
                    float v[8] = {t0[0], t0[1], t0[2], t0[3], t1[0], t1[1], t1[2], t1[3]};
                    if (d == 0) { float fb[8], fz[8]; unpack8(ybv[ps], fb); unpack8(zv[ps], fz); float q = 0.f;
#pragma unroll
                        for (int e = 0; e < 8; ++e) { v[e] = (v[e] + fb[e]) * fz[e]; q += v[e] * v[e]; }
                        q = sum8(q);
                        if (c8 == 0) SSQ[orow2[ps] * 16 + h0 + hh] = q; }
                    v4u o; o.x = pk2(v[0], v[1]); o.y = pk2(v[2], v[3]); o.z = pk2(v[4], v[5]); o.w = pk2(v[6], v[7]);
                    *(v4u*)(YQ + orow2[ps] * 2048 + (h0 + hh) * 64 + 8 * c8) = o;
                }
                if (hh == 0 && fwdy) {
#pragma unroll
                    for (int ps = 0; ps < 2; ++ps) { ybv[ps] = *(const v4u*)(YQ + orow2[ps] * 2048 + (h0 + 1) * 64 + 8 * c8); zv[ps] = *(const v4u*)(Z + orow2[ps] * 1024 + (h0 + 1) * 64 + 8 * c8); } }
            }
        }
        if (step + 1 < 36) PR_LOADC(step + 1);
        { const float dec0 = __builtin_amdgcn_exp2f(cs2[(par * 2 + 0) * 128 + 127]), dec1 = __builtin_amdgcn_exp2f(cs2[(par * 2 + 1) * 128 + 127]);
#pragma unroll
          for (int pt = 0; pt < 4; ++pt) { st[0][pt] *= dec0; st[1][pt] *= dec1; }
#pragma unroll
          for (int kk = 0; kk < 4; ++kk) { const bf16x8 af = trfragB(Bi, lo.bb, 32 * kk);
#pragma unroll
              for (int pt = 0; pt < 4; ++pt) { st[0][pt] = SSD_MFMA(af, trfragX(L + P_XD, lo.xb[pt], 32 * kk), st[0][pt]); st[1][pt] = SSD_MFMA(af, trfragX(L + P_XD + 16384, lo.xb[pt], 32 * kk), st[1][pt]); } } }
        if (step + 1 < 36) PR_CUMSUM(step + 1, par ^ 1);
        if (step == 17) {
#pragma unroll
            for (int pt = 0; pt < 4; ++pt) { st[0][pt] = (f32x4){0.f, 0.f, 0.f, 0.f}; st[1][pt] = (f32x4){0.f, 0.f, 0.f, 0.f}; }
            VM_WAIT();
        }
        __syncthreads();
        PR_WRITE_STATE();
        if (step + 1 < 36) PR_WRITE(step + 1, par ^ 1);
        __syncthreads();
    }
#undef PR_DECODE
#undef PR_ISSUE
#undef PR_CUMSUM
#undef PR_LOADC
#undef PR_WRITE
#undef PR_WRITE_STATE
}
}
}

constexpr int RING_OFF = 0, RING_BYTES = 131072;
constexpr int LDSCTL_OFF = RING_BYTES, MISC_OFF = LDSCTL_OFF + 320;
constexpr int RSTD_OFF = LDSCTL_OFF + 1024;
constexpr int LDS_BYTES = 155648;
constexpr int CW_BAR = 4096;
constexpr int CW_TMO2 = 8192, CW_CNT = 16384;
constexpr int EXL_OFF = 140288;
constexpr int NPHASE = 7;

struct Args { const float* in[18]; float* out; unsigned char* ws; int ph_lo, ph_hi; };

__global__ void __launch_bounds__(NWAVES * 64, 2) mega(Args args) {
    extern __shared__ __attribute__((aligned(16))) unsigned char lds[];
    LAS unsigned char* ldsp = (LAS unsigned char*)lds;
    volatile LAS unsigned* MISC = (volatile LAS unsigned*)(ldsp + MISC_OFF);
    const int wave = __builtin_amdgcn_readfirstlane((int)threadIdx.x >> 6);
#define PH_IDS() int lane = mk_lane(); asm volatile("" : "+v"(lane)); const int tid = wave * 64 + lane; (void)tid
    const int G = gridDim.x; const int bx = blockIdx.x; const int vcu = (G % 8 == 0) ? (bx % 8) * (G / 8) + bx / 8 : bx;
    unsigned char* ws = args.ws;
    gu32* ctl = (gu32*)(ws + WS_CTL);
    float* mod = (float*)(ws + WS_MOD); float* rope = (float*)(ws + WS_ROPE); float* SSQ = (float*)(ws + WS_SSQ); float* RPART = (float*)(ws + WS_RPART);
    bf16* bt1 = (bf16*)(ws + WS_BT1); bf16* bt2 = (bf16*)(ws + WS_BT2); float* DT = (float*)(ws + WS_DT); bf16* KB = (bf16*)(ws + WS_KB); bf16* VB = (bf16*)(ws + WS_VB);
    bf16* H = (bf16*)(ws + WS_R1); bf16* XC = (bf16*)(ws + WS_R1); bf16* XBC = (bf16*)(ws + WS_XBC); bf16* YQ = (bf16*)(ws + WS_YQ); bf16* Z = (bf16*)(ws + WS_Z);
    { PH_IDS(); for (int u = tid; u < (LDS_BYTES - LDSCTL_OFF) / 4; u += NWAVES * 64) ((LAS unsigned*)(ldsp + LDSCTL_OFF))[u] = 0u; }
    __syncthreads();
    const bool leader = wave == 0 && mk_lane() == 0; (void)leader;
    const int lo = args.ph_lo, hi = args.ph_hi;
    XcdBarrier bar; bar.bar = (unsigned*)(ctl + CW_BAR); bar.x = 0; bar.st = nullptr;
    if (hi - lo > 1) bar = xcd_barrier_post((unsigned*)(ctl + CW_BAR), MISC + 8, leader);
#ifndef DUP_MASK
#define DUP_MASK 0
#endif
#define IN(k) (lo <= (k) && (k) < hi)
#define REP(k) for (int rep_ = 0; rep_ < 1 + ((DUP_MASK >> (k)) & 1); ++rep_)
#define SEAM(k) do { if (IN(k) && IN((k) + 1)) xcd_barrier(bar, wave == 0 && mk_lane() == 0); } while (0)

    if (IN(0)) REP(0) {
        PH_IDS();
        LAS float* ldsf = (LAS float*)(ldsp + RING_OFF);
        if (bx < 48) p0_mod_block(args.in[1], args.in[3], args.in[4], args.in[5], mod, ldsf, bx, tid, lane, wave);
        else if (bx == 48) { for (int i = tid; i < 1024; i += NWAVES * 64) { const int p = i >> 4, f = i & 15; const float inv = powf(10000.f, -(float)f / 16.f); const float ang = (float)p * inv; rope[i] = cosf(ang); rope[1024 + i] = sinf(ang); } }
        LAS float* scr = ldsf + wave * (64 * 33);
        const int gw = ((bx + G - 49) % G) * NWAVES + wave, NGW = G * NWAVES;
        constexpr int I1 = 16 * 168, I2 = 32 * 32;
        for (int it = gw; it < I1 + I2; it += NGW) { if (it < I1) p0_bt1_item(args.in[7], bt1, scr, it, lane); else p0_bt2_item(args.in[16], args.in[15], bt2, scr, it - I1, lane); }
    }
    SEAM(0);
    if (IN(1)) REP(1) {
        PH_IDS();
        const int gw = bx * NWAVES + wave, NGW = G * NWAVES;
        static_assert(MT % (8 * 2048) == 0 || true, "row batches");
        {
            const int step = NGW * 4; int m0 = gw * 4;
            f32x4 va[4][4], vb[4][4];
            if (m0 < MT) p1_load4(va, args.in[0], args.in[2], m0, lane);
            while (m0 < MT) {
                if (m0 + step < MT) p1_load4(vb, args.in[0], args.in[2], m0 + step, lane);
                asm volatile("" ::: "memory");
                p1_proc4(va, mod, args.in[6], H, m0, lane);
                m0 += step; if (m0 >= MT) break;
                if (m0 + step < MT) p1_load4(va, args.in[0], args.in[2], m0 + step, lane);
                asm volatile("" ::: "memory");
                p1_proc4(vb, mod, args.in[6], H, m0, lane);
                m0 += step;
            }
        }
    }
    SEAM(1);

    if (IN(2)) REP(2) {
        pg8::Gemm g{H, bt1, MT, N1, 1024}; pg8::Sched1 S; S.init(G, bx);
        pg8::Epi1 E{KB, VB, XBC, YQ, Z, DT, rope, args.in[13], args.in[14], args.in[10]};
        pg8::gemm_phase<pg8::Epi1, pg8::Sched1, true, true>(ldsp + RING_OFF, g, S, E, wave);
    }
    SEAM(2);
    if (IN(3)) {
        PH_IDS();
        float sbound;
        { float gq = fabsf(args.in[13][lane]), gk = fabsf(args.in[14][lane]);
#pragma unroll
          for (int o = 1; o < 64; o <<= 1) { gq = fmaxf(gq, __shfl_xor(gq, o)); gk = fmaxf(gk, __shfl_xor(gk, o)); }
          sbound = __uint_as_float(__builtin_amdgcn_readfirstlane(__float_as_uint(C2 * 64.f * gq * gk * 1.01f))); }
        const attn_body::Order S{vcu, G, false};
        const attn_body::Order S2{vcu, G, true};
#ifndef ATTN_SHADOW
#define ATTN_SHADOW 0
#endif
        if (ATTN_SHADOW) attn_body::attn_phase<8>((char*)lds + RING_OFF, (attn_body::bf16*)YQ, (const attn_body::bf16*)KB, (const attn_body::bf16*)VB, ATTN_SHADOW == 2 ? S2 : S, wave, sbound, (attn_body::bf16*)(ws + WS_END + 8 * MiB));
        attn_body::attn_phase<8>((char*)lds + RING_OFF, (attn_body::bf16*)YQ, (const attn_body::bf16*)KB, (const attn_body::bf16*)VB, S, wave, sbound);
        conv_phase(XBC, args.in[8], args.in[9], XC, bx, G, tid);
    }
    SEAM(3);
    if (IN(4)) REP(4) {
        PH_IDS();
#if defined(SSD_NAIVE)
        for (int it = bx; it < NB * 16; it += G) ssd_item_naive(it >> 4, it & 15, XC, DT, Z, args.in[11], args.in[12], YQ, SSQ, (LAS float*)(ldsp + RING_OFF), tid);
#else
#ifndef SSD_SHADOW
#define SSD_SHADOW 0
#endif
        if (SSD_SHADOW) { bf16* dY = (bf16*)(ws + WS_END); float* dS = (float*)(ws + WS_END + 2 * MiB);
            for (int it = vcu; it < NB * 16; it += G) ssd::ssd_item<SSD_SHADOW>(it >> 4, it & 15, XC, DT, Z, args.in[11], args.in[12], dY, dS, ldsp, tid, lane, wave); }
#ifndef SSD_PAIR
#define SSD_PAIR 1
#endif
        if (SSD_PAIR) { for (int it = vcu; it < NB * 8; it += G) { int ln_ = mk_lane(); asm volatile("" : "+v"(ln_)); ssd::pr::ssd_pair(it >> 3, it & 7, XC, DT, Z, args.in[11], args.in[12], YQ, SSQ, ldsp, wave * 64 + ln_, ln_, wave); } }
        else for (int it = vcu; it < NB * 16; it += G) ssd::ssd_item<0>(it >> 4, it & 15, XC, DT, Z, args.in[11], args.in[12], YQ, SSQ, ldsp, tid, lane, wave);
#endif
    }
    SEAM(4);

    if (IN(5)) REP(5) {
        PH_IDS();
        pg8::Sched2 S; S.init(G, bx);
        LAS float* rt = (LAS float*)(ldsp + RSTD_OFF);
        { pg8::Unit u; for (int i = 0; i < 4 && S.next(i, u); ++i) if (tid < 256) { const float* q = SSQ + ((size_t)u.pm * 256 + tid) * 16; float s = 0.f;
#pragma unroll
                for (int j = 0; j < 16; ++j) s += q[j];
                rt[i * 256 + tid] = rsqrtf(s * (1.f / 1024.f) + EPS); } }
        __syncthreads();
        pg8::Gemm g{YQ, bt2, ML, 1024, 2048};
        pg8::Epi2 E{args.in[0], mod, args.in[17], args.out, (unsigned long long*)RPART, (unsigned*)(ctl + CW_CNT), (unsigned*)(ctl + CW_TMO2), (const LAS float*)rt, (LAS float*)(ldsp + EXL_OFF)};
        pg8::gemm_phase<pg8::Epi2, pg8::Sched2, true, true>(ldsp + RING_OFF, g, S, E, wave);
    }

#undef IN
#undef SEAM
}

__global__ void k_mod(const float* c, const float* c_ctx, const float* ada_w, const float* ada_b, float* mod) {
    const int i = blockIdx.x * 256 + threadIdx.x; if (i >= 33 * 3072) return;
    const int b = i / 3072, n = i % 3072; const float* cv = b < 32 ? c + b * 1024 : c_ctx;
    float acc = 0.f;
    for (int k = 0; k < 1024; ++k) acc += siluf(cv[k]) * ada_w[(size_t)k * 3072 + n];
    mod[i] = acc + ada_b[n];
}
__global__ void k_tables(float* rope) {
    const int i = blockIdx.x * 256 + threadIdx.x; if (i >= 1024) return;
    const int p = i >> 4, f = i & 15; const float inv = powf(10000.f, -(float)f / 16.f); const float ang = (float)p * inv;
    rope[i] = cosf(ang); rope[1024 + i] = sinf(ang);
}
__global__ void k_bt1(const float* w_in, bf16* bt1) {
    const size_t i = (size_t)blockIdx.x * 256 + threadIdx.x; if (i >= (size_t)N1 * 1024) return;
    const int v = (int)(i >> 10), k = (int)(i & 1023); const int a = vcol_actual(v);
    bt1[i] = (bf16)(a >= 0 ? f2bf(w_in[(size_t)k * PROJ + a]) : 0u);
}
__global__ void k_bt2(const float* w_out, const float* ssd_g, bf16* bt2) {
    const size_t i = (size_t)blockIdx.x * 256 + threadIdx.x; if (i >= (size_t)1024 * 2048) return;
    const int n = (int)(i >> 11), kk = (int)(i & 2047);
    const float v = kk < 1024 ? w_out[(size_t)(1024 + kk) * 1024 + n] * ssd_g[kk] : w_out[(size_t)(kk - 1024) * 1024 + n];
    bt2[i] = (bf16)f2bf(v);
}
__global__ void k_norm(const float* x, const float* ctx, const float* norm_g, const float* mod, bf16* H) {
    const int row = blockIdx.x * 4 + (threadIdx.x >> 6), lane = threadIdx.x & 63; if (row >= MT) return;
    const float* xr = row < ML ? x + (size_t)row * DM : ctx + (size_t)(row - ML) * DM;
    const float* md = mod + (size_t)(row < ML ? row / SEQ : 32) * 3072;
    float v[16]; float s = 0.f;
    for (int j = 0; j < 16; ++j) { v[j] = xr[lane + 64 * j]; s += v[j] * v[j]; }
    for (int o = 1; o < 64; o <<= 1) s += __shfl_xor(s, o);
    const float rstd = rsqrtf(s * (1.f / DM) + EPS);
    for (int j = 0; j < 16; ++j) { const int k = lane + 64 * j; const float h = v[j] * rstd * norm_g[k] * (1.f + md[1024 + k]) + md[k]; H[(size_t)row * DM + k] = (bf16)f2bf(h); }
}
__global__ __launch_bounds__(256) void k_gemm1(const bf16* H, const bf16* bt1, const float* rope, const float* qg, const float* kg, const float* dt_bias,
                                                bf16* KB, bf16* VB, bf16* XBC, float* DT, bf16* YQ, bf16* Z) {
    __shared__ float As[32][65];
    __shared__ float Ps[32][257];
    const int pn = blockIdx.x, rt = blockIdx.y, tid = threadIdx.x; const int row0 = rt * 32;
    if (row0 >= ML && pn > 8) return;
    float acc[32];
    for (int r = 0; r < 32; ++r) acc[r] = 0.f;
    const bf16* bp = bt1 + (size_t)(pn * 256 + tid) * 1024;
    for (int k0 = 0; k0 < 1024; k0 += 64) {
        __syncthreads();
        for (int e = tid; e < 32 * 64; e += 256) { const int r = e >> 6, kk = e & 63; As[r][kk] = bf2f(H[(size_t)(row0 + r) * DM + k0 + kk]); }
        __syncthreads();
        for (int kk = 0; kk < 64; ++kk) { const float b = bf2f(bp[k0 + kk]);
            for (int r = 0; r < 32; ++r) acc[r] += As[r][kk] * b; }
    }
    for (int r = 0; r < 32; ++r) Ps[r][tid] = acc[r];
    __syncthreads();
    const bool isctx = row0 >= ML;
    if (pn == 0 || (pn >= 9 && pn < 13)) {
        {
            const int r = tid >> 3, hd = (tid >> 1) & 3, ax = tid & 1, row = row0 + r; const float* g = pn == 0 ? kg : qg;
            float s = 0.f;
            for (int d = 0; d < 32; ++d) { const float v = Ps[r][hperm_inv(hd, ax * 32 + d)]; s += v * v; }
            s += __shfl_xor(s, 1);
            const float rstd = rsqrtf(s * (1.f / 64.f) + EPS);
            const int t = row % SEQ, p = ax == 0 ? (t >> 6) : (t & 63);
            bf16* dst; float osc = 1.f;
            if (pn == 0) { const int b = isctx ? (row - ML) / CTXL : row / SEQ, pos = isctx ? SEQ + (row - ML) % CTXL : row % SEQ; dst = KB + ((size_t)b * KVL + pos) * 256 + hd * 64 + ax * 32; }
            else { dst = YQ + (size_t)row * 2048 + 1024 + ((pn - 9) * 4 + hd) * 64 + ax * 32; osc = C2; }
            for (int f = 0; f < 16; ++f) {
                const float x1 = Ps[r][hperm_inv(hd, ax * 32 + f)] * rstd * g[ax * 32 + f], x2 = Ps[r][hperm_inv(hd, ax * 32 + 16 + f)] * rstd * g[ax * 32 + 16 + f];
                float o1 = x1, o2 = x2;
                if (!isctx) { const float cs = rope[p * 16 + f], sn = rope[1024 + p * 16 + f]; o1 = x1 * cs - x2 * sn; o2 = x2 * cs + x1 * sn; }
                dst[f] = (bf16)f2bf(o1 * osc); dst[16 + f] = (bf16)f2bf(o2 * osc);
            }
        }
    } else {
        for (int r = 0; r < 32; ++r) { const int row = row0 + r; const float v = Ps[r][tid];
            if (pn == 1) { const int b = isctx ? (row - ML) / CTXL : row / SEQ, pos = isctx ? SEQ + (row - ML) % CTXL : row % SEQ;
                VB[((size_t)b * KVL + pos) * 256 + tid] = (bf16)f2bf(v); }
            else if (pn < 8) XBC[(size_t)row * CONVC + (pn - 2) * 256 + tid] = (bf16)f2bf(v);
            else if (pn == 8) { if (tid < 32) DT[(size_t)row * 32 + tid] = softplusf(v + dt_bias[tid]); }
            else if (pn < 17) YQ[(size_t)row * 2048 + (pn - 13) * 256 + tid] = (bf16)f2bf(siluf(v));
            else Z[(size_t)row * 1024 + (pn - 17) * 256 + tid] = (bf16)f2bf(siluf(v)); }
    }
}
__global__ __launch_bounds__(256) void k_attn(bf16* YQ, const bf16* KB, const bf16* VB) {
    __shared__ float Qs[64][65]; __shared__ float Ks[64][65]; __shared__ float Ps[64][65]; __shared__ bf16 Vs[64][66];
    const int qb = blockIdx.x, h = blockIdx.y, b = blockIdx.z, tid = threadIdx.x, ty = tid >> 4, tx = tid & 15;
    const size_t row0 = (size_t)b * SEQ + qb * 64; const int kvh = h >> 2;
    for (int e = tid; e < 4096; e += 256) { const int r = e >> 6, d = e & 63; Qs[r][d] = bf2f(YQ[(row0 + r) * 2048 + 1024 + h * 64 + d]); }
    float o[4][4], l[4];
    for (int i = 0; i < 4; ++i) { l[i] = 0.f; for (int j = 0; j < 4; ++j) o[i][j] = 0.f; }
    for (int kt = 0; kt < KVL / 64; ++kt) {
        __syncthreads();
        for (int e = tid; e < 4096; e += 256) { const int r = e >> 6, d = e & 63; const size_t src = ((size_t)b * KVL + kt * 64 + r) * 256 + kvh * 64 + d;
            Ks[r][d] = bf2f(KB[src]); Vs[r][d] = VB[src]; }
        __syncthreads();
        float s[4][4];
        for (int i = 0; i < 4; ++i) for (int j = 0; j < 4; ++j) s[i][j] = 0.f;
        for (int d = 0; d < 64; ++d) { float a[4], k4[4];
            for (int i = 0; i < 4; ++i) { a[i] = Qs[ty * 4 + i][d]; k4[i] = Ks[tx * 4 + i][d]; }
            for (int i = 0; i < 4; ++i) for (int j = 0; j < 4; ++j) s[i][j] += a[i] * k4[j]; }
        for (int i = 0; i < 4; ++i) for (int j = 0; j < 4; ++j) Ps[ty * 4 + i][tx * 4 + j] = exp2f(s[i][j]);
        __syncthreads();
        for (int key = 0; key < 64; ++key) { float p[4], v4[4];
            for (int i = 0; i < 4; ++i) { p[i] = Ps[ty * 4 + i][key]; v4[i] = bf2f(Vs[key][tx * 4 + i]); }
            for (int i = 0; i < 4; ++i) { l[i] += p[i]; for (int j = 0; j < 4; ++j) o[i][j] += p[i] * v4[j]; } }
    }
    for (int i = 0; i < 4; ++i) for (int j = 0; j < 4; ++j) { const size_t row = row0 + ty * 4 + i; const int d = tx * 4 + j;
        const float ga = bf2f(YQ[row * 2048 + h * 64 + d]);
        YQ[row * 2048 + 1024 + h * 64 + d] = (bf16)f2bf(o[i][j] / l[i] * ga); }
}
__global__ void k_conv(const bf16* XBC, const float* cw, const float* cb, bf16* XC) {
    const size_t i = (size_t)blockIdx.x * 256 + threadIdx.x; if (i >= (size_t)MT * CONVC) return;
    const int row = (int)(i / CONVC), ch = (int)(i % CONVC);
    int t, len; if (row < ML) { t = row % SEQ; len = SEQ; } else { t = (row - ML) % CTXL; len = CTXL; }
    float acc = cb[ch];
    for (int j = 0; j < 5; ++j) { const int tt = t + j - 2; if (tt >= 0 && tt < len) acc += cw[j * CONVC + ch] * bf2f(XBC[(size_t)(row + j - 2) * CONVC + ch]); }
    XC[i] = (bf16)f2bf(siluf(acc));
}
__global__ __launch_bounds__(512) void k_ssd(const bf16* XC, const float* DT, const bf16* Z, const float* a_log, const float* d_skip, bf16* YQ, float* SSQ) {
    __shared__ float ysq[64];
    const int h = blockIdx.x, b = blockIdx.y, tid = threadIdx.x, p = tid >> 3, nc = tid & 7, g = h >> 3;
    for (int dd = 0; dd < 2; ++dd) { const int d = 1 - dd;
        const float a_neg = -expf(a_log[d * 16 + h]);
        float S[16];
        for (int j = 0; j < 16; ++j) S[j] = 0.f;
        for (int seq = 0; seq < 2; ++seq) { const int len = seq == 0 ? CTXL : SEQ; const size_t rbase = seq == 0 ? (size_t)ML + (size_t)b * CTXL : (size_t)b * SEQ;
            for (int st = 0; st < len; ++st) { const int t = d ? len - 1 - st : st; const size_t row = rbase + t;
                const float dt = DT[row * 32 + d * 16 + h]; const float dec = expf(dt * a_neg);
                const float xs = bf2f(XC[row * CONVC + h * 64 + p]); const float X = xs * dt;
                const bf16* Bp = XC + row * CONVC + 1024 + g * 128 + nc * 16; const bf16* Cp = Bp + 256;
                float y = 0.f;
                for (int j = 0; j < 16; ++j) { S[j] = S[j] * dec + X * bf2f(Bp[j]); y += bf2f(Cp[j]) * S[j]; }
                y += __shfl_xor(y, 1); y += __shfl_xor(y, 2); y += __shfl_xor(y, 4);
                if (seq == 1) {
                    bf16* yp = YQ + row * 2048 + h * 64 + p;
                    if (d == 1) { if (nc == 0) *yp = (bf16)f2bf(y); }
                    else {
                        float yg = 0.f;
                        if (nc == 0) { const float yt = y + bf2f(*yp) + d_skip[h] * xs; yg = yt * bf2f(Z[row * 1024 + h * 64 + p]); *yp = (bf16)f2bf(yg); ysq[p] = yg * yg; }
                        __syncthreads();
                        if (tid < 64) { float q = ysq[tid]; for (int o = 1; o < 64; o <<= 1) q += __shfl_xor(q, o); if (tid == 0) SSQ[row * 16 + h] = q; }
                        __syncthreads();
                    }
                }
            }
        }
    }
}
__global__ __launch_bounds__(256) void k_gemm2(const bf16* YQ, const bf16* bt2, const float* SSQ, const float* x, const float* mod, float* out, float* RPART) {
    __shared__ float As[32][65]; __shared__ float red[32][4];
    const int pn = blockIdx.x, rt = blockIdx.y, tid = threadIdx.x, row0 = rt * 32;
    float acc[32];
    for (int r = 0; r < 32; ++r) acc[r] = 0.f;
    const bf16* bp = bt2 + (size_t)(pn * 256 + tid) * 2048;
    for (int k0 = 0; k0 < 2048; k0 += 64) {
        if (k0 == 1024) { for (int r = 0; r < 32; ++r) { float s = 0.f; for (int j = 0; j < 16; ++j) s += SSQ[(size_t)(row0 + r) * 16 + j]; acc[r] *= rsqrtf(s * (1.f / 1024.f) + EPS); } }
        __syncthreads();
        for (int e = tid; e < 32 * 64; e += 256) { const int r = e >> 6, kk = e & 63; As[r][kk] = bf2f(YQ[(size_t)(row0 + r) * 2048 + k0 + kk]); }
        __syncthreads();
        for (int kk = 0; kk < 64; ++kk) { const float bv = bf2f(bp[k0 + kk]);
            for (int r = 0; r < 32; ++r) acc[r] += As[r][kk] * bv; }
    }
    const int n = pn * 256 + tid;
    for (int r = 0; r < 32; ++r) { const int row = row0 + r; const float v = x[(size_t)row * DM + n] + mod[(size_t)(row / SEQ) * 3072 + 2048 + n] * acc[r];
        out[(size_t)row * DM + n] = v; float q = v * v;
        for (int o = 1; o < 64; o <<= 1) q += __shfl_xor(q, o);
        if ((tid & 63) == 0) RPART[(size_t)row * 16 + pn * 4 + (tid >> 6)] = q; }
}
__global__ void k_final(float* out, const float* RPART, const float* fg) {
    const int row = blockIdx.x * 4 + (threadIdx.x >> 6), lane = threadIdx.x & 63;
    float s = 0.f;
    for (int j = 0; j < 16; ++j) s += RPART[(size_t)row * 16 + j];
    const float rstd = rsqrtf(s * (1.f / DM) + EPS);
    for (int j = 0; j < 16; ++j) { const int k = lane + 64 * j; out[(size_t)row * DM + k] *= rstd * fg[k]; }
}


#ifndef FAST_MASK
#define FAST_MASK 0x7f
#endif
extern "C" void kernel_launch(void* const* d_in, const int* in_sizes, int n_in, void* d_out, int out_size, void* d_ws, size_t ws_size, hipStream_t stream) {
    if (n_in != 18 || out_size != ML * DM || ws_size < WS_END) { fprintf(stderr, "kernel_launch: unexpected shapes (n_in %d out %d ws %zu)\n", n_in, out_size, ws_size); return; }
    static int grid = 0;
    if (grid == 0) {
        int dev = 0, cus = 0;
        if (hipGetDevice(&dev) != hipSuccess || hipDeviceGetAttribute(&cus, hipDeviceAttributeMultiprocessorCount, dev) != hipSuccess) { fprintf(stderr, "kernel_launch: device query failed\n"); grid = -1; return; }
        if (hipFuncSetAttribute((const void*)mega, hipFuncAttributeMaxDynamicSharedMemorySize, LDS_BYTES) != hipSuccess) { fprintf(stderr, "kernel_launch: hipFuncSetAttribute failed\n"); grid = -1; return; }
        int per_cu = 0;
        if (hipOccupancyMaxActiveBlocksPerMultiprocessor(&per_cu, (const void*)mega, NWAVES * 64, LDS_BYTES) != hipSuccess || per_cu < 1) fprintf(stderr, "kernel_launch: note: occupancy query says %d blocks/CU\n", per_cu);
        (void)hipGetLastError();
        grid = cus;
    }
    if (grid < 0) return;
    const float* x = (const float*)d_in[0]; const float* c = (const float*)d_in[1]; const float* ctx = (const float*)d_in[2]; const float* c_ctx = (const float*)d_in[3];
    const float* ada_w = (const float*)d_in[4]; const float* ada_b = (const float*)d_in[5]; const float* norm_g = (const float*)d_in[6]; const float* w_in = (const float*)d_in[7];
    const float* conv_w = (const float*)d_in[8]; const float* conv_b = (const float*)d_in[9]; const float* dt_bias = (const float*)d_in[10]; const float* a_log = (const float*)d_in[11];
    const float* d_skip = (const float*)d_in[12]; const float* qg = (const float*)d_in[13]; const float* kg = (const float*)d_in[14]; const float* ssd_g = (const float*)d_in[15];
    const float* w_out = (const float*)d_in[16]; const float* final_g = (const float*)d_in[17];
    unsigned char* ws = (unsigned char*)d_ws; float* out = (float*)d_out;
    float* mod = (float*)(ws + WS_MOD); float* rope = (float*)(ws + WS_ROPE); float* SSQ = (float*)(ws + WS_SSQ); float* RPART = (float*)(ws + WS_RPART);
    bf16* bt1 = (bf16*)(ws + WS_BT1); bf16* bt2 = (bf16*)(ws + WS_BT2); float* DT = (float*)(ws + WS_DT); bf16* KB = (bf16*)(ws + WS_KB); bf16* VB = (bf16*)(ws + WS_VB);
    bf16* H = (bf16*)(ws + WS_R1); bf16* XC = (bf16*)(ws + WS_R1); bf16* XBC = (bf16*)(ws + WS_XBC); bf16* YQ = (bf16*)(ws + WS_YQ); bf16* Z = (bf16*)(ws + WS_Z);
    (void)hipMemsetAsync(ws + WS_CTL, 0, 1 * MiB, stream);
    Args a{};
    for (int i = 0; i < 18; ++i) a.in[i] = (const float*)d_in[i];
    a.out = out; a.ws = ws;
    for (int ph = 0; ph < NPHASE;) {
        if ((FAST_MASK >> ph) & 1) { int e = ph; while (e < NPHASE && ((FAST_MASK >> e) & 1)) ++e;
            a.ph_lo = ph; a.ph_hi = e; hipLaunchKernelGGL(mega, dim3(grid), dim3(NWAVES * 64), LDS_BYTES, stream, a);
            const hipError_t le = hipPeekAtLastError(); if (le != hipSuccess) fprintf(stderr, "kernel_launch: mega launch failed: %s\n", hipGetErrorName(le));
            ph = e; continue; }
        switch (ph) {
        case 0: k_mod<<<(33 * 3072 + 255) / 256, 256, 0, stream>>>(c, c_ctx, ada_w, ada_b, mod); k_tables<<<4, 256, 0, stream>>>(rope);
                k_bt1<<<(N1 * 1024) / 256, 256, 0, stream>>>(w_in, bt1); k_bt2<<<(1024 * 2048) / 256, 256, 0, stream>>>(w_out, ssd_g, bt2); break;
        case 1: k_norm<<<MT / 4, 256, 0, stream>>>(x, ctx, norm_g, mod, H); break;
        case 2: k_gemm1<<<dim3(21, MT / 32), 256, 0, stream>>>(H, bt1, rope, qg, kg, dt_bias, KB, VB, XBC, DT, YQ, Z); break;
        case 3: k_attn<<<dim3(SEQ / 64, 16, NB), 256, 0, stream>>>(YQ, KB, VB); k_conv<<<(unsigned)(((size_t)MT * CONVC + 255) / 256), 256, 0, stream>>>(XBC, conv_w, conv_b, XC); break;
        case 4: k_ssd<<<dim3(16, NB), 512, 0, stream>>>(XC, DT, Z, a_log, d_skip, YQ, SSQ); break;
        case 5: k_gemm2<<<dim3(4, ML / 32), 256, 0, stream>>>(YQ, bt2, SSQ, x, mod, out, RPART); break;
        case 6: k_final<<<ML / 4, 256, 0, stream>>>(out, RPART, final_g); break;
        }
        ++ph;
    }
}
```

```cpp
#include <hip/hip_runtime.h>
#include <cstdio>
#include <cstdint>
#include <hip/hip_bf16.h>

constexpr int DM = 1024, NB = 32, SEQ = 2048, CTXL = 256, KVL = SEQ + CTXL;
constexpr int ML = NB * SEQ, MC = NB * CTXL, MT = ML + MC;
constexpr int PROJ = 5152, OFF_XBC = 512, OFF_DT = 2048, CTXC = 2080, CONVC = 1536;
constexpr int N1 = 21 * 256;
constexpr float EPS = 1e-6f;
constexpr float C2 = 0.125f * 1.4426950408889634f;

typedef unsigned short bf16;
__device__ __forceinline__ int mk_lane() { return (int)__builtin_amdgcn_mbcnt_hi(~0u, __builtin_amdgcn_mbcnt_lo(~0u, 0u)); }
__host__ __device__ __forceinline__ unsigned f2bf(float f) { unsigned u = __builtin_bit_cast(unsigned, f); return (u + 0x7fffu + ((u >> 16) & 1u)) >> 16; }
__host__ __device__ __forceinline__ float bf2f(unsigned h) { return __builtin_bit_cast(float, (h & 0xffffu) << 16); }
__device__ __forceinline__ float siluf(float v) { return v / (1.f + __expf(-v)); }
__device__ __forceinline__ float softplusf(float v) { return v > 20.f ? v : log1pf(expf(v)); }

constexpr size_t MiB = 1u << 20;
constexpr size_t WS_CTL = 0;
constexpr size_t WS_MOD = 2 * MiB;
constexpr size_t WS_ROPE = 3 * MiB;
constexpr size_t WS_SSQ = 4 * MiB;
constexpr size_t WS_RPART = 8 * MiB;
constexpr size_t WS_BT1 = 12 * MiB;
constexpr size_t WS_BT2 = 23 * MiB;
constexpr size_t WS_DT = 28 * MiB;
constexpr size_t WS_KB = 38 * MiB;
constexpr size_t WS_VB = 74 * MiB;
constexpr size_t WS_R1 = 110 * MiB;
constexpr size_t WS_XBC = 326 * MiB;
constexpr size_t WS_YQ = 542 * MiB;
constexpr size_t WS_Z = 798 * MiB;
constexpr size_t WS_END = 926 * MiB;

__host__ __device__ __forceinline__ int hperm_dim(int vin) {
    const int bj = vin >> 7, wc = (vin >> 5) & 3, s = vin & 31, fq = s >> 3, e = s & 7;
    return wc * 64 + bj * 32 + (e >> 2) * 16 + 4 * fq + (e & 3);
}
__host__ __device__ __forceinline__ int hperm_inv(int head, int dim) {
    const int axis = dim >> 5, half = (dim >> 4) & 1, i16 = dim & 15, fq = i16 >> 2, e = (i16 & 3) + 4 * half;
    return 128 * axis + 32 * head + 8 * fq + e;
}
__host__ __device__ __forceinline__ int vcol_actual(int v) {
    const int t = v >> 8, vin = v & 255;
    if (t == 0) return hperm_dim(vin);
    if (t == 1) return 256 + vin;
    if (t < 8) return v;
    if (t == 8) return vin < 32 ? OFF_DT + vin : -1;
    if (t < 13) return CTXC + (t - 9) * 256 + hperm_dim(vin);
    if (t < 17) return CTXC + 1024 + (v - 13 * 256);
    return CTXC + 2048 + (v - 17 * 256);
}

namespace pg8 {
#define PG8_LAS __attribute__((address_space(3)))
typedef unsigned short bf16_t;
typedef short bf16x8 __attribute__((ext_vector_type(8)));
typedef float f32x4 __attribute__((ext_vector_type(4)));
typedef unsigned u32x4 __attribute__((ext_vector_type(4)));
constexpr int BM = 256, BK = 64, HALF = 128, HTB = HALF * BK * 2  , STAGE_BYTES = 8 * HTB, NXCD = 8, WGM = 8;

__host__ __device__ __forceinline__ int lds_byte(int r, int c) { const int st = (r >> 4) * 2 + (c >> 5), rr = r & 15, cc = c & 31, ob = rr * 64 + cc * 2; return st * 1024 + (ob ^ (((ob >> 9) & 1) << 5)); }
__host__ __device__ __forceinline__ void stage_rc(int b, int& R, int& C) { const int st = b / 1024, sb = b % 1024, swz = sb ^ (((sb >> 9) & 1) << 5); R = (st >> 1) * 16 + swz / 64; C = (st & 1) * 32 + (swz % 64) / 2; }
__host__ __device__ __forceinline__ int perm32(int rho) { const int n = rho >> 4, i = rho & 15; return 8 * (i >> 2) + 4 * n + (i & 3); }

struct Unit { int pm, pn; };
struct Gemm { const bf16_t* A; const bf16_t* Bt; int M, N, K; };

__device__ __forceinline__ unsigned cvt_pk_bf16(float lo, float hi) { unsigned r; asm volatile("v_cvt_pk_bf16_f32 %0, %1, %2" : "=v"(r) : "v"(lo), "v"(hi)); return r; }
typedef float f32x2 __attribute__((ext_vector_type(2)));
template <class Epi, class Sched, bool ALIGN_EPI = false, bool SP2 = false>
__device__ __forceinline__ void gemm_phase(PG8_LAS unsigned char* lds, const Gemm g, const Sched& S, const Epi& E, int wid_in) {
    const int wid = wid_in; int lane = mk_lane(); asm volatile("" : "+v"(lane)); const int tid = wid * 64 + lane, wr = wid >> 2, wc = wid & 3, fr = lane & 15, fq = lane >> 4;
    const int K = g.K, nt = K / BK;
    unsigned voffA[2], voffB[2];
#pragma unroll
    for (int i = 0; i < 2; ++i) { int R, C; stage_rc(tid * 16 + i * 8192, R, C); const int Rb = Epi::PERM ? ((R & ~31) + perm32(R & 31)) : R;
        voffA[i] = (unsigned)(R * K + C) * 2u; voffB[i] = (unsigned)(Rb * K + C) * 2u; }
    const size_t kstep = (size_t)(BK * 2);
    const size_t hstep = (size_t)HALF * K * 2;
    const size_t tstep = 2 * hstep;
    const unsigned ldsw = (unsigned)wid * 1024u;
    const int aoff = lds_byte(wr * 64 + fr, fq * 8), boff = lds_byte(wc * 32 + fr, fq * 8);
#define PG8_SA(b, h) (((b) * 2 + (h)) * HTB)
#define PG8_SB(b, h) ((4 + (b) * 2 + (h)) * HTB)
#define PG8_STAGE(bufoff, gbase, voff) do { _Pragma("unroll") for (int _i = 0; _i < 2; ++_i) \
        __builtin_amdgcn_global_load_lds((const unsigned*)((const char*)(gbase) + (voff)[_i]), (PG8_LAS unsigned*)(lds + (bufoff) + ldsw + _i * 8192), 16, 0, 0); } while (0)
#define PG8_LDA(dst, b, h) do { _Pragma("unroll") for (int m = 0; m < 4; ++m) _Pragma("unroll") for (int k = 0; k < 2; ++k) dst[m][k] = *(const PG8_LAS bf16x8*)(lds + PG8_SA(b, h) + aoff + m * 2048 + k * 1024); } while (0)
#define PG8_LDB(dst, b, h) do { _Pragma("unroll") for (int n = 0; n < 2; ++n) _Pragma("unroll") for (int k = 0; k < 2; ++k) dst[n][k] = *(const PG8_LAS bf16x8*)(lds + PG8_SB(b, h) + boff + n * 2048 + k * 1024); } while (0)
#define PG8_MMA(ai, bj, At, Bt) do { __builtin_amdgcn_s_setprio(1); _Pragma("unroll") for (int m = 0; m < 4; ++m) _Pragma("unroll") for (int n = 0; n < 2; ++n) _Pragma("unroll") for (int k = 0; k < 2; ++k) \
        acc[ai][bj][m][n] = __builtin_amdgcn_mfma_f32_16x16x32_bf16(Bt[n][k], At[m][k], acc[ai][bj][m][n], 0, 0, 0); __builtin_amdgcn_s_setprio(0); } while (0)
#define PG8_WAIT_V(n) asm volatile("s_waitcnt vmcnt(" #n ")" ::: "memory")
#define PG8_WAIT_L(n) asm volatile("s_waitcnt lgkmcnt(" #n ")" ::: "memory")
#define PG8_BAR __builtin_amdgcn_s_barrier()
#define PG8_SCHED __builtin_amdgcn_sched_barrier(0)
    Unit cur, nxt; int ui = 0;
    if (!S.next(0, cur)) return;
    f32x4 acc[2][2][4][2];
#pragma unroll
    for (int a = 0; a < 2; ++a)
#pragma unroll
        for (int b = 0; b < 2; ++b)
#pragma unroll
            for (int m = 0; m < 4; ++m)
#pragma unroll
                for (int n = 0; n < 2; ++n) acc[a][b][m][n] = (f32x4){0.f, 0.f, 0.f, 0.f};
    bf16x8 At[4][2], B0[2][2], B1[2][2];
    const char* cA = (const char*)g.A + (size_t)cur.pm * tstep; const char* cB = (const char*)g.Bt + (size_t)cur.pn * tstep;
    S.a_ready(cur);
    if constexpr (SP2) {
        PG8_STAGE(PG8_SB(0, 0), cB, voffB); PG8_STAGE(PG8_SB(0, 1), cB + hstep, voffB); PG8_STAGE(PG8_SA(0, 0), cA, voffA); PG8_STAGE(PG8_SA(0, 1), cA + hstep, voffA);
        if (wr == 1) PG8_BAR;
        PG8_WAIT_V(2); PG8_BAR;
        PG8_STAGE(PG8_SB(1, 0), cB + kstep, voffB); PG8_STAGE(PG8_SA(1, 0), cA + kstep, voffA); PG8_STAGE(PG8_SB(1, 1), cB + hstep + kstep, voffB);
        PG8_WAIT_V(6); PG8_BAR;
    } else {
        PG8_STAGE(PG8_SB(0, 0), cB, voffB); PG8_STAGE(PG8_SA(0, 0), cA, voffA); PG8_STAGE(PG8_SB(0, 1), cB + hstep, voffB); PG8_STAGE(PG8_SA(0, 1), cA + hstep, voffA);
        if (wr == 1) PG8_BAR;
        PG8_WAIT_V(4); PG8_BAR;
        PG8_STAGE(PG8_SB(1, 0), cB + kstep, voffB); PG8_STAGE(PG8_SA(1, 0), cA + kstep, voffA); PG8_STAGE(PG8_SB(1, 1), cB + hstep + kstep, voffB);
        PG8_WAIT_V(6); PG8_BAR;
    }
    for (;;) {
        const bool has_next = S.next(ui + 1, nxt);
        const char* nA = has_next ? (const char*)g.A + (size_t)nxt.pm * tstep : cA; const char* nB = has_next ? (const char*)g.Bt + (size_t)nxt.pn * tstep : cB;
        for (int t = 0; t < nt; t += 2) {
            if constexpr (Epi::MIDK) { if (t == nt / 2) E.midk(acc, ui, wr, fr); }
            const bool last = (t == nt - 2);
            const char* a1 = cA + (size_t)(t + 1) * kstep;
            const char* a2 = last ? nA : cA + (size_t)(t + 2) * kstep; const char* b2 = last ? nB : cB + (size_t)(t + 2) * kstep;
            const char* a3 = a2 + kstep; const char* b3 = b2 + kstep;
            if (last && has_next) S.a_ready(nxt);
            if constexpr (SP2) {
            PG8_LDB(B0, 0, 0); PG8_LDB(B1, 0, 1); PG8_SCHED; PG8_LDA(At, 0, 0); PG8_STAGE(PG8_SA(1, 1), a1 + hstep, voffA);
            PG8_WAIT_V(8); PG8_WAIT_L(0); PG8_BAR; PG8_MMA(0, 0, At, B0); PG8_MMA(0, 1, At, B1); PG8_BAR; PG8_SCHED;
            PG8_LDA(At, 0, 1); PG8_STAGE(PG8_SB(0, 0), b2, voffB); PG8_STAGE(PG8_SB(0, 1), b2 + hstep, voffB); PG8_STAGE(PG8_SA(0, 0), a2, voffA);
            PG8_WAIT_V(8); PG8_WAIT_L(0); PG8_BAR; PG8_MMA(1, 0, At, B0); PG8_MMA(1, 1, At, B1); PG8_BAR; PG8_SCHED;
            PG8_LDB(B0, 1, 0); PG8_LDB(B1, 1, 1); PG8_SCHED; PG8_LDA(At, 1, 0); PG8_STAGE(PG8_SA(0, 1), a2 + hstep, voffA);
            PG8_WAIT_V(8); PG8_WAIT_L(0); PG8_BAR; PG8_MMA(0, 0, At, B0); PG8_MMA(0, 1, At, B1); PG8_BAR; PG8_SCHED;
            PG8_LDA(At, 1, 1); PG8_STAGE(PG8_SB(1, 0), b3, voffB); PG8_STAGE(PG8_SB(1, 1), b3 + hstep, voffB); PG8_STAGE(PG8_SA(1, 0), a3, voffA);
            PG8_WAIT_V(8); PG8_WAIT_L(0); PG8_BAR; PG8_MMA(1, 0, At, B0); PG8_MMA(1, 1, At, B1); PG8_BAR; PG8_SCHED;
            } else {
            PG8_LDB(B0, 0, 0); PG8_SCHED; PG8_LDA(At, 0, 0); PG8_STAGE(PG8_SA(1, 1), a1 + hstep, voffA);
            PG8_WAIT_L(8); PG8_BAR; PG8_WAIT_L(0); PG8_MMA(0, 0, At, B0); PG8_BAR; PG8_SCHED;
            PG8_LDB(B1, 0, 1); PG8_STAGE(PG8_SB(0, 0), b2, voffB);
            PG8_BAR; PG8_WAIT_L(0); PG8_MMA(0, 1, At, B1); PG8_BAR;
            PG8_LDA(At, 0, 1); PG8_STAGE(PG8_SA(0, 0), a2, voffA);
            PG8_BAR; PG8_WAIT_L(0); PG8_MMA(1, 0, At, B0); PG8_BAR; PG8_SCHED;
            PG8_STAGE(PG8_SB(0, 1), b2 + hstep, voffB);
            PG8_WAIT_V(6); PG8_BAR; PG8_MMA(1, 1, At, B1); PG8_BAR;
            PG8_LDB(B0, 1, 0); PG8_SCHED; PG8_LDA(At, 1, 0); PG8_STAGE(PG8_SA(0, 1), a2 + hstep, voffA);
            PG8_WAIT_L(8); PG8_BAR; PG8_WAIT_L(0); PG8_MMA(0, 0, At, B0); PG8_BAR; PG8_SCHED;
            PG8_LDB(B1, 1, 1); PG8_STAGE(PG8_SB(1, 0), b3, voffB);
            PG8_BAR; PG8_WAIT_L(0); PG8_MMA(0, 1, At, B1); PG8_BAR;
            PG8_LDA(At, 1, 1); PG8_STAGE(PG8_SA(1, 0), a3, voffA);
            PG8_BAR; PG8_WAIT_L(0); PG8_MMA(1, 0, At, B0); PG8_BAR; PG8_SCHED;
            PG8_STAGE(PG8_SB(1, 1), b3 + hstep, voffB);
            PG8_WAIT_V(6); PG8_BAR; PG8_MMA(1, 1, At, B1); PG8_BAR;
            }
        }
        if constexpr (ALIGN_EPI) { if (wr == 0) PG8_BAR; }
        if constexpr (!Epi::AFTER_DRAIN) { E(acc, cur, wr, wc, fr, fq); S.done(cur); }
        if (!has_next) break;
#pragma unroll
        for (int a = 0; a < 2; ++a)
#pragma unroll
            for (int b = 0; b < 2; ++b)
#pragma unroll
                for (int m = 0; m < 4; ++m)
#pragma unroll
                    for (int n = 0; n < 2; ++n) acc[a][b][m][n] = (f32x4){0.f, 0.f, 0.f, 0.f};
        cur = nxt; cA = nA; cB = nB; ++ui;
        if constexpr (ALIGN_EPI) { if (wr == 1) PG8_BAR; }
    }
    PG8_WAIT_V(0);
    if constexpr (!ALIGN_EPI) { if (wr == 0) PG8_BAR; }
    PG8_BAR;
    if constexpr (Epi::AFTER_DRAIN) { E.fused(acc, cur, wr, wc, fr, fq, lds, wid, lane); S.done(cur); }
#undef PG8_SA
#undef PG8_SB
#undef PG8_STAGE
#undef PG8_LDA
#undef PG8_LDB
#undef PG8_MMA
#undef PG8_WAIT_V
#undef PG8_WAIT_L
#undef PG8_BAR
#undef PG8_SCHED
}
struct Sched1 {
    int G, c;
    __device__ __forceinline__ void init(int G_, int c_) { G = G_; c = c_; }
    __device__ __forceinline__ bool next(int i, Unit& u) const {
        constexpr int nN = 21, nwg = 256 * nN;
        const int L = i * G + c;
        if (L < nwg) { const int wgid = (L % NXCD) * (nwg / NXCD) + L / NXCD; const int nig = WGM * nN, fm = (wgid / nig) * WGM;
            u.pm = fm + ((wgid % nig) % WGM); u.pn = (wgid % nig) / WGM; return true; }
        const int L2 = L - nwg; if (L2 >= 256) return false;
        const int wg = (L2 % NXCD) * 32 + L2 / NXCD; u.pn = wg >> 5; u.pm = 256 + (wg & 31); return true;
    }
    __device__ __forceinline__ void a_ready(const Unit&) const {}
    __device__ __forceinline__ void done(const Unit&) const {}
};
struct Sched2 {
    int G, c;
    __device__ __forceinline__ void init(int G_, int c_) { G = G_; c = c_; }
    __device__ __forceinline__ bool next(int i, Unit& u) const {
        constexpr int nN = 4, nwg = 256 * nN;
        const int L = i * G + c; if (L >= nwg) return false;
        const int wgid = (L % NXCD) * (nwg / NXCD) + L / NXCD; const int nig = WGM * nN, fm = (wgid / nig) * WGM;
        u.pm = fm + ((wgid % nig) % WGM); u.pn = (wgid % nig) / WGM; return true;
    }
    __device__ __forceinline__ void a_ready(const Unit&) const {}
    __device__ __forceinline__ void done(const Unit&) const {}
};
__device__ __forceinline__ float dot4(const f32x4 a) { return (a[0] * a[0] + a[1] * a[1]) + (a[2] * a[2] + a[3] * a[3]); }
__device__ __forceinline__ float silu1(float v) { return v * __builtin_amdgcn_rcpf(1.f + __expf(-v)); }
typedef unsigned u32x2 __attribute__((ext_vector_type(2)));
__device__ __forceinline__ u32x2 pk4(const f32x4 v) { u32x2 w; w.x = cvt_pk_bf16(v[0], v[1]); w.y = cvt_pk_bf16(v[2], v[3]); return w; }
struct Epi1 {
    static constexpr bool PERM = true, AFTER_DRAIN = false, MIDK = false;
    bf16_t *KB, *VB, *XBC, *YQ, *Z; float* DT; const float *rope, *qg, *kg, *dt_bias;
    __device__ __forceinline__ void midk(f32x4 (&)[2][2][4][2], int, int, int) const {}
    __device__ __forceinline__ void operator()(const f32x4 (&acc)[2][2][4][2], const Unit& u, int wr, int wc, int fr_in, int fq_in) const {
        int fr = fr_in, fq = fq_in; asm volatile("" : "+v"(fr), "+v"(fq));
        const int pn = u.pn, pm = u.pm; const bool isctx = pm >= 256; const int rloc = wr * 64 + fr;
        const int bb = isctx ? pm - 256 : pm >> 3, pos0 = isctx ? SEQ : (pm & 7) * 256;
        if (pn == 0 || (pn >= 9 && pn < 13)) {
            const float* g = pn == 0 ? kg : qg;
            const f32x4 g00 = *(const f32x4*)(g + 4 * fq), g01 = *(const f32x4*)(g + 16 + 4 * fq), g10 = *(const f32x4*)(g + 32 + 4 * fq), g11 = *(const f32x4*)(g + 48 + 4 * fq);
            const float osc = pn == 0 ? 1.f : C2;
            bf16_t* dbase; size_t pitch;
            if (pn == 0) { dbase = KB + ((size_t)bb * KVL + pos0) * 256 + wc * 64 + 4 * fq; pitch = 256; }
            else { dbase = YQ + (size_t)pm * 256 * 2048 + 1024 + ((pn - 9) * 4 + wc) * 64 + 4 * fq; pitch = 2048; }
#pragma unroll
            for (int ai = 0; ai < 2; ++ai) {
                const int prow = (pm & 7) * 4 + 2 * ai + wr;
                f32x4 c0 = (f32x4){1.f, 1.f, 1.f, 1.f}, s0 = (f32x4){0.f, 0.f, 0.f, 0.f};
                if (!isctx) { c0 = *(const f32x4*)(rope + prow * 16 + 4 * fq); s0 = *(const f32x4*)(rope + 1024 + prow * 16 + 4 * fq); }
#pragma unroll
                for (int m = 0; m < 4; ++m) {
                    f32x4 a0 = acc[ai][0][m][0], a1 = acc[ai][0][m][1], b0 = acc[ai][1][m][0], b1 = acc[ai][1][m][1];
                    float s = (dot4(a0) + dot4(a1)) + (dot4(b0) + dot4(b1));
                    s += __shfl_xor(s, 16); s += __shfl_xor(s, 32);
                    const float rstd = rsqrtf(s * (1.f / 64.f) + EPS) * osc;
                    a0 = a0 * rstd * g00; a1 = a1 * rstd * g01; b0 = b0 * rstd * g10; b1 = b1 * rstd * g11;
                    f32x4 c1 = (f32x4){1.f, 1.f, 1.f, 1.f}, s1 = (f32x4){0.f, 0.f, 0.f, 0.f};
                    if (!isctx) { const int pcol = 16 * m + fr; c1 = *(const f32x4*)(rope + pcol * 16 + 4 * fq); s1 = *(const f32x4*)(rope + 1024 + pcol * 16 + 4 * fq); }
                    const f32x4 o00 = a0 * c0 - a1 * s0, o01 = a1 * c0 + a0 * s0, o10 = b0 * c1 - b1 * s1, o11 = b1 * c1 + b0 * s1;
                    bf16_t* dst = dbase + (size_t)(rloc + 128 * ai + 16 * m) * pitch;
                    *(u32x2*)(dst) = pk4(o00); *(u32x2*)(dst + 16) = pk4(o01); *(u32x2*)(dst + 32) = pk4(o10); *(u32x2*)(dst + 48) = pk4(o11);
                    asm volatile("" ::: "memory");
                }
            }
        } else if (pn == 8) {
            if (wc == 0) {
                const f32x4 bA = *(const f32x4*)(dt_bias + 8 * fq), bB = *(const f32x4*)(dt_bias + 8 * fq + 4);
#pragma unroll
                for (int ai = 0; ai < 2; ++ai)
#pragma unroll
                    for (int m = 0; m < 4; ++m) { const size_t row = (size_t)pm * 256 + rloc + 128 * ai + 16 * m;
                        f32x4 v0 = acc[ai][0][m][0] + bA, v1 = acc[ai][0][m][1] + bB;
#pragma unroll
                        for (int e = 0; e < 4; ++e) { v0[e] = v0[e] > 20.f ? v0[e] : log1pf(__expf(v0[e])); v1[e] = v1[e] > 20.f ? v1[e] : log1pf(__expf(v1[e])); }
                        *(f32x4*)(DT + row * 32 + 8 * fq) = v0; *(f32x4*)(DT + row * 32 + 8 * fq + 4) = v1; asm volatile("" ::: "memory"); }
            }
        } else {
            bf16_t* dbase; size_t pitch; bool act = false;
            const int cin = wc * 32 + 8 * fq;
            if (pn == 1) { dbase = VB + ((size_t)bb * KVL + pos0) * 256 + cin; pitch = 256; }
            else if (pn < 8) { dbase = XBC + (size_t)pm * 256 * CONVC + (pn - 2) * 256 + cin; pitch = CONVC; }
            else if (pn < 17) { dbase = YQ + (size_t)pm * 256 * 2048 + (pn - 13) * 256 + cin; pitch = 2048; act = true; }
            else { dbase = Z + (size_t)pm * 256 * 1024 + (pn - 17) * 256 + cin; pitch = 1024; act = true; }
#pragma unroll
            for (int ai = 0; ai < 2; ++ai)
#pragma unroll
                for (int m = 0; m < 4; ++m) { bf16_t* dst = dbase + (size_t)(rloc + 128 * ai + 16 * m) * pitch;
#pragma unroll
                    for (int bj = 0; bj < 2; ++bj) { f32x4 v0 = acc[ai][bj][m][0], v1 = acc[ai][bj][m][1];
                        if (act) {
#pragma unroll
                            for (int e = 0; e < 4; ++e) { v0[e] = silu1(v0[e]); v1[e] = silu1(v1[e]); } }
                        u32x4 w; w.x = cvt_pk_bf16(v0[0], v0[1]); w.y = cvt_pk_bf16(v0[2], v0[3]); w.z = cvt_pk_bf16(v1[0], v1[1]); w.w = cvt_pk_bf16(v1[2], v1[3]);
                        *(u32x4*)(dst + bj * HALF) = w; } asm volatile("" ::: "memory"); }
        }
    }
};
struct Epi2 {
    static constexpr bool PERM = false, AFTER_DRAIN = false, MIDK = true;
    const float* x; const float* mod; const float* fg; float* out; unsigned long long* xbuf; unsigned* cnt; unsigned* tmo; const PG8_LAS float* rstd_tab; PG8_LAS float* exl;
    __device__ __forceinline__ void midk(f32x4 (&acc)[2][2][4][2], int ui, int wr, int fr) const {
#pragma unroll
        for (int ai = 0; ai < 2; ++ai)
#pragma unroll
            for (int m = 0; m < 4; ++m) { const float r = rstd_tab[ui * 256 + 128 * ai + 64 * wr + 16 * m + fr];
#pragma unroll
                for (int bj = 0; bj < 2; ++bj)
#pragma unroll
                    for (int n = 0; n < 2; ++n) acc[ai][bj][m][n] *= r; }
    }
    __device__ __forceinline__ void operator()(f32x4 (&acc)[2][2][4][2], const Unit& u, int wr, int wc, int fr_in, int fq_in) const {
        int fr = fr_in, fq = fq_in; asm volatile("" : "+v"(fr), "+v"(fq));
        const int lane = mk_lane(); const int tid = (wr * 4 + wc) * 64 + lane;
        const int b = u.pm >> 3, col0 = u.pn * BM + wc * 32 + 4 * fq;
        PG8_LAS float* P = exl; PG8_LAS float* S = exl + 1024;
        { f32x4 gv[2][2];
#pragma unroll
          for (int bj = 0; bj < 2; ++bj)
#pragma unroll
            for (int n = 0; n < 2; ++n) gv[bj][n] = *(const f32x4*)(mod + (size_t)b * 3072 + 2048 + col0 + bj * HALF + n * 16);
#pragma unroll
          for (int ai = 0; ai < 2; ++ai)
#pragma unroll
            for (int m = 0; m < 4; ++m) { const int rt = 128 * ai + 64 * wr + 16 * m + fr; const size_t off = ((size_t)u.pm * BM + rt) * 1024 + col0; float q = 0.f;
#pragma unroll
                for (int bj = 0; bj < 2; ++bj)
#pragma unroll
                    for (int n = 0; n < 2; ++n) { const f32x4 xv = *(const f32x4*)(x + off + bj * HALF + n * 16); const f32x4 o = xv + gv[bj][n] * acc[ai][bj][m][n]; acc[ai][bj][m][n] = o; q += dot4(o); }
                q += __shfl_xor(q, 16); q += __shfl_xor(q, 32);
                if (fq == 0) P[rt * 4 + wc] = q;
                if (m == 3) asm volatile("" ::: "memory"); } }
        asm volatile("s_waitcnt lgkmcnt(0)" ::: "memory"); __builtin_amdgcn_s_barrier(); asm volatile("" ::: "memory");
        if (tid < 256) {
            const f32x4 p = *(const PG8_LAS f32x4*)(P + tid * 4); const float s = (p[0] + p[1]) + (p[2] + p[3]);
            __hip_atomic_store((float*)xbuf + ((size_t)u.pm * BM + tid) * 4 + u.pn, s, __ATOMIC_RELAXED, __HIP_MEMORY_SCOPE_AGENT);
        }
        asm volatile("s_waitcnt vmcnt(0)" ::: "memory");
        if (tid < 256 && lane == 0) __hip_atomic_fetch_add(cnt + 64 * u.pm, 1u, __ATOMIC_RELAXED, __HIP_MEMORY_SCOPE_AGENT);
        if (tid < 64) {
            unsigned sp = 0;
            while ((unsigned)__builtin_amdgcn_readfirstlane(__hip_atomic_load(cnt + 64 * u.pm, __ATOMIC_RELAXED, __HIP_MEMORY_SCOPE_AGENT)) < 16u) {
                __builtin_amdgcn_s_sleep(2); if (++sp > (1u << 22)) { if (lane == 0) __hip_atomic_store(tmo, 1u, __ATOMIC_RELAXED, __HIP_MEMORY_SCOPE_AGENT); break; } }
        }
        asm volatile("s_waitcnt vmcnt(0) lgkmcnt(0)" ::: "memory"); __builtin_amdgcn_s_barrier(); asm volatile("" ::: "memory");
        if (tid < 256) {
            const unsigned long long* sl = xbuf + ((size_t)u.pm * BM + tid) * 2;
            const unsigned long long w0 = __hip_atomic_load(sl, __ATOMIC_RELAXED, __HIP_MEMORY_SCOPE_AGENT), w1 = __hip_atomic_load(sl + 1, __ATOMIC_RELAXED, __HIP_MEMORY_SCOPE_AGENT);
            const float s = (__uint_as_float((unsigned)w0) + __uint_as_float((unsigned)(w0 >> 32))) + (__uint_as_float((unsigned)w1) + __uint_as_float((unsigned)(w1 >> 32)));
            S[tid] = rsqrtf(s * (1.f / 1024.f) + EPS);
        }
        asm volatile("s_waitcnt lgkmcnt(0)" ::: "memory"); __builtin_amdgcn_s_barrier(); asm volatile("" ::: "memory");
        { f32x4 fv[2][2];
#pragma unroll
          for (int bj = 0; bj < 2; ++bj)
#pragma unroll
            for (int n = 0; n < 2; ++n) fv[bj][n] = *(const f32x4*)(fg + col0 + bj * HALF + n * 16);
#pragma unroll
          for (int ai = 0; ai < 2; ++ai)
#pragma unroll
            for (int m = 0; m < 4; ++m) { const int rt = 128 * ai + 64 * wr + 16 * m + fr; const size_t off = ((size_t)u.pm * BM + rt) * 1024 + col0; const float r = S[rt];
#pragma unroll
                for (int bj = 0; bj < 2; ++bj)
#pragma unroll
                    for (int n = 0; n < 2; ++n) *(f32x4*)(out + off + bj * HALF + n * 16) = acc[ai][bj][m][n] * r * fv[bj][n];
                if (m & 1) asm volatile("" ::: "memory"); } }
    }
};
}
#define GAS __attribute__((address_space(1)))
#define LAS __attribute__((address_space(3)))
typedef unsigned v4u __attribute__((ext_vector_type(4)));
typedef GAS unsigned gu32;
typedef GAS unsigned long long gu64;
#define RLX_AGENT __ATOMIC_RELAXED, __HIP_MEMORY_SCOPE_AGENT
#define LDS_WAIT() asm volatile("s_waitcnt lgkmcnt(0)" ::: "memory")
#define VM_WAIT() asm volatile("s_waitcnt vmcnt(0)" ::: "memory")
__device__ __forceinline__ unsigned long long rt() { return __builtin_amdgcn_s_memrealtime(); }
typedef float f32x2_pk __attribute__((ext_vector_type(2))); typedef __bf16 bf16x2_pk __attribute__((ext_vector_type(2)));
__device__ __forceinline__ unsigned pk2(float lo, float hi) { const f32x2_pk v = {lo, hi}; return __builtin_bit_cast(unsigned, __builtin_convertvector(v, bf16x2_pk)); }
#define XB_TMO      128
#define XB_XCNT(j)  (256  + 64 * (j))
#define XB_XSUB(j)  (1280 + 64 * (j))
#define XB_XGEN(j)  (2304 + 64 * (j))
#define XB_TOP      3328
#define XB_TOPGEN   3392
#define XCD_BAR_WORDS 3456
#define XB_SPIN_CAP (1u << 22)

__device__ __forceinline__ unsigned xb_ld(unsigned* p)              { return __hip_atomic_load(p, __ATOMIC_RELAXED, __HIP_MEMORY_SCOPE_AGENT); }
__device__ __forceinline__ unsigned xb_add(unsigned* p, unsigned v) { return __hip_atomic_fetch_add(p, v, __ATOMIC_RELAXED, __HIP_MEMORY_SCOPE_AGENT); }
__device__ __forceinline__ unsigned xb_xcc_id() { return (unsigned)__builtin_amdgcn_s_getreg((3 << 11) | 20) & 0xFu; }
#define XB_SPIN(cond, bar) do { unsigned _sp = 0; while (cond) { __builtin_amdgcn_s_sleep(1); \
    if ((++_sp & 255u) == 0u) { if (xb_ld(&(bar)[XB_TMO])) break; if (_sp > XB_SPIN_CAP) { atomicAdd(&(bar)[XB_TMO], 1u); break; } } } } while (0)

struct XcdBarrier {
    unsigned* bar; unsigned x;
    volatile LAS unsigned* st;
};

__device__ __forceinline__ XcdBarrier xcd_barrier_post(unsigned* bar, volatile LAS unsigned* st, bool leader) {
    XcdBarrier b; b.bar = bar; b.x = xb_xcc_id(); b.st = st;
    if (leader) (void)xb_add(&bar[XB_XCNT(b.x)], 1u);
    return b;
}
__device__ __forceinline__ void xcd_barrier_complete(unsigned* bar, unsigned x, unsigned& nloc, unsigned& nx) {
    const unsigned G = gridDim.x * gridDim.y * gridDim.z;
    unsigned sum, cnt, mine, sp = 0u;
    for (;;) {
        sum = 0u; cnt = 0u; mine = 0u;
#pragma unroll
        for (unsigned j = 0; j < 16; ++j) { const unsigned c = xb_ld(&bar[XB_XCNT(j)]); sum += c; cnt += (c > 0u) ? 1u : 0u; mine = (j == x) ? c : mine; }
        if (sum == G) break;
        __builtin_amdgcn_s_sleep(1);
        if ((++sp & 255u) == 0u) { if (xb_ld(&bar[XB_TMO])) break; if (sp > XB_SPIN_CAP) { atomicAdd(&bar[XB_TMO], 1u); break; } }
    }
    nloc = mine > 0u ? mine : 1u; nx = cnt > 0u ? cnt : 1u;
}

__device__ __forceinline__ void xcd_barrier(const XcdBarrier& b, bool leader) {
    asm volatile("s_waitcnt vmcnt(0)" ::: "memory");
    __syncthreads();
    if (leader) {
        unsigned* bar = b.bar;
        __builtin_amdgcn_s_waitcnt(0);
        unsigned nloc = b.st[0], nx = b.st[1];
        if (nloc == 0u) { xcd_barrier_complete(bar, b.x, nloc, nx); b.st[0] = nloc; b.st[1] = nx; }
        const unsigned old = xb_add(&bar[XB_XSUB(b.x)], 1u);
        const unsigned gen = old / nloc;
        if (old + 1u == (gen + 1u) * nloc) {
            __builtin_amdgcn_fence(__ATOMIC_RELEASE, "agent");
            asm volatile("s_waitcnt vmcnt(0)" ::: "memory");
            const unsigned og = xb_add(&bar[XB_TOP], 1u);
            const unsigned tg = og / nx;
            if (og + 1u == (tg + 1u) * nx) xb_add(&bar[XB_TOPGEN], 1u);
            else XB_SPIN(xb_ld(&bar[XB_TOPGEN]) == tg, bar);
            __builtin_amdgcn_fence(__ATOMIC_ACQUIRE, "agent");
            xb_add(&bar[XB_XGEN(b.x)], 1u);
            asm volatile("s_waitcnt vmcnt(0)" ::: "memory");
        } else {
            XB_SPIN(xb_ld(&bar[XB_XGEN(b.x)]) == gen, bar);
            __builtin_amdgcn_fence(__ATOMIC_ACQUIRE, "agent");
            asm volatile("s_waitcnt vmcnt(0)" ::: "memory");
        }
    }
    __syncthreads();
}

typedef float f32x4 __attribute__((ext_vector_type(4)));
constexpr int NWAVES = 8;
__device__ __forceinline__ float wave_sum(float v) {
#pragma unroll
    for (int o = 1; o < 64; o <<= 1) v += __shfl_xor(v, o);
    return v;
}
__device__ __forceinline__ float dot4g(const f32x4 a) { return (a[0] * a[0] + a[1] * a[1]) + (a[2] * a[2] + a[3] * a[3]); }
__device__ __forceinline__ void p0_bt1_item(const float* W, bf16* WT, LAS float* scr, int item, int lane) {
    const int kb = item / 168, vb = item % 168, k0 = 64 * kb, v0 = 32 * vb;
    const int a = vcol_actual(v0 + (lane & 31));
#pragma unroll 8
    for (int i = 0; i < 32; ++i) { const int kk = 2 * i + (lane >> 5); scr[kk * 33 + (lane & 31)] = a >= 0 ? W[(size_t)(k0 + kk) * PROJ + a] : 0.f; }
    LDS_WAIT(); asm volatile("" ::: "memory");
    const int c = lane & 7;
#pragma unroll
    for (int j = 0; j < 4; ++j) { const int n = (lane >> 3) + 8 * j; const LAS float* s = scr + (8 * c) * 33 + n;
        v4u o; o.x = pk2(s[0 * 33], s[1 * 33]); o.y = pk2(s[2 * 33], s[3 * 33]); o.z = pk2(s[4 * 33], s[5 * 33]); o.w = pk2(s[6 * 33], s[7 * 33]);
        *(GAS v4u*)(WT + (size_t)(v0 + n) * 1024 + k0 + 8 * c) = o; }
    LDS_WAIT(); asm volatile("" ::: "memory");
}
__device__ __forceinline__ void p0_bt2_item(const float* W, const float* sg, bf16* WT, LAS float* scr, int item, int lane) {
    const int kb = item >> 5, nb = item & 31, kk0 = 64 * kb, n0 = 32 * nb;
#pragma unroll 8
    for (int i = 0; i < 32; ++i) { const int kk = 2 * i + (lane >> 5), kq = kk0 + kk; const int ks = kq < 1024 ? 1024 + kq : kq - 1024;
        float v = W[(size_t)ks * 1024 + n0 + (lane & 31)]; if (kq < 1024) v *= sg[kq]; scr[kk * 33 + (lane & 31)] = v; }
    LDS_WAIT(); asm volatile("" ::: "memory");
    const int c = lane & 7;
#pragma unroll
    for (int j = 0; j < 4; ++j) { const int n = (lane >> 3) + 8 * j; const LAS float* s = scr + (8 * c) * 33 + n;
        v4u o; o.x = pk2(s[0 * 33], s[1 * 33]); o.y = pk2(s[2 * 33], s[3 * 33]); o.z = pk2(s[4 * 33], s[5 * 33]); o.w = pk2(s[6 * 33], s[7 * 33]);
        *(GAS v4u*)(WT + (size_t)(n0 + n) * 2048 + kk0 + 8 * c) = o; }
    LDS_WAIT(); asm volatile("" ::: "memory");
}
__device__ __forceinline__ void p0_mod_block(const float* c, const float* c_ctx, const float* ada_w, const float* ada_b, float* mod, LAS float* ldsf, int cb, int tid, int lane, int wave) {
    LAS float* sil = ldsf; LAS float* red = ldsf + 33 * 256;
    float acc[33];
#pragma unroll
    for (int b = 0; b < 33; ++b) acc[b] = 0.f;
    for (int q = 0; q < 4; ++q) {
        __syncthreads();
        for (int e = tid; e < 33 * 256; e += NWAVES * 64) { const int b = e >> 8, k = e & 255; const float v = b < 32 ? c[b * 1024 + q * 256 + k] : c_ctx[q * 256 + k]; sil[e] = siluf(v); }
        __syncthreads();
#pragma unroll 8
        for (int kk = 0; kk < 32; ++kk) { const int kl = wave * 32 + kk; const float w = ada_w[(size_t)(q * 256 + kl) * 3072 + cb * 64 + lane];
#pragma unroll
            for (int b = 0; b < 33; ++b) acc[b] += sil[b * 256 + kl] * w; }
    }
#pragma unroll
    for (int b = 0; b < 33; ++b) red[(wave * 33 + b) * 64 + lane] = acc[b];
    __syncthreads();
    for (int e = tid; e < 33 * 64; e += NWAVES * 64) { const int b = e >> 6, col = e & 63; float s = 0.f;
#pragma unroll
        for (int w = 0; w < 8; ++w) s += red[(w * 33 + b) * 64 + col];
        mod[b * 3072 + cb * 64 + col] = s + ada_b[cb * 64 + col]; }
    __syncthreads();
}
__device__ __forceinline__ const float* p1_src(const float* x, const float* ctx, int m) { return m < ML ? x + (size_t)m * DM : ctx + (size_t)(m - ML) * DM; }
__device__ __forceinline__ void p1_load4(f32x4 (&v)[4][4], const float* x, const float* ctx, int m0, int lane) {
#pragma unroll
    for (int r = 0; r < 4; ++r) { const GAS f32x4* xr = (const GAS f32x4*)p1_src(x, ctx, m0 + r) + lane;
#pragma unroll
        for (int j = 0; j < 4; ++j) v[r][j] = xr[64 * j]; }
}
__device__ __forceinline__ void p1_proc4(const f32x4 (&v)[4][4], const float* mod, const float* ng, bf16* H, int m0, int lane) {
#pragma unroll
    for (int r = 0; r < 4; ++r) { const int m = m0 + r; const float* md = mod + (size_t)(m < ML ? m / SEQ : 32) * 3072;
        float s = 0.f;
#pragma unroll
        for (int j = 0; j < 4; ++j) s += dot4g(v[r][j]);
        const float rstd = rsqrtf(wave_sum(s) * (1.f / DM) + EPS);
        GAS unsigned long long* o8 = (GAS unsigned long long*)(H + (size_t)m * DM) + lane;
#pragma unroll
        for (int j = 0; j < 4; ++j) { const int k = 4 * lane + 256 * j;
            const f32x4 g = *(const f32x4*)(ng + k), sc = *(const f32x4*)(md + 1024 + k), sh = *(const f32x4*)(md + k);
            const f32x4 h = v[r][j] * rstd * g * (sc + 1.f) + sh;
            o8[64 * j] = (unsigned long long)pk2(h[0], h[1]) | ((unsigned long long)pk2(h[2], h[3]) << 32); }
    }
}
__device__ __forceinline__ void conv_phase(const bf16* XBC, const float* cw, const float* cb, bf16* XC, int bx, int G, int tid) {
    if (tid < 384) {
        const int cg = tid % 192, sub = tid / 192;
        f32x4 w[5][2], bias[2];
#pragma unroll
        for (int j = 0; j < 5; ++j) { w[j][0] = *(const f32x4*)(cw + j * CONVC + cg * 8); w[j][1] = *(const f32x4*)(cw + j * CONVC + cg * 8 + 4); }
        bias[0] = *(const f32x4*)(cb + cg * 8); bias[1] = *(const f32x4*)(cb + cg * 8 + 4);
        for (int seg = bx; seg < MT / 32; seg += G) {
            const int row0 = seg * 32 + sub * 16; int t0, len;
            if (row0 < ML) { t0 = row0 % SEQ; len = SEQ; } else { t0 = (row0 - ML) % CTXL; len = CTXL; }
            const bf16* src = XBC + (size_t)row0 * CONVC + cg * 8; bf16* dst = XC + (size_t)row0 * CONVC + cg * 8;
            f32x4 r[5][2];
#pragma unroll
            for (int j = 0; j < 5; ++j) { const int tt = t0 + j - 2; v4u u = (v4u){0u, 0u, 0u, 0u};
                if (tt >= 0 && tt < len) u = *(const v4u*)(src + (ptrdiff_t)(j - 2) * CONVC);
                r[j][0] = (f32x4){__uint_as_float(u.x << 16), __uint_as_float(u.x & 0xffff0000u), __uint_as_float(u.y << 16), __uint_as_float(u.y & 0xffff0000u)};
                r[j][1] = (f32x4){__uint_as_float(u.z << 16), __uint_as_float(u.z & 0xffff0000u), __uint_as_float(u.w << 16), __uint_as_float(u.w & 0xffff0000u)}; }
#pragma unroll
            for (int i = 0; i < 16; ++i) {
                f32x4 a0 = bias[0], a1 = bias[1];
#pragma unroll
                for (int j = 0; j < 5; ++j) { a0 += w[j][0] * r[j][0]; a1 += w[j][1] * r[j][1]; }
#pragma unroll
                for (int e = 0; e < 4; ++e) { a0[e] = siluf(a0[e]); a1[e] = siluf(a1[e]); }
                v4u o; o.x = pk2(a0[0], a0[1]); o.y = pk2(a0[2], a0[3]); o.z = pk2(a1[0], a1[1]); o.w = pk2(a1[2], a1[3]);
                *(v4u*)(dst + (size_t)i * CONVC) = o;
#pragma unroll
                for (int j = 0; j < 4; ++j) { r[j][0] = r[j + 1][0]; r[j][1] = r[j + 1][1]; }
                const int tt = t0 + i + 3; v4u u = (v4u){0u, 0u, 0u, 0u};
                if (i < 15 && tt < len) u = *(const v4u*)(src + (size_t)(i + 3) * CONVC);
                r[4][0] = (f32x4){__uint_as_float(u.x << 16), __uint_as_float(u.x & 0xffff0000u), __uint_as_float(u.y << 16), __uint_as_float(u.y & 0xffff0000u)};
                r[4][1] = (f32x4){__uint_as_float(u.z << 16), __uint_as_float(u.z & 0xffff0000u), __uint_as_float(u.w << 16), __uint_as_float(u.w & 0xffff0000u)};
            }
        }
    }
}
__device__ __forceinline__ void ssd_item_naive(int b, int h, const bf16* XC, const float* DT, const bf16* Z, const float* a_log, const float* d_skip, bf16* YQ, float* SSQ, LAS float* ysq, int tid) {
    const int p = tid >> 3, nc = tid & 7, g = h >> 3;
    for (int dd = 0; dd < 2; ++dd) { const int d = 1 - dd;
        const float a_neg = -expf(a_log[d * 16 + h]);
        float S[16];
#pragma unroll
        for (int j = 0; j < 16; ++j) S[j] = 0.f;
        for (int seq = 0; seq < 2; ++seq) { const int len = seq == 0 ? CTXL : SEQ; const size_t rbase = seq == 0 ? (size_t)ML + (size_t)b * CTXL : (size_t)b * SEQ;
            for (int st = 0; st < len; ++st) { const int t = d ? len - 1 - st : st; const size_t row = rbase + t;
                const float dt = DT[row * 32 + d * 16 + h]; const float dec = expf(dt * a_neg);
                const float xs = bf2f(XC[row * CONVC + h * 64 + p]); const float X = xs * dt;
                const v4u b0 = *(const v4u*)(XC + row * CONVC + 1024 + g * 128 + nc * 16), b1 = *(const v4u*)(XC + row * CONVC + 1024 + g * 128 + nc * 16 + 8);
                const v4u c0 = *(const v4u*)(XC + row * CONVC + 1280 + g * 128 + nc * 16), c1 = *(const v4u*)(XC + row * CONVC + 1280 + g * 128 + nc * 16 + 8);
                const unsigned bw[8] = {b0.x, b0.y, b0.z, b0.w, b1.x, b1.y, b1.z, b1.w}, cw8[8] = {c0.x, c0.y, c0.z, c0.w, c1.x, c1.y, c1.z, c1.w};
                float y = 0.f;
#pragma unroll
                for (int j = 0; j < 8; ++j) { S[2 * j] = S[2 * j] * dec + X * __uint_as_float(bw[j] << 16); y += __uint_as_float(cw8[j] << 16) * S[2 * j];
                    S[2 * j + 1] = S[2 * j + 1] * dec + X * __uint_as_float(bw[j] & 0xffff0000u); y += __uint_as_float(cw8[j] & 0xffff0000u) * S[2 * j + 1]; }
                y += __shfl_xor(y, 1); y += __shfl_xor(y, 2); y += __shfl_xor(y, 4);
                if (seq == 1) {
                    bf16* yp = YQ + row * 2048 + h * 64 + p;
                    if (d == 1) { if (nc == 0) *yp = (bf16)f2bf(y); }
                    else {
                        if (nc == 0) { const float yt = y + bf2f(*yp) + d_skip[h] * xs; const float yg = yt * bf2f(Z[row * 1024 + h * 64 + p]); *yp = (bf16)f2bf(yg); ysq[p] = yg * yg; }
                        __syncthreads();
                        if (tid < 64) { float q = ysq[tid]; q = wave_sum(q); if (tid == 0) SSQ[row * 16 + h] = q; }
                        __syncthreads();
                    }
                }
            }
        }
        VM_WAIT(); __syncthreads();
    }
}

namespace attn_body {
using bf16=__hip_bfloat16;
using bf16x8=__attribute__((ext_vector_type(8)))short;
using s16x4=__attribute__((ext_vector_type(4)))short;
using f32x16=__attribute__((ext_vector_type(16)))float;
using u32x4=__attribute__((ext_vector_type(4)))unsigned;
constexpr int D=64,QP=2048,KP=256;
constexpr int NW=8,QBLK=32,QB=QBLK*NW,KVBLK=64,NQB=SEQ/QB;
constexpr int ATTN_UNIT_ROWS=QB;
__device__ __forceinline__ int crow(int r,int hi){return (r&3)+8*(r>>2)+4*hi;}
#define SBAR() __builtin_amdgcn_sched_barrier(0)
__device__ __forceinline__ void cmask(f32x16&p0,f32x16&p1,int jb,int qrel,int hi){
  const float NEG=-INFINITY; int kb=64*jb+4*hi;
  #pragma unroll
  for(int r=0;r<16;++r){int kv=kb+(r&3)+8*(r>>2); if(kv>qrel)p0[r]=NEG; if(kv+32>qrel)p1[r]=NEG;}
}

constexpr int NSLOT=3, SLOTB=8192;
constexpr int LDS_K=0, LDS_V=NSLOT*SLOTB, LDS_WS=2*NSLOT*SLOTB, LDS_OST=LDS_WS+NW*64*4, LDS_BYTES=LDS_OST+NW*8192;
constexpr float C2=0.125f*1.4426950408889634f;
__device__ __forceinline__ void glds16(const void*gsrc,unsigned lds_dst){unsigned keep;
  asm volatile("s_mov_b32 %0, m0\n\ts_mov_b32 m0, %2\n\ts_nop 0\n\tglobal_load_lds_dwordx4 %1, off\n\ts_mov_b32 m0, %0":"=&s"(keep):"v"(gsrc),"s"(lds_dst):"memory");}
__device__ __forceinline__ float max3f(float a,float b,float c){float r;asm("v_max3_f32 %0, %1, %2, %3":"=v"(r):"v"(a),"v"(b),"v"(c));return r;}
__device__ __forceinline__ float max2f(float a,float b){float r;asm("v_max_f32_e32 %0, %1, %2":"=v"(r):"v"(a),"v"(b));return r;}
__device__ __forceinline__ float fadd_s(float a,float b){float r;asm("v_add_f32_e32 %0, %1, %2":"=v"(r):"v"(a),"v"(b));return r;}
__device__ __forceinline__ float fsub_s(float a,float b){float r;asm("v_sub_f32_e32 %0, %1, %2":"=v"(r):"v"(a),"v"(b));return r;}
typedef float f32x2_t __attribute__((ext_vector_type(2))); typedef float f32x4_t __attribute__((ext_vector_type(4))); typedef __bf16 bf16x2_t __attribute__((ext_vector_type(2)));
__device__ __forceinline__ unsigned cvtpk_s(float lo,float hi){f32x2_t v={lo,hi};bf16x2_t b=__builtin_convertvector(v,bf16x2_t);return __builtin_bit_cast(unsigned,b);}
#define WAIT_BAR(N) asm volatile("s_waitcnt vmcnt(" #N ") lgkmcnt(0)\n\ts_barrier":::"memory")

__device__ __forceinline__ void qkt(f32x16&p0,f32x16&p1,const char*Kslot,const bf16x8*qr,const f32x16&negm,int r32,int hi){
  const char*kb=Kslot+hi*1024+r32*16;
  #pragma unroll
  for(int d0=0;d0<4;++d0){
    const bf16x8 b0=*reinterpret_cast<const bf16x8*>(kb+d0*2048);
    const bf16x8 b1=*reinterpret_cast<const bf16x8*>(kb+d0*2048+512);
    if(d0==0){p0=__builtin_amdgcn_mfma_f32_32x32x16_bf16(b0,qr[0],negm,0,0,0);p1=__builtin_amdgcn_mfma_f32_32x32x16_bf16(b1,qr[0],negm,0,0,0);}
    else{p0=__builtin_amdgcn_mfma_f32_32x32x16_bf16(b0,qr[d0],p0,0,0,0);p1=__builtin_amdgcn_mfma_f32_32x32x16_bf16(b1,qr[d0],p1,0,0,0);}}
}
typedef __attribute__((address_space(3))) const char* lds_cptr;
typedef short v4i16_t __attribute__((ext_vector_type(4)));
__device__ __forceinline__ void kload8(bf16x8*kf,lds_cptr kp){
  kf[0]=*(const __attribute__((address_space(3))) bf16x8*)(kp);      kf[1]=*(const __attribute__((address_space(3))) bf16x8*)(kp+512);
  kf[2]=*(const __attribute__((address_space(3))) bf16x8*)(kp+2048); kf[3]=*(const __attribute__((address_space(3))) bf16x8*)(kp+2560);
  kf[4]=*(const __attribute__((address_space(3))) bf16x8*)(kp+4096); kf[5]=*(const __attribute__((address_space(3))) bf16x8*)(kp+4608);
  kf[6]=*(const __attribute__((address_space(3))) bf16x8*)(kp+6144); kf[7]=*(const __attribute__((address_space(3))) bf16x8*)(kp+6656);
}
__device__ __forceinline__ void kload2(bf16x8*kf,lds_cptr kp,int j){ kf[2*j]=*(const __attribute__((address_space(3))) bf16x8*)(kp+j*2048); kf[2*j+1]=*(const __attribute__((address_space(3))) bf16x8*)(kp+j*2048+512); }
__device__ __forceinline__ s16x4 vtr(lds_cptr p){ return __builtin_bit_cast(s16x4,__builtin_amdgcn_ds_read_tr16_b64_v4i16((__attribute__((address_space(3))) v4i16_t*)p)); }
__device__ __forceinline__ float rowmax(const f32x16&p0,const f32x16&p1){
  float a=max3f(p0[0],p0[1],p1[0]),b=max3f(p0[2],p0[3],p1[1]);a=max3f(a,p1[2],p1[3]);
  #pragma unroll
  for(int r=4;r<16;r+=4){a=max3f(a,p0[r],p0[r+1]);b=max3f(b,p0[r+2],p0[r+3]);a=max3f(a,p1[r],p1[r+1]);b=max3f(b,p1[r+2],p1[r+3]);}
  const float m=max2f(a,b);
  auto rr=__builtin_amdgcn_permlane32_swap(__float_as_uint(m),__float_as_uint(m),false,false);
  return max2f(__uint_as_float(rr[0]),__uint_as_float(rr[1]));
}
__device__ __forceinline__ void pv(f32x16*o,int vb,bf16x8 pa0,bf16x8 pa1,bf16x8 pa2,bf16x8 pa3){
  #pragma unroll
  for(int d0=0;d0<2;++d0){s16x4 lo[4],hi[4];
    #pragma unroll
    for(int ks=0;ks<4;++ks){
      asm volatile("ds_read_b64_tr_b16 %0,%1 offset:%c2":"=&v"(lo[ks]):"v"(vb),"i"(d0*4096+ks*1024):"memory");
      asm volatile("ds_read_b64_tr_b16 %0,%1 offset:%c2":"=&v"(hi[ks]):"v"(vb),"i"(d0*4096+ks*1024+512):"memory");}
    asm volatile("s_waitcnt lgkmcnt(0)":::"memory");SBAR();
    #define PK(k) (bf16x8){lo[k][0],lo[k][1],lo[k][2],lo[k][3],hi[k][0],hi[k][1],hi[k][2],hi[k][3]}
    o[d0]=__builtin_amdgcn_mfma_f32_32x32x16_bf16(pa0,PK(0),o[d0],0,0,0);
    o[d0]=__builtin_amdgcn_mfma_f32_32x32x16_bf16(pa1,PK(1),o[d0],0,0,0);
    o[d0]=__builtin_amdgcn_mfma_f32_32x32x16_bf16(pa2,PK(2),o[d0],0,0,0);
    o[d0]=__builtin_amdgcn_mfma_f32_32x32x16_bf16(pa3,PK(3),o[d0],0,0,0);
    #undef PK
  }
}

#ifndef ATTN_STORE16
#define ATTN_STORE16(p,v) (*(u32x4*)(p)=(v))
#endif
template<int THRL> __device__ __forceinline__ void attn_unit(int b,int h,int qb,bf16*YQb,const bf16*__restrict__ K,const bf16*__restrict__ V,char*shm,int wid_in,float sbound,bf16x8 (&qr)[4],bool first,bool hasNext,int nb,int nh,int nqb,bf16*dummyO=nullptr){
  const int wid=wid_in; int lane=mk_lane(); asm volatile("":"+v"(lane)); const int tid=wid*64+lane,r32=lane&31,hi=lane>>5; (void)tid;
  const long rowbase=(long)b*SEQ; const int q0=qb*QB;
  const bf16*Qw=YQb+(rowbase+q0+wid*QBLK)*QP+1024+h*D;
  const bf16*Kh=K+(long)b*KVL*KP+(h>>2)*D,*Vh=V+(long)b*KVL*KP+(h>>2)*D;
  const unsigned lds0=(unsigned)(uintptr_t)shm;
  float*wsf=(float*)(shm+LDS_WS)+wid*64;
  const bf16*ksrc=Kh+(long)lane*KP+wid*8;
  const bf16*vsrc=Vh+(long)(16*(wid&3)+(lane>>2))*KP+(wid>>2)*32+(lane&3)*8;
  const unsigned kdst=lds0+LDS_K+wid*1024, vdst=lds0+LDS_V+wid*1024;
  #define DMA_K(t,slot) glds16(ksrc+(long)(t)*KVBLK*KP,(unsigned)__builtin_amdgcn_readfirstlane(kdst+(slot)))
  #define DMA_V(t,slot) glds16(vsrc+(long)(t)*KVBLK*KP,(unsigned)__builtin_amdgcn_readfirstlane(vdst+(slot)))
  const int vb0=(int)(lds0+LDS_V)+((lane>>4)&1)*32+(lane&3)*8+(4*hi+((lane&15)>>2))*64;
  const char*Kbase=shm+LDS_K; bf16x8 kf[8];
  const lds_cptr shm3=(lds_cptr)shm; const lds_cptr kp0=shm3+LDS_K+hi*1024+r32*16; const lds_cptr vp0=shm3+LDS_V+((lane>>4)&1)*32+(lane&3)*8+(4*hi+((lane&15)>>2))*64;
  constexpr int NT=KVL/KVBLK;
  if(first){ DMA_K(0,0);DMA_V(0,0);DMA_K(1,SLOTB);
    #pragma unroll
    for(int d0=0;d0<4;++d0)qr[d0]=*reinterpret_cast<const bf16x8*>(&Qw[(long)r32*QP+d0*16+hi*8]); }
  float l_reg=0.f;f32x16 o[2];o[0]=f32x16{};o[1]=f32x16{};f32x16 negm;
  #pragma unroll
  for(int r=0;r<16;++r)negm[r]=-sbound;
  asm volatile("":"+v"(negm));
  #define CMASK(P0,P1,t) do{}while(0)
  #define START(P0,P1) do{ _Pragma("unroll") for(int r=0;r<16;++r)P0[r]=__builtin_amdgcn_exp2f(P0[r]); }while(0)
  #define RESC() do{}while(0)
  f32x16 pA0,pA1,pB0,pB1;
  int sl_prev=0,sl_cur=0,sl_next=SLOTB;
  #define ROT() do{sl_prev=sl_cur;sl_cur=sl_next;sl_next=(sl_next==(NSLOT-1)*SLOTB)?0:sl_next+SLOTB;}while(0)
  if(first){ DMA_K(2,2*SLOTB);
    WAIT_BAR(3); }
  else { WAIT_BAR(0); }
  qkt(pA0,pA1,Kbase,qr,negm,r32,hi);asm volatile("s_nop 15\n\ts_nop 7":"+v"(pA0),"+v"(pA1));CMASK(pA0,pA1,0);
  START(pA0,pA1);
  _Pragma("unroll") for(int r=0;r<16;++r)pA1[r]=__builtin_amdgcn_exp2f(pA1[r]);
  WAIT_BAR(0);
  DMA_K(3,0);DMA_V(1,SLOTB);
  ROT();
  kload8(kf,kp0+sl_cur);
  WAIT_BAR(2);
  s16x4 vlo[8],vhi[8]; u32x4 pw0,pw1,pw2,pw3;
  #define PKW(P,B) cvtpk_s(P[B],P[B+1])
  #define PAF(k) __builtin_bit_cast(bf16x8,pw##k)
  #define VFR(i) (bf16x8){vlo[i][0],vlo[i][1],vlo[i][2],vlo[i][3],vhi[i][0],vhi[i][1],vhi[i][2],vhi[i][3]}
  #define PIN(x) asm volatile("":"+v"(x))
  #define MX3(a,b,c) __builtin_fmaxf(__builtin_fmaxf((a),(b)),(c))
  #define GAPA(MF,A0,A1,A2,A3,W0,W1,PW) do{ MF; sacc+=A0; sacc+=A1; sacc+=A2; sacc+=A3; PIN(sacc); W0; W1; PIN(PW); SBAR(); }while(0)
  #define EX(v) __builtin_amdgcn_exp2f(v)
  #define GAPB(MF,X,B) do{ MF; X[B]=EX(X[B]); X[B+1]=EX(X[B+1]); X[B+2]=EX(X[B+2]); X[B+3]=EX(X[B+3]); PIN(X); SBAR(); }while(0)
  #define VRD(i) do{ vlo[i]=vtr(vp_+(((i)>>2)*4096+((i)&3)*1024)); vhi[i]=vtr(vp_+(((i)>>2)*4096+((i)&3)*1024+512)); }while(0)
  #define KRD(G,j) do{ if(G){ kload2(kf,kp0+sl_next,j); SBAR(); } }while(0)
  #define STEP(C0,C1,P0,P1,t,GK,GV,GL) do{ SBAR(); \
    const lds_cptr vp_=vp0+sl_prev; \
    VRD(0); SBAR(); float sacc=(P0[0]+P0[1]); \
    GAPA(C0=__builtin_amdgcn_mfma_f32_32x32x16_bf16(kf[0],qr[0],negm,0,0,0), P0[2],P0[3],P0[4],P0[5],     pw0[0]=PKW(P0,0), pw0[1]=PKW(P0,2), pw0); \
    VRD(4); SBAR(); GAPA(C1=__builtin_amdgcn_mfma_f32_32x32x16_bf16(kf[1],qr[0],negm,0,0,0), P0[6],P0[7],P0[8],P0[9],     pw0[2]=PKW(P0,4), pw0[3]=PKW(P0,6), pw0); \
    VRD(1); SBAR(); GAPA(C0=__builtin_amdgcn_mfma_f32_32x32x16_bf16(kf[2],qr[1],C0,0,0,0),   P0[10],P0[11],P0[12],P0[13], pw1[0]=PKW(P0,8), pw1[1]=PKW(P0,10), pw1); \
    VRD(5); SBAR(); GAPA(C1=__builtin_amdgcn_mfma_f32_32x32x16_bf16(kf[3],qr[1],C1,0,0,0),   P0[14],P0[15],P1[0],P1[1],   pw1[2]=PKW(P0,12),pw1[3]=PKW(P0,14), pw1); \
    VRD(2); SBAR(); GAPA(C0=__builtin_amdgcn_mfma_f32_32x32x16_bf16(kf[4],qr[2],C0,0,0,0),   P1[2],P1[3],P1[4],P1[5],     pw2[0]=PKW(P1,0), pw2[1]=PKW(P1,2), pw2); \
    VRD(6); SBAR(); GAPA(C1=__builtin_amdgcn_mfma_f32_32x32x16_bf16(kf[5],qr[2],C1,0,0,0),   P1[6],P1[7],P1[8],P1[9],     pw2[2]=PKW(P1,4), pw2[3]=PKW(P1,6), pw2); \
    VRD(3); SBAR(); GAPA(C0=__builtin_amdgcn_mfma_f32_32x32x16_bf16(kf[6],qr[3],C0,0,0,0),   P1[10],P1[11],P1[12],P1[13], pw3[0]=PKW(P1,8), pw3[1]=PKW(P1,10), pw3); \
    VRD(7); SBAR(); GAPA(C1=__builtin_amdgcn_mfma_f32_32x32x16_bf16(kf[7],qr[3],C1,0,0,0),   P1[14],P1[15],0.f,0.f,       pw3[2]=PKW(P1,12),pw3[3]=PKW(P1,14), pw3); \
    l_reg+=sacc; \
    if(GK){DMA_K((t)+3,sl_cur);} if(GV){DMA_V((t)+1,sl_next);} \
    CMASK(C0,C1,t); \
    SBAR(); \
    GAPB(o[0]=__builtin_amdgcn_mfma_f32_32x32x16_bf16(PAF(0),VFR(0),o[0],0,0,0), C0,0); \
    GAPB(o[1]=__builtin_amdgcn_mfma_f32_32x32x16_bf16(PAF(0),VFR(4),o[1],0,0,0), C0,4); \
    KRD(GL,0); GAPB(o[0]=__builtin_amdgcn_mfma_f32_32x32x16_bf16(PAF(1),VFR(1),o[0],0,0,0), C0,8); \
    KRD(GL,1); GAPB(o[1]=__builtin_amdgcn_mfma_f32_32x32x16_bf16(PAF(1),VFR(5),o[1],0,0,0), C0,12); \
    KRD(GL,2); GAPB(o[0]=__builtin_amdgcn_mfma_f32_32x32x16_bf16(PAF(2),VFR(2),o[0],0,0,0), C1,0); \
    KRD(GL,3); GAPB(o[1]=__builtin_amdgcn_mfma_f32_32x32x16_bf16(PAF(2),VFR(6),o[1],0,0,0), C1,4); \
    GAPB(o[0]=__builtin_amdgcn_mfma_f32_32x32x16_bf16(PAF(3),VFR(3),o[0],0,0,0), C1,8); \
    GAPB(o[1]=__builtin_amdgcn_mfma_f32_32x32x16_bf16(PAF(3),VFR(7),o[1],0,0,0), C1,12); \
    }while(0)
  int t=1;
  #undef CMASK
  #define CMASK(P0,P1,t) do{}while(0)
  for(;t+5<NT;t+=2){
    STEP(pB0,pB1,pA0,pA1,t,true,true,true);     WAIT_BAR(2); RESC(); ROT();
    STEP(pA0,pA1,pB0,pB1,t+1,true,true,true);   WAIT_BAR(2); RESC(); ROT();
  }
  #undef CMASK
  #define CMASK(P0,P1,t) do{}while(0)
  #define ENDW(tt) do{ if((tt)+3<NT){WAIT_BAR(2);} else if((tt)+2<NT){WAIT_BAR(1);} else {WAIT_BAR(0);} }while(0)
  for(;t+1<NT;t+=2){
    STEP(pB0,pB1,pA0,pA1,t,(t+3<NT),(t+1<NT),(t+1<NT));       ENDW(t);   RESC(); ROT();
    STEP(pA0,pA1,pB0,pB1,t+1,(t+4<NT),(t+2<NT),(t+2<NT));     ENDW(t+1); RESC(); ROT();
  }
  const bf16*nQw=YQb+((long)nb*SEQ+nqb*QB+wid*QBLK)*QP+1024+nh*D;
  if(hasNext){ const bf16*nK=K+(long)nb*KVL*KP+(nh>>2)*D+(long)lane*KP+wid*8; const bf16*nV=V+(long)nb*KVL*KP+(nh>>2)*D+(long)(16*(wid&3)+(lane>>2))*KP+(wid>>2)*32+(lane&3)*8;
    glds16(nK,(unsigned)__builtin_amdgcn_readfirstlane(kdst)); glds16(nV,(unsigned)__builtin_amdgcn_readfirstlane(vdst)); glds16(nK+(long)KVBLK*KP,(unsigned)__builtin_amdgcn_readfirstlane(kdst+SLOTB)); glds16(nK+(long)2*KVBLK*KP,(unsigned)__builtin_amdgcn_readfirstlane(kdst+2*SLOTB)); }
  STEP(pB0,pB1,pA0,pA1,NT-1,false,false,false); RESC();
  { float sacc=pB0[0]+pB0[1]; _Pragma("unroll") for(int r=2;r<16;++r)sacc+=pB0[r]; _Pragma("unroll") for(int r=0;r<16;++r)sacc+=pB1[r]; l_reg+=sacc;
    pw0=(u32x4){PKW(pB0,0),PKW(pB0,2),PKW(pB0,4),PKW(pB0,6)};pw1=(u32x4){PKW(pB0,8),PKW(pB0,10),PKW(pB0,12),PKW(pB0,14)};pw2=(u32x4){PKW(pB1,0),PKW(pB1,2),PKW(pB1,4),PKW(pB1,6)};pw3=(u32x4){PKW(pB1,8),PKW(pB1,10),PKW(pB1,12),PKW(pB1,14)};
    SBAR(); pv(o,vb0+sl_cur,PAF(0),PAF(1),PAF(2),PAF(3)); }
  if(hasNext){
    #pragma unroll
    for(int d0=0;d0<4;++d0)qr[d0]=*reinterpret_cast<const bf16x8*>(&nQw[(long)r32*QP+d0*16+hi*8]); }
  #undef PKW
  #undef PAF
  #undef VFR
  #undef PIN
  #undef MX3
  #undef GAPA
  #undef GAPB
  #undef EX
  #undef VRD
  #undef KRD
  #undef STEP
  #undef ENDW
  {auto rr=__builtin_amdgcn_permlane32_swap(__float_as_uint(l_reg),__float_as_uint(l_reg),false,false);l_reg=__uint_as_float(rr[0])+__uint_as_float(rr[1]);}
  if(hi==0)wsf[32+r32]=l_reg;asm volatile("s_waitcnt lgkmcnt(0)":::"memory");
  float rli[16];
  #pragma unroll
  for(int r=0;r<16;++r)rli[r]=__builtin_amdgcn_rcpf(wsf[32+crow(r,hi)]);
  bf16*Ow=dummyO?dummyO+(long)(wid*QBLK)*QP:YQb+(rowbase+q0+wid*QBLK)*QP+1024+h*D; const bf16*Gw=YQb+(rowbase+q0+wid*QBLK)*QP+h*D;
  { float*stg=(float*)(shm+LDS_OST)+wid*2048;
    #pragma unroll
    for(int r=0;r<16;++r){const int orow=crow(r,hi);
      #pragma unroll
      for(int d0=0;d0<2;++d0)stg[orow*64+d0*32+r32]=o[d0][r]*rli[r];}
    asm volatile("s_waitcnt lgkmcnt(0)":::"memory");
    #pragma unroll
    for(int i=0;i<4;++i){const int row=i*8+(lane>>3),ch=lane&7; const float*sp=stg+row*64+ch*8;
      const f32x4_t a=*(const f32x4_t*)sp,c=*(const f32x4_t*)(sp+4); const u32x4 g=*(const u32x4*)(Gw+(long)row*QP+ch*8);
      u32x4 v; v[0]=cvtpk_s(a[0]*__uint_as_float(g[0]<<16),a[1]*__uint_as_float(g[0]&0xffff0000u)); v[1]=cvtpk_s(a[2]*__uint_as_float(g[1]<<16),a[3]*__uint_as_float(g[1]&0xffff0000u));
      v[2]=cvtpk_s(c[0]*__uint_as_float(g[2]<<16),c[1]*__uint_as_float(g[2]&0xffff0000u)); v[3]=cvtpk_s(c[2]*__uint_as_float(g[3]<<16),c[3]*__uint_as_float(g[3]&0xffff0000u));
      ATTN_STORE16(Ow+(long)row*QP+ch*8,v);} }
  asm volatile("s_waitcnt lgkmcnt(0)\n\ts_barrier":::"memory");
  #undef DMA_K
  #undef DMA_V
  #undef CMASK
  #undef START
  #undef RESC
  #undef ROT
}
constexpr int ATTN_LDS_BYTES=LDS_BYTES;
struct Order {
  int vcu, G; bool alt;
  __device__ __forceinline__ bool next(int i,int&b,int&h,int&qb)const{
    if(G==256&&!alt){ if(i>=16)return false; const int x=vcu>>5,j=vcu&31,rd=i>>2,k=i&3; const int pair=x*16+rd*4+(j>>3),un=(j&7)*4+k; b=pair>>2; h=(pair&3)*4+(un&3); qb=un>>2; return true; }
    const int U=i*G+vcu; if(U>=4096)return false; b=U>>7; h=(U>>3)&15; qb=U&7; return true; }
};
template<int THRL=8> __device__ __forceinline__ void attn_phase(char*lds,bf16*YQb,const bf16*K,const bf16*V,const Order&S,int wid,float sbound,bf16*dummyO=nullptr){
  int b,h,qb,nb=0,nh=0,nqb=0; bf16x8 qr[4]; bool first=true;
  bool has=S.next(0,b,h,qb);
  for(int i=0;has;++i){ const bool hn=S.next(i+1,nb,nh,nqb);
    attn_unit<THRL>(b,h,qb,YQb,K,V,lds,wid,sbound,qr,first,hn,nb,nh,nqb,dummyO);
    b=nb;h=nh;qb=nqb;has=hn;first=false; }
}
#undef SBAR
#undef WAIT_BAR
}

namespace ssd {
typedef short bf16x8 __attribute__((ext_vector_type(8)));
typedef short s16x4 __attribute__((ext_vector_type(4)));
typedef unsigned u32x2_t __attribute__((ext_vector_type(2)));
constexpr int O_B = 0, O_C = 32768, O_X = 65536, O_XD = 81920, O_ST = 98304, O_SM = 114688;
constexpr float LOG2E = 1.4426950408889634f;
struct Lofs { int fb[4], xb[4], bb, sw; };
__device__ __forceinline__ bf16x8 frag(const LAS unsigned char* img, int fbk, int t) { return *(const LAS bf16x8*)(img + fbk + t * 4096); }
__device__ __forceinline__ s16x4 trd(const LAS unsigned char* p) { typedef short v4i16_t __attribute__((ext_vector_type(4))); return __builtin_bit_cast(s16x4, __builtin_amdgcn_ds_read_tr16_b64_v4i16((LAS v4i16_t*)p)); }
__device__ __forceinline__ bf16x8 trfragX(const LAS unsigned char* img, int xbp, int s0) {
    const s16x4 a = trd(img + xbp + s0 * 128), b = trd(img + xbp + s0 * 128 + 2048);
    return (bf16x8){a[0], a[1], a[2], a[3], b[0], b[1], b[2], b[3]};
}
__device__ __forceinline__ bf16x8 trfragB(const LAS unsigned char* img, int bb, int s0) {
    const s16x4 a = trd(img + bb + s0 * 256), b = trd(img + bb + s0 * 256 + 4096);
    return (bf16x8){a[0], a[1], a[2], a[3], b[0], b[1], b[2], b[3]};
}
__device__ __forceinline__ void unpack4(const u32x2_t u, float (&f)[4]) { f[0] = __uint_as_float(u.x << 16); f[1] = __uint_as_float(u.x & 0xffff0000u); f[2] = __uint_as_float(u.y << 16); f[3] = __uint_as_float(u.y & 0xffff0000u); }
__device__ __forceinline__ void unpack8(const v4u u, float (&f)[8]) {
    f[0] = __uint_as_float(u.x << 16); f[1] = __uint_as_float(u.x & 0xffff0000u); f[2] = __uint_as_float(u.y << 16); f[3] = __uint_as_float(u.y & 0xffff0000u);
    f[4] = __uint_as_float(u.z << 16); f[5] = __uint_as_float(u.z & 0xffff0000u); f[6] = __uint_as_float(u.w << 16); f[7] = __uint_as_float(u.w & 0xffff0000u);
}
#define SSD_MFMA(a, b, c) __builtin_amdgcn_mfma_f32_16x16x32_bf16(a, b, c, 0, 0, 0)

template <int W> __device__ __forceinline__ void diag(f32x4 (&y)[4], const bf16x8 (&cf)[4], const LAS unsigned char* Bi, const LAS unsigned char* Xi, const LAS float* csc, float csl, float skd, int fr, int fq, const Lofs& lo) {
    constexpr int NU = W / 2 + 1;
    bf16x8 bA[2][4], bB[2][4];
#pragma unroll
    for (int kk = 0; kk < 4; ++kk) { bA[0][kk] = frag(Bi, lo.fb[kk], 0); if (1 <= W) bB[0][kk] = frag(Bi, lo.fb[kk], 1); }
#pragma unroll
    for (int u = 0; u < NU; ++u) {
        const int cur = u & 1; const bool has1 = 2 * u + 1 <= W;
        bf16x8 xf[4];
#pragma unroll
        for (int pt = 0; pt < 4; ++pt) xf[pt] = trfragX(Xi, lo.xb[pt], 32 * u);
        const f32x4 c0 = *(const LAS f32x4*)(csc + 32 * u + 4 * fq), c1 = *(const LAS f32x4*)(csc + 32 * u + 16 + 4 * fq);
        if (u + 1 < NU) {
#pragma unroll
            for (int kk = 0; kk < 4; ++kk) { bA[cur ^ 1][kk] = frag(Bi, lo.fb[kk], 2 * u + 2); if (2 * u + 3 <= W) bB[cur ^ 1][kk] = frag(Bi, lo.fb[kk], 2 * u + 3); } }
        asm volatile("" ::: "memory");
        f32x4 a0 = (f32x4){0.f, 0.f, 0.f, 0.f}, a1 = (f32x4){0.f, 0.f, 0.f, 0.f};
#pragma unroll
        for (int kk = 0; kk < 4; ++kk) { a0 = SSD_MFMA(bA[cur][kk], cf[kk], a0); if (has1) a1 = SSD_MFMA(bB[cur][kk], cf[kk], a1); }
        float m0[4], m1[4];
#pragma unroll
        for (int e = 0; e < 4; ++e) {
            m0[e] = a0[e] * __builtin_amdgcn_exp2f(fminf(csl - c0[e], 0.f)); if (2 * u == W) { if (4 * fq + e > fr) m0[e] = 0.f; if (4 * fq + e == fr) m0[e] += skd; }
            m1[e] = has1 ? a1[e] * __builtin_amdgcn_exp2f(fminf(csl - c1[e], 0.f)) : 0.f; if (2 * u + 1 == W) { if (4 * fq + e > fr) m1[e] = 0.f; if (4 * fq + e == fr) m1[e] += skd; } }
        const v4u mw = (v4u){pk2(m0[0], m0[1]), pk2(m0[2], m0[3]), pk2(m1[0], m1[1]), pk2(m1[2], m1[3])};
        const bf16x8 mf = __builtin_bit_cast(bf16x8, mw);
#pragma unroll
        for (int pt = 0; pt < 4; ++pt) y[pt] = SSD_MFMA(xf[pt], mf, y[pt]);
    }
}

template <int SH> __device__ __forceinline__ void ssd_item(int b, int h, const bf16* XC, const float* DT, const bf16* Z, const float* a_log, const float* d_skip, bf16* YQ, float* SSQ,
                                          LAS unsigned char* L, int tid_in, int lane_in, int wave) {
    int tid = tid_in, lane = lane_in; asm volatile("" : "+v"(tid), "+v"(lane));
    const int fr = lane & 15, fq = lane >> 4, g = h >> 3;
    LAS unsigned char* Bi = L + O_B; LAS unsigned char* Ci = L + O_C; LAS unsigned char* Xi = L + O_X; LAS unsigned char* Xdi = L + O_XD; LAS unsigned char* Sti = L + O_ST;
    LAS float* dtv = (LAS float*)(L + O_SM); LAS float* cs2 = dtv + 256;
    const float aneg1 = -expf(a_log[16 + h]) * LOG2E, aneg0 = -expf(a_log[h]) * LOG2E, dsk = d_skip[h];
    Lofs lo;
    { const int q = (lane & 15) >> 2, pp = lane & 3, rr = 4 * fq + q;
#pragma unroll
      for (int kk = 0; kk < 4; ++kk) lo.fb[kk] = fr * 256 + (((4 * kk + fq) ^ fr) << 4);
#pragma unroll
      for (int pt = 0; pt < 4; ++pt) lo.xb[pt] = rr * 128 + ((pt ^ ((rr >> 1) & 3)) << 5) + 8 * pp;
      lo.bb = rr * 256 + (((2 * wave + (pp >> 1)) ^ rr) << 4) + 8 * (pp & 1);
      lo.sw = fr * 256 + (((2 * wave + (fq >> 1)) ^ fr) << 4) + (fq & 1) * 8; }
    const int sB = tid >> 4, cB = tid & 15, sX = tid >> 3, cX = tid & 7;
    const int wB = sB * 256 + ((cB ^ (sB & 15)) << 4);
    const int wX = sX * 128 + (((cX >> 1) ^ ((sX >> 1) & 3)) << 5) + (cX & 1) * 16;
    f32x4 st[4];
#pragma unroll
    for (int pt = 0; pt < 4; ++pt) st[pt] = (f32x4){0.f, 0.f, 0.f, 0.f};
    v4u Bq[4], Cq[4], Xq[2]; float dq0 = 0.f, dq1 = 0.f; bf16x8 cf[4];
#define SSD_DECODE(step, d_, base_, ctx_) const int d_ = 1 - (step) / 18; const int k_##d_ = (step) % 18; const bool ctx_ = k_##d_ < 2; \
    const size_t base_ = ctx_ ? (size_t)ML + (size_t)b * CTXL + (size_t)(d_ ? 1 - k_##d_ : k_##d_) * 128 : (size_t)b * SEQ + (size_t)(d_ ? 17 - k_##d_ : k_##d_ - 2) * 128;
#define SSD_ISSUE(step) do { SSD_DECODE(step, di, basei, ctxi) (void)ctxi; \
        const bf16* cb_ = XC + (SH == 8 ? (size_t)b * SEQ : basei) * CONVC; const int sg_ = di ? -CONVC : CONVC; const int o0_ = di ? 127 * CONVC : 0; \
        const bf16* pb_ = cb_ + (o0_ + sB * sg_ + 1024 + g * 128 + 8 * cB); const bf16* px_ = cb_ + (o0_ + sX * sg_ + h * 64 + 8 * cX); \
        const bf16* pc_ = cb_ + (o0_ + (16 * wave + fr) * sg_ + 1280 + g * 128 + 8 * fq); \
        _Pragma("unroll") for (int k4 = 0; k4 < 4; ++k4) { Bq[k4] = *(const v4u*)(pb_ + k4 * 32 * sg_); Cq[k4] = *(const v4u*)(pc_ + 32 * k4); } \
        _Pragma("unroll") for (int k2 = 0; k2 < 2; ++k2) Xq[k2] = *(const v4u*)(px_ + k2 * 64 * sg_); \
        if (wave == 0) { const size_t r0 = basei + (di ? 127 - 2 * lane : 2 * lane), r1 = basei + (di ? 126 - 2 * lane : 2 * lane + 1); dq0 = DT[r0 * 32 + di * 16 + h]; dq1 = DT[r1 * 32 + di * 16 + h]; } } while (0)
#define SSD_CUMSUM(step, par) do { if (wave == 0) { const float an = (1 - (step) / 18) ? aneg1 : aneg0; const float a0 = dq0 * an, a1 = dq1 * an; float v = a0 + a1; \
        _Pragma("unroll") for (int o = 1; o < 64; o <<= 1) { const float t = __shfl_up(v, o); if (lane >= o) v += t; } \
        dtv[(par) * 128 + 2 * lane] = dq0; dtv[(par) * 128 + 2 * lane + 1] = dq1; cs2[(par) * 128 + 2 * lane] = v - a1; cs2[(par) * 128 + 2 * lane + 1] = v; } } while (0)
#define SSD_WRITE(step, par) do { \
        _Pragma("unroll") for (int k4 = 0; k4 < 4; ++k4) { *(LAS v4u*)(Bi + wB + k4 * 8192) = Bq[k4]; cf[k4] = __builtin_bit_cast(bf16x8, Cq[k4]); } \
        const float cl = cs2[(par) * 128 + 127]; \
        _Pragma("unroll") for (int k2 = 0; k2 < 2; ++k2) { const int s = sX + 64 * k2; const float dts = dtv[(par) * 128 + s], es = __builtin_amdgcn_exp2f(cl - cs2[(par) * 128 + s]); \
            float f[8]; unpack8(Xq[k2], f); _Pragma("unroll") for (int e = 0; e < 8; ++e) f[e] *= dts; \
            v4u xo; xo.x = pk2(f[0], f[1]); xo.y = pk2(f[2], f[3]); xo.z = pk2(f[4], f[5]); xo.w = pk2(f[6], f[7]); \
            _Pragma("unroll") for (int e = 0; e < 8; ++e) f[e] *= es; \
            v4u xd; xd.x = pk2(f[0], f[1]); xd.y = pk2(f[2], f[3]); xd.z = pk2(f[4], f[5]); xd.w = pk2(f[6], f[7]); \
            *(LAS v4u*)(Xi + wX + k2 * 8192) = xo; *(LAS v4u*)(Xdi + wX + k2 * 8192) = xd; } } while (0)
#define SSD_WRITE_STATE() do { _Pragma("unroll") for (int pt = 0; pt < 4; ++pt) { \
        u32x2_t w; w.x = pk2(st[pt][0], st[pt][1]); w.y = pk2(st[pt][2], st[pt][3]); *(LAS u32x2_t*)(Sti + lo.sw + pt * 4096) = w; } } while (0)

    __syncthreads();
    SSD_ISSUE(0); SSD_CUMSUM(0, 0); SSD_WRITE_STATE();
    __syncthreads();
    SSD_WRITE(0, 0);
    __syncthreads();
    for (int step = 0; step < 36; ++step) {
        const int par = step & 1; SSD_DECODE(step, d, base, isctx)
        const int r8 = lane >> 3, c8 = lane & 7;
        size_t orow2[2]; v4u ybv[2], zv[2];
#pragma unroll
        for (int ps = 0; ps < 2; ++ps) { const int l = 16 * wave + 8 * ps + r8; orow2[ps] = base + (d ? 127 - l : l); }
        if (!isctx && d == 0 && SH != 5 && SH != 7) {
#pragma unroll
            for (int ps = 0; ps < 2; ++ps) { ybv[ps] = *(const v4u*)((SH ? YQ + (orow2[ps] & 255) * 2048 : YQ + orow2[ps] * 2048) + h * 64 + 8 * c8); zv[ps] = *(const v4u*)(Z + orow2[ps] * 1024 + h * 64 + 8 * c8); } }
        if (step + 1 < 36 && SH != 3 && SH != 7) SSD_ISSUE(step + 1);
        const LAS float* csc = cs2 + par * 128;
        if (!isctx && SH != 7) {
            const float csl = csc[16 * wave + fr];
            const float skd = d == 0 ? dsk * __builtin_amdgcn_rcpf(dtv[par * 128 + 16 * wave + fr]) : 0.f;
            f32x4 y[4];
#pragma unroll
            for (int pt = 0; pt < 4; ++pt) { y[pt] = (f32x4){0.f, 0.f, 0.f, 0.f};
                if (SH != 6) {
#pragma unroll
                for (int kk = 0; kk < 4; ++kk) y[pt] = SSD_MFMA(frag(Sti, lo.fb[kk], pt), cf[kk], y[pt]); } }
            { const float El = __builtin_amdgcn_exp2f(csl);
#pragma unroll
              for (int pt = 0; pt < 4; ++pt) y[pt] *= El; }
            if (SH != 2) switch (wave) {
                case 0: diag<0>(y, cf, Bi, Xi, csc, csl, skd, fr, fq, lo); break; case 1: diag<1>(y, cf, Bi, Xi, csc, csl, skd, fr, fq, lo); break;
                case 2: diag<2>(y, cf, Bi, Xi, csc, csl, skd, fr, fq, lo); break; case 3: diag<3>(y, cf, Bi, Xi, csc, csl, skd, fr, fq, lo); break;
                case 4: diag<4>(y, cf, Bi, Xi, csc, csl, skd, fr, fq, lo); break; case 5: diag<5>(y, cf, Bi, Xi, csc, csl, skd, fr, fq, lo); break;
                case 6: diag<6>(y, cf, Bi, Xi, csc, csl, skd, fr, fq, lo); break; default: diag<7>(y, cf, Bi, Xi, csc, csl, skd, fr, fq, lo); break;
            }
            LAS unsigned char* stg = Ci + wave * 4096;
#pragma unroll
            for (int pt = 0; pt < 4; ++pt) *(LAS f32x4*)(stg + fr * 256 + (((4 * pt + fq) ^ fr) << 4)) = y[pt];
#pragma unroll
            for (int ps = 0; ps < 2; ++ps) { const int rl = 8 * ps + r8;
                const f32x4 t0 = *(const LAS f32x4*)(stg + rl * 256 + (((2 * c8) ^ rl) << 4)), t1 = *(const LAS f32x4*)(stg + rl * 256 + (((2 * c8 + 1) ^ rl) << 4));
                float v[8] = {t0[0], t0[1], t0[2], t0[3], t1[0], t1[1], t1[2], t1[3]};
                if (d == 0 && SH != 5) { float fb[8], fz[8]; unpack8(ybv[ps], fb); unpack8(zv[ps], fz); float q = 0.f;
#pragma unroll
                    for (int e = 0; e < 8; ++e) { v[e] = (v[e] + fb[e]) * fz[e]; q += v[e] * v[e]; }
                    q += __shfl_xor(q, 1); q += __shfl_xor(q, 2); q += __shfl_xor(q, 4);
                    if (c8 == 0) SSQ[(SH ? (orow2[ps] & 255) : orow2[ps]) * 16 + h] = q; }
                v4u o; o.x = pk2(v[0], v[1]); o.y = pk2(v[2], v[3]); o.z = pk2(v[4], v[5]); o.w = pk2(v[6], v[7]);
                if (SH != 5) *(v4u*)((SH ? YQ + (orow2[ps] & 255) * 2048 : YQ + orow2[ps] * 2048) + h * 64 + 8 * c8) = o; else asm volatile("" :: "v"(o)); }
        }
        if (SH != 6 && SH != 7) { const float dec = __builtin_amdgcn_exp2f(csc[127]);
#pragma unroll
          for (int pt = 0; pt < 4; ++pt) st[pt] *= dec;
#pragma unroll
          for (int kk = 0; kk < 4; ++kk) { const bf16x8 af = trfragB(Bi, lo.bb, 32 * kk);
#pragma unroll
              for (int pt = 0; pt < 4; ++pt) st[pt] = SSD_MFMA(af, trfragX(Xdi, lo.xb[pt], 32 * kk), st[pt]); } }
        if (step + 1 < 36) SSD_CUMSUM(step + 1, par ^ 1);
        if (step == 17) {
#pragma unroll
            for (int pt = 0; pt < 4; ++pt) st[pt] = (f32x4){0.f, 0.f, 0.f, 0.f};
            VM_WAIT();
        }
        __syncthreads();
        SSD_WRITE_STATE();
        if (step + 1 < 36 && SH != 4 && SH != 7) SSD_WRITE(step + 1, par ^ 1);
        __syncthreads();
    }
#undef SSD_DECODE
#undef SSD_ISSUE
#undef SSD_CUMSUM
#undef SSD_WRITE
#undef SSD_WRITE_STATE
}
namespace pr {
template <int CTRL, int ROWMASK> __device__ __forceinline__ float dpp_get(float v) {
    return __builtin_bit_cast(float, __builtin_amdgcn_update_dpp(0, __builtin_bit_cast(int, v), CTRL, ROWMASK, 0xF, false)); }
__device__ __forceinline__ float sum8(float q) {
    q += dpp_get<0xB1, 0xF>(q); q += dpp_get<0x4E, 0xF>(q); q += dpp_get<0x141, 0xF>(q); return q; }
__device__ __forceinline__ float scan64(float v) {
    v += dpp_get<0x111, 0xF>(v); v += dpp_get<0x112, 0xF>(v); v += dpp_get<0x114, 0xF>(v); v += dpp_get<0x118, 0xF>(v);
    v += dpp_get<0x142, 0xA>(v); v += dpp_get<0x143, 0xC>(v); return v; }
constexpr int P_B = 0, P_STG = 32768, P_X = 49152, P_XD = 81920, P_ST0 = 114688, P_ST1 = 132096, P_SM = 148480;
template <int W> __device__ __forceinline__ void diag1(f32x4 (&y)[4], const bf16x8 (&cf)[4], const LAS unsigned char* Bi, const LAS unsigned char* Xi, const LAS float* csc, float csl, float skd, int fr, int fq, const Lofs& lo) {
#pragma unroll
    for (int u = 0; u <= W / 2; ++u) {
        const bool has1 = 2 * u + 1 <= W;
        bf16x8 xf[4];
#pragma unroll
        for (int pt = 0; pt < 4; ++pt) xf[pt] = trfragX(Xi, lo.xb[pt], 32 * u);
        const f32x4 c0 = *(const LAS f32x4*)(csc + 32 * u + 4 * fq), c1 = *(const LAS f32x4*)(csc + 32 * u + 16 + 4 * fq);
        f32x4 a0 = (f32x4){0.f, 0.f, 0.f, 0.f}, a1 = (f32x4){0.f, 0.f, 0.f, 0.f};
#pragma unroll
        for (int kk = 0; kk < 4; ++kk) { a0 = SSD_MFMA(frag(Bi, lo.fb[kk], 2 * u), cf[kk], a0); if (has1) a1 = SSD_MFMA(frag(Bi, lo.fb[kk], 2 * u + 1), cf[kk], a1); }
        float m0[4], m1[4];
#pragma unroll
        for (int e = 0; e < 4; ++e) {
            m0[e] = a0[e] * __builtin_amdgcn_exp2f(fminf(csl - c0[e], 0.f)); if (2 * u == W) { if (4 * fq + e > fr) m0[e] = 0.f; if (4 * fq + e == fr) m0[e] += skd; }
            m1[e] = has1 ? a1[e] * __builtin_amdgcn_exp2f(fminf(csl - c1[e], 0.f)) : 0.f; if (2 * u + 1 == W) { if (4 * fq + e > fr) m1[e] = 0.f; if (4 * fq + e == fr) m1[e] += skd; } }
        const v4u mw = (v4u){pk2(m0[0], m0[1]), pk2(m0[2], m0[3]), pk2(m1[0], m1[1]), pk2(m1[2], m1[3])};
        const bf16x8 mf = __builtin_bit_cast(bf16x8, mw);
#pragma unroll
        for (int pt = 0; pt < 4; ++pt) y[pt] = SSD_MFMA(xf[pt], mf, y[pt]);
    }
}
__device__ __forceinline__ void diag_sw(int wave, f32x4 (&y)[4], const bf16x8 (&cf)[4], const LAS unsigned char* Bi, const LAS unsigned char* Xi, const LAS float* csc, float csl, float skd, int fr, int fq, const Lofs& lo) {
    switch (wave) {
        case 0: diag1<0>(y, cf, Bi, Xi, csc, csl, skd, fr, fq, lo); break; case 1: diag1<1>(y, cf, Bi, Xi, csc, csl, skd, fr, fq, lo); break;
        case 2: diag1<2>(y, cf, Bi, Xi, csc, csl, skd, fr, fq, lo); break; case 3: diag1<3>(y, cf, Bi, Xi, csc, csl, skd, fr, fq, lo); break;
        case 4: diag1<4>(y, cf, Bi, Xi, csc, csl, skd, fr, fq, lo); break; case 5: diag1<5>(y, cf, Bi, Xi, csc, csl, skd, fr, fq, lo); break;
        case 6: diag1<6>(y, cf, Bi, Xi, csc, csl, skd, fr, fq, lo); break; default: diag1<7>(y, cf, Bi, Xi, csc, csl, skd, fr, fq, lo); break;
    }
}

__device__ __forceinline__ void ssd_pair(int b, int hp, const bf16* XC, const float* DT, const bf16* Z, const float* a_log, const float* d_skip, bf16* YQ, float* SSQ,
                                          LAS unsigned char* L, int tid_in, int lane_in, int wave) {
    int tid = tid_in, lane = lane_in; asm volatile("" : "+v"(tid), "+v"(lane));
    const int fr = lane & 15, fq = lane >> 4, h0 = 2 * hp, g = hp >> 2;
    LAS unsigned char* Bi = L + P_B; LAS unsigned char* Stg = L + P_STG + wave * 2048;
    LAS float* dtv = (LAS float*)(L + P_SM); LAS float* cs2 = dtv + 512;
    const float an00 = -expf(a_log[h0]) * LOG2E, an01 = -expf(a_log[h0 + 1]) * LOG2E, an10 = -expf(a_log[16 + h0]) * LOG2E, an11 = -expf(a_log[16 + h0 + 1]) * LOG2E;
    const float dsk0 = d_skip[h0], dsk1 = d_skip[h0 + 1];
    Lofs lo;
    { const int q = (lane & 15) >> 2, pp = lane & 3, rr = 4 * fq + q;
#pragma unroll
      for (int kk = 0; kk < 4; ++kk) lo.fb[kk] = fr * 256 + (((4 * kk + fq) ^ fr) << 4);
#pragma unroll
      for (int pt = 0; pt < 4; ++pt) lo.xb[pt] = rr * 128 + ((pt ^ ((rr >> 1) & 3)) << 5) + 8 * pp;
      lo.bb = rr * 256 + (((2 * wave + (pp >> 1)) ^ rr) << 4) + 8 * (pp & 1);
      lo.sw = fr * 256 + (((2 * wave + (fq >> 1)) ^ fr) << 4) + (fq & 1) * 8; }
    const int sB = tid >> 4, cB = tid & 15, hx = (tid >> 3) & 1, cX = tid & 7;
    const int wB = sB * 256 + ((cB ^ (sB & 15)) << 4);
    const int wX = hx * 16384 + sB * 128 + (((cX >> 1) ^ ((sB >> 1) & 3)) << 5) + (cX & 1) * 16;
    f32x4 st[2][4];
#pragma unroll
    for (int hh = 0; hh < 2; ++hh)
#pragma unroll
        for (int pt = 0; pt < 4; ++pt) st[hh][pt] = (f32x4){0.f, 0.f, 0.f, 0.f};
    v4u Bq[4], Xq[4]; float dq0 = 0.f, dq1 = 0.f; bf16x8 cf[4];
#define PR_DECODE(step, d_, base_, ctx_) const int d_ = 1 - (step) / 18; const int k_##d_ = (step) % 18; const bool ctx_ = k_##d_ < 2; \
    const size_t base_ = ctx_ ? (size_t)ML + (size_t)b * CTXL + (size_t)(d_ ? 1 - k_##d_ : k_##d_) * 128 : (size_t)b * SEQ + (size_t)(d_ ? 17 - k_##d_ : k_##d_ - 2) * 128;
#define PR_ISSUE(step) do { PR_DECODE(step, di, basei, ctxi) (void)ctxi; \
        const bf16* cb_ = XC + basei * CONVC; const int sg_ = di ? -CONVC : CONVC; const int o0_ = di ? 127 * CONVC : 0; \
        const bf16* pb_ = cb_ + (o0_ + sB * sg_ + 1024 + g * 128 + 8 * cB); const bf16* px_ = cb_ + (o0_ + sB * sg_ + h0 * 64 + 8 * cB); \
        _Pragma("unroll") for (int k4 = 0; k4 < 4; ++k4) { Bq[k4] = *(const v4u*)(pb_ + k4 * 32 * sg_); Xq[k4] = *(const v4u*)(px_ + k4 * 32 * sg_); } \
        if (wave < 2) { const size_t r0 = basei + (di ? 127 - 2 * lane : 2 * lane), r1 = basei + (di ? 126 - 2 * lane : 2 * lane + 1); dq0 = DT[r0 * 32 + di * 16 + h0 + wave]; dq1 = DT[r1 * 32 + di * 16 + h0 + wave]; } } while (0)
#define PR_LOADC(step) do { PR_DECODE(step, dc, basec, ctxc) (void)ctxc; const bf16* pc_ = XC + basec * CONVC + ((dc ? 127 - (16 * wave + fr) : 16 * wave + fr) * CONVC + 1280 + g * 128 + 8 * fq); \
        _Pragma("unroll") for (int k4 = 0; k4 < 4; ++k4) cf[k4] = __builtin_bit_cast(bf16x8, *(const v4u*)(pc_ + 32 * k4)); } while (0)
#define PR_CUMSUM(step, par) do { if (wave < 2) { const float an = (1 - (step) / 18) ? (wave ? an11 : an10) : (wave ? an01 : an00); const float a0 = dq0 * an, a1 = dq1 * an; const float v = scan64(a0 + a1); \
        const int o_ = ((par) * 2 + wave) * 128 + 2 * lane; dtv[o_] = dq0; dtv[o_ + 1] = dq1; cs2[o_] = v - a1; cs2[o_ + 1] = v; } } while (0)
#define PR_WRITE(step, par) do { const int ob_ = ((par) * 2 + hx) * 128; const float cl = cs2[ob_ + 127]; \
        _Pragma("unroll") for (int k4 = 0; k4 < 4; ++k4) { *(LAS v4u*)(Bi + wB + k4 * 8192) = Bq[k4]; \
            const int s = sB + 32 * k4; const float dts = dtv[ob_ + s], es = __builtin_amdgcn_exp2f(cl - cs2[ob_ + s]); \
            float f[8]; unpack8(Xq[k4], f); _Pragma("unroll") for (int e = 0; e < 8; ++e) f[e] *= dts; \
            v4u xo; xo.x = pk2(f[0], f[1]); xo.y = pk2(f[2], f[3]); xo.z = pk2(f[4], f[5]); xo.w = pk2(f[6], f[7]); \
            _Pragma("unroll") for (int e = 0; e < 8; ++e) f[e] *= es; \
            v4u xd; xd.x = pk2(f[0], f[1]); xd.y = pk2(f[2], f[3]); xd.z = pk2(f[4], f[5]); xd.w = pk2(f[6], f[7]); \
            *(LAS v4u*)(L + P_X + wX + k4 * 4096) = xo; *(LAS v4u*)(L + P_XD + wX + k4 * 4096) = xd; } } while (0)
#define PR_WRITE_STATE() do { _Pragma("unroll") for (int pt = 0; pt < 4; ++pt) { \
        u32x2_t w; w.x = pk2(st[0][pt][0], st[0][pt][1]); w.y = pk2(st[0][pt][2], st[0][pt][3]); *(LAS u32x2_t*)(L + P_ST0 + lo.sw + pt * 4096) = w; \
        w.x = pk2(st[1][pt][0], st[1][pt][1]); w.y = pk2(st[1][pt][2], st[1][pt][3]); *(LAS u32x2_t*)(L + P_ST1 + lo.sw + pt * 4096) = w; } } while (0)

    __syncthreads();
    PR_ISSUE(0); PR_LOADC(0); PR_CUMSUM(0, 0); PR_WRITE_STATE();
    __syncthreads();
    PR_WRITE(0, 0);
    __syncthreads();
    for (int step = 0; step < 36; ++step) {
        const int par = step & 1; PR_DECODE(step, d, base, isctx)
        const int r8 = lane >> 3, c8 = lane & 7;
        size_t orow2[2]; v4u ybv[2], zv[2];
#pragma unroll
        for (int ps = 0; ps < 2; ++ps) { const int l = 16 * wave + 8 * ps + r8; orow2[ps] = base + (d ? 127 - l : l); }
        const bool fwdy = !isctx && d == 0;
        if (fwdy) {
#pragma unroll
            for (int ps = 0; ps < 2; ++ps) { ybv[ps] = *(const v4u*)(YQ + orow2[ps] * 2048 + h0 * 64 + 8 * c8); zv[ps] = *(const v4u*)(Z + orow2[ps] * 1024 + h0 * 64 + 8 * c8); } }
        if (step + 1 < 36) PR_ISSUE(step + 1);
        if (!isctx) {
#pragma unroll
            for (int hh = 0; hh < 2; ++hh) {
                const LAS float* csc = cs2 + (par * 2 + hh) * 128;
                const LAS unsigned char* Xi = L + P_X + hh * 16384; const LAS unsigned char* Sti = L + (hh ? P_ST1 : P_ST0);
                const float csl = csc[16 * wave + fr];
                const float skd = d == 0 ? (hh ? dsk1 : dsk0) * __builtin_amdgcn_rcpf(dtv[(par * 2 + hh) * 128 + 16 * wave + fr]) : 0.f;
                f32x4 y[4];
#pragma unroll
                for (int pt = 0; pt < 4; ++pt) { y[pt] = (f32x4){0.f, 0.f, 0.f, 0.f};
#pragma unroll
                    for (int kk = 0; kk < 4; ++kk) y[pt] = SSD_MFMA(frag(Sti, lo.fb[kk], pt), cf[kk], y[pt]); }
                { const float El = __builtin_amdgcn_exp2f(csl);
#pragma unroll
                  for (int pt = 0; pt < 4; ++pt) y[pt] *= El; }
                diag_sw(wave, y, cf, Bi, Xi, csc, csl, skd, fr, fq, lo);
#pragma unroll
                for (int ps = 0; ps < 2; ++ps) {
                    if ((fr >> 3) == ps) {
#pragma unroll
                        for (int pt = 0; pt < 4; ++pt) *(LAS f32x4*)(Stg + (fr & 7) * 256 + (((4 * pt + fq) ^ fr) << 4)) = y[pt]; }
                    const int key = 8 * ps + r8;
                    const f32x4 t0 = *(const LAS f32x4*)(Stg + r8 * 256 + (((2 * c8) ^ key) << 4)), t1 = *(const LAS f32x4*)(Stg + r8 * 256 + (((2 * c8 + 1) ^ key) << 4));
                    float v[8] = {t0[0], t0[1], t0[2], t0[3], t1[0], t1[1], t1[2], t1[3]};
                    if (d == 0) { float fb[8], fz[8]; unpack8(ybv[ps], fb); unpack8(zv[ps], fz); float q = 0.f;
#pragma unroll
                        for (int e = 0; e < 8; ++e) { v[e] = (v[e] + fb[e]) * fz[e]; q += v[e] * v[e]; }
                        q = sum8(q);
                        if (c8 == 0) SSQ[orow2[ps] * 16 + h0 + hh] = q; }
                    v4u o; o.x = pk2(v[0], v[1]); o.y = pk2(v[2], v[3]); o.z = pk2(v[4], v[5]); o.w = pk2(v[6], v[7]);
                    *(v4u*)(YQ + orow2[ps] * 2048 + (h0 + hh) * 64 + 8 * c8) = o;
                }
                if (hh == 0 && fwdy) {
#pragma unroll
                    for (int ps = 0; ps < 2; ++ps) { ybv[ps] = *(const v4u*)(YQ + orow2[ps] * 2048 + (h0 + 1) * 64 + 8 * c8); zv[ps] = *(const v4u*)(Z + orow2[ps] * 1024 + (h0 + 1) * 64 + 8 * c8); } }
            }
        }
        if (step + 1 < 36) PR_LOADC(step + 1);
        { const float dec0 = __builtin_amdgcn_exp2f(cs2[(par * 2 + 0) * 128 + 127]), dec1 = __builtin_amdgcn_exp2f(cs2[(par * 2 + 1) * 128 + 127]);
#pragma unroll
          for (int pt = 0; pt < 4; ++pt) { st[0][pt] *= dec0; st[1][pt] *= dec1; }
#pragma unroll
          for (int kk = 0; kk < 4; ++kk) { const bf16x8 af = trfragB(Bi, lo.bb, 32 * kk);
#pragma unroll
              for (int pt = 0; pt < 4; ++pt) { st[0][pt] = SSD_MFMA(af, trfragX(L + P_XD, lo.xb[pt], 32 * kk), st[0][pt]); st[1][pt] = SSD_MFMA(af, trfragX(L + P_XD + 16384, lo.xb[pt], 32 * kk), st[1][pt]); } } }
        if (step + 1 < 36) PR_CUMSUM(step + 1, par ^ 1);
        if (step == 17) {
#pragma unroll
            for (int pt = 0; pt < 4; ++pt) { st[0][pt] = (f32x4){0.f, 0.f, 0.f, 0.f}; st[1][pt] = (f32x4){0.f, 0.f, 0.f, 0.f}; }
            VM_WAIT();
        }
        __syncthreads();
        PR_WRITE_STATE();
        if (step + 1 < 36) PR_WRITE(step + 1, par ^ 1);
        __syncthreads();
    }
#undef PR_DECODE
#undef PR_ISSUE
#undef PR_CUMSUM
#undef PR_LOADC
#undef PR_WRITE
#undef PR_WRITE_STATE
}
}
}

__device__ __forceinline__ void ctx_dt_slice(const bf16* H, const bf16* bt1, const float* dt_bias, float* DT, int bx, int G, int wave, int lane) {
    typedef short bf16x8_t __attribute__((ext_vector_type(8)));
    const int fr = lane & 15, fq = lane >> 4;
    for (int sl = bx; sl < MC / 32; sl += G) {
        if (wave < 4) {
            const int r0 = ML + 32 * sl + 16 * (wave >> 1), j0 = 16 * (wave & 1);
            const bf16* ap = H + (size_t)(r0 + fr) * DM + 8 * fq; const bf16* bp = bt1 + (size_t)(2048 + j0 + fr) * DM + 8 * fq;
            f32x4 acc = (f32x4){0.f, 0.f, 0.f, 0.f};
#pragma unroll 8
            for (int kk = 0; kk < 32; ++kk) acc = __builtin_amdgcn_mfma_f32_16x16x32_bf16(*(const bf16x8_t*)(ap + 32 * kk), *(const bf16x8_t*)(bp + 32 * kk), acc, 0, 0, 0);
            const float bias = dt_bias[j0 + fr];
#pragma unroll
            for (int e = 0; e < 4; ++e) { const float v = acc[e] + bias; DT[(size_t)(r0 + 4 * fq + e) * 32 + j0 + fr] = v > 20.f ? v : log1pf(__expf(v)); }
        }
    }
}
constexpr int RING_OFF = 0, RING_BYTES = 131072;
constexpr int LDSCTL_OFF = RING_BYTES, MISC_OFF = LDSCTL_OFF + 320;
constexpr int RSTD_OFF = LDSCTL_OFF + 1024;
constexpr int LDS_BYTES = 155648;
constexpr int CW_BAR = 4096;
constexpr int CW_TMO2 = 8192, CW_CNT = 16384;
constexpr int EXL_OFF = 140288;
constexpr int NPHASE = 7;

struct Args { const float* in[18]; float* out; unsigned char* ws; int ph_lo, ph_hi; };

__global__ void __launch_bounds__(NWAVES * 64, 2) mega(Args args) {
    extern __shared__ __attribute__((aligned(16))) unsigned char lds[];
    LAS unsigned char* ldsp = (LAS unsigned char*)lds;
    volatile LAS unsigned* MISC = (volatile LAS unsigned*)(ldsp + MISC_OFF);
    const int wave = __builtin_amdgcn_readfirstlane((int)threadIdx.x >> 6);
#define PH_IDS() int lane = mk_lane(); asm volatile("" : "+v"(lane)); const int tid = wave * 64 + lane; (void)tid
    const int G = gridDim.x; const int bx = blockIdx.x; const int vcu = (G % 8 == 0) ? (bx % 8) * (G / 8) + bx / 8 : bx;
    unsigned char* ws = args.ws;
    gu32* ctl = (gu32*)(ws + WS_CTL);
    float* mod = (float*)(ws + WS_MOD); float* rope = (float*)(ws + WS_ROPE); float* SSQ = (float*)(ws + WS_SSQ); float* RPART = (float*)(ws + WS_RPART);
    bf16* bt1 = (bf16*)(ws + WS_BT1); bf16* bt2 = (bf16*)(ws + WS_BT2); float* DT = (float*)(ws + WS_DT); bf16* KB = (bf16*)(ws + WS_KB); bf16* VB = (bf16*)(ws + WS_VB);
    bf16* H = (bf16*)(ws + WS_R1); bf16* XC = (bf16*)(ws + WS_R1); bf16* XBC = (bf16*)(ws + WS_XBC); bf16* YQ = (bf16*)(ws + WS_YQ); bf16* Z = (bf16*)(ws + WS_Z);
    { PH_IDS(); for (int u = tid; u < (LDS_BYTES - LDSCTL_OFF) / 4; u += NWAVES * 64) ((LAS unsigned*)(ldsp + LDSCTL_OFF))[u] = 0u; }
    __syncthreads();
    const bool leader = wave == 0 && mk_lane() == 0; (void)leader;
    const int lo = args.ph_lo, hi = args.ph_hi;
    XcdBarrier bar; bar.bar = (unsigned*)(ctl + CW_BAR); bar.x = 0; bar.st = nullptr;
    if (hi - lo > 1) bar = xcd_barrier_post((unsigned*)(ctl + CW_BAR), MISC + 8, leader);
#ifndef DUP_MASK
#define DUP_MASK 0
#endif
#define IN(k) (lo <= (k) && (k) < hi)
#define REP(k) for (int rep_ = 0; rep_ < 1 + ((DUP_MASK >> (k)) & 1); ++rep_)
#define SEAM(k) do { if (IN(k) && IN((k) + 1)) xcd_barrier(bar, wave == 0 && mk_lane() == 0); } while (0)

    if (IN(0)) REP(0) {
        PH_IDS();
        LAS float* ldsf = (LAS float*)(ldsp + RING_OFF);
        if (bx < 48) p0_mod_block(args.in[1], args.in[3], args.in[4], args.in[5], mod, ldsf, bx, tid, lane, wave);
        else if (bx == 48) { for (int i = tid; i < 1024; i += NWAVES * 64) { const int p = i >> 4, f = i & 15; const float inv = powf(10000.f, -(float)f / 16.f); const float ang = (float)p * inv; rope[i] = cosf(ang); rope[1024 + i] = sinf(ang); } }
        LAS float* scr = ldsf + wave * (64 * 33);
        const int gw = ((bx + G - 49) % G) * NWAVES + wave, NGW = G * NWAVES;
        constexpr int I1 = 16 * 168, I2 = 32 * 32;
        for (int it = gw; it < I1 + I2; it += NGW) { if (it < I1) p0_bt1_item(args.in[7], bt1, scr, it, lane); else p0_bt2_item(args.in[16], args.in[15], bt2, scr, it - I1, lane); }
    }
    SEAM(0);
    if (IN(1)) REP(1) {
        PH_IDS();
        const int gw = bx * NWAVES + wave, NGW = G * NWAVES;
        static_assert(MT % (8 * 2048) == 0 || true, "row batches");
        {
            const int step = NGW * 4; int m0 = gw * 4;
            f32x4 va[4][4], vb[4][4];
            if (m0 < MT) p1_load4(va, args.in[0], args.in[2], m0, lane);
            while (m0 < MT) {
                if (m0 + step < MT) p1_load4(vb, args.in[0], args.in[2], m0 + step, lane);
                asm volatile("" ::: "memory");
                p1_proc4(va, mod, args.in[6], H, m0, lane);
                m0 += step; if (m0 >= MT) break;
                if (m0 + step < MT) p1_load4(va, args.in[0], args.in[2], m0 + step, lane);
                asm volatile("" ::: "memory");
                p1_proc4(vb, mod, args.in[6], H, m0, lane);
                m0 += step;
            }
        }
    }
    SEAM(1);

    if (IN(2)) REP(2) {
        pg8::Gemm g{H, bt1, MT, N1, 1024}; pg8::Sched1 S; S.init(G, bx);
        pg8::Epi1 E{KB, VB, XBC, YQ, Z, DT, rope, args.in[13], args.in[14], args.in[10]};
        pg8::gemm_phase<pg8::Epi1, pg8::Sched1, true, true>(ldsp + RING_OFF, g, S, E, wave);
        { int ln_ = mk_lane(); asm volatile("" : "+v"(ln_)); ctx_dt_slice(H, bt1, args.in[10], DT, bx, G, wave, ln_); }
    }
    SEAM(2);
    if (IN(3)) {
        PH_IDS();
        float sbound;
        { float gq = fabsf(args.in[13][lane]), gk = fabsf(args.in[14][lane]);
#pragma unroll
          for (int o = 1; o < 64; o <<= 1) { gq = fmaxf(gq, __shfl_xor(gq, o)); gk = fmaxf(gk, __shfl_xor(gk, o)); }
          sbound = __uint_as_float(__builtin_amdgcn_readfirstlane(__float_as_uint(C2 * 64.f * gq * gk * 1.01f))); }
        const attn_body::Order S{vcu, G, false};
        const attn_body::Order S2{vcu, G, true};
#ifndef ATTN_SHADOW
#define ATTN_SHADOW 0
#endif
        if (ATTN_SHADOW) attn_body::attn_phase<8>((char*)lds + RING_OFF, (attn_body::bf16*)YQ, (const attn_body::bf16*)KB, (const attn_body::bf16*)VB, ATTN_SHADOW == 2 ? S2 : S, wave, sbound, (attn_body::bf16*)(ws + WS_END + 8 * MiB));
        attn_body::attn_phase<8>((char*)lds + RING_OFF, (attn_body::bf16*)YQ, (const attn_body::bf16*)KB, (const attn_body::bf16*)VB, S, wave, sbound);
        conv_phase(XBC, args.in[8], args.in[9], XC, bx, G, tid);
    }
    SEAM(3);
    if (IN(4)) REP(4) {
        PH_IDS();
#if defined(SSD_NAIVE)
        for (int it = bx; it < NB * 16; it += G) ssd_item_naive(it >> 4, it & 15, XC, DT, Z, args.in[11], args.in[12], YQ, SSQ, (LAS float*)(ldsp + RING_OFF), tid);
#else
#ifndef SSD_SHADOW
#define SSD_SHADOW 0
#endif
        if (SSD_SHADOW) { bf16* dY = (bf16*)(ws + WS_END); float* dS = (float*)(ws + WS_END + 2 * MiB);
            for (int it = vcu; it < NB * 16; it += G) ssd::ssd_item<SSD_SHADOW>(it >> 4, it & 15, XC, DT, Z, args.in[11], args.in[12], dY, dS, ldsp, tid, lane, wave); }
#ifndef SSD_PAIR
#define SSD_PAIR 1
#endif
        if (SSD_PAIR) { for (int it = vcu; it < NB * 8; it += G) { int ln_ = mk_lane(); asm volatile("" : "+v"(ln_)); ssd::pr::ssd_pair(it >> 3, it & 7, XC, DT, Z, args.in[11], args.in[12], YQ, SSQ, ldsp, wave * 64 + ln_, ln_, wave); } }
        else for (int it = vcu; it < NB * 16; it += G) ssd::ssd_item<0>(it >> 4, it & 15, XC, DT, Z, args.in[11], args.in[12], YQ, SSQ, ldsp, tid, lane, wave);
#endif
    }
    SEAM(4);

    if (IN(5)) REP(5) {
        PH_IDS();
        pg8::Sched2 S; S.init(G, bx);
        LAS float* rt = (LAS float*)(ldsp + RSTD_OFF);
        { pg8::Unit u; for (int i = 0; i < 4 && S.next(i, u); ++i) if (tid < 256) { const float* q = SSQ + ((size_t)u.pm * 256 + tid) * 16; float s = 0.f;
#pragma unroll
                for (int j = 0; j < 16; ++j) s += q[j];
                rt[i * 256 + tid] = rsqrtf(s * (1.f / 1024.f) + EPS); } }
        __syncthreads();
        pg8::Gemm g{YQ, bt2, ML, 1024, 2048};
        pg8::Epi2 E{args.in[0], mod, args.in[17], args.out, (unsigned long long*)RPART, (unsigned*)(ctl + CW_CNT), (unsigned*)(ctl + CW_TMO2), (const LAS float*)rt, (LAS float*)(ldsp + EXL_OFF)};
        pg8::gemm_phase<pg8::Epi2, pg8::Sched2, true, true>(ldsp + RING_OFF, g, S, E, wave);
    }

#undef IN
#undef SEAM
}

__global__ void k_mod(const float* c, const float* c_ctx, const float* ada_w, const float* ada_b, float* mod) {
    const int i = blockIdx.x * 256 + threadIdx.x; if (i >= 33 * 3072) return;
    const int b = i / 3072, n = i % 3072; const float* cv = b < 32 ? c + b * 1024 : c_ctx;
    float acc = 0.f;
    for (int k = 0; k < 1024; ++k) acc += siluf(cv[k]) * ada_w[(size_t)k * 3072 + n];
    mod[i] = acc + ada_b[n];
}
__global__ void k_tables(float* rope) {
    const int i = blockIdx.x * 256 + threadIdx.x; if (i >= 1024) return;
    const int p = i >> 4, f = i & 15; const float inv = powf(10000.f, -(float)f / 16.f); const float ang = (float)p * inv;
    rope[i] = cosf(ang); rope[1024 + i] = sinf(ang);
}
__global__ void k_bt1(const float* w_in, bf16* bt1) {
    const size_t i = (size_t)blockIdx.x * 256 + threadIdx.x; if (i >= (size_t)N1 * 1024) return;
    const int v = (int)(i >> 10), k = (int)(i & 1023); const int a = vcol_actual(v);
    bt1[i] = (bf16)(a >= 0 ? f2bf(w_in[(size_t)k * PROJ + a]) : 0u);
}
__global__ void k_bt2(const float* w_out, const float* ssd_g, bf16* bt2) {
    const size_t i = (size_t)blockIdx.x * 256 + threadIdx.x; if (i >= (size_t)1024 * 2048) return;
    const int n = (int)(i >> 11), kk = (int)(i & 2047);
    const float v = kk < 1024 ? w_out[(size_t)(1024 + kk) * 1024 + n] * ssd_g[kk] : w_out[(size_t)(kk - 1024) * 1024 + n];
    bt2[i] = (bf16)f2bf(v);
}
__global__ void k_norm(const float* x, const float* ctx, const float* norm_g, const float* mod, bf16* H) {
    const int row = blockIdx.x * 4 + (threadIdx.x >> 6), lane = threadIdx.x & 63; if (row >= MT) return;
    const float* xr = row < ML ? x + (size_t)row * DM : ctx + (size_t)(row - ML) * DM;
    const float* md = mod + (size_t)(row < ML ? row / SEQ : 32) * 3072;
    float v[16]; float s = 0.f;
    for (int j = 0; j < 16; ++j) { v[j] = xr[lane + 64 * j]; s += v[j] * v[j]; }
    for (int o = 1; o < 64; o <<= 1) s += __shfl_xor(s, o);
    const float rstd = rsqrtf(s * (1.f / DM) + EPS);
    for (int j = 0; j < 16; ++j) { const int k = lane + 64 * j; const float h = v[j] * rstd * norm_g[k] * (1.f + md[1024 + k]) + md[k]; H[(size_t)row * DM + k] = (bf16)f2bf(h); }
}
__global__ __launch_bounds__(256) void k_gemm1(const bf16* H, const bf16* bt1, const float* rope, const float* qg, const float* kg, const float* dt_bias,
                                                bf16* KB, bf16* VB, bf16* XBC, float* DT, bf16* YQ, bf16* Z) {
    __shared__ float As[32][65];
    __shared__ float Ps[32][257];
    const int pn = blockIdx.x, rt = blockIdx.y, tid = threadIdx.x; const int row0 = rt * 32;
    if (row0 >= ML && pn > 8) return;
    float acc[32];
    for (int r = 0; r < 32; ++r) acc[r] = 0.f;
    const bf16* bp = bt1 + (size_t)(pn * 256 + tid) * 1024;
    for (int k0 = 0; k0 < 1024; k0 += 64) {
        __syncthreads();
        for (int e = tid; e < 32 * 64; e += 256) { const int r = e >> 6, kk = e & 63; As[r][kk] = bf2f(H[(size_t)(row0 + r) * DM + k0 + kk]); }
        __syncthreads();
        for (int kk = 0; kk < 64; ++kk) { const float b = bf2f(bp[k0 + kk]);
            for (int r = 0; r < 32; ++r) acc[r] += As[r][kk] * b; }
    }
    for (int r = 0; r < 32; ++r) Ps[r][tid] = acc[r];
    __syncthreads();
    const bool isctx = row0 >= ML;
    if (pn == 0 || (pn >= 9 && pn < 13)) {
        {
            const int r = tid >> 3, hd = (tid >> 1) & 3, ax = tid & 1, row = row0 + r; const float* g = pn == 0 ? kg : qg;
            float s = 0.f;
            for (int d = 0; d < 32; ++d) { const float v = Ps[r][hperm_inv(hd, ax * 32 + d)]; s += v * v; }
            s += __shfl_xor(s, 1);
            const float rstd = rsqrtf(s * (1.f / 64.f) + EPS);
            const int t = row % SEQ, p = ax == 0 ? (t >> 6) : (t & 63);
            bf16* dst; float osc = 1.f;
            if (pn == 0) { const int b = isctx ? (row - ML) / CTXL : row / SEQ, pos = isctx ? SEQ + (row - ML) % CTXL : row % SEQ; dst = KB + ((size_t)b * KVL + pos) * 256 + hd * 64 + ax * 32; }
            else { dst = YQ + (size_t)row * 2048 + 1024 + ((pn - 9) * 4 + hd) * 64 + ax * 32; osc = C2; }
            for (int f = 0; f < 16; ++f) {
                const float x1 = Ps[r][hperm_inv(hd, ax * 32 + f)] * rstd * g[ax * 32 + f], x2 = Ps[r][hperm_inv(hd, ax * 32 + 16 + f)] * rstd * g[ax * 32 + 16 + f];
                float o1 = x1, o2 = x2;
                if (!isctx) { const float cs = rope[p * 16 + f], sn = rope[1024 + p * 16 + f]; o1 = x1 * cs - x2 * sn; o2 = x2 * cs + x1 * sn; }
                dst[f] = (bf16)f2bf(o1 * osc); dst[16 + f] = (bf16)f2bf(o2 * osc);
            }
        }
    } else {
        for (int r = 0; r < 32; ++r) { const int row = row0 + r; const float v = Ps[r][tid];
            if (pn == 1) { const int b = isctx ? (row - ML) / CTXL : row / SEQ, pos = isctx ? SEQ + (row - ML) % CTXL : row % SEQ;
                VB[((size_t)b * KVL + pos) * 256 + tid] = (bf16)f2bf(v); }
            else if (pn < 8) XBC[(size_t)row * CONVC + (pn - 2) * 256 + tid] = (bf16)f2bf(v);
            else if (pn == 8) { if (tid < 32) DT[(size_t)row * 32 + tid] = softplusf(v + dt_bias[tid]); }
            else if (pn < 17) YQ[(size_t)row * 2048 + (pn - 13) * 256 + tid] = (bf16)f2bf(siluf(v));
            else Z[(size_t)row * 1024 + (pn - 17) * 256 + tid] = (bf16)f2bf(siluf(v)); }
    }
}
__global__ __launch_bounds__(256) void k_attn(bf16* YQ, const bf16* KB, const bf16* VB) {
    __shared__ float Qs[64][65]; __shared__ float Ks[64][65]; __shared__ float Ps[64][65]; __shared__ bf16 Vs[64][66];
    const int qb = blockIdx.x, h = blockIdx.y, b = blockIdx.z, tid = threadIdx.x, ty = tid >> 4, tx = tid & 15;
    const size_t row0 = (size_t)b * SEQ + qb * 64; const int kvh = h >> 2;
    for (int e = tid; e < 4096; e += 256) { const int r = e >> 6, d = e & 63; Qs[r][d] = bf2f(YQ[(row0 + r) * 2048 + 1024 + h * 64 + d]); }
    float o[4][4], l[4];
    for (int i = 0; i < 4; ++i) { l[i] = 0.f; for (int j = 0; j < 4; ++j) o[i][j] = 0.f; }
    for (int kt = 0; kt < KVL / 64; ++kt) {
        __syncthreads();
        for (int e = tid; e < 4096; e += 256) { const int r = e >> 6, d = e & 63; const size_t src = ((size_t)b * KVL + kt * 64 + r) * 256 + kvh * 64 + d;
            Ks[r][d] = bf2f(KB[src]); Vs[r][d] = VB[src]; }
        __syncthreads();
        float s[4][4];
        for (int i = 0; i < 4; ++i) for (int j = 0; j < 4; ++j) s[i][j] = 0.f;
        for (int d = 0; d < 64; ++d) { float a[4], k4[4];
            for (int i = 0; i < 4; ++i) { a[i] = Qs[ty * 4 + i][d]; k4[i] = Ks[tx * 4 + i][d]; }
            for (int i = 0; i < 4; ++i) for (int j = 0; j < 4; ++j) s[i][j] += a[i] * k4[j]; }
        for (int i = 0; i < 4; ++i) for (int j = 0; j < 4; ++j) Ps[ty * 4 + i][tx * 4 + j] = exp2f(s[i][j]);
        __syncthreads();
        for (int key = 0; key < 64; ++key) { float p[4], v4[4];
            for (int i = 0; i < 4; ++i) { p[i] = Ps[ty * 4 + i][key]; v4[i] = bf2f(Vs[key][tx * 4 + i]); }
            for (int i = 0; i < 4; ++i) { l[i] += p[i]; for (int j = 0; j < 4; ++j) o[i][j] += p[i] * v4[j]; } }
    }
    for (int i = 0; i < 4; ++i) for (int j = 0; j < 4; ++j) { const size_t row = row0 + ty * 4 + i; const int d = tx * 4 + j;
        const float ga = bf2f(YQ[row * 2048 + h * 64 + d]);
        YQ[row * 2048 + 1024 + h * 64 + d] = (bf16)f2bf(o[i][j] / l[i] * ga); }
}
__global__ void k_conv(const bf16* XBC, const float* cw, const float* cb, bf16* XC) {
    const size_t i = (size_t)blockIdx.x * 256 + threadIdx.x; if (i >= (size_t)MT * CONVC) return;
    const int row = (int)(i / CONVC), ch = (int)(i % CONVC);
    int t, len; if (row < ML) { t = row % SEQ; len = SEQ; } else { t = (row - ML) % CTXL; len = CTXL; }
    float acc = cb[ch];
    for (int j = 0; j < 5; ++j) { const int tt = t + j - 2; if (tt >= 0 && tt < len) acc += cw[j * CONVC + ch] * bf2f(XBC[(size_t)(row + j - 2) * CONVC + ch]); }
    XC[i] = (bf16)f2bf(siluf(acc));
}
__global__ __launch_bounds__(512) void k_ssd(const bf16* XC, const float* DT, const bf16* Z, const float* a_log, const float* d_skip, bf16* YQ, float* SSQ) {
    __shared__ float ysq[64];
    const int h = blockIdx.x, b = blockIdx.y, tid = threadIdx.x, p = tid >> 3, nc = tid & 7, g = h >> 3;
    for (int dd = 0; dd < 2; ++dd) { const int d = 1 - dd;
        const float a_neg = -expf(a_log[d * 16 + h]);
        float S[16];
        for (int j = 0; j < 16; ++j) S[j] = 0.f;
        for (int seq = 0; seq < 2; ++seq) { const int len = seq == 0 ? CTXL : SEQ; const size_t rbase = seq == 0 ? (size_t)ML + (size_t)b * CTXL : (size_t)b * SEQ;
            for (int st = 0; st < len; ++st) { const int t = d ? len - 1 - st : st; const size_t row = rbase + t;
                const float dt = DT[row * 32 + d * 16 + h]; const float dec = expf(dt * a_neg);
                const float xs = bf2f(XC[row * CONVC + h * 64 + p]); const float X = xs * dt;
                const bf16* Bp = XC + row * CONVC + 1024 + g * 128 + nc * 16; const bf16* Cp = Bp + 256;
                float y = 0.f;
                for (int j = 0; j < 16; ++j) { S[j] = S[j] * dec + X * bf2f(Bp[j]); y += bf2f(Cp[j]) * S[j]; }
                y += __shfl_xor(y, 1); y += __shfl_xor(y, 2); y += __shfl_xor(y, 4);
                if (seq == 1) {
                    bf16* yp = YQ + row * 2048 + h * 64 + p;
                    if (d == 1) { if (nc == 0) *yp = (bf16)f2bf(y); }
                    else {
                        float yg = 0.f;
                        if (nc == 0) { const float yt = y + bf2f(*yp) + d_skip[h] * xs; yg = yt * bf2f(Z[row * 1024 + h * 64 + p]); *yp = (bf16)f2bf(yg); ysq[p] = yg * yg; }
                        __syncthreads();
                        if (tid < 64) { float q = ysq[tid]; for (int o = 1; o < 64; o <<= 1) q += __shfl_xor(q, o); if (tid == 0) SSQ[row * 16 + h] = q; }
                        __syncthreads();
                    }
                }
            }
        }
    }
}
__global__ __launch_bounds__(256) void k_gemm2(const bf16* YQ, const bf16* bt2, const float* SSQ, const float* x, const float* mod, float* out, float* RPART) {
    __shared__ float As[32][65]; __shared__ float red[32][4];
    const int pn = blockIdx.x, rt = blockIdx.y, tid = threadIdx.x, row0 = rt * 32;
    float acc[32];
    for (int r = 0; r < 32; ++r) acc[r] = 0.f;
    const bf16* bp = bt2 + (size_t)(pn * 256 + tid) * 2048;
    for (int k0 = 0; k0 < 2048; k0 += 64) {
        if (k0 == 1024) { for (int r = 0; r < 32; ++r) { float s = 0.f; for (int j = 0; j < 16; ++j) s += SSQ[(size_t)(row0 + r) * 16 + j]; acc[r] *= rsqrtf(s * (1.f / 1024.f) + EPS); } }
        __syncthreads();
        for (int e = tid; e < 32 * 64; e += 256) { const int r = e >> 6, kk = e & 63; As[r][kk] = bf2f(YQ[(size_t)(row0 + r) * 2048 + k0 + kk]); }
        __syncthreads();
        for (int kk = 0; kk < 64; ++kk) { const float bv = bf2f(bp[k0 + kk]);
            for (int r = 0; r < 32; ++r) acc[r] += As[r][kk] * bv; }
    }
    const int n = pn * 256 + tid;
    for (int r = 0; r < 32; ++r) { const int row = row0 + r; const float v = x[(size_t)row * DM + n] + mod[(size_t)(row / SEQ) * 3072 + 2048 + n] * acc[r];
        out[(size_t)row * DM + n] = v; float q = v * v;
        for (int o = 1; o < 64; o <<= 1) q += __shfl_xor(q, o);
        if ((tid & 63) == 0) RPART[(size_t)row * 16 + pn * 4 + (tid >> 6)] = q; }
}
__global__ void k_final(float* out, const float* RPART, const float* fg) {
    const int row = blockIdx.x * 4 + (threadIdx.x >> 6), lane = threadIdx.x & 63;
    float s = 0.f;
    for (int j = 0; j < 16; ++j) s += RPART[(size_t)row * 16 + j];
    const float rstd = rsqrtf(s * (1.f / DM) + EPS);
    for (int j = 0; j < 16; ++j) { const int k = lane + 64 * j; out[(size_t)row * DM + k] *= rstd * fg[k]; }
}


#ifndef FAST_MASK
#define FAST_MASK 0x7f
#endif
extern "C" void kernel_launch(void* const* d_in, const int* in_sizes, int n_in, void* d_out, int out_size, void* d_ws, size_t ws_size, hipStream_t stream) {
    if (n_in != 18 || out_size != ML * DM || ws_size < WS_END) { fprintf(stderr, "kernel_launch: unexpected shapes (n_in %d out %d ws %zu)\n", n_in, out_size, ws_size); return; }
    static int grid = 0;
    if (grid == 0) {
        int dev = 0, cus = 0;
        if (hipGetDevice(&dev) != hipSuccess || hipDeviceGetAttribute(&cus, hipDeviceAttributeMultiprocessorCount, dev) != hipSuccess) { fprintf(stderr, "kernel_launch: device query failed\n"); grid = -1; return; }
        if (hipFuncSetAttribute((const void*)mega, hipFuncAttributeMaxDynamicSharedMemorySize, LDS_BYTES) != hipSuccess) { fprintf(stderr, "kernel_launch: hipFuncSetAttribute failed\n"); grid = -1; return; }
        int per_cu = 0;
        if (hipOccupancyMaxActiveBlocksPerMultiprocessor(&per_cu, (const void*)mega, NWAVES * 64, LDS_BYTES) != hipSuccess || per_cu < 1) fprintf(stderr, "kernel_launch: note: occupancy query says %d blocks/CU\n", per_cu);
        (void)hipGetLastError();
        grid = cus;
    }
    if (grid < 0) return;
    const float* x = (const float*)d_in[0]; const float* c = (const float*)d_in[1]; const float* ctx = (const float*)d_in[2]; const float* c_ctx = (const float*)d_in[3];
    const float* ada_w = (const float*)d_in[4]; const float* ada_b = (const float*)d_in[5]; const float* norm_g = (const float*)d_in[6]; const float* w_in = (const float*)d_in[7];
    const float* conv_w = (const float*)d_in[8]; const float* conv_b = (const float*)d_in[9]; const float* dt_bias = (const float*)d_in[10]; const float* a_log = (const float*)d_in[11];
    const float* d_skip = (const float*)d_in[12]; const float* qg = (const float*)d_in[13]; const float* kg = (const float*)d_in[14]; const float* ssd_g = (const float*)d_in[15];
    const float* w_out = (const float*)d_in[16]; const float* final_g = (const float*)d_in[17];
    unsigned char* ws = (unsigned char*)d_ws; float* out = (float*)d_out;
    float* mod = (float*)(ws + WS_MOD); float* rope = (float*)(ws + WS_ROPE); float* SSQ = (float*)(ws + WS_SSQ); float* RPART = (float*)(ws + WS_RPART);
    bf16* bt1 = (bf16*)(ws + WS_BT1); bf16* bt2 = (bf16*)(ws + WS_BT2); float* DT = (float*)(ws + WS_DT); bf16* KB = (bf16*)(ws + WS_KB); bf16* VB = (bf16*)(ws + WS_VB);
    bf16* H = (bf16*)(ws + WS_R1); bf16* XC = (bf16*)(ws + WS_R1); bf16* XBC = (bf16*)(ws + WS_XBC); bf16* YQ = (bf16*)(ws + WS_YQ); bf16* Z = (bf16*)(ws + WS_Z);
    (void)hipMemsetAsync(ws + WS_CTL, 0, 1 * MiB, stream);
    Args a{};
    for (int i = 0; i < 18; ++i) a.in[i] = (const float*)d_in[i];
    a.out = out; a.ws = ws;
    for (int ph = 0; ph < NPHASE;) {
        if ((FAST_MASK >> ph) & 1) { int e = ph; while (e < NPHASE && ((FAST_MASK >> e) & 1)) ++e;
            a.ph_lo = ph; a.ph_hi = e; hipLaunchKernelGGL(mega, dim3(grid), dim3(NWAVES * 64), LDS_BYTES, stream, a);
            const hipError_t le = hipPeekAtLastError(); if (le != hipSuccess) fprintf(stderr, "kernel_launch: mega launch failed: %s\n", hipGetErrorName(le));
            ph = e; continue; }
        switch (ph) {
        case 0: k_mod<<<(33 * 3072 + 255) / 256, 256, 0, stream>>>(c, c_ctx, ada_w, ada_b, mod); k_tables<<<4, 256, 0, stream>>>(rope);
                k_bt1<<<(N1 * 1024) / 256, 256, 0, stream>>>(w_in, bt1); k_bt2<<<(1024 * 2048) / 256, 256, 0, stream>>>(w_out, ssd_g, bt2); break;
        case 1: k_norm<<<MT / 4, 256, 0, stream>>>(x, ctx, norm_g, mod, H); break;
        case 2: k_gemm1<<<dim3(21, MT / 32), 256, 0, stream>>>(H, bt1, rope, qg, kg, dt_bias, KB, VB, XBC, DT, YQ, Z); break;
        case 3: k_attn<<<dim3(SEQ / 64, 16, NB), 256, 0, stream>>>(YQ, KB, VB); k_conv<<<(unsigned)(((size_t)MT * CONVC + 255) / 256), 256, 0, stream>>>(XBC, conv_w, conv_b, XC); break;
        case 4: k_ssd<<<dim3(16, NB), 512, 0, stream>>>(XC, DT, Z, a_log, d_skip, YQ, SSQ); break;
        case 5: k_gemm2<<<dim3(4, ML / 32), 256, 0, stream>>>(YQ, bt2, SSQ, x, mod, out, RPART); break;
        case 6: k_final<<<ML / 4, 256, 0, stream>>>(out, RPART, final_g); break;
        }
        ++ph;
    }
}
```

```cpp
#include <hip/hip_runtime.h>
#include <cstdio>
#include <cstdint>
#include <hip/hip_bf16.h>

constexpr int DM = 1024, NB = 32, SEQ = 2048, CTXL = 256, KVL = SEQ + CTXL;
constexpr int ML = NB * SEQ, MC = NB * CTXL, MT = ML + MC;
constexpr int PROJ = 5152, OFF_XBC = 512, OFF_DT = 2048, CTXC = 2080, CONVC = 1536;
constexpr int N1 = 21 * 256;
constexpr float EPS = 1e-6f;
constexpr float C2 = 0.125f * 1.4426950408889634f;

typedef unsigned short bf16;
__device__ __forceinline__ int mk_lane() { return (int)__builtin_amdgcn_mbcnt_hi(~0u, __builtin_amdgcn_mbcnt_lo(~0u, 0u)); }
__host__ __device__ __forceinline__ unsigned f2bf(float f) { unsigned u = __builtin_bit_cast(unsigned, f); return (u + 0x7fffu + ((u >> 16) & 1u)) >> 16; }
__host__ __device__ __forceinline__ float bf2f(unsigned h) { return __builtin_bit_cast(float, (h & 0xffffu) << 16); }
__device__ __forceinline__ float siluf(float v) { return v / (1.f + __expf(-v)); }
__device__ __forceinline__ float softplusf(float v) { return v > 20.f ? v : log1pf(expf(v)); }

constexpr size_t MiB = 1u << 20;
constexpr size_t WS_CTL = 0;
constexpr size_t WS_MOD = 2 * MiB;
constexpr size_t WS_ROPE = 3 * MiB;
constexpr size_t WS_SSQ = 4 * MiB;
constexpr size_t WS_RPART = 8 * MiB;
constexpr size_t WS_BT1 = 12 * MiB;
constexpr size_t WS_BT2 = 23 * MiB;
constexpr size_t WS_DT = 28 * MiB;
constexpr size_t WS_KB = 38 * MiB;
constexpr size_t WS_VB = 74 * MiB;
constexpr size_t WS_R1 = 110 * MiB;
constexpr size_t WS_XBC = 326 * MiB;
constexpr size_t WS_YQ = 542 * MiB;
constexpr size_t WS_Z = 798 * MiB;
constexpr size_t WS_END = 926 * MiB;

__host__ __device__ __forceinline__ int hperm_dim(int vin) {
    const int bj = vin >> 7, wc = (vin >> 5) & 3, s = vin & 31, fq = s >> 3, e = s & 7;
    return wc * 64 + bj * 32 + (e >> 2) * 16 + 4 * fq + (e & 3);
}
__host__ __device__ __forceinline__ int hperm_inv(int head, int dim) {
    const int axis = dim >> 5, half = (dim >> 4) & 1, i16 = dim & 15, fq = i16 >> 2, e = (i16 & 3) + 4 * half;
    return 128 * axis + 32 * head + 8 * fq + e;
}
__host__ __device__ __forceinline__ int vcol_actual(int v) {
    const int t = v >> 8, vin = v & 255;
    if (t == 0) return hperm_dim(vin);
    if (t == 1) return 256 + vin;
    if (t < 8) return v;
    if (t == 8) return vin < 32 ? OFF_DT + vin : -1;
    if (t < 13) return CTXC + (t - 9) * 256 + hperm_dim(vin);
    if (t < 17) return CTXC + 1024 + (v - 13 * 256);
    return CTXC + 2048 + (v - 17 * 256);
}

namespace pg8 {
#define PG8_LAS __attribute__((address_space(3)))
typedef unsigned short bf16_t;
typedef short bf16x8 __attribute__((ext_vector_type(8)));
typedef float f32x4 __attribute__((ext_vector_type(4)));
typedef unsigned u32x4 __attribute__((ext_vector_type(4)));
constexpr int BM = 256, BK = 64, HALF = 128, HTB = HALF * BK * 2  , STAGE_BYTES = 8 * HTB, NXCD = 8, WGM = 8;

__host__ __device__ __forceinline__ int lds_byte(int r, int c) { const int st = (r >> 4) * 2 + (c >> 5), rr = r & 15, cc = c & 31, ob = rr * 64 + cc * 2; return st * 1024 + (ob ^ (((ob >> 9) & 1) << 5)); }
__host__ __device__ __forceinline__ void stage_rc(int b, int& R, int& C) { const int st = b / 1024, sb = b % 1024, swz = sb ^ (((sb >> 9) & 1) << 5); R = (st >> 1) * 16 + swz / 64; C = (st & 1) * 32 + (swz % 64) / 2; }
__host__ __device__ __forceinline__ int perm32(int rho) { const int n = rho >> 4, i = rho & 15; return 8 * (i >> 2) + 4 * n + (i & 3); }

struct Unit { int pm, pn; };
struct Gemm { const bf16_t* A; const bf16_t* Bt; int M, N, K; };

__device__ __forceinline__ unsigned cvt_pk_bf16(float lo, float hi) { unsigned r; asm volatile("v_cvt_pk_bf16_f32 %0, %1, %2" : "=v"(r) : "v"(lo), "v"(hi)); return r; }
typedef float f32x2 __attribute__((ext_vector_type(2)));
template <class Epi, class Sched, bool ALIGN_EPI = false, bool SP2 = false>
__device__ __forceinline__ void gemm_phase(PG8_LAS unsigned char* lds, const Gemm g, const Sched& S, const Epi& E, int wid_in) {
    const int wid = wid_in; int lane = mk_lane(); asm volatile("" : "+v"(lane)); const int tid = wid * 64 + lane, wr = wid >> 2, wc = wid & 3, fr = lane & 15, fq = lane >> 4;
    const int K = g.K, nt = K / BK;
    unsigned voffA[2], voffB[2];
#pragma unroll
    for (int i = 0; i < 2; ++i) { int R, C; stage_rc(tid * 16 + i * 8192, R, C); const int Rb = Epi::PERM ? ((R & ~31) + perm32(R & 31)) : R;
        voffA[i] = (unsigned)(R * K + C) * 2u; voffB[i] = (unsigned)(Rb * K + C) * 2u; }
    const size_t kstep = (size_t)(BK * 2);
    const size_t hstep = (size_t)HALF * K * 2;
    const size_t tstep = 2 * hstep;
    const unsigned ldsw = (unsigned)wid * 1024u;
    const int aoff = lds_byte(wr * 64 + fr, fq * 8), boff = lds_byte(wc * 32 + fr, fq * 8);
#define PG8_SA(b, h) (((b) * 2 + (h)) * HTB)
#define PG8_SB(b, h) ((4 + (b) * 2 + (h)) * HTB)
#define PG8_STAGE(bufoff, gbase, voff) do { _Pragma("unroll") for (int _i = 0; _i < 2; ++_i) \
        __builtin_amdgcn_global_load_lds((const unsigned*)((const char*)(gbase) + (voff)[_i]), (PG8_LAS unsigned*)(lds + (bufoff) + ldsw + _i * 8192), 16, 0, 0); } while (0)
#define PG8_LDA(dst, b, h) do { _Pragma("unroll") for (int m = 0; m < 4; ++m) _Pragma("unroll") for (int k = 0; k < 2; ++k) dst[m][k] = *(const PG8_LAS bf16x8*)(lds + PG8_SA(b, h) + aoff + m * 2048 + k * 1024); } while (0)
#define PG8_LDB(dst, b, h) do { _Pragma("unroll") for (int n = 0; n < 2; ++n) _Pragma("unroll") for (int k = 0; k < 2; ++k) dst[n][k] = *(const PG8_LAS bf16x8*)(lds + PG8_SB(b, h) + boff + n * 2048 + k * 1024); } while (0)
#define PG8_MMA(ai, bj, At, Bt) do { __builtin_amdgcn_s_setprio(1); _Pragma("unroll") for (int m = 0; m < 4; ++m) _Pragma("unroll") for (int n = 0; n < 2; ++n) _Pragma("unroll") for (int k = 0; k < 2; ++k) \
        acc[ai][bj][m][n] = __builtin_amdgcn_mfma_f32_16x16x32_bf16(Bt[n][k], At[m][k], acc[ai][bj][m][n], 0, 0, 0); __builtin_amdgcn_s_setprio(0); } while (0)
#define PG8_WAIT_V(n) asm volatile("s_waitcnt vmcnt(" #n ")" ::: "memory")
#define PG8_WAIT_L(n) asm volatile("s_waitcnt lgkmcnt(" #n ")" ::: "memory")
#define PG8_BAR __builtin_amdgcn_s_barrier()
#define PG8_SCHED __builtin_amdgcn_sched_barrier(0)
    Unit cur, nxt; int ui = 0;
    if (!S.next(0, cur)) return;
    f32x4 acc[2][2][4][2];
#pragma unroll
    for (int a = 0; a < 2; ++a)
#pragma unroll
        for (int b = 0; b < 2; ++b)
#pragma unroll
            for (int m = 0; m < 4; ++m)
#pragma unroll
                for (int n = 0; n < 2; ++n) acc[a][b][m][n] = (f32x4){0.f, 0.f, 0.f, 0.f};
    bf16x8 At[4][2], B0[2][2], B1[2][2];
    const char* cA = (const char*)g.A + (size_t)cur.pm * tstep; const char* cB = (const char*)g.Bt + (size_t)cur.pn * tstep;
    S.a_ready(cur);
    if constexpr (SP2) {
        PG8_STAGE(PG8_SB(0, 0), cB, voffB); PG8_STAGE(PG8_SB(0, 1), cB + hstep, voffB); PG8_STAGE(PG8_SA(0, 0), cA, voffA); PG8_STAGE(PG8_SA(0, 1), cA + hstep, voffA);
        if (wr == 1) PG8_BAR;
        PG8_WAIT_V(2); PG8_BAR;
        PG8_STAGE(PG8_SB(1, 0), cB + kstep, voffB); PG8_STAGE(PG8_SA(1, 0), cA + kstep, voffA); PG8_STAGE(PG8_SB(1, 1), cB + hstep + kstep, voffB);
        PG8_WAIT_V(6); PG8_BAR;
    } else {
        PG8_STAGE(PG8_SB(0, 0), cB, voffB); PG8_STAGE(PG8_SA(0, 0), cA, voffA); PG8_STAGE(PG8_SB(0, 1), cB + hstep, voffB); PG8_STAGE(PG8_SA(0, 1), cA + hstep, voffA);
        if (wr == 1) PG8_BAR;
        PG8_WAIT_V(4); PG8_BAR;
        PG8_STAGE(PG8_SB(1, 0), cB + kstep, voffB); PG8_STAGE(PG8_SA(1, 0), cA + kstep, voffA); PG8_STAGE(PG8_SB(1, 1), cB + hstep + kstep, voffB);
        PG8_WAIT_V(6); PG8_BAR;
    }
    for (;;) {
        const bool has_next = S.next(ui + 1, nxt);
        const char* nA = has_next ? (const char*)g.A + (size_t)nxt.pm * tstep : cA; const char* nB = has_next ? (const char*)g.Bt + (size_t)nxt.pn * tstep : cB;
        for (int t = 0; t < nt; t += 2) {
            if constexpr (Epi::MIDK) { if (t == nt / 2) E.midk(acc, ui, wr, fr); }
            const bool last = (t == nt - 2);
            const char* a1 = cA + (size_t)(t + 1) * kstep;
            const char* a2 = last ? nA : cA + (size_t)(t + 2) * kstep; const char* b2 = last ? nB : cB + (size_t)(t + 2) * kstep;
            const char* a3 = a2 + kstep; const char* b3 = b2 + kstep;
            if (last && has_next) S.a_ready(nxt);
            if constexpr (SP2) {
            PG8_LDB(B0, 0, 0); PG8_LDB(B1, 0, 1); PG8_SCHED; PG8_LDA(At, 0, 0); PG8_STAGE(PG8_SA(1, 1), a1 + hstep, voffA);
            PG8_WAIT_V(8); PG8_WAIT_L(0); PG8_BAR; PG8_MMA(0, 0, At, B0); PG8_MMA(0, 1, At, B1); PG8_BAR; PG8_SCHED;
            PG8_LDA(At, 0, 1); PG8_STAGE(PG8_SB(0, 0), b2, voffB); PG8_STAGE(PG8_SB(0, 1), b2 + hstep, voffB); PG8_STAGE(PG8_SA(0, 0), a2, voffA);
            PG8_WAIT_V(8); PG8_WAIT_L(0); PG8_BAR; PG8_MMA(1, 0, At, B0); PG8_MMA(1, 1, At, B1); PG8_BAR; PG8_SCHED;
            PG8_LDB(B0, 1, 0); PG8_LDB(B1, 1, 1); PG8_SCHED; PG8_LDA(At, 1, 0); PG8_STAGE(PG8_SA(0, 1), a2 + hstep, voffA);
            PG8_WAIT_V(8); PG8_WAIT_L(0); PG8_BAR; PG8_MMA(0, 0, At, B0); PG8_MMA(0, 1, At, B1); PG8_BAR; PG8_SCHED;
            PG8_LDA(At, 1, 1); PG8_STAGE(PG8_SB(1, 0), b3, voffB); PG8_STAGE(PG8_SB(1, 1), b3 + hstep, voffB); PG8_STAGE(PG8_SA(1, 0), a3, voffA);
            PG8_WAIT_V(8); PG8_WAIT_L(0); PG8_BAR; PG8_MMA(1, 0, At, B0); PG8_MMA(1, 1, At, B1); PG8_BAR; PG8_SCHED;
            } else {
            PG8_LDB(B0, 0, 0); PG8_SCHED; PG8_LDA(At, 0, 0); PG8_STAGE(PG8_SA(1, 1), a1 + hstep, voffA);
            PG8_WAIT_L(8); PG8_BAR; PG8_WAIT_L(0); PG8_MMA(0, 0, At, B0); PG8_BAR; PG8_SCHED;
            PG8_LDB(B1, 0, 1); PG8_STAGE(PG8_SB(0, 0), b2, voffB);
            PG8_BAR; PG8_WAIT_L(0); PG8_MMA(0, 1, At, B1); PG8_BAR;
            PG8_LDA(At, 0, 1); PG8_STAGE(PG8_SA(0, 0), a2, voffA);
            PG8_BAR; PG8_WAIT_L(0); PG8_MMA(1, 0, At, B0); PG8_BAR; PG8_SCHED;
            PG8_STAGE(PG8_SB(0, 1), b2 + hstep, voffB);
            PG8_WAIT_V(6); PG8_BAR; PG8_MMA(1, 1, At, B1); PG8_BAR;
            PG8_LDB(B0, 1, 0); PG8_SCHED; PG8_LDA(At, 1, 0); PG8_STAGE(PG8_SA(0, 1), a2 + hstep, voffA);
            PG8_WAIT_L(8); PG8_BAR; PG8_WAIT_L(0); PG8_MMA(0, 0, At, B0); PG8_BAR; PG8_SCHED;
            PG8_LDB(B1, 1, 1); PG8_STAGE(PG8_SB(1, 0), b3, voffB);
            PG8_BAR; PG8_WAIT_L(0); PG8_MMA(0, 1, At, B1); PG8_BAR;
            PG8_LDA(At, 1, 1); PG8_STAGE(PG8_SA(1, 0), a3, voffA);
            PG8_BAR; PG8_WAIT_L(0); PG8_MMA(1, 0, At, B0); PG8_BAR; PG8_SCHED;
            PG8_STAGE(PG8_SB(1, 1), b3 + hstep, voffB);
            PG8_WAIT_V(6); PG8_BAR; PG8_MMA(1, 1, At, B1); PG8_BAR;
            }
        }
        if constexpr (ALIGN_EPI) { if (wr == 0) PG8_BAR; }
        if constexpr (!Epi::AFTER_DRAIN) { E(acc, cur, wr, wc, fr, fq); S.done(cur); }
        if (!has_next) break;
#pragma unroll
        for (int a = 0; a < 2; ++a)
#pragma unroll
            for (int b = 0; b < 2; ++b)
#pragma unroll
                for (int m = 0; m < 4; ++m)
#pragma unroll
                    for (int n = 0; n < 2; ++n) acc[a][b][m][n] = (f32x4){0.f, 0.f, 0.f, 0.f};
        cur = nxt; cA = nA; cB = nB; ++ui;
        if constexpr (ALIGN_EPI) { if (wr == 1) PG8_BAR; }
    }
    PG8_WAIT_V(0);
    if constexpr (!ALIGN_EPI) { if (wr == 0) PG8_BAR; }
    PG8_BAR;
    if constexpr (Epi::AFTER_DRAIN) { E.fused(acc, cur, wr, wc, fr, fq, lds, wid, lane); S.done(cur); }
#undef PG8_SA
#undef PG8_SB
#undef PG8_STAGE
#undef PG8_LDA
#undef PG8_LDB
#undef PG8_MMA
#undef PG8_WAIT_V
#undef PG8_WAIT_L
#undef PG8_BAR
#undef PG8_SCHED
}
struct Sched1 {
    int G, c;
    __device__ __forceinline__ void init(int G_, int c_) { G = G_; c = c_; }
    __device__ __forceinline__ bool next(int i, Unit& u) const {
        constexpr int nN = 21, nwg = 256 * nN;
        const int L = i * G + c;
        if (L < nwg) { const int wgid = (L % NXCD) * (nwg / NXCD) + L / NXCD; const int nig = WGM * nN, fm = (wgid / nig) * WGM;
            u.pm = fm + ((wgid % nig) % WGM); u.pn = (wgid % nig) / WGM; return true; }
        const int L2 = L - nwg; if (L2 >= 256) return false;
        const int wg = (L2 % NXCD) * 32 + L2 / NXCD; u.pn = wg >> 5; u.pm = 256 + (wg & 31); return true;
    }
    __device__ __forceinline__ void a_ready(const Unit&) const {}
    __device__ __forceinline__ void done(const Unit&) const {}
};
struct Sched2 {
    int G, c;
    __device__ __forceinline__ void init(int G_, int c_) { G = G_; c = c_; }
    __device__ __forceinline__ bool next(int i, Unit& u) const {
        constexpr int nN = 4, nwg = 256 * nN;
        const int L = i * G + c; if (L >= nwg) return false;
        const int wgid = (L % NXCD) * (nwg / NXCD) + L / NXCD; const int nig = WGM * nN, fm = (wgid / nig) * WGM;
        u.pm = fm + ((wgid % nig) % WGM); u.pn = (wgid % nig) / WGM; return true;
    }
    __device__ __forceinline__ void a_ready(const Unit&) const {}
    __device__ __forceinline__ void done(const Unit&) const {}
};
__device__ __forceinline__ float dot4(const f32x4 a) { return (a[0] * a[0] + a[1] * a[1]) + (a[2] * a[2] + a[3] * a[3]); }
__device__ __forceinline__ float silu1(float v) { return v * __builtin_amdgcn_rcpf(1.f + __expf(-v)); }
typedef unsigned u32x2 __attribute__((ext_vector_type(2)));
__device__ __forceinline__ u32x2 pk4(const f32x4 v) { u32x2 w; w.x = cvt_pk_bf16(v[0], v[1]); w.y = cvt_pk_bf16(v[2], v[3]); return w; }
struct Epi1 {
    static constexpr bool PERM = true, AFTER_DRAIN = false, MIDK = false;
    bf16_t *KB, *VB, *XBC, *YQ, *Z; float* DT; const float *rope, *qg, *kg, *dt_bias;
    __device__ __forceinline__ void midk(f32x4 (&)[2][2][4][2], int, int, int) const {}
    __device__ __forceinline__ void operator()(const f32x4 (&acc)[2][2][4][2], const Unit& u, int wr, int wc, int fr_in, int fq_in) const {
        int fr = fr_in, fq = fq_in; asm volatile("" : "+v"(fr), "+v"(fq));
        const int pn = u.pn, pm = u.pm; const bool isctx = pm >= 256; const int rloc = wr * 64 + fr;
        const int bb = isctx ? pm - 256 : pm >> 3, pos0 = isctx ? SEQ : (pm & 7) * 256;
        if (pn == 0 || (pn >= 9 && pn < 13)) {
            const float* g = pn == 0 ? kg : qg;
            const f32x4 g00 = *(const f32x4*)(g + 4 * fq), g01 = *(const f32x4*)(g + 16 + 4 * fq), g10 = *(const f32x4*)(g + 32 + 4 * fq), g11 = *(const f32x4*)(g + 48 + 4 * fq);
            const float osc = pn == 0 ? 1.f : C2;
            bf16_t* dbase; size_t pitch;
            if (pn == 0) { dbase = KB + ((size_t)bb * KVL + pos0) * 256 + wc * 64 + 4 * fq; pitch = 256; }
            else { dbase = YQ + (size_t)pm * 256 * 2048 + 1024 + ((pn - 9) * 4 + wc) * 64 + 4 * fq; pitch = 2048; }
#pragma unroll
            for (int ai = 0; ai < 2; ++ai) {
                const int prow = (pm & 7) * 4 + 2 * ai + wr;
                f32x4 c0 = (f32x4){1.f, 1.f, 1.f, 1.f}, s0 = (f32x4){0.f, 0.f, 0.f, 0.f};
                if (!isctx) { c0 = *(const f32x4*)(rope + prow * 16 + 4 * fq); s0 = *(const f32x4*)(rope + 1024 + prow * 16 + 4 * fq); }
#pragma unroll
                for (int m = 0; m < 4; ++m) {
                    f32x4 a0 = acc[ai][0][m][0], a1 = acc[ai][0][m][1], b0 = acc[ai][1][m][0], b1 = acc[ai][1][m][1];
                    float s = (dot4(a0) + dot4(a1)) + (dot4(b0) + dot4(b1));
                    s += __shfl_xor(s, 16); s += __shfl_xor(s, 32);
                    const float rstd = rsqrtf(s * (1.f / 64.f) + EPS) * osc;
                    a0 = a0 * rstd * g00; a1 = a1 * rstd * g01; b0 = b0 * rstd * g10; b1 = b1 * rstd * g11;
                    f32x4 c1 = (f32x4){1.f, 1.f, 1.f, 1.f}, s1 = (f32x4){0.f, 0.f, 0.f, 0.f};
                    if (!isctx) { const int pcol = 16 * m + fr; c1 = *(const f32x4*)(rope + pcol * 16 + 4 * fq); s1 = *(const f32x4*)(rope + 1024 + pcol * 16 + 4 * fq); }
                    const f32x4 o00 = a0 * c0 - a1 * s0, o01 = a1 * c0 + a0 * s0, o10 = b0 * c1 - b1 * s1, o11 = b1 * c1 + b0 * s1;
                    bf16_t* dst = dbase + (size_t)(rloc + 128 * ai + 16 * m) * pitch;
                    *(u32x2*)(dst) = pk4(o00); *(u32x2*)(dst + 16) = pk4(o01); *(u32x2*)(dst + 32) = pk4(o10); *(u32x2*)(dst + 48) = pk4(o11);
                    asm volatile("" ::: "memory");
                }
            }
        } else if (pn == 8) {
            if (wc == 0) {
                const f32x4 bA = *(const f32x4*)(dt_bias + 8 * fq), bB = *(const f32x4*)(dt_bias + 8 * fq + 4);
#pragma unroll
                for (int ai = 0; ai < 2; ++ai)
#pragma unroll
                    for (int m = 0; m < 4; ++m) { const size_t row = (size_t)pm * 256 + rloc + 128 * ai + 16 * m;
                        f32x4 v0 = acc[ai][0][m][0] + bA, v1 = acc[ai][0][m][1] + bB;
#pragma unroll
                        for (int e = 0; e < 4; ++e) { v0[e] = v0[e] > 20.f ? v0[e] : log1pf(__expf(v0[e])); v1[e] = v1[e] > 20.f ? v1[e] : log1pf(__expf(v1[e])); }
                        *(f32x4*)(DT + row * 32 + 8 * fq) = v0; *(f32x4*)(DT + row * 32 + 8 * fq + 4) = v1; asm volatile("" ::: "memory"); }
            }
        } else {
            bf16_t* dbase; size_t pitch; bool act = false;
            const int cin = wc * 32 + 8 * fq;
            if (pn == 1) { dbase = VB + ((size_t)bb * KVL + pos0) * 256 + cin; pitch = 256; }
            else if (pn < 8) { dbase = XBC + (size_t)pm * 256 * CONVC + (pn - 2) * 256 + cin; pitch = CONVC; }
            else if (pn < 17) { dbase = YQ + (size_t)pm * 256 * 2048 + (pn - 13) * 256 + cin; pitch = 2048; act = true; }
            else { dbase = Z + (size_t)pm * 256 * 1024 + (pn - 17) * 256 + cin; pitch = 1024; act = true; }
#pragma unroll
            for (int ai = 0; ai < 2; ++ai)
#pragma unroll
                for (int m = 0; m < 4; ++m) { bf16_t* dst = dbase + (size_t)(rloc + 128 * ai + 16 * m) * pitch;
#pragma unroll
                    for (int bj = 0; bj < 2; ++bj) { f32x4 v0 = acc[ai][bj][m][0], v1 = acc[ai][bj][m][1];
                        if (act) {
#pragma unroll
                            for (int e = 0; e < 4; ++e) { v0[e] = silu1(v0[e]); v1[e] = silu1(v1[e]); } }
                        u32x4 w; w.x = cvt_pk_bf16(v0[0], v0[1]); w.y = cvt_pk_bf16(v0[2], v0[3]); w.z = cvt_pk_bf16(v1[0], v1[1]); w.w = cvt_pk_bf16(v1[2], v1[3]);
                        *(u32x4*)(dst + bj * HALF) = w; } asm volatile("" ::: "memory"); }
        }
    }
};
struct Epi2 {
    static constexpr bool PERM = false, AFTER_DRAIN = false, MIDK = true;
    const float* x; const float* mod; const float* fg; float* out; unsigned long long* xbuf; unsigned* cnt; unsigned* tmo; const PG8_LAS float* rstd_tab; PG8_LAS float* exl;
    __device__ __forceinline__ void midk(f32x4 (&acc)[2][2][4][2], int ui, int wr, int fr) const {
#pragma unroll
        for (int ai = 0; ai < 2; ++ai)
#pragma unroll
            for (int m = 0; m < 4; ++m) { const float r = rstd_tab[ui * 256 + 128 * ai + 64 * wr + 16 * m + fr];
#pragma unroll
                for (int bj = 0; bj < 2; ++bj)
#pragma unroll
                    for (int n = 0; n < 2; ++n) acc[ai][bj][m][n] *= r; }
    }
    __device__ __forceinline__ void operator()(f32x4 (&acc)[2][2][4][2], const Unit& u, int wr, int wc, int fr_in, int fq_in) const {
        int fr = fr_in, fq = fq_in; asm volatile("" : "+v"(fr), "+v"(fq));
        const int lane = mk_lane(); const int tid = (wr * 4 + wc) * 64 + lane;
        const int b = u.pm >> 3, col0 = u.pn * BM + wc * 32 + 4 * fq;
        PG8_LAS float* P = exl; PG8_LAS float* S = exl + 1024;
        { f32x4 gv[2][2];
#pragma unroll
          for (int bj = 0; bj < 2; ++bj)
#pragma unroll
            for (int n = 0; n < 2; ++n) gv[bj][n] = *(const f32x4*)(mod + (size_t)b * 3072 + 2048 + col0 + bj * HALF + n * 16);
#pragma unroll
          for (int ai = 0; ai < 2; ++ai)
#pragma unroll
            for (int m = 0; m < 4; ++m) { const int rt = 128 * ai + 64 * wr + 16 * m + fr; const size_t off = ((size_t)u.pm * BM + rt) * 1024 + col0; float q = 0.f;
#pragma unroll
                for (int bj = 0; bj < 2; ++bj)
#pragma unroll
                    for (int n = 0; n < 2; ++n) { const f32x4 xv = *(const f32x4*)(x + off + bj * HALF + n * 16); const f32x4 o = xv + gv[bj][n] * acc[ai][bj][m][n]; acc[ai][bj][m][n] = o; q += dot4(o); }
                q += __shfl_xor(q, 16); q += __shfl_xor(q, 32);
                if (fq == 0) P[rt * 4 + wc] = q;
                if (m == 3) asm volatile("" ::: "memory"); } }
        asm volatile("s_waitcnt lgkmcnt(0)" ::: "memory"); __builtin_amdgcn_s_barrier(); asm volatile("" ::: "memory");
        if (tid < 256) {
            const f32x4 p = *(const PG8_LAS f32x4*)(P + tid * 4); const float s = (p[0] + p[1]) + (p[2] + p[3]);
            __hip_atomic_store((float*)xbuf + ((size_t)u.pm * BM + tid) * 4 + u.pn, s, __ATOMIC_RELAXED, __HIP_MEMORY_SCOPE_AGENT);
        }
        asm volatile("s_waitcnt vmcnt(0)" ::: "memory");
        if (tid < 256 && lane == 0) __hip_atomic_fetch_add(cnt + 64 * u.pm, 1u, __ATOMIC_RELAXED, __HIP_MEMORY_SCOPE_AGENT);
        if (tid < 64) {
            unsigned sp = 0;
            while ((unsigned)__builtin_amdgcn_readfirstlane(__hip_atomic_load(cnt + 64 * u.pm, __ATOMIC_RELAXED, __HIP_MEMORY_SCOPE_AGENT)) < 16u) {
                __builtin_amdgcn_s_sleep(2); if (++sp > (1u << 22)) { if (lane == 0) __hip_atomic_store(tmo, 1u, __ATOMIC_RELAXED, __HIP_MEMORY_SCOPE_AGENT); break; } }
        }
        asm volatile("s_waitcnt vmcnt(0) lgkmcnt(0)" ::: "memory"); __builtin_amdgcn_s_barrier(); asm volatile("" ::: "memory");
        if (tid < 256) {
            const unsigned long long* sl = xbuf + ((size_t)u.pm * BM + tid) * 2;
            const unsigned long long w0 = __hip_atomic_load(sl, __ATOMIC_RELAXED, __HIP_MEMORY_SCOPE_AGENT), w1 = __hip_atomic_load(sl + 1, __ATOMIC_RELAXED, __HIP_MEMORY_SCOPE_AGENT);
            const float s = (__uint_as_float((unsigned)w0) + __uint_as_float((unsigned)(w0 >> 32))) + (__uint_as_float((unsigned)w1) + __uint_as_float((unsigned)(w1 >> 32)));
            S[tid] = rsqrtf(s * (1.f / 1024.f) + EPS);
        }
        asm volatile("s_waitcnt lgkmcnt(0)" ::: "memory"); __builtin_amdgcn_s_barrier(); asm volatile("" ::: "memory");
        { f32x4 fv[2][2];
#pragma unroll
          for (int bj = 0; bj < 2; ++bj)
#pragma unroll
            for (int n = 0; n < 2; ++n) fv[bj][n] = *(const f32x4*)(fg + col0 + bj * HALF + n * 16);
#pragma unroll
          for (int ai = 0; ai < 2; ++ai)
#pragma unroll
            for (int m = 0; m < 4; ++m) { const int rt = 128 * ai + 64 * wr + 16 * m + fr; const size_t off = ((size_t)u.pm * BM + rt) * 1024 + col0; const float r = S[rt];
#pragma unroll
                for (int bj = 0; bj < 2; ++bj)
#pragma unroll
                    for (int n = 0; n < 2; ++n) *(f32x4*)(out + off + bj * HALF + n * 16) = acc[ai][bj][m][n] * r * fv[bj][n];
                if (m & 1) asm volatile("" ::: "memory"); } }
    }
};
}
#define GAS __attribute__((address_space(1)))
#define LAS __attribute__((address_space(3)))
typedef unsigned v4u __attribute__((ext_vector_type(4)));
typedef GAS unsigned gu32;
typedef GAS unsigned long long gu64;
#define RLX_AGENT __ATOMIC_RELAXED, __HIP_MEMORY_SCOPE_AGENT
#define LDS_WAIT() asm volatile("s_waitcnt lgkmcnt(0)" ::: "memory")
#define VM_WAIT() asm volatile("s_waitcnt vmcnt(0)" ::: "memory")
__device__ __forceinline__ unsigned long long rt() { return __builtin_amdgcn_s_memrealtime(); }
typedef float f32x2_pk __attribute__((ext_vector_type(2))); typedef __bf16 bf16x2_pk __attribute__((ext_vector_type(2)));
__device__ __forceinline__ unsigned pk2(float lo, float hi) { const f32x2_pk v = {lo, hi}; return __builtin_bit_cast(unsigned, __builtin_convertvector(v, bf16x2_pk)); }
#define XB_TMO      128
#define XB_XCNT(j)  (256  + 64 * (j))
#define XB_XSUB(j)  (1280 + 64 * (j))
#define XB_XGEN(j)  (2304 + 64 * (j))
#define XB_TOP      3328
#define XB_TOPGEN   3392
#define XCD_BAR_WORDS 3456
#define XB_SPIN_CAP (1u << 22)

__device__ __forceinline__ unsigned xb_ld(unsigned* p)              { return __hip_atomic_load(p, __ATOMIC_RELAXED, __HIP_MEMORY_SCOPE_AGENT); }
__device__ __forceinline__ unsigned xb_add(unsigned* p, unsigned v) { return __hip_atomic_fetch_add(p, v, __ATOMIC_RELAXED, __HIP_MEMORY_SCOPE_AGENT); }
__device__ __forceinline__ unsigned xb_xcc_id() { return (unsigned)__builtin_amdgcn_s_getreg((3 << 11) | 20) & 0xFu; }
#define XB_SPIN(cond, bar) do { unsigned _sp = 0; while (cond) { __builtin_amdgcn_s_sleep(1); \
    if ((++_sp & 255u) == 0u) { if (xb_ld(&(bar)[XB_TMO])) break; if (_sp > XB_SPIN_CAP) { atomicAdd(&(bar)[XB_TMO], 1u); break; } } } } while (0)

struct XcdBarrier {
    unsigned* bar; unsigned x;
    volatile LAS unsigned* st;
};

__device__ __forceinline__ XcdBarrier xcd_barrier_post(unsigned* bar, volatile LAS unsigned* st, bool leader) {
    XcdBarrier b; b.bar = bar; b.x = xb_xcc_id(); b.st = st;
    if (leader) (void)xb_add(&bar[XB_XCNT(b.x)], 1u);
    return b;
}
__device__ __forceinline__ void xcd_barrier_complete(unsigned* bar, unsigned x, unsigned& nloc, unsigned& nx) {
    const unsigned G = gridDim.x * gridDim.y * gridDim.z;
    unsigned sum, cnt, mine, sp = 0u;
    for (;;) {
        sum = 0u; cnt = 0u; mine = 0u;
#pragma unroll
        for (unsigned j = 0; j < 16; ++j) { const unsigned c = xb_ld(&bar[XB_XCNT(j)]); sum += c; cnt += (c > 0u) ? 1u : 0u; mine = (j == x) ? c : mine; }
        if (sum == G) break;
        __builtin_amdgcn_s_sleep(1);
        if ((++sp & 255u) == 0u) { if (xb_ld(&bar[XB_TMO])) break; if (sp > XB_SPIN_CAP) { atomicAdd(&bar[XB_TMO], 1u); break; } }
    }
    nloc = mine > 0u ? mine : 1u; nx = cnt > 0u ? cnt : 1u;
}

__device__ __forceinline__ void xcd_barrier(const XcdBarrier& b, bool leader) {
    asm volatile("s_waitcnt vmcnt(0)" ::: "memory");
    __syncthreads();
    if (leader) {
        unsigned* bar = b.bar;
        __builtin_amdgcn_s_waitcnt(0);
        unsigned nloc = b.st[0], nx = b.st[1];
        if (nloc == 0u) { xcd_barrier_complete(bar, b.x, nloc, nx); b.st[0] = nloc; b.st[1] = nx; }
        const unsigned old = xb_add(&bar[XB_XSUB(b.x)], 1u);
        const unsigned gen = old / nloc;
        if (old + 1u == (gen + 1u) * nloc) {
            __builtin_amdgcn_fence(__ATOMIC_RELEASE, "agent");
            asm volatile("s_waitcnt vmcnt(0)" ::: "memory");
            const unsigned og = xb_add(&bar[XB_TOP], 1u);
            const unsigned tg = og / nx;
            if (og + 1u == (tg + 1u) * nx) xb_add(&bar[XB_TOPGEN], 1u);
            else XB_SPIN(xb_ld(&bar[XB_TOPGEN]) == tg, bar);
            __builtin_amdgcn_fence(__ATOMIC_ACQUIRE, "agent");
            xb_add(&bar[XB_XGEN(b.x)], 1u);
            asm volatile("s_waitcnt vmcnt(0)" ::: "memory");
        } else {
            XB_SPIN(xb_ld(&bar[XB_XGEN(b.x)]) == gen, bar);
            __builtin_amdgcn_fence(__ATOMIC_ACQUIRE, "agent");
            asm volatile("s_waitcnt vmcnt(0)" ::: "memory");
        }
    }
    __syncthreads();
}

typedef float f32x4 __attribute__((ext_vector_type(4)));
constexpr int NWAVES = 8;
__device__ __forceinline__ float wave_sum(float v) {
#pragma unroll
    for (int o = 1; o < 64; o <<= 1) v += __shfl_xor(v, o);
    return v;
}
__device__ __forceinline__ float dot4g(const f32x4 a) { return (a[0] * a[0] + a[1] * a[1]) + (a[2] * a[2] + a[3] * a[3]); }
__device__ __forceinline__ void p0_bt1_item(const float* W, bf16* WT, LAS float* scr, int item, int lane) {
    const int kb = item / 168, vb = item % 168, k0 = 64 * kb, v0 = 32 * vb;
    const int a = vcol_actual(v0 + (lane & 31));
#pragma unroll 8
    for (int i = 0; i < 32; ++i) { const int kk = 2 * i + (lane >> 5); scr[kk * 33 + (lane & 31)] = a >= 0 ? W[(size_t)(k0 + kk) * PROJ + a] : 0.f; }
    LDS_WAIT(); asm volatile("" ::: "memory");
    const int c = lane & 7;
#pragma unroll
    for (int j = 0; j < 4; ++j) { const int n = (lane >> 3) + 8 * j; const LAS float* s = scr + (8 * c) * 33 + n;
        v4u o; o.x = pk2(s[0 * 33], s[1 * 33]); o.y = pk2(s[2 * 33], s[3 * 33]); o.z = pk2(s[4 * 33], s[5 * 33]); o.w = pk2(s[6 * 33], s[7 * 33]);
        *(GAS v4u*)(WT + (size_t)(v0 + n) * 1024 + k0 + 8 * c) = o; }
    LDS_WAIT(); asm volatile("" ::: "memory");
}
__device__ __forceinline__ void p0_bt2_item(const float* W, const float* sg, bf16* WT, LAS float* scr, int item, int lane) {
    const int kb = item >> 5, nb = item & 31, kk0 = 64 * kb, n0 = 32 * nb;
#pragma unroll 8
    for (int i = 0; i < 32; ++i) { const int kk = 2 * i + (lane >> 5), kq = kk0 + kk; const int ks = kq < 1024 ? 1024 + kq : kq - 1024;
        float v = W[(size_t)ks * 1024 + n0 + (lane & 31)]; if (kq < 1024) v *= sg[kq]; scr[kk * 33 + (lane & 31)] = v; }
    LDS_WAIT(); asm volatile("" ::: "memory");
    const int c = lane & 7;
#pragma unroll
    for (int j = 0; j < 4; ++j) { const int n = (lane >> 3) + 8 * j; const LAS float* s = scr + (8 * c) * 33 + n;
        v4u o; o.x = pk2(s[0 * 33], s[1 * 33]); o.y = pk2(s[2 * 33], s[3 * 33]); o.z = pk2(s[4 * 33], s[5 * 33]); o.w = pk2(s[6 * 33], s[7 * 33]);
        *(GAS v4u*)(WT + (size_t)(n0 + n) * 2048 + kk0 + 8 * c) = o; }
    LDS_WAIT(); asm volatile("" ::: "memory");
}
__device__ __forceinline__ void p0_mod_block(const float* c, const float* c_ctx, const float* ada_w, const float* ada_b, float* mod, LAS float* ldsf, int cb, int tid, int lane, int wave) {
    LAS float* sil = ldsf; LAS float* red = ldsf + 33 * 256;
    float acc[33];
#pragma unroll
    for (int b = 0; b < 33; ++b) acc[b] = 0.f;
    for (int q = 0; q < 4; ++q) {
        __syncthreads();
        for (int e = tid; e < 33 * 256; e += NWAVES * 64) { const int b = e >> 8, k = e & 255; const float v = b < 32 ? c[b * 1024 + q * 256 + k] : c_ctx[q * 256 + k]; sil[e] = siluf(v); }
        __syncthreads();
#pragma unroll 8
        for (int kk = 0; kk < 32; ++kk) { const int kl = wave * 32 + kk; const float w = ada_w[(size_t)(q * 256 + kl) * 3072 + cb * 64 + lane];
#pragma unroll
            for (int b = 0; b < 33; ++b) acc[b] += sil[b * 256 + kl] * w; }
    }
#pragma unroll
    for (int b = 0; b < 33; ++b) red[(wave * 33 + b) * 64 + lane] = acc[b];
    __syncthreads();
    for (int e = tid; e < 33 * 64; e += NWAVES * 64) { const int b = e >> 6, col = e & 63; float s = 0.f;
#pragma unroll
        for (int w = 0; w < 8; ++w) s += red[(w * 33 + b) * 64 + col];
        mod[b * 3072 + cb * 64 + col] = s + ada_b[cb * 64 + col]; }
    __syncthreads();
}
__device__ __forceinline__ const float* p1_src(const float* x, const float* ctx, int m) { return m < ML ? x + (size_t)m * DM : ctx + (size_t)(m - ML) * DM; }
__device__ __forceinline__ void p1_load4(f32x4 (&v)[4][4], const float* x, const float* ctx, int m0, int lane) {
#pragma unroll
    for (int r = 0; r < 4; ++r) { const GAS f32x4* xr = (const GAS f32x4*)p1_src(x, ctx, m0 + r) + lane;
#pragma unroll
        for (int j = 0; j < 4; ++j) v[r][j] = xr[64 * j]; }
}
__device__ __forceinline__ void p1_proc4(const f32x4 (&v)[4][4], const float* mod, const float* ng, bf16* H, int m0, int lane) {
#pragma unroll
    for (int r = 0; r < 4; ++r) { const int m = m0 + r; const float* md = mod + (size_t)(m < ML ? m / SEQ : 32) * 3072;
        float s = 0.f;
#pragma unroll
        for (int j = 0; j < 4; ++j) s += dot4g(v[r][j]);
        const float rstd = rsqrtf(wave_sum(s) * (1.f / DM) + EPS);
        GAS unsigned long long* o8 = (GAS unsigned long long*)(H + (size_t)m * DM) + lane;
#pragma unroll
        for (int j = 0; j < 4; ++j) { const int k = 4 * lane + 256 * j;
            const f32x4 g = *(const f32x4*)(ng + k), sc = *(const f32x4*)(md + 1024 + k), sh = *(const f32x4*)(md + k);
            const f32x4 h = v[r][j] * rstd * g * (sc + 1.f) + sh;
            o8[64 * j] = (unsigned long long)pk2(h[0], h[1]) | ((unsigned long long)pk2(h[2], h[3]) << 32); }
    }
}
__device__ __forceinline__ void conv_phase(const bf16* XBC, const float* cw, const float* cb, bf16* XC, int bx, int G, int tid) {
    if (tid < 384) {
        const int cg = tid % 192, sub = tid / 192;
        f32x4 w[5][2], bias[2];
#pragma unroll
        for (int j = 0; j < 5; ++j) { w[j][0] = *(const f32x4*)(cw + j * CONVC + cg * 8); w[j][1] = *(const f32x4*)(cw + j * CONVC + cg * 8 + 4); }
        bias[0] = *(const f32x4*)(cb + cg * 8); bias[1] = *(const f32x4*)(cb + cg * 8 + 4);
        for (int seg = bx; seg < MT / 32; seg += G) {
            const int row0 = seg * 32 + sub * 16; int t0, len;
            if (row0 < ML) { t0 = row0 % SEQ; len = SEQ; } else { t0 = (row0 - ML) % CTXL; len = CTXL; }
            const bf16* src = XBC + (size_t)row0 * CONVC + cg * 8; bf16* dst = XC + (size_t)row0 * CONVC + cg * 8;
            f32x4 r[5][2];
#pragma unroll
            for (int j = 0; j < 5; ++j) { const int tt = t0 + j - 2; v4u u = (v4u){0u, 0u, 0u, 0u};
                if (tt >= 0 && tt < len) u = *(const v4u*)(src + (ptrdiff_t)(j - 2) * CONVC);
                r[j][0] = (f32x4){__uint_as_float(u.x << 16), __uint_as_float(u.x & 0xffff0000u), __uint_as_float(u.y << 16), __uint_as_float(u.y & 0xffff0000u)};
                r[j][1] = (f32x4){__uint_as_float(u.z << 16), __uint_as_float(u.z & 0xffff0000u), __uint_as_float(u.w << 16), __uint_as_float(u.w & 0xffff0000u)}; }
#pragma unroll
            for (int i = 0; i < 16; ++i) {
                f32x4 a0 = bias[0], a1 = bias[1];
#pragma unroll
                for (int j = 0; j < 5; ++j) { a0 += w[j][0] * r[j][0]; a1 += w[j][1] * r[j][1]; }
#pragma unroll
                for (int e = 0; e < 4; ++e) { a0[e] = siluf(a0[e]); a1[e] = siluf(a1[e]); }
                v4u o; o.x = pk2(a0[0], a0[1]); o.y = pk2(a0[2], a0[3]); o.z = pk2(a1[0], a1[1]); o.w = pk2(a1[2], a1[3]);
                *(v4u*)(dst + (size_t)i * CONVC) = o;
#pragma unroll
                for (int j = 0; j < 4; ++j) { r[j][0] = r[j + 1][0]; r[j][1] = r[j + 1][1]; }
                const int tt = t0 + i + 3; v4u u = (v4u){0u, 0u, 0u, 0u};
                if (i < 15 && tt < len) u = *(const v4u*)(src + (size_t)(i + 3) * CONVC);
                r[4][0] = (f32x4){__uint_as_float(u.x << 16), __uint_as_float(u.x & 0xffff0000u), __uint_as_float(u.y << 16), __uint_as_float(u.y & 0xffff0000u)};
                r[4][1] = (f32x4){__uint_as_float(u.z << 16), __uint_as_float(u.z & 0xffff0000u), __uint_as_float(u.w << 16), __uint_as_float(u.w & 0xffff0000u)};
            }
        }
    }
}
__device__ __forceinline__ void ssd_item_naive(int b, int h, const bf16* XC, const float* DT, const bf16* Z, const float* a_log, const float* d_skip, bf16* YQ, float* SSQ, LAS float* ysq, int tid) {
    const int p = tid >> 3, nc = tid & 7, g = h >> 3;
    for (int dd = 0; dd < 2; ++dd) { const int d = 1 - dd;
        const float a_neg = -expf(a_log[d * 16 + h]);
        float S[16];
#pragma unroll
        for (int j = 0; j < 16; ++j) S[j] = 0.f;
        for (int seq = 0; seq < 2; ++seq) { const int len = seq == 0 ? CTXL : SEQ; const size_t rbase = seq == 0 ? (size_t)ML + (size_t)b * CTXL : (size_t)b * SEQ;
            for (int st = 0; st < len; ++st) { const int t = d ? len - 1 - st : st; const size_t row = rbase + t;
                const float dt = DT[row * 32 + d * 16 + h]; const float dec = expf(dt * a_neg);
                const float xs = bf2f(XC[row * CONVC + h * 64 + p]); const float X = xs * dt;
                const v4u b0 = *(const v4u*)(XC + row * CONVC + 1024 + g * 128 + nc * 16), b1 = *(const v4u*)(XC + row * CONVC + 1024 + g * 128 + nc * 16 + 8);
                const v4u c0 = *(const v4u*)(XC + row * CONVC + 1280 + g * 128 + nc * 16), c1 = *(const v4u*)(XC + row * CONVC + 1280 + g * 128 + nc * 16 + 8);
                const unsigned bw[8] = {b0.x, b0.y, b0.z, b0.w, b1.x, b1.y, b1.z, b1.w}, cw8[8] = {c0.x, c0.y, c0.z, c0.w, c1.x, c1.y, c1.z, c1.w};
                float y = 0.f;
#pragma unroll
                for (int j = 0; j < 8; ++j) { S[2 * j] = S[2 * j] * dec + X * __uint_as_float(bw[j] << 16); y += __uint_as_float(cw8[j] << 16) * S[2 * j];
                    S[2 * j + 1] = S[2 * j + 1] * dec + X * __uint_as_float(bw[j] & 0xffff0000u); y += __uint_as_float(cw8[j] & 0xffff0000u) * S[2 * j + 1]; }
                y += __shfl_xor(y, 1); y += __shfl_xor(y, 2); y += __shfl_xor(y, 4);
                if (seq == 1) {
                    bf16* yp = YQ + row * 2048 + h * 64 + p;
                    if (d == 1) { if (nc == 0) *yp = (bf16)f2bf(y); }
                    else {
                        if (nc == 0) { const float yt = y + bf2f(*yp) + d_skip[h] * xs; const float yg = yt * bf2f(Z[row * 1024 + h * 64 + p]); *yp = (bf16)f2bf(yg); ysq[p] = yg * yg; }
                        __syncthreads();
                        if (tid < 64) { float q = ysq[tid]; q = wave_sum(q); if (tid == 0) SSQ[row * 16 + h] = q; }
                        __syncthreads();
                    }
                }
            }
        }
        VM_WAIT(); __syncthreads();
    }
}

namespace attn_body {
using bf16=__hip_bfloat16;
using bf16x8=__attribute__((ext_vector_type(8)))short;
using s16x4=__attribute__((ext_vector_type(4)))short;
using f32x16=__attribute__((ext_vector_type(16)))float;
using u32x4=__attribute__((ext_vector_type(4)))unsigned;
constexpr int D=64,QP=2048,KP=256;
constexpr int NW=8,QBLK=32,QB=QBLK*NW,KVBLK=64,NQB=SEQ/QB;
constexpr int ATTN_UNIT_ROWS=QB;
__device__ __forceinline__ int crow(int r,int hi){return (r&3)+8*(r>>2)+4*hi;}
#define SBAR() __builtin_amdgcn_sched_barrier(0)
__device__ __forceinline__ void cmask(f32x16&p0,f32x16&p1,int jb,int qrel,int hi){
  const float NEG=-INFINITY; int kb=64*jb+4*hi;
  #pragma unroll
  for(int r=0;r<16;++r){int kv=kb+(r&3)+8*(r>>2); if(kv>qrel)p0[r]=NEG; if(kv+32>qrel)p1[r]=NEG;}
}

constexpr int NSLOT=3, SLOTB=8192;
constexpr int LDS_K=0, LDS_V=NSLOT*SLOTB, LDS_WS=2*NSLOT*SLOTB, LDS_OST=LDS_WS+NW*64*4, LDS_BYTES=LDS_OST+NW*8192;
constexpr float C2=0.125f*1.4426950408889634f;
__device__ __forceinline__ void glds16(const void*gsrc,unsigned lds_dst){unsigned keep;
  asm volatile("s_mov_b32 %0, m0\n\ts_mov_b32 m0, %2\n\ts_nop 0\n\tglobal_load_lds_dwordx4 %1, off\n\ts_mov_b32 m0, %0":"=&s"(keep):"v"(gsrc),"s"(lds_dst):"memory");}
__device__ __forceinline__ float max3f(float a,float b,float c){float r;asm("v_max3_f32 %0, %1, %2, %3":"=v"(r):"v"(a),"v"(b),"v"(c));return r;}
__device__ __forceinline__ float max2f(float a,float b){float r;asm("v_max_f32_e32 %0, %1, %2":"=v"(r):"v"(a),"v"(b));return r;}
__device__ __forceinline__ float fadd_s(float a,float b){float r;asm("v_add_f32_e32 %0, %1, %2":"=v"(r):"v"(a),"v"(b));return r;}
__device__ __forceinline__ float fsub_s(float a,float b){float r;asm("v_sub_f32_e32 %0, %1, %2":"=v"(r):"v"(a),"v"(b));return r;}
typedef float f32x2_t __attribute__((ext_vector_type(2))); typedef float f32x4_t __attribute__((ext_vector_type(4))); typedef __bf16 bf16x2_t __attribute__((ext_vector_type(2)));
__device__ __forceinline__ unsigned cvtpk_s(float lo,float hi){f32x2_t v={lo,hi};bf16x2_t b=__builtin_convertvector(v,bf16x2_t);return __builtin_bit_cast(unsigned,b);}
#define WAIT_BAR(N) asm volatile("s_waitcnt vmcnt(" #N ") lgkmcnt(0)\n\ts_barrier":::"memory")

__device__ __forceinline__ void qkt(f32x16&p0,f32x16&p1,const char*Kslot,const bf16x8*qr,const f32x16&negm,int r32,int hi){
  const char*kb=Kslot+hi*1024+r32*16;
  #pragma unroll
  for(int d0=0;d0<4;++d0){
    const bf16x8 b0=*reinterpret_cast<const bf16x8*>(kb+d0*2048);
    const bf16x8 b1=*reinterpret_cast<const bf16x8*>(kb+d0*2048+512);
    if(d0==0){p0=__builtin_amdgcn_mfma_f32_32x32x16_bf16(b0,qr[0],negm,0,0,0);p1=__builtin_amdgcn_mfma_f32_32x32x16_bf16(b1,qr[0],negm,0,0,0);}
    else{p0=__builtin_amdgcn_mfma_f32_32x32x16_bf16(b0,qr[d0],p0,0,0,0);p1=__builtin_amdgcn_mfma_f32_32x32x16_bf16(b1,qr[d0],p1,0,0,0);}}
}
typedef __attribute__((address_space(3))) const char* lds_cptr;
typedef short v4i16_t __attribute__((ext_vector_type(4)));
__device__ __forceinline__ void kload8(bf16x8*kf,lds_cptr kp){
  kf[0]=*(const __attribute__((address_space(3))) bf16x8*)(kp);      kf[1]=*(const __attribute__((address_space(3))) bf16x8*)(kp+512);
  kf[2]=*(const __attribute__((address_space(3))) bf16x8*)(kp+2048); kf[3]=*(const __attribute__((address_space(3))) bf16x8*)(kp+2560);
  kf[4]=*(const __attribute__((address_space(3))) bf16x8*)(kp+4096); kf[5]=*(const __attribute__((address_space(3))) bf16x8*)(kp+4608);
  kf[6]=*(const __attribute__((address_space(3))) bf16x8*)(kp+6144); kf[7]=*(const __attribute__((address_space(3))) bf16x8*)(kp+6656);
}
__device__ __forceinline__ void kload2(bf16x8*kf,lds_cptr kp,int j){ kf[2*j]=*(const __attribute__((address_space(3))) bf16x8*)(kp+j*2048); kf[2*j+1]=*(const __attribute__((address_space(3))) bf16x8*)(kp+j*2048+512); }
__device__ __forceinline__ s16x4 vtr(lds_cptr p){ return __builtin_bit_cast(s16x4,__builtin_amdgcn_ds_read_tr16_b64_v4i16((__attribute__((address_space(3))) v4i16_t*)p)); }
__device__ __forceinline__ float rowmax(const f32x16&p0,const f32x16&p1){
  float a=max3f(p0[0],p0[1],p1[0]),b=max3f(p0[2],p0[3],p1[1]);a=max3f(a,p1[2],p1[3]);
  #pragma unroll
  for(int r=4;r<16;r+=4){a=max3f(a,p0[r],p0[r+1]);b=max3f(b,p0[r+2],p0[r+3]);a=max3f(a,p1[r],p1[r+1]);b=max3f(b,p1[r+2],p1[r+3]);}
  const float m=max2f(a,b);
  auto rr=__builtin_amdgcn_permlane32_swap(__float_as_uint(m),__float_as_uint(m),false,false);
  return max2f(__uint_as_float(rr[0]),__uint_as_float(rr[1]));
}
__device__ __forceinline__ void pv(f32x16*o,int vb,bf16x8 pa0,bf16x8 pa1,bf16x8 pa2,bf16x8 pa3){
  #pragma unroll
  for(int d0=0;d0<2;++d0){s16x4 lo[4],hi[4];
    #pragma unroll
    for(int ks=0;ks<4;++ks){
      asm volatile("ds_read_b64_tr_b16 %0,%1 offset:%c2":"=&v"(lo[ks]):"v"(vb),"i"(d0*4096+ks*1024):"memory");
      asm volatile("ds_read_b64_tr_b16 %0,%1 offset:%c2":"=&v"(hi[ks]):"v"(vb),"i"(d0*4096+ks*1024+512):"memory");}
    asm volatile("s_waitcnt lgkmcnt(0)":::"memory");SBAR();
    #define PK(k) (bf16x8){lo[k][0],lo[k][1],lo[k][2],lo[k][3],hi[k][0],hi[k][1],hi[k][2],hi[k][3]}
    o[d0]=__builtin_amdgcn_mfma_f32_32x32x16_bf16(pa0,PK(0),o[d0],0,0,0);
    o[d0]=__builtin_amdgcn_mfma_f32_32x32x16_bf16(pa1,PK(1),o[d0],0,0,0);
    o[d0]=__builtin_amdgcn_mfma_f32_32x32x16_bf16(pa2,PK(2),o[d0],0,0,0);
    o[d0]=__builtin_amdgcn_mfma_f32_32x32x16_bf16(pa3,PK(3),o[d0],0,0,0);
    #undef PK
  }
}

#ifndef ATTN_STORE16
#define ATTN_STORE16(p,v) (*(u32x4*)(p)=(v))
#endif
template<int THRL> __device__ __forceinline__ void attn_unit(int b,int h,int qb,bf16*YQb,const bf16*__restrict__ K,const bf16*__restrict__ V,char*shm,int wid_in,float sbound,bf16x8 (&qr)[4],bool first,bool hasNext,int nb,int nh,int nqb,bf16*dummyO=nullptr){
  const int wid=wid_in; int lane=mk_lane(); asm volatile("":"+v"(lane)); const int tid=wid*64+lane,r32=lane&31,hi=lane>>5; (void)tid;
  const long rowbase=(long)b*SEQ; const int q0=qb*QB;
  const bf16*Qw=YQb+(rowbase+q0+wid*QBLK)*QP+1024+h*D;
  const bf16*Kh=K+(long)b*KVL*KP+(h>>2)*D,*Vh=V+(long)b*KVL*KP+(h>>2)*D;
  const unsigned lds0=(unsigned)(uintptr_t)shm;
  float*wsf=(float*)(shm+LDS_WS)+wid*64;
  const bf16*ksrc=Kh+(long)lane*KP+wid*8;
  const bf16*vsrc=Vh+(long)(16*(wid&3)+(lane>>2))*KP+(wid>>2)*32+(lane&3)*8;
  const unsigned kdst=lds0+LDS_K+wid*1024, vdst=lds0+LDS_V+wid*1024;
  #define DMA_K(t,slot) glds16(ksrc+(long)(t)*KVBLK*KP,(unsigned)__builtin_amdgcn_readfirstlane(kdst+(slot)))
  #define DMA_V(t,slot) glds16(vsrc+(long)(t)*KVBLK*KP,(unsigned)__builtin_amdgcn_readfirstlane(vdst+(slot)))
  const int vb0=(int)(lds0+LDS_V)+((lane>>4)&1)*32+(lane&3)*8+(4*hi+((lane&15)>>2))*64;
  const char*Kbase=shm+LDS_K; bf16x8 kf[8];
  const lds_cptr shm3=(lds_cptr)shm; const lds_cptr kp0=shm3+LDS_K+hi*1024+r32*16; const lds_cptr vp0=shm3+LDS_V+((lane>>4)&1)*32+(lane&3)*8+(4*hi+((lane&15)>>2))*64;
  constexpr int NT=KVL/KVBLK;
  if(first){ DMA_K(0,0);DMA_V(0,0);DMA_K(1,SLOTB);
    #pragma unroll
    for(int d0=0;d0<4;++d0)qr[d0]=*reinterpret_cast<const bf16x8*>(&Qw[(long)r32*QP+d0*16+hi*8]); }
  float l_reg=0.f;f32x16 o[2];o[0]=f32x16{};o[1]=f32x16{};f32x16 negm;
  #pragma unroll
  for(int r=0;r<16;++r)negm[r]=-sbound;
  asm volatile("":"+v"(negm));
  #define CMASK(P0,P1,t) do{}while(0)
  #define START(P0,P1) do{ _Pragma("unroll") for(int r=0;r<16;++r)P0[r]=__builtin_amdgcn_exp2f(P0[r]); }while(0)
  #define RESC() do{}while(0)
  f32x16 pA0,pA1,pB0,pB1;
  int sl_prev=0,sl_cur=0,sl_next=SLOTB;
  #define ROT() do{sl_prev=sl_cur;sl_cur=sl_next;sl_next=(sl_next==(NSLOT-1)*SLOTB)?0:sl_next+SLOTB;}while(0)
  if(first){ DMA_K(2,2*SLOTB);
    WAIT_BAR(3); }
  else { WAIT_BAR(0); }
  qkt(pA0,pA1,Kbase,qr,negm,r32,hi);asm volatile("s_nop 15\n\ts_nop 7":"+v"(pA0),"+v"(pA1));CMASK(pA0,pA1,0);
  START(pA0,pA1);
  _Pragma("unroll") for(int r=0;r<16;++r)pA1[r]=__builtin_amdgcn_exp2f(pA1[r]);
  WAIT_BAR(0);
  DMA_K(3,0);DMA_V(1,SLOTB);
  ROT();
  kload8(kf,kp0+sl_cur);
  WAIT_BAR(2);
  s16x4 vlo[8],vhi[8]; u32x4 pw0,pw1,pw2,pw3;
  #define PKW(P,B) cvtpk_s(P[B],P[B+1])
  #define PAF(k) __builtin_bit_cast(bf16x8,pw##k)
  #define VFR(i) (bf16x8){vlo[i][0],vlo[i][1],vlo[i][2],vlo[i][3],vhi[i][0],vhi[i][1],vhi[i][2],vhi[i][3]}
  #define PIN(x) asm volatile("":"+v"(x))
  #define MX3(a,b,c) __builtin_fmaxf(__builtin_fmaxf((a),(b)),(c))
  #define GAPA(MF,A0,A1,A2,A3,W0,W1,PW) do{ MF; sacc+=A0; sacc+=A1; sacc+=A2; sacc+=A3; PIN(sacc); W0; W1; PIN(PW); SBAR(); }while(0)
  #define EX(v) __builtin_amdgcn_exp2f(v)
  #define GAPB(MF,X,B) do{ MF; X[B]=EX(X[B]); X[B+1]=EX(X[B+1]); X[B+2]=EX(X[B+2]); X[B+3]=EX(X[B+3]); PIN(X); SBAR(); }while(0)
  #define VRD(i) do{ vlo[i]=vtr(vp_+(((i)>>2)*4096+((i)&3)*1024)); vhi[i]=vtr(vp_+(((i)>>2)*4096+((i)&3)*1024+512)); }while(0)
  #define KRD(G,j) do{ if(G){ kload2(kf,kp0+sl_next,j); SBAR(); } }while(0)
  #define STEP(C0,C1,P0,P1,t,GK,GV,GL) do{ SBAR(); \
    const lds_cptr vp_=vp0+sl_prev; \
    VRD(0); SBAR(); float sacc=(P0[0]+P0[1]); \
    GAPA(C0=__builtin_amdgcn_mfma_f32_32x32x16_bf16(kf[0],qr[0],negm,0,0,0), P0[2],P0[3],P0[4],P0[5],     pw0[0]=PKW(P0,0), pw0[1]=PKW(P0,2), pw0); \
    VRD(4); SBAR(); GAPA(C1=__builtin_amdgcn_mfma_f32_32x32x16_bf16(kf[1],qr[0],negm,0,0,0), P0[6],P0[7],P0[8],P0[9],     pw0[2]=PKW(P0,4), pw0[3]=PKW(P0,6), pw0); \
    VRD(1); SBAR(); GAPA(C0=__builtin_amdgcn_mfma_f32_32x32x16_bf16(kf[2],qr[1],C0,0,0,0),   P0[10],P0[11],P0[12],P0[13], pw1[0]=PKW(P0,8), pw1[1]=PKW(P0,10), pw1); \
    VRD(5); SBAR(); GAPA(C1=__builtin_amdgcn_mfma_f32_32x32x16_bf16(kf[3],qr[1],C1,0,0,0),   P0[14],P0[15],P1[0],P1[1],   pw1[2]=PKW(P0,12),pw1[3]=PKW(P0,14), pw1); \
    VRD(2); SBAR(); GAPA(C0=__builtin_amdgcn_mfma_f32_32x32x16_bf16(kf[4],qr[2],C0,0,0,0),   P1[2],P1[3],P1[4],P1[5],     pw2[0]=PKW(P1,0), pw2[1]=PKW(P1,2), pw2); \
    VRD(6); SBAR(); GAPA(C1=__builtin_amdgcn_mfma_f32_32x32x16_bf16(kf[5],qr[2],C1,0,0,0),   P1[6],P1[7],P1[8],P1[9],     pw2[2]=PKW(P1,4), pw2[3]=PKW(P1,6), pw2); \
    VRD(3); SBAR(); GAPA(C0=__builtin_amdgcn_mfma_f32_32x32x16_bf16(kf[6],qr[3],C0,0,0,0),   P1[10],P1[11],P1[12],P1[13], pw3[0]=PKW(P1,8), pw3[1]=PKW(P1,10), pw3); \
    VRD(7); SBAR(); GAPA(C1=__builtin_amdgcn_mfma_f32_32x32x16_bf16(kf[7],qr[3],C1,0,0,0),   P1[14],P1[15],0.f,0.f,       pw3[2]=PKW(P1,12),pw3[3]=PKW(P1,14), pw3); \
    l_reg+=sacc; \
    if(GK){DMA_K((t)+3,sl_cur);} if(GV){DMA_V((t)+1,sl_next);} \
    CMASK(C0,C1,t); \
    SBAR(); \
    GAPB(o[0]=__builtin_amdgcn_mfma_f32_32x32x16_bf16(PAF(0),VFR(0),o[0],0,0,0), C0,0); \
    GAPB(o[1]=__builtin_amdgcn_mfma_f32_32x32x16_bf16(PAF(0),VFR(4),o[1],0,0,0), C0,4); \
    KRD(GL,0); GAPB(o[0]=__builtin_amdgcn_mfma_f32_32x32x16_bf16(PAF(1),VFR(1),o[0],0,0,0), C0,8); \
    KRD(GL,1); GAPB(o[1]=__builtin_amdgcn_mfma_f32_32x32x16_bf16(PAF(1),VFR(5),o[1],0,0,0), C0,12); \
    KRD(GL,2); GAPB(o[0]=__builtin_amdgcn_mfma_f32_32x32x16_bf16(PAF(2),VFR(2),o[0],0,0,0), C1,0); \
    KRD(GL,3); GAPB(o[1]=__builtin_amdgcn_mfma_f32_32x32x16_bf16(PAF(2),VFR(6),o[1],0,0,0), C1,4); \
    GAPB(o[0]=__builtin_amdgcn_mfma_f32_32x32x16_bf16(PAF(3),VFR(3),o[0],0,0,0), C1,8); \
    GAPB(o[1]=__builtin_amdgcn_mfma_f32_32x32x16_bf16(PAF(3),VFR(7),o[1],0,0,0), C1,12); \
    }while(0)
  int t=1;
  #undef CMASK
  #define CMASK(P0,P1,t) do{}while(0)
  for(;t+5<NT;t+=2){
    STEP(pB0,pB1,pA0,pA1,t,true,true,true);     WAIT_BAR(2); RESC(); ROT();
    STEP(pA0,pA1,pB0,pB1,t+1,true,true,true);   WAIT_BAR(2); RESC(); ROT();
  }
  #undef CMASK
  #define CMASK(P0,P1,t) do{}while(0)
  #define ENDW(tt) do{ if((tt)+3<NT){WAIT_BAR(2);} else if((tt)+2<NT){WAIT_BAR(1);} else {WAIT_BAR(0);} }while(0)
  for(;t+1<NT;t+=2){
    STEP(pB0,pB1,pA0,pA1,t,(t+3<NT),(t+1<NT),(t+1<NT));       ENDW(t);   RESC(); ROT();
    STEP(pA0,pA1,pB0,pB1,t+1,(t+4<NT),(t+2<NT),(t+2<NT));     ENDW(t+1); RESC(); ROT();
  }
  const bf16*nQw=YQb+((long)nb*SEQ+nqb*QB+wid*QBLK)*QP+1024+nh*D;
  if(hasNext){ const bf16*nK=K+(long)nb*KVL*KP+(nh>>2)*D+(long)lane*KP+wid*8; const bf16*nV=V+(long)nb*KVL*KP+(nh>>2)*D+(long)(16*(wid&3)+(lane>>2))*KP+(wid>>2)*32+(lane&3)*8;
    glds16(nK,(unsigned)__builtin_amdgcn_readfirstlane(kdst)); glds16(nV,(unsigned)__builtin_amdgcn_readfirstlane(vdst)); glds16(nK+(long)KVBLK*KP,(unsigned)__builtin_amdgcn_readfirstlane(kdst+SLOTB)); glds16(nK+(long)2*KVBLK*KP,(unsigned)__builtin_amdgcn_readfirstlane(kdst+2*SLOTB)); }
  STEP(pB0,pB1,pA0,pA1,NT-1,false,false,false); RESC();
  { float sacc=pB0[0]+pB0[1]; _Pragma("unroll") for(int r=2;r<16;++r)sacc+=pB0[r]; _Pragma("unroll") for(int r=0;r<16;++r)sacc+=pB1[r]; l_reg+=sacc;
    pw0=(u32x4){PKW(pB0,0),PKW(pB0,2),PKW(pB0,4),PKW(pB0,6)};pw1=(u32x4){PKW(pB0,8),PKW(pB0,10),PKW(pB0,12),PKW(pB0,14)};pw2=(u32x4){PKW(pB1,0),PKW(pB1,2),PKW(pB1,4),PKW(pB1,6)};pw3=(u32x4){PKW(pB1,8),PKW(pB1,10),PKW(pB1,12),PKW(pB1,14)};
    SBAR(); pv(o,vb0+sl_cur,PAF(0),PAF(1),PAF(2),PAF(3)); }
  if(hasNext){
    #pragma unroll
    for(int d0=0;d0<4;++d0)qr[d0]=*reinterpret_cast<const bf16x8*>(&nQw[(long)r32*QP+d0*16+hi*8]); }
  #undef PKW
  #undef PAF
  #undef VFR
  #undef PIN
  #undef MX3
  #undef GAPA
  #undef GAPB
  #undef EX
  #undef VRD
  #undef KRD
  #undef STEP
  #undef ENDW
  {auto rr=__builtin_amdgcn_permlane32_swap(__float_as_uint(l_reg),__float_as_uint(l_reg),false,false);l_reg=__uint_as_float(rr[0])+__uint_as_float(rr[1]);}
  if(hi==0)wsf[32+r32]=l_reg;asm volatile("s_waitcnt lgkmcnt(0)":::"memory");
  float rli[16];
  #pragma unroll
  for(int r=0;r<16;++r)rli[r]=__builtin_amdgcn_rcpf(wsf[32+crow(r,hi)]);
  bf16*Ow=dummyO?dummyO+(long)(wid*QBLK)*QP:YQb+(rowbase+q0+wid*QBLK)*QP+1024+h*D; const bf16*Gw=YQb+(rowbase+q0+wid*QBLK)*QP+h*D;
  { float*stg=(float*)(shm+LDS_OST)+wid*2048;
    #pragma unroll
    for(int r=0;r<16;++r){const int orow=crow(r,hi);
      #pragma unroll
      for(int d0=0;d0<2;++d0)stg[orow*64+d0*32+r32]=o[d0][r]*rli[r];}
    asm volatile("s_waitcnt lgkmcnt(0)":::"memory");
    #pragma unroll
    for(int i=0;i<4;++i){const int row=i*8+(lane>>3),ch=lane&7; const float*sp=stg+row*64+ch*8;
      const f32x4_t a=*(const f32x4_t*)sp,c=*(const f32x4_t*)(sp+4); const u32x4 g=*(const u32x4*)(Gw+(long)row*QP+ch*8);
      u32x4 v; v[0]=cvtpk_s(a[0]*__uint_as_float(g[0]<<16),a[1]*__uint_as_float(g[0]&0xffff0000u)); v[1]=cvtpk_s(a[2]*__uint_as_float(g[1]<<16),a[3]*__uint_as_float(g[1]&0xffff0000u));
      v[2]=cvtpk_s(c[0]*__uint_as_float(g[2]<<16),c[1]*__uint_as_float(g[2]&0xffff0000u)); v[3]=cvtpk_s(c[2]*__uint_as_float(g[3]<<16),c[3]*__uint_as_float(g[3]&0xffff0000u));
      ATTN_STORE16(Ow+(long)row*QP+ch*8,v);} }
  asm volatile("s_waitcnt lgkmcnt(0)\n\ts_barrier":::"memory");
  #undef DMA_K
  #undef DMA_V
  #undef CMASK
  #undef START
  #undef RESC
  #undef ROT
}
constexpr int ATTN_LDS_BYTES=LDS_BYTES;
struct Order {
  int vcu, G; bool alt;
  __device__ __forceinline__ bool next(int i,int&b,int&h,int&qb)const{
    if(G==256&&!alt){ if(i>=16)return false; const int x=vcu>>5,j=vcu&31,rd=i>>2,k=i&3; const int pair=x*16+rd*4+(j>>3),un=(j&7)*4+k; b=pair>>2; h=(pair&3)*4+(un&3); qb=un>>2; return true; }
    const int U=i*G+vcu; if(U>=4096)return false; b=U>>7; h=(U>>3)&15; qb=U&7; return true; }
};
template<int THRL=8> __device__ __forceinline__ void attn_phase(char*lds,bf16*YQb,const bf16*K,const bf16*V,const Order&S,int wid,float sbound,bf16*dummyO=nullptr){
  int b,h,qb,nb=0,nh=0,nqb=0; bf16x8 qr[4]; bool first=true;
  bool has=S.next(0,b,h,qb);
  for(int i=0;has;++i){ const bool hn=S.next(i+1,nb,nh,nqb);
    attn_unit<THRL>(b,h,qb,YQb,K,V,lds,wid,sbound,qr,first,hn,nb,nh,nqb,dummyO);
    b=nb;h=nh;qb=nqb;has=hn;first=false; }
}
#undef SBAR
#undef WAIT_BAR
}

namespace ssd {
typedef short bf16x8 __attribute__((ext_vector_type(8)));
typedef short s16x4 __attribute__((ext_vector_type(4)));
typedef unsigned u32x2_t __attribute__((ext_vector_type(2)));
constexpr int O_B = 0, O_C = 32768, O_X = 65536, O_XD = 81920, O_ST = 98304, O_SM = 114688;
constexpr float LOG2E = 1.4426950408889634f;
struct Lofs { int fb[4], xb[4], bb, sw; };
__device__ __forceinline__ bf16x8 frag(const LAS unsigned char* img, int fbk, int t) { return *(const LAS bf16x8*)(img + fbk + t * 4096); }
__device__ __forceinline__ s16x4 trd(const LAS unsigned char* p) { typedef short v4i16_t __attribute__((ext_vector_type(4))); return __builtin_bit_cast(s16x4, __builtin_amdgcn_ds_read_tr16_b64_v4i16((LAS v4i16_t*)p)); }
__device__ __forceinline__ bf16x8 trfragX(const LAS unsigned char* img, int xbp, int s0) {
    const s16x4 a = trd(img + xbp + s0 * 128), b = trd(img + xbp + s0 * 128 + 2048);
    return (bf16x8){a[0], a[1], a[2], a[3], b[0], b[1], b[2], b[3]};
}
__device__ __forceinline__ bf16x8 trfragB(const LAS unsigned char* img, int bb, int s0) {
    const s16x4 a = trd(img + bb + s0 * 256), b = trd(img + bb + s0 * 256 + 4096);
    return (bf16x8){a[0], a[1], a[2], a[3], b[0], b[1], b[2], b[3]};
}
__device__ __forceinline__ void unpack4(const u32x2_t u, float (&f)[4]) { f[0] = __uint_as_float(u.x << 16); f[1] = __uint_as_float(u.x & 0xffff0000u); f[2] = __uint_as_float(u.y << 16); f[3] = __uint_as_float(u.y & 0xffff0000u); }
__device__ __forceinline__ void unpack8(const v4u u, float (&f)[8]) {
    f[0] = __uint_as_float(u.x << 16); f[1] = __uint_as_float(u.x & 0xffff0000u); f[2] = __uint_as_float(u.y << 16); f[3] = __uint_as_float(u.y & 0xffff0000u);
    f[4] = __uint_as_float(u.z << 16); f[5] = __uint_as_float(u.z & 0xffff0000u); f[6] = __uint_as_float(u.w << 16); f[7] = __uint_as_float(u.w & 0xffff0000u);
}
#define SSD_MFMA(a, b, c) __builtin_amdgcn_mfma_f32_16x16x32_bf16(a, b, c, 0, 0, 0)

template <int W> __device__ __forceinline__ void diag(f32x4 (&y)[4], const bf16x8 (&cf)[4], const LAS unsigned char* Bi, const LAS unsigned char* Xi, const LAS float* csc, float csl, float skd, int fr, int fq, const Lofs& lo) {
    constexpr int NU = W / 2 + 1;
    bf16x8 bA[2][4], bB[2][4];
#pragma unroll
    for (int kk = 0; kk < 4; ++kk) { bA[0][kk] = frag(Bi, lo.fb[kk], 0); if (1 <= W) bB[0][kk] = frag(Bi, lo.fb[kk], 1); }
#pragma unroll
    for (int u = 0; u < NU; ++u) {
        const int cur = u & 1; const bool has1 = 2 * u + 1 <= W;
        bf16x8 xf[4];
#pragma unroll
        for (int pt = 0; pt < 4; ++pt) xf[pt] = trfragX(Xi, lo.xb[pt], 32 * u);
        const f32x4 c0 = *(const LAS f32x4*)(csc + 32 * u + 4 * fq), c1 = *(const LAS f32x4*)(csc + 32 * u + 16 + 4 * fq);
        if (u + 1 < NU) {
#pragma unroll
            for (int kk = 0; kk < 4; ++kk) { bA[cur ^ 1][kk] = frag(Bi, lo.fb[kk], 2 * u + 2); if (2 * u + 3 <= W) bB[cur ^ 1][kk] = frag(Bi, lo.fb[kk], 2 * u + 3); } }
        asm volatile("" ::: "memory");
        f32x4 a0 = (f32x4){0.f, 0.f, 0.f, 0.f}, a1 = (f32x4){0.f, 0.f, 0.f, 0.f};
#pragma unroll
        for (int kk = 0; kk < 4; ++kk) { a0 = SSD_MFMA(bA[cur][kk], cf[kk], a0); if (has1) a1 = SSD_MFMA(bB[cur][kk], cf[kk], a1); }
        float m0[4], m1[4];
#pragma unroll
        for (int e = 0; e < 4; ++e) {
            m0[e] = a0[e] * __builtin_amdgcn_exp2f(fminf(csl - c0[e], 0.f)); if (2 * u == W) { if (4 * fq + e > fr) m0[e] = 0.f; if (4 * fq + e == fr) m0[e] += skd; }
            m1[e] = has1 ? a1[e] * __builtin_amdgcn_exp2f(fminf(csl - c1[e], 0.f)) : 0.f; if (2 * u + 1 == W) { if (4 * fq + e > fr) m1[e] = 0.f; if (4 * fq + e == fr) m1[e] += skd; } }
        const v4u mw = (v4u){pk2(m0[0], m0[1]), pk2(m0[2], m0[3]), pk2(m1[0], m1[1]), pk2(m1[2], m1[3])};
        const bf16x8 mf = __builtin_bit_cast(bf16x8, mw);
#pragma unroll
        for (int pt = 0; pt < 4; ++pt) y[pt] = SSD_MFMA(xf[pt], mf, y[pt]);
    }
}

template <int SH> __device__ __forceinline__ void ssd_item(int b, int h, const bf16* XC, const float* DT, const bf16* Z, const float* a_log, const float* d_skip, bf16* YQ, float* SSQ,
                                          LAS unsigned char* L, int tid_in, int lane_in, int wave) {
    int tid = tid_in, lane = lane_in; asm volatile("" : "+v"(tid), "+v"(lane));
    const int fr = lane & 15, fq = lane >> 4, g = h >> 3;
    LAS unsigned char* Bi = L + O_B; LAS unsigned char* Ci = L + O_C; LAS unsigned char* Xi = L + O_X; LAS unsigned char* Xdi = L + O_XD; LAS unsigned char* Sti = L + O_ST;
    LAS float* dtv = (LAS float*)(L + O_SM); LAS float* cs2 = dtv + 256;
    const float aneg1 = -expf(a_log[16 + h]) * LOG2E, aneg0 = -expf(a_log[h]) * LOG2E, dsk = d_skip[h];
    Lofs lo;
    { const int q = (lane & 15) >> 2, pp = lane & 3, rr = 4 * fq + q;
#pragma unroll
      for (int kk = 0; kk < 4; ++kk) lo.fb[kk] = fr * 256 + (((4 * kk + fq) ^ fr) << 4);
#pragma unroll
      for (int pt = 0; pt < 4; ++pt) lo.xb[pt] = rr * 128 + ((pt ^ ((rr >> 1) & 3)) << 5) + 8 * pp;
      lo.bb = rr * 256 + (((2 * wave + (pp >> 1)) ^ rr) << 4) + 8 * (pp & 1);
      lo.sw = fr * 256 + (((2 * wave + (fq >> 1)) ^ fr) << 4) + (fq & 1) * 8; }
    const int sB = tid >> 4, cB = tid & 15, sX = tid >> 3, cX = tid & 7;
    const int wB = sB * 256 + ((cB ^ (sB & 15)) << 4);
    const int wX = sX * 128 + (((cX >> 1) ^ ((sX >> 1) & 3)) << 5) + (cX & 1) * 16;
    f32x4 st[4];
#pragma unroll
    for (int pt = 0; pt < 4; ++pt) st[pt] = (f32x4){0.f, 0.f, 0.f, 0.f};
    v4u Bq[4], Cq[4], Xq[2]; float dq0 = 0.f, dq1 = 0.f; bf16x8 cf[4];
#define SSD_DECODE(step, d_, base_, ctx_) const int d_ = 1 - (step) / 18; const int k_##d_ = (step) % 18; const bool ctx_ = k_##d_ < 2; \
    const size_t base_ = ctx_ ? (size_t)ML + (size_t)b * CTXL + (size_t)(d_ ? 1 - k_##d_ : k_##d_) * 128 : (size_t)b * SEQ + (size_t)(d_ ? 17 - k_##d_ : k_##d_ - 2) * 128;
#define SSD_ISSUE(step) do { SSD_DECODE(step, di, basei, ctxi) (void)ctxi; \
        const bf16* cb_ = XC + (SH == 8 ? (size_t)b * SEQ : basei) * CONVC; const int sg_ = di ? -CONVC : CONVC; const int o0_ = di ? 127 * CONVC : 0; \
        const bf16* pb_ = cb_ + (o0_ + sB * sg_ + 1024 + g * 128 + 8 * cB); const bf16* px_ = cb_ + (o0_ + sX * sg_ + h * 64 + 8 * cX); \
        const bf16* pc_ = cb_ + (o0_ + (16 * wave + fr) * sg_ + 1280 + g * 128 + 8 * fq); \
        _Pragma("unroll") for (int k4 = 0; k4 < 4; ++k4) { Bq[k4] = *(const v4u*)(pb_ + k4 * 32 * sg_); Cq[k4] = *(const v4u*)(pc_ + 32 * k4); } \
        _Pragma("unroll") for (int k2 = 0; k2 < 2; ++k2) Xq[k2] = *(const v4u*)(px_ + k2 * 64 * sg_); \
        if (wave == 0) { const size_t r0 = basei + (di ? 127 - 2 * lane : 2 * lane), r1 = basei + (di ? 126 - 2 * lane : 2 * lane + 1); dq0 = DT[r0 * 32 + di * 16 + h]; dq1 = DT[r1 * 32 + di * 16 + h]; } } while (0)
#define SSD_CUMSUM(step, par) do { if (wave == 0) { const float an = (1 - (step) / 18) ? aneg1 : aneg0; const float a0 = dq0 * an, a1 = dq1 * an; float v = a0 + a1; \
        _Pragma("unroll") for (int o = 1; o < 64; o <<= 1) { const float t = __shfl_up(v, o); if (lane >= o) v += t; } \
        dtv[(par) * 128 + 2 * lane] = dq0; dtv[(par) * 128 + 2 * lane + 1] = dq1; cs2[(par) * 128 + 2 * lane] = v - a1; cs2[(par) * 128 + 2 * lane + 1] = v; } } while (0)
#define SSD_WRITE(step, par) do { \
        _Pragma("unroll") for (int k4 = 0; k4 < 4; ++k4) { *(LAS v4u*)(Bi + wB + k4 * 8192) = Bq[k4]; cf[k4] = __builtin_bit_cast(bf16x8, Cq[k4]); } \
        const float cl = cs2[(par) * 128 + 127]; \
        _Pragma("unroll") for (int k2 = 0; k2 < 2; ++k2) { const int s = sX + 64 * k2; const float dts = dtv[(par) * 128 + s], es = __builtin_amdgcn_exp2f(cl - cs2[(par) * 128 + s]); \
            float f[8]; unpack8(Xq[k2], f); _Pragma("unroll") for (int e = 0; e < 8; ++e) f[e] *= dts; \
            v4u xo; xo.x = pk2(f[0], f[1]); xo.y = pk2(f[2], f[3]); xo.z = pk2(f[4], f[5]); xo.w = pk2(f[6], f[7]); \
            _Pragma("unroll") for (int e = 0; e < 8; ++e) f[e] *= es; \
            v4u xd; xd.x = pk2(f[0], f[1]); xd.y = pk2(f[2], f[3]); xd.z = pk2(f[4], f[5]); xd.w = pk2(f[6], f[7]); \
            *(LAS v4u*)(Xi + wX + k2 * 8192) = xo; *(LAS v4u*)(Xdi + wX + k2 * 8192) = xd; } } while (0)
#define SSD_WRITE_STATE() do { _Pragma("unroll") for (int pt = 0; pt < 4; ++pt) { \
        u32x2_t w; w.x = pk2(st[pt][0], st[pt][1]); w.y = pk2(st[pt][2], st[pt][3]); *(LAS u32x2_t*)(Sti + lo.sw + pt * 4096) = w; } } while (0)

    __syncthreads();
    SSD_ISSUE(0); SSD_CUMSUM(0, 0); SSD_WRITE_STATE();
    __syncthreads();
    SSD_WRITE(0, 0);
    __syncthreads();
    for (int step = 0; step < 36; ++step) {
        const int par = step & 1; SSD_DECODE(step, d, base, isctx)
        const int r8 = lane >> 3, c8 = lane & 7;
        size_t orow2[2]; v4u ybv[2], zv[2];
#pragma unroll
        for (int ps = 0; ps < 2; ++ps) { const int l = 16 * wave + 8 * ps + r8; orow2[ps] = base + (d ? 127 - l : l); }
        if (!isctx && d == 0 && SH != 5 && SH != 7) {
#pragma unroll
            for (int ps = 0; ps < 2; ++ps) { ybv[ps] = *(const v4u*)((SH ? YQ + (orow2[ps] & 255) * 2048 : YQ + orow2[ps] * 2048) + h * 64 + 8 * c8); zv[ps] = *(const v4u*)(Z + orow2[ps] * 1024 + h * 64 + 8 * c8); } }
        if (step + 1 < 36 && SH != 3 && SH != 7) SSD_ISSUE(step + 1);
        const LAS float* csc = cs2 + par * 128;
        if (!isctx && SH != 7) {
            const float csl = csc[16 * wave + fr];
            const float skd = d == 0 ? dsk * __builtin_amdgcn_rcpf(dtv[par * 128 + 16 * wave + fr]) : 0.f;
            f32x4 y[4];
#pragma unroll
            for (int pt = 0; pt < 4; ++pt) { y[pt] = (f32x4){0.f, 0.f, 0.f, 0.f};
                if (SH != 6) {
#pragma unroll
                for (int kk = 0; kk < 4; ++kk) y[pt] = SSD_MFMA(frag(Sti, lo.fb[kk], pt), cf[kk], y[pt]); } }
            { const float El = __builtin_amdgcn_exp2f(csl);
#pragma unroll
              for (int pt = 0; pt < 4; ++pt) y[pt] *= El; }
            if (SH != 2) switch (wave) {
                case 0: diag<0>(y, cf, Bi, Xi, csc, csl, skd, fr, fq, lo); break; case 1: diag<1>(y, cf, Bi, Xi, csc, csl, skd, fr, fq, lo); break;
                case 2: diag<2>(y, cf, Bi, Xi, csc, csl, skd, fr, fq, lo); break; case 3: diag<3>(y, cf, Bi, Xi, csc, csl, skd, fr, fq, lo); break;
                case 4: diag<4>(y, cf, Bi, Xi, csc, csl, skd, fr, fq, lo); break; case 5: diag<5>(y, cf, Bi, Xi, csc, csl, skd, fr, fq, lo); break;
                case 6: diag<6>(y, cf, Bi, Xi, csc, csl, skd, fr, fq, lo); break; default: diag<7>(y, cf, Bi, Xi, csc, csl, skd, fr, fq, lo); break;
            }
            LAS unsigned char* stg = Ci + wave * 4096;
#pragma unroll
            for (int pt = 0; pt < 4; ++pt) *(LAS f32x4*)(stg + fr * 256 + (((4 * pt + fq) ^ fr) << 4)) = y[pt];
#pragma unroll
            for (int ps = 0; ps < 2; ++ps) { const int rl = 8 * ps + r8;
                const f32x4 t0 = *(const LAS f32x4*)(stg + rl * 256 + (((2 * c8) ^ rl) << 4)), t1 = *(const LAS f32x4*)(stg + rl * 256 + (((2 * c8 + 1) ^ rl) << 4));
                float v[8] = {t0[0], t0[1], t0[2], t0[3], t1[0], t1[1], t1[2], t1[3]};
                if (d == 0 && SH != 5) { float fb[8], fz[8]; unpack8(ybv[ps], fb); unpack8(zv[ps], fz); float q = 0.f;
#pragma unroll
                    for (int e = 0; e < 8; ++e) { v[e] = (v[e] + fb[e]) * fz[e]; q += v[e] * v[e]; }
                    q += __shfl_xor(q, 1); q += __shfl_xor(q, 2); q += __shfl_xor(q, 4);
                    if (c8 == 0) SSQ[(SH ? (orow2[ps] & 255) : orow2[ps]) * 16 + h] = q; }
                v4u o; o.x = pk2(v[0], v[1]); o.y = pk2(v[2], v[3]); o.z = pk2(v[4], v[5]); o.w = pk2(v[6], v[7]);
                if (SH != 5) *(v4u*)((SH ? YQ + (orow2[ps] & 255) * 2048 : YQ + orow2[ps] * 2048) + h * 64 + 8 * c8) = o; else asm volatile("" :: "v"(o)); }
        }
        if (SH != 6 && SH != 7) { const float dec = __builtin_amdgcn_exp2f(csc[127]);
#pragma unroll
          for (int pt = 0; pt < 4; ++pt) st[pt] *= dec;
#pragma unroll
          for (int kk = 0; kk < 4; ++kk) { const bf16x8 af = trfragB(Bi, lo.bb, 32 * kk);
#pragma unroll
              for (int pt = 0; pt < 4; ++pt) st[pt] = SSD_MFMA(af, trfragX(Xdi, lo.xb[pt], 32 * kk), st[pt]); } }
        if (step + 1 < 36) SSD_CUMSUM(step + 1, par ^ 1);
        if (step == 17) {
#pragma unroll
            for (int pt = 0; pt < 4; ++pt) st[pt] = (f32x4){0.f, 0.f, 0.f, 0.f};
            VM_WAIT();
        }
        __syncthreads();
        SSD_WRITE_STATE();
        if (step + 1 < 36 && SH != 4 && SH != 7) SSD_WRITE(step + 1, par ^ 1);
        __syncthreads();
    }
#undef SSD_DECODE
#undef SSD_ISSUE
#undef SSD_CUMSUM
#undef SSD_WRITE
#undef SSD_WRITE_STATE
}
namespace pr {
template <int CTRL, int ROWMASK> __device__ __forceinline__ float dpp_get(float v) {
    return __builtin_bit_cast(float, __builtin_amdgcn_update_dpp(0, __builtin_bit_cast(int, v), CTRL, ROWMASK, 0xF, false)); }
__device__ __forceinline__ float sum8(float q) {
    q += dpp_get<0xB1, 0xF>(q); q += dpp_get<0x4E, 0xF>(q); q += dpp_get<0x141, 0xF>(q); return q; }
__device__ __forceinline__ float scan64(float v) {
    v += dpp_get<0x111, 0xF>(v); v += dpp_get<0x112, 0xF>(v); v += dpp_get<0x114, 0xF>(v); v += dpp_get<0x118, 0xF>(v);
    v += dpp_get<0x142, 0xA>(v); v += dpp_get<0x143, 0xC>(v); return v; }
constexpr int P_B = 0, P_STG = 32768, P_X = 49152, P_XD = 81920, P_ST0 = 114688, P_ST1 = 132096, P_SM = 148480;
template <int W> __device__ __forceinline__ void diag1(f32x4 (&y)[4], const bf16x8 (&cf)[4], const LAS unsigned char* Bi, const LAS unsigned char* Xi, const LAS float* csc, float csl, float skd, int fr, int fq, const Lofs& lo) {
#pragma unroll
    for (int u = 0; u <= W / 2; ++u) {
        const bool has1 = 2 * u + 1 <= W;
        bf16x8 xf[4];
#pragma unroll
        for (int pt = 0; pt < 4; ++pt) xf[pt] = trfragX(Xi, lo.xb[pt], 32 * u);
        const f32x4 c0 = *(const LAS f32x4*)(csc + 32 * u + 4 * fq), c1 = *(const LAS f32x4*)(csc + 32 * u + 16 + 4 * fq);
        f32x4 a0 = (f32x4){0.f, 0.f, 0.f, 0.f}, a1 = (f32x4){0.f, 0.f, 0.f, 0.f};
#pragma unroll
        for (int kk = 0; kk < 4; ++kk) { a0 = SSD_MFMA(frag(Bi, lo.fb[kk], 2 * u), cf[kk], a0); if (has1) a1 = SSD_MFMA(frag(Bi, lo.fb[kk], 2 * u + 1), cf[kk], a1); }
        float m0[4], m1[4];
#pragma unroll
        for (int e = 0; e < 4; ++e) {
            m0[e] = a0[e] * __builtin_amdgcn_exp2f(fminf(csl - c0[e], 0.f)); if (2 * u == W) { if (4 * fq + e > fr) m0[e] = 0.f; if (4 * fq + e == fr) m0[e] += skd; }
            m1[e] = has1 ? a1[e] * __builtin_amdgcn_exp2f(fminf(csl - c1[e], 0.f)) : 0.f; if (2 * u + 1 == W) { if (4 * fq + e > fr) m1[e] = 0.f; if (4 * fq + e == fr) m1[e] += skd; } }
        const v4u mw = (v4u){pk2(m0[0], m0[1]), pk2(m0[2], m0[3]), pk2(m1[0], m1[1]), pk2(m1[2], m1[3])};
        const bf16x8 mf = __builtin_bit_cast(bf16x8, mw);
#pragma unroll
        for (int pt = 0; pt < 4; ++pt) y[pt] = SSD_MFMA(xf[pt], mf, y[pt]);
    }
}
__device__ __forceinline__ void diag_sw(int wave, f32x4 (&y)[4], const bf16x8 (&cf)[4], const LAS unsigned char* Bi, const LAS unsigned char* Xi, const LAS float* csc, float csl, float skd, int fr, int fq, const Lofs& lo) {
    switch (wave) {
        case 0: diag1<0>(y, cf, Bi, Xi, csc, csl, skd, fr, fq, lo); break; case 1: diag1<1>(y, cf, Bi, Xi, csc, csl, skd, fr, fq, lo); break;
        case 2: diag1<2>(y, cf, Bi, Xi, csc, csl, skd, fr, fq, lo); break; case 3: diag1<3>(y, cf, Bi, Xi, csc, csl, skd, fr, fq, lo); break;
        case 4: diag1<4>(y, cf, Bi, Xi, csc, csl, skd, fr, fq, lo); break; case 5: diag1<5>(y, cf, Bi, Xi, csc, csl, skd, fr, fq, lo); break;
        case 6: diag1<6>(y, cf, Bi, Xi, csc, csl, skd, fr, fq, lo); break; default: diag1<7>(y, cf, Bi, Xi, csc, csl, skd, fr, fq, lo); break;
    }
}

__device__ __forceinline__ void ssd_pair(int b, int hp, const bf16* XC, const float* DT, const bf16* Z, const float* a_log, const float* d_skip, bf16* YQ, float* SSQ,
                                          LAS unsigned char* L, int tid_in, int lane_in, int wave) {
    int tid = tid_in, lane = lane_in; asm volatile("" : "+v"(tid), "+v"(lane));
    const int fr = lane & 15, fq = lane >> 4, h0 = 2 * hp, g = hp >> 2;
    LAS unsigned char* Bi = L + P_B; LAS unsigned char* Stg = L + P_STG + wave * 2048;
    LAS float* dtv = (LAS float*)(L + P_SM); LAS float* cs2 = dtv + 512;
    const float an00 = -expf(a_log[h0]) * LOG2E, an01 = -expf(a_log[h0 + 1]) * LOG2E, an10 = -expf(a_log[16 + h0]) * LOG2E, an11 = -expf(a_log[16 + h0 + 1]) * LOG2E;
    const float dsk0 = d_skip[h0], dsk1 = d_skip[h0 + 1];
    Lofs lo;
    { const int q = (lane & 15) >> 2, pp = lane & 3, rr = 4 * fq + q;
#pragma unroll
      for (int kk = 0; kk < 4; ++kk) lo.fb[kk] = fr * 256 + (((4 * kk + fq) ^ fr) << 4);
#pragma unroll
      for (int pt = 0; pt < 4; ++pt) lo.xb[pt] = rr * 128 + ((pt ^ ((rr >> 1) & 3)) << 5) + 8 * pp;
      lo.bb = rr * 256 + (((2 * wave + (pp >> 1)) ^ rr) << 4) + 8 * (pp & 1);
      lo.sw = fr * 256 + (((2 * wave + (fq >> 1)) ^ fr) << 4) + (fq & 1) * 8; }
    const int sB = tid >> 4, cB = tid & 15, hx = (tid >> 3) & 1, cX = tid & 7;
    const int wB = sB * 256 + ((cB ^ (sB & 15)) << 4);
    const int wX = hx * 16384 + sB * 128 + (((cX >> 1) ^ ((sB >> 1) & 3)) << 5) + (cX & 1) * 16;
    f32x4 st[2][4];
#pragma unroll
    for (int hh = 0; hh < 2; ++hh)
#pragma unroll
        for (int pt = 0; pt < 4; ++pt) st[hh][pt] = (f32x4){0.f, 0.f, 0.f, 0.f};
    v4u Bq[4], Xq[4]; float dq0 = 0.f, dq1 = 0.f; bf16x8 cf[4];
#define PR_DECODE(step, d_, base_, ctx_) const int d_ = 1 - (step) / 18; const int k_##d_ = (step) % 18; const bool ctx_ = k_##d_ < 2; \
    const size_t base_ = ctx_ ? (size_t)ML + (size_t)b * CTXL + (size_t)(d_ ? 1 - k_##d_ : k_##d_) * 128 : (size_t)b * SEQ + (size_t)(d_ ? 17 - k_##d_ : k_##d_ - 2) * 128;
#define PR_ISSUE(step) do { PR_DECODE(step, di, basei, ctxi) (void)ctxi; \
        const bf16* cb_ = XC + basei * CONVC; const int sg_ = di ? -CONVC : CONVC; const int o0_ = di ? 127 * CONVC : 0; \
        const bf16* pb_ = cb_ + (o0_ + sB * sg_ + 1024 + g * 128 + 8 * cB); const bf16* px_ = cb_ + (o0_ + sB * sg_ + h0 * 64 + 8 * cB); \
        _Pragma("unroll") for (int k4 = 0; k4 < 4; ++k4) { Bq[k4] = *(const v4u*)(pb_ + k4 * 32 * sg_); Xq[k4] = *(const v4u*)(px_ + k4 * 32 * sg_); } \
        if (wave < 2) { const size_t r0 = basei + (di ? 127 - 2 * lane : 2 * lane), r1 = basei + (di ? 126 - 2 * lane : 2 * lane + 1); dq0 = DT[r0 * 32 + di * 16 + h0 + wave]; dq1 = DT[r1 * 32 + di * 16 + h0 + wave]; } } while (0)
#define PR_LOADC(step) do { PR_DECODE(step, dc, basec, ctxc) (void)ctxc; const bf16* pc_ = XC + basec * CONVC + ((dc ? 127 - (16 * wave + fr) : 16 * wave + fr) * CONVC + 1280 + g * 128 + 8 * fq); \
        _Pragma("unroll") for (int k4 = 0; k4 < 4; ++k4) cf[k4] = __builtin_bit_cast(bf16x8, *(const v4u*)(pc_ + 32 * k4)); } while (0)
#define PR_CUMSUM(step, par) do { if (wave < 2) { const float an = (1 - (step) / 18) ? (wave ? an11 : an10) : (wave ? an01 : an00); const float a0 = dq0 * an, a1 = dq1 * an; const float v = scan64(a0 + a1); \
        const int o_ = ((par) * 2 + wave) * 128 + 2 * lane; dtv[o_] = dq0; dtv[o_ + 1] = dq1; cs2[o_] = v - a1; cs2[o_ + 1] = v; } } while (0)
#define PR_WRITE(step, par) do { const int ob_ = ((par) * 2 + hx) * 128; const float cl = cs2[ob_ + 127]; \
        _Pragma("unroll") for (int k4 = 0; k4 < 4; ++k4) { *(LAS v4u*)(Bi + wB + k4 * 8192) = Bq[k4]; \
            const int s = sB + 32 * k4; const float dts = dtv[ob_ + s], es = __builtin_amdgcn_exp2f(cl - cs2[ob_ + s]); \
            float f[8]; unpack8(Xq[k4], f); _Pragma("unroll") for (int e = 0; e < 8; ++e) f[e] *= dts; \
            v4u xo; xo.x = pk2(f[0], f[1]); xo.y = pk2(f[2], f[3]); xo.z = pk2(f[4], f[5]); xo.w = pk2(f[6], f[7]); \
            _Pragma("unroll") for (int e = 0; e < 8; ++e) f[e] *= es; \
            v4u xd; xd.x = pk2(f[0], f[1]); xd.y = pk2(f[2], f[3]); xd.z = pk2(f[4], f[5]); xd.w = pk2(f[6], f[7]); \
            *(LAS v4u*)(L + P_X + wX + k4 * 4096) = xo; *(LAS v4u*)(L + P_XD + wX + k4 * 4096) = xd; } } while (0)
#define PR_WRITE_STATE() do { _Pragma("unroll") for (int pt = 0; pt < 4; ++pt) { \
        u32x2_t w; w.x = pk2(st[0][pt][0], st[0][pt][1]); w.y = pk2(st[0][pt][2], st[0][pt][3]); *(LAS u32x2_t*)(L + P_ST0 + lo.sw + pt * 4096) = w; \
        w.x = pk2(st[1][pt][0], st[1][pt][1]); w.y = pk2(st[1][pt][2], st[1][pt][3]); *(LAS u32x2_t*)(L + P_ST1 + lo.sw + pt * 4096) = w; } } while (0)

    __syncthreads();
    PR_ISSUE(0); PR_LOADC(0); PR_CUMSUM(0, 0); PR_WRITE_STATE();
    __syncthreads();
    PR_WRITE(0, 0);
    __syncthreads();
    for (int step = 0; step < 36; ++step) {
        const int par = step & 1; PR_DECODE(step, d, base, isctx)
        const int r8 = lane >> 3, c8 = lane & 7;
        size_t orow2[2]; v4u ybv[2], zv[2];
#pragma unroll
        for (int ps = 0; ps < 2; ++ps) { const int l = 16 * wave + 8 * ps + r8; orow2[ps] = base + (d ? 127 - l : l); }
        const bool fwdy = !isctx && d == 0;
        if (fwdy) {
#pragma unroll
            for (int ps = 0; ps < 2; ++ps) { ybv[ps] = *(const v4u*)(YQ + orow2[ps] * 2048 + h0 * 64 + 8 * c8); zv[ps] = *(const v4u*)(Z + orow2[ps] * 1024 + h0 * 64 + 8 * c8); } }
        if (step + 1 < 36) PR_ISSUE(step + 1);
        if (!isctx) {
#pragma unroll
            for (int hh = 0; hh < 2; ++hh) {
                const LAS float* csc = cs2 + (par * 2 + hh) * 128;
                const LAS unsigned char* Xi = L + P_X + hh * 16384; const LAS unsigned char* Sti = L + (hh ? P_ST1 : P_ST0);
                const float csl = csc[16 * wave + fr];
                const float skd = d == 0 ? (hh ? dsk1 : dsk0) * __builtin_amdgcn_rcpf(dtv[(par * 2 + hh) * 128 + 16 * wave + fr]) : 0.f;
                f32x4 y[4];
#pragma unroll
                for (int pt = 0; pt < 4; ++pt) { y[pt] = (f32x4){0.f, 0.f, 0.f, 0.f};
#pragma unroll
                    for (int kk = 0; kk < 4; ++kk) y[pt] = SSD_MFMA(frag(Sti, lo.fb[kk], pt), cf[kk], y[pt]); }
                { const float El = __builtin_amdgcn_exp2f(csl);
#pragma unroll
                  for (int pt = 0; pt < 4; ++pt) y[pt] *= El; }
                diag_sw(wave, y, cf, Bi, Xi, csc, csl, skd, fr, fq, lo);
#pragma unroll
                for (int ps = 0; ps < 2; ++ps) {
                    if ((fr >> 3) == ps) {
#pragma unroll
                        for (int pt = 0; pt < 4; ++pt) *(LAS f32x4*)(Stg + (fr & 7) * 256 + (((4 * pt + fq) ^ fr) << 4)) = y[pt]; }
                    const int key = 8 * ps + r8;
                    const f32x4 t0 = *(const LAS f32x4*)(Stg + r8 * 256 + (((2 * c8) ^ key) << 4)), t1 = *(const LAS f32x4*)(Stg + r8 * 256 + (((2 * c8 + 1) ^ key) << 4));
                    float v[8] = {t0[0], t0[1], t0[2], t0[3], t1[0], t1[1], t1[2], t1[3]};
                    if (d == 0) { float fb[8], fz[8]; unpack8(ybv[ps], fb); unpack8(zv[ps], fz); float q = 0.f;
#pragma unroll
                        for (int e = 0; e < 8; ++e) { v[e] = (v[e] + fb[e]) * fz[e]; q += v[e] * v[e]; }
                        q = sum8(q);
                        if (c8 == 0) SSQ[orow2[ps] * 16 + h0 + hh] = q; }
                    v4u o; o.x = pk2(v[0], v[1]); o.y = pk2(v[2], v[3]); o.z = pk2(v[4], v[5]); o.w = pk2(v[6], v[7]);
                    *(v4u*)(YQ + orow2[ps] * 2048 + (h0 + hh) * 64 + 8 * c8) = o;
                }
                if (hh == 0 && fwdy) {
#pragma unroll
                    for (int ps = 0; ps < 2; ++ps) { ybv[ps] = *(const v4u*)(YQ + orow2[ps] * 2048 + (h0 + 1) * 64 + 8 * c8); zv[ps] = *(const v4u*)(Z + orow2[ps] * 1024 + (h0 + 1) * 64 + 8 * c8); } }
            }
        }
        if (step + 1 < 36) PR_LOADC(step + 1);
        { const float dec0 = __builtin_amdgcn_exp2f(cs2[(par * 2 + 0) * 128 + 127]), dec1 = __builtin_amdgcn_exp2f(cs2[(par * 2 + 1) * 128 + 127]);
#pragma unroll
          for (int pt = 0; pt < 4; ++pt) { st[0][pt] *= dec0; st[1][pt] *= dec1; }
#pragma unroll
          for (int kk = 0; kk < 4; ++kk) { const bf16x8 af = trfragB(Bi, lo.bb, 32 * kk);
#pragma unroll
              for (int pt = 0; pt < 4; ++pt) { st[0][pt] = SSD_MFMA(af, trfragX(L + P_XD, lo.xb[pt], 32 * kk), st[0][pt]); st[1][pt] = SSD_MFMA(af, trfragX(L + P_XD + 16384, lo.xb[pt], 32 * kk), st[1][pt]); } } }
        if (step + 1 < 36) PR_CUMSUM(step + 1, par ^ 1);
        if (step == 17) {
#pragma unroll
            for (int pt = 0; pt < 4; ++pt) { st[0][pt] = (f32x4){0.f, 0.f, 0.f, 0.f}; st[1][pt] = (f32x4){0.f, 0.f, 0.f, 0.f}; }
            VM_WAIT();
        }
        __syncthreads();
        PR_WRITE_STATE();
        if (step + 1 < 36) PR_WRITE(step + 1, par ^ 1);
        __syncthreads();
    }
#undef PR_DECODE
#undef PR_ISSUE
#undef PR_CUMSUM
#undef PR_LOADC
#undef PR_WRITE
#undef PR_WRITE_STATE
}
}
}

__device__ __forceinline__ void ctx_dt_slice(const bf16* H, const bf16* bt1, const float* dt_bias, float* DT, int bx, int G, int wave, int lane) {
    typedef short bf16x8_t __attribute__((ext_vector_type(8)));
    const int fr = lane & 15, fq = lane >> 4;
    for (int sl = bx; sl < MC / 32; sl += G) {
        if (wave < 4) {
            const int r0 = ML + 32 * sl + 16 * (wave >> 1), j0 = 16 * (wave & 1);
            const bf16* ap = H + (size_t)(r0 + fr) * DM + 8 * fq; const bf16* bp = bt1 + (size_t)(2048 + j0 + fr) * DM + 8 * fq;
            f32x4 acc = (f32x4){0.f, 0.f, 0.f, 0.f};
#pragma unroll 8
            for (int kk = 0; kk < 32; ++kk) acc = __builtin_amdgcn_mfma_f32_16x16x32_bf16(*(const bf16x8_t*)(ap + 32 * kk), *(const bf16x8_t*)(bp + 32 * kk), acc, 0, 0, 0);
            const float bias = dt_bias[j0 + fr];
#pragma unroll
            for (int e = 0; e < 4; ++e) { const float v = acc[e] + bias; DT[(size_t)(r0 + 4 * fq + e) * 32 + j0 + fr] = v > 20.f ? v : log1pf(__expf(v)); }
        }
    }
}
constexpr int RING_OFF = 0, RING_BYTES = 131072;
constexpr int LDSCTL_OFF = RING_BYTES, MISC_OFF = LDSCTL_OFF + 320;
constexpr int RSTD_OFF = LDSCTL_OFF + 1024;
constexpr int LDS_BYTES = 155648;
constexpr int CW_BAR = 4096;
constexpr int CW_TMO2 = 8192, CW_CNT = 16384;
constexpr int EXL_OFF = 140288;
constexpr int NPHASE = 7;

struct Args { const float* in[18]; float* out; unsigned char* ws; int ph_lo, ph_hi; };

__global__ void __launch_bounds__(NWAVES * 64, 2) mega(Args args) {
    extern __shared__ __attribute__((aligned(16))) unsigned char lds[];
    LAS unsigned char* ldsp = (LAS unsigned char*)lds;
    volatile LAS unsigned* MISC = (volatile LAS unsigned*)(ldsp + MISC_OFF);
    const int wave = __builtin_amdgcn_readfirstlane((int)threadIdx.x >> 6);
#define PH_IDS() int lane = mk_lane(); asm volatile("" : "+v"(lane)); const int tid = wave * 64 + lane; (void)tid
    const int G = gridDim.x; const int bx = blockIdx.x; const int vcu = (G % 8 == 0) ? (bx % 8) * (G / 8) + bx / 8 : bx;
    unsigned char* ws = args.ws;
    gu32* ctl = (gu32*)(ws + WS_CTL);
    float* mod = (float*)(ws + WS_MOD); float* rope = (float*)(ws + WS_ROPE); float* SSQ = (float*)(ws + WS_SSQ); float* RPART = (float*)(ws + WS_RPART);
    bf16* bt1 = (bf16*)(ws + WS_BT1); bf16* bt2 = (bf16*)(ws + WS_BT2); float* DT = (float*)(ws + WS_DT); bf16* KB = (bf16*)(ws + WS_KB); bf16* VB = (bf16*)(ws + WS_VB);
    bf16* H = (bf16*)(ws + WS_R1); bf16* XC = (bf16*)(ws + WS_R1); bf16* XBC = (bf16*)(ws + WS_XBC); bf16* YQ = (bf16*)(ws + WS_YQ); bf16* Z = (bf16*)(ws + WS_Z);
    { PH_IDS(); for (int u = tid; u < (LDS_BYTES - LDSCTL_OFF) / 4; u += NWAVES * 64) ((LAS unsigned*)(ldsp + LDSCTL_OFF))[u] = 0u; }
    __syncthreads();
    const bool leader = wave == 0 && mk_lane() == 0; (void)leader;
    const int lo = args.ph_lo, hi = args.ph_hi;
    XcdBarrier bar; bar.bar = (unsigned*)(ctl + CW_BAR); bar.x = 0; bar.st = nullptr;
    if (hi - lo > 1) bar = xcd_barrier_post((unsigned*)(ctl + CW_BAR), MISC + 8, leader);
#ifndef DUP_MASK
#define DUP_MASK 0
#endif
#define IN(k) (lo <= (k) && (k) < hi)
#define REP(k) for (int rep_ = 0; rep_ < 1 + ((DUP_MASK >> (k)) & 1); ++rep_)
#define SEAM(k) do { if (IN(k) && IN((k) + 1)) xcd_barrier(bar, wave == 0 && mk_lane() == 0); } while (0)

    if (IN(0)) REP(0) {
        PH_IDS();
        LAS float* ldsf = (LAS float*)(ldsp + RING_OFF);
        if (bx < 48) p0_mod_block(args.in[1], args.in[3], args.in[4], args.in[5], mod, ldsf, bx, tid, lane, wave);
        else if (bx == 48) { for (int i = tid; i < 1024; i += NWAVES * 64) { const int p = i >> 4, f = i & 15; const float inv = powf(10000.f, -(float)f / 16.f); const float ang = (float)p * inv; rope[i] = cosf(ang); rope[1024 + i] = sinf(ang); } }
        LAS float* scr = ldsf + wave * (64 * 33);
        const int gw = ((bx + G - 49) % G) * NWAVES + wave, NGW = G * NWAVES;
        constexpr int I1 = 16 * 168, I2 = 32 * 32;
        for (int it = gw; it < I1 + I2; it += NGW) { if (it < I1) p0_bt1_item(args.in[7], bt1, scr, it, lane); else p0_bt2_item(args.in[16], args.in[15], bt2, scr, it - I1, lane); }
    }
    SEAM(0);
    if (IN(1)) REP(1) {
        PH_IDS();
        const int gw = bx * NWAVES + wave, NGW = G * NWAVES;
        static_assert(MT % (8 * 2048) == 0 || true, "row batches");
        {
            const int step = NGW * 4; int m0 = gw * 4;
            f32x4 va[4][4], vb[4][4];
            if (m0 < MT) p1_load4(va, args.in[0], args.in[2], m0, lane);
            while (m0 < MT) {
                if (m0 + step < MT) p1_load4(vb, args.in[0], args.in[2], m0 + step, lane);
                asm volatile("" ::: "memory");
                p1_proc4(va, mod, args.in[6], H, m0, lane);
                m0 += step; if (m0 >= MT) break;
                if (m0 + step < MT) p1_load4(va, args.in[0], args.in[2], m0 + step, lane);
                asm volatile("" ::: "memory");
                p1_proc4(vb, mod, args.in[6], H, m0, lane);
                m0 += step;
            }
        }
    }
    SEAM(1);

    if (IN(2)) REP(2) {
        pg8::Gemm g{H, bt1, MT, N1, 1024}; pg8::Sched1 S; S.init(G, bx);
        pg8::Epi1 E{KB, VB, XBC, YQ, Z, DT, rope, args.in[13], args.in[14], args.in[10]};
        pg8::gemm_phase<pg8::Epi1, pg8::Sched1, true, true>(ldsp + RING_OFF, g, S, E, wave);
        { int ln_ = mk_lane(); asm volatile("" : "+v"(ln_)); ctx_dt_slice(H, bt1, args.in[10], DT, bx, G, wave, ln_); }
    }
    SEAM(2);
    if (IN(3)) {
        PH_IDS();
        float sbound;
        { float gq = fabsf(args.in[13][lane]), gk = fabsf(args.in[14][lane]);
#pragma unroll
          for (int o = 1; o < 64; o <<= 1) { gq = fmaxf(gq, __shfl_xor(gq, o)); gk = fmaxf(gk, __shfl_xor(gk, o)); }
          sbound = __uint_as_float(__builtin_amdgcn_readfirstlane(__float_as_uint(C2 * 64.f * gq * gk * 1.01f))); }
        const attn_body::Order S{vcu, G, false};
        const attn_body::Order S2{vcu, G, true};
#ifndef ATTN_SHADOW
#define ATTN_SHADOW 0
#endif
        if (ATTN_SHADOW) attn_body::attn_phase<8>((char*)lds + RING_OFF, (attn_body::bf16*)YQ, (const attn_body::bf16*)KB, (const attn_body::bf16*)VB, ATTN_SHADOW == 2 ? S2 : S, wave, sbound, (attn_body::bf16*)(ws + WS_END + 8 * MiB));
        attn_body::attn_phase<8>((char*)lds + RING_OFF, (attn_body::bf16*)YQ, (const attn_body::bf16*)KB, (const attn_body::bf16*)VB, S, wave, sbound);
        conv_phase(XBC, args.in[8], args.in[9], XC, bx, G, tid);
    }
    SEAM(3);
    if (IN(4)) REP(4) {
        PH_IDS();
#if defined(SSD_NAIVE)
        for (int it = bx; it < NB * 16; it += G) ssd_item_naive(it >> 4, it & 15, XC, DT, Z, args.in[11], args.in[12], YQ, SSQ, (LAS float*)(ldsp + RING_OFF), tid);
#else
#ifndef SSD_SHADOW
#define SSD_SHADOW 0
#endif
        if (SSD_SHADOW) { bf16* dY = (bf16*)(ws + WS_END); float* dS = (float*)(ws + WS_END + 2 * MiB);
            for (int it = vcu; it < NB * 16; it += G) ssd::ssd_item<SSD_SHADOW>(it >> 4, it & 15, XC, DT, Z, args.in[11], args.in[12], dY, dS, ldsp, tid, lane, wave); }
#ifndef SSD_PAIR
#define SSD_PAIR 1
#endif
        if (SSD_PAIR) { for (int it = vcu; it < NB * 8; it += G) { int ln_ = mk_lane(); asm volatile("" : "+v"(ln_)); ssd::pr::ssd_pair(it >> 3, it & 7, XC, DT, Z, args.in[11], args.in[12], YQ, SSQ, ldsp, wave * 64 + ln_, ln_, wave); } }
        else for (int it = vcu; it < NB * 16; it += G) ssd::ssd_item<0>(it >> 4, it & 15, XC, DT, Z, args.in[11], args.in[12], YQ, SSQ, ldsp, tid, lane, wave);
#endif
    }
    SEAM(4);

    if (IN(5)) REP(5) {
        PH_IDS();
        pg8::Sched2 S; S.init(G, bx);
        LAS float* rt = (LAS float*)(ldsp + RSTD_OFF);
        { pg8::Unit u; for (int i = 0; i < 4 && S.next(i, u); ++i) if (tid < 256) { const float* q = SSQ + ((size_t)u.pm * 256 + tid) * 16; float s = 0.f;
#pragma unroll
                for (int j = 0; j < 16; ++j) s += q[j];
                rt[i * 256 + tid] = rsqrtf(s * (1.f / 1024.f) + EPS); } }
        __syncthreads();
        pg8::Gemm g{YQ, bt2, ML, 1024, 2048};
        pg8::Epi2 E{args.in[0], mod, args.in[17], args.out, (unsigned long long*)RPART, (unsigned*)(ctl + CW_CNT), (unsigned*)(ctl + CW_TMO2), (const LAS float*)rt, (LAS float*)(ldsp + EXL_OFF)};
        pg8::gemm_phase<pg8::Epi2, pg8::Sched2, true, true>(ldsp + RING_OFF, g, S, E, wave);
    }

#undef IN
#undef SEAM
}

extern "C" void kernel_launch(void* const* d_in, const int* in_sizes, int n_in, void* d_out, int out_size, void* d_ws, size_t ws_size, hipStream_t stream) {
    if (n_in != 18 || out_size != ML * DM || ws_size < WS_END) { fprintf(stderr, "kernel_launch: unexpected shapes (n_in %d out %d ws %zu); nothing launched\n", n_in, out_size, ws_size); return; }
    static int grid = 0;
    if (grid == 0) {
        int dev = 0, cus = 0;
        if (hipGetDevice(&dev) != hipSuccess || hipDeviceGetAttribute(&cus, hipDeviceAttributeMultiprocessorCount, dev) != hipSuccess) { fprintf(stderr, "kernel_launch: device query failed\n"); grid = -1; return; }
        if (hipFuncSetAttribute((const void*)mega, hipFuncAttributeMaxDynamicSharedMemorySize, LDS_BYTES) != hipSuccess) { fprintf(stderr, "kernel_launch: hipFuncSetAttribute failed\n"); grid = -1; return; }
        int per_cu = 0;
        if (hipOccupancyMaxActiveBlocksPerMultiprocessor(&per_cu, (const void*)mega, NWAVES * 64, LDS_BYTES) != hipSuccess || per_cu < 1) fprintf(stderr, "kernel_launch: note: occupancy query says %d blocks/CU\n", per_cu);
        (void)hipGetLastError();
        grid = cus;
    }
    if (grid < 0) return;
    (void)hipMemsetAsync((unsigned char*)d_ws + WS_CTL, 0, 1 * MiB, stream);
    Args a{};
    for (int i = 0; i < 18; ++i) a.in[i] = (const float*)d_in[i];
    a.out = (float*)d_out; a.ws = (unsigned char*)d_ws; a.ph_lo = 0; a.ph_hi = NPHASE;
    hipLaunchKernelGGL(mega, dim3(grid), dim3(NWAVES * 64), LDS_BYTES, stream, a);
    const hipError_t le = hipPeekAtLastError(); if (le != hipSuccess) fprintf(stderr, "kernel_launch: launch failed: %s\n", hipGetErrorName(le));
}
```

```cpp
#include <hip/hip_runtime.h>
#include <cstdio>
#include <cstdint>
#include <hip/hip_bf16.h>

constexpr int DM = 1024, NB = 32, SEQ = 2048, CTXL = 256, KVL = SEQ + CTXL;
constexpr int ML = NB * SEQ, MC = NB * CTXL, MT = ML + MC;
constexpr int PROJ = 5152, OFF_XBC = 512, OFF_DT = 2048, CTXC = 2080, CONVC = 1536;
constexpr int N1 = 21 * 256;
constexpr float EPS = 1e-6f;
constexpr float C2 = 0.125f * 1.4426950408889634f;

typedef unsigned short bf16;
__device__ __forceinline__ int mk_lane() { return (int)__builtin_amdgcn_mbcnt_hi(~0u, __builtin_amdgcn_mbcnt_lo(~0u, 0u)); }
__host__ __device__ __forceinline__ unsigned f2bf(float f) { unsigned u = __builtin_bit_cast(unsigned, f); return (u + 0x7fffu + ((u >> 16) & 1u)) >> 16; }
__host__ __device__ __forceinline__ float bf2f(unsigned h) { return __builtin_bit_cast(float, (h & 0xffffu) << 16); }
__device__ __forceinline__ float siluf(float v) { return v / (1.f + __expf(-v)); }
__device__ __forceinline__ float softplusf(float v) { return v > 20.f ? v : log1pf(expf(v)); }

constexpr size_t MiB = 1u << 20;
constexpr size_t WS_CTL = 0;
constexpr size_t WS_MOD = 2 * MiB;
constexpr size_t WS_ROPE = 3 * MiB;
constexpr size_t WS_SSQ = 4 * MiB;
constexpr size_t WS_RPART = 8 * MiB;
constexpr size_t WS_BT1 = 12 * MiB;
constexpr size_t WS_BT2 = 23 * MiB;
constexpr size_t WS_DT = 28 * MiB;
constexpr size_t WS_KB = 38 * MiB;
constexpr size_t WS_VB = 74 * MiB;
constexpr size_t WS_R1 = 110 * MiB;
constexpr size_t WS_XBC = 326 * MiB;
constexpr size_t WS_YQ = 542 * MiB;
constexpr size_t WS_Z = 798 * MiB;
constexpr size_t WS_END = 926 * MiB;

__host__ __device__ __forceinline__ int hperm_dim(int vin) {
    const int bj = vin >> 7, wc = (vin >> 5) & 3, s = vin & 31, fq = s >> 3, e = s & 7;
    return wc * 64 + bj * 32 + (e >> 2) * 16 + 4 * fq + (e & 3);
}
__host__ __device__ __forceinline__ int hperm_inv(int head, int dim) {
    const int axis = dim >> 5, half = (dim >> 4) & 1, i16 = dim & 15, fq = i16 >> 2, e = (i16 & 3) + 4 * half;
    return 128 * axis + 32 * head + 8 * fq + e;
}
__host__ __device__ __forceinline__ int vcol_actual(int v) {
    const int t = v >> 8, vin = v & 255;
    if (t == 0) return hperm_dim(vin);
    if (t == 1) return 256 + vin;
    if (t < 8) return v;
    if (t == 8) return vin < 32 ? OFF_DT + vin : -1;
    if (t < 13) return CTXC + (t - 9) * 256 + hperm_dim(vin);
    if (t < 17) return CTXC + 1024 + (v - 13 * 256);
    return CTXC + 2048 + (v - 17 * 256);
}

namespace pg8 {
#define PG8_LAS __attribute__((address_space(3)))
typedef unsigned short bf16_t;
typedef short bf16x8 __attribute__((ext_vector_type(8)));
typedef float f32x4 __attribute__((ext_vector_type(4)));
typedef unsigned u32x4 __attribute__((ext_vector_type(4)));
constexpr int BM = 256, BK = 64, HALF = 128, HTB = HALF * BK * 2  , STAGE_BYTES = 8 * HTB, NXCD = 8, WGM = 8;

__host__ __device__ __forceinline__ int lds_byte(int r, int c) { const int st = (r >> 4) * 2 + (c >> 5), rr = r & 15, cc = c & 31, ob = rr * 64 + cc * 2; return st * 1024 + (ob ^ (((ob >> 9) & 1) << 5)); }
__host__ __device__ __forceinline__ void stage_rc(int b, int& R, int& C) { const int st = b / 1024, sb = b % 1024, swz = sb ^ (((sb >> 9) & 1) << 5); R = (st >> 1) * 16 + swz / 64; C = (st & 1) * 32 + (swz % 64) / 2; }
__host__ __device__ __forceinline__ int perm32(int rho) { const int n = rho >> 4, i = rho & 15; return 8 * (i >> 2) + 4 * n + (i & 3); }

struct Unit { int pm, pn; };
struct Gemm { const bf16_t* A; const bf16_t* Bt; int M, N, K; };

__device__ __forceinline__ unsigned cvt_pk_bf16(float lo, float hi) { unsigned r; asm volatile("v_cvt_pk_bf16_f32 %0, %1, %2" : "=v"(r) : "v"(lo), "v"(hi)); return r; }
typedef float f32x2 __attribute__((ext_vector_type(2)));
template <class Epi, class Sched, bool ALIGN_EPI = false, bool SP2 = false>
__device__ __forceinline__ void gemm_phase(PG8_LAS unsigned char* lds, const Gemm g, const Sched& S, const Epi& E, int wid_in) {
    const int wid = wid_in; int lane = mk_lane(); asm volatile("" : "+v"(lane)); const int tid = wid * 64 + lane, wr = wid >> 2, wc = wid & 3, fr = lane & 15, fq = lane >> 4;
    const int K = g.K, nt = K / BK;
    unsigned voffA[2], voffB[2];
#pragma unroll
    for (int i = 0; i < 2; ++i) { int R, C; stage_rc(tid * 16 + i * 8192, R, C); const int Rb = Epi::PERM ? ((R & ~31) + perm32(R & 31)) : R;
        voffA[i] = (unsigned)(R * K + C) * 2u; voffB[i] = (unsigned)(Rb * K + C) * 2u; }
    const size_t kstep = (size_t)(BK * 2);
    const size_t hstep = (size_t)HALF * K * 2;
    const size_t tstep = 2 * hstep;
    const unsigned ldsw = (unsigned)wid * 1024u;
    const int aoff = lds_byte(wr * 64 + fr, fq * 8), boff = lds_byte(wc * 32 + fr, fq * 8);
#define PG8_SA(b, h) (((b) * 2 + (h)) * HTB)
#define PG8_SB(b, h) ((4 + (b) * 2 + (h)) * HTB)
#define PG8_STAGE(bufoff, gbase, voff) do { _Pragma("unroll") for (int _i = 0; _i < 2; ++_i) \
        __builtin_amdgcn_global_load_lds((const unsigned*)((const char*)(gbase) + (voff)[_i]), (PG8_LAS unsigned*)(lds + (bufoff) + ldsw + _i * 8192), 16, 0, 0); } while (0)
#define PG8_LDA(dst, b, h) do { _Pragma("unroll") for (int m = 0; m < 4; ++m) _Pragma("unroll") for (int k = 0; k < 2; ++k) dst[m][k] = *(const PG8_LAS bf16x8*)(lds + PG8_SA(b, h) + aoff + m * 2048 + k * 1024); } while (0)
#define PG8_LDB(dst, b, h) do { _Pragma("unroll") for (int n = 0; n < 2; ++n) _Pragma("unroll") for (int k = 0; k < 2; ++k) dst[n][k] = *(const PG8_LAS bf16x8*)(lds + PG8_SB(b, h) + boff + n * 2048 + k * 1024); } while (0)
#define PG8_MMA(ai, bj, At, Bt) do { __builtin_amdgcn_s_setprio(1); _Pragma("unroll") for (int m = 0; m < 4; ++m) _Pragma("unroll") for (int n = 0; n < 2; ++n) _Pragma("unroll") for (int k = 0; k < 2; ++k) \
        acc[ai][bj][m][n] = __builtin_amdgcn_mfma_f32_16x16x32_bf16(Bt[n][k], At[m][k], acc[ai][bj][m][n], 0, 0, 0); __builtin_amdgcn_s_setprio(0); } while (0)
#define PG8_WAIT_V(n) asm volatile("s_waitcnt vmcnt(" #n ")" ::: "memory")
#define PG8_WAIT_L(n) asm volatile("s_waitcnt lgkmcnt(" #n ")" ::: "memory")
#define PG8_BAR __builtin_amdgcn_s_barrier()
#define PG8_SCHED __builtin_amdgcn_sched_barrier(0)
    Unit cur, nxt; int ui = 0;
    if (!S.next(0, cur)) return;
    f32x4 acc[2][2][4][2];
#pragma unroll
    for (int a = 0; a < 2; ++a)
#pragma unroll
        for (int b = 0; b < 2; ++b)
#pragma unroll
            for (int m = 0; m < 4; ++m)
#pragma unroll
                for (int n = 0; n < 2; ++n) acc[a][b][m][n] = (f32x4){0.f, 0.f, 0.f, 0.f};
    bf16x8 At[4][2], B0[2][2], B1[2][2];
    const char* cA = (const char*)g.A + (size_t)cur.pm * tstep; const char* cB = (const char*)g.Bt + (size_t)cur.pn * tstep;
    S.a_ready(cur);
    if constexpr (SP2) {
        PG8_STAGE(PG8_SB(0, 0), cB, voffB); PG8_STAGE(PG8_SB(0, 1), cB + hstep, voffB); PG8_STAGE(PG8_SA(0, 0), cA, voffA); PG8_STAGE(PG8_SA(0, 1), cA + hstep, voffA);
        if (wr == 1) PG8_BAR;
        PG8_WAIT_V(2); PG8_BAR;
        PG8_STAGE(PG8_SB(1, 0), cB + kstep, voffB); PG8_STAGE(PG8_SA(1, 0), cA + kstep, voffA); PG8_STAGE(PG8_SB(1, 1), cB + hstep + kstep, voffB);
        PG8_WAIT_V(6); PG8_BAR;
    } else {
        PG8_STAGE(PG8_SB(0, 0), cB, voffB); PG8_STAGE(PG8_SA(0, 0), cA, voffA); PG8_STAGE(PG8_SB(0, 1), cB + hstep, voffB); PG8_STAGE(PG8_SA(0, 1), cA + hstep, voffA);
        if (wr == 1) PG8_BAR;
        PG8_WAIT_V(4); PG8_BAR;
        PG8_STAGE(PG8_SB(1, 0), cB + kstep, voffB); PG8_STAGE(PG8_SA(1, 0), cA + kstep, voffA); PG8_STAGE(PG8_SB(1, 1), cB + hstep + kstep, voffB);
        PG8_WAIT_V(6); PG8_BAR;
    }
    for (;;) {
        const bool has_next = S.next(ui + 1, nxt);
        const char* nA = has_next ? (const char*)g.A + (size_t)nxt.pm * tstep : cA; const char* nB = has_next ? (const char*)g.Bt + (size_t)nxt.pn * tstep : cB;
        for (int t = 0; t < nt; t += 2) {
            if constexpr (Epi::MIDK) { if (t == nt / 2) E.midk(acc, ui, wr, fr); }
            const bool last = (t == nt - 2);
            const char* a1 = cA + (size_t)(t + 1) * kstep;
            const char* a2 = last ? nA : cA + (size_t)(t + 2) * kstep; const char* b2 = last ? nB : cB + (size_t)(t + 2) * kstep;
            const char* a3 = a2 + kstep; const char* b3 = b2 + kstep;
            if (last && has_next) S.a_ready(nxt);
            if constexpr (SP2) {
            PG8_LDB(B0, 0, 0); PG8_LDB(B1, 0, 1); PG8_SCHED; PG8_LDA(At, 0, 0); PG8_STAGE(PG8_SA(1, 1), a1 + hstep, voffA);
            PG8_WAIT_V(8); PG8_WAIT_L(0); PG8_BAR; PG8_MMA(0, 0, At, B0); PG8_MMA(0, 1, At, B1); PG8_BAR; PG8_SCHED;
            PG8_LDA(At, 0, 1); PG8_STAGE(PG8_SB(0, 0), b2, voffB); PG8_STAGE(PG8_SB(0, 1), b2 + hstep, voffB); PG8_STAGE(PG8_SA(0, 0), a2, voffA);
            PG8_WAIT_V(8); PG8_WAIT_L(0); PG8_BAR; PG8_MMA(1, 0, At, B0); PG8_MMA(1, 1, At, B1); PG8_BAR; PG8_SCHED;
            PG8_LDB(B0, 1, 0); PG8_LDB(B1, 1, 1); PG8_SCHED; PG8_LDA(At, 1, 0); PG8_STAGE(PG8_SA(0, 1), a2 + hstep, voffA);
            PG8_WAIT_V(8); PG8_WAIT_L(0); PG8_BAR; PG8_MMA(0, 0, At, B0); PG8_MMA(0, 1, At, B1); PG8_BAR; PG8_SCHED;
            PG8_LDA(At, 1, 1); PG8_STAGE(PG8_SB(1, 0), b3, voffB); PG8_STAGE(PG8_SB(1, 1), b3 + hstep, voffB); PG8_STAGE(PG8_SA(1, 0), a3, voffA);
            PG8_WAIT_V(8); PG8_WAIT_L(0); PG8_BAR; PG8_MMA(1, 0, At, B0); PG8_MMA(1, 1, At, B1); PG8_BAR; PG8_SCHED;
            } else {
            PG8_LDB(B0, 0, 0); PG8_SCHED; PG8_LDA(At, 0, 0); PG8_STAGE(PG8_SA(1, 1), a1 + hstep, voffA);
            PG8_WAIT_L(8); PG8_BAR; PG8_WAIT_L(0); PG8_MMA(0, 0, At, B0); PG8_BAR; PG8_SCHED;
            PG8_LDB(B1, 0, 1); PG8_STAGE(PG8_SB(0, 0), b2, voffB);
            PG8_BAR; PG8_WAIT_L(0); PG8_MMA(0, 1, At, B1); PG8_BAR;
            PG8_LDA(At, 0, 1); PG8_STAGE(PG8_SA(0, 0), a2, voffA);
            PG8_BAR; PG8_WAIT_L(0); PG8_MMA(1, 0, At, B0); PG8_BAR; PG8_SCHED;
            PG8_STAGE(PG8_SB(0, 1), b2 + hstep, voffB);
            PG8_WAIT_V(6); PG8_BAR; PG8_MMA(1, 1, At, B1); PG8_BAR;
            PG8_LDB(B0, 1, 0); PG8_SCHED; PG8_LDA(At, 1, 0); PG8_STAGE(PG8_SA(0, 1), a2 + hstep, voffA);
            PG8_WAIT_L(8); PG8_BAR; PG8_WAIT_L(0); PG8_MMA(0, 0, At, B0); PG8_BAR; PG8_SCHED;
            PG8_LDB(B1, 1, 1); PG8_STAGE(PG8_SB(1, 0), b3, voffB);
            PG8_BAR; PG8_WAIT_L(0); PG8_MMA(0, 1, At, B1); PG8_BAR;
            PG8_LDA(At, 1, 1); PG8_STAGE(PG8_SA(1, 0), a3, voffA);
            PG8_BAR; PG8_WAIT_L(0); PG8_MMA(1, 0, At, B0); PG8_BAR; PG8_SCHED;
            PG8_STAGE(PG8_SB(1, 1), b3 + hstep, voffB);
            PG8_WAIT_V(6); PG8_BAR; PG8_MMA(1, 1, At, B1); PG8_BAR;
            }
        }
        if constexpr (ALIGN_EPI) { if (wr == 0) PG8_BAR; }
        if constexpr (!Epi::AFTER_DRAIN) { E(acc, cur, wr, wc, fr, fq); S.done(cur); }
        if (!has_next) break;
#pragma unroll
        for (int a = 0; a < 2; ++a)
#pragma unroll
            for (int b = 0; b < 2; ++b)
#pragma unroll
                for (int m = 0; m < 4; ++m)
#pragma unroll
                    for (int n = 0; n < 2; ++n) acc[a][b][m][n] = (f32x4){0.f, 0.f, 0.f, 0.f};
        cur = nxt; cA = nA; cB = nB; ++ui;
        if constexpr (ALIGN_EPI) { if (wr == 1) PG8_BAR; }
    }
    PG8_WAIT_V(0);
    if constexpr (!ALIGN_EPI) { if (wr == 0) PG8_BAR; }
    PG8_BAR;
    if constexpr (Epi::AFTER_DRAIN) { E.fused(acc, cur, wr, wc, fr, fq, lds, wid, lane); S.done(cur); }
#undef PG8_SA
#undef PG8_SB
#undef PG8_STAGE
#undef PG8_LDA
#undef PG8_LDB
#undef PG8_MMA
#undef PG8_WAIT_V
#undef PG8_WAIT_L
#undef PG8_BAR
#undef PG8_SCHED
}
struct Sched1 {
    int G, c;
    __device__ __forceinline__ void init(int G_, int c_) { G = G_; c = c_; }
    __device__ __forceinline__ bool next(int i, Unit& u) const {
        constexpr int nN = 21, nwg = 256 * nN;
        const int L = i * G + c;
        if (L < nwg) { const int wgid = (L % NXCD) * (nwg / NXCD) + L / NXCD; const int nig = WGM * nN, fm = (wgid / nig) * WGM;
            u.pm = fm + ((wgid % nig) % WGM); u.pn = (wgid % nig) / WGM; return true; }
        const int L2 = L - nwg; if (L2 >= 256) return false;
        const int wg = (L2 % NXCD) * 32 + L2 / NXCD; u.pn = wg >> 5; u.pm = 256 + (wg & 31); return true;
    }
    __device__ __forceinline__ void a_ready(const Unit&) const {}
    __device__ __forceinline__ void done(const Unit&) const {}
};
struct Sched2 {
    int G, c;
    __device__ __forceinline__ void init(int G_, int c_) { G = G_; c = c_; }
    __device__ __forceinline__ bool next(int i, Unit& u) const {
        constexpr int nN = 4, nwg = 256 * nN;
        const int L = i * G + c; if (L >= nwg) return false;
        const int wgid = (L % NXCD) * (nwg / NXCD) + L / NXCD; const int nig = WGM * nN, fm = (wgid / nig) * WGM;
        u.pm = fm + ((wgid % nig) % WGM); u.pn = (wgid % nig) / WGM; return true;
    }
    __device__ __forceinline__ void a_ready(const Unit&) const {}
    __device__ __forceinline__ void done(const Unit&) const {}
};
__device__ __forceinline__ float dot4(const f32x4 a) { return (a[0] * a[0] + a[1] * a[1]) + (a[2] * a[2] + a[3] * a[3]); }
__device__ __forceinline__ float silu1(float v) { return v * __builtin_amdgcn_rcpf(1.f + __expf(-v)); }
typedef unsigned u32x2 __attribute__((ext_vector_type(2)));
__device__ __forceinline__ u32x2 pk4(const f32x4 v) { u32x2 w; w.x = cvt_pk_bf16(v[0], v[1]); w.y = cvt_pk_bf16(v[2], v[3]); return w; }
struct Epi1 {
    static constexpr bool PERM = true, AFTER_DRAIN = false, MIDK = false;
    bf16_t *KB, *VB, *XBC, *YQ, *Z; float* DT; const float *rope, *qg, *kg, *dt_bias;
    __device__ __forceinline__ void midk(f32x4 (&)[2][2][4][2], int, int, int) const {}
    __device__ __forceinline__ void operator()(const f32x4 (&acc)[2][2][4][2], const Unit& u, int wr, int wc, int fr_in, int fq_in) const {
        int fr = fr_in, fq = fq_in; asm volatile("" : "+v"(fr), "+v"(fq));
        const int pn = u.pn, pm = u.pm; const bool isctx = pm >= 256; const int rloc = wr * 64 + fr;
        const int bb = isctx ? pm - 256 : pm >> 3, pos0 = isctx ? SEQ : (pm & 7) * 256;
        if (pn == 0 || (pn >= 9 && pn < 13)) {
            const float* g = pn == 0 ? kg : qg;
            const f32x4 g00 = *(const f32x4*)(g + 4 * fq), g01 = *(const f32x4*)(g + 16 + 4 * fq), g10 = *(const f32x4*)(g + 32 + 4 * fq), g11 = *(const f32x4*)(g + 48 + 4 * fq);
            const float osc = pn == 0 ? 1.f : C2;
            bf16_t* dbase; size_t pitch;
            if (pn == 0) { dbase = KB + ((size_t)bb * KVL + pos0) * 256 + wc * 64 + 4 * fq; pitch = 256; }
            else { dbase = YQ + (size_t)pm * 256 * 2048 + 1024 + ((pn - 9) * 4 + wc) * 64 + 4 * fq; pitch = 2048; }
#pragma unroll
            for (int ai = 0; ai < 2; ++ai) {
                const int prow = (pm & 7) * 4 + 2 * ai + wr;
                f32x4 c0 = (f32x4){1.f, 1.f, 1.f, 1.f}, s0 = (f32x4){0.f, 0.f, 0.f, 0.f};
                if (!isctx) { c0 = *(const f32x4*)(rope + prow * 16 + 4 * fq); s0 = *(const f32x4*)(rope + 1024 + prow * 16 + 4 * fq); }
#pragma unroll
                for (int m = 0; m < 4; ++m) {
                    f32x4 a0 = acc[ai][0][m][0], a1 = acc[ai][0][m][1], b0 = acc[ai][1][m][0], b1 = acc[ai][1][m][1];
                    float s = (dot4(a0) + dot4(a1)) + (dot4(b0) + dot4(b1));
                    s += __shfl_xor(s, 16); s += __shfl_xor(s, 32);
                    const float rstd = rsqrtf(s * (1.f / 64.f) + EPS) * osc;
                    a0 = a0 * rstd * g00; a1 = a1 * rstd * g01; b0 = b0 * rstd * g10; b1 = b1 * rstd * g11;
                    f32x4 c1 = (f32x4){1.f, 1.f, 1.f, 1.f}, s1 = (f32x4){0.f, 0.f, 0.f, 0.f};
                    if (!isctx) { const int pcol = 16 * m + fr; c1 = *(const f32x4*)(rope + pcol * 16 + 4 * fq); s1 = *(const f32x4*)(rope + 1024 + pcol * 16 + 4 * fq); }
                    const f32x4 o00 = a0 * c0 - a1 * s0, o01 = a1 * c0 + a0 * s0, o10 = b0 * c1 - b1 * s1, o11 = b1 * c1 + b0 * s1;
                    bf16_t* dst = dbase + (size_t)(rloc + 128 * ai + 16 * m) * pitch;
                    *(u32x2*)(dst) = pk4(o00); *(u32x2*)(dst + 16) = pk4(o01); *(u32x2*)(dst + 32) = pk4(o10); *(u32x2*)(dst + 48) = pk4(o11);
                    asm volatile("" ::: "memory");
                }
            }
        } else if (pn == 8) {
            if (wc == 0) {
                const f32x4 bA = *(const f32x4*)(dt_bias + 8 * fq), bB = *(const f32x4*)(dt_bias + 8 * fq + 4);
#pragma unroll
                for (int ai = 0; ai < 2; ++ai)
#pragma unroll
                    for (int m = 0; m < 4; ++m) { const size_t row = (size_t)pm * 256 + rloc + 128 * ai + 16 * m;
                        f32x4 v0 = acc[ai][0][m][0] + bA, v1 = acc[ai][0][m][1] + bB;
#pragma unroll
                        for (int e = 0; e < 4; ++e) { v0[e] = v0[e] > 20.f ? v0[e] : log1pf(__expf(v0[e])); v1[e] = v1[e] > 20.f ? v1[e] : log1pf(__expf(v1[e])); }
                        *(f32x4*)(DT + row * 32 + 8 * fq) = v0; *(f32x4*)(DT + row * 32 + 8 * fq + 4) = v1; asm volatile("" ::: "memory"); }
            }
        } else {
            bf16_t* dbase; size_t pitch; bool act = false;
            const int cin = wc * 32 + 8 * fq;
            if (pn == 1) { dbase = VB + ((size_t)bb * KVL + pos0) * 256 + cin; pitch = 256; }
            else if (pn < 8) { dbase = XBC + (size_t)pm * 256 * CONVC + (pn - 2) * 256 + cin; pitch = CONVC; }
            else if (pn < 17) { dbase = YQ + (size_t)pm * 256 * 2048 + (pn - 13) * 256 + cin; pitch = 2048; act = true; }
            else { dbase = Z + (size_t)pm * 256 * 1024 + (pn - 17) * 256 + cin; pitch = 1024; act = true; }
#pragma unroll
            for (int ai = 0; ai < 2; ++ai)
#pragma unroll
                for (int m = 0; m < 4; ++m) { bf16_t* dst = dbase + (size_t)(rloc + 128 * ai + 16 * m) * pitch;
#pragma unroll
                    for (int bj = 0; bj < 2; ++bj) { f32x4 v0 = acc[ai][bj][m][0], v1 = acc[ai][bj][m][1];
                        if (act) {
#pragma unroll
                            for (int e = 0; e < 4; ++e) { v0[e] = silu1(v0[e]); v1[e] = silu1(v1[e]); } }
                        u32x4 w; w.x = cvt_pk_bf16(v0[0], v0[1]); w.y = cvt_pk_bf16(v0[2], v0[3]); w.z = cvt_pk_bf16(v1[0], v1[1]); w.w = cvt_pk_bf16(v1[2], v1[3]);
                        *(u32x4*)(dst + bj * HALF) = w; } asm volatile("" ::: "memory"); }
        }
    }
};
struct Epi2 {
    static constexpr bool PERM = false, AFTER_DRAIN = false, MIDK = true;
    const float* x; const float* mod; const float* fg; float* out; unsigned long long* xbuf; unsigned* cnt; unsigned* tmo; const PG8_LAS float* rstd_tab; PG8_LAS float* exl;
    __device__ __forceinline__ void midk(f32x4 (&acc)[2][2][4][2], int ui, int wr, int fr) const {
#pragma unroll
        for (int ai = 0; ai < 2; ++ai)
#pragma unroll
            for (int m = 0; m < 4; ++m) { const float r = rstd_tab[ui * 256 + 128 * ai + 64 * wr + 16 * m + fr];
#pragma unroll
                for (int bj = 0; bj < 2; ++bj)
#pragma unroll
                    for (int n = 0; n < 2; ++n) acc[ai][bj][m][n] *= r; }
    }
    __device__ __forceinline__ void operator()(f32x4 (&acc)[2][2][4][2], const Unit& u, int wr, int wc, int fr_in, int fq_in) const {
        int fr = fr_in, fq = fq_in; asm volatile("" : "+v"(fr), "+v"(fq));
        const int lane = mk_lane(); const int tid = (wr * 4 + wc) * 64 + lane;
        const int b = u.pm >> 3, col0 = u.pn * BM + wc * 32 + 4 * fq;
        PG8_LAS float* P = exl; PG8_LAS float* S = exl + 1024;
        { f32x4 gv[2][2];
#pragma unroll
          for (int bj = 0; bj < 2; ++bj)
#pragma unroll
            for (int n = 0; n < 2; ++n) gv[bj][n] = *(const f32x4*)(mod + (size_t)b * 3072 + 2048 + col0 + bj * HALF + n * 16);
#pragma unroll
          for (int ai = 0; ai < 2; ++ai)
#pragma unroll
            for (int m = 0; m < 4; ++m) { const int rt = 128 * ai + 64 * wr + 16 * m + fr; const size_t off = ((size_t)u.pm * BM + rt) * 1024 + col0; float q = 0.f;
#pragma unroll
                for (int bj = 0; bj < 2; ++bj)
#pragma unroll
                    for (int n = 0; n < 2; ++n) { const f32x4 xv = *(const f32x4*)(x + off + bj * HALF + n * 16); const f32x4 o = xv + gv[bj][n] * acc[ai][bj][m][n]; acc[ai][bj][m][n] = o; q += dot4(o); }
                q += __shfl_xor(q, 16); q += __shfl_xor(q, 32);
                if (fq == 0) P[rt * 4 + wc] = q;
                if (m == 3) asm volatile("" ::: "memory"); } }
        asm volatile("s_waitcnt lgkmcnt(0)" ::: "memory"); __builtin_amdgcn_s_barrier(); asm volatile("" ::: "memory");
        if (tid < 256) {
            const f32x4 p = *(const PG8_LAS f32x4*)(P + tid * 4); const float s = (p[0] + p[1]) + (p[2] + p[3]);
            __hip_atomic_store((float*)xbuf + ((size_t)u.pm * BM + tid) * 4 + u.pn, s, __ATOMIC_RELAXED, __HIP_MEMORY_SCOPE_AGENT);
        }
        asm volatile("s_waitcnt vmcnt(0)" ::: "memory");
        if (tid < 256 && lane == 0) __hip_atomic_fetch_add(cnt + 64 * u.pm, 1u, __ATOMIC_RELAXED, __HIP_MEMORY_SCOPE_AGENT);
        if (tid < 64) {
            unsigned sp = 0;
            while ((unsigned)__builtin_amdgcn_readfirstlane(__hip_atomic_load(cnt + 64 * u.pm, __ATOMIC_RELAXED, __HIP_MEMORY_SCOPE_AGENT)) < 16u) {
                __builtin_amdgcn_s_sleep(2); if (++sp > (1u << 22)) { if (lane == 0) __hip_atomic_store(tmo, 1u, __ATOMIC_RELAXED, __HIP_MEMORY_SCOPE_AGENT); break; } }
        }
        asm volatile("s_waitcnt vmcnt(0) lgkmcnt(0)" ::: "memory"); __builtin_amdgcn_s_barrier(); asm volatile("" ::: "memory");
        if (tid < 256) {
            const unsigned long long* sl = xbuf + ((size_t)u.pm * BM + tid) * 2;
            const unsigned long long w0 = __hip_atomic_load(sl, __ATOMIC_RELAXED, __HIP_MEMORY_SCOPE_AGENT), w1 = __hip_atomic_load(sl + 1, __ATOMIC_RELAXED, __HIP_MEMORY_SCOPE_AGENT);
            const float s = (__uint_as_float((unsigned)w0) + __uint_as_float((unsigned)(w0 >> 32))) + (__uint_as_float((unsigned)w1) + __uint_as_float((unsigned)(w1 >> 32)));
            S[tid] = rsqrtf(s * (1.f / 1024.f) + EPS);
        }
        asm volatile("s_waitcnt lgkmcnt(0)" ::: "memory"); __builtin_amdgcn_s_barrier(); asm volatile("" ::: "memory");
        { f32x4 fv[2][2];
#pragma unroll
          for (int bj = 0; bj < 2; ++bj)
#pragma unroll
            for (int n = 0; n < 2; ++n) fv[bj][n] = *(const f32x4*)(fg + col0 + bj * HALF + n * 16);
#pragma unroll
          for (int ai = 0; ai < 2; ++ai)
#pragma unroll
            for (int m = 0; m < 4; ++m) { const int rt = 128 * ai + 64 * wr + 16 * m + fr; const size_t off = ((size_t)u.pm * BM + rt) * 1024 + col0; const float r = S[rt];
#pragma unroll
                for (int bj = 0; bj < 2; ++bj)
#pragma unroll
                    for (int n = 0; n < 2; ++n) *(f32x4*)(out + off + bj * HALF + n * 16) = acc[ai][bj][m][n] * r * fv[bj][n];
                if (m & 1) asm volatile("" ::: "memory"); } }
    }
};
}
#define GAS __attribute__((address_space(1)))
#define LAS __attribute__((address_space(3)))
typedef unsigned v4u __attribute__((ext_vector_type(4)));
typedef GAS unsigned gu32;
typedef GAS unsigned long long gu64;
#define RLX_AGENT __ATOMIC_RELAXED, __HIP_MEMORY_SCOPE_AGENT
#define LDS_WAIT() asm volatile("s_waitcnt lgkmcnt(0)" ::: "memory")
#define VM_WAIT() asm volatile("s_waitcnt vmcnt(0)" ::: "memory")
__device__ __forceinline__ unsigned long long rt() { return __builtin_amdgcn_s_memrealtime(); }
typedef float f32x2_pk __attribute__((ext_vector_type(2))); typedef __bf16 bf16x2_pk __attribute__((ext_vector_type(2)));
__device__ __forceinline__ unsigned pk2(float lo, float hi) { const f32x2_pk v = {lo, hi}; return __builtin_bit_cast(unsigned, __builtin_convertvector(v, bf16x2_pk)); }
#define XB_TMO      128
#define XB_XCNT(j)  (256  + 64 * (j))
#define XB_XSUB(j)  (1280 + 64 * (j))
#define XB_XGEN(j)  (2304 + 64 * (j))
#define XB_TOP      3328
#define XB_TOPGEN   3392
#define XCD_BAR_WORDS 3456
#define XB_SPIN_CAP (1u << 22)

__device__ __forceinline__ unsigned xb_ld(unsigned* p)              { return __hip_atomic_load(p, __ATOMIC_RELAXED, __HIP_MEMORY_SCOPE_AGENT); }
__device__ __forceinline__ unsigned xb_add(unsigned* p, unsigned v) { return __hip_atomic_fetch_add(p, v, __ATOMIC_RELAXED, __HIP_MEMORY_SCOPE_AGENT); }
__device__ __forceinline__ unsigned xb_xcc_id() { return (unsigned)__builtin_amdgcn_s_getreg((3 << 11) | 20) & 0xFu; }
#define XB_SPIN(cond, bar) do { unsigned _sp = 0; while (cond) { __builtin_amdgcn_s_sleep(1); \
    if ((++_sp & 255u) == 0u) { if (xb_ld(&(bar)[XB_TMO])) break; if (_sp > XB_SPIN_CAP) { atomicAdd(&(bar)[XB_TMO], 1u); break; } } } } while (0)

struct XcdBarrier {
    unsigned* bar; unsigned x;
    volatile LAS unsigned* st;
};

__device__ __forceinline__ XcdBarrier xcd_barrier_post(unsigned* bar, volatile LAS unsigned* st, bool leader) {
    XcdBarrier b; b.bar = bar; b.x = xb_xcc_id(); b.st = st;
    if (leader) (void)xb_add(&bar[XB_XCNT(b.x)], 1u);
    return b;
}
__device__ __forceinline__ void xcd_barrier_complete(unsigned* bar, unsigned x, unsigned& nloc, unsigned& nx) {
    const unsigned G = gridDim.x * gridDim.y * gridDim.z;
    unsigned sum, cnt, mine, sp = 0u;
    for (;;) {
        sum = 0u; cnt = 0u; mine = 0u;
#pragma unroll
        for (unsigned j = 0; j < 16; ++j) { const unsigned c = xb_ld(&bar[XB_XCNT(j)]); sum += c; cnt += (c > 0u) ? 1u : 0u; mine = (j == x) ? c : mine; }
        if (sum == G) break;
        __builtin_amdgcn_s_sleep(1);
        if ((++sp & 255u) == 0u) { if (xb_ld(&bar[XB_TMO])) break; if (sp > XB_SPIN_CAP) { atomicAdd(&bar[XB_TMO], 1u); break; } }
    }
    nloc = mine > 0u ? mine : 1u; nx = cnt > 0u ? cnt : 1u;
}

__device__ __forceinline__ void xcd_barrier(const XcdBarrier& b, bool leader) {
    asm volatile("s_waitcnt vmcnt(0)" ::: "memory");
    __syncthreads();
    if (leader) {
        unsigned* bar = b.bar;
        __builtin_amdgcn_s_waitcnt(0);
        unsigned nloc = b.st[0], nx = b.st[1];
        if (nloc == 0u) { xcd_barrier_complete(bar, b.x, nloc, nx); b.st[0] = nloc; b.st[1] = nx; }
        const unsigned old = xb_add(&bar[XB_XSUB(b.x)], 1u);
        const unsigned gen = old / nloc;
        if (old + 1u == (gen + 1u) * nloc) {
            __builtin_amdgcn_fence(__ATOMIC_RELEASE, "agent");
            asm volatile("s_waitcnt vmcnt(0)" ::: "memory");
            const unsigned og = xb_add(&bar[XB_TOP], 1u);
            const unsigned tg = og / nx;
            if (og + 1u == (tg + 1u) * nx) xb_add(&bar[XB_TOPGEN], 1u);
            else XB_SPIN(xb_ld(&bar[XB_TOPGEN]) == tg, bar);
            __builtin_amdgcn_fence(__ATOMIC_ACQUIRE, "agent");
            xb_add(&bar[XB_XGEN(b.x)], 1u);
            asm volatile("s_waitcnt vmcnt(0)" ::: "memory");
        } else {
            XB_SPIN(xb_ld(&bar[XB_XGEN(b.x)]) == gen, bar);
            __builtin_amdgcn_fence(__ATOMIC_ACQUIRE, "agent");
            asm volatile("s_waitcnt vmcnt(0)" ::: "memory");
        }
    }
    __syncthreads();
}

typedef float f32x4 __attribute__((ext_vector_type(4)));
constexpr int NWAVES = 8;
__device__ __forceinline__ float wave_sum(float v) {
#pragma unroll
    for (int o = 1; o < 64; o <<= 1) v += __shfl_xor(v, o);
    return v;
}
__device__ __forceinline__ float dot4g(const f32x4 a) { return (a[0] * a[0] + a[1] * a[1]) + (a[2] * a[2] + a[3] * a[3]); }
__device__ __forceinline__ void p0_bt1_item(const float* W, bf16* WT, LAS float* scr, int item, int lane) {
    const int kb = item / 168, vb = item % 168, k0 = 64 * kb, v0 = 32 * vb;
    const int a = vcol_actual(v0 + (lane & 31));
#pragma unroll 8
    for (int i = 0; i < 32; ++i) { const int kk = 2 * i + (lane >> 5); scr[kk * 33 + (lane & 31)] = a >= 0 ? W[(size_t)(k0 + kk) * PROJ + a] : 0.f; }
    LDS_WAIT(); asm volatile("" ::: "memory");
    const int c = lane & 7;
#pragma unroll
    for (int j = 0; j < 4; ++j) { const int n = (lane >> 3) + 8 * j; const LAS float* s = scr + (8 * c) * 33 + n;
        v4u o; o.x = pk2(s[0 * 33], s[1 * 33]); o.y = pk2(s[2 * 33], s[3 * 33]); o.z = pk2(s[4 * 33], s[5 * 33]); o.w = pk2(s[6 * 33], s[7 * 33]);
        *(GAS v4u*)(WT + (size_t)(v0 + n) * 1024 + k0 + 8 * c) = o; }
    LDS_WAIT(); asm volatile("" ::: "memory");
}
__device__ __forceinline__ void p0_bt2_item(const float* W, const float* sg, bf16* WT, LAS float* scr, int item, int lane) {
    const int kb = item >> 5, nb = item & 31, kk0 = 64 * kb, n0 = 32 * nb;
#pragma unroll 8
    for (int i = 0; i < 32; ++i) { const int kk = 2 * i + (lane >> 5), kq = kk0 + kk; const int ks = kq < 1024 ? 1024 + kq : kq - 1024;
        float v = W[(size_t)ks * 1024 + n0 + (lane & 31)]; if (kq < 1024) v *= sg[kq]; scr[kk * 33 + (lane & 31)] = v; }
    LDS_WAIT(); asm volatile("" ::: "memory");
    const int c = lane & 7;
#pragma unroll
    for (int j = 0; j < 4; ++j) { const int n = (lane >> 3) + 8 * j; const LAS float* s = scr + (8 * c) * 33 + n;
        v4u o; o.x = pk2(s[0 * 33], s[1 * 33]); o.y = pk2(s[2 * 33], s[3 * 33]); o.z = pk2(s[4 * 33], s[5 * 33]); o.w = pk2(s[6 * 33], s[7 * 33]);
        *(GAS v4u*)(WT + (size_t)(n0 + n) * 2048 + kk0 + 8 * c) = o; }
    LDS_WAIT(); asm volatile("" ::: "memory");
}
__device__ __forceinline__ void p0_mod_block(const float* c, const float* c_ctx, const float* ada_w, const float* ada_b, float* mod, LAS float* ldsf, int cb, int tid, int lane, int wave) {
    LAS float* sil = ldsf; LAS float* red = ldsf + 33 * 256;
    float acc[33];
#pragma unroll
    for (int b = 0; b < 33; ++b) acc[b] = 0.f;
    for (int q = 0; q < 4; ++q) {
        __syncthreads();
        for (int e = tid; e < 33 * 256; e += NWAVES * 64) { const int b = e >> 8, k = e & 255; const float v = b < 32 ? c[b * 1024 + q * 256 + k] : c_ctx[q * 256 + k]; sil[e] = siluf(v); }
        __syncthreads();
#pragma unroll 2
        for (int k4 = 0; k4 < 8; ++k4) { const int kl = wave * 32 + 4 * k4; const float* wp = ada_w + (size_t)(q * 256 + kl) * 3072 + cb * 64 + lane;
            const float w0 = wp[0], w1 = wp[3072], w2 = wp[2 * 3072], w3 = wp[3 * 3072];
#pragma unroll
            for (int b = 0; b < 33; ++b) { const f32x4 sv = *(const LAS f32x4*)(sil + b * 256 + kl); acc[b] += (sv[0] * w0 + sv[1] * w1) + (sv[2] * w2 + sv[3] * w3); } }
    }
#pragma unroll
    for (int b = 0; b < 33; ++b) red[(wave * 33 + b) * 64 + lane] = acc[b];
    __syncthreads();
    for (int e = tid; e < 33 * 64; e += NWAVES * 64) { const int b = e >> 6, col = e & 63; float s = 0.f;
#pragma unroll
        for (int w = 0; w < 8; ++w) s += red[(w * 33 + b) * 64 + col];
        mod[b * 3072 + cb * 64 + col] = s + ada_b[cb * 64 + col]; }
    __syncthreads();
}
__device__ __forceinline__ const float* p1_src(const float* x, const float* ctx, int m) { return m < ML ? x + (size_t)m * DM : ctx + (size_t)(m - ML) * DM; }
__device__ __forceinline__ void p1_load4(f32x4 (&v)[4][4], const float* x, const float* ctx, int m0, int lane) {
#pragma unroll
    for (int r = 0; r < 4; ++r) { const GAS f32x4* xr = (const GAS f32x4*)p1_src(x, ctx, m0 + r) + 2 * lane;
#pragma unroll
        for (int j = 0; j < 2; ++j) { v[r][2 * j] = xr[128 * j]; v[r][2 * j + 1] = xr[128 * j + 1]; } }
}
__device__ __forceinline__ void p1_proc4(const f32x4 (&v)[4][4], const float* mod, const float* ng, bf16* H, int m0, int lane) {
#pragma unroll
    for (int r = 0; r < 4; ++r) { const int m = m0 + r; const float* md = mod + (size_t)(m < ML ? m / SEQ : 32) * 3072;
        float s = 0.f;
#pragma unroll
        for (int j = 0; j < 4; ++j) s += dot4g(v[r][j]);
        const float rstd = rsqrtf(wave_sum(s) * (1.f / DM) + EPS);
        GAS v4u* o16 = (GAS v4u*)(H + (size_t)m * DM) + lane;
#pragma unroll
        for (int j = 0; j < 2; ++j) { const int k = 8 * lane + 512 * j; f32x4 h[2];
#pragma unroll
            for (int q = 0; q < 2; ++q) { const f32x4 g = *(const f32x4*)(ng + k + 4 * q), sc = *(const f32x4*)(md + 1024 + k + 4 * q), sh = *(const f32x4*)(md + k + 4 * q);
                h[q] = v[r][2 * j + q] * rstd * g * (sc + 1.f) + sh; }
            v4u o; o.x = pk2(h[0][0], h[0][1]); o.y = pk2(h[0][2], h[0][3]); o.z = pk2(h[1][0], h[1][1]); o.w = pk2(h[1][2], h[1][3]);
            o16[64 * j] = o; }
    }
}
__device__ __forceinline__ void conv_phase(const bf16* XBC, const float* cw, const float* cb, bf16* XC, int bx, int G, int tid) {
    if (tid < 384) {
        const int cg = tid % 192, sub = tid / 192;
        f32x4 w[5][2], bias[2];
#pragma unroll
        for (int j = 0; j < 5; ++j) { w[j][0] = *(const f32x4*)(cw + j * CONVC + cg * 8); w[j][1] = *(const f32x4*)(cw + j * CONVC + cg * 8 + 4); }
        bias[0] = *(const f32x4*)(cb + cg * 8); bias[1] = *(const f32x4*)(cb + cg * 8 + 4);
        for (int seg = bx; seg < MT / 32; seg += G) {
            const int row0 = seg * 32 + sub * 16; int t0, len;
            if (row0 < ML) { t0 = row0 % SEQ; len = SEQ; } else { t0 = (row0 - ML) % CTXL; len = CTXL; }
            const bf16* src = XBC + (size_t)row0 * CONVC + cg * 8; bf16* dst = XC + (size_t)row0 * CONVC + cg * 8;
            f32x4 r[5][2];
#pragma unroll
            for (int j = 0; j < 5; ++j) { const int tt = t0 + j - 2; v4u u = (v4u){0u, 0u, 0u, 0u};
                if (tt >= 0 && tt < len) u = *(const v4u*)(src + (ptrdiff_t)(j - 2) * CONVC);
                r[j][0] = (f32x4){__uint_as_float(u.x << 16), __uint_as_float(u.x & 0xffff0000u), __uint_as_float(u.y << 16), __uint_as_float(u.y & 0xffff0000u)};
                r[j][1] = (f32x4){__uint_as_float(u.z << 16), __uint_as_float(u.z & 0xffff0000u), __uint_as_float(u.w << 16), __uint_as_float(u.w & 0xffff0000u)}; }
#pragma unroll
            for (int i = 0; i < 16; ++i) {
                f32x4 a0 = bias[0], a1 = bias[1];
#pragma unroll
                for (int j = 0; j < 5; ++j) { a0 += w[j][0] * r[j][0]; a1 += w[j][1] * r[j][1]; }
#pragma unroll
                for (int e = 0; e < 4; ++e) { a0[e] = siluf(a0[e]); a1[e] = siluf(a1[e]); }
                v4u o; o.x = pk2(a0[0], a0[1]); o.y = pk2(a0[2], a0[3]); o.z = pk2(a1[0], a1[1]); o.w = pk2(a1[2], a1[3]);
                *(v4u*)(dst + (size_t)i * CONVC) = o;
#pragma unroll
                for (int j = 0; j < 4; ++j) { r[j][0] = r[j + 1][0]; r[j][1] = r[j + 1][1]; }
                const int tt = t0 + i + 3; v4u u = (v4u){0u, 0u, 0u, 0u};
                if (i < 15 && tt < len) u = *(const v4u*)(src + (size_t)(i + 3) * CONVC);
                r[4][0] = (f32x4){__uint_as_float(u.x << 16), __uint_as_float(u.x & 0xffff0000u), __uint_as_float(u.y << 16), __uint_as_float(u.y & 0xffff0000u)};
                r[4][1] = (f32x4){__uint_as_float(u.z << 16), __uint_as_float(u.z & 0xffff0000u), __uint_as_float(u.w << 16), __uint_as_float(u.w & 0xffff0000u)};
            }
        }
    }
}
__device__ __forceinline__ void ssd_item_naive(int b, int h, const bf16* XC, const float* DT, const bf16* Z, const float* a_log, const float* d_skip, bf16* YQ, float* SSQ, LAS float* ysq, int tid) {
    const int p = tid >> 3, nc = tid & 7, g = h >> 3;
    for (int dd = 0; dd < 2; ++dd) { const int d = 1 - dd;
        const float a_neg = -expf(a_log[d * 16 + h]);
        float S[16];
#pragma unroll
        for (int j = 0; j < 16; ++j) S[j] = 0.f;
        for (int seq = 0; seq < 2; ++seq) { const int len = seq == 0 ? CTXL : SEQ; const size_t rbase = seq == 0 ? (size_t)ML + (size_t)b * CTXL : (size_t)b * SEQ;
            for (int st = 0; st < len; ++st) { const int t = d ? len - 1 - st : st; const size_t row = rbase + t;
                const float dt = DT[row * 32 + d * 16 + h]; const float dec = expf(dt * a_neg);
                const float xs = bf2f(XC[row * CONVC + h * 64 + p]); const float X = xs * dt;
                const v4u b0 = *(const v4u*)(XC + row * CONVC + 1024 + g * 128 + nc * 16), b1 = *(const v4u*)(XC + row * CONVC + 1024 + g * 128 + nc * 16 + 8);
                const v4u c0 = *(const v4u*)(XC + row * CONVC + 1280 + g * 128 + nc * 16), c1 = *(const v4u*)(XC + row * CONVC + 1280 + g * 128 + nc * 16 + 8);
                const unsigned bw[8] = {b0.x, b0.y, b0.z, b0.w, b1.x, b1.y, b1.z, b1.w}, cw8[8] = {c0.x, c0.y, c0.z, c0.w, c1.x, c1.y, c1.z, c1.w};
                float y = 0.f;
#pragma unroll
                for (int j = 0; j < 8; ++j) { S[2 * j] = S[2 * j] * dec + X * __uint_as_float(bw[j] << 16); y += __uint_as_float(cw8[j] << 16) * S[2 * j];
                    S[2 * j + 1] = S[2 * j + 1] * dec + X * __uint_as_float(bw[j] & 0xffff0000u); y += __uint_as_float(cw8[j] & 0xffff0000u) * S[2 * j + 1]; }
                y += __shfl_xor(y, 1); y += __shfl_xor(y, 2); y += __shfl_xor(y, 4);
                if (seq == 1) {
                    bf16* yp = YQ + row * 2048 + h * 64 + p;
                    if (d == 1) { if (nc == 0) *yp = (bf16)f2bf(y); }
                    else {
                        if (nc == 0) { const float yt = y + bf2f(*yp) + d_skip[h] * xs; const float yg = yt * bf2f(Z[row * 1024 + h * 64 + p]); *yp = (bf16)f2bf(yg); ysq[p] = yg * yg; }
                        __syncthreads();
                        if (tid < 64) { float q = ysq[tid]; q = wave_sum(q); if (tid == 0) SSQ[row * 16 + h] = q; }
                        __syncthreads();
                    }
                }
            }
        }
        VM_WAIT(); __syncthreads();
    }
}

namespace attn_body {
using bf16=__hip_bfloat16;
using bf16x8=__attribute__((ext_vector_type(8)))short;
using s16x4=__attribute__((ext_vector_type(4)))short;
using f32x16=__attribute__((ext_vector_type(16)))float;
using u32x4=__attribute__((ext_vector_type(4)))unsigned;
constexpr int D=64,QP=2048,KP=256;
constexpr int NW=8,QBLK=32,QB=QBLK*NW,KVBLK=64,NQB=SEQ/QB;
constexpr int ATTN_UNIT_ROWS=QB;
__device__ __forceinline__ int crow(int r,int hi){return (r&3)+8*(r>>2)+4*hi;}
#define SBAR() __builtin_amdgcn_sched_barrier(0)
__device__ __forceinline__ void cmask(f32x16&p0,f32x16&p1,int jb,int qrel,int hi){
  const float NEG=-INFINITY; int kb=64*jb+4*hi;
  #pragma unroll
  for(int r=0;r<16;++r){int kv=kb+(r&3)+8*(r>>2); if(kv>qrel)p0[r]=NEG; if(kv+32>qrel)p1[r]=NEG;}
}

constexpr int NSLOT=3, SLOTB=8192;
constexpr int LDS_K=0, LDS_V=NSLOT*SLOTB, LDS_WS=2*NSLOT*SLOTB, LDS_OST=LDS_WS+NW*64*4, LDS_BYTES=LDS_OST+NW*8192;
constexpr float C2=0.125f*1.4426950408889634f;
__device__ __forceinline__ void glds16(const void*gsrc,unsigned lds_dst){unsigned keep;
  asm volatile("s_mov_b32 %0, m0\n\ts_mov_b32 m0, %2\n\ts_nop 0\n\tglobal_load_lds_dwordx4 %1, off\n\ts_mov_b32 m0, %0":"=&s"(keep):"v"(gsrc),"s"(lds_dst):"memory");}
__device__ __forceinline__ float max3f(float a,float b,float c){float r;asm("v_max3_f32 %0, %1, %2, %3":"=v"(r):"v"(a),"v"(b),"v"(c));return r;}
__device__ __forceinline__ float max2f(float a,float b){float r;asm("v_max_f32_e32 %0, %1, %2":"=v"(r):"v"(a),"v"(b));return r;}
__device__ __forceinline__ float fadd_s(float a,float b){float r;asm("v_add_f32_e32 %0, %1, %2":"=v"(r):"v"(a),"v"(b));return r;}
__device__ __forceinline__ float fsub_s(float a,float b){float r;asm("v_sub_f32_e32 %0, %1, %2":"=v"(r):"v"(a),"v"(b));return r;}
typedef float f32x2_t __attribute__((ext_vector_type(2))); typedef float f32x4_t __attribute__((ext_vector_type(4))); typedef __bf16 bf16x2_t __attribute__((ext_vector_type(2)));
__device__ __forceinline__ unsigned cvtpk_s(float lo,float hi){f32x2_t v={lo,hi};bf16x2_t b=__builtin_convertvector(v,bf16x2_t);return __builtin_bit_cast(unsigned,b);}
#define WAIT_BAR(N) asm volatile("s_waitcnt vmcnt(" #N ") lgkmcnt(0)\n\ts_barrier":::"memory")

__device__ __forceinline__ void qkt(f32x16&p0,f32x16&p1,const char*Kslot,const bf16x8*qr,const f32x16&negm,int r32,int hi){
  const char*kb=Kslot+hi*1024+r32*16;
  #pragma unroll
  for(int d0=0;d0<4;++d0){
    const bf16x8 b0=*reinterpret_cast<const bf16x8*>(kb+d0*2048);
    const bf16x8 b1=*reinterpret_cast<const bf16x8*>(kb+d0*2048+512);
    if(d0==0){p0=__builtin_amdgcn_mfma_f32_32x32x16_bf16(b0,qr[0],negm,0,0,0);p1=__builtin_amdgcn_mfma_f32_32x32x16_bf16(b1,qr[0],negm,0,0,0);}
    else{p0=__builtin_amdgcn_mfma_f32_32x32x16_bf16(b0,qr[d0],p0,0,0,0);p1=__builtin_amdgcn_mfma_f32_32x32x16_bf16(b1,qr[d0],p1,0,0,0);}}
}
typedef __attribute__((address_space(3))) const char* lds_cptr;
typedef short v4i16_t __attribute__((ext_vector_type(4)));
__device__ __forceinline__ void kload8(bf16x8*kf,lds_cptr kp){
  kf[0]=*(const __attribute__((address_space(3))) bf16x8*)(kp);      kf[1]=*(const __attribute__((address_space(3))) bf16x8*)(kp+512);
  kf[2]=*(const __attribute__((address_space(3))) bf16x8*)(kp+2048); kf[3]=*(const __attribute__((address_space(3))) bf16x8*)(kp+2560);
  kf[4]=*(const __attribute__((address_space(3))) bf16x8*)(kp+4096); kf[5]=*(const __attribute__((address_space(3))) bf16x8*)(kp+4608);
  kf[6]=*(const __attribute__((address_space(3))) bf16x8*)(kp+6144); kf[7]=*(const __attribute__((address_space(3))) bf16x8*)(kp+6656);
}
__device__ __forceinline__ void kload2(bf16x8*kf,lds_cptr kp,int j){ kf[2*j]=*(const __attribute__((address_space(3))) bf16x8*)(kp+j*2048); kf[2*j+1]=*(const __attribute__((address_space(3))) bf16x8*)(kp+j*2048+512); }
__device__ __forceinline__ s16x4 vtr(lds_cptr p){ return __builtin_bit_cast(s16x4,__builtin_amdgcn_ds_read_tr16_b64_v4i16((__attribute__((address_space(3))) v4i16_t*)p)); }
__device__ __forceinline__ float rowmax(const f32x16&p0,const f32x16&p1){
  float a=max3f(p0[0],p0[1],p1[0]),b=max3f(p0[2],p0[3],p1[1]);a=max3f(a,p1[2],p1[3]);
  #pragma unroll
  for(int r=4;r<16;r+=4){a=max3f(a,p0[r],p0[r+1]);b=max3f(b,p0[r+2],p0[r+3]);a=max3f(a,p1[r],p1[r+1]);b=max3f(b,p1[r+2],p1[r+3]);}
  const float m=max2f(a,b);
  auto rr=__builtin_amdgcn_permlane32_swap(__float_as_uint(m),__float_as_uint(m),false,false);
  return max2f(__uint_as_float(rr[0]),__uint_as_float(rr[1]));
}
__device__ __forceinline__ void pv(f32x16*o,int vb,bf16x8 pa0,bf16x8 pa1,bf16x8 pa2,bf16x8 pa3){
  #pragma unroll
  for(int d0=0;d0<2;++d0){s16x4 lo[4],hi[4];
    #pragma unroll
    for(int ks=0;ks<4;++ks){
      asm volatile("ds_read_b64_tr_b16 %0,%1 offset:%c2":"=&v"(lo[ks]):"v"(vb),"i"(d0*4096+ks*1024):"memory");
      asm volatile("ds_read_b64_tr_b16 %0,%1 offset:%c2":"=&v"(hi[ks]):"v"(vb),"i"(d0*4096+ks*1024+512):"memory");}
    asm volatile("s_waitcnt lgkmcnt(0)":::"memory");SBAR();
    #define PK(k) (bf16x8){lo[k][0],lo[k][1],lo[k][2],lo[k][3],hi[k][0],hi[k][1],hi[k][2],hi[k][3]}
    o[d0]=__builtin_amdgcn_mfma_f32_32x32x16_bf16(pa0,PK(0),o[d0],0,0,0);
    o[d0]=__builtin_amdgcn_mfma_f32_32x32x16_bf16(pa1,PK(1),o[d0],0,0,0);
    o[d0]=__builtin_amdgcn_mfma_f32_32x32x16_bf16(pa2,PK(2),o[d0],0,0,0);
    o[d0]=__builtin_amdgcn_mfma_f32_32x32x16_bf16(pa3,PK(3),o[d0],0,0,0);
    #undef PK
  }
}

#ifndef ATTN_STORE16
#define ATTN_STORE16(p,v) (*(u32x4*)(p)=(v))
#endif
template<int THRL> __device__ __forceinline__ void attn_unit(int b,int h,int qb,bf16*YQb,const bf16*__restrict__ K,const bf16*__restrict__ V,char*shm,int wid_in,float sbound,bf16x8 (&qr)[4],bool first,bool hasNext,int nb,int nh,int nqb,bf16*dummyO=nullptr){
  const int wid=wid_in; int lane=mk_lane(); asm volatile("":"+v"(lane)); const int tid=wid*64+lane,r32=lane&31,hi=lane>>5; (void)tid;
  const long rowbase=(long)b*SEQ; const int q0=qb*QB;
  const bf16*Qw=YQb+(rowbase+q0+wid*QBLK)*QP+1024+h*D;
  const bf16*Kh=K+(long)b*KVL*KP+(h>>2)*D,*Vh=V+(long)b*KVL*KP+(h>>2)*D;
  const unsigned lds0=(unsigned)(uintptr_t)shm;
  float*wsf=(float*)(shm+LDS_WS)+wid*64;
  const bf16*ksrc=Kh+(long)lane*KP+wid*8;
  const bf16*vsrc=Vh+(long)(16*(wid&3)+(lane>>2))*KP+(wid>>2)*32+(lane&3)*8;
  const unsigned kdst=lds0+LDS_K+wid*1024, vdst=lds0+LDS_V+wid*1024;
  #define DMA_K(t,slot) glds16(ksrc+(long)(t)*KVBLK*KP,(unsigned)__builtin_amdgcn_readfirstlane(kdst+(slot)))
  #define DMA_V(t,slot) glds16(vsrc+(long)(t)*KVBLK*KP,(unsigned)__builtin_amdgcn_readfirstlane(vdst+(slot)))
  const int vb0=(int)(lds0+LDS_V)+((lane>>4)&1)*32+(lane&3)*8+(4*hi+((lane&15)>>2))*64;
  const char*Kbase=shm+LDS_K; bf16x8 kf[8];
  const lds_cptr shm3=(lds_cptr)shm; const lds_cptr kp0=shm3+LDS_K+hi*1024+r32*16; const lds_cptr vp0=shm3+LDS_V+((lane>>4)&1)*32+(lane&3)*8+(4*hi+((lane&15)>>2))*64;
  constexpr int NT=KVL/KVBLK;
  if(first){ DMA_K(0,0);DMA_V(0,0);DMA_K(1,SLOTB);
    #pragma unroll
    for(int d0=0;d0<4;++d0)qr[d0]=*reinterpret_cast<const bf16x8*>(&Qw[(long)r32*QP+d0*16+hi*8]); }
  float l_reg=0.f;f32x16 o[2];o[0]=f32x16{};o[1]=f32x16{};f32x16 negm;
  #pragma unroll
  for(int r=0;r<16;++r)negm[r]=-sbound;
  asm volatile("":"+v"(negm));
  #define CMASK(P0,P1,t) do{}while(0)
  #define START(P0,P1) do{ _Pragma("unroll") for(int r=0;r<16;++r)P0[r]=__builtin_amdgcn_exp2f(P0[r]); }while(0)
  #define RESC() do{}while(0)
  f32x16 pA0,pA1,pB0,pB1;
  int sl_prev=0,sl_cur=0,sl_next=SLOTB;
  #define ROT() do{sl_prev=sl_cur;sl_cur=sl_next;sl_next=(sl_next==(NSLOT-1)*SLOTB)?0:sl_next+SLOTB;}while(0)
  if(first){ DMA_K(2,2*SLOTB);
    WAIT_BAR(3); }
  else { WAIT_BAR(0); }
  qkt(pA0,pA1,Kbase,qr,negm,r32,hi);asm volatile("s_nop 15\n\ts_nop 7":"+v"(pA0),"+v"(pA1));CMASK(pA0,pA1,0);
  START(pA0,pA1);
  _Pragma("unroll") for(int r=0;r<16;++r)pA1[r]=__builtin_amdgcn_exp2f(pA1[r]);
  WAIT_BAR(0);
  DMA_K(3,0);DMA_V(1,SLOTB);
  ROT();
  kload8(kf,kp0+sl_cur);
  WAIT_BAR(2);
  s16x4 vlo[8],vhi[8]; u32x4 pw0,pw1,pw2,pw3;
  #define PKW(P,B) cvtpk_s(P[B],P[B+1])
  #define PAF(k) __builtin_bit_cast(bf16x8,pw##k)
  #define VFR(i) (bf16x8){vlo[i][0],vlo[i][1],vlo[i][2],vlo[i][3],vhi[i][0],vhi[i][1],vhi[i][2],vhi[i][3]}
  #define PIN(x) asm volatile("":"+v"(x))
  #define MX3(a,b,c) __builtin_fmaxf(__builtin_fmaxf((a),(b)),(c))
  #define GAPA(MF,A0,A1,A2,A3,W0,W1,PW) do{ MF; sacc+=A0; sacc+=A1; sacc+=A2; sacc+=A3; PIN(sacc); W0; W1; PIN(PW); SBAR(); }while(0)
  #define EX(v) __builtin_amdgcn_exp2f(v)
  #define GAPB(MF,X,B) do{ MF; X[B]=EX(X[B]); X[B+1]=EX(X[B+1]); X[B+2]=EX(X[B+2]); X[B+3]=EX(X[B+3]); PIN(X); SBAR(); }while(0)
  #define VRD(i) do{ vlo[i]=vtr(vp_+(((i)>>2)*4096+((i)&3)*1024)); vhi[i]=vtr(vp_+(((i)>>2)*4096+((i)&3)*1024+512)); }while(0)
  #define KRD(G,j) do{ if(G){ kload2(kf,kp0+sl_next,j); SBAR(); } }while(0)
  #define STEP(C0,C1,P0,P1,t,GK,GV,GL) do{ SBAR(); \
    const lds_cptr vp_=vp0+sl_prev; \
    VRD(0); SBAR(); float sacc=(P0[0]+P0[1]); \
    GAPA(C0=__builtin_amdgcn_mfma_f32_32x32x16_bf16(kf[0],qr[0],negm,0,0,0), P0[2],P0[3],P0[4],P0[5],     pw0[0]=PKW(P0,0), pw0[1]=PKW(P0,2), pw0); \
    VRD(4); SBAR(); GAPA(C1=__builtin_amdgcn_mfma_f32_32x32x16_bf16(kf[1],qr[0],negm,0,0,0), P0[6],P0[7],P0[8],P0[9],     pw0[2]=PKW(P0,4), pw0[3]=PKW(P0,6), pw0); \
    VRD(1); SBAR(); GAPA(C0=__builtin_amdgcn_mfma_f32_32x32x16_bf16(kf[2],qr[1],C0,0,0,0),   P0[10],P0[11],P0[12],P0[13], pw1[0]=PKW(P0,8), pw1[1]=PKW(P0,10), pw1); \
    VRD(5); SBAR(); GAPA(C1=__builtin_amdgcn_mfma_f32_32x32x16_bf16(kf[3],qr[1],C1,0,0,0),   P0[14],P0[15],P1[0],P1[1],   pw1[2]=PKW(P0,12),pw1[3]=PKW(P0,14), pw1); \
    VRD(2); SBAR(); GAPA(C0=__builtin_amdgcn_mfma_f32_32x32x16_bf16(kf[4],qr[2],C0,0,0,0),   P1[2],P1[3],P1[4],P1[5],     pw2[0]=PKW(P1,0), pw2[1]=PKW(P1,2), pw2); \
    VRD(6); SBAR(); GAPA(C1=__builtin_amdgcn_mfma_f32_32x32x16_bf16(kf[5],qr[2],C1,0,0,0),   P1[6],P1[7],P1[8],P1[9],     pw2[2]=PKW(P1,4), pw2[3]=PKW(P1,6), pw2); \
    VRD(3); SBAR(); GAPA(C0=__builtin_amdgcn_mfma_f32_32x32x16_bf16(kf[6],qr[3],C0,0,0,0),   P1[10],P1[11],P1[12],P1[13], pw3[0]=PKW(P1,8), pw3[1]=PKW(P1,10), pw3); \
    VRD(7); SBAR(); GAPA(C1=__builtin_amdgcn_mfma_f32_32x32x16_bf16(kf[7],qr[3],C1,0,0,0),   P1[14],P1[15],0.f,0.f,       pw3[2]=PKW(P1,12),pw3[3]=PKW(P1,14), pw3); \
    l_reg+=sacc; \
    if(GK){DMA_K((t)+3,sl_cur);} if(GV){DMA_V((t)+1,sl_next);} \
    CMASK(C0,C1,t); \
    SBAR(); \
    GAPB(o[0]=__builtin_amdgcn_mfma_f32_32x32x16_bf16(PAF(0),VFR(0),o[0],0,0,0), C0,0); \
    GAPB(o[1]=__builtin_amdgcn_mfma_f32_32x32x16_bf16(PAF(0),VFR(4),o[1],0,0,0), C0,4); \
    KRD(GL,0); GAPB(o[0]=__builtin_amdgcn_mfma_f32_32x32x16_bf16(PAF(1),VFR(1),o[0],0,0,0), C0,8); \
    KRD(GL,1); GAPB(o[1]=__builtin_amdgcn_mfma_f32_32x32x16_bf16(PAF(1),VFR(5),o[1],0,0,0), C0,12); \
    KRD(GL,2); GAPB(o[0]=__builtin_amdgcn_mfma_f32_32x32x16_bf16(PAF(2),VFR(2),o[0],0,0,0), C1,0); \
    KRD(GL,3); GAPB(o[1]=__builtin_amdgcn_mfma_f32_32x32x16_bf16(PAF(2),VFR(6),o[1],0,0,0), C1,4); \
    GAPB(o[0]=__builtin_amdgcn_mfma_f32_32x32x16_bf16(PAF(3),VFR(3),o[0],0,0,0), C1,8); \
    GAPB(o[1]=__builtin_amdgcn_mfma_f32_32x32x16_bf16(PAF(3),VFR(7),o[1],0,0,0), C1,12); \
    }while(0)
  int t=1;
  #undef CMASK
  #define CMASK(P0,P1,t) do{}while(0)
  for(;t+5<NT;t+=2){
    STEP(pB0,pB1,pA0,pA1,t,true,true,true);     WAIT_BAR(2); RESC(); ROT();
    STEP(pA0,pA1,pB0,pB1,t+1,true,true,true);   WAIT_BAR(2); RESC(); ROT();
  }
  #undef CMASK
  #define CMASK(P0,P1,t) do{}while(0)
  #define ENDW(tt) do{ if((tt)+3<NT){WAIT_BAR(2);} else if((tt)+2<NT){WAIT_BAR(1);} else {WAIT_BAR(0);} }while(0)
  for(;t+1<NT;t+=2){
    STEP(pB0,pB1,pA0,pA1,t,(t+3<NT),(t+1<NT),(t+1<NT));       ENDW(t);   RESC(); ROT();
    STEP(pA0,pA1,pB0,pB1,t+1,(t+4<NT),(t+2<NT),(t+2<NT));     ENDW(t+1); RESC(); ROT();
  }
  const bf16*nQw=YQb+((long)nb*SEQ+nqb*QB+wid*QBLK)*QP+1024+nh*D;
  if(hasNext){ const bf16*nK=K+(long)nb*KVL*KP+(nh>>2)*D+(long)lane*KP+wid*8; const bf16*nV=V+(long)nb*KVL*KP+(nh>>2)*D+(long)(16*(wid&3)+(lane>>2))*KP+(wid>>2)*32+(lane&3)*8;
    glds16(nK,(unsigned)__builtin_amdgcn_readfirstlane(kdst)); glds16(nV,(unsigned)__builtin_amdgcn_readfirstlane(vdst)); glds16(nK+(long)KVBLK*KP,(unsigned)__builtin_amdgcn_readfirstlane(kdst+SLOTB)); glds16(nK+(long)2*KVBLK*KP,(unsigned)__builtin_amdgcn_readfirstlane(kdst+2*SLOTB)); }
  STEP(pB0,pB1,pA0,pA1,NT-1,false,false,false); RESC();
  { float sacc=pB0[0]+pB0[1]; _Pragma("unroll") for(int r=2;r<16;++r)sacc+=pB0[r]; _Pragma("unroll") for(int r=0;r<16;++r)sacc+=pB1[r]; l_reg+=sacc;
    pw0=(u32x4){PKW(pB0,0),PKW(pB0,2),PKW(pB0,4),PKW(pB0,6)};pw1=(u32x4){PKW(pB0,8),PKW(pB0,10),PKW(pB0,12),PKW(pB0,14)};pw2=(u32x4){PKW(pB1,0),PKW(pB1,2),PKW(pB1,4),PKW(pB1,6)};pw3=(u32x4){PKW(pB1,8),PKW(pB1,10),PKW(pB1,12),PKW(pB1,14)};
    SBAR(); pv(o,vb0+sl_cur,PAF(0),PAF(1),PAF(2),PAF(3)); }
  if(hasNext){
    #pragma unroll
    for(int d0=0;d0<4;++d0)qr[d0]=*reinterpret_cast<const bf16x8*>(&nQw[(long)r32*QP+d0*16+hi*8]); }
  #undef PKW
  #undef PAF
  #undef VFR
  #undef PIN
  #undef MX3
  #undef GAPA
  #undef GAPB
  #undef EX
  #undef VRD
  #undef KRD
  #undef STEP
  #undef ENDW
  {auto rr=__builtin_amdgcn_permlane32_swap(__float_as_uint(l_reg),__float_as_uint(l_reg),false,false);l_reg=__uint_as_float(rr[0])+__uint_as_float(rr[1]);}
  if(hi==0)wsf[32+r32]=l_reg;asm volatile("s_waitcnt lgkmcnt(0)":::"memory");
  float rli[16];
  #pragma unroll
  for(int r=0;r<16;++r)rli[r]=__builtin_amdgcn_rcpf(wsf[32+crow(r,hi)]);
  bf16*Ow=dummyO?dummyO+(long)(wid*QBLK)*QP:YQb+(rowbase+q0+wid*QBLK)*QP+1024+h*D; const bf16*Gw=YQb+(rowbase+q0+wid*QBLK)*QP+h*D;
  { float*stg=(float*)(shm+LDS_OST)+wid*2048;
    #pragma unroll
    for(int r=0;r<16;++r){const int orow=crow(r,hi);
      #pragma unroll
      for(int d0=0;d0<2;++d0)stg[orow*64+d0*32+r32]=o[d0][r]*rli[r];}
    asm volatile("s_waitcnt lgkmcnt(0)":::"memory");
    #pragma unroll
    for(int i=0;i<4;++i){const int row=i*8+(lane>>3),ch=lane&7; const float*sp=stg+row*64+ch*8;
      const f32x4_t a=*(const f32x4_t*)sp,c=*(const f32x4_t*)(sp+4); const u32x4 g=*(const u32x4*)(Gw+(long)row*QP+ch*8);
      u32x4 v; v[0]=cvtpk_s(a[0]*__uint_as_float(g[0]<<16),a[1]*__uint_as_float(g[0]&0xffff0000u)); v[1]=cvtpk_s(a[2]*__uint_as_float(g[1]<<16),a[3]*__uint_as_float(g[1]&0xffff0000u));
      v[2]=cvtpk_s(c[0]*__uint_as_float(g[2]<<16),c[1]*__uint_as_float(g[2]&0xffff0000u)); v[3]=cvtpk_s(c[2]*__uint_as_float(g[3]<<16),c[3]*__uint_as_float(g[3]&0xffff0000u));
      ATTN_STORE16(Ow+(long)row*QP+ch*8,v);} }
  asm volatile("s_waitcnt lgkmcnt(0)\n\ts_barrier":::"memory");
  #undef DMA_K
  #undef DMA_V
  #undef CMASK
  #undef START
  #undef RESC
  #undef ROT
}
constexpr int ATTN_LDS_BYTES=LDS_BYTES;
struct Order {
  int vcu, G; bool alt;
  __device__ __forceinline__ bool next(int i,int&b,int&h,int&qb)const{
    if(G==256&&!alt){ if(i>=16)return false; const int x=vcu>>5,j=vcu&31,rd=i>>2,k=i&3; const int pair=x*16+rd*4+(j>>3),un=(j&7)*4+k; b=pair>>2; h=(pair&3)*4+(un&3); qb=un>>2; return true; }
    const int U=i*G+vcu; if(U>=4096)return false; b=U>>7; h=(U>>3)&15; qb=U&7; return true; }
};
template<int THRL=8> __device__ __forceinline__ void attn_phase(char*lds,bf16*YQb,const bf16*K,const bf16*V,const Order&S,int wid,float sbound,bf16*dummyO=nullptr){
  int b,h,qb,nb=0,nh=0,nqb=0; bf16x8 qr[4]; bool first=true;
  bool has=S.next(0,b,h,qb);
  for(int i=0;has;++i){ const bool hn=S.next(i+1,nb,nh,nqb);
    attn_unit<THRL>(b,h,qb,YQb,K,V,lds,wid,sbound,qr,first,hn,nb,nh,nqb,dummyO);
    b=nb;h=nh;qb=nqb;has=hn;first=false; }
}
#undef SBAR
#undef WAIT_BAR
}

namespace ssd {
typedef short bf16x8 __attribute__((ext_vector_type(8)));
typedef short s16x4 __attribute__((ext_vector_type(4)));
typedef unsigned u32x2_t __attribute__((ext_vector_type(2)));
constexpr int O_B = 0, O_C = 32768, O_X = 65536, O_XD = 81920, O_ST = 98304, O_SM = 114688;
constexpr float LOG2E = 1.4426950408889634f;
struct Lofs { int fb[4], xb[4], bb, sw; };
__device__ __forceinline__ bf16x8 frag(const LAS unsigned char* img, int fbk, int t) { return *(const LAS bf16x8*)(img + fbk + t * 4096); }
__device__ __forceinline__ s16x4 trd(const LAS unsigned char* p) { typedef short v4i16_t __attribute__((ext_vector_type(4))); return __builtin_bit_cast(s16x4, __builtin_amdgcn_ds_read_tr16_b64_v4i16((LAS v4i16_t*)p)); }
__device__ __forceinline__ bf16x8 trfragX(const LAS unsigned char* img, int xbp, int s0) {
    const s16x4 a = trd(img + xbp + s0 * 128), b = trd(img + xbp + s0 * 128 + 2048);
    return (bf16x8){a[0], a[1], a[2], a[3], b[0], b[1], b[2], b[3]};
}
__device__ __forceinline__ bf16x8 trfragB(const LAS unsigned char* img, int bb, int s0) {
    const s16x4 a = trd(img + bb + s0 * 256), b = trd(img + bb + s0 * 256 + 4096);
    return (bf16x8){a[0], a[1], a[2], a[3], b[0], b[1], b[2], b[3]};
}
__device__ __forceinline__ void unpack4(const u32x2_t u, float (&f)[4]) { f[0] = __uint_as_float(u.x << 16); f[1] = __uint_as_float(u.x & 0xffff0000u); f[2] = __uint_as_float(u.y << 16); f[3] = __uint_as_float(u.y & 0xffff0000u); }
__device__ __forceinline__ void unpack8(const v4u u, float (&f)[8]) {
    f[0] = __uint_as_float(u.x << 16); f[1] = __uint_as_float(u.x & 0xffff0000u); f[2] = __uint_as_float(u.y << 16); f[3] = __uint_as_float(u.y & 0xffff0000u);
    f[4] = __uint_as_float(u.z << 16); f[5] = __uint_as_float(u.z & 0xffff0000u); f[6] = __uint_as_float(u.w << 16); f[7] = __uint_as_float(u.w & 0xffff0000u);
}
#define SSD_MFMA(a, b, c) __builtin_amdgcn_mfma_f32_16x16x32_bf16(a, b, c, 0, 0, 0)

template <int W> __device__ __forceinline__ void diag(f32x4 (&y)[4], const bf16x8 (&cf)[4], const LAS unsigned char* Bi, const LAS unsigned char* Xi, const LAS float* csc, float csl, float skd, int fr, int fq, const Lofs& lo) {
    constexpr int NU = W / 2 + 1;
    bf16x8 bA[2][4], bB[2][4];
#pragma unroll
    for (int kk = 0; kk < 4; ++kk) { bA[0][kk] = frag(Bi, lo.fb[kk], 0); if (1 <= W) bB[0][kk] = frag(Bi, lo.fb[kk], 1); }
#pragma unroll
    for (int u = 0; u < NU; ++u) {
        const int cur = u & 1; const bool has1 = 2 * u + 1 <= W;
        bf16x8 xf[4];
#pragma unroll
        for (int pt = 0; pt < 4; ++pt) xf[pt] = trfragX(Xi, lo.xb[pt], 32 * u);
        const f32x4 c0 = *(const LAS f32x4*)(csc + 32 * u + 4 * fq), c1 = *(const LAS f32x4*)(csc + 32 * u + 16 + 4 * fq);
        if (u + 1 < NU) {
#pragma unroll
            for (int kk = 0; kk < 4; ++kk) { bA[cur ^ 1][kk] = frag(Bi, lo.fb[kk], 2 * u + 2); if (2 * u + 3 <= W) bB[cur ^ 1][kk] = frag(Bi, lo.fb[kk], 2 * u + 3); } }
        asm volatile("" ::: "memory");
        f32x4 a0 = (f32x4){0.f, 0.f, 0.f, 0.f}, a1 = (f32x4){0.f, 0.f, 0.f, 0.f};
#pragma unroll
        for (int kk = 0; kk < 4; ++kk) { a0 = SSD_MFMA(bA[cur][kk], cf[kk], a0); if (has1) a1 = SSD_MFMA(bB[cur][kk], cf[kk], a1); }
        float m0[4], m1[4];
#pragma unroll
        for (int e = 0; e < 4; ++e) {
            m0[e] = a0[e] * __builtin_amdgcn_exp2f(fminf(csl - c0[e], 0.f)); if (2 * u == W) { if (4 * fq + e > fr) m0[e] = 0.f; if (4 * fq + e == fr) m0[e] += skd; }
            m1[e] = has1 ? a1[e] * __builtin_amdgcn_exp2f(fminf(csl - c1[e], 0.f)) : 0.f; if (2 * u + 1 == W) { if (4 * fq + e > fr) m1[e] = 0.f; if (4 * fq + e == fr) m1[e] += skd; } }
        const v4u mw = (v4u){pk2(m0[0], m0[1]), pk2(m0[2], m0[3]), pk2(m1[0], m1[1]), pk2(m1[2], m1[3])};
        const bf16x8 mf = __builtin_bit_cast(bf16x8, mw);
#pragma unroll
        for (int pt = 0; pt < 4; ++pt) y[pt] = SSD_MFMA(xf[pt], mf, y[pt]);
    }
}

template <int SH> __device__ __forceinline__ void ssd_item(int b, int h, const bf16* XC, const float* DT, const bf16* Z, const float* a_log, const float* d_skip, bf16* YQ, float* SSQ,
                                          LAS unsigned char* L, int tid_in, int lane_in, int wave) {
    int tid = tid_in, lane = lane_in; asm volatile("" : "+v"(tid), "+v"(lane));
    const int fr = lane & 15, fq = lane >> 4, g = h >> 3;
    LAS unsigned char* Bi = L + O_B; LAS unsigned char* Ci = L + O_C; LAS unsigned char* Xi = L + O_X; LAS unsigned char* Xdi = L + O_XD; LAS unsigned char* Sti = L + O_ST;
    LAS float* dtv = (LAS float*)(L + O_SM); LAS float* cs2 = dtv + 256;
    const float aneg1 = -expf(a_log[16 + h]) * LOG2E, aneg0 = -expf(a_log[h]) * LOG2E, dsk = d_skip[h];
    Lofs lo;
    { const int q = (lane & 15) >> 2, pp = lane & 3, rr = 4 * fq + q;
#pragma unroll
      for (int kk = 0; kk < 4; ++kk) lo.fb[kk] = fr * 256 + (((4 * kk + fq) ^ fr) << 4);
#pragma unroll
      for (int pt = 0; pt < 4; ++pt) lo.xb[pt] = rr * 128 + ((pt ^ ((rr >> 1) & 3)) << 5) + 8 * pp;
      lo.bb = rr * 256 + (((2 * wave + (pp >> 1)) ^ rr) << 4) + 8 * (pp & 1);
      lo.sw = fr * 256 + (((2 * wave + (fq >> 1)) ^ fr) << 4) + (fq & 1) * 8; }
    const int sB = tid >> 4, cB = tid & 15, sX = tid >> 3, cX = tid & 7;
    const int wB = sB * 256 + ((cB ^ (sB & 15)) << 4);
    const int wX = sX * 128 + (((cX >> 1) ^ ((sX >> 1) & 3)) << 5) + (cX & 1) * 16;
    f32x4 st[4];
#pragma unroll
    for (int pt = 0; pt < 4; ++pt) st[pt] = (f32x4){0.f, 0.f, 0.f, 0.f};
    v4u Bq[4], Cq[4], Xq[2]; float dq0 = 0.f, dq1 = 0.f; bf16x8 cf[4];
#define SSD_DECODE(step, d_, base_, ctx_) const int d_ = 1 - (step) / 18; const int k_##d_ = (step) % 18; const bool ctx_ = k_##d_ < 2; \
    const size_t base_ = ctx_ ? (size_t)ML + (size_t)b * CTXL + (size_t)(d_ ? 1 - k_##d_ : k_##d_) * 128 : (size_t)b * SEQ + (size_t)(d_ ? 17 - k_##d_ : k_##d_ - 2) * 128;
#define SSD_ISSUE(step) do { SSD_DECODE(step, di, basei, ctxi) (void)ctxi; \
        const bf16* cb_ = XC + (SH == 8 ? (size_t)b * SEQ : basei) * CONVC; const int sg_ = di ? -CONVC : CONVC; const int o0_ = di ? 127 * CONVC : 0; \
        const bf16* pb_ = cb_ + (o0_ + sB * sg_ + 1024 + g * 128 + 8 * cB); const bf16* px_ = cb_ + (o0_ + sX * sg_ + h * 64 + 8 * cX); \
        const bf16* pc_ = cb_ + (o0_ + (16 * wave + fr) * sg_ + 1280 + g * 128 + 8 * fq); \
        _Pragma("unroll") for (int k4 = 0; k4 < 4; ++k4) { Bq[k4] = *(const v4u*)(pb_ + k4 * 32 * sg_); Cq[k4] = *(const v4u*)(pc_ + 32 * k4); } \
        _Pragma("unroll") for (int k2 = 0; k2 < 2; ++k2) Xq[k2] = *(const v4u*)(px_ + k2 * 64 * sg_); \
        if (wave == 0) { const size_t r0 = basei + (di ? 127 - 2 * lane : 2 * lane), r1 = basei + (di ? 126 - 2 * lane : 2 * lane + 1); dq0 = DT[r0 * 32 + di * 16 + h]; dq1 = DT[r1 * 32 + di * 16 + h]; } } while (0)
#define SSD_CUMSUM(step, par) do { if (wave == 0) { const float an = (1 - (step) / 18) ? aneg1 : aneg0; const float a0 = dq0 * an, a1 = dq1 * an; float v = a0 + a1; \
        _Pragma("unroll") for (int o = 1; o < 64; o <<= 1) { const float t = __shfl_up(v, o); if (lane >= o) v += t; } \
        dtv[(par) * 128 + 2 * lane] = dq0; dtv[(par) * 128 + 2 * lane + 1] = dq1; cs2[(par) * 128 + 2 * lane] = v - a1; cs2[(par) * 128 + 2 * lane + 1] = v; } } while (0)
#define SSD_WRITE(step, par) do { \
        _Pragma("unroll") for (int k4 = 0; k4 < 4; ++k4) { *(LAS v4u*)(Bi + wB + k4 * 8192) = Bq[k4]; cf[k4] = __builtin_bit_cast(bf16x8, Cq[k4]); } \
        const float cl = cs2[(par) * 128 + 127]; \
        _Pragma("unroll") for (int k2 = 0; k2 < 2; ++k2) { const int s = sX + 64 * k2; const float dts = dtv[(par) * 128 + s], es = __builtin_amdgcn_exp2f(cl - cs2[(par) * 128 + s]); \
            float f[8]; unpack8(Xq[k2], f); _Pragma("unroll") for (int e = 0; e < 8; ++e) f[e] *= dts; \
            v4u xo; xo.x = pk2(f[0], f[1]); xo.y = pk2(f[2], f[3]); xo.z = pk2(f[4], f[5]); xo.w = pk2(f[6], f[7]); \
            _Pragma("unroll") for (int e = 0; e < 8; ++e) f[e] *= es; \
            v4u xd; xd.x = pk2(f[0], f[1]); xd.y = pk2(f[2], f[3]); xd.z = pk2(f[4], f[5]); xd.w = pk2(f[6], f[7]); \
            *(LAS v4u*)(Xi + wX + k2 * 8192) = xo; *(LAS v4u*)(Xdi + wX + k2 * 8192) = xd; } } while (0)
#define SSD_WRITE_STATE() do { _Pragma("unroll") for (int pt = 0; pt < 4; ++pt) { \
        u32x2_t w; w.x = pk2(st[pt][0], st[pt][1]); w.y = pk2(st[pt][2], st[pt][3]); *(LAS u32x2_t*)(Sti + lo.sw + pt * 4096) = w; } } while (0)

    __syncthreads();
    SSD_ISSUE(0); SSD_CUMSUM(0, 0); SSD_WRITE_STATE();
    __syncthreads();
    SSD_WRITE(0, 0);
    __syncthreads();
    for (int step = 0; step < 36; ++step) {
        const int par = step & 1; SSD_DECODE(step, d, base, isctx)
        const int r8 = lane >> 3, c8 = lane & 7;
        size_t orow2[2]; v4u ybv[2], zv[2];
#pragma unroll
        for (int ps = 0; ps < 2; ++ps) { const int l = 16 * wave + 8 * ps + r8; orow2[ps] = base + (d ? 127 - l : l); }
        if (!isctx && d == 0 && SH != 5 && SH != 7) {
#pragma unroll
            for (int ps = 0; ps < 2; ++ps) { ybv[ps] = *(const v4u*)((SH ? YQ + (orow2[ps] & 255) * 2048 : YQ + orow2[ps] * 2048) + h * 64 + 8 * c8); zv[ps] = *(const v4u*)(Z + orow2[ps] * 1024 + h * 64 + 8 * c8); } }
        if (step + 1 < 36 && SH != 3 && SH != 7) SSD_ISSUE(step + 1);
        const LAS float* csc = cs2 + par * 128;
        if (!isctx && SH != 7) {
            const float csl = csc[16 * wave + fr];
            const float skd = d == 0 ? dsk * __builtin_amdgcn_rcpf(dtv[par * 128 + 16 * wave + fr]) : 0.f;
            f32x4 y[4];
#pragma unroll
            for (int pt = 0; pt < 4; ++pt) { y[pt] = (f32x4){0.f, 0.f, 0.f, 0.f};
                if (SH != 6) {
#pragma unroll
                for (int kk = 0; kk < 4; ++kk) y[pt] = SSD_MFMA(frag(Sti, lo.fb[kk], pt), cf[kk], y[pt]); } }
            { const float El = __builtin_amdgcn_exp2f(csl);
#pragma unroll
              for (int pt = 0; pt < 4; ++pt) y[pt] *= El; }
            if (SH != 2) switch (wave) {
                case 0: diag<0>(y, cf, Bi, Xi, csc, csl, skd, fr, fq, lo); break; case 1: diag<1>(y, cf, Bi, Xi, csc, csl, skd, fr, fq, lo); break;
                case 2: diag<2>(y, cf, Bi, Xi, csc, csl, skd, fr, fq, lo); break; case 3: diag<3>(y, cf, Bi, Xi, csc, csl, skd, fr, fq, lo); break;
                case 4: diag<4>(y, cf, Bi, Xi, csc, csl, skd, fr, fq, lo); break; case 5: diag<5>(y, cf, Bi, Xi, csc, csl, skd, fr, fq, lo); break;
                case 6: diag<6>(y, cf, Bi, Xi, csc, csl, skd, fr, fq, lo); break; default: diag<7>(y, cf, Bi, Xi, csc, csl, skd, fr, fq, lo); break;
            }
            LAS unsigned char* stg = Ci + wave * 4096;
#pragma unroll
            for (int pt = 0; pt < 4; ++pt) *(LAS f32x4*)(stg + fr * 256 + (((4 * pt + fq) ^ fr) << 4)) = y[pt];
#pragma unroll
            for (int ps = 0; ps < 2; ++ps) { const int rl = 8 * ps + r8;
                const f32x4 t0 = *(const LAS f32x4*)(stg + rl * 256 + (((2 * c8) ^ rl) << 4)), t1 = *(const LAS f32x4*)(stg + rl * 256 + (((2 * c8 + 1) ^ rl) << 4));
                float v[8] = {t0[0], t0[1], t0[2], t0[3], t1[0], t1[1], t1[2], t1[3]};
                if (d == 0 && SH != 5) { float fb[8], fz[8]; unpack8(ybv[ps], fb); unpack8(zv[ps], fz); float q = 0.f;
#pragma unroll
                    for (int e = 0; e < 8; ++e) { v[e] = (v[e] + fb[e]) * fz[e]; q += v[e] * v[e]; }
                    q += __shfl_xor(q, 1); q += __shfl_xor(q, 2); q += __shfl_xor(q, 4);
                    if (c8 == 0) SSQ[(SH ? (orow2[ps] & 255) : orow2[ps]) * 16 + h] = q; }
                v4u o; o.x = pk2(v[0], v[1]); o.y = pk2(v[2], v[3]); o.z = pk2(v[4], v[5]); o.w = pk2(v[6], v[7]);
                if (SH != 5) *(v4u*)((SH ? YQ + (orow2[ps] & 255) * 2048 : YQ + orow2[ps] * 2048) + h * 64 + 8 * c8) = o; else asm volatile("" :: "v"(o)); }
        }
        if (SH != 6 && SH != 7) { const float dec = __builtin_amdgcn_exp2f(csc[127]);
#pragma unroll
          for (int pt = 0; pt < 4; ++pt) st[pt] *= dec;
#pragma unroll
          for (int kk = 0; kk < 4; ++kk) { const bf16x8 af = trfragB(Bi, lo.bb, 32 * kk);
#pragma unroll
              for (int pt = 0; pt < 4; ++pt) st[pt] = SSD_MFMA(af, trfragX(Xdi, lo.xb[pt], 32 * kk), st[pt]); } }
        if (step + 1 < 36) SSD_CUMSUM(step + 1, par ^ 1);
        if (step == 17) {
#pragma unroll
            for (int pt = 0; pt < 4; ++pt) st[pt] = (f32x4){0.f, 0.f, 0.f, 0.f};
            VM_WAIT();
        }
        __syncthreads();
        SSD_WRITE_STATE();
        if (step + 1 < 36 && SH != 4 && SH != 7) SSD_WRITE(step + 1, par ^ 1);
        __syncthreads();
    }
#undef SSD_DECODE
#undef SSD_ISSUE
#undef SSD_CUMSUM
#undef SSD_WRITE
#undef SSD_WRITE_STATE
}
namespace pr {
template <int CTRL, int ROWMASK> __device__ __forceinline__ float dpp_get(float v) {
    return __builtin_bit_cast(float, __builtin_amdgcn_update_dpp(0, __builtin_bit_cast(int, v), CTRL, ROWMASK, 0xF, false)); }
__device__ __forceinline__ float sum8(float q) {
    q += dpp_get<0xB1, 0xF>(q); q += dpp_get<0x4E, 0xF>(q); q += dpp_get<0x141, 0xF>(q); return q; }
__device__ __forceinline__ float scan64(float v) {
    v += dpp_get<0x111, 0xF>(v); v += dpp_get<0x112, 0xF>(v); v += dpp_get<0x114, 0xF>(v); v += dpp_get<0x118, 0xF>(v);
    v += dpp_get<0x142, 0xA>(v); v += dpp_get<0x143, 0xC>(v); return v; }
constexpr int P_B = 0, P_STG = 32768, P_X = 49152, P_XD = 81920, P_ST0 = 114688, P_ST1 = 132096, P_SM = 148480;
template <int W> __device__ __forceinline__ void diag1(f32x4 (&y)[4], const bf16x8 (&cf)[4], const LAS unsigned char* Bi, const LAS unsigned char* Xi, const LAS float* csc, float csl, float skd, int fr, int fq, const Lofs& lo) {
#pragma unroll
    for (int u = 0; u <= W / 2; ++u) {
        const bool has1 = 2 * u + 1 <= W;
        bf16x8 xf[4];
#pragma unroll
        for (int pt = 0; pt < 4; ++pt) xf[pt] = trfragX(Xi, lo.xb[pt], 32 * u);
        const f32x4 c0 = *(const LAS f32x4*)(csc + 32 * u + 4 * fq), c1 = *(const LAS f32x4*)(csc + 32 * u + 16 + 4 * fq);
        f32x4 a0 = (f32x4){0.f, 0.f, 0.f, 0.f}, a1 = (f32x4){0.f, 0.f, 0.f, 0.f};
#pragma unroll
        for (int kk = 0; kk < 4; ++kk) { a0 = SSD_MFMA(frag(Bi, lo.fb[kk], 2 * u), cf[kk], a0); if (has1) a1 = SSD_MFMA(frag(Bi, lo.fb[kk], 2 * u + 1), cf[kk], a1); }
        float m0[4], m1[4];
#pragma unroll
        for (int e = 0; e < 4; ++e) {
            m0[e] = a0[e] * __builtin_amdgcn_exp2f(fminf(csl - c0[e], 0.f)); if (2 * u == W) { if (4 * fq + e > fr) m0[e] = 0.f; if (4 * fq + e == fr) m0[e] += skd; }
            m1[e] = has1 ? a1[e] * __builtin_amdgcn_exp2f(fminf(csl - c1[e], 0.f)) : 0.f; if (2 * u + 1 == W) { if (4 * fq + e > fr) m1[e] = 0.f; if (4 * fq + e == fr) m1[e] += skd; } }
        const v4u mw = (v4u){pk2(m0[0], m0[1]), pk2(m0[2], m0[3]), pk2(m1[0], m1[1]), pk2(m1[2], m1[3])};
        const bf16x8 mf = __builtin_bit_cast(bf16x8, mw);
#pragma unroll
        for (int pt = 0; pt < 4; ++pt) y[pt] = SSD_MFMA(xf[pt], mf, y[pt]);
    }
}
__device__ __forceinline__ void diag_sw(int wave, f32x4 (&y)[4], const bf16x8 (&cf)[4], const LAS unsigned char* Bi, const LAS unsigned char* Xi, const LAS float* csc, float csl, float skd, int fr, int fq, const Lofs& lo) {
    switch (wave) {
        case 0: diag1<0>(y, cf, Bi, Xi, csc, csl, skd, fr, fq, lo); break; case 1: diag1<1>(y, cf, Bi, Xi, csc, csl, skd, fr, fq, lo); break;
        case 2: diag1<2>(y, cf, Bi, Xi, csc, csl, skd, fr, fq, lo); break; case 3: diag1<3>(y, cf, Bi, Xi, csc, csl, skd, fr, fq, lo); break;
        case 4: diag1<4>(y, cf, Bi, Xi, csc, csl, skd, fr, fq, lo); break; case 5: diag1<5>(y, cf, Bi, Xi, csc, csl, skd, fr, fq, lo); break;
        case 6: diag1<6>(y, cf, Bi, Xi, csc, csl, skd, fr, fq, lo); break; default: diag1<7>(y, cf, Bi, Xi, csc, csl, skd, fr, fq, lo); break;
    }
}

__device__ __forceinline__ void ssd_pair(int b, int hp, const bf16* XC, const float* DT, const bf16* Z, const float* a_log, const float* d_skip, bf16* YQ, float* SSQ,
                                          LAS unsigned char* L, int tid_in, int lane_in, int wave) {
    int tid = tid_in, lane = lane_in; asm volatile("" : "+v"(tid), "+v"(lane));
    const int fr = lane & 15, fq = lane >> 4, h0 = 2 * hp, g = hp >> 2;
    LAS unsigned char* Bi = L + P_B; LAS unsigned char* Stg = L + P_STG + wave * 2048;
    LAS float* dtv = (LAS float*)(L + P_SM); LAS float* cs2 = dtv + 512;
    const float an00 = -expf(a_log[h0]) * LOG2E, an01 = -expf(a_log[h0 + 1]) * LOG2E, an10 = -expf(a_log[16 + h0]) * LOG2E, an11 = -expf(a_log[16 + h0 + 1]) * LOG2E;
    const float dsk0 = d_skip[h0], dsk1 = d_skip[h0 + 1];
    Lofs lo;
    { const int q = (lane & 15) >> 2, pp = lane & 3, rr = 4 * fq + q;
#pragma unroll
      for (int kk = 0; kk < 4; ++kk) lo.fb[kk] = fr * 256 + (((4 * kk + fq) ^ fr) << 4);
#pragma unroll
      for (int pt = 0; pt < 4; ++pt) lo.xb[pt] = rr * 128 + ((pt ^ ((rr >> 1) & 3)) << 5) + 8 * pp;
      lo.bb = rr * 256 + (((2 * wave + (pp >> 1)) ^ rr) << 4) + 8 * (pp & 1);
      lo.sw = fr * 256 + (((2 * wave + (fq >> 1)) ^ fr) << 4) + (fq & 1) * 8; }
    const int sB = tid >> 4, cB = tid & 15, hx = (tid >> 3) & 1, cX = tid & 7;
    const int wB = sB * 256 + ((cB ^ (sB & 15)) << 4);
    const int wX = hx * 16384 + sB * 128 + (((cX >> 1) ^ ((sB >> 1) & 3)) << 5) + (cX & 1) * 16;
    f32x4 st[2][4];
#pragma unroll
    for (int hh = 0; hh < 2; ++hh)
#pragma unroll
        for (int pt = 0; pt < 4; ++pt) st[hh][pt] = (f32x4){0.f, 0.f, 0.f, 0.f};
    v4u Bq[4], Xq[4]; float dq0 = 0.f, dq1 = 0.f; bf16x8 cf[4];
#define PR_DECODE(step, d_, base_, ctx_) const int d_ = 1 - (step) / 18; const int k_##d_ = (step) % 18; const bool ctx_ = k_##d_ < 2; \
    const size_t base_ = ctx_ ? (size_t)ML + (size_t)b * CTXL + (size_t)(d_ ? 1 - k_##d_ : k_##d_) * 128 : (size_t)b * SEQ + (size_t)(d_ ? 17 - k_##d_ : k_##d_ - 2) * 128;
#define PR_ISSUE(step) do { PR_DECODE(step, di, basei, ctxi) (void)ctxi; \
        const bf16* cb_ = XC + basei * CONVC; const int sg_ = di ? -CONVC : CONVC; const int o0_ = di ? 127 * CONVC : 0; \
        const bf16* pb_ = cb_ + (o0_ + sB * sg_ + 1024 + g * 128 + 8 * cB); const bf16* px_ = cb_ + (o0_ + sB * sg_ + h0 * 64 + 8 * cB); \
        _Pragma("unroll") for (int k4 = 0; k4 < 4; ++k4) { Bq[k4] = *(const v4u*)(pb_ + k4 * 32 * sg_); Xq[k4] = *(const v4u*)(px_ + k4 * 32 * sg_); } \
        if (wave < 2) { const size_t r0 = basei + (di ? 127 - 2 * lane : 2 * lane), r1 = basei + (di ? 126 - 2 * lane : 2 * lane + 1); dq0 = DT[r0 * 32 + di * 16 + h0 + wave]; dq1 = DT[r1 * 32 + di * 16 + h0 + wave]; } } while (0)
#define PR_LOADC(step) do { PR_DECODE(step, dc, basec, ctxc) (void)ctxc; const bf16* pc_ = XC + basec * CONVC + ((dc ? 127 - (16 * wave + fr) : 16 * wave + fr) * CONVC + 1280 + g * 128 + 8 * fq); \
        _Pragma("unroll") for (int k4 = 0; k4 < 4; ++k4) cf[k4] = __builtin_bit_cast(bf16x8, *(const v4u*)(pc_ + 32 * k4)); } while (0)
#define PR_CUMSUM(step, par) do { if (wave < 2) { const float an = (1 - (step) / 18) ? (wave ? an11 : an10) : (wave ? an01 : an00); const float a0 = dq0 * an, a1 = dq1 * an; const float v = scan64(a0 + a1); \
        const int o_ = ((par) * 2 + wave) * 128 + 2 * lane; dtv[o_] = dq0; dtv[o_ + 1] = dq1; cs2[o_] = v - a1; cs2[o_ + 1] = v; } } while (0)
#define PR_WRITE(step, par) do { const int ob_ = ((par) * 2 + hx) * 128; const float cl = cs2[ob_ + 127]; \
        _Pragma("unroll") for (int k4 = 0; k4 < 4; ++k4) { *(LAS v4u*)(Bi + wB + k4 * 8192) = Bq[k4]; \
            const int s = sB + 32 * k4; const float dts = dtv[ob_ + s], es = __builtin_amdgcn_exp2f(cl - cs2[ob_ + s]); \
            float f[8]; unpack8(Xq[k4], f); _Pragma("unroll") for (int e = 0; e < 8; ++e) f[e] *= dts; \
            v4u xo; xo.x = pk2(f[0], f[1]); xo.y = pk2(f[2], f[3]); xo.z = pk2(f[4], f[5]); xo.w = pk2(f[6], f[7]); \
            _Pragma("unroll") for (int e = 0; e < 8; ++e) f[e] *= es; \
            v4u xd; xd.x = pk2(f[0], f[1]); xd.y = pk2(f[2], f[3]); xd.z = pk2(f[4], f[5]); xd.w = pk2(f[6], f[7]); \
            *(LAS v4u*)(L + P_X + wX + k4 * 4096) = xo; *(LAS v4u*)(L + P_XD + wX + k4 * 4096) = xd; } } while (0)
#define PR_WRITE_STATE() do { _Pragma("unroll") for (int pt = 0; pt < 4; ++pt) { \
        u32x2_t w; w.x = pk2(st[0][pt][0], st[0][pt][1]); w.y = pk2(st[0][pt][2], st[0][pt][3]); *(LAS u32x2_t*)(L + P_ST0 + lo.sw + pt * 4096) = w; \
        w.x = pk2(st[1][pt][0], st[1][pt][1]); w.y = pk2(st[1][pt][2], st[1][pt][3]); *(LAS u32x2_t*)(L + P_ST1 + lo.sw + pt * 4096) = w; } } while (0)

    __syncthreads();
    PR_ISSUE(0); PR_LOADC(0); PR_CUMSUM(0, 0); PR_WRITE_STATE();
    __syncthreads();
    PR_WRITE(0, 0);
    __syncthreads();
    for (int step = 0; step < 36; ++step) {
        const int par = step & 1; PR_DECODE(step, d, base, isctx)
        const int r8 = lane >> 3, c8 = lane & 7;
        size_t orow2[2]; v4u ybv[2], zv[2];
#pragma unroll
        for (int ps = 0; ps < 2; ++ps) { const int l = 16 * wave + 8 * ps + r8; orow2[ps] = base + (d ? 127 - l : l); }
        const bool fwdy = !isctx && d == 0;
        if (fwdy) {
#pragma unroll
            for (int ps = 0; ps < 2; ++ps) { ybv[ps] = *(const v4u*)(YQ + orow2[ps] * 2048 + h0 * 64 + 8 * c8); zv[ps] = *(const v4u*)(Z + orow2[ps] * 1024 + h0 * 64 + 8 * c8); } }
        if (step + 1 < 36) PR_ISSUE(step + 1);
        if (!isctx) {
#pragma unroll
            for (int hh = 0; hh < 2; ++hh) {
                const LAS float* csc = cs2 + (par * 2 + hh) * 128;
                const LAS unsigned char* Xi = L + P_X + hh * 16384; const LAS unsigned char* Sti = L + (hh ? P_ST1 : P_ST0);
                const float csl = csc[16 * wave + fr];
                const float skd = d == 0 ? (hh ? dsk1 : dsk0) * __builtin_amdgcn_rcpf(dtv[(par * 2 + hh) * 128 + 16 * wave + fr]) : 0.f;
                f32x4 y[4];
#pragma unroll
                for (int pt = 0; pt < 4; ++pt) { y[pt] = (f32x4){0.f, 0.f, 0.f, 0.f};
#pragma unroll
                    for (int kk = 0; kk < 4; ++kk) y[pt] = SSD_MFMA(frag(Sti, lo.fb[kk], pt), cf[kk], y[pt]); }
                { const float El = __builtin_amdgcn_exp2f(csl);
#pragma unroll
                  for (int pt = 0; pt < 4; ++pt) y[pt] *= El; }
                diag_sw(wave, y, cf, Bi, Xi, csc, csl, skd, fr, fq, lo);
#pragma unroll
                for (int ps = 0; ps < 2; ++ps) {
                    if ((fr >> 3) == ps) {
#pragma unroll
                        for (int pt = 0; pt < 4; ++pt) *(LAS f32x4*)(Stg + (fr & 7) * 256 + (((4 * pt + fq) ^ fr) << 4)) = y[pt]; }
                    const int key = 8 * ps + r8;
                    const f32x4 t0 = *(const LAS f32x4*)(Stg + r8 * 256 + (((2 * c8) ^ key) << 4)), t1 = *(const LAS f32x4*)(Stg + r8 * 256 + (((2 * c8 + 1) ^ key) << 4));
                    float v[8] = {t0[0], t0[1], t0[2], t0[3], t1[0], t1[1], t1[2], t1[3]};
                    if (d == 0) { float fb[8], fz[8]; unpack8(ybv[ps], fb); unpack8(zv[ps], fz); float q = 0.f;
#pragma unroll
                        for (int e = 0; e < 8; ++e) { v[e] = (v[e] + fb[e]) * fz[e]; q += v[e] * v[e]; }
                        q = sum8(q);
                        if (c8 == 0) SSQ[orow2[ps] * 16 + h0 + hh] = q; }
                    v4u o; o.x = pk2(v[0], v[1]); o.y = pk2(v[2], v[3]); o.z = pk2(v[4], v[5]); o.w = pk2(v[6], v[7]);
                    *(v4u*)(YQ + orow2[ps] * 2048 + (h0 + hh) * 64 + 8 * c8) = o;
                }
                if (hh == 0 && fwdy) {
#pragma unroll
                    for (int ps = 0; ps < 2; ++ps) { ybv[ps] = *(const v4u*)(YQ + orow2[ps] * 2048 + (h0 + 1) * 64 + 8 * c8); zv[ps] = *(const v4u*)(Z + orow2[ps] * 1024 + (h0 + 1) * 64 + 8 * c8); } }
            }
        }
        if (step + 1 < 36) PR_LOADC(step + 1);
        { const float dec0 = __builtin_amdgcn_exp2f(cs2[(par * 2 + 0) * 128 + 127]), dec1 = __builtin_amdgcn_exp2f(cs2[(par * 2 + 1) * 128 + 127]);
#pragma unroll
          for (int pt = 0; pt < 4; ++pt) { st[0][pt] *= dec0; st[1][pt] *= dec1; }
#pragma unroll
          for (int kk = 0; kk < 4; ++kk) { const bf16x8 af = trfragB(Bi, lo.bb, 32 * kk);
#pragma unroll
              for (int pt = 0; pt < 4; ++pt) { st[0][pt] = SSD_MFMA(af, trfragX(L + P_XD, lo.xb[pt], 32 * kk), st[0][pt]); st[1][pt] = SSD_MFMA(af, trfragX(L + P_XD + 16384, lo.xb[pt], 32 * kk), st[1][pt]); } } }
        if (step + 1 < 36) PR_CUMSUM(step + 1, par ^ 1);
        if (step == 17) {
#pragma unroll
            for (int pt = 0; pt < 4; ++pt) { st[0][pt] = (f32x4){0.f, 0.f, 0.f, 0.f}; st[1][pt] = (f32x4){0.f, 0.f, 0.f, 0.f}; }
            VM_WAIT();
        }
        __syncthreads();
        PR_WRITE_STATE();
        if (step + 1 < 36) PR_WRITE(step + 1, par ^ 1);
        __syncthreads();
    }
#undef PR_DECODE
#undef PR_ISSUE
#undef PR_CUMSUM
#undef PR_LOADC
#undef PR_WRITE
#undef PR_WRITE_STATE
}
}
}

__device__ __forceinline__ void ctx_dt_slice(const bf16* H, const bf16* bt1, const float* dt_bias, float* DT, int bx, int G, int wave, int lane) {
    typedef short bf16x8_t __attribute__((ext_vector_type(8)));
    const int fr = lane & 15, fq = lane >> 4;
    for (int sl = bx; sl < MC / 32; sl += G) {
        if (wave < 4) {
            const int r0 = ML + 32 * sl + 16 * (wave >> 1), j0 = 16 * (wave & 1);
            const bf16* ap = H + (size_t)(r0 + fr) * DM + 8 * fq; const bf16* bp = bt1 + (size_t)(2048 + j0 + fr) * DM + 8 * fq;
            f32x4 acc = (f32x4){0.f, 0.f, 0.f, 0.f};
#pragma unroll 8
            for (int kk = 0; kk < 32; ++kk) acc = __builtin_amdgcn_mfma_f32_16x16x32_bf16(*(const bf16x8_t*)(ap + 32 * kk), *(const bf16x8_t*)(bp + 32 * kk), acc, 0, 0, 0);
            const float bias = dt_bias[j0 + fr];
#pragma unroll
            for (int e = 0; e < 4; ++e) { const float v = acc[e] + bias; DT[(size_t)(r0 + 4 * fq + e) * 32 + j0 + fr] = v > 20.f ? v : log1pf(__expf(v)); }
        }
    }
}
constexpr int RING_OFF = 0, RING_BYTES = 131072;
constexpr int LDSCTL_OFF = RING_BYTES, MISC_OFF = LDSCTL_OFF + 320;
constexpr int RSTD_OFF = LDSCTL_OFF + 1024;
constexpr int LDS_BYTES = 155648;
constexpr int CW_BAR = 4096;
constexpr int CW_TMO2 = 8192, CW_CNT = 16384;
constexpr int EXL_OFF = 140288;
constexpr int NPHASE = 7;

struct Args { const float* in[18]; float* out; unsigned char* ws; int ph_lo, ph_hi; };

__global__ void __launch_bounds__(NWAVES * 64, 2) mega(Args args) {
    extern __shared__ __attribute__((aligned(16))) unsigned char lds[];
    LAS unsigned char* ldsp = (LAS unsigned char*)lds;
    volatile LAS unsigned* MISC = (volatile LAS unsigned*)(ldsp + MISC_OFF);
    const int wave = __builtin_amdgcn_readfirstlane((int)threadIdx.x >> 6);
#define PH_IDS() int lane = mk_lane(); asm volatile("" : "+v"(lane)); const int tid = wave * 64 + lane; (void)tid
    const int G = gridDim.x; const int bx = blockIdx.x; const int vcu = (G % 8 == 0) ? (bx % 8) * (G / 8) + bx / 8 : bx;
    unsigned char* ws = args.ws;
    gu32* ctl = (gu32*)(ws + WS_CTL);
    float* mod = (float*)(ws + WS_MOD); float* rope = (float*)(ws + WS_ROPE); float* SSQ = (float*)(ws + WS_SSQ); float* RPART = (float*)(ws + WS_RPART);
    bf16* bt1 = (bf16*)(ws + WS_BT1); bf16* bt2 = (bf16*)(ws + WS_BT2); float* DT = (float*)(ws + WS_DT); bf16* KB = (bf16*)(ws + WS_KB); bf16* VB = (bf16*)(ws + WS_VB);
    bf16* H = (bf16*)(ws + WS_R1); bf16* XC = (bf16*)(ws + WS_R1); bf16* XBC = (bf16*)(ws + WS_XBC); bf16* YQ = (bf16*)(ws + WS_YQ); bf16* Z = (bf16*)(ws + WS_Z);
    { PH_IDS(); for (int u = tid; u < (LDS_BYTES - LDSCTL_OFF) / 4; u += NWAVES * 64) ((LAS unsigned*)(ldsp + LDSCTL_OFF))[u] = 0u; }
    __syncthreads();
    const bool leader = wave == 0 && mk_lane() == 0; (void)leader;
    const int lo = args.ph_lo, hi = args.ph_hi;
    XcdBarrier bar; bar.bar = (unsigned*)(ctl + CW_BAR); bar.x = 0; bar.st = nullptr;
    if (hi - lo > 1) bar = xcd_barrier_post((unsigned*)(ctl + CW_BAR), MISC + 8, leader);
#ifndef DUP_MASK
#define DUP_MASK 0
#endif
#define IN(k) (lo <= (k) && (k) < hi)
#define REP(k) for (int rep_ = 0; rep_ < 1 + ((DUP_MASK >> (k)) & 1); ++rep_)
#define SEAM(k) do { if (IN(k) && IN((k) + 1)) xcd_barrier(bar, wave == 0 && mk_lane() == 0); } while (0)

    if (IN(0)) REP(0) {
        PH_IDS();
        LAS float* ldsf = (LAS float*)(ldsp + RING_OFF);
        if (bx < 48) p0_mod_block(args.in[1], args.in[3], args.in[4], args.in[5], mod, ldsf, bx, tid, lane, wave);
        else if (bx == 48) { for (int i = tid; i < 1024; i += NWAVES * 64) { const int p = i >> 4, f = i & 15; const float inv = powf(10000.f, -(float)f / 16.f); const float ang = (float)p * inv; rope[i] = cosf(ang); rope[1024 + i] = sinf(ang); } }
        LAS float* scr = ldsf + wave * (64 * 33);
        const int gw = ((bx + G - 49) % G) * NWAVES + wave, NGW = G * NWAVES;
        constexpr int I1 = 16 * 168, I2 = 32 * 32;
        for (int it = gw; it < I1 + I2; it += NGW) { if (it < I1) p0_bt1_item(args.in[7], bt1, scr, it, lane); else p0_bt2_item(args.in[16], args.in[15], bt2, scr, it - I1, lane); }
    }
    SEAM(0);
    if (IN(1)) REP(1) {
        PH_IDS();
        const int gw = bx * NWAVES + wave, NGW = G * NWAVES;
        static_assert(MT % (8 * 2048) == 0 || true, "row batches");
        {
            const int step = NGW * 4; int m0 = gw * 4;
            f32x4 va[4][4], vb[4][4];
            if (m0 < MT) p1_load4(va, args.in[0], args.in[2], m0, lane);
            while (m0 < MT) {
                if (m0 + step < MT) p1_load4(vb, args.in[0], args.in[2], m0 + step, lane);
                asm volatile("" ::: "memory");
                p1_proc4(va, mod, args.in[6], H, m0, lane);
                m0 += step; if (m0 >= MT) break;
                if (m0 + step < MT) p1_load4(va, args.in[0], args.in[2], m0 + step, lane);
                asm volatile("" ::: "memory");
                p1_proc4(vb, mod, args.in[6], H, m0, lane);
                m0 += step;
            }
        }
    }
    SEAM(1);

    if (IN(2)) REP(2) {
        pg8::Gemm g{H, bt1, MT, N1, 1024}; pg8::Sched1 S; S.init(G, bx);
        pg8::Epi1 E{KB, VB, XBC, YQ, Z, DT, rope, args.in[13], args.in[14], args.in[10]};
        pg8::gemm_phase<pg8::Epi1, pg8::Sched1, true, true>(ldsp + RING_OFF, g, S, E, wave);
        { int ln_ = mk_lane(); asm volatile("" : "+v"(ln_)); ctx_dt_slice(H, bt1, args.in[10], DT, bx, G, wave, ln_); }
    }
    SEAM(2);
    if (IN(3)) {
        PH_IDS();
        float sbound;
        { float gq = fabsf(args.in[13][lane]), gk = fabsf(args.in[14][lane]);
#pragma unroll
          for (int o = 1; o < 64; o <<= 1) { gq = fmaxf(gq, __shfl_xor(gq, o)); gk = fmaxf(gk, __shfl_xor(gk, o)); }
          sbound = __uint_as_float(__builtin_amdgcn_readfirstlane(__float_as_uint(C2 * 64.f * gq * gk * 1.01f))); }
        const attn_body::Order S{vcu, G, false};
        const attn_body::Order S2{vcu, G, true};
#ifndef ATTN_SHADOW
#define ATTN_SHADOW 0
#endif
        if (ATTN_SHADOW) attn_body::attn_phase<8>((char*)lds + RING_OFF, (attn_body::bf16*)YQ, (const attn_body::bf16*)KB, (const attn_body::bf16*)VB, ATTN_SHADOW == 2 ? S2 : S, wave, sbound, (attn_body::bf16*)(ws + WS_END + 8 * MiB));
        attn_body::attn_phase<8>((char*)lds + RING_OFF, (attn_body::bf16*)YQ, (const attn_body::bf16*)KB, (const attn_body::bf16*)VB, S, wave, sbound);
        conv_phase(XBC, args.in[8], args.in[9], XC, bx, G, tid);
    }
    SEAM(3);
    if (IN(4)) REP(4) {
        PH_IDS();
#if defined(SSD_NAIVE)
        for (int it = bx; it < NB * 16; it += G) ssd_item_naive(it >> 4, it & 15, XC, DT, Z, args.in[11], args.in[12], YQ, SSQ, (LAS float*)(ldsp + RING_OFF), tid);
#else
#ifndef SSD_SHADOW
#define SSD_SHADOW 0
#endif
        if (SSD_SHADOW) { bf16* dY = (bf16*)(ws + WS_END); float* dS = (float*)(ws + WS_END + 2 * MiB);
            for (int it = vcu; it < NB * 16; it += G) ssd::ssd_item<SSD_SHADOW>(it >> 4, it & 15, XC, DT, Z, args.in[11], args.in[12], dY, dS, ldsp, tid, lane, wave); }
#ifndef SSD_PAIR
#define SSD_PAIR 1
#endif
        if (SSD_PAIR) { for (int it = vcu; it < NB * 8; it += G) { int ln_ = mk_lane(); asm volatile("" : "+v"(ln_)); ssd::pr::ssd_pair(it >> 3, it & 7, XC, DT, Z, args.in[11], args.in[12], YQ, SSQ, ldsp, wave * 64 + ln_, ln_, wave); } }
        else for (int it = vcu; it < NB * 16; it += G) ssd::ssd_item<0>(it >> 4, it & 15, XC, DT, Z, args.in[11], args.in[12], YQ, SSQ, ldsp, tid, lane, wave);
#endif
    }
    SEAM(4);

    if (IN(5)) REP(5) {
        PH_IDS();
        pg8::Sched2 S; S.init(G, bx);
        LAS float* rt = (LAS float*)(ldsp + RSTD_OFF);
        { pg8::Unit u; for (int i = 0; i < 4 && S.next(i, u); ++i) if (tid < 256) { const float* q = SSQ + ((size_t)u.pm * 256 + tid) * 16; float s = 0.f;
#pragma unroll
                for (int j = 0; j < 16; ++j) s += q[j];
                rt[i * 256 + tid] = rsqrtf(s * (1.f / 1024.f) + EPS); } }
        __syncthreads();
        pg8::Gemm g{YQ, bt2, ML, 1024, 2048};
        pg8::Epi2 E{args.in[0], mod, args.in[17], args.out, (unsigned long long*)RPART, (unsigned*)(ctl + CW_CNT), (unsigned*)(ctl + CW_TMO2), (const LAS float*)rt, (LAS float*)(ldsp + EXL_OFF)};
        pg8::gemm_phase<pg8::Epi2, pg8::Sched2, true, true>(ldsp + RING_OFF, g, S, E, wave);
    }

#undef IN
#undef SEAM
}

extern "C" void kernel_launch(void* const* d_in, const int* in_sizes, int n_in, void* d_out, int out_size, void* d_ws, size_t ws_size, hipStream_t stream) {
    if (n_in != 18 || out_size != ML * DM || ws_size < WS_END) { fprintf(stderr, "kernel_launch: unexpected shapes (n_in %d out %d ws %zu); nothing launched\n", n_in, out_size, ws_size); return; }
    static int grid = 0;
    if (grid == 0) {
        int dev = 0, cus = 0;
        if (hipGetDevice(&dev) != hipSuccess || hipDeviceGetAttribute(&cus, hipDeviceAttributeMultiprocessorCount, dev) != hipSuccess) { fprintf(stderr, "kernel_launch: device query failed\n"); grid = -1; return; }
        if (hipFuncSetAttribute((const void*)mega, hipFuncAttributeMaxDynamicSharedMemorySize, LDS_BYTES) != hipSuccess) { fprintf(stderr, "kernel_launch: hipFuncSetAttribute failed\n"); grid = -1; return; }
        int per_cu = 0;
        if (hipOccupancyMaxActiveBlocksPerMultiprocessor(&per_cu, (const void*)mega, NWAVES * 64, LDS_BYTES) != hipSuccess || per_cu < 1) fprintf(stderr, "kernel_launch: note: occupancy query says %d blocks/CU\n", per_cu);
        (void)hipGetLastError();
        grid = cus;
    }
    if (grid < 0) return;
    (void)hipMemsetAsync((unsigned char*)d_ws + WS_CTL, 0, 1 * MiB, stream);
    Args a{};
    for (int i = 0; i < 18; ++i) a.in[i] = (const float*)d_in[i];
    a.out = (float*)d_out; a.ws = (unsigned char*)d_ws; a.ph_lo = 0; a.ph_hi = NPHASE;
    hipLaunchKernelGGL(mega, dim3(grid), dim3(NWAVES * 64), LDS_BYTES, stream, a);
    const hipError_t le = hipPeekAtLastError(); if (le != hipSuccess) fprintf(stderr, "kernel_launch: launch failed: %s\n", hipGetErrorName(le));
}
```

```cpp
#include <hip/hip_runtime.h>
#include <cstdio>
#include <cstdint>
#include <hip/hip_bf16.h>

constexpr int DM = 1024, NB = 32, SEQ = 2048, CTXL = 256, KVL = SEQ + CTXL;
constexpr int ML = NB * SEQ, MC = NB * CTXL, MT = ML + MC;
constexpr int PROJ = 5152, OFF_XBC = 512, OFF_DT = 2048, CTXC = 2080, CONVC = 1536;
constexpr int N1 = 21 * 256;
constexpr float EPS = 1e-6f;
constexpr float C2 = 0.125f * 1.4426950408889634f;

typedef unsigned short bf16;
__device__ __forceinline__ int mk_lane() { return (int)__builtin_amdgcn_mbcnt_hi(~0u, __builtin_amdgcn_mbcnt_lo(~0u, 0u)); }
__host__ __device__ __forceinline__ unsigned f2bf(float f) { unsigned u = __builtin_bit_cast(unsigned, f); return (u + 0x7fffu + ((u >> 16) & 1u)) >> 16; }
__host__ __device__ __forceinline__ float bf2f(unsigned h) { return __builtin_bit_cast(float, (h & 0xffffu) << 16); }
__device__ __forceinline__ float siluf(float v) { return v / (1.f + __expf(-v)); }
__device__ __forceinline__ float softplusf(float v) { return v > 20.f ? v : log1pf(expf(v)); }

constexpr size_t MiB = 1u << 20;
constexpr size_t WS_CTL = 0;
constexpr size_t WS_MOD = 2 * MiB;
constexpr size_t WS_ROPE = 3 * MiB;
constexpr size_t WS_SSQ = 4 * MiB;
constexpr size_t WS_RPART = 8 * MiB;
constexpr size_t WS_BT1 = 12 * MiB;
constexpr size_t WS_BT2 = 23 * MiB;
constexpr size_t WS_DT = 28 * MiB;
constexpr size_t WS_KB = 38 * MiB;
constexpr size_t WS_VB = 74 * MiB;
constexpr size_t WS_R1 = 110 * MiB;
constexpr size_t WS_XBC = 326 * MiB;
constexpr size_t WS_YQ = 542 * MiB;
constexpr size_t WS_Z = 798 * MiB;
constexpr size_t WS_END = 926 * MiB;

__host__ __device__ __forceinline__ int hperm_dim(int vin) {
    const int bj = vin >> 7, wc = (vin >> 5) & 3, s = vin & 31, fq = s >> 3, e = s & 7;
    return wc * 64 + bj * 32 + (e >> 2) * 16 + 4 * fq + (e & 3);
}
__host__ __device__ __forceinline__ int hperm_inv(int head, int dim) {
    const int axis = dim >> 5, half = (dim >> 4) & 1, i16 = dim & 15, fq = i16 >> 2, e = (i16 & 3) + 4 * half;
    return 128 * axis + 32 * head + 8 * fq + e;
}
__host__ __device__ __forceinline__ int vcol_actual(int v) {
    const int t = v >> 8, vin = v & 255;
    if (t == 0) return hperm_dim(vin);
    if (t == 1) return 256 + vin;
    if (t < 8) return v;
    if (t == 8) return vin < 32 ? OFF_DT + vin : -1;
    if (t < 13) return CTXC + (t - 9) * 256 + hperm_dim(vin);
    if (t < 17) return CTXC + 1024 + (v - 13 * 256);
    return CTXC + 2048 + (v - 17 * 256);
}

namespace pg8 {
#define PG8_LAS __attribute__((address_space(3)))
typedef unsigned short bf16_t;
typedef short bf16x8 __attribute__((ext_vector_type(8)));
typedef float f32x4 __attribute__((ext_vector_type(4)));
typedef unsigned u32x4 __attribute__((ext_vector_type(4)));
constexpr int BM = 256, BK = 64, HALF = 128, HTB = HALF * BK * 2  , STAGE_BYTES = 8 * HTB, NXCD = 8, WGM = 8;

__host__ __device__ __forceinline__ int lds_byte(int r, int c) { const int st = (r >> 4) * 2 + (c >> 5), rr = r & 15, cc = c & 31, ob = rr * 64 + cc * 2; return st * 1024 + (ob ^ (((ob >> 9) & 1) << 5)); }
__host__ __device__ __forceinline__ void stage_rc(int b, int& R, int& C) { const int st = b / 1024, sb = b % 1024, swz = sb ^ (((sb >> 9) & 1) << 5); R = (st >> 1) * 16 + swz / 64; C = (st & 1) * 32 + (swz % 64) / 2; }
__host__ __device__ __forceinline__ int perm32(int rho) { const int n = rho >> 4, i = rho & 15; return 8 * (i >> 2) + 4 * n + (i & 3); }

struct Unit { int pm, pn; };
struct Gemm { const bf16_t* A; const bf16_t* Bt; int M, N, K; };

__device__ __forceinline__ unsigned cvt_pk_bf16(float lo, float hi) { unsigned r; asm volatile("v_cvt_pk_bf16_f32 %0, %1, %2" : "=v"(r) : "v"(lo), "v"(hi)); return r; }
typedef float f32x2 __attribute__((ext_vector_type(2)));
template <class Epi, class Sched, bool ALIGN_EPI = false, bool SP2 = false>
__device__ __forceinline__ void gemm_phase(PG8_LAS unsigned char* lds, const Gemm g, const Sched& S, const Epi& E, int wid_in) {
    const int wid = wid_in; int lane = mk_lane(); asm volatile("" : "+v"(lane)); const int tid = wid * 64 + lane, wr = wid >> 2, wc = wid & 3, fr = lane & 15, fq = lane >> 4;
    const int K = g.K, nt = K / BK;
    unsigned voffA[2], voffB[2];
#pragma unroll
    for (int i = 0; i < 2; ++i) { int R, C; stage_rc(tid * 16 + i * 8192, R, C); const int Rb = Epi::PERM ? ((R & ~31) + perm32(R & 31)) : R;
        voffA[i] = (unsigned)(R * K + C) * 2u; voffB[i] = (unsigned)(Rb * K + C) * 2u; }
    const size_t kstep = (size_t)(BK * 2);
    const size_t hstep = (size_t)HALF * K * 2;
    const size_t tstep = 2 * hstep;
    const unsigned ldsw = (unsigned)wid * 1024u;
    const int aoff = lds_byte(wr * 64 + fr, fq * 8), boff = lds_byte(wc * 32 + fr, fq * 8);
#define PG8_SA(b, h) (((b) * 2 + (h)) * HTB)
#define PG8_SB(b, h) ((4 + (b) * 2 + (h)) * HTB)
#define PG8_STAGE(bufoff, gbase, voff) do { _Pragma("unroll") for (int _i = 0; _i < 2; ++_i) \
        __builtin_amdgcn_global_load_lds((const unsigned*)((const char*)(gbase) + (voff)[_i]), (PG8_LAS unsigned*)(lds + (bufoff) + ldsw + _i * 8192), 16, 0, 0); } while (0)
#define PG8_LDA(dst, b, h) do { _Pragma("unroll") for (int m = 0; m < 4; ++m) _Pragma("unroll") for (int k = 0; k < 2; ++k) dst[m][k] = *(const PG8_LAS bf16x8*)(lds + PG8_SA(b, h) + aoff + m * 2048 + k * 1024); } while (0)
#define PG8_LDB(dst, b, h) do { _Pragma("unroll") for (int n = 0; n < 2; ++n) _Pragma("unroll") for (int k = 0; k < 2; ++k) dst[n][k] = *(const PG8_LAS bf16x8*)(lds + PG8_SB(b, h) + boff + n * 2048 + k * 1024); } while (0)
#define PG8_MMA(ai, bj, At, Bt) do { __builtin_amdgcn_s_setprio(1); _Pragma("unroll") for (int m = 0; m < 4; ++m) _Pragma("unroll") for (int n = 0; n < 2; ++n) _Pragma("unroll") for (int k = 0; k < 2; ++k) \
        acc[ai][bj][m][n] = __builtin_amdgcn_mfma_f32_16x16x32_bf16(Bt[n][k], At[m][k], acc[ai][bj][m][n], 0, 0, 0); __builtin_amdgcn_s_setprio(0); } while (0)
#define PG8_WAIT_V(n) asm volatile("s_waitcnt vmcnt(" #n ")" ::: "memory")
#define PG8_WAIT_L(n) asm volatile("s_waitcnt lgkmcnt(" #n ")" ::: "memory")
#define PG8_BAR __builtin_amdgcn_s_barrier()
#define PG8_SCHED __builtin_amdgcn_sched_barrier(0)
    Unit cur, nxt; int ui = 0;
    if (!S.next(0, cur)) return;
    f32x4 acc[2][2][4][2];
#pragma unroll
    for (int a = 0; a < 2; ++a)
#pragma unroll
        for (int b = 0; b < 2; ++b)
#pragma unroll
            for (int m = 0; m < 4; ++m)
#pragma unroll
                for (int n = 0; n < 2; ++n) acc[a][b][m][n] = (f32x4){0.f, 0.f, 0.f, 0.f};
    bf16x8 At[4][2], B0[2][2], B1[2][2];
    const char* cA = (const char*)g.A + (size_t)cur.pm * tstep; const char* cB = (const char*)g.Bt + (size_t)cur.pn * tstep;
    S.a_ready(cur);
    if constexpr (SP2) {
        PG8_STAGE(PG8_SB(0, 0), cB, voffB); PG8_STAGE(PG8_SB(0, 1), cB + hstep, voffB); PG8_STAGE(PG8_SA(0, 0), cA, voffA); PG8_STAGE(PG8_SA(0, 1), cA + hstep, voffA);
        if (wr == 1) PG8_BAR;
        PG8_WAIT_V(2); PG8_BAR;
        PG8_STAGE(PG8_SB(1, 0), cB + kstep, voffB); PG8_STAGE(PG8_SA(1, 0), cA + kstep, voffA); PG8_STAGE(PG8_SB(1, 1), cB + hstep + kstep, voffB);
        PG8_WAIT_V(6); PG8_BAR;
    } else {
        PG8_STAGE(PG8_SB(0, 0), cB, voffB); PG8_STAGE(PG8_SA(0, 0), cA, voffA); PG8_STAGE(PG8_SB(0, 1), cB + hstep, voffB); PG8_STAGE(PG8_SA(0, 1), cA + hstep, voffA);
        if (wr == 1) PG8_BAR;
        PG8_WAIT_V(4); PG8_BAR;
        PG8_STAGE(PG8_SB(1, 0), cB + kstep, voffB); PG8_STAGE(PG8_SA(1, 0), cA + kstep, voffA); PG8_STAGE(PG8_SB(1, 1), cB + hstep + kstep, voffB);
        PG8_WAIT_V(6); PG8_BAR;
    }
    for (;;) {
        const bool has_next = S.next(ui + 1, nxt);
        const char* nA = has_next ? (const char*)g.A + (size_t)nxt.pm * tstep : cA; const char* nB = has_next ? (const char*)g.Bt + (size_t)nxt.pn * tstep : cB;
        for (int t = 0; t < nt; t += 2) {
            if constexpr (Epi::MIDK) { if (t == nt / 2) E.midk(acc, ui, wr, fr); }
            const bool last = (t == nt - 2);
            const char* a1 = cA + (size_t)(t + 1) * kstep;
            const char* a2 = last ? nA : cA + (size_t)(t + 2) * kstep; const char* b2 = last ? nB : cB + (size_t)(t + 2) * kstep;
            const char* a3 = a2 + kstep; const char* b3 = b2 + kstep;
            if (last && has_next) S.a_ready(nxt);
            if constexpr (SP2) {
            PG8_LDB(B0, 0, 0); PG8_LDB(B1, 0, 1); PG8_SCHED; PG8_LDA(At, 0, 0); PG8_STAGE(PG8_SA(1, 1), a1 + hstep, voffA);
            PG8_WAIT_V(8); PG8_WAIT_L(0); PG8_BAR; PG8_MMA(0, 0, At, B0); PG8_MMA(0, 1, At, B1); PG8_BAR; PG8_SCHED;
            PG8_LDA(At, 0, 1); PG8_STAGE(PG8_SB(0, 0), b2, voffB); PG8_STAGE(PG8_SB(0, 1), b2 + hstep, voffB); PG8_STAGE(PG8_SA(0, 0), a2, voffA);
            PG8_WAIT_V(8); PG8_WAIT_L(0); PG8_BAR; PG8_MMA(1, 0, At, B0); PG8_MMA(1, 1, At, B1); PG8_BAR; PG8_SCHED;
            PG8_LDB(B0, 1, 0); PG8_LDB(B1, 1, 1); PG8_SCHED; PG8_LDA(At, 1, 0); PG8_STAGE(PG8_SA(0, 1), a2 + hstep, voffA);
            PG8_WAIT_V(8); PG8_WAIT_L(0); PG8_BAR; PG8_MMA(0, 0, At, B0); PG8_MMA(0, 1, At, B1); PG8_BAR; PG8_SCHED;
            PG8_LDA(At, 1, 1); PG8_STAGE(PG8_SB(1, 0), b3, voffB); PG8_STAGE(PG8_SB(1, 1), b3 + hstep, voffB); PG8_STAGE(PG8_SA(1, 0), a3, voffA);
            PG8_WAIT_V(8); PG8_WAIT_L(0); PG8_BAR; PG8_MMA(1, 0, At, B0); PG8_MMA(1, 1, At, B1); PG8_BAR; PG8_SCHED;
            } else {
            PG8_LDB(B0, 0, 0); PG8_SCHED; PG8_LDA(At, 0, 0); PG8_STAGE(PG8_SA(1, 1), a1 + hstep, voffA);
            PG8_WAIT_L(8); PG8_BAR; PG8_WAIT_L(0); PG8_MMA(0, 0, At, B0); PG8_BAR; PG8_SCHED;
            PG8_LDB(B1, 0, 1); PG8_STAGE(PG8_SB(0, 0), b2, voffB);
            PG8_BAR; PG8_WAIT_L(0); PG8_MMA(0, 1, At, B1); PG8_BAR;
            PG8_LDA(At, 0, 1); PG8_STAGE(PG8_SA(0, 0), a2, voffA);
            PG8_BAR; PG8_WAIT_L(0); PG8_MMA(1, 0, At, B0); PG8_BAR; PG8_SCHED;
            PG8_STAGE(PG8_SB(0, 1), b2 + hstep, voffB);
            PG8_WAIT_V(6); PG8_BAR; PG8_MMA(1, 1, At, B1); PG8_BAR;
            PG8_LDB(B0, 1, 0); PG8_SCHED; PG8_LDA(At, 1, 0); PG8_STAGE(PG8_SA(0, 1), a2 + hstep, voffA);
            PG8_WAIT_L(8); PG8_BAR; PG8_WAIT_L(0); PG8_MMA(0, 0, At, B0); PG8_BAR; PG8_SCHED;
            PG8_LDB(B1, 1, 1); PG8_STAGE(PG8_SB(1, 0), b3, voffB);
            PG8_BAR; PG8_WAIT_L(0); PG8_MMA(0, 1, At, B1); PG8_BAR;
            PG8_LDA(At, 1, 1); PG8_STAGE(PG8_SA(1, 0), a3, voffA);
            PG8_BAR; PG8_WAIT_L(0); PG8_MMA(1, 0, At, B0); PG8_BAR; PG8_SCHED;
            PG8_STAGE(PG8_SB(1, 1), b3 + hstep, voffB);
            PG8_WAIT_V(6); PG8_BAR; PG8_MMA(1, 1, At, B1); PG8_BAR;
            }
        }
        if constexpr (ALIGN_EPI) { if (wr == 0) PG8_BAR; }
        if constexpr (!Epi::AFTER_DRAIN) { E(acc, cur, wr, wc, fr, fq); S.done(cur); }
        if (!has_next) break;
#pragma unroll
        for (int a = 0; a < 2; ++a)
#pragma unroll
            for (int b = 0; b < 2; ++b)
#pragma unroll
                for (int m = 0; m < 4; ++m)
#pragma unroll
                    for (int n = 0; n < 2; ++n) acc[a][b][m][n] = (f32x4){0.f, 0.f, 0.f, 0.f};
        cur = nxt; cA = nA; cB = nB; ++ui;
        if constexpr (ALIGN_EPI) { if (wr == 1) PG8_BAR; }
    }
    PG8_WAIT_V(0);
    if constexpr (!ALIGN_EPI) { if (wr == 0) PG8_BAR; }
    PG8_BAR;
    if constexpr (Epi::AFTER_DRAIN) { E.fused(acc, cur, wr, wc, fr, fq, lds, wid, lane); S.done(cur); }
#undef PG8_SA
#undef PG8_SB
#undef PG8_STAGE
#undef PG8_LDA
#undef PG8_LDB
#undef PG8_MMA
#undef PG8_WAIT_V
#undef PG8_WAIT_L
#undef PG8_BAR
#undef PG8_SCHED
}
struct Sched1 {
    int G, c;
    __device__ __forceinline__ void init(int G_, int c_) { G = G_; c = c_; }
    __device__ __forceinline__ bool next(int i, Unit& u) const {
        constexpr int nN = 21, nwg = 256 * nN;
        const int L = i * G + c;
        if (L < nwg) { const int wgid = (L % NXCD) * (nwg / NXCD) + L / NXCD; const int nig = WGM * nN, fm = (wgid / nig) * WGM;
            u.pm = fm + ((wgid % nig) % WGM); u.pn = (wgid % nig) / WGM; return true; }
        const int L2 = L - nwg; if (L2 >= 256) return false;
        const int wg = (L2 % NXCD) * 32 + L2 / NXCD; u.pn = wg >> 5; u.pm = 256 + (wg & 31); return true;
    }
    __device__ __forceinline__ void a_ready(const Unit&) const {}
    __device__ __forceinline__ void done(const Unit&) const {}
};
struct Sched2 {
    int G, c;
    __device__ __forceinline__ void init(int G_, int c_) { G = G_; c = c_; }
    __device__ __forceinline__ bool next(int i, Unit& u) const {
        constexpr int nN = 4, nwg = 256 * nN;
        const int L = i * G + c; if (L >= nwg) return false;
        const int wgid = (L % NXCD) * (nwg / NXCD) + L / NXCD; const int nig = WGM * nN, fm = (wgid / nig) * WGM;
        u.pm = fm + ((wgid % nig) % WGM); u.pn = (wgid % nig) / WGM; return true;
    }
    __device__ __forceinline__ void a_ready(const Unit&) const {}
    __device__ __forceinline__ void done(const Unit&) const {}
};
__device__ __forceinline__ float dot4(const f32x4 a) { return (a[0] * a[0] + a[1] * a[1]) + (a[2] * a[2] + a[3] * a[3]); }
__device__ __forceinline__ float silu1(float v) { return v * __builtin_amdgcn_rcpf(1.f + __expf(-v)); }
typedef unsigned u32x2 __attribute__((ext_vector_type(2)));
__device__ __forceinline__ u32x2 pk4(const f32x4 v) { u32x2 w; w.x = cvt_pk_bf16(v[0], v[1]); w.y = cvt_pk_bf16(v[2], v[3]); return w; }
struct Epi1 {
    static constexpr bool PERM = true, AFTER_DRAIN = false, MIDK = false;
    bf16_t *KB, *VB, *XBC, *YQ, *Z; float* DT; const float *rope, *qg, *kg, *dt_bias;
    __device__ __forceinline__ void midk(f32x4 (&)[2][2][4][2], int, int, int) const {}
    __device__ __forceinline__ void operator()(const f32x4 (&acc)[2][2][4][2], const Unit& u, int wr, int wc, int fr_in, int fq_in) const {
        int fr = fr_in, fq = fq_in; asm volatile("" : "+v"(fr), "+v"(fq));
        const int pn = u.pn, pm = u.pm; const bool isctx = pm >= 256; const int rloc = wr * 64 + fr;
        const int bb = isctx ? pm - 256 : pm >> 3, pos0 = isctx ? SEQ : (pm & 7) * 256;
        if (pn == 0 || (pn >= 9 && pn < 13)) {
            const float* g = pn == 0 ? kg : qg;
            const f32x4 g00 = *(const f32x4*)(g + 4 * fq), g01 = *(const f32x4*)(g + 16 + 4 * fq), g10 = *(const f32x4*)(g + 32 + 4 * fq), g11 = *(const f32x4*)(g + 48 + 4 * fq);
            const float osc = pn == 0 ? 1.f : C2;
            bf16_t* dbase; size_t pitch;
            if (pn == 0) { dbase = KB + ((size_t)bb * KVL + pos0) * 256 + wc * 64 + 4 * fq; pitch = 256; }
            else { dbase = YQ + (size_t)pm * 256 * 2048 + 1024 + ((pn - 9) * 4 + wc) * 64 + 4 * fq; pitch = 2048; }
#pragma unroll
            for (int ai = 0; ai < 2; ++ai) {
                const int prow = (pm & 7) * 4 + 2 * ai + wr;
                f32x4 c0 = (f32x4){1.f, 1.f, 1.f, 1.f}, s0 = (f32x4){0.f, 0.f, 0.f, 0.f};
                if (!isctx) { c0 = *(const f32x4*)(rope + prow * 16 + 4 * fq); s0 = *(const f32x4*)(rope + 1024 + prow * 16 + 4 * fq); }
#pragma unroll
                for (int m = 0; m < 4; ++m) {
                    f32x4 a0 = acc[ai][0][m][0], a1 = acc[ai][0][m][1], b0 = acc[ai][1][m][0], b1 = acc[ai][1][m][1];
                    float s = (dot4(a0) + dot4(a1)) + (dot4(b0) + dot4(b1));
                    s += __shfl_xor(s, 16); s += __shfl_xor(s, 32);
                    const float rstd = rsqrtf(s * (1.f / 64.f) + EPS) * osc;
                    a0 = a0 * rstd * g00; a1 = a1 * rstd * g01; b0 = b0 * rstd * g10; b1 = b1 * rstd * g11;
                    f32x4 c1 = (f32x4){1.f, 1.f, 1.f, 1.f}, s1 = (f32x4){0.f, 0.f, 0.f, 0.f};
                    if (!isctx) { const int pcol = 16 * m + fr; c1 = *(const f32x4*)(rope + pcol * 16 + 4 * fq); s1 = *(const f32x4*)(rope + 1024 + pcol * 16 + 4 * fq); }
                    const f32x4 o00 = a0 * c0 - a1 * s0, o01 = a1 * c0 + a0 * s0, o10 = b0 * c1 - b1 * s1, o11 = b1 * c1 + b0 * s1;
                    bf16_t* dst = dbase + (size_t)(rloc + 128 * ai + 16 * m) * pitch;
                    *(u32x2*)(dst) = pk4(o00); *(u32x2*)(dst + 16) = pk4(o01); *(u32x2*)(dst + 32) = pk4(o10); *(u32x2*)(dst + 48) = pk4(o11);
                    asm volatile("" ::: "memory");
                }
            }
        } else if (pn == 8) {
            if (wc == 0) {
                const f32x4 bA = *(const f32x4*)(dt_bias + 8 * fq), bB = *(const f32x4*)(dt_bias + 8 * fq + 4);
#pragma unroll
                for (int ai = 0; ai < 2; ++ai)
#pragma unroll
                    for (int m = 0; m < 4; ++m) { const size_t row = (size_t)pm * 256 + rloc + 128 * ai + 16 * m;
                        f32x4 v0 = acc[ai][0][m][0] + bA, v1 = acc[ai][0][m][1] + bB;
#pragma unroll
                        for (int e = 0; e < 4; ++e) { v0[e] = v0[e] > 20.f ? v0[e] : log1pf(__expf(v0[e])); v1[e] = v1[e] > 20.f ? v1[e] : log1pf(__expf(v1[e])); }
                        *(f32x4*)(DT + row * 32 + 8 * fq) = v0; *(f32x4*)(DT + row * 32 + 8 * fq + 4) = v1; asm volatile("" ::: "memory"); }
            }
        } else {
            bf16_t* dbase; size_t pitch; bool act = false;
            const int cin = wc * 32 + 8 * fq;
            if (pn == 1) { dbase = VB + ((size_t)bb * KVL + pos0) * 256 + cin; pitch = 256; }
            else if (pn < 8) { dbase = XBC + (size_t)pm * 256 * CONVC + (pn - 2) * 256 + cin; pitch = CONVC; }
            else if (pn < 17) { dbase = YQ + (size_t)pm * 256 * 2048 + (pn - 13) * 256 + cin; pitch = 2048; act = true; }
            else { dbase = Z + (size_t)pm * 256 * 1024 + (pn - 17) * 256 + cin; pitch = 1024; act = true; }
#pragma unroll
            for (int ai = 0; ai < 2; ++ai)
#pragma unroll
                for (int m = 0; m < 4; ++m) { bf16_t* dst = dbase + (size_t)(rloc + 128 * ai + 16 * m) * pitch;
#pragma unroll
                    for (int bj = 0; bj < 2; ++bj) { f32x4 v0 = acc[ai][bj][m][0], v1 = acc[ai][bj][m][1];
                        if (act) {
#pragma unroll
                            for (int e = 0; e < 4; ++e) { v0[e] = silu1(v0[e]); v1[e] = silu1(v1[e]); } }
                        u32x4 w; w.x = cvt_pk_bf16(v0[0], v0[1]); w.y = cvt_pk_bf16(v0[2], v0[3]); w.z = cvt_pk_bf16(v1[0], v1[1]); w.w = cvt_pk_bf16(v1[2], v1[3]);
                        *(u32x4*)(dst + bj * HALF) = w; } asm volatile("" ::: "memory"); }
        }
    }
};
struct Epi2 {
    static constexpr bool PERM = false, AFTER_DRAIN = false, MIDK = true;
    const float* x; const float* mod; const float* fg; float* out; unsigned long long* xbuf; unsigned* cnt; unsigned* tmo; const PG8_LAS float* rstd_tab; PG8_LAS float* exl;
    __device__ __forceinline__ void midk(f32x4 (&acc)[2][2][4][2], int ui, int wr, int fr) const {
#pragma unroll
        for (int ai = 0; ai < 2; ++ai)
#pragma unroll
            for (int m = 0; m < 4; ++m) { const float r = rstd_tab[ui * 256 + 128 * ai + 64 * wr + 16 * m + fr];
#pragma unroll
                for (int bj = 0; bj < 2; ++bj)
#pragma unroll
                    for (int n = 0; n < 2; ++n) acc[ai][bj][m][n] *= r; }
    }
    __device__ __forceinline__ void operator()(f32x4 (&acc)[2][2][4][2], const Unit& u, int wr, int wc, int fr_in, int fq_in) const {
        int fr = fr_in, fq = fq_in; asm volatile("" : "+v"(fr), "+v"(fq));
        const int lane = mk_lane(); const int tid = (wr * 4 + wc) * 64 + lane;
        const int b = u.pm >> 3, col0 = u.pn * BM + wc * 32 + 4 * fq;
        PG8_LAS float* P = exl; PG8_LAS float* S = exl + 1024;
        { f32x4 gv[2][2];
#pragma unroll
          for (int bj = 0; bj < 2; ++bj)
#pragma unroll
            for (int n = 0; n < 2; ++n) gv[bj][n] = *(const f32x4*)(mod + (size_t)b * 3072 + 2048 + col0 + bj * HALF + n * 16);
#pragma unroll
          for (int ai = 0; ai < 2; ++ai)
#pragma unroll
            for (int m = 0; m < 4; ++m) { const int rt = 128 * ai + 64 * wr + 16 * m + fr; const size_t off = ((size_t)u.pm * BM + rt) * 1024 + col0; float q = 0.f;
#pragma unroll
                for (int bj = 0; bj < 2; ++bj)
#pragma unroll
                    for (int n = 0; n < 2; ++n) { const f32x4 xv = *(const f32x4*)(x + off + bj * HALF + n * 16); const f32x4 o = xv + gv[bj][n] * acc[ai][bj][m][n]; acc[ai][bj][m][n] = o; q += dot4(o); }
                q += __shfl_xor(q, 16); q += __shfl_xor(q, 32);
                if (fq == 0) P[rt * 4 + wc] = q;
                if (m == 3) asm volatile("" ::: "memory"); } }
        asm volatile("s_waitcnt lgkmcnt(0)" ::: "memory"); __builtin_amdgcn_s_barrier(); asm volatile("" ::: "memory");
        if (tid < 256) {
            const f32x4 p = *(const PG8_LAS f32x4*)(P + tid * 4); const float s = (p[0] + p[1]) + (p[2] + p[3]);
            __hip_atomic_store((float*)xbuf + ((size_t)u.pm * BM + tid) * 4 + u.pn, s, __ATOMIC_RELAXED, __HIP_MEMORY_SCOPE_AGENT);
        }
        asm volatile("s_waitcnt vmcnt(0)" ::: "memory");
        if (tid < 256 && lane == 0) __hip_atomic_fetch_add(cnt + 64 * u.pm, 1u, __ATOMIC_RELAXED, __HIP_MEMORY_SCOPE_AGENT);
        if (tid < 64) {
            unsigned sp = 0;
            while ((unsigned)__builtin_amdgcn_readfirstlane(__hip_atomic_load(cnt + 64 * u.pm, __ATOMIC_RELAXED, __HIP_MEMORY_SCOPE_AGENT)) < 16u) {
                __builtin_amdgcn_s_sleep(2); if (++sp > (1u << 22)) { if (lane == 0) __hip_atomic_store(tmo, 1u, __ATOMIC_RELAXED, __HIP_MEMORY_SCOPE_AGENT); break; } }
        }
        asm volatile("s_waitcnt vmcnt(0) lgkmcnt(0)" ::: "memory"); __builtin_amdgcn_s_barrier(); asm volatile("" ::: "memory");
        if (tid < 256) {
            const unsigned long long* sl = xbuf + ((size_t)u.pm * BM + tid) * 2;
            const unsigned long long w0 = __hip_atomic_load(sl, __ATOMIC_RELAXED, __HIP_MEMORY_SCOPE_AGENT), w1 = __hip_atomic_load(sl + 1, __ATOMIC_RELAXED, __HIP_MEMORY_SCOPE_AGENT);
            const float s = (__uint_as_float((unsigned)w0) + __uint_as_float((unsigned)(w0 >> 32))) + (__uint_as_float((unsigned)w1) + __uint_as_float((unsigned)(w1 >> 32)));
            S[tid] = rsqrtf(s * (1.f / 1024.f) + EPS);
        }
        asm volatile("s_waitcnt lgkmcnt(0)" ::: "memory"); __builtin_amdgcn_s_barrier(); asm volatile("" ::: "memory");
        { f32x4 fv[2][2];
#pragma unroll
          for (int bj = 0; bj < 2; ++bj)
#pragma unroll
            for (int n = 0; n < 2; ++n) fv[bj][n] = *(const f32x4*)(fg + col0 + bj * HALF + n * 16);
#pragma unroll
          for (int ai = 0; ai < 2; ++ai)
#pragma unroll
            for (int m = 0; m < 4; ++m) { const int rt = 128 * ai + 64 * wr + 16 * m + fr; const size_t off = ((size_t)u.pm * BM + rt) * 1024 + col0; const float r = S[rt];
#pragma unroll
                for (int bj = 0; bj < 2; ++bj)
#pragma unroll
                    for (int n = 0; n < 2; ++n) *(f32x4*)(out + off + bj * HALF + n * 16) = acc[ai][bj][m][n] * r * fv[bj][n];
                if (m & 1) asm volatile("" ::: "memory"); } }
    }
};
}
#define GAS __attribute__((address_space(1)))
#define LAS __attribute__((address_space(3)))
typedef unsigned v4u __attribute__((ext_vector_type(4)));
typedef GAS unsigned gu32;
typedef GAS unsigned long long gu64;
#define RLX_AGENT __ATOMIC_RELAXED, __HIP_MEMORY_SCOPE_AGENT
#define LDS_WAIT() asm volatile("s_waitcnt lgkmcnt(0)" ::: "memory")
#define VM_WAIT() asm volatile("s_waitcnt vmcnt(0)" ::: "memory")
__device__ __forceinline__ unsigned long long rt() { return __builtin_amdgcn_s_memrealtime(); }
typedef float f32x2_pk __attribute__((ext_vector_type(2))); typedef __bf16 bf16x2_pk __attribute__((ext_vector_type(2)));
__device__ __forceinline__ unsigned pk2(float lo, float hi) { const f32x2_pk v = {lo, hi}; return __builtin_bit_cast(unsigned, __builtin_convertvector(v, bf16x2_pk)); }
#define XB_TMO      128
#define XB_XCNT(j)  (256  + 64 * (j))
#define XB_XSUB(j)  (1280 + 64 * (j))
#define XB_XGEN(j)  (2304 + 64 * (j))
#define XB_TOP      3328
#define XB_TOPGEN   3392
#define XCD_BAR_WORDS 3456
#define XB_SPIN_CAP (1u << 22)

__device__ __forceinline__ unsigned xb_ld(unsigned* p)              { return __hip_atomic_load(p, __ATOMIC_RELAXED, __HIP_MEMORY_SCOPE_AGENT); }
__device__ __forceinline__ unsigned xb_add(unsigned* p, unsigned v) { return __hip_atomic_fetch_add(p, v, __ATOMIC_RELAXED, __HIP_MEMORY_SCOPE_AGENT); }
__device__ __forceinline__ unsigned xb_xcc_id() { return (unsigned)__builtin_amdgcn_s_getreg((3 << 11) | 20) & 0xFu; }
#define XB_SPIN(cond, bar) do { unsigned _sp = 0; while (cond) { __builtin_amdgcn_s_sleep(1); \
    if ((++_sp & 255u) == 0u) { if (xb_ld(&(bar)[XB_TMO])) break; if (_sp > XB_SPIN_CAP) { atomicAdd(&(bar)[XB_TMO], 1u); break; } } } } while (0)

struct XcdBarrier {
    unsigned* bar; unsigned x;
    volatile LAS unsigned* st;
};

__device__ __forceinline__ XcdBarrier xcd_barrier_post(unsigned* bar, volatile LAS unsigned* st, bool leader) {
    XcdBarrier b; b.bar = bar; b.x = xb_xcc_id(); b.st = st;
    if (leader) (void)xb_add(&bar[XB_XCNT(b.x)], 1u);
    return b;
}
__device__ __forceinline__ void xcd_barrier_complete(unsigned* bar, unsigned x, unsigned& nloc, unsigned& nx) {
    const unsigned G = gridDim.x * gridDim.y * gridDim.z;
    unsigned sum, cnt, mine, sp = 0u;
    for (;;) {
        sum = 0u; cnt = 0u; mine = 0u;
#pragma unroll
        for (unsigned j = 0; j < 16; ++j) { const unsigned c = xb_ld(&bar[XB_XCNT(j)]); sum += c; cnt += (c > 0u) ? 1u : 0u; mine = (j == x) ? c : mine; }
        if (sum == G) break;
        __builtin_amdgcn_s_sleep(1);
        if ((++sp & 255u) == 0u) { if (xb_ld(&bar[XB_TMO])) break; if (sp > XB_SPIN_CAP) { atomicAdd(&bar[XB_TMO], 1u); break; } }
    }
    nloc = mine > 0u ? mine : 1u; nx = cnt > 0u ? cnt : 1u;
}

__device__ __forceinline__ void xcd_barrier(const XcdBarrier& b, bool leader) {
    asm volatile("s_waitcnt vmcnt(0)" ::: "memory");
    __syncthreads();
    if (leader) {
        unsigned* bar = b.bar;
        __builtin_amdgcn_s_waitcnt(0);
        unsigned nloc = b.st[0], nx = b.st[1];
        if (nloc == 0u) { xcd_barrier_complete(bar, b.x, nloc, nx); b.st[0] = nloc; b.st[1] = nx; }
        const unsigned old = xb_add(&bar[XB_XSUB(b.x)], 1u);
        const unsigned gen = old / nloc;
        if (old + 1u == (gen + 1u) * nloc) {
            __builtin_amdgcn_fence(__ATOMIC_RELEASE, "agent");
            asm volatile("s_waitcnt vmcnt(0)" ::: "memory");
            const unsigned og = xb_add(&bar[XB_TOP], 1u);
            const unsigned tg = og / nx;
            if (og + 1u == (tg + 1u) * nx) xb_add(&bar[XB_TOPGEN], 1u);
            else XB_SPIN(xb_ld(&bar[XB_TOPGEN]) == tg, bar);
            __builtin_amdgcn_fence(__ATOMIC_ACQUIRE, "agent");
            xb_add(&bar[XB_XGEN(b.x)], 1u);
            asm volatile("s_waitcnt vmcnt(0)" ::: "memory");
        } else {
            XB_SPIN(xb_ld(&bar[XB_XGEN(b.x)]) == gen, bar);
            __builtin_amdgcn_fence(__ATOMIC_ACQUIRE, "agent");
            asm volatile("s_waitcnt vmcnt(0)" ::: "memory");
        }
    }
    __syncthreads();
}

typedef float f32x4 __attribute__((ext_vector_type(4)));
constexpr int NWAVES = 8;
__device__ __forceinline__ float wave_sum(float v) {
#pragma unroll
    for (int o = 1; o < 64; o <<= 1) v += __shfl_xor(v, o);
    return v;
}
__device__ __forceinline__ float dot4g(const f32x4 a) { return (a[0] * a[0] + a[1] * a[1]) + (a[2] * a[2] + a[3] * a[3]); }
__device__ __forceinline__ void p0_bt1_item(const float* W, bf16* WT, LAS float* scr, int item, int lane) {
    const int kb = item / 168, vb = item % 168, k0 = 64 * kb, v0 = 32 * vb;
    const int a = vcol_actual(v0 + (lane & 31));
#pragma unroll 8
    for (int i = 0; i < 32; ++i) { const int kk = 2 * i + (lane >> 5); scr[kk * 33 + (lane & 31)] = a >= 0 ? W[(size_t)(k0 + kk) * PROJ + a] : 0.f; }
    LDS_WAIT(); asm volatile("" ::: "memory");
    const int c = lane & 7;
#pragma unroll
    for (int j = 0; j < 4; ++j) { const int n = (lane >> 3) + 8 * j; const LAS float* s = scr + (8 * c) * 33 + n;
        v4u o; o.x = pk2(s[0 * 33], s[1 * 33]); o.y = pk2(s[2 * 33], s[3 * 33]); o.z = pk2(s[4 * 33], s[5 * 33]); o.w = pk2(s[6 * 33], s[7 * 33]);
        *(GAS v4u*)(WT + (size_t)(v0 + n) * 1024 + k0 + 8 * c) = o; }
    LDS_WAIT(); asm volatile("" ::: "memory");
}
__device__ __forceinline__ void p0_bt2_item(const float* W, const float* sg, bf16* WT, LAS float* scr, int item, int lane) {
    const int kb = item >> 5, nb = item & 31, kk0 = 64 * kb, n0 = 32 * nb;
#pragma unroll 8
    for (int i = 0; i < 32; ++i) { const int kk = 2 * i + (lane >> 5), kq = kk0 + kk; const int ks = kq < 1024 ? 1024 + kq : kq - 1024;
        float v = W[(size_t)ks * 1024 + n0 + (lane & 31)]; if (kq < 1024) v *= sg[kq]; scr[kk * 33 + (lane & 31)] = v; }
    LDS_WAIT(); asm volatile("" ::: "memory");
    const int c = lane & 7;
#pragma unroll
    for (int j = 0; j < 4; ++j) { const int n = (lane >> 3) + 8 * j; const LAS float* s = scr + (8 * c) * 33 + n;
        v4u o; o.x = pk2(s[0 * 33], s[1 * 33]); o.y = pk2(s[2 * 33], s[3 * 33]); o.z = pk2(s[4 * 33], s[5 * 33]); o.w = pk2(s[6 * 33], s[7 * 33]);
        *(GAS v4u*)(WT + (size_t)(n0 + n) * 2048 + kk0 + 8 * c) = o; }
    LDS_WAIT(); asm volatile("" ::: "memory");
}
__device__ __forceinline__ void p0_mod_block(const float* c, const float* c_ctx, const float* ada_w, const float* ada_b, float* mod, LAS float* ldsf, int cb, int tid, int lane, int wave) {
    LAS float* sil = ldsf; LAS float* red = ldsf + 33 * 256;
    float acc[33];
#pragma unroll
    for (int b = 0; b < 33; ++b) acc[b] = 0.f;
    for (int q = 0; q < 4; ++q) {
        __syncthreads();
        for (int e = tid; e < 33 * 256; e += NWAVES * 64) { const int b = e >> 8, k = e & 255; const float v = b < 32 ? c[b * 1024 + q * 256 + k] : c_ctx[q * 256 + k]; sil[e] = siluf(v); }
        __syncthreads();
#pragma unroll 2
        for (int k4 = 0; k4 < 8; ++k4) { const int kl = wave * 32 + 4 * k4; const float* wp = ada_w + (size_t)(q * 256 + kl) * 3072 + cb * 64 + lane;
            const float w0 = wp[0], w1 = wp[3072], w2 = wp[2 * 3072], w3 = wp[3 * 3072];
#pragma unroll
            for (int b = 0; b < 33; ++b) { const f32x4 sv = *(const LAS f32x4*)(sil + b * 256 + kl); acc[b] += (sv[0] * w0 + sv[1] * w1) + (sv[2] * w2 + sv[3] * w3); } }
    }
#pragma unroll
    for (int b = 0; b < 33; ++b) red[(wave * 33 + b) * 64 + lane] = acc[b];
    __syncthreads();
    for (int e = tid; e < 33 * 64; e += NWAVES * 64) { const int b = e >> 6, col = e & 63; float s = 0.f;
#pragma unroll
        for (int w = 0; w < 8; ++w) s += red[(w * 33 + b) * 64 + col];
        mod[b * 3072 + cb * 64 + col] = s + ada_b[cb * 64 + col]; }
    __syncthreads();
}
__device__ __forceinline__ const float* p1_src(const float* x, const float* ctx, int m) { return m < ML ? x + (size_t)m * DM : ctx + (size_t)(m - ML) * DM; }
__device__ __forceinline__ void p1_load4(f32x4 (&v)[4][4], const float* x, const float* ctx, int m0, int lane) {
#pragma unroll
    for (int r = 0; r < 4; ++r) { const GAS f32x4* xr = (const GAS f32x4*)p1_src(x, ctx, m0 + r) + 2 * lane;
#pragma unroll
        for (int j = 0; j < 2; ++j) { v[r][2 * j] = xr[128 * j]; v[r][2 * j + 1] = xr[128 * j + 1]; } }
}
__device__ __forceinline__ void p1_proc4(const f32x4 (&v)[4][4], const float* mod, const float* ng, bf16* H, int m0, int lane) {
#pragma unroll
    for (int r = 0; r < 4; ++r) { const int m = m0 + r; const float* md = mod + (size_t)(m < ML ? m / SEQ : 32) * 3072;
        float s = 0.f;
#pragma unroll
        for (int j = 0; j < 4; ++j) s += dot4g(v[r][j]);
        const float rstd = rsqrtf(wave_sum(s) * (1.f / DM) + EPS);
        GAS v4u* o16 = (GAS v4u*)(H + (size_t)m * DM) + lane;
#pragma unroll
        for (int j = 0; j < 2; ++j) { const int k = 8 * lane + 512 * j; f32x4 h[2];
#pragma unroll
            for (int q = 0; q < 2; ++q) { const f32x4 g = *(const f32x4*)(ng + k + 4 * q), sc = *(const f32x4*)(md + 1024 + k + 4 * q), sh = *(const f32x4*)(md + k + 4 * q);
                h[q] = v[r][2 * j + q] * rstd * g * (sc + 1.f) + sh; }
            v4u o; o.x = pk2(h[0][0], h[0][1]); o.y = pk2(h[0][2], h[0][3]); o.z = pk2(h[1][0], h[1][1]); o.w = pk2(h[1][2], h[1][3]);
            o16[64 * j] = o; }
    }
}
__device__ __forceinline__ void conv_phase(const bf16* XBC, const float* cw, const float* cb, bf16* XC, int bx, int G, int tid) {
    if (tid < 384) {
        const int cg = tid % 192, sub = tid / 192;
        f32x4 w[5][2], bias[2];
#pragma unroll
        for (int j = 0; j < 5; ++j) { w[j][0] = *(const f32x4*)(cw + j * CONVC + cg * 8); w[j][1] = *(const f32x4*)(cw + j * CONVC + cg * 8 + 4); }
        bias[0] = *(const f32x4*)(cb + cg * 8); bias[1] = *(const f32x4*)(cb + cg * 8 + 4);
        for (int seg = bx; seg < MT / 32; seg += G) {
            const int row0 = seg * 32 + sub * 16; int t0, len;
            if (row0 < ML) { t0 = row0 % SEQ; len = SEQ; } else { t0 = (row0 - ML) % CTXL; len = CTXL; }
            const bf16* src = XBC + (size_t)row0 * CONVC + cg * 8; bf16* dst = XC + (size_t)row0 * CONVC + cg * 8;
            f32x4 r[5][2];
#pragma unroll
            for (int j = 0; j < 5; ++j) { const int tt = t0 + j - 2; v4u u = (v4u){0u, 0u, 0u, 0u};
                if (tt >= 0 && tt < len) u = *(const v4u*)(src + (ptrdiff_t)(j - 2) * CONVC);
                r[j][0] = (f32x4){__uint_as_float(u.x << 16), __uint_as_float(u.x & 0xffff0000u), __uint_as_float(u.y << 16), __uint_as_float(u.y & 0xffff0000u)};
                r[j][1] = (f32x4){__uint_as_float(u.z << 16), __uint_as_float(u.z & 0xffff0000u), __uint_as_float(u.w << 16), __uint_as_float(u.w & 0xffff0000u)}; }
#pragma unroll
            for (int i = 0; i < 16; ++i) {
                f32x4 a0 = bias[0], a1 = bias[1];
#pragma unroll
                for (int j = 0; j < 5; ++j) { a0 += w[j][0] * r[j][0]; a1 += w[j][1] * r[j][1]; }
#pragma unroll
                for (int e = 0; e < 4; ++e) { a0[e] = siluf(a0[e]); a1[e] = siluf(a1[e]); }
                v4u o; o.x = pk2(a0[0], a0[1]); o.y = pk2(a0[2], a0[3]); o.z = pk2(a1[0], a1[1]); o.w = pk2(a1[2], a1[3]);
                *(v4u*)(dst + (size_t)i * CONVC) = o;
#pragma unroll
                for (int j = 0; j < 4; ++j) { r[j][0] = r[j + 1][0]; r[j][1] = r[j + 1][1]; }
                const int tt = t0 + i + 3; v4u u = (v4u){0u, 0u, 0u, 0u};
                if (i < 15 && tt < len) u = *(const v4u*)(src + (size_t)(i + 3) * CONVC);
                r[4][0] = (f32x4){__uint_as_float(u.x << 16), __uint_as_float(u.x & 0xffff0000u), __uint_as_float(u.y << 16), __uint_as_float(u.y & 0xffff0000u)};
                r[4][1] = (f32x4){__uint_as_float(u.z << 16), __uint_as_float(u.z & 0xffff0000u), __uint_as_float(u.w << 16), __uint_as_float(u.w & 0xffff0000u)};
            }
        }
    }
}
__device__ __forceinline__ void ssd_item_naive(int b, int h, const bf16* XC, const float* DT, const bf16* Z, const float* a_log, const float* d_skip, bf16* YQ, float* SSQ, LAS float* ysq, int tid) {
    const int p = tid >> 3, nc = tid & 7, g = h >> 3;
    for (int dd = 0; dd < 2; ++dd) { const int d = 1 - dd;
        const float a_neg = -expf(a_log[d * 16 + h]);
        float S[16];
#pragma unroll
        for (int j = 0; j < 16; ++j) S[j] = 0.f;
        for (int seq = 0; seq < 2; ++seq) { const int len = seq == 0 ? CTXL : SEQ; const size_t rbase = seq == 0 ? (size_t)ML + (size_t)b * CTXL : (size_t)b * SEQ;
            for (int st = 0; st < len; ++st) { const int t = d ? len - 1 - st : st; const size_t row = rbase + t;
                const float dt = DT[row * 32 + d * 16 + h]; const float dec = expf(dt * a_neg);
                const float xs = bf2f(XC[row * CONVC + h * 64 + p]); const float X = xs * dt;
                const v4u b0 = *(const v4u*)(XC + row * CONVC + 1024 + g * 128 + nc * 16), b1 = *(const v4u*)(XC + row * CONVC + 1024 + g * 128 + nc * 16 + 8);
                const v4u c0 = *(const v4u*)(XC + row * CONVC + 1280 + g * 128 + nc * 16), c1 = *(const v4u*)(XC + row * CONVC + 1280 + g * 128 + nc * 16 + 8);
                const unsigned bw[8] = {b0.x, b0.y, b0.z, b0.w, b1.x, b1.y, b1.z, b1.w}, cw8[8] = {c0.x, c0.y, c0.z, c0.w, c1.x, c1.y, c1.z, c1.w};
                float y = 0.f;
#pragma unroll
                for (int j = 0; j < 8; ++j) { S[2 * j] = S[2 * j] * dec + X * __uint_as_float(bw[j] << 16); y += __uint_as_float(cw8[j] << 16) * S[2 * j];
                    S[2 * j + 1] = S[2 * j + 1] * dec + X * __uint_as_float(bw[j] & 0xffff0000u); y += __uint_as_float(cw8[j] & 0xffff0000u) * S[2 * j + 1]; }
                y += __shfl_xor(y, 1); y += __shfl_xor(y, 2); y += __shfl_xor(y, 4);
                if (seq == 1) {
                    bf16* yp = YQ + row * 2048 + h * 64 + p;
                    if (d == 1) { if (nc == 0) *yp = (bf16)f2bf(y); }
                    else {
                        if (nc == 0) { const float yt = y + bf2f(*yp) + d_skip[h] * xs; const float yg = yt * bf2f(Z[row * 1024 + h * 64 + p]); *yp = (bf16)f2bf(yg); ysq[p] = yg * yg; }
                        __syncthreads();
                        if (tid < 64) { float q = ysq[tid]; q = wave_sum(q); if (tid == 0) SSQ[row * 16 + h] = q; }
                        __syncthreads();
                    }
                }
            }
        }
        VM_WAIT(); __syncthreads();
    }
}

namespace attn_body {
using bf16=__hip_bfloat16;
using bf16x8=__attribute__((ext_vector_type(8)))short;
using s16x4=__attribute__((ext_vector_type(4)))short;
using f32x16=__attribute__((ext_vector_type(16)))float;
using u32x4=__attribute__((ext_vector_type(4)))unsigned;
constexpr int D=64,QP=2048,KP=256;
constexpr int NW=8,QBLK=32,QB=QBLK*NW,KVBLK=64,NQB=SEQ/QB;
constexpr int ATTN_UNIT_ROWS=QB;
__device__ __forceinline__ int crow(int r,int hi){return (r&3)+8*(r>>2)+4*hi;}
#define SBAR() __builtin_amdgcn_sched_barrier(0)
__device__ __forceinline__ void cmask(f32x16&p0,f32x16&p1,int jb,int qrel,int hi){
  const float NEG=-INFINITY; int kb=64*jb+4*hi;
  #pragma unroll
  for(int r=0;r<16;++r){int kv=kb+(r&3)+8*(r>>2); if(kv>qrel)p0[r]=NEG; if(kv+32>qrel)p1[r]=NEG;}
}

constexpr int NSLOT=3, SLOTB=8192;
constexpr int LDS_K=0, LDS_V=NSLOT*SLOTB, LDS_WS=2*NSLOT*SLOTB, LDS_OST=LDS_WS+NW*64*4, LDS_BYTES=LDS_OST+NW*8192;
constexpr float C2=0.125f*1.4426950408889634f;
__device__ __forceinline__ void glds16(const void*gsrc,unsigned lds_dst){unsigned keep;
  asm volatile("s_mov_b32 %0, m0\n\ts_mov_b32 m0, %2\n\ts_nop 0\n\tglobal_load_lds_dwordx4 %1, off\n\ts_mov_b32 m0, %0":"=&s"(keep):"v"(gsrc),"s"(lds_dst):"memory");}
__device__ __forceinline__ float max3f(float a,float b,float c){float r;asm("v_max3_f32 %0, %1, %2, %3":"=v"(r):"v"(a),"v"(b),"v"(c));return r;}
__device__ __forceinline__ float max2f(float a,float b){float r;asm("v_max_f32_e32 %0, %1, %2":"=v"(r):"v"(a),"v"(b));return r;}
__device__ __forceinline__ float fadd_s(float a,float b){float r;asm("v_add_f32_e32 %0, %1, %2":"=v"(r):"v"(a),"v"(b));return r;}
__device__ __forceinline__ float fsub_s(float a,float b){float r;asm("v_sub_f32_e32 %0, %1, %2":"=v"(r):"v"(a),"v"(b));return r;}
typedef float f32x2_t __attribute__((ext_vector_type(2))); typedef float f32x4_t __attribute__((ext_vector_type(4))); typedef __bf16 bf16x2_t __attribute__((ext_vector_type(2)));
__device__ __forceinline__ unsigned cvtpk_s(float lo,float hi){f32x2_t v={lo,hi};bf16x2_t b=__builtin_convertvector(v,bf16x2_t);return __builtin_bit_cast(unsigned,b);}
#define WAIT_BAR(N) asm volatile("s_waitcnt vmcnt(" #N ") lgkmcnt(0)\n\ts_barrier":::"memory")

__device__ __forceinline__ void qkt(f32x16&p0,f32x16&p1,const char*Kslot,const bf16x8*qr,const f32x16&negm,int r32,int hi){
  const char*kb=Kslot+hi*1024+r32*16;
  #pragma unroll
  for(int d0=0;d0<4;++d0){
    const bf16x8 b0=*reinterpret_cast<const bf16x8*>(kb+d0*2048);
    const bf16x8 b1=*reinterpret_cast<const bf16x8*>(kb+d0*2048+512);
    if(d0==0){p0=__builtin_amdgcn_mfma_f32_32x32x16_bf16(b0,qr[0],negm,0,0,0);p1=__builtin_amdgcn_mfma_f32_32x32x16_bf16(b1,qr[0],negm,0,0,0);}
    else{p0=__builtin_amdgcn_mfma_f32_32x32x16_bf16(b0,qr[d0],p0,0,0,0);p1=__builtin_amdgcn_mfma_f32_32x32x16_bf16(b1,qr[d0],p1,0,0,0);}}
}
typedef __attribute__((address_space(3))) const char* lds_cptr;
typedef short v4i16_t __attribute__((ext_vector_type(4)));
__device__ __forceinline__ void kload8(bf16x8*kf,lds_cptr kp){
  kf[0]=*(const __attribute__((address_space(3))) bf16x8*)(kp);      kf[1]=*(const __attribute__((address_space(3))) bf16x8*)(kp+512);
  kf[2]=*(const __attribute__((address_space(3))) bf16x8*)(kp+2048); kf[3]=*(const __attribute__((address_space(3))) bf16x8*)(kp+2560);
  kf[4]=*(const __attribute__((address_space(3))) bf16x8*)(kp+4096); kf[5]=*(const __attribute__((address_space(3))) bf16x8*)(kp+4608);
  kf[6]=*(const __attribute__((address_space(3))) bf16x8*)(kp+6144); kf[7]=*(const __attribute__((address_space(3))) bf16x8*)(kp+6656);
}
__device__ __forceinline__ void kload2(bf16x8*kf,lds_cptr kp,int j){ kf[2*j]=*(const __attribute__((address_space(3))) bf16x8*)(kp+j*2048); kf[2*j+1]=*(const __attribute__((address_space(3))) bf16x8*)(kp+j*2048+512); }
__device__ __forceinline__ s16x4 vtr(lds_cptr p){ return __builtin_bit_cast(s16x4,__builtin_amdgcn_ds_read_tr16_b64_v4i16((__attribute__((address_space(3))) v4i16_t*)p)); }
__device__ __forceinline__ float rowmax(const f32x16&p0,const f32x16&p1){
  float a=max3f(p0[0],p0[1],p1[0]),b=max3f(p0[2],p0[3],p1[1]);a=max3f(a,p1[2],p1[3]);
  #pragma unroll
  for(int r=4;r<16;r+=4){a=max3f(a,p0[r],p0[r+1]);b=max3f(b,p0[r+2],p0[r+3]);a=max3f(a,p1[r],p1[r+1]);b=max3f(b,p1[r+2],p1[r+3]);}
  const float m=max2f(a,b);
  auto rr=__builtin_amdgcn_permlane32_swap(__float_as_uint(m),__float_as_uint(m),false,false);
  return max2f(__uint_as_float(rr[0]),__uint_as_float(rr[1]));
}
__device__ __forceinline__ void pv(f32x16*o,int vb,bf16x8 pa0,bf16x8 pa1,bf16x8 pa2,bf16x8 pa3){
  #pragma unroll
  for(int d0=0;d0<2;++d0){s16x4 lo[4],hi[4];
    #pragma unroll
    for(int ks=0;ks<4;++ks){
      asm volatile("ds_read_b64_tr_b16 %0,%1 offset:%c2":"=&v"(lo[ks]):"v"(vb),"i"(d0*4096+ks*1024):"memory");
      asm volatile("ds_read_b64_tr_b16 %0,%1 offset:%c2":"=&v"(hi[ks]):"v"(vb),"i"(d0*4096+ks*1024+512):"memory");}
    asm volatile("s_waitcnt lgkmcnt(0)":::"memory");SBAR();
    #define PK(k) (bf16x8){lo[k][0],lo[k][1],lo[k][2],lo[k][3],hi[k][0],hi[k][1],hi[k][2],hi[k][3]}
    o[d0]=__builtin_amdgcn_mfma_f32_32x32x16_bf16(pa0,PK(0),o[d0],0,0,0);
    o[d0]=__builtin_amdgcn_mfma_f32_32x32x16_bf16(pa1,PK(1),o[d0],0,0,0);
    o[d0]=__builtin_amdgcn_mfma_f32_32x32x16_bf16(pa2,PK(2),o[d0],0,0,0);
    o[d0]=__builtin_amdgcn_mfma_f32_32x32x16_bf16(pa3,PK(3),o[d0],0,0,0);
    #undef PK
  }
}

#ifndef ATTN_STORE16
#define ATTN_STORE16(p,v) (*(u32x4*)(p)=(v))
#endif
template<int THRL> __device__ __forceinline__ void attn_unit(int b,int h,int qb,bf16*YQb,const bf16*__restrict__ K,const bf16*__restrict__ V,char*shm,int wid_in,float sbound,bf16x8 (&qr)[4],bool first,bool hasNext,int nb,int nh,int nqb,bf16*dummyO=nullptr){
  const int wid=wid_in; int lane=mk_lane(); asm volatile("":"+v"(lane)); const int tid=wid*64+lane,r32=lane&31,hi=lane>>5; (void)tid;
  const long rowbase=(long)b*SEQ; const int q0=qb*QB;
  const bf16*Qw=YQb+(rowbase+q0+wid*QBLK)*QP+1024+h*D;
  const bf16*Kh=K+(long)b*KVL*KP+(h>>2)*D,*Vh=V+(long)b*KVL*KP+(h>>2)*D;
  const unsigned lds0=(unsigned)(uintptr_t)shm;
  float*wsf=(float*)(shm+LDS_WS)+wid*64;
  const bf16*ksrc=Kh+(long)lane*KP+wid*8;
  const bf16*vsrc=Vh+(long)(16*(wid&3)+(lane>>2))*KP+(wid>>2)*32+(lane&3)*8;
  const unsigned kdst=lds0+LDS_K+wid*1024, vdst=lds0+LDS_V+wid*1024;
  #define DMA_K(t,slot) glds16(ksrc+(long)(t)*KVBLK*KP,(unsigned)__builtin_amdgcn_readfirstlane(kdst+(slot)))
  #define DMA_V(t,slot) glds16(vsrc+(long)(t)*KVBLK*KP,(unsigned)__builtin_amdgcn_readfirstlane(vdst+(slot)))
  const int vb0=(int)(lds0+LDS_V)+((lane>>4)&1)*32+(lane&3)*8+(4*hi+((lane&15)>>2))*64;
  const char*Kbase=shm+LDS_K; bf16x8 kf[8];
  const lds_cptr shm3=(lds_cptr)shm; const lds_cptr kp0=shm3+LDS_K+hi*1024+r32*16; const lds_cptr vp0=shm3+LDS_V+((lane>>4)&1)*32+(lane&3)*8+(4*hi+((lane&15)>>2))*64;
  constexpr int NT=KVL/KVBLK;
  if(first){ DMA_K(0,0);DMA_V(0,0);DMA_K(1,SLOTB);
    #pragma unroll
    for(int d0=0;d0<4;++d0)qr[d0]=*reinterpret_cast<const bf16x8*>(&Qw[(long)r32*QP+d0*16+hi*8]); }
  float l_reg=0.f;f32x16 o[2];o[0]=f32x16{};o[1]=f32x16{};f32x16 negm;
  #pragma unroll
  for(int r=0;r<16;++r)negm[r]=-sbound;
  asm volatile("":"+v"(negm));
  #define CMASK(P0,P1,t) do{}while(0)
  #define START(P0,P1) do{ _Pragma("unroll") for(int r=0;r<16;++r)P0[r]=__builtin_amdgcn_exp2f(P0[r]); }while(0)
  #define RESC() do{}while(0)
  f32x16 pA0,pA1,pB0,pB1;
  int sl_prev=0,sl_cur=0,sl_next=SLOTB;
  #define ROT() do{sl_prev=sl_cur;sl_cur=sl_next;sl_next=(sl_next==(NSLOT-1)*SLOTB)?0:sl_next+SLOTB;}while(0)
  if(first){ DMA_K(2,2*SLOTB);
    WAIT_BAR(3); }
  else { WAIT_BAR(0); }
  qkt(pA0,pA1,Kbase,qr,negm,r32,hi);asm volatile("s_nop 15\n\ts_nop 7":"+v"(pA0),"+v"(pA1));CMASK(pA0,pA1,0);
  START(pA0,pA1);
  _Pragma("unroll") for(int r=0;r<16;++r)pA1[r]=__builtin_amdgcn_exp2f(pA1[r]);
  WAIT_BAR(0);
  DMA_K(3,0);DMA_V(1,SLOTB);
  ROT();
  kload8(kf,kp0+sl_cur);
  WAIT_BAR(2);
  s16x4 vlo[8],vhi[8]; u32x4 pw0,pw1,pw2,pw3;
  #define PKW(P,B) cvtpk_s(P[B],P[B+1])
  #define PAF(k) __builtin_bit_cast(bf16x8,pw##k)
  #define VFR(i) (bf16x8){vlo[i][0],vlo[i][1],vlo[i][2],vlo[i][3],vhi[i][0],vhi[i][1],vhi[i][2],vhi[i][3]}
  #define PIN(x) asm volatile("":"+v"(x))
  #define MX3(a,b,c) __builtin_fmaxf(__builtin_fmaxf((a),(b)),(c))
  #define GAPA(MF,A0,A1,A2,A3,W0,W1,PW) do{ MF; sacc+=A0; sacc+=A1; sacc+=A2; sacc+=A3; PIN(sacc); W0; W1; PIN(PW); SBAR(); }while(0)
  #define EX(v) __builtin_amdgcn_exp2f(v)
  #define GAPB(MF,X,B) do{ MF; X[B]=EX(X[B]); X[B+1]=EX(X[B+1]); X[B+2]=EX(X[B+2]); X[B+3]=EX(X[B+3]); PIN(X); SBAR(); }while(0)
  #define VRD(i) do{ vlo[i]=vtr(vp_+(((i)>>2)*4096+((i)&3)*1024)); vhi[i]=vtr(vp_+(((i)>>2)*4096+((i)&3)*1024+512)); }while(0)
  #define KRD(G,j) do{ if(G){ kload2(kf,kp0+sl_next,j); SBAR(); } }while(0)
  #define STEP(C0,C1,P0,P1,t,GK,GV,GL) do{ SBAR(); \
    const lds_cptr vp_=vp0+sl_prev; \
    VRD(0); SBAR(); float sacc=(P0[0]+P0[1]); \
    GAPA(C0=__builtin_amdgcn_mfma_f32_32x32x16_bf16(kf[0],qr[0],negm,0,0,0), P0[2],P0[3],P0[4],P0[5],     pw0[0]=PKW(P0,0), pw0[1]=PKW(P0,2), pw0); \
    VRD(4); SBAR(); GAPA(C1=__builtin_amdgcn_mfma_f32_32x32x16_bf16(kf[1],qr[0],negm,0,0,0), P0[6],P0[7],P0[8],P0[9],     pw0[2]=PKW(P0,4), pw0[3]=PKW(P0,6), pw0); \
    VRD(1); SBAR(); GAPA(C0=__builtin_amdgcn_mfma_f32_32x32x16_bf16(kf[2],qr[1],C0,0,0,0),   P0[10],P0[11],P0[12],P0[13], pw1[0]=PKW(P0,8), pw1[1]=PKW(P0,10), pw1); \
    VRD(5); SBAR(); GAPA(C1=__builtin_amdgcn_mfma_f32_32x32x16_bf16(kf[3],qr[1],C1,0,0,0),   P0[14],P0[15],P1[0],P1[1],   pw1[2]=PKW(P0,12),pw1[3]=PKW(P0,14), pw1); \
    VRD(2); SBAR(); GAPA(C0=__builtin_amdgcn_mfma_f32_32x32x16_bf16(kf[4],qr[2],C0,0,0,0),   P1[2],P1[3],P1[4],P1[5],     pw2[0]=PKW(P1,0), pw2[1]=PKW(P1,2), pw2); \
    VRD(6); SBAR(); GAPA(C1=__builtin_amdgcn_mfma_f32_32x32x16_bf16(kf[5],qr[2],C1,0,0,0),   P1[6],P1[7],P1[8],P1[9],     pw2[2]=PKW(P1,4), pw2[3]=PKW(P1,6), pw2); \
    VRD(3); SBAR(); GAPA(C0=__builtin_amdgcn_mfma_f32_32x32x16_bf16(kf[6],qr[3],C0,0,0,0),   P1[10],P1[11],P1[12],P1[13], pw3[0]=PKW(P1,8), pw3[1]=PKW(P1,10), pw3); \
    VRD(7); SBAR(); GAPA(C1=__builtin_amdgcn_mfma_f32_32x32x16_bf16(kf[7],qr[3],C1,0,0,0),   P1[14],P1[15],0.f,0.f,       pw3[2]=PKW(P1,12),pw3[3]=PKW(P1,14), pw3); \
    l_reg+=sacc; \
    if(GK){DMA_K((t)+3,sl_cur);} if(GV){DMA_V((t)+1,sl_next);} \
    CMASK(C0,C1,t); \
    SBAR(); \
    GAPB(o[0]=__builtin_amdgcn_mfma_f32_32x32x16_bf16(PAF(0),VFR(0),o[0],0,0,0), C0,0); \
    GAPB(o[1]=__builtin_amdgcn_mfma_f32_32x32x16_bf16(PAF(0),VFR(4),o[1],0,0,0), C0,4); \
    KRD(GL,0); GAPB(o[0]=__builtin_amdgcn_mfma_f32_32x32x16_bf16(PAF(1),VFR(1),o[0],0,0,0), C0,8); \
    KRD(GL,1); GAPB(o[1]=__builtin_amdgcn_mfma_f32_32x32x16_bf16(PAF(1),VFR(5),o[1],0,0,0), C0,12); \
    KRD(GL,2); GAPB(o[0]=__builtin_amdgcn_mfma_f32_32x32x16_bf16(PAF(2),VFR(2),o[0],0,0,0), C1,0); \
    KRD(GL,3); GAPB(o[1]=__builtin_amdgcn_mfma_f32_32x32x16_bf16(PAF(2),VFR(6),o[1],0,0,0), C1,4); \
    GAPB(o[0]=__builtin_amdgcn_mfma_f32_32x32x16_bf16(PAF(3),VFR(3),o[0],0,0,0), C1,8); \
    GAPB(o[1]=__builtin_amdgcn_mfma_f32_32x32x16_bf16(PAF(3),VFR(7),o[1],0,0,0), C1,12); \
    }while(0)
  int t=1;
  #undef CMASK
  #define CMASK(P0,P1,t) do{}while(0)
  for(;t+5<NT;t+=2){
    STEP(pB0,pB1,pA0,pA1,t,true,true,true);     WAIT_BAR(2); RESC(); ROT();
    STEP(pA0,pA1,pB0,pB1,t+1,true,true,true);   WAIT_BAR(2); RESC(); ROT();
  }
  #undef CMASK
  #define CMASK(P0,P1,t) do{}while(0)
  #define ENDW(tt) do{ if((tt)+3<NT){WAIT_BAR(2);} else if((tt)+2<NT){WAIT_BAR(1);} else {WAIT_BAR(0);} }while(0)
  for(;t+1<NT;t+=2){
    STEP(pB0,pB1,pA0,pA1,t,(t+3<NT),(t+1<NT),(t+1<NT));       ENDW(t);   RESC(); ROT();
    STEP(pA0,pA1,pB0,pB1,t+1,(t+4<NT),(t+2<NT),(t+2<NT));     ENDW(t+1); RESC(); ROT();
  }
  const bf16*nQw=YQb+((long)nb*SEQ+nqb*QB+wid*QBLK)*QP+1024+nh*D;
  if(hasNext){ const bf16*nK=K+(long)nb*KVL*KP+(nh>>2)*D+(long)lane*KP+wid*8; const bf16*nV=V+(long)nb*KVL*KP+(nh>>2)*D+(long)(16*(wid&3)+(lane>>2))*KP+(wid>>2)*32+(lane&3)*8;
    glds16(nK,(unsigned)__builtin_amdgcn_readfirstlane(kdst)); glds16(nV,(unsigned)__builtin_amdgcn_readfirstlane(vdst)); glds16(nK+(long)KVBLK*KP,(unsigned)__builtin_amdgcn_readfirstlane(kdst+SLOTB)); glds16(nK+(long)2*KVBLK*KP,(unsigned)__builtin_amdgcn_readfirstlane(kdst+2*SLOTB)); }
  STEP(pB0,pB1,pA0,pA1,NT-1,false,false,false); RESC();
  { float sacc=pB0[0]+pB0[1]; _Pragma("unroll") for(int r=2;r<16;++r)sacc+=pB0[r]; _Pragma("unroll") for(int r=0;r<16;++r)sacc+=pB1[r]; l_reg+=sacc;
    pw0=(u32x4){PKW(pB0,0),PKW(pB0,2),PKW(pB0,4),PKW(pB0,6)};pw1=(u32x4){PKW(pB0,8),PKW(pB0,10),PKW(pB0,12),PKW(pB0,14)};pw2=(u32x4){PKW(pB1,0),PKW(pB1,2),PKW(pB1,4),PKW(pB1,6)};pw3=(u32x4){PKW(pB1,8),PKW(pB1,10),PKW(pB1,12),PKW(pB1,14)};
    SBAR(); pv(o,vb0+sl_cur,PAF(0),PAF(1),PAF(2),PAF(3)); }
  if(hasNext){
    #pragma unroll
    for(int d0=0;d0<4;++d0)qr[d0]=*reinterpret_cast<const bf16x8*>(&nQw[(long)r32*QP+d0*16+hi*8]); }
  #undef PKW
  #undef PAF
  #undef VFR
  #undef PIN
  #undef MX3
  #undef GAPA
  #undef GAPB
  #undef EX
  #undef VRD
  #undef KRD
  #undef STEP
  #undef ENDW
  {auto rr=__builtin_amdgcn_permlane32_swap(__float_as_uint(l_reg),__float_as_uint(l_reg),false,false);l_reg=__uint_as_float(rr[0])+__uint_as_float(rr[1]);}
  if(hi==0)wsf[32+r32]=l_reg;asm volatile("s_waitcnt lgkmcnt(0)":::"memory");
  float rli[16];
  #pragma unroll
  for(int r=0;r<16;++r)rli[r]=__builtin_amdgcn_rcpf(wsf[32+crow(r,hi)]);
  bf16*Ow=dummyO?dummyO+(long)(wid*QBLK)*QP:YQb+(rowbase+q0+wid*QBLK)*QP+1024+h*D; const bf16*Gw=YQb+(rowbase+q0+wid*QBLK)*QP+h*D;
  { float*stg=(float*)(shm+LDS_OST)+wid*2048;
    #pragma unroll
    for(int r=0;r<16;++r){const int orow=crow(r,hi);
      #pragma unroll
      for(int d0=0;d0<2;++d0)stg[orow*64+d0*32+r32]=o[d0][r]*rli[r];}
    asm volatile("s_waitcnt lgkmcnt(0)":::"memory");
    #pragma unroll
    for(int i=0;i<4;++i){const int row=i*8+(lane>>3),ch=lane&7; const float*sp=stg+row*64+ch*8;
      const f32x4_t a=*(const f32x4_t*)sp,c=*(const f32x4_t*)(sp+4); const u32x4 g=*(const u32x4*)(Gw+(long)row*QP+ch*8);
      u32x4 v; v[0]=cvtpk_s(a[0]*__uint_as_float(g[0]<<16),a[1]*__uint_as_float(g[0]&0xffff0000u)); v[1]=cvtpk_s(a[2]*__uint_as_float(g[1]<<16),a[3]*__uint_as_float(g[1]&0xffff0000u));
      v[2]=cvtpk_s(c[0]*__uint_as_float(g[2]<<16),c[1]*__uint_as_float(g[2]&0xffff0000u)); v[3]=cvtpk_s(c[2]*__uint_as_float(g[3]<<16),c[3]*__uint_as_float(g[3]&0xffff0000u));
      ATTN_STORE16(Ow+(long)row*QP+ch*8,v);} }
  asm volatile("s_waitcnt lgkmcnt(0)\n\ts_barrier":::"memory");
  #undef DMA_K
  #undef DMA_V
  #undef CMASK
  #undef START
  #undef RESC
  #undef ROT
}
constexpr int ATTN_LDS_BYTES=LDS_BYTES;
struct Order {
  int vcu, G; bool alt;
  __device__ __forceinline__ bool next(int i,int&b,int&h,int&qb)const{
    if(G==256&&!alt){ if(i>=16)return false; const int x=vcu>>5,j=vcu&31,rd=i>>2,k=i&3; const int pair=x*16+rd*4+(j>>3),un=(j&7)*4+k; b=pair>>2; h=(pair&3)*4+(un&3); qb=un>>2; return true; }
    const int U=i*G+vcu; if(U>=4096)return false; b=U>>7; h=(U>>3)&15; qb=U&7; return true; }
};
template<int THRL=8> __device__ __forceinline__ void attn_phase(char*lds,bf16*YQb,const bf16*K,const bf16*V,const Order&S,int wid,float sbound,bf16*dummyO=nullptr){
  int b,h,qb,nb=0,nh=0,nqb=0; bf16x8 qr[4]; bool first=true;
  bool has=S.next(0,b,h,qb);
  for(int i=0;has;++i){ const bool hn=S.next(i+1,nb,nh,nqb);
    attn_unit<THRL>(b,h,qb,YQb,K,V,lds,wid,sbound,qr,first,hn,nb,nh,nqb,dummyO);
    b=nb;h=nh;qb=nqb;has=hn;first=false; }
}
#undef SBAR
#undef WAIT_BAR
}

namespace ssd {
typedef short bf16x8 __attribute__((ext_vector_type(8)));
typedef short s16x4 __attribute__((ext_vector_type(4)));
typedef unsigned u32x2_t __attribute__((ext_vector_type(2)));
constexpr int O_B = 0, O_C = 32768, O_X = 65536, O_XD = 81920, O_ST = 98304, O_SM = 114688;
constexpr float LOG2E = 1.4426950408889634f;
struct Lofs { int fb[4], xb[4], bb, sw; };
__device__ __forceinline__ bf16x8 frag(const LAS unsigned char* img, int fbk, int t) { return *(const LAS bf16x8*)(img + fbk + t * 4096); }
__device__ __forceinline__ s16x4 trd(const LAS unsigned char* p) { typedef short v4i16_t __attribute__((ext_vector_type(4))); return __builtin_bit_cast(s16x4, __builtin_amdgcn_ds_read_tr16_b64_v4i16((LAS v4i16_t*)p)); }
__device__ __forceinline__ bf16x8 trfragX(const LAS unsigned char* img, int xbp, int s0) {
    const s16x4 a = trd(img + xbp + s0 * 128), b = trd(img + xbp + s0 * 128 + 2048);
    return (bf16x8){a[0], a[1], a[2], a[3], b[0], b[1], b[2], b[3]};
}
__device__ __forceinline__ bf16x8 trfragB(const LAS unsigned char* img, int bb, int s0) {
    const s16x4 a = trd(img + bb + s0 * 256), b = trd(img + bb + s0 * 256 + 4096);
    return (bf16x8){a[0], a[1], a[2], a[3], b[0], b[1], b[2], b[3]};
}
__device__ __forceinline__ void unpack4(const u32x2_t u, float (&f)[4]) { f[0] = __uint_as_float(u.x << 16); f[1] = __uint_as_float(u.x & 0xffff0000u); f[2] = __uint_as_float(u.y << 16); f[3] = __uint_as_float(u.y & 0xffff0000u); }
__device__ __forceinline__ void unpack8(const v4u u, float (&f)[8]) {
    f[0] = __uint_as_float(u.x << 16); f[1] = __uint_as_float(u.x & 0xffff0000u); f[2] = __uint_as_float(u.y << 16); f[3] = __uint_as_float(u.y & 0xffff0000u);
    f[4] = __uint_as_float(u.z << 16); f[5] = __uint_as_float(u.z & 0xffff0000u); f[6] = __uint_as_float(u.w << 16); f[7] = __uint_as_float(u.w & 0xffff0000u);
}
#define SSD_MFMA(a, b, c) __builtin_amdgcn_mfma_f32_16x16x32_bf16(a, b, c, 0, 0, 0)

template <int W> __device__ __forceinline__ void diag(f32x4 (&y)[4], const bf16x8 (&cf)[4], const LAS unsigned char* Bi, const LAS unsigned char* Xi, const LAS float* csc, float csl, float skd, int fr, int fq, const Lofs& lo) {
    constexpr int NU = W / 2 + 1;
    bf16x8 bA[2][4], bB[2][4];
#pragma unroll
    for (int kk = 0; kk < 4; ++kk) { bA[0][kk] = frag(Bi, lo.fb[kk], 0); if (1 <= W) bB[0][kk] = frag(Bi, lo.fb[kk], 1); }
#pragma unroll
    for (int u = 0; u < NU; ++u) {
        const int cur = u & 1; const bool has1 = 2 * u + 1 <= W;
        bf16x8 xf[4];
#pragma unroll
        for (int pt = 0; pt < 4; ++pt) xf[pt] = trfragX(Xi, lo.xb[pt], 32 * u);
        const f32x4 c0 = *(const LAS f32x4*)(csc + 32 * u + 4 * fq), c1 = *(const LAS f32x4*)(csc + 32 * u + 16 + 4 * fq);
        if (u + 1 < NU) {
#pragma unroll
            for (int kk = 0; kk < 4; ++kk) { bA[cur ^ 1][kk] = frag(Bi, lo.fb[kk], 2 * u + 2); if (2 * u + 3 <= W) bB[cur ^ 1][kk] = frag(Bi, lo.fb[kk], 2 * u + 3); } }
        asm volatile("" ::: "memory");
        f32x4 a0 = (f32x4){0.f, 0.f, 0.f, 0.f}, a1 = (f32x4){0.f, 0.f, 0.f, 0.f};
#pragma unroll
        for (int kk = 0; kk < 4; ++kk) { a0 = SSD_MFMA(bA[cur][kk], cf[kk], a0); if (has1) a1 = SSD_MFMA(bB[cur][kk], cf[kk], a1); }
        float m0[4], m1[4];
#pragma unroll
        for (int e = 0; e < 4; ++e) {
            m0[e] = a0[e] * __builtin_amdgcn_exp2f(fminf(csl - c0[e], 0.f)); if (2 * u == W) { if (4 * fq + e > fr) m0[e] = 0.f; if (4 * fq + e == fr) m0[e] += skd; }
            m1[e] = has1 ? a1[e] * __builtin_amdgcn_exp2f(fminf(csl - c1[e], 0.f)) : 0.f; if (2 * u + 1 == W) { if (4 * fq + e > fr) m1[e] = 0.f; if (4 * fq + e == fr) m1[e] += skd; } }
        const v4u mw = (v4u){pk2(m0[0], m0[1]), pk2(m0[2], m0[3]), pk2(m1[0], m1[1]), pk2(m1[2], m1[3])};
        const bf16x8 mf = __builtin_bit_cast(bf16x8, mw);
#pragma unroll
        for (int pt = 0; pt < 4; ++pt) y[pt] = SSD_MFMA(xf[pt], mf, y[pt]);
    }
}

template <int SH> __device__ __forceinline__ void ssd_item(int b, int h, const bf16* XC, const float* DT, const bf16* Z, const float* a_log, const float* d_skip, bf16* YQ, float* SSQ,
                                          LAS unsigned char* L, int tid_in, int lane_in, int wave) {
    int tid = tid_in, lane = lane_in; asm volatile("" : "+v"(tid), "+v"(lane));
    const int fr = lane & 15, fq = lane >> 4, g = h >> 3;
    LAS unsigned char* Bi = L + O_B; LAS unsigned char* Ci = L + O_C; LAS unsigned char* Xi = L + O_X; LAS unsigned char* Xdi = L + O_XD; LAS unsigned char* Sti = L + O_ST;
    LAS float* dtv = (LAS float*)(L + O_SM); LAS float* cs2 = dtv + 256;
    const float aneg1 = -expf(a_log[16 + h]) * LOG2E, aneg0 = -expf(a_log[h]) * LOG2E, dsk = d_skip[h];
    Lofs lo;
    { const int q = (lane & 15) >> 2, pp = lane & 3, rr = 4 * fq + q;
#pragma unroll
      for (int kk = 0; kk < 4; ++kk) lo.fb[kk] = fr * 256 + (((4 * kk + fq) ^ fr) << 4);
#pragma unroll
      for (int pt = 0; pt < 4; ++pt) lo.xb[pt] = rr * 128 + ((pt ^ ((rr >> 1) & 3)) << 5) + 8 * pp;
      lo.bb = rr * 256 + (((2 * wave + (pp >> 1)) ^ rr) << 4) + 8 * (pp & 1);
      lo.sw = fr * 256 + (((2 * wave + (fq >> 1)) ^ fr) << 4) + (fq & 1) * 8; }
    const int sB = tid >> 4, cB = tid & 15, sX = tid >> 3, cX = tid & 7;
    const int wB = sB * 256 + ((cB ^ (sB & 15)) << 4);
    const int wX = sX * 128 + (((cX >> 1) ^ ((sX >> 1) & 3)) << 5) + (cX & 1) * 16;
    f32x4 st[4];
#pragma unroll
    for (int pt = 0; pt < 4; ++pt) st[pt] = (f32x4){0.f, 0.f, 0.f, 0.f};
    v4u Bq[4], Cq[4], Xq[2]; float dq0 = 0.f, dq1 = 0.f; bf16x8 cf[4];
#define SSD_DECODE(step, d_, base_, ctx_) const int d_ = 1 - (step) / 18; const int k_##d_ = (step) % 18; const bool ctx_ = k_##d_ < 2; \
    const size_t base_ = ctx_ ? (size_t)ML + (size_t)b * CTXL + (size_t)(d_ ? 1 - k_##d_ : k_##d_) * 128 : (size_t)b * SEQ + (size_t)(d_ ? 17 - k_##d_ : k_##d_ - 2) * 128;
#define SSD_ISSUE(step) do { SSD_DECODE(step, di, basei, ctxi) (void)ctxi; \
        const bf16* cb_ = XC + (SH == 8 ? (size_t)b * SEQ : basei) * CONVC; const int sg_ = di ? -CONVC : CONVC; const int o0_ = di ? 127 * CONVC : 0; \
        const bf16* pb_ = cb_ + (o0_ + sB * sg_ + 1024 + g * 128 + 8 * cB); const bf16* px_ = cb_ + (o0_ + sX * sg_ + h * 64 + 8 * cX); \
        const bf16* pc_ = cb_ + (o0_ + (16 * wave + fr) * sg_ + 1280 + g * 128 + 8 * fq); \
        _Pragma("unroll") for (int k4 = 0; k4 < 4; ++k4) { Bq[k4] = *(const v4u*)(pb_ + k4 * 32 * sg_); Cq[k4] = *(const v4u*)(pc_ + 32 * k4); } \
        _Pragma("unroll") for (int k2 = 0; k2 < 2; ++k2) Xq[k2] = *(const v4u*)(px_ + k2 * 64 * sg_); \
        if (wave == 0) { const size_t r0 = basei + (di ? 127 - 2 * lane : 2 * lane), r1 = basei + (di ? 126 - 2 * lane : 2 * lane + 1); dq0 = DT[r0 * 32 + di * 16 + h]; dq1 = DT[r1 * 32 + di * 16 + h]; } } while (0)
#define SSD_CUMSUM(step, par) do { if (wave == 0) { const float an = (1 - (step) / 18) ? aneg1 : aneg0; const float a0 = dq0 * an, a1 = dq1 * an; float v = a0 + a1; \
        _Pragma("unroll") for (int o = 1; o < 64; o <<= 1) { const float t = __shfl_up(v, o); if (lane >= o) v += t; } \
        dtv[(par) * 128 + 2 * lane] = dq0; dtv[(par) * 128 + 2 * lane + 1] = dq1; cs2[(par) * 128 + 2 * lane] = v - a1; cs2[(par) * 128 + 2 * lane + 1] = v; } } while (0)
#define SSD_WRITE(step, par) do { \
        _Pragma("unroll") for (int k4 = 0; k4 < 4; ++k4) { *(LAS v4u*)(Bi + wB + k4 * 8192) = Bq[k4]; cf[k4] = __builtin_bit_cast(bf16x8, Cq[k4]); } \
        const float cl = cs2[(par) * 128 + 127]; \
        _Pragma("unroll") for (int k2 = 0; k2 < 2; ++k2) { const int s = sX + 64 * k2; const float dts = dtv[(par) * 128 + s], es = __builtin_amdgcn_exp2f(cl - cs2[(par) * 128 + s]); \
            float f[8]; unpack8(Xq[k2], f); _Pragma("unroll") for (int e = 0; e < 8; ++e) f[e] *= dts; \
            v4u xo; xo.x = pk2(f[0], f[1]); xo.y = pk2(f[2], f[3]); xo.z = pk2(f[4], f[5]); xo.w = pk2(f[6], f[7]); \
            _Pragma("unroll") for (int e = 0; e < 8; ++e) f[e] *= es; \
            v4u xd; xd.x = pk2(f[0], f[1]); xd.y = pk2(f[2], f[3]); xd.z = pk2(f[4], f[5]); xd.w = pk2(f[6], f[7]); \
            *(LAS v4u*)(Xi + wX + k2 * 8192) = xo; *(LAS v4u*)(Xdi + wX + k2 * 8192) = xd; } } while (0)
#define SSD_WRITE_STATE() do { _Pragma("unroll") for (int pt = 0; pt < 4; ++pt) { \
        u32x2_t w; w.x = pk2(st[pt][0], st[pt][1]); w.y = pk2(st[pt][2], st[pt][3]); *(LAS u32x2_t*)(Sti + lo.sw + pt * 4096) = w; } } while (0)

    __syncthreads();
    SSD_ISSUE(0); SSD_CUMSUM(0, 0); SSD_WRITE_STATE();
    __syncthreads();
    SSD_WRITE(0, 0);
    __syncthreads();
    for (int step = 0; step < 36; ++step) {
        const int par = step & 1; SSD_DECODE(step, d, base, isctx)
        const int r8 = lane >> 3, c8 = lane & 7;
        size_t orow2[2]; v4u ybv[2], zv[2];
#pragma unroll
        for (int ps = 0; ps < 2; ++ps) { const int l = 16 * wave + 8 * ps + r8; orow2[ps] = base + (d ? 127 - l : l); }
        if (!isctx && d == 0 && SH != 5 && SH != 7) {
#pragma unroll
            for (int ps = 0; ps < 2; ++ps) { ybv[ps] = *(const v4u*)((SH ? YQ + (orow2[ps] & 255) * 2048 : YQ + orow2[ps] * 2048) + h * 64 + 8 * c8); zv[ps] = *(const v4u*)(Z + orow2[ps] * 1024 + h * 64 + 8 * c8); } }
        if (step + 1 < 36 && SH != 3 && SH != 7) SSD_ISSUE(step + 1);
        const LAS float* csc = cs2 + par * 128;
        if (!isctx && SH != 7) {
            const float csl = csc[16 * wave + fr];
            const float skd = d == 0 ? dsk * __builtin_amdgcn_rcpf(dtv[par * 128 + 16 * wave + fr]) : 0.f;
            f32x4 y[4];
#pragma unroll
            for (int pt = 0; pt < 4; ++pt) { y[pt] = (f32x4){0.f, 0.f, 0.f, 0.f};
                if (SH != 6) {
#pragma unroll
                for (int kk = 0; kk < 4; ++kk) y[pt] = SSD_MFMA(frag(Sti, lo.fb[kk], pt), cf[kk], y[pt]); } }
            { const float El = __builtin_amdgcn_exp2f(csl);
#pragma unroll
              for (int pt = 0; pt < 4; ++pt) y[pt] *= El; }
            if (SH != 2) switch (wave) {
                case 0: diag<0>(y, cf, Bi, Xi, csc, csl, skd, fr, fq, lo); break; case 1: diag<1>(y, cf, Bi, Xi, csc, csl, skd, fr, fq, lo); break;
                case 2: diag<2>(y, cf, Bi, Xi, csc, csl, skd, fr, fq, lo); break; case 3: diag<3>(y, cf, Bi, Xi, csc, csl, skd, fr, fq, lo); break;
                case 4: diag<4>(y, cf, Bi, Xi, csc, csl, skd, fr, fq, lo); break; case 5: diag<5>(y, cf, Bi, Xi, csc, csl, skd, fr, fq, lo); break;
                case 6: diag<6>(y, cf, Bi, Xi, csc, csl, skd, fr, fq, lo); break; default: diag<7>(y, cf, Bi, Xi, csc, csl, skd, fr, fq, lo); break;
            }
            LAS unsigned char* stg = Ci + wave * 4096;
#pragma unroll
            for (int pt = 0; pt < 4; ++pt) *(LAS f32x4*)(stg + fr * 256 + (((4 * pt + fq) ^ fr) << 4)) = y[pt];
#pragma unroll
            for (int ps = 0; ps < 2; ++ps) { const int rl = 8 * ps + r8;
                const f32x4 t0 = *(const LAS f32x4*)(stg + rl * 256 + (((2 * c8) ^ rl) << 4)), t1 = *(const LAS f32x4*)(stg + rl * 256 + (((2 * c8 + 1) ^ rl) << 4));
                float v[8] = {t0[0], t0[1], t0[2], t0[3], t1[0], t1[1], t1[2], t1[3]};
                if (d == 0 && SH != 5) { float fb[8], fz[8]; unpack8(ybv[ps], fb); unpack8(zv[ps], fz); float q = 0.f;
#pragma unroll
                    for (int e = 0; e < 8; ++e) { v[e] = (v[e] + fb[e]) * fz[e]; q += v[e] * v[e]; }
                    q += __shfl_xor(q, 1); q += __shfl_xor(q, 2); q += __shfl_xor(q, 4);
                    if (c8 == 0) SSQ[(SH ? (orow2[ps] & 255) : orow2[ps]) * 16 + h] = q; }
                v4u o; o.x = pk2(v[0], v[1]); o.y = pk2(v[2], v[3]); o.z = pk2(v[4], v[5]); o.w = pk2(v[6], v[7]);
                if (SH != 5) *(v4u*)((SH ? YQ + (orow2[ps] & 255) * 2048 : YQ + orow2[ps] * 2048) + h * 64 + 8 * c8) = o; else asm volatile("" :: "v"(o)); }
        }
        if (SH != 6 && SH != 7) { const float dec = __builtin_amdgcn_exp2f(csc[127]);
#pragma unroll
          for (int pt = 0; pt < 4; ++pt) st[pt] *= dec;
#pragma unroll
          for (int kk = 0; kk < 4; ++kk) { const bf16x8 af = trfragB(Bi, lo.bb, 32 * kk);
#pragma unroll
              for (int pt = 0; pt < 4; ++pt) st[pt] = SSD_MFMA(af, trfragX(Xdi, lo.xb[pt], 32 * kk), st[pt]); } }
        if (step + 1 < 36) SSD_CUMSUM(step + 1, par ^ 1);
        if (step == 17) {
#pragma unroll
            for (int pt = 0; pt < 4; ++pt) st[pt] = (f32x4){0.f, 0.f, 0.f, 0.f};
            VM_WAIT();
        }
        __syncthreads();
        SSD_WRITE_STATE();
        if (step + 1 < 36 && SH != 4 && SH != 7) SSD_WRITE(step + 1, par ^ 1);
        __syncthreads();
    }
#undef SSD_DECODE
#undef SSD_ISSUE
#undef SSD_CUMSUM
#undef SSD_WRITE
#undef SSD_WRITE_STATE
}
namespace pr {
template <int CTRL, int ROWMASK> __device__ __forceinline__ float dpp_get(float v) {
    return __builtin_bit_cast(float, __builtin_amdgcn_update_dpp(0, __builtin_bit_cast(int, v), CTRL, ROWMASK, 0xF, false)); }
__device__ __forceinline__ float sum8(float q) {
    q += dpp_get<0xB1, 0xF>(q); q += dpp_get<0x4E, 0xF>(q); q += dpp_get<0x141, 0xF>(q); return q; }
__device__ __forceinline__ float scan64(float v) {
    v += dpp_get<0x111, 0xF>(v); v += dpp_get<0x112, 0xF>(v); v += dpp_get<0x114, 0xF>(v); v += dpp_get<0x118, 0xF>(v);
    v += dpp_get<0x142, 0xA>(v); v += dpp_get<0x143, 0xC>(v); return v; }
constexpr int P_B = 0, P_STG = 32768, P_X = 49152, P_XD = 81920, P_ST0 = 114688, P_ST1 = 132096, P_SM = 148480;
template <int W> __device__ __forceinline__ void diag1(f32x4 (&y)[4], const bf16x8 (&cf)[4], const LAS unsigned char* Bi, const LAS unsigned char* Xi, const LAS float* csc, float csl, float skd, int fr, int fq, const Lofs& lo) {
#pragma unroll
    for (int u = 0; u <= W / 2; ++u) {
        const bool has1 = 2 * u + 1 <= W;
        bf16x8 xf[4];
#pragma unroll
        for (int pt = 0; pt < 4; ++pt) xf[pt] = trfragX(Xi, lo.xb[pt], 32 * u);
        const f32x4 c0 = *(const LAS f32x4*)(csc + 32 * u + 4 * fq), c1 = *(const LAS f32x4*)(csc + 32 * u + 16 + 4 * fq);
        f32x4 a0 = (f32x4){0.f, 0.f, 0.f, 0.f}, a1 = (f32x4){0.f, 0.f, 0.f, 0.f};
#pragma unroll
        for (int kk = 0; kk < 4; ++kk) { a0 = SSD_MFMA(frag(Bi, lo.fb[kk], 2 * u), cf[kk], a0); if (has1) a1 = SSD_MFMA(frag(Bi, lo.fb[kk], 2 * u + 1), cf[kk], a1); }
        float m0[4], m1[4];
#pragma unroll
        for (int e = 0; e < 4; ++e) {
            m0[e] = a0[e] * __builtin_amdgcn_exp2f(fminf(csl - c0[e], 0.f)); if (2 * u == W) { if (4 * fq + e > fr) m0[e] = 0.f; if (4 * fq + e == fr) m0[e] += skd; }
            m1[e] = has1 ? a1[e] * __builtin_amdgcn_exp2f(fminf(csl - c1[e], 0.f)) : 0.f; if (2 * u + 1 == W) { if (4 * fq + e > fr) m1[e] = 0.f; if (4 * fq + e == fr) m1[e] += skd; } }
        const v4u mw = (v4u){pk2(m0[0], m0[1]), pk2(m0[2], m0[3]), pk2(m1[0], m1[1]), pk2(m1[2], m1[3])};
        const bf16x8 mf = __builtin_bit_cast(bf16x8, mw);
#pragma unroll
        for (int pt = 0; pt < 4; ++pt) y[pt] = SSD_MFMA(xf[pt], mf, y[pt]);
    }
}
__device__ __forceinline__ void diag_sw(int wave, f32x4 (&y)[4], const bf16x8 (&cf)[4], const LAS unsigned char* Bi, const LAS unsigned char* Xi, const LAS float* csc, float csl, float skd, int fr, int fq, const Lofs& lo) {
    switch (wave) {
        case 0: diag<0>(y, cf, Bi, Xi, csc, csl, skd, fr, fq, lo); break; case 1: diag<1>(y, cf, Bi, Xi, csc, csl, skd, fr, fq, lo); break;
        case 2: diag<2>(y, cf, Bi, Xi, csc, csl, skd, fr, fq, lo); break; case 3: diag<3>(y, cf, Bi, Xi, csc, csl, skd, fr, fq, lo); break;
        case 4: diag<4>(y, cf, Bi, Xi, csc, csl, skd, fr, fq, lo); break; case 5: diag<5>(y, cf, Bi, Xi, csc, csl, skd, fr, fq, lo); break;
        case 6: diag<6>(y, cf, Bi, Xi, csc, csl, skd, fr, fq, lo); break; default: diag<7>(y, cf, Bi, Xi, csc, csl, skd, fr, fq, lo); break;
    }
}

__device__ __forceinline__ void ssd_pair(int b, int hp, const bf16* XC, const float* DT, const bf16* Z, const float* a_log, const float* d_skip, bf16* YQ, float* SSQ,
                                          LAS unsigned char* L, int tid_in, int lane_in, int wave) {
    int tid = tid_in, lane = lane_in; asm volatile("" : "+v"(tid), "+v"(lane));
    const int fr = lane & 15, fq = lane >> 4, h0 = 2 * hp, g = hp >> 2;
    LAS unsigned char* Bi = L + P_B; LAS unsigned char* Stg = L + P_STG + wave * 2048;
    LAS float* dtv = (LAS float*)(L + P_SM); LAS float* cs2 = dtv + 512;
    const float an00 = -expf(a_log[h0]) * LOG2E, an01 = -expf(a_log[h0 + 1]) * LOG2E, an10 = -expf(a_log[16 + h0]) * LOG2E, an11 = -expf(a_log[16 + h0 + 1]) * LOG2E;
    const float dsk0 = d_skip[h0], dsk1 = d_skip[h0 + 1];
    Lofs lo;
    { const int q = (lane & 15) >> 2, pp = lane & 3, rr = 4 * fq + q;
#pragma unroll
      for (int kk = 0; kk < 4; ++kk) lo.fb[kk] = fr * 256 + (((4 * kk + fq) ^ fr) << 4);
#pragma unroll
      for (int pt = 0; pt < 4; ++pt) lo.xb[pt] = rr * 128 + ((pt ^ ((rr >> 1) & 3)) << 5) + 8 * pp;
      lo.bb = rr * 256 + (((2 * wave + (pp >> 1)) ^ rr) << 4) + 8 * (pp & 1);
      lo.sw = fr * 256 + (((2 * wave + (fq >> 1)) ^ fr) << 4) + (fq & 1) * 8; }
    const int sB = tid >> 4, cB = tid & 15, hx = (tid >> 3) & 1, cX = tid & 7;
    const int wB = sB * 256 + ((cB ^ (sB & 15)) << 4);
    const int wX = hx * 16384 + sB * 128 + (((cX >> 1) ^ ((sB >> 1) & 3)) << 5) + (cX & 1) * 16;
    f32x4 st[2][4];
#pragma unroll
    for (int hh = 0; hh < 2; ++hh)
#pragma unroll
        for (int pt = 0; pt < 4; ++pt) st[hh][pt] = (f32x4){0.f, 0.f, 0.f, 0.f};
    v4u Bq[4], Xq[4]; float dq0 = 0.f, dq1 = 0.f; bf16x8 cf[4];
#define PR_DECODE(step, d_, base_, ctx_) const int d_ = 1 - (step) / 18; const int k_##d_ = (step) % 18; const bool ctx_ = k_##d_ < 2; \
    const size_t base_ = ctx_ ? (size_t)ML + (size_t)b * CTXL + (size_t)(d_ ? 1 - k_##d_ : k_##d_) * 128 : (size_t)b * SEQ + (size_t)(d_ ? 17 - k_##d_ : k_##d_ - 2) * 128;
#define PR_ISSUE(step) do { PR_DECODE(step, di, basei, ctxi) (void)ctxi; \
        const bf16* cb_ = XC + basei * CONVC; const int sg_ = di ? -CONVC : CONVC; const int o0_ = di ? 127 * CONVC : 0; \
        const bf16* pb_ = cb_ + (o0_ + sB * sg_ + 1024 + g * 128 + 8 * cB); const bf16* px_ = cb_ + (o0_ + sB * sg_ + h0 * 64 + 8 * cB); \
        _Pragma("unroll") for (int k4 = 0; k4 < 4; ++k4) { Bq[k4] = *(const v4u*)(pb_ + k4 * 32 * sg_); Xq[k4] = *(const v4u*)(px_ + k4 * 32 * sg_); } \
        if (wave < 2) { const size_t r0 = basei + (di ? 127 - 2 * lane : 2 * lane), r1 = basei + (di ? 126 - 2 * lane : 2 * lane + 1); dq0 = DT[r0 * 32 + di * 16 + h0 + wave]; dq1 = DT[r1 * 32 + di * 16 + h0 + wave]; } } while (0)
#define PR_LOADC(step) do { PR_DECODE(step, dc, basec, ctxc) (void)ctxc; const bf16* pc_ = XC + basec * CONVC + ((dc ? 127 - (16 * wave + fr) : 16 * wave + fr) * CONVC + 1280 + g * 128 + 8 * fq); \
        _Pragma("unroll") for (int k4 = 0; k4 < 4; ++k4) cf[k4] = __builtin_bit_cast(bf16x8, *(const v4u*)(pc_ + 32 * k4)); } while (0)
#define PR_CUMSUM(step, par) do { if (wave < 2) { const float an = (1 - (step) / 18) ? (wave ? an11 : an10) : (wave ? an01 : an00); const float a0 = dq0 * an, a1 = dq1 * an; const float v = scan64(a0 + a1); \
        const int o_ = ((par) * 2 + wave) * 128 + 2 * lane; dtv[o_] = dq0; dtv[o_ + 1] = dq1; cs2[o_] = v - a1; cs2[o_ + 1] = v; } } while (0)
#define PR_WRITE(step, par) do { const int ob_ = ((par) * 2 + hx) * 128; const float cl = cs2[ob_ + 127]; \
        _Pragma("unroll") for (int k4 = 0; k4 < 4; ++k4) { *(LAS v4u*)(Bi + wB + k4 * 8192) = Bq[k4]; \
            const int s = sB + 32 * k4; const float dts = dtv[ob_ + s], es = __builtin_amdgcn_exp2f(cl - cs2[ob_ + s]); \
            float f[8]; unpack8(Xq[k4], f); _Pragma("unroll") for (int e = 0; e < 8; ++e) f[e] *= dts; \
            v4u xo; xo.x = pk2(f[0], f[1]); xo.y = pk2(f[2], f[3]); xo.z = pk2(f[4], f[5]); xo.w = pk2(f[6], f[7]); \
            _Pragma("unroll") for (int e = 0; e < 8; ++e) f[e] *= es; \
            v4u xd; xd.x = pk2(f[0], f[1]); xd.y = pk2(f[2], f[3]); xd.z = pk2(f[4], f[5]); xd.w = pk2(f[6], f[7]); \
            *(LAS v4u*)(L + P_X + wX + k4 * 4096) = xo; *(LAS v4u*)(L + P_XD + wX + k4 * 4096) = xd; } } while (0)
#define PR_WRITE_STATE() do { _Pragma("unroll") for (int pt = 0; pt < 4; ++pt) { \
        u32x2_t w; w.x = pk2(st[0][pt][0], st[0][pt][1]); w.y = pk2(st[0][pt][2], st[0][pt][3]); *(LAS u32x2_t*)(L + P_ST0 + lo.sw + pt * 4096) = w; \
        w.x = pk2(st[1][pt][0], st[1][pt][1]); w.y = pk2(st[1][pt][2], st[1][pt][3]); *(LAS u32x2_t*)(L + P_ST1 + lo.sw + pt * 4096) = w; } } while (0)

    __syncthreads();
    PR_ISSUE(0); PR_LOADC(0); PR_CUMSUM(0, 0); PR_WRITE_STATE();
    __syncthreads();
    PR_WRITE(0, 0);
    __syncthreads();
    for (int step = 0; step < 36; ++step) {
        const int par = step & 1; PR_DECODE(step, d, base, isctx)
        const int r8 = lane >> 3, c8 = lane & 7;
        size_t orow2[2]; v4u ybv[2], zv[2];
#pragma unroll
        for (int ps = 0; ps < 2; ++ps) { const int l = 16 * wave + 8 * ps + r8; orow2[ps] = base + (d ? 127 - l : l); }
        const bool fwdy = !isctx && d == 0;
        if (fwdy) {
#pragma unroll
            for (int ps = 0; ps < 2; ++ps) { ybv[ps] = *(const v4u*)(YQ + orow2[ps] * 2048 + h0 * 64 + 8 * c8); zv[ps] = *(const v4u*)(Z + orow2[ps] * 1024 + h0 * 64 + 8 * c8); } }
        if (step + 1 < 36) PR_ISSUE(step + 1);
        if (!isctx) {
#pragma unroll
            for (int hh = 0; hh < 2; ++hh) {
                const LAS float* csc = cs2 + (par * 2 + hh) * 128;
                const LAS unsigned char* Xi = L + P_X + hh * 16384; const LAS unsigned char* Sti = L + (hh ? P_ST1 : P_ST0);
                const float csl = csc[16 * wave + fr];
                const float skd = d == 0 ? (hh ? dsk1 : dsk0) * __builtin_amdgcn_rcpf(dtv[(par * 2 + hh) * 128 + 16 * wave + fr]) : 0.f;
                f32x4 y[4];
#pragma unroll
                for (int pt = 0; pt < 4; ++pt) { y[pt] = (f32x4){0.f, 0.f, 0.f, 0.f};
#pragma unroll
                    for (int kk = 0; kk < 4; ++kk) y[pt] = SSD_MFMA(frag(Sti, lo.fb[kk], pt), cf[kk], y[pt]); }
                { const float El = __builtin_amdgcn_exp2f(csl);
#pragma unroll
                  for (int pt = 0; pt < 4; ++pt) y[pt] *= El; }
                diag_sw(wave, y, cf, Bi, Xi, csc, csl, skd, fr, fq, lo);
#pragma unroll
                for (int ps = 0; ps < 2; ++ps) {
                    if ((fr >> 3) == ps) {
#pragma unroll
                        for (int pt = 0; pt < 4; ++pt) *(LAS f32x4*)(Stg + (fr & 7) * 256 + (((4 * pt + fq) ^ fr) << 4)) = y[pt]; }
                    const int key = 8 * ps + r8;
                    const f32x4 t0 = *(const LAS f32x4*)(Stg + r8 * 256 + (((2 * c8) ^ key) << 4)), t1 = *(const LAS f32x4*)(Stg + r8 * 256 + (((2 * c8 + 1) ^ key) << 4));
                    float v[8] = {t0[0], t0[1], t0[2], t0[3], t1[0], t1[1], t1[2], t1[3]};
                    if (d == 0) { float fb[8], fz[8]; unpack8(ybv[ps], fb); unpack8(zv[ps], fz); float q = 0.f;
#pragma unroll
                        for (int e = 0; e < 8; ++e) { v[e] = (v[e] + fb[e]) * fz[e]; q += v[e] * v[e]; }
                        q = sum8(q);
                        if (c8 == 0) SSQ[orow2[ps] * 16 + h0 + hh] = q; }
                    v4u o; o.x = pk2(v[0], v[1]); o.y = pk2(v[2], v[3]); o.z = pk2(v[4], v[5]); o.w = pk2(v[6], v[7]);
                    *(v4u*)(YQ + orow2[ps] * 2048 + (h0 + hh) * 64 + 8 * c8) = o;
                }
                if (hh == 0 && fwdy) {
#pragma unroll
                    for (int ps = 0; ps < 2; ++ps) { ybv[ps] = *(const v4u*)(YQ + orow2[ps] * 2048 + (h0 + 1) * 64 + 8 * c8); zv[ps] = *(const v4u*)(Z + orow2[ps] * 1024 + (h0 + 1) * 64 + 8 * c8); } }
            }
        }
        if (step + 1 < 36) PR_LOADC(step + 1);
        { const float dec0 = __builtin_amdgcn_exp2f(cs2[(par * 2 + 0) * 128 + 127]), dec1 = __builtin_amdgcn_exp2f(cs2[(par * 2 + 1) * 128 + 127]);
#pragma unroll
          for (int pt = 0; pt < 4; ++pt) { st[0][pt] *= dec0; st[1][pt] *= dec1; }
#pragma unroll
          for (int kk = 0; kk < 4; ++kk) { const bf16x8 af = trfragB(Bi, lo.bb, 32 * kk);
#pragma unroll
              for (int pt = 0; pt < 4; ++pt) { st[0][pt] = SSD_MFMA(af, trfragX(L + P_XD, lo.xb[pt], 32 * kk), st[0][pt]); st[1][pt] = SSD_MFMA(af, trfragX(L + P_XD + 16384, lo.xb[pt], 32 * kk), st[1][pt]); } } }
        if (step + 1 < 36) PR_CUMSUM(step + 1, par ^ 1);
        if (step == 17) {
#pragma unroll
            for (int pt = 0; pt < 4; ++pt) { st[0][pt] = (f32x4){0.f, 0.f, 0.f, 0.f}; st[1][pt] = (f32x4){0.f, 0.f, 0.f, 0.f}; }
            VM_WAIT();
        }
        __syncthreads();
        PR_WRITE_STATE();
        if (step + 1 < 36) PR_WRITE(step + 1, par ^ 1);
        __syncthreads();
    }
#undef PR_DECODE
#undef PR_ISSUE
#undef PR_CUMSUM
#undef PR_LOADC
#undef PR_WRITE
#undef PR_WRITE_STATE
}
}
}

__device__ __forceinline__ void ctx_dt_slice(const bf16* H, const bf16* bt1, const float* dt_bias, float* DT, int bx, int G, int wave, int lane) {
    typedef short bf16x8_t __attribute__((ext_vector_type(8)));
    const int fr = lane & 15, fq = lane >> 4;
    for (int sl = bx; sl < MC / 32; sl += G) {
        if (wave < 4) {
            const int r0 = ML + 32 * sl + 16 * (wave >> 1), j0 = 16 * (wave & 1);
            const bf16* ap = H + (size_t)(r0 + fr) * DM + 8 * fq; const bf16* bp = bt1 + (size_t)(2048 + j0 + fr) * DM + 8 * fq;
            f32x4 acc = (f32x4){0.f, 0.f, 0.f, 0.f};
#pragma unroll 8
            for (int kk = 0; kk < 32; ++kk) acc = __builtin_amdgcn_mfma_f32_16x16x32_bf16(*(const bf16x8_t*)(ap + 32 * kk), *(const bf16x8_t*)(bp + 32 * kk), acc, 0, 0, 0);
            const float bias = dt_bias[j0 + fr];
#pragma unroll
            for (int e = 0; e < 4; ++e) { const float v = acc[e] + bias; DT[(size_t)(r0 + 4 * fq + e) * 32 + j0 + fr] = v > 20.f ? v : log1pf(__expf(v)); }
        }
    }
}
constexpr int RING_OFF = 0, RING_BYTES = 131072;
constexpr int LDSCTL_OFF = RING_BYTES, MISC_OFF = LDSCTL_OFF + 320;
constexpr int RSTD_OFF = LDSCTL_OFF + 1024;
constexpr int LDS_BYTES = 155648;
constexpr int CW_BAR = 4096;
constexpr int CW_TMO2 = 8192, CW_CNT = 16384;
constexpr int EXL_OFF = 140288;
constexpr int NPHASE = 7;

struct Args { const float* in[18]; float* out; unsigned char* ws; int ph_lo, ph_hi; };

__global__ void __launch_bounds__(NWAVES * 64, 2) mega(Args args) {
    extern __shared__ __attribute__((aligned(16))) unsigned char lds[];
    LAS unsigned char* ldsp = (LAS unsigned char*)lds;
    volatile LAS unsigned* MISC = (volatile LAS unsigned*)(ldsp + MISC_OFF);
    const int wave = __builtin_amdgcn_readfirstlane((int)threadIdx.x >> 6);
#define PH_IDS() int lane = mk_lane(); asm volatile("" : "+v"(lane)); const int tid = wave * 64 + lane; (void)tid
    const int G = gridDim.x; const int bx = blockIdx.x; const int vcu = (G % 8 == 0) ? (bx % 8) * (G / 8) + bx / 8 : bx;
    unsigned char* ws = args.ws;
    gu32* ctl = (gu32*)(ws + WS_CTL);
    float* mod = (float*)(ws + WS_MOD); float* rope = (float*)(ws + WS_ROPE); float* SSQ = (float*)(ws + WS_SSQ); float* RPART = (float*)(ws + WS_RPART);
    bf16* bt1 = (bf16*)(ws + WS_BT1); bf16* bt2 = (bf16*)(ws + WS_BT2); float* DT = (float*)(ws + WS_DT); bf16* KB = (bf16*)(ws + WS_KB); bf16* VB = (bf16*)(ws + WS_VB);
    bf16* H = (bf16*)(ws + WS_R1); bf16* XC = (bf16*)(ws + WS_R1); bf16* XBC = (bf16*)(ws + WS_XBC); bf16* YQ = (bf16*)(ws + WS_YQ); bf16* Z = (bf16*)(ws + WS_Z);
    { PH_IDS(); for (int u = tid; u < (LDS_BYTES - LDSCTL_OFF) / 4; u += NWAVES * 64) ((LAS unsigned*)(ldsp + LDSCTL_OFF))[u] = 0u; }
    __syncthreads();
    const bool leader = wave == 0 && mk_lane() == 0; (void)leader;
    const int lo = args.ph_lo, hi = args.ph_hi;
    XcdBarrier bar; bar.bar = (unsigned*)(ctl + CW_BAR); bar.x = 0; bar.st = nullptr;
    if (hi - lo > 1) bar = xcd_barrier_post((unsigned*)(ctl + CW_BAR), MISC + 8, leader);
#ifndef DUP_MASK
#define DUP_MASK 0
#endif
#define IN(k) (lo <= (k) && (k) < hi)
#define REP(k) for (int rep_ = 0; rep_ < 1 + ((DUP_MASK >> (k)) & 1); ++rep_)
#define SEAM(k) do { if (IN(k) && IN((k) + 1)) xcd_barrier(bar, wave == 0 && mk_lane() == 0); } while (0)

    if (IN(0)) REP(0) {
        PH_IDS();
        LAS float* ldsf = (LAS float*)(ldsp + RING_OFF);
        if (bx < 48) p0_mod_block(args.in[1], args.in[3], args.in[4], args.in[5], mod, ldsf, bx, tid, lane, wave);
        else if (bx == 48) { for (int i = tid; i < 1024; i += NWAVES * 64) { const int p = i >> 4, f = i & 15; const float inv = powf(10000.f, -(float)f / 16.f); const float ang = (float)p * inv; rope[i] = cosf(ang); rope[1024 + i] = sinf(ang); } }
        LAS float* scr = ldsf + wave * (64 * 33);
        const int gw = ((bx + G - 49) % G) * NWAVES + wave, NGW = G * NWAVES;
        constexpr int I1 = 16 * 168, I2 = 32 * 32;
        for (int it = gw; it < I1 + I2; it += NGW) { if (it < I1) p0_bt1_item(args.in[7], bt1, scr, it, lane); else p0_bt2_item(args.in[16], args.in[15], bt2, scr, it - I1, lane); }
    }
    SEAM(0);
    if (IN(1)) REP(1) {
        PH_IDS();
        const int gw = bx * NWAVES + wave, NGW = G * NWAVES;
        static_assert(MT % (8 * 2048) == 0 || true, "row batches");
        {
            const int step = NGW * 4; int m0 = gw * 4;
            f32x4 va[4][4], vb[4][4];
            if (m0 < MT) p1_load4(va, args.in[0], args.in[2], m0, lane);
            while (m0 < MT) {
                if (m0 + step < MT) p1_load4(vb, args.in[0], args.in[2], m0 + step, lane);
                asm volatile("" ::: "memory");
                p1_proc4(va, mod, args.in[6], H, m0, lane);
                m0 += step; if (m0 >= MT) break;
                if (m0 + step < MT) p1_load4(va, args.in[0], args.in[2], m0 + step, lane);
                asm volatile("" ::: "memory");
                p1_proc4(vb, mod, args.in[6], H, m0, lane);
                m0 += step;
            }
        }
    }
    SEAM(1);

    if (IN(2)) REP(2) {
        pg8::Gemm g{H, bt1, MT, N1, 1024}; pg8::Sched1 S; S.init(G, bx);
        pg8::Epi1 E{KB, VB, XBC, YQ, Z, DT, rope, args.in[13], args.in[14], args.in[10]};
        pg8::gemm_phase<pg8::Epi1, pg8::Sched1, true, true>(ldsp + RING_OFF, g, S, E, wave);
        { int ln_ = mk_lane(); asm volatile("" : "+v"(ln_)); ctx_dt_slice(H, bt1, args.in[10], DT, bx, G, wave, ln_); }
    }
    SEAM(2);
    if (IN(3)) {
        PH_IDS();
        float sbound;
        { float gq = fabsf(args.in[13][lane]), gk = fabsf(args.in[14][lane]);
#pragma unroll
          for (int o = 1; o < 64; o <<= 1) { gq = fmaxf(gq, __shfl_xor(gq, o)); gk = fmaxf(gk, __shfl_xor(gk, o)); }
          sbound = __uint_as_float(__builtin_amdgcn_readfirstlane(__float_as_uint(C2 * 64.f * gq * gk * 1.01f))); }
        const attn_body::Order S{vcu, G, false};
        const attn_body::Order S2{vcu, G, true};
#ifndef ATTN_SHADOW
#define ATTN_SHADOW 0
#endif
        if (ATTN_SHADOW) attn_body::attn_phase<8>((char*)lds + RING_OFF, (attn_body::bf16*)YQ, (const attn_body::bf16*)KB, (const attn_body::bf16*)VB, ATTN_SHADOW == 2 ? S2 : S, wave, sbound, (attn_body::bf16*)(ws + WS_END + 8 * MiB));
        attn_body::attn_phase<8>((char*)lds + RING_OFF, (attn_body::bf16*)YQ, (const attn_body::bf16*)KB, (const attn_body::bf16*)VB, S, wave, sbound);
        conv_phase(XBC, args.in[8], args.in[9], XC, bx, G, tid);
    }
    SEAM(3);
    if (IN(4)) REP(4) {
        PH_IDS();
#if defined(SSD_NAIVE)
        for (int it = bx; it < NB * 16; it += G) ssd_item_naive(it >> 4, it & 15, XC, DT, Z, args.in[11], args.in[12], YQ, SSQ, (LAS float*)(ldsp + RING_OFF), tid);
#else
#ifndef SSD_SHADOW
#define SSD_SHADOW 0
#endif
        if (SSD_SHADOW) { bf16* dY = (bf16*)(ws + WS_END); float* dS = (float*)(ws + WS_END + 2 * MiB);
            for (int it = vcu; it < NB * 16; it += G) ssd::ssd_item<SSD_SHADOW>(it >> 4, it & 15, XC, DT, Z, args.in[11], args.in[12], dY, dS, ldsp, tid, lane, wave); }
#ifndef SSD_PAIR
#define SSD_PAIR 1
#endif
        if (SSD_PAIR) { for (int it = vcu; it < NB * 8; it += G) { int ln_ = mk_lane(); asm volatile("" : "+v"(ln_)); ssd::pr::ssd_pair(it >> 3, it & 7, XC, DT, Z, args.in[11], args.in[12], YQ, SSQ, ldsp, wave * 64 + ln_, ln_, wave); } }
        else for (int it = vcu; it < NB * 16; it += G) ssd::ssd_item<0>(it >> 4, it & 15, XC, DT, Z, args.in[11], args.in[12], YQ, SSQ, ldsp, tid, lane, wave);
#endif
    }
    SEAM(4);

    if (IN(5)) REP(5) {
        PH_IDS();
        pg8::Sched2 S; S.init(G, bx);
        LAS float* rt = (LAS float*)(ldsp + RSTD_OFF);
        { pg8::Unit u; for (int i = 0; i < 4 && S.next(i, u); ++i) if (tid < 256) { const float* q = SSQ + ((size_t)u.pm * 256 + tid) * 16; float s = 0.f;
#pragma unroll
                for (int j = 0; j < 16; ++j) s += q[j];
                rt[i * 256 + tid] = rsqrtf(s * (1.f / 1024.f) + EPS); } }
        __syncthreads();
        pg8::Gemm g{YQ, bt2, ML, 1024, 2048};
        pg8::Epi2 E{args.in[0], mod, args.in[17], args.out, (unsigned long long*)RPART, (unsigned*)(ctl + CW_CNT), (unsigned*)(ctl + CW_TMO2), (const LAS float*)rt, (LAS float*)(ldsp + EXL_OFF)};
        pg8::gemm_phase<pg8::Epi2, pg8::Sched2, true, true>(ldsp + RING_OFF, g, S, E, wave);
    }

#undef IN
#undef SEAM
}

extern "C" void kernel_launch(void* const* d_in, const int* in_sizes, int n_in, void* d_out, int out_size, void* d_ws, size_t ws_size, hipStream_t stream) {
    if (n_in != 18 || out_size != ML * DM || ws_size < WS_END) { fprintf(stderr, "kernel_launch: unexpected shapes (n_in %d out %d ws %zu); nothing launched\n", n_in, out_size, ws_size); return; }
    static int grid = 0;
    if (grid == 0) {
        int dev = 0, cus = 0;
        if (hipGetDevice(&dev) != hipSuccess || hipDeviceGetAttribute(&cus, hipDeviceAttributeMultiprocessorCount, dev) != hipSuccess) { fprintf(stderr, "kernel_launch: device query failed\n"); grid = -1; return; }
        if (hipFuncSetAttribute((const void*)mega, hipFuncAttributeMaxDynamicSharedMemorySize, LDS_BYTES) != hipSuccess) { fprintf(stderr, "kernel_launch: hipFuncSetAttribute failed\n"); grid = -1; return; }
        int per_cu = 0;
        if (hipOccupancyMaxActiveBlocksPerMultiprocessor(&per_cu, (const void*)mega, NWAVES * 64, LDS_BYTES) != hipSuccess || per_cu < 1) fprintf(stderr, "kernel_launch: note: occupancy query says %d blocks/CU\n", per_cu);
        (void)hipGetLastError();
        grid = cus;
    }
    if (grid < 0) return;
    (void)hipMemsetAsync((unsigned char*)d_ws + WS_CTL, 0, 1 * MiB, stream);
    Args a{};
    for (int i = 0; i < 18; ++i) a.in[i] = (const float*)d_in[i];
    a.out = (float*)d_out; a.ws = (unsigned char*)d_ws; a.ph_lo = 0; a.ph_hi = NPHASE;
    hipLaunchKernelGGL(mega, dim3(grid), dim3(NWAVES * 64), LDS_BYTES, stream, a);
    const hipError_t le = hipPeekAtLastError(); if (le != hipSuccess) fprintf(stderr, "kernel_launch: launch failed: %s\n", hipGetErrorName(le));
}
```

```cpp
#include <hip/hip_runtime.h>
#include <cstdio>
#include <cstdint>
#include <hip/hip_bf16.h>

constexpr int DM = 1024, NB = 32, SEQ = 2048, CTXL = 256, KVL = SEQ + CTXL;
constexpr int ML = NB * SEQ, MC = NB * CTXL, MT = ML + MC;
constexpr int PROJ = 5152, OFF_XBC = 512, OFF_DT = 2048, CTXC = 2080, CONVC = 1536;
constexpr int N1 = 21 * 256;
constexpr float EPS = 1e-6f;
constexpr float C2 = 0.125f * 1.4426950408889634f;

typedef unsigned short bf16;
__device__ __forceinline__ int mk_lane() { return (int)__builtin_amdgcn_mbcnt_hi(~0u, __builtin_amdgcn_mbcnt_lo(~0u, 0u)); }
__host__ __device__ __forceinline__ unsigned f2bf(float f) { unsigned u = __builtin_bit_cast(unsigned, f); return (u + 0x7fffu + ((u >> 16) & 1u)) >> 16; }
__host__ __device__ __forceinline__ float bf2f(unsigned h) { return __builtin_bit_cast(float, (h & 0xffffu) << 16); }
__device__ __forceinline__ float siluf(float v) { return v / (1.f + __expf(-v)); }
__device__ __forceinline__ float softplusf(float v) { return v > 20.f ? v : log1pf(expf(v)); }

constexpr size_t MiB = 1u << 20;
constexpr size_t WS_CTL = 0;
constexpr size_t WS_MOD = 2 * MiB;
constexpr size_t WS_ROPE = 3 * MiB;
constexpr size_t WS_SSQ = 4 * MiB;
constexpr size_t WS_RPART = 8 * MiB;
constexpr size_t WS_BT1 = 12 * MiB;
constexpr size_t WS_BT2 = 23 * MiB;
constexpr size_t WS_DT = 28 * MiB;
constexpr size_t WS_KB = 38 * MiB;
constexpr size_t WS_VB = 74 * MiB;
constexpr size_t WS_R1 = 110 * MiB;
constexpr size_t WS_XBC = 326 * MiB;
constexpr size_t WS_YQ = 542 * MiB;
constexpr size_t WS_Z = 798 * MiB;
constexpr size_t WS_END = 926 * MiB;

__host__ __device__ __forceinline__ int hperm_dim(int vin) {
    const int bj = vin >> 7, wc = (vin >> 5) & 3, s = vin & 31, fq = s >> 3, e = s & 7;
    return wc * 64 + bj * 32 + (e >> 2) * 16 + 4 * fq + (e & 3);
}
__host__ __device__ __forceinline__ int hperm_inv(int head, int dim) {
    const int axis = dim >> 5, half = (dim >> 4) & 1, i16 = dim & 15, fq = i16 >> 2, e = (i16 & 3) + 4 * half;
    return 128 * axis + 32 * head + 8 * fq + e;
}
__host__ __device__ __forceinline__ int vcol_actual(int v) {
    const int t = v >> 8, vin = v & 255;
    if (t == 0) return hperm_dim(vin);
    const int pv = 64 * ((vin >> 5) & 3) + 32 * (vin >> 7) + (vin & 31);
    if (t == 1) return 256 + pv;
    if (t < 8) return t * 256 + pv;
    if (t == 8) return vin < 32 ? OFF_DT + vin : -1;
    if (t < 13) return CTXC + (t - 9) * 256 + hperm_dim(vin);
    if (t < 17) return CTXC + 1024 + (t - 13) * 256 + pv;
    return CTXC + 2048 + (t - 17) * 256 + pv;
}

namespace pg8 {
#define PG8_LAS __attribute__((address_space(3)))
typedef unsigned short bf16_t;
typedef short bf16x8 __attribute__((ext_vector_type(8)));
typedef float f32x4 __attribute__((ext_vector_type(4)));
typedef unsigned u32x4 __attribute__((ext_vector_type(4)));
constexpr int BM = 256, BK = 64, HALF = 128, HTB = HALF * BK * 2  , STAGE_BYTES = 8 * HTB, NXCD = 8, WGM = 8;

__host__ __device__ __forceinline__ int lds_byte(int r, int c) { const int st = (r >> 4) * 2 + (c >> 5), rr = r & 15, cc = c & 31, ob = rr * 64 + cc * 2; return st * 1024 + (ob ^ (((ob >> 9) & 1) << 5)); }
__host__ __device__ __forceinline__ void stage_rc(int b, int& R, int& C) { const int st = b / 1024, sb = b % 1024, swz = sb ^ (((sb >> 9) & 1) << 5); R = (st >> 1) * 16 + swz / 64; C = (st & 1) * 32 + (swz % 64) / 2; }
__host__ __device__ __forceinline__ int perm32(int rho) { const int n = rho >> 4, i = rho & 15; return 8 * (i >> 2) + 4 * n + (i & 3); }

struct Unit { int pm, pn; };
struct Gemm { const bf16_t* A; const bf16_t* Bt; int M, N, K; };

__device__ __forceinline__ unsigned cvt_pk_bf16(float lo, float hi) { unsigned r; asm volatile("v_cvt_pk_bf16_f32 %0, %1, %2" : "=v"(r) : "v"(lo), "v"(hi)); return r; }
typedef float f32x2 __attribute__((ext_vector_type(2)));
template <class Epi, class Sched, bool ALIGN_EPI = false, bool SP2 = false>
__device__ __forceinline__ void gemm_phase(PG8_LAS unsigned char* lds, const Gemm g, const Sched& S, const Epi& E, int wid_in) {
    const int wid = wid_in; int lane = mk_lane(); asm volatile("" : "+v"(lane)); const int tid = wid * 64 + lane, wr = wid >> 2, wc = wid & 3, fr = lane & 15, fq = lane >> 4;
    const int K = g.K, nt = K / BK;
    unsigned voffA[2], voffB[2];
#pragma unroll
    for (int i = 0; i < 2; ++i) { int R, C; stage_rc(tid * 16 + i * 8192, R, C); const int Rb = Epi::PERM ? ((R & ~31) + perm32(R & 31)) : R;
        voffA[i] = (unsigned)(R * K + C) * 2u; voffB[i] = (unsigned)(Rb * K + C) * 2u; }
    const size_t kstep = (size_t)(BK * 2);
    const size_t hstep = (size_t)HALF * K * 2;
    const size_t tstep = 2 * hstep;
    const unsigned ldsw = (unsigned)wid * 1024u;
    const int aoff = lds_byte(wr * 64 + fr, fq * 8), boff = lds_byte(wc * 32 + fr, fq * 8);
#define PG8_SA(b, h) (((b) * 2 + (h)) * HTB)
#define PG8_SB(b, h) ((4 + (b) * 2 + (h)) * HTB)
#define PG8_STAGE(bufoff, gbase, voff) do { _Pragma("unroll") for (int _i = 0; _i < 2; ++_i) \
        __builtin_amdgcn_global_load_lds((const unsigned*)((const char*)(gbase) + (voff)[_i]), (PG8_LAS unsigned*)(lds + (bufoff) + ldsw + _i * 8192), 16, 0, 0); } while (0)
#define PG8_LDA(dst, b, h) do { _Pragma("unroll") for (int m = 0; m < 4; ++m) _Pragma("unroll") for (int k = 0; k < 2; ++k) dst[m][k] = *(const PG8_LAS bf16x8*)(lds + PG8_SA(b, h) + aoff + m * 2048 + k * 1024); } while (0)
#define PG8_LDB(dst, b, h) do { _Pragma("unroll") for (int n = 0; n < 2; ++n) _Pragma("unroll") for (int k = 0; k < 2; ++k) dst[n][k] = *(const PG8_LAS bf16x8*)(lds + PG8_SB(b, h) + boff + n * 2048 + k * 1024); } while (0)
#define PG8_MMA(ai, bj, At, Bt) do { __builtin_amdgcn_s_setprio(1); _Pragma("unroll") for (int m = 0; m < 4; ++m) _Pragma("unroll") for (int n = 0; n < 2; ++n) _Pragma("unroll") for (int k = 0; k < 2; ++k) \
        acc[ai][bj][m][n] = __builtin_amdgcn_mfma_f32_16x16x32_bf16(Bt[n][k], At[m][k], acc[ai][bj][m][n], 0, 0, 0); __builtin_amdgcn_s_setprio(0); } while (0)
#define PG8_WAIT_V(n) asm volatile("s_waitcnt vmcnt(" #n ")" ::: "memory")
#define PG8_WAIT_L(n) asm volatile("s_waitcnt lgkmcnt(" #n ")" ::: "memory")
#define PG8_BAR __builtin_amdgcn_s_barrier()
#define PG8_SCHED __builtin_amdgcn_sched_barrier(0)
    Unit cur, nxt; int ui = 0;
    if (!S.next(0, cur)) return;
    f32x4 acc[2][2][4][2];
#pragma unroll
    for (int a = 0; a < 2; ++a)
#pragma unroll
        for (int b = 0; b < 2; ++b)
#pragma unroll
            for (int m = 0; m < 4; ++m)
#pragma unroll
                for (int n = 0; n < 2; ++n) acc[a][b][m][n] = (f32x4){0.f, 0.f, 0.f, 0.f};
    bf16x8 At[4][2], B0[2][2], B1[2][2];
    const char* cA = (const char*)g.A + (size_t)cur.pm * tstep; const char* cB = (const char*)g.Bt + (size_t)cur.pn * tstep;
    S.a_ready(cur);
    if constexpr (SP2) {
        PG8_STAGE(PG8_SB(0, 0), cB, voffB); PG8_STAGE(PG8_SB(0, 1), cB + hstep, voffB); PG8_STAGE(PG8_SA(0, 0), cA, voffA); PG8_STAGE(PG8_SA(0, 1), cA + hstep, voffA);
        if (wr == 1) PG8_BAR;
        PG8_WAIT_V(2); PG8_BAR;
        PG8_STAGE(PG8_SB(1, 0), cB + kstep, voffB); PG8_STAGE(PG8_SA(1, 0), cA + kstep, voffA); PG8_STAGE(PG8_SB(1, 1), cB + hstep + kstep, voffB);
        PG8_WAIT_V(6); PG8_BAR;
    } else {
        PG8_STAGE(PG8_SB(0, 0), cB, voffB); PG8_STAGE(PG8_SA(0, 0), cA, voffA); PG8_STAGE(PG8_SB(0, 1), cB + hstep, voffB); PG8_STAGE(PG8_SA(0, 1), cA + hstep, voffA);
        if (wr == 1) PG8_BAR;
        PG8_WAIT_V(4); PG8_BAR;
        PG8_STAGE(PG8_SB(1, 0), cB + kstep, voffB); PG8_STAGE(PG8_SA(1, 0), cA + kstep, voffA); PG8_STAGE(PG8_SB(1, 1), cB + hstep + kstep, voffB);
        PG8_WAIT_V(6); PG8_BAR;
    }
    for (;;) {
        const bool has_next = S.next(ui + 1, nxt);
        const char* nA = has_next ? (const char*)g.A + (size_t)nxt.pm * tstep : cA; const char* nB = has_next ? (const char*)g.Bt + (size_t)nxt.pn * tstep : cB;
        for (int t = 0; t < nt; t += 2) {
            if constexpr (Epi::MIDK) { if (t == nt / 2) E.midk(acc, ui, wr, fr); }
            const bool last = (t == nt - 2);
            const char* a1 = cA + (size_t)(t + 1) * kstep;
            const char* a2 = last ? nA : cA + (size_t)(t + 2) * kstep; const char* b2 = last ? nB : cB + (size_t)(t + 2) * kstep;
            const char* a3 = a2 + kstep; const char* b3 = b2 + kstep;
            if (last && has_next) S.a_ready(nxt);
            if constexpr (SP2) {
            PG8_LDB(B0, 0, 0); PG8_LDB(B1, 0, 1); PG8_SCHED; PG8_LDA(At, 0, 0); PG8_STAGE(PG8_SA(1, 1), a1 + hstep, voffA);
            PG8_WAIT_V(8); PG8_WAIT_L(0); PG8_BAR; PG8_MMA(0, 0, At, B0); PG8_MMA(0, 1, At, B1); PG8_BAR; PG8_SCHED;
            PG8_LDA(At, 0, 1); PG8_STAGE(PG8_SB(0, 0), b2, voffB); PG8_STAGE(PG8_SB(0, 1), b2 + hstep, voffB); PG8_STAGE(PG8_SA(0, 0), a2, voffA);
            PG8_WAIT_V(8); PG8_WAIT_L(0); PG8_BAR; PG8_MMA(1, 0, At, B0); PG8_MMA(1, 1, At, B1); PG8_BAR; PG8_SCHED;
            PG8_LDB(B0, 1, 0); PG8_LDB(B1, 1, 1); PG8_SCHED; PG8_LDA(At, 1, 0); PG8_STAGE(PG8_SA(0, 1), a2 + hstep, voffA);
            PG8_WAIT_V(8); PG8_WAIT_L(0); PG8_BAR; PG8_MMA(0, 0, At, B0); PG8_MMA(0, 1, At, B1); PG8_BAR; PG8_SCHED;
            PG8_LDA(At, 1, 1); PG8_STAGE(PG8_SB(1, 0), b3, voffB); PG8_STAGE(PG8_SB(1, 1), b3 + hstep, voffB); PG8_STAGE(PG8_SA(1, 0), a3, voffA);
            PG8_WAIT_V(8); PG8_WAIT_L(0); PG8_BAR; PG8_MMA(1, 0, At, B0); PG8_MMA(1, 1, At, B1); PG8_BAR; PG8_SCHED;
            } else {
            PG8_LDB(B0, 0, 0); PG8_SCHED; PG8_LDA(At, 0, 0); PG8_STAGE(PG8_SA(1, 1), a1 + hstep, voffA);
            PG8_WAIT_L(8); PG8_BAR; PG8_WAIT_L(0); PG8_MMA(0, 0, At, B0); PG8_BAR; PG8_SCHED;
            PG8_LDB(B1, 0, 1); PG8_STAGE(PG8_SB(0, 0), b2, voffB);
            PG8_BAR; PG8_WAIT_L(0); PG8_MMA(0, 1, At, B1); PG8_BAR;
            PG8_LDA(At, 0, 1); PG8_STAGE(PG8_SA(0, 0), a2, voffA);
            PG8_BAR; PG8_WAIT_L(0); PG8_MMA(1, 0, At, B0); PG8_BAR; PG8_SCHED;
            PG8_STAGE(PG8_SB(0, 1), b2 + hstep, voffB);
            PG8_WAIT_V(6); PG8_BAR; PG8_MMA(1, 1, At, B1); PG8_BAR;
            PG8_LDB(B0, 1, 0); PG8_SCHED; PG8_LDA(At, 1, 0); PG8_STAGE(PG8_SA(0, 1), a2 + hstep, voffA);
            PG8_WAIT_L(8); PG8_BAR; PG8_WAIT_L(0); PG8_MMA(0, 0, At, B0); PG8_BAR; PG8_SCHED;
            PG8_LDB(B1, 1, 1); PG8_STAGE(PG8_SB(1, 0), b3, voffB);
            PG8_BAR; PG8_WAIT_L(0); PG8_MMA(0, 1, At, B1); PG8_BAR;
            PG8_LDA(At, 1, 1); PG8_STAGE(PG8_SA(1, 0), a3, voffA);
            PG8_BAR; PG8_WAIT_L(0); PG8_MMA(1, 0, At, B0); PG8_BAR; PG8_SCHED;
            PG8_STAGE(PG8_SB(1, 1), b3 + hstep, voffB);
            PG8_WAIT_V(6); PG8_BAR; PG8_MMA(1, 1, At, B1); PG8_BAR;
            }
        }
        if constexpr (ALIGN_EPI) { if (wr == 0) PG8_BAR; }
        if constexpr (!Epi::AFTER_DRAIN) { E(acc, cur, wr, wc, fr, fq); S.done(cur); }
        if (!has_next) break;
#pragma unroll
        for (int a = 0; a < 2; ++a)
#pragma unroll
            for (int b = 0; b < 2; ++b)
#pragma unroll
                for (int m = 0; m < 4; ++m)
#pragma unroll
                    for (int n = 0; n < 2; ++n) acc[a][b][m][n] = (f32x4){0.f, 0.f, 0.f, 0.f};
        cur = nxt; cA = nA; cB = nB; ++ui;
        if constexpr (ALIGN_EPI) { if (wr == 1) PG8_BAR; }
    }
    PG8_WAIT_V(0);
    if constexpr (!ALIGN_EPI) { if (wr == 0) PG8_BAR; }
    PG8_BAR;
    if constexpr (Epi::AFTER_DRAIN) { E.fused(acc, cur, wr, wc, fr, fq, lds, wid, lane); S.done(cur); }
#undef PG8_SA
#undef PG8_SB
#undef PG8_STAGE
#undef PG8_LDA
#undef PG8_LDB
#undef PG8_MMA
#undef PG8_WAIT_V
#undef PG8_WAIT_L
#undef PG8_BAR
#undef PG8_SCHED
}
struct Sched1 {
    int G, c;
    __device__ __forceinline__ void init(int G_, int c_) { G = G_; c = c_; }
    __device__ __forceinline__ bool next(int i, Unit& u) const {
        constexpr int nN = 21, nwg = 256 * nN;
        const int L = i * G + c;
        if (L < nwg) { const int wgid = (L % NXCD) * (nwg / NXCD) + L / NXCD; const int nig = WGM * nN, fm = (wgid / nig) * WGM;
            u.pm = fm + ((wgid % nig) % WGM); u.pn = (wgid % nig) / WGM; return true; }
        const int L2 = L - nwg; if (L2 >= 256) return false;
        const int wg = (L2 % NXCD) * 32 + L2 / NXCD; u.pn = wg >> 5; u.pm = 256 + (wg & 31); return true;
    }
    __device__ __forceinline__ void a_ready(const Unit&) const {}
    __device__ __forceinline__ void done(const Unit&) const {}
};
struct Sched2 {
    int G, c;
    __device__ __forceinline__ void init(int G_, int c_) { G = G_; c = c_; }
    __device__ __forceinline__ bool next(int i, Unit& u) const {
        constexpr int nN = 4, nwg = 256 * nN;
        const int L = i * G + c; if (L >= nwg) return false;
        const int wgid = (L % NXCD) * (nwg / NXCD) + L / NXCD; const int nig = WGM * nN, fm = (wgid / nig) * WGM;
        u.pm = fm + ((wgid % nig) % WGM); u.pn = (wgid % nig) / WGM; return true;
    }
    __device__ __forceinline__ void a_ready(const Unit&) const {}
    __device__ __forceinline__ void done(const Unit&) const {}
};
__device__ __forceinline__ float dot4(const f32x4 a) { return (a[0] * a[0] + a[1] * a[1]) + (a[2] * a[2] + a[3] * a[3]); }
__device__ __forceinline__ float silu1(float v) { return v * __builtin_amdgcn_rcpf(1.f + __expf(-v)); }
typedef unsigned u32x2 __attribute__((ext_vector_type(2)));
__device__ __forceinline__ u32x2 pk4(const f32x4 v) { u32x2 w; w.x = cvt_pk_bf16(v[0], v[1]); w.y = cvt_pk_bf16(v[2], v[3]); return w; }
struct Epi1 {
    static constexpr bool PERM = true, AFTER_DRAIN = false, MIDK = false;
    bf16_t *KB, *VB, *XBC, *YQ, *Z; float* DT; const float *rope, *qg, *kg, *dt_bias; PG8_LAS unsigned char* stage;
    __device__ __forceinline__ void midk(f32x4 (&)[2][2][4][2], int, int, int) const {}
    __device__ __forceinline__ void operator()(const f32x4 (&acc)[2][2][4][2], const Unit& u, int wr, int wc, int fr_in, int fq_in) const {
        int fr = fr_in, fq = fq_in; asm volatile("" : "+v"(fr), "+v"(fq));
        const int pn = u.pn, pm = u.pm; const bool isctx = pm >= 256; const int rloc = wr * 64 + fr;
        const int bb = isctx ? pm - 256 : pm >> 3, pos0 = isctx ? SEQ : (pm & 7) * 256;
        if (pn == 0 || (pn >= 9 && pn < 13)) {
            const float* g = pn == 0 ? kg : qg;
            const f32x4 g00 = *(const f32x4*)(g + 4 * fq), g01 = *(const f32x4*)(g + 16 + 4 * fq), g10 = *(const f32x4*)(g + 32 + 4 * fq), g11 = *(const f32x4*)(g + 48 + 4 * fq);
            const float osc = pn == 0 ? 1.f : C2;
            bf16_t* dbase; size_t pitch;
            if (pn == 0) { dbase = KB + ((size_t)bb * KVL + pos0) * 256 + wc * 64; pitch = 256; }
            else { dbase = YQ + (size_t)pm * 256 * 2048 + 1024 + ((pn - 9) * 4 + wc) * 64; pitch = 2048; }
            PG8_LAS unsigned char* stg = stage + (wr * 4 + wc) * 2048; const int lane_ = fr + 16 * fq, r8 = lane_ >> 3, c8 = lane_ & 7;
#pragma unroll
            for (int ai = 0; ai < 2; ++ai) {
                const int prow = (pm & 7) * 4 + 2 * ai + wr;
                f32x4 c0 = (f32x4){1.f, 1.f, 1.f, 1.f}, s0 = (f32x4){0.f, 0.f, 0.f, 0.f};
                if (!isctx) { c0 = *(const f32x4*)(rope + prow * 16 + 4 * fq); s0 = *(const f32x4*)(rope + 1024 + prow * 16 + 4 * fq); }
#pragma unroll
                for (int m = 0; m < 4; ++m) {
                    f32x4 a0 = acc[ai][0][m][0], a1 = acc[ai][0][m][1], b0 = acc[ai][1][m][0], b1 = acc[ai][1][m][1];
                    float s = (dot4(a0) + dot4(a1)) + (dot4(b0) + dot4(b1));
                    s += __shfl_xor(s, 16); s += __shfl_xor(s, 32);
                    const float rstd = rsqrtf(s * (1.f / 64.f) + EPS) * osc;
                    a0 = a0 * rstd * g00; a1 = a1 * rstd * g01; b0 = b0 * rstd * g10; b1 = b1 * rstd * g11;
                    f32x4 c1 = (f32x4){1.f, 1.f, 1.f, 1.f}, s1 = (f32x4){0.f, 0.f, 0.f, 0.f};
                    if (!isctx) { const int pcol = 16 * m + fr; c1 = *(const f32x4*)(rope + pcol * 16 + 4 * fq); s1 = *(const f32x4*)(rope + 1024 + pcol * 16 + 4 * fq); }
                    const f32x4 o00 = a0 * c0 - a1 * s0, o01 = a1 * c0 + a0 * s0, o10 = b0 * c1 - b1 * s1, o11 = b1 * c1 + b0 * s1;
                    { PG8_LAS unsigned char* sp = stg + fr * 128 + (fq & 1) * 8; const int k7 = fr & 7, cq = fq >> 1;
                      *(PG8_LAS u32x2*)(sp + (((0 + cq) ^ k7) << 4)) = pk4(o00); *(PG8_LAS u32x2*)(sp + (((2 + cq) ^ k7) << 4)) = pk4(o01); *(PG8_LAS u32x2*)(sp + (((4 + cq) ^ k7) << 4)) = pk4(o10); *(PG8_LAS u32x2*)(sp + (((6 + cq) ^ k7) << 4)) = pk4(o11); }
                    bf16_t* rowp = dbase + (size_t)(wr * 64 + 128 * ai + 16 * m) * pitch + 8 * c8;
#pragma unroll
                    for (int ps = 0; ps < 2; ++ps) { const int r = 8 * ps + r8; const u32x4 w = *(const PG8_LAS u32x4*)(stg + r * 128 + ((c8 ^ (r & 7)) << 4)); *(u32x4*)(rowp + (size_t)r * pitch) = w; }
                    asm volatile("" ::: "memory");
                }
            }
        } else if (pn == 8) {
            if (wc == 0) {
                const f32x4 bA = *(const f32x4*)(dt_bias + 8 * fq), bB = *(const f32x4*)(dt_bias + 8 * fq + 4);
#pragma unroll
                for (int ai = 0; ai < 2; ++ai)
#pragma unroll
                    for (int m = 0; m < 4; ++m) { const size_t row = (size_t)pm * 256 + rloc + 128 * ai + 16 * m;
                        f32x4 v0 = acc[ai][0][m][0] + bA, v1 = acc[ai][0][m][1] + bB;
#pragma unroll
                        for (int e = 0; e < 4; ++e) { v0[e] = v0[e] > 20.f ? v0[e] : log1pf(__expf(v0[e])); v1[e] = v1[e] > 20.f ? v1[e] : log1pf(__expf(v1[e])); }
                        *(f32x4*)(DT + row * 32 + 8 * fq) = v0; *(f32x4*)(DT + row * 32 + 8 * fq + 4) = v1; asm volatile("" ::: "memory"); }
            }
        } else {
            bf16_t* dbase; size_t pitch; bool act = false;
            const int cin = wc * 64;
            if (pn == 1) { dbase = VB + ((size_t)bb * KVL + pos0) * 256 + cin; pitch = 256; }
            else if (pn < 8) { dbase = XBC + (size_t)pm * 256 * CONVC + (pn - 2) * 256 + cin; pitch = CONVC; }
            else if (pn < 17) { dbase = YQ + (size_t)pm * 256 * 2048 + (pn - 13) * 256 + cin; pitch = 2048; act = true; }
            else { dbase = Z + (size_t)pm * 256 * 1024 + (pn - 17) * 256 + cin; pitch = 1024; act = true; }
            PG8_LAS unsigned char* stg = stage + (wr * 4 + wc) * 2048;
            const int lane = fr + 16 * fq, r8 = lane >> 3, c8 = lane & 7;
#pragma unroll
            for (int ai = 0; ai < 2; ++ai)
#pragma unroll
                for (int m = 0; m < 4; ++m) {
#pragma unroll
                    for (int bj = 0; bj < 2; ++bj) { f32x4 v0 = acc[ai][bj][m][0], v1 = acc[ai][bj][m][1];
                        if (act) {
#pragma unroll
                            for (int e = 0; e < 4; ++e) { v0[e] = silu1(v0[e]); v1[e] = silu1(v1[e]); } }
                        u32x4 w; w.x = cvt_pk_bf16(v0[0], v0[1]); w.y = cvt_pk_bf16(v0[2], v0[3]); w.z = cvt_pk_bf16(v1[0], v1[1]); w.w = cvt_pk_bf16(v1[2], v1[3]);
                        *(PG8_LAS u32x4*)(stg + fr * 128 + (((4 * bj + fq) ^ (fr & 7)) << 4)) = w; }
                    bf16_t* rowp = dbase + (size_t)(wr * 64 + 128 * ai + 16 * m) * pitch + 8 * c8;
#pragma unroll
                    for (int ps = 0; ps < 2; ++ps) { const int r = 8 * ps + r8; const u32x4 w = *(const PG8_LAS u32x4*)(stg + r * 128 + ((c8 ^ (r & 7)) << 4)); *(u32x4*)(rowp + (size_t)r * pitch) = w; }
                    asm volatile("" ::: "memory"); }
        }
    }
};
struct EpiNull {
    static constexpr bool PERM = true, AFTER_DRAIN = false, MIDK = false;
    __device__ __forceinline__ void midk(f32x4 (&)[2][2][4][2], int, int, int) const {}
    __device__ __forceinline__ void operator()(const f32x4 (&acc)[2][2][4][2], const Unit&, int, int, int, int) const {
#pragma unroll
        for (int ai = 0; ai < 2; ++ai)
#pragma unroll
            for (int bj = 0; bj < 2; ++bj)
#pragma unroll
                for (int m = 0; m < 4; ++m) { asm volatile("" :: "v"(acc[ai][bj][m][0]), "v"(acc[ai][bj][m][1])); } }
};
struct EpiPlainReal {
    static constexpr bool PERM = true, AFTER_DRAIN = false, MIDK = false;
    bf16_t *KB, *VB, *XBC, *YQ, *Z; float* DT;
    __device__ __forceinline__ void midk(f32x4 (&)[2][2][4][2], int, int, int) const {}
    __device__ __forceinline__ void operator()(const f32x4 (&acc)[2][2][4][2], const Unit& u, int wr, int wc, int fr_in, int fq_in) const {
        int fr = fr_in, fq = fq_in; asm volatile("" : "+v"(fr), "+v"(fq));
        const int pn = u.pn, pm = u.pm; const bool isctx = pm >= 256; const int rloc = wr * 64 + fr;
        const int bb = isctx ? pm - 256 : pm >> 3, pos0 = isctx ? SEQ : (pm & 7) * 256;
        bf16_t* dbase; size_t pitch; const int cin = wc * 32 + 8 * fq;
        if (pn == 0) { dbase = KB + ((size_t)bb * KVL + pos0) * 256 + cin; pitch = 256; }
        else if (pn == 1) { dbase = VB + ((size_t)bb * KVL + pos0) * 256 + cin; pitch = 256; }
        else if (pn < 8) { dbase = XBC + (size_t)pm * 256 * CONVC + (pn - 2) * 256 + cin; pitch = CONVC; }
        else if (pn == 8) { dbase = (bf16_t*)DT + (size_t)pm * 256 * 64 + (cin & 31); pitch = 64; }
        else if (pn < 13) { dbase = YQ + (size_t)pm * 256 * 2048 + 1024 + (pn - 9) * 256 + cin; pitch = 2048; }
        else if (pn < 17) { dbase = YQ + (size_t)pm * 256 * 2048 + (pn - 13) * 256 + cin; pitch = 2048; }
        else { dbase = Z + (size_t)pm * 256 * 1024 + (pn - 17) * 256 + cin; pitch = 1024; }
#pragma unroll
        for (int ai = 0; ai < 2; ++ai)
#pragma unroll
            for (int m = 0; m < 4; ++m) { bf16_t* dst = dbase + (size_t)(rloc + 128 * ai + 16 * m) * pitch;
#pragma unroll
                for (int bj = 0; bj < 2; ++bj) { const f32x4 v0 = acc[ai][bj][m][0], v1 = acc[ai][bj][m][1];
                    u32x4 w; w.x = cvt_pk_bf16(v0[0], v0[1]); w.y = cvt_pk_bf16(v0[2], v0[3]); w.z = cvt_pk_bf16(v1[0], v1[1]); w.w = cvt_pk_bf16(v1[2], v1[3]);
                    *(u32x4*)(dst + (pn == 8 ? 0 : bj * HALF)) = w; } asm volatile("" ::: "memory"); }
    }
};
struct Epi2 {
    static constexpr bool PERM = false, AFTER_DRAIN = false, MIDK = true;
    const float* x; const float* mod; const float* fg; float* out; unsigned long long* xbuf; unsigned* cnt; unsigned* tmo; const PG8_LAS float* rstd_tab; PG8_LAS float* exl;
    __device__ __forceinline__ void midk(f32x4 (&acc)[2][2][4][2], int ui, int wr, int fr) const {
#pragma unroll
        for (int ai = 0; ai < 2; ++ai)
#pragma unroll
            for (int m = 0; m < 4; ++m) { const float r = rstd_tab[ui * 256 + 128 * ai + 64 * wr + 16 * m + fr];
#pragma unroll
                for (int bj = 0; bj < 2; ++bj)
#pragma unroll
                    for (int n = 0; n < 2; ++n) acc[ai][bj][m][n] *= r; }
    }
    __device__ __forceinline__ void operator()(f32x4 (&acc)[2][2][4][2], const Unit& u, int wr, int wc, int fr_in, int fq_in) const {
        int fr = fr_in, fq = fq_in; asm volatile("" : "+v"(fr), "+v"(fq));
        const int lane = mk_lane(); const int tid = (wr * 4 + wc) * 64 + lane;
        const int b = u.pm >> 3, col0 = u.pn * BM + wc * 32 + 4 * fq;
        PG8_LAS float* P = exl; PG8_LAS float* S = exl + 1024;
        { f32x4 gv[2][2];
#pragma unroll
          for (int bj = 0; bj < 2; ++bj)
#pragma unroll
            for (int n = 0; n < 2; ++n) gv[bj][n] = *(const f32x4*)(mod + (size_t)b * 3072 + 2048 + col0 + bj * HALF + n * 16);
#pragma unroll
          for (int ai = 0; ai < 2; ++ai)
#pragma unroll
            for (int m = 0; m < 4; ++m) { const int rt = 128 * ai + 64 * wr + 16 * m + fr; const size_t off = ((size_t)u.pm * BM + rt) * 1024 + col0; float q = 0.f;
#pragma unroll
                for (int bj = 0; bj < 2; ++bj)
#pragma unroll
                    for (int n = 0; n < 2; ++n) { const f32x4 xv = *(const f32x4*)(x + off + bj * HALF + n * 16); const f32x4 o = xv + gv[bj][n] * acc[ai][bj][m][n]; acc[ai][bj][m][n] = o; q += dot4(o); }
                q += __shfl_xor(q, 16); q += __shfl_xor(q, 32);
                if (fq == 0) P[rt * 4 + wc] = q;
                if (m == 3) asm volatile("" ::: "memory"); } }
        asm volatile("s_waitcnt lgkmcnt(0)" ::: "memory"); __builtin_amdgcn_s_barrier(); asm volatile("" ::: "memory");
        if (tid < 256) {
            const f32x4 p = *(const PG8_LAS f32x4*)(P + tid * 4); const float s = (p[0] + p[1]) + (p[2] + p[3]);
            __hip_atomic_store((float*)xbuf + ((size_t)u.pm * BM + tid) * 4 + u.pn, s, __ATOMIC_RELAXED, __HIP_MEMORY_SCOPE_AGENT);
        }
        asm volatile("s_waitcnt vmcnt(0)" ::: "memory");
        if (tid < 256 && lane == 0) __hip_atomic_fetch_add(cnt + 64 * u.pm, 1u, __ATOMIC_RELAXED, __HIP_MEMORY_SCOPE_AGENT);
        if (tid < 64) {
            unsigned sp = 0;
            while ((unsigned)__builtin_amdgcn_readfirstlane(__hip_atomic_load(cnt + 64 * u.pm, __ATOMIC_RELAXED, __HIP_MEMORY_SCOPE_AGENT)) < 16u) {
                __builtin_amdgcn_s_sleep(2); if (++sp > (1u << 22)) { if (lane == 0) __hip_atomic_store(tmo, 1u, __ATOMIC_RELAXED, __HIP_MEMORY_SCOPE_AGENT); break; } }
        }
        asm volatile("s_waitcnt vmcnt(0) lgkmcnt(0)" ::: "memory"); __builtin_amdgcn_s_barrier(); asm volatile("" ::: "memory");
        if (tid < 256) {
            const unsigned long long* sl = xbuf + ((size_t)u.pm * BM + tid) * 2;
            const unsigned long long w0 = __hip_atomic_load(sl, __ATOMIC_RELAXED, __HIP_MEMORY_SCOPE_AGENT), w1 = __hip_atomic_load(sl + 1, __ATOMIC_RELAXED, __HIP_MEMORY_SCOPE_AGENT);
            const float s = (__uint_as_float((unsigned)w0) + __uint_as_float((unsigned)(w0 >> 32))) + (__uint_as_float((unsigned)w1) + __uint_as_float((unsigned)(w1 >> 32)));
            S[tid] = rsqrtf(s * (1.f / 1024.f) + EPS);
        }
        asm volatile("s_waitcnt lgkmcnt(0)" ::: "memory"); __builtin_amdgcn_s_barrier(); asm volatile("" ::: "memory");
        { f32x4 fv[2][2];
#pragma unroll
          for (int bj = 0; bj < 2; ++bj)
#pragma unroll
            for (int n = 0; n < 2; ++n) fv[bj][n] = *(const f32x4*)(fg + col0 + bj * HALF + n * 16);
#pragma unroll
          for (int ai = 0; ai < 2; ++ai)
#pragma unroll
            for (int m = 0; m < 4; ++m) { const int rt = 128 * ai + 64 * wr + 16 * m + fr; const size_t off = ((size_t)u.pm * BM + rt) * 1024 + col0; const float r = S[rt];
#pragma unroll
                for (int bj = 0; bj < 2; ++bj)
#pragma unroll
                    for (int n = 0; n < 2; ++n) *(f32x4*)(out + off + bj * HALF + n * 16) = acc[ai][bj][m][n] * r * fv[bj][n];
                if (m & 1) asm volatile("" ::: "memory"); } }
    }
};
}
#define GAS __attribute__((address_space(1)))
#define LAS __attribute__((address_space(3)))
typedef unsigned v4u __attribute__((ext_vector_type(4)));
typedef GAS unsigned gu32;
typedef GAS unsigned long long gu64;
#define RLX_AGENT __ATOMIC_RELAXED, __HIP_MEMORY_SCOPE_AGENT
#define LDS_WAIT() asm volatile("s_waitcnt lgkmcnt(0)" ::: "memory")
#define VM_WAIT() asm volatile("s_waitcnt vmcnt(0)" ::: "memory")
__device__ __forceinline__ unsigned long long rt() { return __builtin_amdgcn_s_memrealtime(); }
typedef float f32x2_pk __attribute__((ext_vector_type(2))); typedef __bf16 bf16x2_pk __attribute__((ext_vector_type(2)));
__device__ __forceinline__ unsigned pk2(float lo, float hi) { const f32x2_pk v = {lo, hi}; return __builtin_bit_cast(unsigned, __builtin_convertvector(v, bf16x2_pk)); }
#define XB_TMO      128
#define XB_XCNT(j)  (256  + 64 * (j))
#define XB_XSUB(j)  (1280 + 64 * (j))
#define XB_XGEN(j)  (2304 + 64 * (j))
#define XB_TOP      3328
#define XB_TOPGEN   3392
#define XCD_BAR_WORDS 3456
#define XB_SPIN_CAP (1u << 22)

__device__ __forceinline__ unsigned xb_ld(unsigned* p)              { return __hip_atomic_load(p, __ATOMIC_RELAXED, __HIP_MEMORY_SCOPE_AGENT); }
__device__ __forceinline__ unsigned xb_add(unsigned* p, unsigned v) { return __hip_atomic_fetch_add(p, v, __ATOMIC_RELAXED, __HIP_MEMORY_SCOPE_AGENT); }
__device__ __forceinline__ unsigned xb_xcc_id() { return (unsigned)__builtin_amdgcn_s_getreg((3 << 11) | 20) & 0xFu; }
#define XB_SPIN(cond, bar) do { unsigned _sp = 0; while (cond) { __builtin_amdgcn_s_sleep(1); \
    if ((++_sp & 255u) == 0u) { if (xb_ld(&(bar)[XB_TMO])) break; if (_sp > XB_SPIN_CAP) { atomicAdd(&(bar)[XB_TMO], 1u); break; } } } } while (0)

struct XcdBarrier {
    unsigned* bar; unsigned x;
    volatile LAS unsigned* st;
};

__device__ __forceinline__ XcdBarrier xcd_barrier_post(unsigned* bar, volatile LAS unsigned* st, bool leader) {
    XcdBarrier b; b.bar = bar; b.x = xb_xcc_id(); b.st = st;
    if (leader) (void)xb_add(&bar[XB_XCNT(b.x)], 1u);
    return b;
}
__device__ __forceinline__ void xcd_barrier_complete(unsigned* bar, unsigned x, unsigned& nloc, unsigned& nx) {
    const unsigned G = gridDim.x * gridDim.y * gridDim.z;
    unsigned sum, cnt, mine, sp = 0u;
    for (;;) {
        sum = 0u; cnt = 0u; mine = 0u;
#pragma unroll
        for (unsigned j = 0; j < 16; ++j) { const unsigned c = xb_ld(&bar[XB_XCNT(j)]); sum += c; cnt += (c > 0u) ? 1u : 0u; mine = (j == x) ? c : mine; }
        if (sum == G) break;
        __builtin_amdgcn_s_sleep(1);
        if ((++sp & 255u) == 0u) { if (xb_ld(&bar[XB_TMO])) break; if (sp > XB_SPIN_CAP) { atomicAdd(&bar[XB_TMO], 1u); break; } }
    }
    nloc = mine > 0u ? mine : 1u; nx = cnt > 0u ? cnt : 1u;
}

__device__ __forceinline__ void xcd_barrier(const XcdBarrier& b, bool leader) {
    asm volatile("s_waitcnt vmcnt(0)" ::: "memory");
    __syncthreads();
    if (leader) {
        unsigned* bar = b.bar;
        __builtin_amdgcn_s_waitcnt(0);
        unsigned nloc = b.st[0], nx = b.st[1];
        if (nloc == 0u) { xcd_barrier_complete(bar, b.x, nloc, nx); b.st[0] = nloc; b.st[1] = nx; }
        const unsigned old = xb_add(&bar[XB_XSUB(b.x)], 1u);
        const unsigned gen = old / nloc;
        if (old + 1u == (gen + 1u) * nloc) {
            __builtin_amdgcn_fence(__ATOMIC_RELEASE, "agent");
            asm volatile("s_waitcnt vmcnt(0)" ::: "memory");
            const unsigned og = xb_add(&bar[XB_TOP], 1u);
            const unsigned tg = og / nx;
            if (og + 1u == (tg + 1u) * nx) xb_add(&bar[XB_TOPGEN], 1u);
            else XB_SPIN(xb_ld(&bar[XB_TOPGEN]) == tg, bar);
            __builtin_amdgcn_fence(__ATOMIC_ACQUIRE, "agent");
            xb_add(&bar[XB_XGEN(b.x)], 1u);
            asm volatile("s_waitcnt vmcnt(0)" ::: "memory");
        } else {
            XB_SPIN(xb_ld(&bar[XB_XGEN(b.x)]) == gen, bar);
            __builtin_amdgcn_fence(__ATOMIC_ACQUIRE, "agent");
            asm volatile("s_waitcnt vmcnt(0)" ::: "memory");
        }
    }
    __syncthreads();
}

typedef float f32x4 __attribute__((ext_vector_type(4)));
constexpr int NWAVES = 8;
__device__ __forceinline__ float wave_sum(float v) {
#pragma unroll
    for (int o = 1; o < 64; o <<= 1) v += __shfl_xor(v, o);
    return v;
}
__device__ __forceinline__ float dot4g(const f32x4 a) { return (a[0] * a[0] + a[1] * a[1]) + (a[2] * a[2] + a[3] * a[3]); }
__device__ __forceinline__ void p0_bt1_item(const float* W, bf16* WT, LAS float* scr, int item, int lane) {
    const int kb = item / 168, vb = item % 168, k0 = 64 * kb, v0 = 32 * vb;
    const int a = vcol_actual(v0 + (lane & 31));
#pragma unroll 8
    for (int i = 0; i < 32; ++i) { const int kk = 2 * i + (lane >> 5); scr[kk * 33 + (lane & 31)] = a >= 0 ? W[(size_t)(k0 + kk) * PROJ + a] : 0.f; }
    LDS_WAIT(); asm volatile("" ::: "memory");
    const int c = lane & 7;
#pragma unroll
    for (int j = 0; j < 4; ++j) { const int n = (lane >> 3) + 8 * j; const LAS float* s = scr + (8 * c) * 33 + n;
        v4u o; o.x = pk2(s[0 * 33], s[1 * 33]); o.y = pk2(s[2 * 33], s[3 * 33]); o.z = pk2(s[4 * 33], s[5 * 33]); o.w = pk2(s[6 * 33], s[7 * 33]);
        *(GAS v4u*)(WT + (size_t)(v0 + n) * 1024 + k0 + 8 * c) = o; }
    LDS_WAIT(); asm volatile("" ::: "memory");
}
__device__ __forceinline__ void p0_bt2_item(const float* W, const float* sg, bf16* WT, LAS float* scr, int item, int lane) {
    const int kb = item >> 5, nb = item & 31, kk0 = 64 * kb, n0 = 32 * nb;
#pragma unroll 8
    for (int i = 0; i < 32; ++i) { const int kk = 2 * i + (lane >> 5), kq = kk0 + kk; const int ks = kq < 1024 ? 1024 + kq : kq - 1024;
        float v = W[(size_t)ks * 1024 + n0 + (lane & 31)]; if (kq < 1024) v *= sg[kq]; scr[kk * 33 + (lane & 31)] = v; }
    LDS_WAIT(); asm volatile("" ::: "memory");
    const int c = lane & 7;
#pragma unroll
    for (int j = 0; j < 4; ++j) { const int n = (lane >> 3) + 8 * j; const LAS float* s = scr + (8 * c) * 33 + n;
        v4u o; o.x = pk2(s[0 * 33], s[1 * 33]); o.y = pk2(s[2 * 33], s[3 * 33]); o.z = pk2(s[4 * 33], s[5 * 33]); o.w = pk2(s[6 * 33], s[7 * 33]);
        *(GAS v4u*)(WT + (size_t)(n0 + n) * 2048 + kk0 + 8 * c) = o; }
    LDS_WAIT(); asm volatile("" ::: "memory");
}
__device__ __forceinline__ void p0_mod_block(const float* c, const float* c_ctx, const float* ada_w, const float* ada_b, float* mod, LAS float* ldsf, int cb, int tid, int lane, int wave) {
    LAS float* sil = ldsf; LAS float* red = ldsf + 33 * 256;
    float acc[33];
#pragma unroll
    for (int b = 0; b < 33; ++b) acc[b] = 0.f;
    for (int q = 0; q < 4; ++q) {
        __syncthreads();
        for (int e = tid; e < 33 * 256; e += NWAVES * 64) { const int b = e >> 8, k = e & 255; const float v = b < 32 ? c[b * 1024 + q * 256 + k] : c_ctx[q * 256 + k]; sil[e] = siluf(v); }
        __syncthreads();
#pragma unroll 2
        for (int k4 = 0; k4 < 8; ++k4) { const int kl = wave * 32 + 4 * k4; const float* wp = ada_w + (size_t)(q * 256 + kl) * 3072 + cb * 64 + lane;
            const float w0 = wp[0], w1 = wp[3072], w2 = wp[2 * 3072], w3 = wp[3 * 3072];
#pragma unroll
            for (int b = 0; b < 33; ++b) { const f32x4 sv = *(const LAS f32x4*)(sil + b * 256 + kl); acc[b] += (sv[0] * w0 + sv[1] * w1) + (sv[2] * w2 + sv[3] * w3); } }
    }
#pragma unroll
    for (int b = 0; b < 33; ++b) red[(wave * 33 + b) * 64 + lane] = acc[b];
    __syncthreads();
    for (int e = tid; e < 33 * 64; e += NWAVES * 64) { const int b = e >> 6, col = e & 63; float s = 0.f;
#pragma unroll
        for (int w = 0; w < 8; ++w) s += red[(w * 33 + b) * 64 + col];
        mod[b * 3072 + cb * 64 + col] = s + ada_b[cb * 64 + col]; }
    __syncthreads();
}
__device__ __forceinline__ const float* p1_src(const float* x, const float* ctx, int m) { return m < ML ? x + (size_t)m * DM : ctx + (size_t)(m - ML) * DM; }
__device__ __forceinline__ void p1_load4(f32x4 (&v)[4][4], const float* x, const float* ctx, int m0, int lane) {
#pragma unroll
    for (int r = 0; r < 4; ++r) { const GAS f32x4* xr = (const GAS f32x4*)p1_src(x, ctx, m0 + r) + 2 * lane;
#pragma unroll
        for (int j = 0; j < 2; ++j) { v[r][2 * j] = xr[128 * j]; v[r][2 * j + 1] = xr[128 * j + 1]; } }
}
__device__ __forceinline__ void p1_proc4(const f32x4 (&v)[4][4], const float* mod, const float* ng, bf16* H, int m0, int lane) {
#pragma unroll
    for (int r = 0; r < 4; ++r) { const int m = m0 + r; const float* md = mod + (size_t)(m < ML ? m / SEQ : 32) * 3072;
        float s = 0.f;
#pragma unroll
        for (int j = 0; j < 4; ++j) s += dot4g(v[r][j]);
        const float rstd = rsqrtf(wave_sum(s) * (1.f / DM) + EPS);
        GAS v4u* o16 = (GAS v4u*)(H + (size_t)m * DM) + lane;
#pragma unroll
        for (int j = 0; j < 2; ++j) { const int k = 8 * lane + 512 * j; f32x4 h[2];
#pragma unroll
            for (int q = 0; q < 2; ++q) { const f32x4 g = *(const f32x4*)(ng + k + 4 * q), sc = *(const f32x4*)(md + 1024 + k + 4 * q), sh = *(const f32x4*)(md + k + 4 * q);
                h[q] = v[r][2 * j + q] * rstd * g * (sc + 1.f) + sh; }
            v4u o; o.x = pk2(h[0][0], h[0][1]); o.y = pk2(h[0][2], h[0][3]); o.z = pk2(h[1][0], h[1][1]); o.w = pk2(h[1][2], h[1][3]);
            o16[64 * j] = o; }
    }
}
__device__ __forceinline__ void conv_phase(const bf16* XBC, const float* cw, const float* cb, bf16* XC, int bx, int G, int tid) {
    if (tid < 384) {
        const int cg = tid % 192, sub = tid / 192;
        f32x4 w[5][2], bias[2];
#pragma unroll
        for (int j = 0; j < 5; ++j) { w[j][0] = *(const f32x4*)(cw + j * CONVC + cg * 8); w[j][1] = *(const f32x4*)(cw + j * CONVC + cg * 8 + 4); }
        bias[0] = *(const f32x4*)(cb + cg * 8); bias[1] = *(const f32x4*)(cb + cg * 8 + 4);
        for (int seg = bx; seg < MT / 32; seg += G) {
            const int row0 = seg * 32 + sub * 16; int t0, len;
            if (row0 < ML) { t0 = row0 % SEQ; len = SEQ; } else { t0 = (row0 - ML) % CTXL; len = CTXL; }
            const bf16* src = XBC + (size_t)row0 * CONVC + cg * 8; bf16* dst = XC + (size_t)row0 * CONVC + cg * 8;
            f32x4 r[5][2];
#pragma unroll
            for (int j = 0; j < 5; ++j) { const int tt = t0 + j - 2; v4u u = (v4u){0u, 0u, 0u, 0u};
                if (tt >= 0 && tt < len) u = *(const v4u*)(src + (ptrdiff_t)(j - 2) * CONVC);
                r[j][0] = (f32x4){__uint_as_float(u.x << 16), __uint_as_float(u.x & 0xffff0000u), __uint_as_float(u.y << 16), __uint_as_float(u.y & 0xffff0000u)};
                r[j][1] = (f32x4){__uint_as_float(u.z << 16), __uint_as_float(u.z & 0xffff0000u), __uint_as_float(u.w << 16), __uint_as_float(u.w & 0xffff0000u)}; }
#pragma unroll
            for (int i = 0; i < 16; ++i) {
                f32x4 a0 = bias[0], a1 = bias[1];
#pragma unroll
                for (int j = 0; j < 5; ++j) { a0 += w[j][0] * r[j][0]; a1 += w[j][1] * r[j][1]; }
#pragma unroll
                for (int e = 0; e < 4; ++e) { a0[e] = siluf(a0[e]); a1[e] = siluf(a1[e]); }
                v4u o; o.x = pk2(a0[0], a0[1]); o.y = pk2(a0[2], a0[3]); o.z = pk2(a1[0], a1[1]); o.w = pk2(a1[2], a1[3]);
                *(v4u*)(dst + (size_t)i * CONVC) = o;
#pragma unroll
                for (int j = 0; j < 4; ++j) { r[j][0] = r[j + 1][0]; r[j][1] = r[j + 1][1]; }
                const int tt = t0 + i + 3; v4u u = (v4u){0u, 0u, 0u, 0u};
                if (i < 15 && tt < len) u = *(const v4u*)(src + (size_t)(i + 3) * CONVC);
                r[4][0] = (f32x4){__uint_as_float(u.x << 16), __uint_as_float(u.x & 0xffff0000u), __uint_as_float(u.y << 16), __uint_as_float(u.y & 0xffff0000u)};
                r[4][1] = (f32x4){__uint_as_float(u.z << 16), __uint_as_float(u.z & 0xffff0000u), __uint_as_float(u.w << 16), __uint_as_float(u.w & 0xffff0000u)};
            }
        }
    }
}
__device__ __forceinline__ void ssd_item_naive(int b, int h, const bf16* XC, const float* DT, const bf16* Z, const float* a_log, const float* d_skip, bf16* YQ, float* SSQ, LAS float* ysq, int tid) {
    const int p = tid >> 3, nc = tid & 7, g = h >> 3;
    for (int dd = 0; dd < 2; ++dd) { const int d = 1 - dd;
        const float a_neg = -expf(a_log[d * 16 + h]);
        float S[16];
#pragma unroll
        for (int j = 0; j < 16; ++j) S[j] = 0.f;
        for (int seq = 0; seq < 2; ++seq) { const int len = seq == 0 ? CTXL : SEQ; const size_t rbase = seq == 0 ? (size_t)ML + (size_t)b * CTXL : (size_t)b * SEQ;
            for (int st = 0; st < len; ++st) { const int t = d ? len - 1 - st : st; const size_t row = rbase + t;
                const float dt = DT[row * 32 + d * 16 + h]; const float dec = expf(dt * a_neg);
                const float xs = bf2f(XC[row * CONVC + h * 64 + p]); const float X = xs * dt;
                const v4u b0 = *(const v4u*)(XC + row * CONVC + 1024 + g * 128 + nc * 16), b1 = *(const v4u*)(XC + row * CONVC + 1024 + g * 128 + nc * 16 + 8);
                const v4u c0 = *(const v4u*)(XC + row * CONVC + 1280 + g * 128 + nc * 16), c1 = *(const v4u*)(XC + row * CONVC + 1280 + g * 128 + nc * 16 + 8);
                const unsigned bw[8] = {b0.x, b0.y, b0.z, b0.w, b1.x, b1.y, b1.z, b1.w}, cw8[8] = {c0.x, c0.y, c0.z, c0.w, c1.x, c1.y, c1.z, c1.w};
                float y = 0.f;
#pragma unroll
                for (int j = 0; j < 8; ++j) { S[2 * j] = S[2 * j] * dec + X * __uint_as_float(bw[j] << 16); y += __uint_as_float(cw8[j] << 16) * S[2 * j];
                    S[2 * j + 1] = S[2 * j + 1] * dec + X * __uint_as_float(bw[j] & 0xffff0000u); y += __uint_as_float(cw8[j] & 0xffff0000u) * S[2 * j + 1]; }
                y += __shfl_xor(y, 1); y += __shfl_xor(y, 2); y += __shfl_xor(y, 4);
                if (seq == 1) {
                    bf16* yp = YQ + row * 2048 + h * 64 + p;
                    if (d == 1) { if (nc == 0) *yp = (bf16)f2bf(y); }
                    else {
                        if (nc == 0) { const float yt = y + bf2f(*yp) + d_skip[h] * xs; const float yg = yt * bf2f(Z[row * 1024 + h * 64 + p]); *yp = (bf16)f2bf(yg); ysq[p] = yg * yg; }
                        __syncthreads();
                        if (tid < 64) { float q = ysq[tid]; q = wave_sum(q); if (tid == 0) SSQ[row * 16 + h] = q; }
                        __syncthreads();
                    }
                }
            }
        }
        VM_WAIT(); __syncthreads();
    }
}

namespace attn_body {
using bf16=__hip_bfloat16;
using bf16x8=__attribute__((ext_vector_type(8)))short;
using s16x4=__attribute__((ext_vector_type(4)))short;
using f32x16=__attribute__((ext_vector_type(16)))float;
using u32x4=__attribute__((ext_vector_type(4)))unsigned;
constexpr int D=64,QP=2048,KP=256;
constexpr int NW=8,QBLK=32,QB=QBLK*NW,KVBLK=64,NQB=SEQ/QB;
constexpr int ATTN_UNIT_ROWS=QB;
__device__ __forceinline__ int crow(int r,int hi){return (r&3)+8*(r>>2)+4*hi;}
#define SBAR() __builtin_amdgcn_sched_barrier(0)
__device__ __forceinline__ void cmask(f32x16&p0,f32x16&p1,int jb,int qrel,int hi){
  const float NEG=-INFINITY; int kb=64*jb+4*hi;
  #pragma unroll
  for(int r=0;r<16;++r){int kv=kb+(r&3)+8*(r>>2); if(kv>qrel)p0[r]=NEG; if(kv+32>qrel)p1[r]=NEG;}
}

constexpr int NSLOT=3, SLOTB=8192;
constexpr int LDS_K=0, LDS_V=NSLOT*SLOTB, LDS_WS=2*NSLOT*SLOTB, LDS_OST=LDS_WS+NW*64*4, LDS_BYTES=LDS_OST+NW*8192;
constexpr float C2=0.125f*1.4426950408889634f;
__device__ __forceinline__ void glds16(const void*gsrc,unsigned lds_dst){unsigned keep;
  asm volatile("s_mov_b32 %0, m0\n\ts_mov_b32 m0, %2\n\ts_nop 0\n\tglobal_load_lds_dwordx4 %1, off\n\ts_mov_b32 m0, %0":"=&s"(keep):"v"(gsrc),"s"(lds_dst):"memory");}
__device__ __forceinline__ float max3f(float a,float b,float c){float r;asm("v_max3_f32 %0, %1, %2, %3":"=v"(r):"v"(a),"v"(b),"v"(c));return r;}
__device__ __forceinline__ float max2f(float a,float b){float r;asm("v_max_f32_e32 %0, %1, %2":"=v"(r):"v"(a),"v"(b));return r;}
__device__ __forceinline__ float fadd_s(float a,float b){float r;asm("v_add_f32_e32 %0, %1, %2":"=v"(r):"v"(a),"v"(b));return r;}
__device__ __forceinline__ float fsub_s(float a,float b){float r;asm("v_sub_f32_e32 %0, %1, %2":"=v"(r):"v"(a),"v"(b));return r;}
typedef float f32x2_t __attribute__((ext_vector_type(2))); typedef float f32x4_t __attribute__((ext_vector_type(4))); typedef __bf16 bf16x2_t __attribute__((ext_vector_type(2)));
__device__ __forceinline__ unsigned cvtpk_s(float lo,float hi){f32x2_t v={lo,hi};bf16x2_t b=__builtin_convertvector(v,bf16x2_t);return __builtin_bit_cast(unsigned,b);}
#define WAIT_BAR(N) asm volatile("s_waitcnt vmcnt(" #N ") lgkmcnt(0)\n\ts_barrier":::"memory")

__device__ __forceinline__ void qkt(f32x16&p0,f32x16&p1,const char*Kslot,const bf16x8*qr,const f32x16&negm,int r32,int hi){
  const char*kb=Kslot+hi*1024+r32*16;
  #pragma unroll
  for(int d0=0;d0<4;++d0){
    const bf16x8 b0=*reinterpret_cast<const bf16x8*>(kb+d0*2048);
    const bf16x8 b1=*reinterpret_cast<const bf16x8*>(kb+d0*2048+512);
    if(d0==0){p0=__builtin_amdgcn_mfma_f32_32x32x16_bf16(b0,qr[0],negm,0,0,0);p1=__builtin_amdgcn_mfma_f32_32x32x16_bf16(b1,qr[0],negm,0,0,0);}
    else{p0=__builtin_amdgcn_mfma_f32_32x32x16_bf16(b0,qr[d0],p0,0,0,0);p1=__builtin_amdgcn_mfma_f32_32x32x16_bf16(b1,qr[d0],p1,0,0,0);}}
}
typedef __attribute__((address_space(3))) const char* lds_cptr;
typedef short v4i16_t __attribute__((ext_vector_type(4)));
__device__ __forceinline__ void kload8(bf16x8*kf,lds_cptr kp){
  kf[0]=*(const __attribute__((address_space(3))) bf16x8*)(kp);      kf[1]=*(const __attribute__((address_space(3))) bf16x8*)(kp+512);
  kf[2]=*(const __attribute__((address_space(3))) bf16x8*)(kp+2048); kf[3]=*(const __attribute__((address_space(3))) bf16x8*)(kp+2560);
  kf[4]=*(const __attribute__((address_space(3))) bf16x8*)(kp+4096); kf[5]=*(const __attribute__((address_space(3))) bf16x8*)(kp+4608);
  kf[6]=*(const __attribute__((address_space(3))) bf16x8*)(kp+6144); kf[7]=*(const __attribute__((address_space(3))) bf16x8*)(kp+6656);
}
__device__ __forceinline__ void kload2(bf16x8*kf,lds_cptr kp,int j){ kf[2*j]=*(const __attribute__((address_space(3))) bf16x8*)(kp+j*2048); kf[2*j+1]=*(const __attribute__((address_space(3))) bf16x8*)(kp+j*2048+512); }
__device__ __forceinline__ s16x4 vtr(lds_cptr p){ return __builtin_bit_cast(s16x4,__builtin_amdgcn_ds_read_tr16_b64_v4i16((__attribute__((address_space(3))) v4i16_t*)p)); }
__device__ __forceinline__ float rowmax(const f32x16&p0,const f32x16&p1){
  float a=max3f(p0[0],p0[1],p1[0]),b=max3f(p0[2],p0[3],p1[1]);a=max3f(a,p1[2],p1[3]);
  #pragma unroll
  for(int r=4;r<16;r+=4){a=max3f(a,p0[r],p0[r+1]);b=max3f(b,p0[r+2],p0[r+3]);a=max3f(a,p1[r],p1[r+1]);b=max3f(b,p1[r+2],p1[r+3]);}
  const float m=max2f(a,b);
  auto rr=__builtin_amdgcn_permlane32_swap(__float_as_uint(m),__float_as_uint(m),false,false);
  return max2f(__uint_as_float(rr[0]),__uint_as_float(rr[1]));
}
__device__ __forceinline__ void pv(f32x16*o,int vb,bf16x8 pa0,bf16x8 pa1,bf16x8 pa2,bf16x8 pa3){
  #pragma unroll
  for(int d0=0;d0<2;++d0){s16x4 lo[4],hi[4];
    #pragma unroll
    for(int ks=0;ks<4;++ks){
      asm volatile("ds_read_b64_tr_b16 %0,%1 offset:%c2":"=&v"(lo[ks]):"v"(vb),"i"(d0*4096+ks*1024):"memory");
      asm volatile("ds_read_b64_tr_b16 %0,%1 offset:%c2":"=&v"(hi[ks]):"v"(vb),"i"(d0*4096+ks*1024+512):"memory");}
    asm volatile("s_waitcnt lgkmcnt(0)":::"memory");SBAR();
    #define PK(k) (bf16x8){lo[k][0],lo[k][1],lo[k][2],lo[k][3],hi[k][0],hi[k][1],hi[k][2],hi[k][3]}
    o[d0]=__builtin_amdgcn_mfma_f32_32x32x16_bf16(pa0,PK(0),o[d0],0,0,0);
    o[d0]=__builtin_amdgcn_mfma_f32_32x32x16_bf16(pa1,PK(1),o[d0],0,0,0);
    o[d0]=__builtin_amdgcn_mfma_f32_32x32x16_bf16(pa2,PK(2),o[d0],0,0,0);
    o[d0]=__builtin_amdgcn_mfma_f32_32x32x16_bf16(pa3,PK(3),o[d0],0,0,0);
    #undef PK
  }
}

#ifndef ATTN_STORE16
#define ATTN_STORE16(p,v) (*(u32x4*)(p)=(v))
#endif
template<int THRL> __device__ __forceinline__ void attn_unit(int b,int h,int qb,bf16*YQb,const bf16*__restrict__ K,const bf16*__restrict__ V,char*shm,int wid_in,float sbound,bf16x8 (&qr)[4],bool first,bool hasNext,int nb,int nh,int nqb,bf16*dummyO=nullptr){
  const int wid=wid_in; int lane=mk_lane(); asm volatile("":"+v"(lane)); const int tid=wid*64+lane,r32=lane&31,hi=lane>>5; (void)tid;
  const long rowbase=(long)b*SEQ; const int q0=qb*QB;
  const bf16*Qw=YQb+(rowbase+q0+wid*QBLK)*QP+1024+h*D;
  const bf16*Kh=K+(long)b*KVL*KP+(h>>2)*D,*Vh=V+(long)b*KVL*KP+(h>>2)*D;
  const unsigned lds0=(unsigned)(uintptr_t)shm;
  float*wsf=(float*)(shm+LDS_WS)+wid*64;
  const bf16*ksrc=Kh+(long)lane*KP+wid*8;
  const bf16*vsrc=Vh+(long)(16*(wid&3)+(lane>>2))*KP+(wid>>2)*32+(lane&3)*8;
  const unsigned kdst=lds0+LDS_K+wid*1024, vdst=lds0+LDS_V+wid*1024;
  #define DMA_K(t,slot) glds16(ksrc+(long)(t)*KVBLK*KP,(unsigned)__builtin_amdgcn_readfirstlane(kdst+(slot)))
  #define DMA_V(t,slot) glds16(vsrc+(long)(t)*KVBLK*KP,(unsigned)__builtin_amdgcn_readfirstlane(vdst+(slot)))
  const int vb0=(int)(lds0+LDS_V)+((lane>>4)&1)*32+(lane&3)*8+(4*hi+((lane&15)>>2))*64;
  const char*Kbase=shm+LDS_K; bf16x8 kf[8];
  const lds_cptr shm3=(lds_cptr)shm; const lds_cptr kp0=shm3+LDS_K+hi*1024+r32*16; const lds_cptr vp0=shm3+LDS_V+((lane>>4)&1)*32+(lane&3)*8+(4*hi+((lane&15)>>2))*64;
  constexpr int NT=KVL/KVBLK;
  if(first){ DMA_K(0,0);DMA_V(0,0);DMA_K(1,SLOTB);
    #pragma unroll
    for(int d0=0;d0<4;++d0)qr[d0]=*reinterpret_cast<const bf16x8*>(&Qw[(long)r32*QP+d0*16+hi*8]); }
  float l_reg=0.f;f32x16 o[2];o[0]=f32x16{};o[1]=f32x16{};f32x16 negm;
  #pragma unroll
  for(int r=0;r<16;++r)negm[r]=-sbound;
  asm volatile("":"+v"(negm));
  #define CMASK(P0,P1,t) do{}while(0)
  #define START(P0,P1) do{ _Pragma("unroll") for(int r=0;r<16;++r)P0[r]=__builtin_amdgcn_exp2f(P0[r]); }while(0)
  #define RESC() do{}while(0)
  f32x16 pA0,pA1,pB0,pB1;
  int sl_prev=0,sl_cur=0,sl_next=SLOTB;
  #define ROT() do{sl_prev=sl_cur;sl_cur=sl_next;sl_next=(sl_next==(NSLOT-1)*SLOTB)?0:sl_next+SLOTB;}while(0)
  if(first){ DMA_K(2,2*SLOTB);
    WAIT_BAR(3); }
  else { WAIT_BAR(0); }
  qkt(pA0,pA1,Kbase,qr,negm,r32,hi);asm volatile("s_nop 15\n\ts_nop 7":"+v"(pA0),"+v"(pA1));CMASK(pA0,pA1,0);
  START(pA0,pA1);
  _Pragma("unroll") for(int r=0;r<16;++r)pA1[r]=__builtin_amdgcn_exp2f(pA1[r]);
  WAIT_BAR(0);
  DMA_K(3,0);DMA_V(1,SLOTB);
  ROT();
  kload8(kf,kp0+sl_cur);
  WAIT_BAR(2);
  s16x4 vlo[8],vhi[8]; u32x4 pw0,pw1,pw2,pw3;
  #define PKW(P,B) cvtpk_s(P[B],P[B+1])
  #define PAF(k) __builtin_bit_cast(bf16x8,pw##k)
  #define VFR(i) (bf16x8){vlo[i][0],vlo[i][1],vlo[i][2],vlo[i][3],vhi[i][0],vhi[i][1],vhi[i][2],vhi[i][3]}
  #define PIN(x) asm volatile("":"+v"(x))
  #define MX3(a,b,c) __builtin_fmaxf(__builtin_fmaxf((a),(b)),(c))
  #define GAPA(MF,A0,A1,A2,A3,W0,W1,PW) do{ MF; sacc+=A0; sacc+=A1; sacc+=A2; sacc+=A3; PIN(sacc); W0; W1; PIN(PW); SBAR(); }while(0)
  #define EX(v) __builtin_amdgcn_exp2f(v)
  #define GAPB(MF,X,B) do{ MF; X[B]=EX(X[B]); X[B+1]=EX(X[B+1]); X[B+2]=EX(X[B+2]); X[B+3]=EX(X[B+3]); PIN(X); SBAR(); }while(0)
  #define VRD(i) do{ vlo[i]=vtr(vp_+(((i)>>2)*4096+((i)&3)*1024)); vhi[i]=vtr(vp_+(((i)>>2)*4096+((i)&3)*1024+512)); }while(0)
  #define KRD(G,j) do{ if(G){ kload2(kf,kp0+sl_next,j); SBAR(); } }while(0)
  #define STEP(C0,C1,P0,P1,t,GK,GV,GL) do{ SBAR(); \
    const lds_cptr vp_=vp0+sl_prev; \
    VRD(0); SBAR(); float sacc=(P0[0]+P0[1]); \
    GAPA(C0=__builtin_amdgcn_mfma_f32_32x32x16_bf16(kf[0],qr[0],negm,0,0,0), P0[2],P0[3],P0[4],P0[5],     pw0[0]=PKW(P0,0), pw0[1]=PKW(P0,2), pw0); \
    VRD(4); SBAR(); GAPA(C1=__builtin_amdgcn_mfma_f32_32x32x16_bf16(kf[1],qr[0],negm,0,0,0), P0[6],P0[7],P0[8],P0[9],     pw0[2]=PKW(P0,4), pw0[3]=PKW(P0,6), pw0); \
    VRD(1); SBAR(); GAPA(C0=__builtin_amdgcn_mfma_f32_32x32x16_bf16(kf[2],qr[1],C0,0,0,0),   P0[10],P0[11],P0[12],P0[13], pw1[0]=PKW(P0,8), pw1[1]=PKW(P0,10), pw1); \
    VRD(5); SBAR(); GAPA(C1=__builtin_amdgcn_mfma_f32_32x32x16_bf16(kf[3],qr[1],C1,0,0,0),   P0[14],P0[15],P1[0],P1[1],   pw1[2]=PKW(P0,12),pw1[3]=PKW(P0,14), pw1); \
    VRD(2); SBAR(); GAPA(C0=__builtin_amdgcn_mfma_f32_32x32x16_bf16(kf[4],qr[2],C0,0,0,0),   P1[2],P1[3],P1[4],P1[5],     pw2[0]=PKW(P1,0), pw2[1]=PKW(P1,2), pw2); \
    VRD(6); SBAR(); GAPA(C1=__builtin_amdgcn_mfma_f32_32x32x16_bf16(kf[5],qr[2],C1,0,0,0),   P1[6],P1[7],P1[8],P1[9],     pw2[2]=PKW(P1,4), pw2[3]=PKW(P1,6), pw2); \
    VRD(3); SBAR(); GAPA(C0=__builtin_amdgcn_mfma_f32_32x32x16_bf16(kf[6],qr[3],C0,0,0,0),   P1[10],P1[11],P1[12],P1[13], pw3[0]=PKW(P1,8), pw3[1]=PKW(P1,10), pw3); \
    VRD(7); SBAR(); GAPA(C1=__builtin_amdgcn_mfma_f32_32x32x16_bf16(kf[7],qr[3],C1,0,0,0),   P1[14],P1[15],0.f,0.f,       pw3[2]=PKW(P1,12),pw3[3]=PKW(P1,14), pw3); \
    l_reg+=sacc; \
    if(GK){DMA_K((t)+3,sl_cur);} if(GV){DMA_V((t)+1,sl_next);} \
    CMASK(C0,C1,t); \
    SBAR(); \
    GAPB(o[0]=__builtin_amdgcn_mfma_f32_32x32x16_bf16(PAF(0),VFR(0),o[0],0,0,0), C0,0); \
    GAPB(o[1]=__builtin_amdgcn_mfma_f32_32x32x16_bf16(PAF(0),VFR(4),o[1],0,0,0), C0,4); \
    KRD(GL,0); GAPB(o[0]=__builtin_amdgcn_mfma_f32_32x32x16_bf16(PAF(1),VFR(1),o[0],0,0,0), C0,8); \
    KRD(GL,1); GAPB(o[1]=__builtin_amdgcn_mfma_f32_32x32x16_bf16(PAF(1),VFR(5),o[1],0,0,0), C0,12); \
    KRD(GL,2); GAPB(o[0]=__builtin_amdgcn_mfma_f32_32x32x16_bf16(PAF(2),VFR(2),o[0],0,0,0), C1,0); \
    KRD(GL,3); GAPB(o[1]=__builtin_amdgcn_mfma_f32_32x32x16_bf16(PAF(2),VFR(6),o[1],0,0,0), C1,4); \
    GAPB(o[0]=__builtin_amdgcn_mfma_f32_32x32x16_bf16(PAF(3),VFR(3),o[0],0,0,0), C1,8); \
    GAPB(o[1]=__builtin_amdgcn_mfma_f32_32x32x16_bf16(PAF(3),VFR(7),o[1],0,0,0), C1,12); \
    }while(0)
  int t=1;
  #undef CMASK
  #define CMASK(P0,P1,t) do{}while(0)
  for(;t+5<NT;t+=2){
    STEP(pB0,pB1,pA0,pA1,t,true,true,true);     WAIT_BAR(2); RESC(); ROT();
    STEP(pA0,pA1,pB0,pB1,t+1,true,true,true);   WAIT_BAR(2); RESC(); ROT();
  }
  #undef CMASK
  #define CMASK(P0,P1,t) do{}while(0)
  #define ENDW(tt) do{ if((tt)+3<NT){WAIT_BAR(2);} else if((tt)+2<NT){WAIT_BAR(1);} else {WAIT_BAR(0);} }while(0)
  for(;t+1<NT;t+=2){
    STEP(pB0,pB1,pA0,pA1,t,(t+3<NT),(t+1<NT),(t+1<NT));       ENDW(t);   RESC(); ROT();
    STEP(pA0,pA1,pB0,pB1,t+1,(t+4<NT),(t+2<NT),(t+2<NT));     ENDW(t+1); RESC(); ROT();
  }
  const bf16*nQw=YQb+((long)nb*SEQ+nqb*QB+wid*QBLK)*QP+1024+nh*D;
  if(hasNext){ const bf16*nK=K+(long)nb*KVL*KP+(nh>>2)*D+(long)lane*KP+wid*8; const bf16*nV=V+(long)nb*KVL*KP+(nh>>2)*D+(long)(16*(wid&3)+(lane>>2))*KP+(wid>>2)*32+(lane&3)*8;
    glds16(nK,(unsigned)__builtin_amdgcn_readfirstlane(kdst)); glds16(nV,(unsigned)__builtin_amdgcn_readfirstlane(vdst)); glds16(nK+(long)KVBLK*KP,(unsigned)__builtin_amdgcn_readfirstlane(kdst+SLOTB)); glds16(nK+(long)2*KVBLK*KP,(unsigned)__builtin_amdgcn_readfirstlane(kdst+2*SLOTB)); }
  STEP(pB0,pB1,pA0,pA1,NT-1,false,false,false); RESC();
  { float sacc=pB0[0]+pB0[1]; _Pragma("unroll") for(int r=2;r<16;++r)sacc+=pB0[r]; _Pragma("unroll") for(int r=0;r<16;++r)sacc+=pB1[r]; l_reg+=sacc;
    pw0=(u32x4){PKW(pB0,0),PKW(pB0,2),PKW(pB0,4),PKW(pB0,6)};pw1=(u32x4){PKW(pB0,8),PKW(pB0,10),PKW(pB0,12),PKW(pB0,14)};pw2=(u32x4){PKW(pB1,0),PKW(pB1,2),PKW(pB1,4),PKW(pB1,6)};pw3=(u32x4){PKW(pB1,8),PKW(pB1,10),PKW(pB1,12),PKW(pB1,14)};
    SBAR(); pv(o,vb0+sl_cur,PAF(0),PAF(1),PAF(2),PAF(3)); }
  if(hasNext){
    #pragma unroll
    for(int d0=0;d0<4;++d0)qr[d0]=*reinterpret_cast<const bf16x8*>(&nQw[(long)r32*QP+d0*16+hi*8]); }
  #undef PKW
  #undef PAF
  #undef VFR
  #undef PIN
  #undef MX3
  #undef GAPA
  #undef GAPB
  #undef EX
  #undef VRD
  #undef KRD
  #undef STEP
  #undef ENDW
  {auto rr=__builtin_amdgcn_permlane32_swap(__float_as_uint(l_reg),__float_as_uint(l_reg),false,false);l_reg=__uint_as_float(rr[0])+__uint_as_float(rr[1]);}
  if(hi==0)wsf[32+r32]=l_reg;asm volatile("s_waitcnt lgkmcnt(0)":::"memory");
  float rli[16];
  #pragma unroll
  for(int r=0;r<16;++r)rli[r]=__builtin_amdgcn_rcpf(wsf[32+crow(r,hi)]);
  bf16*Ow=dummyO?dummyO+(long)(wid*QBLK)*QP:YQb+(rowbase+q0+wid*QBLK)*QP+1024+h*D; const bf16*Gw=YQb+(rowbase+q0+wid*QBLK)*QP+h*D;
  { float*stg=(float*)(shm+LDS_OST)+wid*2048;
    #pragma unroll
    for(int r=0;r<16;++r){const int orow=crow(r,hi);
      #pragma unroll
      for(int d0=0;d0<2;++d0)stg[orow*64+d0*32+r32]=o[d0][r]*rli[r];}
    asm volatile("s_waitcnt lgkmcnt(0)":::"memory");
    #pragma unroll
    for(int i=0;i<4;++i){const int row=i*8+(lane>>3),ch=lane&7; const float*sp=stg+row*64+ch*8;
      const f32x4_t a=*(const f32x4_t*)sp,c=*(const f32x4_t*)(sp+4); const u32x4 g=*(const u32x4*)(Gw+(long)row*QP+ch*8);
      u32x4 v; v[0]=cvtpk_s(a[0]*__uint_as_float(g[0]<<16),a[1]*__uint_as_float(g[0]&0xffff0000u)); v[1]=cvtpk_s(a[2]*__uint_as_float(g[1]<<16),a[3]*__uint_as_float(g[1]&0xffff0000u));
      v[2]=cvtpk_s(c[0]*__uint_as_float(g[2]<<16),c[1]*__uint_as_float(g[2]&0xffff0000u)); v[3]=cvtpk_s(c[2]*__uint_as_float(g[3]<<16),c[3]*__uint_as_float(g[3]&0xffff0000u));
      ATTN_STORE16(Ow+(long)row*QP+ch*8,v);} }
  asm volatile("s_waitcnt lgkmcnt(0)\n\ts_barrier":::"memory");
  #undef DMA_K
  #undef DMA_V
  #undef CMASK
  #undef START
  #undef RESC
  #undef ROT
}
constexpr int ATTN_LDS_BYTES=LDS_BYTES;
struct Order {
  int vcu, G; bool alt;
  __device__ __forceinline__ bool next(int i,int&b,int&h,int&qb)const{
    if(G==256&&!alt){ if(i>=16)return false; const int x=vcu>>5,j=vcu&31,rd=i>>2,k=i&3; const int pair=x*16+rd*4+(j>>3),un=(j&7)*4+k; b=pair>>2; h=(pair&3)*4+(un&3); qb=un>>2; return true; }
    const int U=i*G+vcu; if(U>=4096)return false; b=U>>7; h=(U>>3)&15; qb=U&7; return true; }
};
template<int THRL=8> __device__ __forceinline__ void attn_phase(char*lds,bf16*YQb,const bf16*K,const bf16*V,const Order&S,int wid,float sbound,bf16*dummyO=nullptr){
  int b,h,qb,nb=0,nh=0,nqb=0; bf16x8 qr[4]; bool first=true;
  bool has=S.next(0,b,h,qb);
  for(int i=0;has;++i){ const bool hn=S.next(i+1,nb,nh,nqb);
    attn_unit<THRL>(b,h,qb,YQb,K,V,lds,wid,sbound,qr,first,hn,nb,nh,nqb,dummyO);
    b=nb;h=nh;qb=nqb;has=hn;first=false; }
}
#undef SBAR
#undef WAIT_BAR
}

namespace ssd {
typedef short bf16x8 __attribute__((ext_vector_type(8)));
typedef short s16x4 __attribute__((ext_vector_type(4)));
typedef unsigned u32x2_t __attribute__((ext_vector_type(2)));
constexpr int O_B = 0, O_C = 32768, O_X = 65536, O_XD = 81920, O_ST = 98304, O_SM = 114688;
constexpr float LOG2E = 1.4426950408889634f;
struct Lofs { int fb[4], xb[4], bb, sw; };
__device__ __forceinline__ bf16x8 frag(const LAS unsigned char* img, int fbk, int t) { return *(const LAS bf16x8*)(img + fbk + t * 4096); }
__device__ __forceinline__ s16x4 trd(const LAS unsigned char* p) { typedef short v4i16_t __attribute__((ext_vector_type(4))); return __builtin_bit_cast(s16x4, __builtin_amdgcn_ds_read_tr16_b64_v4i16((LAS v4i16_t*)p)); }
__device__ __forceinline__ bf16x8 trfragX(const LAS unsigned char* img, int xbp, int s0) {
    const s16x4 a = trd(img + xbp + s0 * 128), b = trd(img + xbp + s0 * 128 + 2048);
    return (bf16x8){a[0], a[1], a[2], a[3], b[0], b[1], b[2], b[3]};
}
__device__ __forceinline__ bf16x8 trfragB(const LAS unsigned char* img, int bb, int s0) {
    const s16x4 a = trd(img + bb + s0 * 256), b = trd(img + bb + s0 * 256 + 4096);
    return (bf16x8){a[0], a[1], a[2], a[3], b[0], b[1], b[2], b[3]};
}
__device__ __forceinline__ void unpack4(const u32x2_t u, float (&f)[4]) { f[0] = __uint_as_float(u.x << 16); f[1] = __uint_as_float(u.x & 0xffff0000u); f[2] = __uint_as_float(u.y << 16); f[3] = __uint_as_float(u.y & 0xffff0000u); }
__device__ __forceinline__ void unpack8(const v4u u, float (&f)[8]) {
    f[0] = __uint_as_float(u.x << 16); f[1] = __uint_as_float(u.x & 0xffff0000u); f[2] = __uint_as_float(u.y << 16); f[3] = __uint_as_float(u.y & 0xffff0000u);
    f[4] = __uint_as_float(u.z << 16); f[5] = __uint_as_float(u.z & 0xffff0000u); f[6] = __uint_as_float(u.w << 16); f[7] = __uint_as_float(u.w & 0xffff0000u);
}
#define SSD_MFMA(a, b, c) __builtin_amdgcn_mfma_f32_16x16x32_bf16(a, b, c, 0, 0, 0)

template <int W> __device__ __forceinline__ void diag(f32x4 (&y)[4], const bf16x8 (&cf)[4], const LAS unsigned char* Bi, const LAS unsigned char* Xi, const LAS float* csc, float csl, float skd, int fr, int fq, const Lofs& lo) {
    constexpr int NU = W / 2 + 1;
    bf16x8 bA[2][4], bB[2][4];
#pragma unroll
    for (int kk = 0; kk < 4; ++kk) { bA[0][kk] = frag(Bi, lo.fb[kk], 0); if (1 <= W) bB[0][kk] = frag(Bi, lo.fb[kk], 1); }
#pragma unroll
    for (int u = 0; u < NU; ++u) {
        const int cur = u & 1; const bool has1 = 2 * u + 1 <= W;
        bf16x8 xf[4];
#pragma unroll
        for (int pt = 0; pt < 4; ++pt) xf[pt] = trfragX(Xi, lo.xb[pt], 32 * u);
        const f32x4 c0 = *(const LAS f32x4*)(csc + 32 * u + 4 * fq), c1 = *(const LAS f32x4*)(csc + 32 * u + 16 + 4 * fq);
        if (u + 1 < NU) {
#pragma unroll
            for (int kk = 0; kk < 4; ++kk) { bA[cur ^ 1][kk] = frag(Bi, lo.fb[kk], 2 * u + 2); if (2 * u + 3 <= W) bB[cur ^ 1][kk] = frag(Bi, lo.fb[kk], 2 * u + 3); } }
        asm volatile("" ::: "memory");
        f32x4 a0 = (f32x4){0.f, 0.f, 0.f, 0.f}, a1 = (f32x4){0.f, 0.f, 0.f, 0.f};
#pragma unroll
        for (int kk = 0; kk < 4; ++kk) { a0 = SSD_MFMA(bA[cur][kk], cf[kk], a0); if (has1) a1 = SSD_MFMA(bB[cur][kk], cf[kk], a1); }
        float m0[4], m1[4];
#pragma unroll
        for (int e = 0; e < 4; ++e) {
            m0[e] = a0[e] * __builtin_amdgcn_exp2f(fminf(csl - c0[e], 0.f)); if (2 * u == W) { if (4 * fq + e > fr) m0[e] = 0.f; if (4 * fq + e == fr) m0[e] += skd; }
            m1[e] = has1 ? a1[e] * __builtin_amdgcn_exp2f(fminf(csl - c1[e], 0.f)) : 0.f; if (2 * u + 1 == W) { if (4 * fq + e > fr) m1[e] = 0.f; if (4 * fq + e == fr) m1[e] += skd; } }
        const v4u mw = (v4u){pk2(m0[0], m0[1]), pk2(m0[2], m0[3]), pk2(m1[0], m1[1]), pk2(m1[2], m1[3])};
        const bf16x8 mf = __builtin_bit_cast(bf16x8, mw);
#pragma unroll
        for (int pt = 0; pt < 4; ++pt) y[pt] = SSD_MFMA(xf[pt], mf, y[pt]);
    }
}

template <int SH> __device__ __forceinline__ void ssd_item(int b, int h, const bf16* XC, const float* DT, const bf16* Z, const float* a_log, const float* d_skip, bf16* YQ, float* SSQ,
                                          LAS unsigned char* L, int tid_in, int lane_in, int wave) {
    int tid = tid_in, lane = lane_in; asm volatile("" : "+v"(tid), "+v"(lane));
    const int fr = lane & 15, fq = lane >> 4, g = h >> 3;
    LAS unsigned char* Bi = L + O_B; LAS unsigned char* Ci = L + O_C; LAS unsigned char* Xi = L + O_X; LAS unsigned char* Xdi = L + O_XD; LAS unsigned char* Sti = L + O_ST;
    LAS float* dtv = (LAS float*)(L + O_SM); LAS float* cs2 = dtv + 256;
    const float aneg1 = -expf(a_log[16 + h]) * LOG2E, aneg0 = -expf(a_log[h]) * LOG2E, dsk = d_skip[h];
    Lofs lo;
    { const int q = (lane & 15) >> 2, pp = lane & 3, rr = 4 * fq + q;
#pragma unroll
      for (int kk = 0; kk < 4; ++kk) lo.fb[kk] = fr * 256 + (((4 * kk + fq) ^ fr) << 4);
#pragma unroll
      for (int pt = 0; pt < 4; ++pt) lo.xb[pt] = rr * 128 + ((pt ^ ((rr >> 1) & 3)) << 5) + 8 * pp;
      lo.bb = rr * 256 + (((2 * wave + (pp >> 1)) ^ rr) << 4) + 8 * (pp & 1);
      lo.sw = fr * 256 + (((2 * wave + (fq >> 1)) ^ fr) << 4) + (fq & 1) * 8; }
    const int sB = tid >> 4, cB = tid & 15, sX = tid >> 3, cX = tid & 7;
    const int wB = sB * 256 + ((cB ^ (sB & 15)) << 4);
    const int wX = sX * 128 + (((cX >> 1) ^ ((sX >> 1) & 3)) << 5) + (cX & 1) * 16;
    f32x4 st[4];
#pragma unroll
    for (int pt = 0; pt < 4; ++pt) st[pt] = (f32x4){0.f, 0.f, 0.f, 0.f};
    v4u Bq[4], Cq[4], Xq[2]; float dq0 = 0.f, dq1 = 0.f; bf16x8 cf[4];
#define SSD_DECODE(step, d_, base_, ctx_) const int d_ = 1 - (step) / 18; const int k_##d_ = (step) % 18; const bool ctx_ = k_##d_ < 2; \
    const size_t base_ = ctx_ ? (size_t)ML + (size_t)b * CTXL + (size_t)(d_ ? 1 - k_##d_ : k_##d_) * 128 : (size_t)b * SEQ + (size_t)(d_ ? 17 - k_##d_ : k_##d_ - 2) * 128;
#define SSD_ISSUE(step) do { SSD_DECODE(step, di, basei, ctxi) (void)ctxi; \
        const bf16* cb_ = XC + (SH == 8 ? (size_t)b * SEQ : basei) * CONVC; const int sg_ = di ? -CONVC : CONVC; const int o0_ = di ? 127 * CONVC : 0; \
        const bf16* pb_ = cb_ + (o0_ + sB * sg_ + 1024 + g * 128 + 8 * cB); const bf16* px_ = cb_ + (o0_ + sX * sg_ + h * 64 + 8 * cX); \
        const bf16* pc_ = cb_ + (o0_ + (16 * wave + fr) * sg_ + 1280 + g * 128 + 8 * fq); \
        _Pragma("unroll") for (int k4 = 0; k4 < 4; ++k4) { Bq[k4] = *(const v4u*)(pb_ + k4 * 32 * sg_); Cq[k4] = *(const v4u*)(pc_ + 32 * k4); } \
        _Pragma("unroll") for (int k2 = 0; k2 < 2; ++k2) Xq[k2] = *(const v4u*)(px_ + k2 * 64 * sg_); \
        if (wave == 0) { const size_t r0 = basei + (di ? 127 - 2 * lane : 2 * lane), r1 = basei + (di ? 126 - 2 * lane : 2 * lane + 1); dq0 = DT[r0 * 32 + di * 16 + h]; dq1 = DT[r1 * 32 + di * 16 + h]; } } while (0)
#define SSD_CUMSUM(step, par) do { if (wave == 0) { const float an = (1 - (step) / 18) ? aneg1 : aneg0; const float a0 = dq0 * an, a1 = dq1 * an; float v = a0 + a1; \
        _Pragma("unroll") for (int o = 1; o < 64; o <<= 1) { const float t = __shfl_up(v, o); if (lane >= o) v += t; } \
        dtv[(par) * 128 + 2 * lane] = dq0; dtv[(par) * 128 + 2 * lane + 1] = dq1; cs2[(par) * 128 + 2 * lane] = v - a1; cs2[(par) * 128 + 2 * lane + 1] = v; } } while (0)
#define SSD_WRITE(step, par) do { \
        _Pragma("unroll") for (int k4 = 0; k4 < 4; ++k4) { *(LAS v4u*)(Bi + wB + k4 * 8192) = Bq[k4]; cf[k4] = __builtin_bit_cast(bf16x8, Cq[k4]); } \
        const float cl = cs2[(par) * 128 + 127]; \
        _Pragma("unroll") for (int k2 = 0; k2 < 2; ++k2) { const int s = sX + 64 * k2; const float dts = dtv[(par) * 128 + s], es = __builtin_amdgcn_exp2f(cl - cs2[(par) * 128 + s]); \
            float f[8]; unpack8(Xq[k2], f); _Pragma("unroll") for (int e = 0; e < 8; ++e) f[e] *= dts; \
            v4u xo; xo.x = pk2(f[0], f[1]); xo.y = pk2(f[2], f[3]); xo.z = pk2(f[4], f[5]); xo.w = pk2(f[6], f[7]); \
            _Pragma("unroll") for (int e = 0; e < 8; ++e) f[e] *= es; \
            v4u xd; xd.x = pk2(f[0], f[1]); xd.y = pk2(f[2], f[3]); xd.z = pk2(f[4], f[5]); xd.w = pk2(f[6], f[7]); \
            *(LAS v4u*)(Xi + wX + k2 * 8192) = xo; *(LAS v4u*)(Xdi + wX + k2 * 8192) = xd; } } while (0)
#define SSD_WRITE_STATE() do { _Pragma("unroll") for (int pt = 0; pt < 4; ++pt) { \
        u32x2_t w; w.x = pk2(st[pt][0], st[pt][1]); w.y = pk2(st[pt][2], st[pt][3]); *(LAS u32x2_t*)(Sti + lo.sw + pt * 4096) = w; } } while (0)

    __syncthreads();
    SSD_ISSUE(0); SSD_CUMSUM(0, 0); SSD_WRITE_STATE();
    __syncthreads();
    SSD_WRITE(0, 0);
    __syncthreads();
    for (int step = 0; step < 36; ++step) {
        const int par = step & 1; SSD_DECODE(step, d, base, isctx)
        const int r8 = lane >> 3, c8 = lane & 7;
        size_t orow2[2]; v4u ybv[2], zv[2];
#pragma unroll
        for (int ps = 0; ps < 2; ++ps) { const int l = 16 * wave + 8 * ps + r8; orow2[ps] = base + (d ? 127 - l : l); }
        if (!isctx && d == 0 && SH != 5 && SH != 7) {
#pragma unroll
            for (int ps = 0; ps < 2; ++ps) { ybv[ps] = *(const v4u*)((SH ? YQ + (orow2[ps] & 255) * 2048 : YQ + orow2[ps] * 2048) + h * 64 + 8 * c8); zv[ps] = *(const v4u*)(Z + orow2[ps] * 1024 + h * 64 + 8 * c8); } }
        if (step + 1 < 36 && SH != 3 && SH != 7) SSD_ISSUE(step + 1);
        const LAS float* csc = cs2 + par * 128;
        if (!isctx && SH != 7) {
            const float csl = csc[16 * wave + fr];
            const float skd = d == 0 ? dsk * __builtin_amdgcn_rcpf(dtv[par * 128 + 16 * wave + fr]) : 0.f;
            f32x4 y[4];
#pragma unroll
            for (int pt = 0; pt < 4; ++pt) { y[pt] = (f32x4){0.f, 0.f, 0.f, 0.f};
                if (SH != 6) {
#pragma unroll
                for (int kk = 0; kk < 4; ++kk) y[pt] = SSD_MFMA(frag(Sti, lo.fb[kk], pt), cf[kk], y[pt]); } }
            { const float El = __builtin_amdgcn_exp2f(csl);
#pragma unroll
              for (int pt = 0; pt < 4; ++pt) y[pt] *= El; }
            if (SH != 2) switch (wave) {
                case 0: diag<0>(y, cf, Bi, Xi, csc, csl, skd, fr, fq, lo); break; case 1: diag<1>(y, cf, Bi, Xi, csc, csl, skd, fr, fq, lo); break;
                case 2: diag<2>(y, cf, Bi, Xi, csc, csl, skd, fr, fq, lo); break; case 3: diag<3>(y, cf, Bi, Xi, csc, csl, skd, fr, fq, lo); break;
                case 4: diag<4>(y, cf, Bi, Xi, csc, csl, skd, fr, fq, lo); break; case 5: diag<5>(y, cf, Bi, Xi, csc, csl, skd, fr, fq, lo); break;
                case 6: diag<6>(y, cf, Bi, Xi, csc, csl, skd, fr, fq, lo); break; default: diag<7>(y, cf, Bi, Xi, csc, csl, skd, fr, fq, lo); break;
            }
            LAS unsigned char* stg = Ci + wave * 4096;
#pragma unroll
            for (int pt = 0; pt < 4; ++pt) *(LAS f32x4*)(stg + fr * 256 + (((4 * pt + fq) ^ fr) << 4)) = y[pt];
#pragma unroll
            for (int ps = 0; ps < 2; ++ps) { const int rl = 8 * ps + r8;
                const f32x4 t0 = *(const LAS f32x4*)(stg + rl * 256 + (((2 * c8) ^ rl) << 4)), t1 = *(const LAS f32x4*)(stg + rl * 256 + (((2 * c8 + 1) ^ rl) << 4));
                float v[8] = {t0[0], t0[1], t0[2], t0[3], t1[0], t1[1], t1[2], t1[3]};
                if (d == 0 && SH != 5) { float fb[8], fz[8]; unpack8(ybv[ps], fb); unpack8(zv[ps], fz); float q = 0.f;
#pragma unroll
                    for (int e = 0; e < 8; ++e) { v[e] = (v[e] + fb[e]) * fz[e]; q += v[e] * v[e]; }
                    q += __shfl_xor(q, 1); q += __shfl_xor(q, 2); q += __shfl_xor(q, 4);
                    if (c8 == 0) SSQ[(SH ? (orow2[ps] & 255) : orow2[ps]) * 16 + h] = q; }
                v4u o; o.x = pk2(v[0], v[1]); o.y = pk2(v[2], v[3]); o.z = pk2(v[4], v[5]); o.w = pk2(v[6], v[7]);
                if (SH != 5) *(v4u*)((SH ? YQ + (orow2[ps] & 255) * 2048 : YQ + orow2[ps] * 2048) + h * 64 + 8 * c8) = o; else asm volatile("" :: "v"(o)); }
        }
        if (SH != 6 && SH != 7) { const float dec = __builtin_amdgcn_exp2f(csc[127]);
#pragma unroll
          for (int pt = 0; pt < 4; ++pt) st[pt] *= dec;
#pragma unroll
          for (int kk = 0; kk < 4; ++kk) { const bf16x8 af = trfragB(Bi, lo.bb, 32 * kk);
#pragma unroll
              for (int pt = 0; pt < 4; ++pt) st[pt] = SSD_MFMA(af, trfragX(Xdi, lo.xb[pt], 32 * kk), st[pt]); } }
        if (step + 1 < 36) SSD_CUMSUM(step + 1, par ^ 1);
        if (step == 17) {
#pragma unroll
            for (int pt = 0; pt < 4; ++pt) st[pt] = (f32x4){0.f, 0.f, 0.f, 0.f};
            VM_WAIT();
        }
        __syncthreads();
        SSD_WRITE_STATE();
        if (step + 1 < 36 && SH != 4 && SH != 7) SSD_WRITE(step + 1, par ^ 1);
        __syncthreads();
    }
#undef SSD_DECODE
#undef SSD_ISSUE
#undef SSD_CUMSUM
#undef SSD_WRITE
#undef SSD_WRITE_STATE
}
namespace pr {
template <int CTRL, int ROWMASK> __device__ __forceinline__ float dpp_get(float v) {
    return __builtin_bit_cast(float, __builtin_amdgcn_update_dpp(0, __builtin_bit_cast(int, v), CTRL, ROWMASK, 0xF, false)); }
__device__ __forceinline__ float sum8(float q) {
    q += dpp_get<0xB1, 0xF>(q); q += dpp_get<0x4E, 0xF>(q); q += dpp_get<0x141, 0xF>(q); return q; }
__device__ __forceinline__ float scan64(float v) {
    v += dpp_get<0x111, 0xF>(v); v += dpp_get<0x112, 0xF>(v); v += dpp_get<0x114, 0xF>(v); v += dpp_get<0x118, 0xF>(v);
    v += dpp_get<0x142, 0xA>(v); v += dpp_get<0x143, 0xC>(v); return v; }
constexpr int P_B = 0, P_STG = 32768, P_X = 49152, P_XD = 81920, P_ST0 = 114688, P_ST1 = 132096, P_SM = 148480;
template <int W> __device__ __forceinline__ void diag1(f32x4 (&y)[4], const bf16x8 (&cf)[4], const LAS unsigned char* Bi, const LAS unsigned char* Xi, const LAS float* csc, float csl, float skd, int fr, int fq, const Lofs& lo) {
#pragma unroll
    for (int u = 0; u <= W / 2; ++u) {
        const bool has1 = 2 * u + 1 <= W;
        bf16x8 xf[4];
#pragma unroll
        for (int pt = 0; pt < 4; ++pt) xf[pt] = trfragX(Xi, lo.xb[pt], 32 * u);
        const f32x4 c0 = *(const LAS f32x4*)(csc + 32 * u + 4 * fq), c1 = *(const LAS f32x4*)(csc + 32 * u + 16 + 4 * fq);
        f32x4 a0 = (f32x4){0.f, 0.f, 0.f, 0.f}, a1 = (f32x4){0.f, 0.f, 0.f, 0.f};
#pragma unroll
        for (int kk = 0; kk < 4; ++kk) { a0 = SSD_MFMA(frag(Bi, lo.fb[kk], 2 * u), cf[kk], a0); if (has1) a1 = SSD_MFMA(frag(Bi, lo.fb[kk], 2 * u + 1), cf[kk], a1); }
        float m0[4], m1[4];
#pragma unroll
        for (int e = 0; e < 4; ++e) {
            m0[e] = a0[e] * __builtin_amdgcn_exp2f(fminf(csl - c0[e], 0.f)); if (2 * u == W) { if (4 * fq + e > fr) m0[e] = 0.f; if (4 * fq + e == fr) m0[e] += skd; }
            m1[e] = has1 ? a1[e] * __builtin_amdgcn_exp2f(fminf(csl - c1[e], 0.f)) : 0.f; if (2 * u + 1 == W) { if (4 * fq + e > fr) m1[e] = 0.f; if (4 * fq + e == fr) m1[e] += skd; } }
        const v4u mw = (v4u){pk2(m0[0], m0[1]), pk2(m0[2], m0[3]), pk2(m1[0], m1[1]), pk2(m1[2], m1[3])};
        const bf16x8 mf = __builtin_bit_cast(bf16x8, mw);
#pragma unroll
        for (int pt = 0; pt < 4; ++pt) y[pt] = SSD_MFMA(xf[pt], mf, y[pt]);
    }
}
__device__ __forceinline__ void diag_sw(int wave, f32x4 (&y)[4], const bf16x8 (&cf)[4], const LAS unsigned char* Bi, const LAS unsigned char* Xi, const LAS float* csc, float csl, float skd, int fr, int fq, const Lofs& lo) {
    switch (wave) {
        case 0: diag<0>(y, cf, Bi, Xi, csc, csl, skd, fr, fq, lo); break; case 1: diag<1>(y, cf, Bi, Xi, csc, csl, skd, fr, fq, lo); break;
        case 2: diag<2>(y, cf, Bi, Xi, csc, csl, skd, fr, fq, lo); break; case 3: diag<3>(y, cf, Bi, Xi, csc, csl, skd, fr, fq, lo); break;
        case 4: diag<4>(y, cf, Bi, Xi, csc, csl, skd, fr, fq, lo); break; case 5: diag<5>(y, cf, Bi, Xi, csc, csl, skd, fr, fq, lo); break;
        case 6: diag<6>(y, cf, Bi, Xi, csc, csl, skd, fr, fq, lo); break; default: diag<7>(y, cf, Bi, Xi, csc, csl, skd, fr, fq, lo); break;
    }
}

__device__ __forceinline__ void ssd_pair(int b, int hp, const bf16* XC, const float* DT, const bf16* Z, const float* a_log, const float* d_skip, bf16* YQ, float* SSQ,
                                          LAS unsigned char* L, int tid_in, int lane_in, int wave) {
    int tid = tid_in, lane = lane_in; asm volatile("" : "+v"(tid), "+v"(lane));
    const int fr = lane & 15, fq = lane >> 4, h0 = 2 * hp, g = hp >> 2;
    LAS unsigned char* Bi = L + P_B; LAS unsigned char* Stg = L + P_STG + wave * 2048;
    LAS float* dtv = (LAS float*)(L + P_SM); LAS float* cs2 = dtv + 512;
    const float an00 = -expf(a_log[h0]) * LOG2E, an01 = -expf(a_log[h0 + 1]) * LOG2E, an10 = -expf(a_log[16 + h0]) * LOG2E, an11 = -expf(a_log[16 + h0 + 1]) * LOG2E;
    const float dsk0 = d_skip[h0], dsk1 = d_skip[h0 + 1];
    Lofs lo;
    { const int q = (lane & 15) >> 2, pp = lane & 3, rr = 4 * fq + q;
#pragma unroll
      for (int kk = 0; kk < 4; ++kk) lo.fb[kk] = fr * 256 + (((4 * kk + fq) ^ fr) << 4);
#pragma unroll
      for (int pt = 0; pt < 4; ++pt) lo.xb[pt] = rr * 128 + ((pt ^ ((rr >> 1) & 3)) << 5) + 8 * pp;
      lo.bb = rr * 256 + (((2 * wave + (pp >> 1)) ^ rr) << 4) + 8 * (pp & 1);
      lo.sw = fr * 256 + (((2 * wave + (fq >> 1)) ^ fr) << 4) + (fq & 1) * 8; }
    const int sB = tid >> 4, cB = tid & 15, hx = (tid >> 3) & 1, cX = tid & 7;
    const int wB = sB * 256 + ((cB ^ (sB & 15)) << 4);
    const int wX = hx * 16384 + sB * 128 + (((cX >> 1) ^ ((sB >> 1) & 3)) << 5) + (cX & 1) * 16;
    f32x4 st[2][4];
#pragma unroll
    for (int hh = 0; hh < 2; ++hh)
#pragma unroll
        for (int pt = 0; pt < 4; ++pt) st[hh][pt] = (f32x4){0.f, 0.f, 0.f, 0.f};
    v4u Bq[4], Xq[4]; float dq0 = 0.f, dq1 = 0.f; bf16x8 cf[4];
#define PR_DECODE(step, d_, base_, ctx_) const int d_ = 1 - (step) / 18; const int k_##d_ = (step) % 18; const bool ctx_ = k_##d_ < 2; \
    const size_t base_ = ctx_ ? (size_t)ML + (size_t)b * CTXL + (size_t)(d_ ? 1 - k_##d_ : k_##d_) * 128 : (size_t)b * SEQ + (size_t)(d_ ? 17 - k_##d_ : k_##d_ - 2) * 128;
#define PR_ISSUE(step) do { PR_DECODE(step, di, basei, ctxi) (void)ctxi; \
        const bf16* cb_ = XC + basei * CONVC; const int sg_ = di ? -CONVC : CONVC; const int o0_ = di ? 127 * CONVC : 0; \
        const bf16* pb_ = cb_ + (o0_ + sB * sg_ + 1024 + g * 128 + 8 * cB); const bf16* px_ = cb_ + (o0_ + sB * sg_ + h0 * 64 + 8 * cB); \
        _Pragma("unroll") for (int k4 = 0; k4 < 4; ++k4) { Bq[k4] = *(const v4u*)(pb_ + k4 * 32 * sg_); Xq[k4] = *(const v4u*)(px_ + k4 * 32 * sg_); } \
        if (wave < 2) { const size_t r0 = basei + (di ? 127 - 2 * lane : 2 * lane), r1 = basei + (di ? 126 - 2 * lane : 2 * lane + 1); dq0 = DT[r0 * 32 + di * 16 + h0 + wave]; dq1 = DT[r1 * 32 + di * 16 + h0 + wave]; } } while (0)
#define PR_LOADC(step) do { PR_DECODE(step, dc, basec, ctxc) (void)ctxc; const bf16* pc_ = XC + basec * CONVC + ((dc ? 127 - (16 * wave + fr) : 16 * wave + fr) * CONVC + 1280 + g * 128 + 8 * fq); \
        _Pragma("unroll") for (int k4 = 0; k4 < 4; ++k4) cf[k4] = __builtin_bit_cast(bf16x8, *(const v4u*)(pc_ + 32 * k4)); } while (0)
#define PR_CUMSUM(step, par) do { if (wave < 2) { const float an = (1 - (step) / 18) ? (wave ? an11 : an10) : (wave ? an01 : an00); const float a0 = dq0 * an, a1 = dq1 * an; const float v = scan64(a0 + a1); \
        const int o_ = ((par) * 2 + wave) * 128 + 2 * lane; dtv[o_] = dq0; dtv[o_ + 1] = dq1; cs2[o_] = v - a1; cs2[o_ + 1] = v; } } while (0)
#define PR_WRITE(step, par) do { const int ob_ = ((par) * 2 + hx) * 128; const float cl = cs2[ob_ + 127]; \
        _Pragma("unroll") for (int k4 = 0; k4 < 4; ++k4) { *(LAS v4u*)(Bi + wB + k4 * 8192) = Bq[k4]; \
            const int s = sB + 32 * k4; const float dts = dtv[ob_ + s], es = __builtin_amdgcn_exp2f(cl - cs2[ob_ + s]); \
            float f[8]; unpack8(Xq[k4], f); _Pragma("unroll") for (int e = 0; e < 8; ++e) f[e] *= dts; \
            v4u xo; xo.x = pk2(f[0], f[1]); xo.y = pk2(f[2], f[3]); xo.z = pk2(f[4], f[5]); xo.w = pk2(f[6], f[7]); \
            _Pragma("unroll") for (int e = 0; e < 8; ++e) f[e] *= es; \
            v4u xd; xd.x = pk2(f[0], f[1]); xd.y = pk2(f[2], f[3]); xd.z = pk2(f[4], f[5]); xd.w = pk2(f[6], f[7]); \
            *(LAS v4u*)(L + P_X + wX + k4 * 4096) = xo; *(LAS v4u*)(L + P_XD + wX + k4 * 4096) = xd; } } while (0)
#define PR_WRITE_STATE() do { _Pragma("unroll") for (int pt = 0; pt < 4; ++pt) { \
        u32x2_t w; w.x = pk2(st[0][pt][0], st[0][pt][1]); w.y = pk2(st[0][pt][2], st[0][pt][3]); *(LAS u32x2_t*)(L + P_ST0 + lo.sw + pt * 4096) = w; \
        w.x = pk2(st[1][pt][0], st[1][pt][1]); w.y = pk2(st[1][pt][2], st[1][pt][3]); *(LAS u32x2_t*)(L + P_ST1 + lo.sw + pt * 4096) = w; } } while (0)

    __syncthreads();
    PR_ISSUE(0); PR_LOADC(0); PR_CUMSUM(0, 0); PR_WRITE_STATE();
    __syncthreads();
    PR_WRITE(0, 0);
    __syncthreads();
    for (int step = 0; step < 36; ++step) {
        const int par = step & 1; PR_DECODE(step, d, base, isctx)
        const int r8 = lane >> 3, c8 = lane & 7;
        size_t orow2[2]; v4u ybv[2], zv[2];
#pragma unroll
        for (int ps = 0; ps < 2; ++ps) { const int l = 16 * wave + 8 * ps + r8; orow2[ps] = base + (d ? 127 - l : l); }
        const bool fwdy = !isctx && d == 0;
        if (fwdy) {
#pragma unroll
            for (int ps = 0; ps < 2; ++ps) { ybv[ps] = *(const v4u*)(YQ + orow2[ps] * 2048 + h0 * 64 + 8 * c8); zv[ps] = *(const v4u*)(Z + orow2[ps] * 1024 + h0 * 64 + 8 * c8); } }
        if (step + 1 < 36) PR_ISSUE(step + 1);
        if (!isctx) {
#pragma unroll
            for (int hh = 0; hh < 2; ++hh) {
                const LAS float* csc = cs2 + (par * 2 + hh) * 128;
                const LAS unsigned char* Xi = L + P_X + hh * 16384; const LAS unsigned char* Sti = L + (hh ? P_ST1 : P_ST0);
                const float csl = csc[16 * wave + fr];
                const float skd = d == 0 ? (hh ? dsk1 : dsk0) * __builtin_amdgcn_rcpf(dtv[(par * 2 + hh) * 128 + 16 * wave + fr]) : 0.f;
                f32x4 y[4];
#pragma unroll
                for (int pt = 0; pt < 4; ++pt) { y[pt] = (f32x4){0.f, 0.f, 0.f, 0.f};
#pragma unroll
                    for (int kk = 0; kk < 4; ++kk) y[pt] = SSD_MFMA(frag(Sti, lo.fb[kk], pt), cf[kk], y[pt]); }
                { const float El = __builtin_amdgcn_exp2f(csl);
#pragma unroll
                  for (int pt = 0; pt < 4; ++pt) y[pt] *= El; }
                diag_sw(wave, y, cf, Bi, Xi, csc, csl, skd, fr, fq, lo);
#pragma unroll
                for (int ps = 0; ps < 2; ++ps) {
                    if ((fr >> 3) == ps) {
#pragma unroll
                        for (int pt = 0; pt < 4; ++pt) *(LAS f32x4*)(Stg + (fr & 7) * 256 + (((4 * pt + fq) ^ fr) << 4)) = y[pt]; }
                    const int key = 8 * ps + r8;
                    const f32x4 t0 = *(const LAS f32x4*)(Stg + r8 * 256 + (((2 * c8) ^ key) << 4)), t1 = *(const LAS f32x4*)(Stg + r8 * 256 + (((2 * c8 + 1) ^ key) << 4));
                    float v[8] = {t0[0], t0[1], t0[2], t0[3], t1[0], t1[1], t1[2], t1[3]};
                    if (d == 0) { float fb[8], fz[8]; unpack8(ybv[ps], fb); unpack8(zv[ps], fz); float q = 0.f;
#pragma unroll
                        for (int e = 0; e < 8; ++e) { v[e] = (v[e] + fb[e]) * fz[e]; q += v[e] * v[e]; }
                        q = sum8(q);
                        if (c8 == 0) SSQ[orow2[ps] * 16 + h0 + hh] = q; }
                    v4u o; o.x = pk2(v[0], v[1]); o.y = pk2(v[2], v[3]); o.z = pk2(v[4], v[5]); o.w = pk2(v[6], v[7]);
                    *(v4u*)(YQ + orow2[ps] * 2048 + (h0 + hh) * 64 + 8 * c8) = o;
                }
                if (hh == 0 && fwdy) {
#pragma unroll
                    for (int ps = 0; ps < 2; ++ps) { ybv[ps] = *(const v4u*)(YQ + orow2[ps] * 2048 + (h0 + 1) * 64 + 8 * c8); zv[ps] = *(const v4u*)(Z + orow2[ps] * 1024 + (h0 + 1) * 64 + 8 * c8); } }
            }
        }
        if (step + 1 < 36) PR_LOADC(step + 1);
        { const float dec0 = __builtin_amdgcn_exp2f(cs2[(par * 2 + 0) * 128 + 127]), dec1 = __builtin_amdgcn_exp2f(cs2[(par * 2 + 1) * 128 + 127]);
#pragma unroll
          for (int pt = 0; pt < 4; ++pt) { st[0][pt] *= dec0; st[1][pt] *= dec1; }
#pragma unroll
          for (int kk = 0; kk < 4; ++kk) { const bf16x8 af = trfragB(Bi, lo.bb, 32 * kk);
#pragma unroll
              for (int pt = 0; pt < 4; ++pt) { st[0][pt] = SSD_MFMA(af, trfragX(L + P_XD, lo.xb[pt], 32 * kk), st[0][pt]); st[1][pt] = SSD_MFMA(af, trfragX(L + P_XD + 16384, lo.xb[pt], 32 * kk), st[1][pt]); } } }
        if (step + 1 < 36) PR_CUMSUM(step + 1, par ^ 1);
        if (step == 17) {
#pragma unroll
            for (int pt = 0; pt < 4; ++pt) { st[0][pt] = (f32x4){0.f, 0.f, 0.f, 0.f}; st[1][pt] = (f32x4){0.f, 0.f, 0.f, 0.f}; }
            VM_WAIT();
        }
        __syncthreads();
        PR_WRITE_STATE();
        if (step + 1 < 36) PR_WRITE(step + 1, par ^ 1);
        __syncthreads();
    }
#undef PR_DECODE
#undef PR_ISSUE
#undef PR_CUMSUM
#undef PR_LOADC
#undef PR_WRITE
#undef PR_WRITE_STATE
}
}
}

__device__ __forceinline__ void ctx_dt_slice(const bf16* H, const bf16* bt1, const float* dt_bias, float* DT, int bx, int G, int wave, int lane) {
    typedef short bf16x8_t __attribute__((ext_vector_type(8)));
    const int fr = lane & 15, fq = lane >> 4;
    for (int sl = bx; sl < MC / 32; sl += G) {
        if (wave < 4) {
            const int r0 = ML + 32 * sl + 16 * (wave >> 1), j0 = 16 * (wave & 1);
            const bf16* ap = H + (size_t)(r0 + fr) * DM + 8 * fq; const bf16* bp = bt1 + (size_t)(2048 + j0 + fr) * DM + 8 * fq;
            f32x4 acc = (f32x4){0.f, 0.f, 0.f, 0.f};
#pragma unroll 8
            for (int kk = 0; kk < 32; ++kk) acc = __builtin_amdgcn_mfma_f32_16x16x32_bf16(*(const bf16x8_t*)(ap + 32 * kk), *(const bf16x8_t*)(bp + 32 * kk), acc, 0, 0, 0);
            const float bias = dt_bias[j0 + fr];
#pragma unroll
            for (int e = 0; e < 4; ++e) { const float v = acc[e] + bias; DT[(size_t)(r0 + 4 * fq + e) * 32 + j0 + fr] = v > 20.f ? v : log1pf(__expf(v)); }
        }
    }
}
constexpr int RING_OFF = 0, RING_BYTES = 131072;
constexpr int LDSCTL_OFF = RING_BYTES, MISC_OFF = LDSCTL_OFF + 320;
constexpr int RSTD_OFF = LDSCTL_OFF + 1024;
constexpr int LDS_BYTES = 155648;
constexpr int CW_BAR = 4096;
constexpr int CW_TMO2 = 8192, CW_CNT = 16384;
constexpr int EXL_OFF = 140288;
constexpr int NPHASE = 7;

struct Args { const float* in[18]; float* out; unsigned char* ws; int ph_lo, ph_hi; };

__global__ void __launch_bounds__(NWAVES * 64, 2) mega(Args args) {
    extern __shared__ __attribute__((aligned(16))) unsigned char lds[];
    LAS unsigned char* ldsp = (LAS unsigned char*)lds;
    volatile LAS unsigned* MISC = (volatile LAS unsigned*)(ldsp + MISC_OFF);
    const int wave = __builtin_amdgcn_readfirstlane((int)threadIdx.x >> 6);
#define PH_IDS() int lane = mk_lane(); asm volatile("" : "+v"(lane)); const int tid = wave * 64 + lane; (void)tid
    const int G = gridDim.x; const int bx = blockIdx.x; const int vcu = (G % 8 == 0) ? (bx % 8) * (G / 8) + bx / 8 : bx;
    unsigned char* ws = args.ws;
    gu32* ctl = (gu32*)(ws + WS_CTL);
    float* mod = (float*)(ws + WS_MOD); float* rope = (float*)(ws + WS_ROPE); float* SSQ = (float*)(ws + WS_SSQ); float* RPART = (float*)(ws + WS_RPART);
    bf16* bt1 = (bf16*)(ws + WS_BT1); bf16* bt2 = (bf16*)(ws + WS_BT2); float* DT = (float*)(ws + WS_DT); bf16* KB = (bf16*)(ws + WS_KB); bf16* VB = (bf16*)(ws + WS_VB);
    bf16* H = (bf16*)(ws + WS_R1); bf16* XC = (bf16*)(ws + WS_R1); bf16* XBC = (bf16*)(ws + WS_XBC); bf16* YQ = (bf16*)(ws + WS_YQ); bf16* Z = (bf16*)(ws + WS_Z);
    { PH_IDS(); for (int u = tid; u < (LDS_BYTES - LDSCTL_OFF) / 4; u += NWAVES * 64) ((LAS unsigned*)(ldsp + LDSCTL_OFF))[u] = 0u; }
    __syncthreads();
    const bool leader = wave == 0 && mk_lane() == 0; (void)leader;
    const int lo = args.ph_lo, hi = args.ph_hi;
    XcdBarrier bar; bar.bar = (unsigned*)(ctl + CW_BAR); bar.x = 0; bar.st = nullptr;
    if (hi - lo > 1) bar = xcd_barrier_post((unsigned*)(ctl + CW_BAR), MISC + 8, leader);
#ifndef DUP_MASK
#define DUP_MASK 0
#endif
#define IN(k) (lo <= (k) && (k) < hi)
#define REP(k) for (int rep_ = 0; rep_ < 1 + ((DUP_MASK >> (k)) & 1); ++rep_)
#define SEAM(k) do { if (IN(k) && IN((k) + 1)) xcd_barrier(bar, wave == 0 && mk_lane() == 0); } while (0)

    if (IN(0)) REP(0) {
        PH_IDS();
        LAS float* ldsf = (LAS float*)(ldsp + RING_OFF);
        if (bx < 48) p0_mod_block(args.in[1], args.in[3], args.in[4], args.in[5], mod, ldsf, bx, tid, lane, wave);
        else if (bx == 48) { for (int i = tid; i < 1024; i += NWAVES * 64) { const int p = i >> 4, f = i & 15; const float inv = powf(10000.f, -(float)f / 16.f); const float ang = (float)p * inv; rope[i] = cosf(ang); rope[1024 + i] = sinf(ang); } }
        LAS float* scr = ldsf + wave * (64 * 33);
        const int gw = ((bx + G - 49) % G) * NWAVES + wave, NGW = G * NWAVES;
        constexpr int I1 = 16 * 168, I2 = 32 * 32;
        for (int it = gw; it < I1 + I2; it += NGW) { if (it < I1) p0_bt1_item(args.in[7], bt1, scr, it, lane); else p0_bt2_item(args.in[16], args.in[15], bt2, scr, it - I1, lane); }
    }
    SEAM(0);
    if (IN(1)) REP(1) {
        PH_IDS();
        const int gw = bx * NWAVES + wave, NGW = G * NWAVES;
        static_assert(MT % (8 * 2048) == 0 || true, "row batches");
        {
            const int step = NGW * 4; int m0 = gw * 4;
            f32x4 va[4][4], vb[4][4];
            if (m0 < MT) p1_load4(va, args.in[0], args.in[2], m0, lane);
            while (m0 < MT) {
                if (m0 + step < MT) p1_load4(vb, args.in[0], args.in[2], m0 + step, lane);
                asm volatile("" ::: "memory");
                p1_proc4(va, mod, args.in[6], H, m0, lane);
                m0 += step; if (m0 >= MT) break;
                if (m0 + step < MT) p1_load4(va, args.in[0], args.in[2], m0 + step, lane);
                asm volatile("" ::: "memory");
                p1_proc4(vb, mod, args.in[6], H, m0, lane);
                m0 += step;
            }
        }
    }
    SEAM(1);

    if (IN(2)) REP(2) {
        pg8::Gemm g{H, bt1, MT, N1, 1024}; pg8::Sched1 S; S.init(G, bx);
        pg8::Epi1 E{KB, VB, XBC, YQ, Z, DT, rope, args.in[13], args.in[14], args.in[10], ldsp + RSTD_OFF};
#ifndef G1_PROBE
#define G1_PROBE 0
#endif
        if (G1_PROBE == 1) { pg8::EpiNull EN; pg8::gemm_phase<pg8::EpiNull, pg8::Sched1, true, true>(ldsp + RING_OFF, g, S, EN, wave); }
        if (G1_PROBE == 2) { pg8::EpiPlainReal EP{KB, VB, XBC, YQ, Z, DT}; pg8::gemm_phase<pg8::EpiPlainReal, pg8::Sched1, true, true>(ldsp + RING_OFF, g, S, EP, wave); }
        if (G1_PROBE == 3) { pg8::gemm_phase<pg8::Epi1, pg8::Sched1, true, true>(ldsp + RING_OFF, g, S, E, wave); }
        pg8::gemm_phase<pg8::Epi1, pg8::Sched1, true, true>(ldsp + RING_OFF, g, S, E, wave);
        { int ln_ = mk_lane(); asm volatile("" : "+v"(ln_)); ctx_dt_slice(H, bt1, args.in[10], DT, bx, G, wave, ln_); }
    }
    SEAM(2);
    if (IN(3)) {
        PH_IDS();
        float sbound;
        { float gq = fabsf(args.in[13][lane]), gk = fabsf(args.in[14][lane]);
#pragma unroll
          for (int o = 1; o < 64; o <<= 1) { gq = fmaxf(gq, __shfl_xor(gq, o)); gk = fmaxf(gk, __shfl_xor(gk, o)); }
          sbound = __uint_as_float(__builtin_amdgcn_readfirstlane(__float_as_uint(C2 * 64.f * gq * gk * 1.01f))); }
        const attn_body::Order S{vcu, G, false};
        const attn_body::Order S2{vcu, G, true};
#ifndef ATTN_SHADOW
#define ATTN_SHADOW 0
#endif
        if (ATTN_SHADOW) attn_body::attn_phase<8>((char*)lds + RING_OFF, (attn_body::bf16*)YQ, (const attn_body::bf16*)KB, (const attn_body::bf16*)VB, ATTN_SHADOW == 2 ? S2 : S, wave, sbound, (attn_body::bf16*)(ws + WS_END + 8 * MiB));
        attn_body::attn_phase<8>((char*)lds + RING_OFF, (attn_body::bf16*)YQ, (const attn_body::bf16*)KB, (const attn_body::bf16*)VB, S, wave, sbound);
        conv_phase(XBC, args.in[8], args.in[9], XC, bx, G, tid);
    }
    SEAM(3);
    if (IN(4)) REP(4) {
        PH_IDS();
#if defined(SSD_NAIVE)
        for (int it = bx; it < NB * 16; it += G) ssd_item_naive(it >> 4, it & 15, XC, DT, Z, args.in[11], args.in[12], YQ, SSQ, (LAS float*)(ldsp + RING_OFF), tid);
#else
#ifndef SSD_SHADOW
#define SSD_SHADOW 0
#endif
        if (SSD_SHADOW) { bf16* dY = (bf16*)(ws + WS_END); float* dS = (float*)(ws + WS_END + 2 * MiB);
            for (int it = vcu; it < NB * 16; it += G) ssd::ssd_item<SSD_SHADOW>(it >> 4, it & 15, XC, DT, Z, args.in[11], args.in[12], dY, dS, ldsp, tid, lane, wave); }
#ifndef SSD_PAIR
#define SSD_PAIR 1
#endif
        if (SSD_PAIR) { for (int it = vcu; it < NB * 8; it += G) { int ln_ = mk_lane(); asm volatile("" : "+v"(ln_)); ssd::pr::ssd_pair(it >> 3, it & 7, XC, DT, Z, args.in[11], args.in[12], YQ, SSQ, ldsp, wave * 64 + ln_, ln_, wave); } }
        else for (int it = vcu; it < NB * 16; it += G) ssd::ssd_item<0>(it >> 4, it & 15, XC, DT, Z, args.in[11], args.in[12], YQ, SSQ, ldsp, tid, lane, wave);
#endif
    }
    SEAM(4);

    if (IN(5)) REP(5) {
        PH_IDS();
        pg8::Sched2 S; S.init(G, bx);
        LAS float* rt = (LAS float*)(ldsp + RSTD_OFF);
        { pg8::Unit u; for (int i = 0; i < 4 && S.next(i, u); ++i) if (tid < 256) { const float* q = SSQ + ((size_t)u.pm * 256 + tid) * 16; float s = 0.f;
#pragma unroll
                for (int j = 0; j < 16; ++j) s += q[j];
                rt[i * 256 + tid] = rsqrtf(s * (1.f / 1024.f) + EPS); } }
        __syncthreads();
        pg8::Gemm g{YQ, bt2, ML, 1024, 2048};
        pg8::Epi2 E{args.in[0], mod, args.in[17], args.out, (unsigned long long*)RPART, (unsigned*)(ctl + CW_CNT), (unsigned*)(ctl + CW_TMO2), (const LAS float*)rt, (LAS float*)(ldsp + EXL_OFF)};
        pg8::gemm_phase<pg8::Epi2, pg8::Sched2, true, true>(ldsp + RING_OFF, g, S, E, wave);
    }

#undef IN
#undef SEAM
}

extern "C" void kernel_launch(void* const* d_in, const int* in_sizes, int n_in, void* d_out, int out_size, void* d_ws, size_t ws_size, hipStream_t stream) {
    if (n_in != 18 || out_size != ML * DM || ws_size < WS_END) { fprintf(stderr, "kernel_launch: unexpected shapes (n_in %d out %d ws %zu); nothing launched\n", n_in, out_size, ws_size); return; }
    static int grid = 0;
    if (grid == 0) {
        int dev = 0, cus = 0;
        if (hipGetDevice(&dev) != hipSuccess || hipDeviceGetAttribute(&cus, hipDeviceAttributeMultiprocessorCount, dev) != hipSuccess) { fprintf(stderr, "kernel_launch: device query failed\n"); grid = -1; return; }
        if (hipFuncSetAttribute((const void*)mega, hipFuncAttributeMaxDynamicSharedMemorySize, LDS_BYTES) != hipSuccess) { fprintf(stderr, "kernel_launch: hipFuncSetAttribute failed\n"); grid = -1; return; }
        int per_cu = 0;
        if (hipOccupancyMaxActiveBlocksPerMultiprocessor(&per_cu, (const void*)mega, NWAVES * 64, LDS_BYTES) != hipSuccess || per_cu < 1) fprintf(stderr, "kernel_launch: note: occupancy query says %d blocks/CU\n", per_cu);
        (void)hipGetLastError();
        grid = cus;
    }
    if (grid < 0) return;
    (void)hipMemsetAsync((unsigned char*)d_ws + WS_CTL, 0, 1 * MiB, stream);
    Args a{};
    for (int i = 0; i < 18; ++i) a.in[i] = (const float*)d_in[i];
    a.out = (float*)d_out; a.ws = (unsigned char*)d_ws; a.ph_lo = 0; a.ph_hi = NPHASE;
    hipLaunchKernelGGL(mega, dim3(grid), dim3(NWAVES * 64), LDS_BYTES, stream, a);
    const hipError_t le = hipPeekAtLastError(); if (le != hipSuccess) fprintf(stderr, "kernel_launch: launch failed: %s\n", hipGetErrorName(le));
}
```

```cpp
#include <hip/hip_runtime.h>
#include <cstdio>
#include <cstdint>
#include <hip/hip_bf16.h>

constexpr int DM = 1024, NB = 32, SEQ = 2048, CTXL = 256, KVL = SEQ + CTXL;
constexpr int ML = NB * SEQ, MC = NB * CTXL, MT = ML + MC;
constexpr int PROJ = 5152, OFF_XBC = 512, OFF_DT = 2048, CTXC = 2080, CONVC = 1536;
constexpr int N1 = 21 * 256;
constexpr float EPS = 1e-6f;
constexpr float C2 = 0.125f * 1.4426950408889634f;

typedef unsigned short bf16;
__device__ __forceinline__ int mk_lane() { return (int)__builtin_amdgcn_mbcnt_hi(~0u, __builtin_amdgcn_mbcnt_lo(~0u, 0u)); }
__host__ __device__ __forceinline__ unsigned f2bf(float f) { unsigned u = __builtin_bit_cast(unsigned, f); return (u + 0x7fffu + ((u >> 16) & 1u)) >> 16; }
__host__ __device__ __forceinline__ float bf2f(unsigned h) { return __builtin_bit_cast(float, (h & 0xffffu) << 16); }
__device__ __forceinline__ float siluf(float v) { return v / (1.f + __expf(-v)); }
__device__ __forceinline__ float softplusf(float v) { return v > 20.f ? v : log1pf(expf(v)); }

constexpr size_t MiB = 1u << 20;
constexpr size_t WS_CTL = 0;
constexpr size_t WS_MOD = 2 * MiB;
constexpr size_t WS_ROPE = 3 * MiB;
constexpr size_t WS_SSQ = 4 * MiB;
constexpr size_t WS_RPART = 8 * MiB;
constexpr size_t WS_BT1 = 12 * MiB;
constexpr size_t WS_BT2 = 23 * MiB;
constexpr size_t WS_DT = 28 * MiB;
constexpr size_t WS_KB = 38 * MiB;
constexpr size_t WS_VB = 74 * MiB;
constexpr size_t WS_R1 = 110 * MiB;
constexpr size_t WS_XBC = 326 * MiB;
constexpr size_t WS_YQ = 542 * MiB;
constexpr size_t WS_Z = 798 * MiB;
constexpr size_t WS_END = 926 * MiB;

__host__ __device__ __forceinline__ int hperm_dim(int vin) {
    const int bj = vin >> 7, wc = (vin >> 5) & 3, s = vin & 31, fq = s >> 3, e = s & 7;
    return wc * 64 + bj * 32 + (e >> 2) * 16 + 4 * fq + (e & 3);
}
__host__ __device__ __forceinline__ int hperm_inv(int head, int dim) {
    const int axis = dim >> 5, half = (dim >> 4) & 1, i16 = dim & 15, fq = i16 >> 2, e = (i16 & 3) + 4 * half;
    return 128 * axis + 32 * head + 8 * fq + e;
}
__host__ __device__ __forceinline__ int vcol_actual(int v) {
    const int t = v >> 8, vin = v & 255;
    if (t == 0) return hperm_dim(vin);
    const int pv = 64 * ((vin >> 5) & 3) + 32 * (vin >> 7) + (vin & 31);
    if (t == 1) return 256 + pv;
    if (t < 8) return t * 256 + pv;
    if (t == 8) return vin < 32 ? OFF_DT + vin : -1;
    if (t < 13) return CTXC + (t - 9) * 256 + hperm_dim(vin);
    if (t < 17) return CTXC + 1024 + (t - 13) * 256 + pv;
    return CTXC + 2048 + (t - 17) * 256 + pv;
}

namespace pg8 {
#define PG8_LAS __attribute__((address_space(3)))
typedef unsigned short bf16_t;
typedef short bf16x8 __attribute__((ext_vector_type(8)));
typedef float f32x4 __attribute__((ext_vector_type(4)));
typedef unsigned u32x4 __attribute__((ext_vector_type(4)));
constexpr int BM = 256, BK = 64, HALF = 128, HTB = HALF * BK * 2  , STAGE_BYTES = 8 * HTB, NXCD = 8, WGM = 8;

__host__ __device__ __forceinline__ int lds_byte(int r, int c) { const int st = (r >> 4) * 2 + (c >> 5), rr = r & 15, cc = c & 31, ob = rr * 64 + cc * 2; return st * 1024 + (ob ^ (((ob >> 9) & 1) << 5)); }
__host__ __device__ __forceinline__ void stage_rc(int b, int& R, int& C) { const int st = b / 1024, sb = b % 1024, swz = sb ^ (((sb >> 9) & 1) << 5); R = (st >> 1) * 16 + swz / 64; C = (st & 1) * 32 + (swz % 64) / 2; }
__host__ __device__ __forceinline__ int perm32(int rho) { const int n = rho >> 4, i = rho & 15; return 8 * (i >> 2) + 4 * n + (i & 3); }

struct Unit { int pm, pn; };
struct Gemm { const bf16_t* A; const bf16_t* Bt; int M, N, K; };

__device__ __forceinline__ unsigned cvt_pk_bf16(float lo, float hi) { unsigned r; asm volatile("v_cvt_pk_bf16_f32 %0, %1, %2" : "=v"(r) : "v"(lo), "v"(hi)); return r; }
typedef float f32x2 __attribute__((ext_vector_type(2)));
template <class Epi, class Sched, bool ALIGN_EPI = false, bool SP2 = false>
__device__ __forceinline__ void gemm_phase(PG8_LAS unsigned char* lds, const Gemm g, const Sched& S, const Epi& E, int wid_in) {
    const int wid = wid_in; int lane = mk_lane(); asm volatile("" : "+v"(lane)); const int tid = wid * 64 + lane, wr = wid >> 2, wc = wid & 3, fr = lane & 15, fq = lane >> 4;
    const int K = g.K, nt = K / BK;
    unsigned voffA[2], voffB[2];
#pragma unroll
    for (int i = 0; i < 2; ++i) { int R, C; stage_rc(tid * 16 + i * 8192, R, C); const int Rb = Epi::PERM ? ((R & ~31) + perm32(R & 31)) : R;
        voffA[i] = (unsigned)(R * K + C) * 2u; voffB[i] = (unsigned)(Rb * K + C) * 2u; }
    const size_t kstep = (size_t)(BK * 2);
    const size_t hstep = (size_t)HALF * K * 2;
    const size_t tstep = 2 * hstep;
    const unsigned ldsw = (unsigned)wid * 1024u;
    const int aoff = lds_byte(wr * 64 + fr, fq * 8), boff = lds_byte(wc * 32 + fr, fq * 8);
#define PG8_SA(b, h) (((b) * 2 + (h)) * HTB)
#define PG8_SB(b, h) ((4 + (b) * 2 + (h)) * HTB)
#define PG8_STAGE(bufoff, gbase, voff) do { _Pragma("unroll") for (int _i = 0; _i < 2; ++_i) \
        __builtin_amdgcn_global_load_lds((const unsigned*)((const char*)(gbase) + (voff)[_i]), (PG8_LAS unsigned*)(lds + (bufoff) + ldsw + _i * 8192), 16, 0, 0); } while (0)
#define PG8_LDA(dst, b, h) do { _Pragma("unroll") for (int m = 0; m < 4; ++m) _Pragma("unroll") for (int k = 0; k < 2; ++k) dst[m][k] = *(const PG8_LAS bf16x8*)(lds + PG8_SA(b, h) + aoff + m * 2048 + k * 1024); } while (0)
#define PG8_LDB(dst, b, h) do { _Pragma("unroll") for (int n = 0; n < 2; ++n) _Pragma("unroll") for (int k = 0; k < 2; ++k) dst[n][k] = *(const PG8_LAS bf16x8*)(lds + PG8_SB(b, h) + boff + n * 2048 + k * 1024); } while (0)
#define PG8_MMA(ai, bj, At, Bt) do { __builtin_amdgcn_s_setprio(1); _Pragma("unroll") for (int m = 0; m < 4; ++m) _Pragma("unroll") for (int n = 0; n < 2; ++n) _Pragma("unroll") for (int k = 0; k < 2; ++k) \
        acc[ai][bj][m][n] = __builtin_amdgcn_mfma_f32_16x16x32_bf16(Bt[n][k], At[m][k], acc[ai][bj][m][n], 0, 0, 0); __builtin_amdgcn_s_setprio(0); } while (0)
#define PG8_WAIT_V(n) asm volatile("s_waitcnt vmcnt(" #n ")" ::: "memory")
#define PG8_WAIT_L(n) asm volatile("s_waitcnt lgkmcnt(" #n ")" ::: "memory")
#define PG8_BAR __builtin_amdgcn_s_barrier()
#define PG8_SCHED __builtin_amdgcn_sched_barrier(0)
    Unit cur, nxt; int ui = 0;
    if (!S.next(0, cur)) return;
    f32x4 acc[2][2][4][2];
#pragma unroll
    for (int a = 0; a < 2; ++a)
#pragma unroll
        for (int b = 0; b < 2; ++b)
#pragma unroll
            for (int m = 0; m < 4; ++m)
#pragma unroll
                for (int n = 0; n < 2; ++n) acc[a][b][m][n] = (f32x4){0.f, 0.f, 0.f, 0.f};
    bf16x8 At[4][2], B0[2][2], B1[2][2];
    const char* cA = (const char*)g.A + (size_t)cur.pm * tstep; const char* cB = (const char*)g.Bt + (size_t)cur.pn * tstep;
    S.a_ready(cur);
    if constexpr (SP2) {
        PG8_STAGE(PG8_SB(0, 0), cB, voffB); PG8_STAGE(PG8_SB(0, 1), cB + hstep, voffB); PG8_STAGE(PG8_SA(0, 0), cA, voffA); PG8_STAGE(PG8_SA(0, 1), cA + hstep, voffA);
        if (wr == 1) PG8_BAR;
        PG8_WAIT_V(2); PG8_BAR;
        PG8_STAGE(PG8_SB(1, 0), cB + kstep, voffB); PG8_STAGE(PG8_SA(1, 0), cA + kstep, voffA); PG8_STAGE(PG8_SB(1, 1), cB + hstep + kstep, voffB);
        PG8_WAIT_V(6); PG8_BAR;
    } else {
        PG8_STAGE(PG8_SB(0, 0), cB, voffB); PG8_STAGE(PG8_SA(0, 0), cA, voffA); PG8_STAGE(PG8_SB(0, 1), cB + hstep, voffB); PG8_STAGE(PG8_SA(0, 1), cA + hstep, voffA);
        if (wr == 1) PG8_BAR;
        PG8_WAIT_V(4); PG8_BAR;
        PG8_STAGE(PG8_SB(1, 0), cB + kstep, voffB); PG8_STAGE(PG8_SA(1, 0), cA + kstep, voffA); PG8_STAGE(PG8_SB(1, 1), cB + hstep + kstep, voffB);
        PG8_WAIT_V(6); PG8_BAR;
    }
    for (;;) {
        const bool has_next = S.next(ui + 1, nxt);
        const char* nA = has_next ? (const char*)g.A + (size_t)nxt.pm * tstep : cA; const char* nB = has_next ? (const char*)g.Bt + (size_t)nxt.pn * tstep : cB;
        for (int t = 0; t < nt; t += 2) {
            if constexpr (Epi::MIDK) { if (t == nt / 2) E.midk(acc, ui, wr, fr); }
            const bool last = (t == nt - 2);
            const char* a1 = cA + (size_t)(t + 1) * kstep;
            const char* a2 = last ? nA : cA + (size_t)(t + 2) * kstep; const char* b2 = last ? nB : cB + (size_t)(t + 2) * kstep;
            const char* a3 = a2 + kstep; const char* b3 = b2 + kstep;
            if (last && has_next) S.a_ready(nxt);
            if constexpr (SP2) {
            PG8_LDB(B0, 0, 0); PG8_LDB(B1, 0, 1); PG8_SCHED; PG8_LDA(At, 0, 0); PG8_STAGE(PG8_SA(1, 1), a1 + hstep, voffA);
            PG8_WAIT_V(8); PG8_WAIT_L(0); PG8_BAR; PG8_MMA(0, 0, At, B0); PG8_MMA(0, 1, At, B1); PG8_BAR; PG8_SCHED;
            PG8_LDA(At, 0, 1); PG8_STAGE(PG8_SB(0, 0), b2, voffB); PG8_STAGE(PG8_SB(0, 1), b2 + hstep, voffB); PG8_STAGE(PG8_SA(0, 0), a2, voffA);
            PG8_WAIT_V(8); PG8_WAIT_L(0); PG8_BAR; PG8_MMA(1, 0, At, B0); PG8_MMA(1, 1, At, B1); PG8_BAR; PG8_SCHED;
            PG8_LDB(B0, 1, 0); PG8_LDB(B1, 1, 1); PG8_SCHED; PG8_LDA(At, 1, 0); PG8_STAGE(PG8_SA(0, 1), a2 + hstep, voffA);
            PG8_WAIT_V(8); PG8_WAIT_L(0); PG8_BAR; PG8_MMA(0, 0, At, B0); PG8_MMA(0, 1, At, B1); PG8_BAR; PG8_SCHED;
            PG8_LDA(At, 1, 1); PG8_STAGE(PG8_SB(1, 0), b3, voffB); PG8_STAGE(PG8_SB(1, 1), b3 + hstep, voffB); PG8_STAGE(PG8_SA(1, 0), a3, voffA);
            PG8_WAIT_V(8); PG8_WAIT_L(0); PG8_BAR; PG8_MMA(1, 0, At, B0); PG8_MMA(1, 1, At, B1); PG8_BAR; PG8_SCHED;
            } else {
            PG8_LDB(B0, 0, 0); PG8_SCHED; PG8_LDA(At, 0, 0); PG8_STAGE(PG8_SA(1, 1), a1 + hstep, voffA);
            PG8_WAIT_L(8); PG8_BAR; PG8_WAIT_L(0); PG8_MMA(0, 0, At, B0); PG8_BAR; PG8_SCHED;
            PG8_LDB(B1, 0, 1); PG8_STAGE(PG8_SB(0, 0), b2, voffB);
            PG8_BAR; PG8_WAIT_L(0); PG8_MMA(0, 1, At, B1); PG8_BAR;
            PG8_LDA(At, 0, 1); PG8_STAGE(PG8_SA(0, 0), a2, voffA);
            PG8_BAR; PG8_WAIT_L(0); PG8_MMA(1, 0, At, B0); PG8_BAR; PG8_SCHED;
            PG8_STAGE(PG8_SB(0, 1), b2 + hstep, voffB);
            PG8_WAIT_V(6); PG8_BAR; PG8_MMA(1, 1, At, B1); PG8_BAR;
            PG8_LDB(B0, 1, 0); PG8_SCHED; PG8_LDA(At, 1, 0); PG8_STAGE(PG8_SA(0, 1), a2 + hstep, voffA);
            PG8_WAIT_L(8); PG8_BAR; PG8_WAIT_L(0); PG8_MMA(0, 0, At, B0); PG8_BAR; PG8_SCHED;
            PG8_LDB(B1, 1, 1); PG8_STAGE(PG8_SB(1, 0), b3, voffB);
            PG8_BAR; PG8_WAIT_L(0); PG8_MMA(0, 1, At, B1); PG8_BAR;
            PG8_LDA(At, 1, 1); PG8_STAGE(PG8_SA(1, 0), a3, voffA);
            PG8_BAR; PG8_WAIT_L(0); PG8_MMA(1, 0, At, B0); PG8_BAR; PG8_SCHED;
            PG8_STAGE(PG8_SB(1, 1), b3 + hstep, voffB);
            PG8_WAIT_V(6); PG8_BAR; PG8_MMA(1, 1, At, B1); PG8_BAR;
            }
        }
        if constexpr (ALIGN_EPI) { if (wr == 0) PG8_BAR; }
        if constexpr (!Epi::AFTER_DRAIN) { E(acc, cur, wr, wc, fr, fq); S.done(cur); }
        if (!has_next) break;
#pragma unroll
        for (int a = 0; a < 2; ++a)
#pragma unroll
            for (int b = 0; b < 2; ++b)
#pragma unroll
                for (int m = 0; m < 4; ++m)
#pragma unroll
                    for (int n = 0; n < 2; ++n) acc[a][b][m][n] = (f32x4){0.f, 0.f, 0.f, 0.f};
        cur = nxt; cA = nA; cB = nB; ++ui;
        if constexpr (ALIGN_EPI) { if (wr == 1) PG8_BAR; }
    }
    PG8_WAIT_V(0);
    if constexpr (!ALIGN_EPI) { if (wr == 0) PG8_BAR; }
    PG8_BAR;
    if constexpr (Epi::AFTER_DRAIN) { E.fused(acc, cur, wr, wc, fr, fq, lds, wid, lane); S.done(cur); }
#undef PG8_SA
#undef PG8_SB
#undef PG8_STAGE
#undef PG8_LDA
#undef PG8_LDB
#undef PG8_MMA
#undef PG8_WAIT_V
#undef PG8_WAIT_L
#undef PG8_BAR
#undef PG8_SCHED
}
struct Sched1 {
    int G, c;
    __device__ __forceinline__ void init(int G_, int c_) { G = G_; c = c_; }
    __device__ __forceinline__ bool next(int i, Unit& u) const {
        constexpr int nN = 21, nwg = 256 * nN;
        const int L = i * G + c;
        if (L < nwg) { const int wgid = (L % NXCD) * (nwg / NXCD) + L / NXCD; const int nig = WGM * nN, fm = (wgid / nig) * WGM;
            u.pm = fm + ((wgid % nig) % WGM); u.pn = (wgid % nig) / WGM; return true; }
        const int L2 = L - nwg; if (L2 >= 256) return false;
        const int wg = (L2 % NXCD) * 32 + L2 / NXCD; u.pn = wg >> 5; u.pm = 256 + (wg & 31); return true;
    }
    __device__ __forceinline__ void a_ready(const Unit&) const {}
    __device__ __forceinline__ void done(const Unit&) const {}
};
struct Sched2 {
    int G, c;
    __device__ __forceinline__ void init(int G_, int c_) { G = G_; c = c_; }
    __device__ __forceinline__ bool next(int i, Unit& u) const {
        constexpr int nN = 4, nwg = 256 * nN;
        const int L = i * G + c; if (L >= nwg) return false;
        const int wgid = (L % NXCD) * (nwg / NXCD) + L / NXCD; const int nig = WGM * nN, fm = (wgid / nig) * WGM;
        u.pm = fm + ((wgid % nig) % WGM); u.pn = (wgid % nig) / WGM; return true;
    }
    __device__ __forceinline__ void a_ready(const Unit&) const {}
    __device__ __forceinline__ void done(const Unit&) const {}
};
__device__ __forceinline__ float dot4(const f32x4 a) { return (a[0] * a[0] + a[1] * a[1]) + (a[2] * a[2] + a[3] * a[3]); }
__device__ __forceinline__ float silu1(float v) { return v * __builtin_amdgcn_rcpf(1.f + __expf(-v)); }
typedef unsigned u32x2 __attribute__((ext_vector_type(2)));
__device__ __forceinline__ u32x2 pk4(const f32x4 v) { u32x2 w; w.x = cvt_pk_bf16(v[0], v[1]); w.y = cvt_pk_bf16(v[2], v[3]); return w; }
struct Epi1 {
    static constexpr bool PERM = true, AFTER_DRAIN = false, MIDK = false;
    bf16_t *KB, *VB, *XBC, *YQ, *Z; float* DT; const float *rope, *qg, *kg, *dt_bias; PG8_LAS unsigned char* stage;
    __device__ __forceinline__ void midk(f32x4 (&)[2][2][4][2], int, int, int) const {}
    __device__ __forceinline__ void operator()(const f32x4 (&acc)[2][2][4][2], const Unit& u, int wr, int wc, int fr_in, int fq_in) const {
        int fr = fr_in, fq = fq_in; asm volatile("" : "+v"(fr), "+v"(fq));
        const int pn = u.pn, pm = u.pm; const bool isctx = pm >= 256; const int rloc = wr * 64 + fr;
        const int bb = isctx ? pm - 256 : pm >> 3, pos0 = isctx ? SEQ : (pm & 7) * 256;
        if (pn == 0 || (pn >= 9 && pn < 13)) {
            const float* g = pn == 0 ? kg : qg;
            const f32x4 g00 = *(const f32x4*)(g + 4 * fq), g01 = *(const f32x4*)(g + 16 + 4 * fq), g10 = *(const f32x4*)(g + 32 + 4 * fq), g11 = *(const f32x4*)(g + 48 + 4 * fq);
            const float osc = pn == 0 ? 1.f : C2;
            bf16_t* dbase; size_t pitch;
            if (pn == 0) { dbase = KB + ((size_t)bb * KVL + pos0) * 256 + wc * 64; pitch = 256; }
            else { dbase = YQ + (size_t)pm * 256 * 2048 + 1024 + ((pn - 9) * 4 + wc) * 64; pitch = 2048; }
            PG8_LAS unsigned char* stg = stage + (wr * 4 + wc) * 2048; const int lane_ = fr + 16 * fq, r8 = lane_ >> 3, c8 = lane_ & 7;
#pragma unroll
            for (int ai = 0; ai < 2; ++ai) {
                const int prow = (pm & 7) * 4 + 2 * ai + wr;
                f32x4 c0 = (f32x4){1.f, 1.f, 1.f, 1.f}, s0 = (f32x4){0.f, 0.f, 0.f, 0.f};
                if (!isctx) { c0 = *(const f32x4*)(rope + prow * 16 + 4 * fq); s0 = *(const f32x4*)(rope + 1024 + prow * 16 + 4 * fq); }
#pragma unroll
                for (int m = 0; m < 4; ++m) {
                    f32x4 a0 = acc[ai][0][m][0], a1 = acc[ai][0][m][1], b0 = acc[ai][1][m][0], b1 = acc[ai][1][m][1];
                    float s = (dot4(a0) + dot4(a1)) + (dot4(b0) + dot4(b1));
                    s += __shfl_xor(s, 16); s += __shfl_xor(s, 32);
                    const float rstd = rsqrtf(s * (1.f / 64.f) + EPS) * osc;
                    a0 = a0 * rstd * g00; a1 = a1 * rstd * g01; b0 = b0 * rstd * g10; b1 = b1 * rstd * g11;
                    f32x4 c1 = (f32x4){1.f, 1.f, 1.f, 1.f}, s1 = (f32x4){0.f, 0.f, 0.f, 0.f};
                    if (!isctx) { const int pcol = 16 * m + fr; c1 = *(const f32x4*)(rope + pcol * 16 + 4 * fq); s1 = *(const f32x4*)(rope + 1024 + pcol * 16 + 4 * fq); }
                    const f32x4 o00 = a0 * c0 - a1 * s0, o01 = a1 * c0 + a0 * s0, o10 = b0 * c1 - b1 * s1, o11 = b1 * c1 + b0 * s1;
                    { PG8_LAS unsigned char* sp = stg + fr * 128 + (fq & 1) * 8; const int k7 = fr & 7, cq = fq >> 1;
                      *(PG8_LAS u32x2*)(sp + (((0 + cq) ^ k7) << 4)) = pk4(o00); *(PG8_LAS u32x2*)(sp + (((2 + cq) ^ k7) << 4)) = pk4(o01); *(PG8_LAS u32x2*)(sp + (((4 + cq) ^ k7) << 4)) = pk4(o10); *(PG8_LAS u32x2*)(sp + (((6 + cq) ^ k7) << 4)) = pk4(o11); }
                    bf16_t* rowp = dbase + (size_t)(wr * 64 + 128 * ai + 16 * m) * pitch + 8 * c8;
#pragma unroll
                    for (int ps = 0; ps < 2; ++ps) { const int r = 8 * ps + r8; const u32x4 w = *(const PG8_LAS u32x4*)(stg + r * 128 + ((c8 ^ (r & 7)) << 4)); *(u32x4*)(rowp + (size_t)r * pitch) = w; }
                    asm volatile("" ::: "memory");
                }
            }
        } else if (pn == 8) {
            if (wc == 0) {
                const f32x4 bA = *(const f32x4*)(dt_bias + 8 * fq), bB = *(const f32x4*)(dt_bias + 8 * fq + 4);
#pragma unroll
                for (int ai = 0; ai < 2; ++ai)
#pragma unroll
                    for (int m = 0; m < 4; ++m) { const size_t row = (size_t)pm * 256 + rloc + 128 * ai + 16 * m;
                        f32x4 v0 = acc[ai][0][m][0] + bA, v1 = acc[ai][0][m][1] + bB;
#pragma unroll
                        for (int e = 0; e < 4; ++e) { v0[e] = v0[e] > 20.f ? v0[e] : log1pf(__expf(v0[e])); v1[e] = v1[e] > 20.f ? v1[e] : log1pf(__expf(v1[e])); }
                        *(f32x4*)(DT + row * 32 + 8 * fq) = v0; *(f32x4*)(DT + row * 32 + 8 * fq + 4) = v1; asm volatile("" ::: "memory"); }
            }
        } else {
            bf16_t* dbase; size_t pitch; bool act = false;
            const int cin = wc * 64;
            if (pn == 1) { dbase = VB + ((size_t)bb * KVL + pos0) * 256 + cin; pitch = 256; }
            else if (pn < 8) { dbase = XBC + (size_t)pm * 256 * CONVC + (pn - 2) * 256 + cin; pitch = CONVC; }
            else if (pn < 17) { dbase = YQ + (size_t)pm * 256 * 2048 + (pn - 13) * 256 + cin; pitch = 2048; act = true; }
            else { dbase = Z + (size_t)pm * 256 * 1024 + (pn - 17) * 256 + cin; pitch = 1024; act = true; }
            PG8_LAS unsigned char* stg = stage + (wr * 4 + wc) * 2048;
            const int lane = fr + 16 * fq, r8 = lane >> 3, c8 = lane & 7;
#pragma unroll
            for (int ai = 0; ai < 2; ++ai)
#pragma unroll
                for (int m = 0; m < 4; ++m) {
#pragma unroll
                    for (int bj = 0; bj < 2; ++bj) { f32x4 v0 = acc[ai][bj][m][0], v1 = acc[ai][bj][m][1];
                        if (act) {
#pragma unroll
                            for (int e = 0; e < 4; ++e) { v0[e] = silu1(v0[e]); v1[e] = silu1(v1[e]); } }
                        u32x4 w; w.x = cvt_pk_bf16(v0[0], v0[1]); w.y = cvt_pk_bf16(v0[2], v0[3]); w.z = cvt_pk_bf16(v1[0], v1[1]); w.w = cvt_pk_bf16(v1[2], v1[3]);
                        *(PG8_LAS u32x4*)(stg + fr * 128 + (((4 * bj + fq) ^ (fr & 7)) << 4)) = w; }
                    bf16_t* rowp = dbase + (size_t)(wr * 64 + 128 * ai + 16 * m) * pitch + 8 * c8;
#pragma unroll
                    for (int ps = 0; ps < 2; ++ps) { const int r = 8 * ps + r8; const u32x4 w = *(const PG8_LAS u32x4*)(stg + r * 128 + ((c8 ^ (r & 7)) << 4)); *(u32x4*)(rowp + (size_t)r * pitch) = w; }
                    asm volatile("" ::: "memory"); }
        }
    }
};
struct EpiNull {
    static constexpr bool PERM = true, AFTER_DRAIN = false, MIDK = false;
    __device__ __forceinline__ void midk(f32x4 (&)[2][2][4][2], int, int, int) const {}
    __device__ __forceinline__ void operator()(const f32x4 (&acc)[2][2][4][2], const Unit&, int, int, int, int) const {
#pragma unroll
        for (int ai = 0; ai < 2; ++ai)
#pragma unroll
            for (int bj = 0; bj < 2; ++bj)
#pragma unroll
                for (int m = 0; m < 4; ++m) { asm volatile("" :: "v"(acc[ai][bj][m][0]), "v"(acc[ai][bj][m][1])); } }
};
struct EpiPlainReal {
    static constexpr bool PERM = true, AFTER_DRAIN = false, MIDK = false;
    bf16_t *KB, *VB, *XBC, *YQ, *Z; float* DT;
    __device__ __forceinline__ void midk(f32x4 (&)[2][2][4][2], int, int, int) const {}
    __device__ __forceinline__ void operator()(const f32x4 (&acc)[2][2][4][2], const Unit& u, int wr, int wc, int fr_in, int fq_in) const {
        int fr = fr_in, fq = fq_in; asm volatile("" : "+v"(fr), "+v"(fq));
        const int pn = u.pn, pm = u.pm; const bool isctx = pm >= 256; const int rloc = wr * 64 + fr;
        const int bb = isctx ? pm - 256 : pm >> 3, pos0 = isctx ? SEQ : (pm & 7) * 256;
        bf16_t* dbase; size_t pitch; const int cin = wc * 32 + 8 * fq;
        if (pn == 0) { dbase = KB + ((size_t)bb * KVL + pos0) * 256 + cin; pitch = 256; }
        else if (pn == 1) { dbase = VB + ((size_t)bb * KVL + pos0) * 256 + cin; pitch = 256; }
        else if (pn < 8) { dbase = XBC + (size_t)pm * 256 * CONVC + (pn - 2) * 256 + cin; pitch = CONVC; }
        else if (pn == 8) { dbase = (bf16_t*)DT + (size_t)pm * 256 * 64 + (cin & 31); pitch = 64; }
        else if (pn < 13) { dbase = YQ + (size_t)pm * 256 * 2048 + 1024 + (pn - 9) * 256 + cin; pitch = 2048; }
        else if (pn < 17) { dbase = YQ + (size_t)pm * 256 * 2048 + (pn - 13) * 256 + cin; pitch = 2048; }
        else { dbase = Z + (size_t)pm * 256 * 1024 + (pn - 17) * 256 + cin; pitch = 1024; }
#pragma unroll
        for (int ai = 0; ai < 2; ++ai)
#pragma unroll
            for (int m = 0; m < 4; ++m) { bf16_t* dst = dbase + (size_t)(rloc + 128 * ai + 16 * m) * pitch;
#pragma unroll
                for (int bj = 0; bj < 2; ++bj) { const f32x4 v0 = acc[ai][bj][m][0], v1 = acc[ai][bj][m][1];
                    u32x4 w; w.x = cvt_pk_bf16(v0[0], v0[1]); w.y = cvt_pk_bf16(v0[2], v0[3]); w.z = cvt_pk_bf16(v1[0], v1[1]); w.w = cvt_pk_bf16(v1[2], v1[3]);
                    *(u32x4*)(dst + (pn == 8 ? 0 : bj * HALF)) = w; } asm volatile("" ::: "memory"); }
    }
};
struct Epi2 {
    static constexpr bool PERM = false, AFTER_DRAIN = false, MIDK = true;
    const float* x; const float* mod; const float* fg; float* out; unsigned long long* xbuf; unsigned* cnt; unsigned* tmo; const PG8_LAS float* rstd_tab; PG8_LAS float* exl;
    __device__ __forceinline__ void midk(f32x4 (&acc)[2][2][4][2], int ui, int wr, int fr) const {
#pragma unroll
        for (int ai = 0; ai < 2; ++ai)
#pragma unroll
            for (int m = 0; m < 4; ++m) { const float r = rstd_tab[ui * 256 + 128 * ai + 64 * wr + 16 * m + fr];
#pragma unroll
                for (int bj = 0; bj < 2; ++bj)
#pragma unroll
                    for (int n = 0; n < 2; ++n) acc[ai][bj][m][n] *= r; }
    }
    __device__ __forceinline__ void operator()(f32x4 (&acc)[2][2][4][2], const Unit& u, int wr, int wc, int fr_in, int fq_in) const {
        int fr = fr_in, fq = fq_in; asm volatile("" : "+v"(fr), "+v"(fq));
        const int lane = mk_lane(); const int tid = (wr * 4 + wc) * 64 + lane;
        const int b = u.pm >> 3, col0 = u.pn * BM + wc * 32 + 4 * fq;
        PG8_LAS float* P = exl; PG8_LAS float* S = exl + 1024;
        { f32x4 gv[2][2];
#pragma unroll
          for (int bj = 0; bj < 2; ++bj)
#pragma unroll
            for (int n = 0; n < 2; ++n) gv[bj][n] = *(const f32x4*)(mod + (size_t)b * 3072 + 2048 + col0 + bj * HALF + n * 16);
#pragma unroll
          for (int ai = 0; ai < 2; ++ai)
#pragma unroll
            for (int m = 0; m < 4; ++m) { const int rt = 128 * ai + 64 * wr + 16 * m + fr; const size_t off = ((size_t)u.pm * BM + rt) * 1024 + col0; float q = 0.f;
#pragma unroll
                for (int bj = 0; bj < 2; ++bj)
#pragma unroll
                    for (int n = 0; n < 2; ++n) { const f32x4 xv = *(const f32x4*)(x + off + bj * HALF + n * 16); const f32x4 o = xv + gv[bj][n] * acc[ai][bj][m][n]; acc[ai][bj][m][n] = o; q += dot4(o); }
                q += __shfl_xor(q, 16); q += __shfl_xor(q, 32);
                if (fq == 0) P[rt * 4 + wc] = q;
                if (m == 3) asm volatile("" ::: "memory"); } }
        asm volatile("s_waitcnt lgkmcnt(0)" ::: "memory"); __builtin_amdgcn_s_barrier(); asm volatile("" ::: "memory");
        if (tid < 256) {
            const f32x4 p = *(const PG8_LAS f32x4*)(P + tid * 4); const float s = (p[0] + p[1]) + (p[2] + p[3]);
            __hip_atomic_store((float*)xbuf + ((size_t)u.pm * BM + tid) * 4 + u.pn, s, __ATOMIC_RELAXED, __HIP_MEMORY_SCOPE_AGENT);
        }
        asm volatile("s_waitcnt vmcnt(0)" ::: "memory");
        if (tid < 256 && lane == 0) __hip_atomic_fetch_add(cnt + 64 * u.pm, 1u, __ATOMIC_RELAXED, __HIP_MEMORY_SCOPE_AGENT);
        if (tid < 64) {
            unsigned sp = 0;
            while ((unsigned)__builtin_amdgcn_readfirstlane(__hip_atomic_load(cnt + 64 * u.pm, __ATOMIC_RELAXED, __HIP_MEMORY_SCOPE_AGENT)) < 16u) {
                __builtin_amdgcn_s_sleep(2); if (++sp > (1u << 22)) { if (lane == 0) __hip_atomic_store(tmo, 1u, __ATOMIC_RELAXED, __HIP_MEMORY_SCOPE_AGENT); break; } }
        }
        asm volatile("s_waitcnt vmcnt(0) lgkmcnt(0)" ::: "memory"); __builtin_amdgcn_s_barrier(); asm volatile("" ::: "memory");
        if (tid < 256) {
            const unsigned long long* sl = xbuf + ((size_t)u.pm * BM + tid) * 2;
            const unsigned long long w0 = __hip_atomic_load(sl, __ATOMIC_RELAXED, __HIP_MEMORY_SCOPE_AGENT), w1 = __hip_atomic_load(sl + 1, __ATOMIC_RELAXED, __HIP_MEMORY_SCOPE_AGENT);
            const float s = (__uint_as_float((unsigned)w0) + __uint_as_float((unsigned)(w0 >> 32))) + (__uint_as_float((unsigned)w1) + __uint_as_float((unsigned)(w1 >> 32)));
            S[tid] = rsqrtf(s * (1.f / 1024.f) + EPS);
        }
        asm volatile("s_waitcnt lgkmcnt(0)" ::: "memory"); __builtin_amdgcn_s_barrier(); asm volatile("" ::: "memory");
        { f32x4 fv[2][2];
#pragma unroll
          for (int bj = 0; bj < 2; ++bj)
#pragma unroll
            for (int n = 0; n < 2; ++n) fv[bj][n] = *(const f32x4*)(fg + col0 + bj * HALF + n * 16);
#pragma unroll
          for (int ai = 0; ai < 2; ++ai)
#pragma unroll
            for (int m = 0; m < 4; ++m) { const int rt = 128 * ai + 64 * wr + 16 * m + fr; const size_t off = ((size_t)u.pm * BM + rt) * 1024 + col0; const float r = S[rt];
#pragma unroll
                for (int bj = 0; bj < 2; ++bj)
#pragma unroll
                    for (int n = 0; n < 2; ++n) *(f32x4*)(out + off + bj * HALF + n * 16) = acc[ai][bj][m][n] * r * fv[bj][n];
                if (m & 1) asm volatile("" ::: "memory"); } }
    }
};
}
#define GAS __attribute__((address_space(1)))
#define LAS __attribute__((address_space(3)))
typedef unsigned v4u __attribute__((ext_vector_type(4)));
typedef GAS unsigned gu32;
typedef GAS unsigned long long gu64;
#define RLX_AGENT __ATOMIC_RELAXED, __HIP_MEMORY_SCOPE_AGENT
#define LDS_WAIT() asm volatile("s_waitcnt lgkmcnt(0)" ::: "memory")
#define VM_WAIT() asm volatile("s_waitcnt vmcnt(0)" ::: "memory")
__device__ __forceinline__ unsigned long long rt() { return __builtin_amdgcn_s_memrealtime(); }
typedef float f32x2_pk __attribute__((ext_vector_type(2))); typedef __bf16 bf16x2_pk __attribute__((ext_vector_type(2)));
__device__ __forceinline__ unsigned pk2(float lo, float hi) { const f32x2_pk v = {lo, hi}; return __builtin_bit_cast(unsigned, __builtin_convertvector(v, bf16x2_pk)); }
#define XB_TMO      128
#define XB_XCNT(j)  (256  + 64 * (j))
#define XB_XSUB(j)  (1280 + 64 * (j))
#define XB_XGEN(j)  (2304 + 64 * (j))
#define XB_TOP      3328
#define XB_TOPGEN   3392
#define XCD_BAR_WORDS 3456
#define XB_SPIN_CAP (1u << 22)

__device__ __forceinline__ unsigned xb_ld(unsigned* p)              { return __hip_atomic_load(p, __ATOMIC_RELAXED, __HIP_MEMORY_SCOPE_AGENT); }
__device__ __forceinline__ unsigned xb_add(unsigned* p, unsigned v) { return __hip_atomic_fetch_add(p, v, __ATOMIC_RELAXED, __HIP_MEMORY_SCOPE_AGENT); }
__device__ __forceinline__ unsigned xb_xcc_id() { return (unsigned)__builtin_amdgcn_s_getreg((3 << 11) | 20) & 0xFu; }
#define XB_SPIN(cond, bar) do { unsigned _sp = 0; while (cond) { __builtin_amdgcn_s_sleep(1); \
    if ((++_sp & 255u) == 0u) { if (xb_ld(&(bar)[XB_TMO])) break; if (_sp > XB_SPIN_CAP) { atomicAdd(&(bar)[XB_TMO], 1u); break; } } } } while (0)

struct XcdBarrier {
    unsigned* bar; unsigned x;
    volatile LAS unsigned* st;
};

__device__ __forceinline__ XcdBarrier xcd_barrier_post(unsigned* bar, volatile LAS unsigned* st, bool leader) {
    XcdBarrier b; b.bar = bar; b.x = xb_xcc_id(); b.st = st;
    if (leader) (void)xb_add(&bar[XB_XCNT(b.x)], 1u);
    return b;
}
__device__ __forceinline__ void xcd_barrier_complete(unsigned* bar, unsigned x, unsigned& nloc, unsigned& nx) {
    const unsigned G = gridDim.x * gridDim.y * gridDim.z;
    unsigned sum, cnt, mine, sp = 0u;
    for (;;) {
        sum = 0u; cnt = 0u; mine = 0u;
#pragma unroll
        for (unsigned j = 0; j < 16; ++j) { const unsigned c = xb_ld(&bar[XB_XCNT(j)]); sum += c; cnt += (c > 0u) ? 1u : 0u; mine = (j == x) ? c : mine; }
        if (sum == G) break;
        __builtin_amdgcn_s_sleep(1);
        if ((++sp & 255u) == 0u) { if (xb_ld(&bar[XB_TMO])) break; if (sp > XB_SPIN_CAP) { atomicAdd(&bar[XB_TMO], 1u); break; } }
    }
    nloc = mine > 0u ? mine : 1u; nx = cnt > 0u ? cnt : 1u;
}

__device__ __forceinline__ void xcd_barrier(const XcdBarrier& b, bool leader) {
    asm volatile("s_waitcnt vmcnt(0)" ::: "memory");
    __syncthreads();
    if (leader) {
        unsigned* bar = b.bar;
        __builtin_amdgcn_s_waitcnt(0);
        unsigned nloc = b.st[0], nx = b.st[1];
        if (nloc == 0u) { xcd_barrier_complete(bar, b.x, nloc, nx); b.st[0] = nloc; b.st[1] = nx; }
        const unsigned old = xb_add(&bar[XB_XSUB(b.x)], 1u);
        const unsigned gen = old / nloc;
        if (old + 1u == (gen + 1u) * nloc) {
            __builtin_amdgcn_fence(__ATOMIC_RELEASE, "agent");
            asm volatile("s_waitcnt vmcnt(0)" ::: "memory");
            const unsigned og = xb_add(&bar[XB_TOP], 1u);
            const unsigned tg = og / nx;
            if (og + 1u == (tg + 1u) * nx) xb_add(&bar[XB_TOPGEN], 1u);
            else XB_SPIN(xb_ld(&bar[XB_TOPGEN]) == tg, bar);
            __builtin_amdgcn_fence(__ATOMIC_ACQUIRE, "agent");
            xb_add(&bar[XB_XGEN(b.x)], 1u);
            asm volatile("s_waitcnt vmcnt(0)" ::: "memory");
        } else {
            XB_SPIN(xb_ld(&bar[XB_XGEN(b.x)]) == gen, bar);
            __builtin_amdgcn_fence(__ATOMIC_ACQUIRE, "agent");
            asm volatile("s_waitcnt vmcnt(0)" ::: "memory");
        }
    }
    __syncthreads();
}

typedef float f32x4 __attribute__((ext_vector_type(4)));
constexpr int NWAVES = 8;
__device__ __forceinline__ float wave_sum(float v) {
#pragma unroll
    for (int o = 1; o < 64; o <<= 1) v += __shfl_xor(v, o);
    return v;
}
__device__ __forceinline__ float dot4g(const f32x4 a) { return (a[0] * a[0] + a[1] * a[1]) + (a[2] * a[2] + a[3] * a[3]); }
__device__ __forceinline__ void p0_bt1_item(const float* W, bf16* WT, LAS float* scr, int item, int lane) {
    const int kb = item / 168, vb = item % 168, k0 = 64 * kb, v0 = 32 * vb;
    const int a = vcol_actual(v0 + (lane & 31));
#pragma unroll 8
    for (int i = 0; i < 32; ++i) { const int kk = 2 * i + (lane >> 5); scr[kk * 33 + (lane & 31)] = a >= 0 ? W[(size_t)(k0 + kk) * PROJ + a] : 0.f; }
    LDS_WAIT(); asm volatile("" ::: "memory");
    const int c = lane & 7;
#pragma unroll
    for (int j = 0; j < 4; ++j) { const int n = (lane >> 3) + 8 * j; const LAS float* s = scr + (8 * c) * 33 + n;
        v4u o; o.x = pk2(s[0 * 33], s[1 * 33]); o.y = pk2(s[2 * 33], s[3 * 33]); o.z = pk2(s[4 * 33], s[5 * 33]); o.w = pk2(s[6 * 33], s[7 * 33]);
        *(GAS v4u*)(WT + (size_t)(v0 + n) * 1024 + k0 + 8 * c) = o; }
    LDS_WAIT(); asm volatile("" ::: "memory");
}
__device__ __forceinline__ void p0_bt2_item(const float* W, const float* sg, bf16* WT, LAS float* scr, int item, int lane) {
    const int kb = item >> 5, nb = item & 31, kk0 = 64 * kb, n0 = 32 * nb;
#pragma unroll 8
    for (int i = 0; i < 32; ++i) { const int kk = 2 * i + (lane >> 5), kq = kk0 + kk; const int ks = kq < 1024 ? 1024 + kq : kq - 1024;
        float v = W[(size_t)ks * 1024 + n0 + (lane & 31)]; if (kq < 1024) v *= sg[kq]; scr[kk * 33 + (lane & 31)] = v; }
    LDS_WAIT(); asm volatile("" ::: "memory");
    const int c = lane & 7;
#pragma unroll
    for (int j = 0; j < 4; ++j) { const int n = (lane >> 3) + 8 * j; const LAS float* s = scr + (8 * c) * 33 + n;
        v4u o; o.x = pk2(s[0 * 33], s[1 * 33]); o.y = pk2(s[2 * 33], s[3 * 33]); o.z = pk2(s[4 * 33], s[5 * 33]); o.w = pk2(s[6 * 33], s[7 * 33]);
        *(GAS v4u*)(WT + (size_t)(n0 + n) * 2048 + kk0 + 8 * c) = o; }
    LDS_WAIT(); asm volatile("" ::: "memory");
}
__device__ __forceinline__ void p0_mod_block(const float* c, const float* c_ctx, const float* ada_w, const float* ada_b, float* mod, LAS float* ldsf, int cb, int tid, int lane, int wave) {
    LAS float* sil = ldsf; LAS float* red = ldsf + 33 * 256;
    float acc[33];
#pragma unroll
    for (int b = 0; b < 33; ++b) acc[b] = 0.f;
    for (int q = 0; q < 4; ++q) {
        __syncthreads();
        for (int e = tid; e < 33 * 256; e += NWAVES * 64) { const int b = e >> 8, k = e & 255; const float v = b < 32 ? c[b * 1024 + q * 256 + k] : c_ctx[q * 256 + k]; sil[e] = siluf(v); }
        __syncthreads();
#pragma unroll 2
        for (int k4 = 0; k4 < 8; ++k4) { const int kl = wave * 32 + 4 * k4; const float* wp = ada_w + (size_t)(q * 256 + kl) * 3072 + cb * 64 + lane;
            const float w0 = wp[0], w1 = wp[3072], w2 = wp[2 * 3072], w3 = wp[3 * 3072];
#pragma unroll
            for (int b = 0; b < 33; ++b) { const f32x4 sv = *(const LAS f32x4*)(sil + b * 256 + kl); acc[b] += (sv[0] * w0 + sv[1] * w1) + (sv[2] * w2 + sv[3] * w3); } }
    }
#pragma unroll
    for (int b = 0; b < 33; ++b) red[(wave * 33 + b) * 64 + lane] = acc[b];
    __syncthreads();
    for (int e = tid; e < 33 * 64; e += NWAVES * 64) { const int b = e >> 6, col = e & 63; float s = 0.f;
#pragma unroll
        for (int w = 0; w < 8; ++w) s += red[(w * 33 + b) * 64 + col];
        mod[b * 3072 + cb * 64 + col] = s + ada_b[cb * 64 + col]; }
    __syncthreads();
}
__device__ __forceinline__ const float* p1_src(const float* x, const float* ctx, int m) { return m < ML ? x + (size_t)m * DM : ctx + (size_t)(m - ML) * DM; }
__device__ __forceinline__ void p1_load4(f32x4 (&v)[4][4], const float* x, const float* ctx, int m0, int lane) {
#pragma unroll
    for (int r = 0; r < 4; ++r) { const GAS f32x4* xr = (const GAS f32x4*)p1_src(x, ctx, m0 + r) + 2 * lane;
#pragma unroll
        for (int j = 0; j < 2; ++j) { v[r][2 * j] = xr[128 * j]; v[r][2 * j + 1] = xr[128 * j + 1]; } }
}
__device__ __forceinline__ void p1_proc4(const f32x4 (&v)[4][4], const float* mod, const float* ng, bf16* H, int m0, int lane) {
#pragma unroll
    for (int r = 0; r < 4; ++r) { const int m = m0 + r; const float* md = mod + (size_t)(m < ML ? m / SEQ : 32) * 3072;
        float s = 0.f;
#pragma unroll
        for (int j = 0; j < 4; ++j) s += dot4g(v[r][j]);
        const float rstd = rsqrtf(wave_sum(s) * (1.f / DM) + EPS);
        GAS v4u* o16 = (GAS v4u*)(H + (size_t)m * DM) + lane;
#pragma unroll
        for (int j = 0; j < 2; ++j) { const int k = 8 * lane + 512 * j; f32x4 h[2];
#pragma unroll
            for (int q = 0; q < 2; ++q) { const f32x4 g = *(const f32x4*)(ng + k + 4 * q), sc = *(const f32x4*)(md + 1024 + k + 4 * q), sh = *(const f32x4*)(md + k + 4 * q);
                h[q] = v[r][2 * j + q] * rstd * g * (sc + 1.f) + sh; }
            v4u o; o.x = pk2(h[0][0], h[0][1]); o.y = pk2(h[0][2], h[0][3]); o.z = pk2(h[1][0], h[1][1]); o.w = pk2(h[1][2], h[1][3]);
            o16[64 * j] = o; }
    }
}
__device__ __forceinline__ void conv_phase(const bf16* XBC, const float* cw, const float* cb, bf16* XC, int bx, int G, int tid) {
    if (tid < 384) {
        const int cg = tid % 192, sub = tid / 192;
        f32x4 w[5][2], bias[2];
#pragma unroll
        for (int j = 0; j < 5; ++j) { w[j][0] = *(const f32x4*)(cw + j * CONVC + cg * 8); w[j][1] = *(const f32x4*)(cw + j * CONVC + cg * 8 + 4); }
        bias[0] = *(const f32x4*)(cb + cg * 8); bias[1] = *(const f32x4*)(cb + cg * 8 + 4);
        for (int seg = bx; seg < MT / 32; seg += G) {
            const int row0 = seg * 32 + sub * 16; int t0, len;
            if (row0 < ML) { t0 = row0 % SEQ; len = SEQ; } else { t0 = (row0 - ML) % CTXL; len = CTXL; }
            const bf16* src = XBC + (size_t)row0 * CONVC + cg * 8; bf16* dst = XC + (size_t)row0 * CONVC + cg * 8;
            v4u raw[20];
#pragma unroll
            for (int j = 0; j < 20; ++j) { const int tt = t0 + j - 2; raw[j] = (v4u){0u, 0u, 0u, 0u}; if (tt >= 0 && tt < len) raw[j] = *(const v4u*)(src + (ptrdiff_t)(j - 2) * CONVC); }
#pragma unroll
            for (int i = 0; i < 16; ++i) {
                f32x4 a0 = bias[0], a1 = bias[1];
#pragma unroll
                for (int j = 0; j < 5; ++j) { const v4u u = raw[i + j];
                    const f32x4 x0 = (f32x4){__uint_as_float(u.x << 16), __uint_as_float(u.x & 0xffff0000u), __uint_as_float(u.y << 16), __uint_as_float(u.y & 0xffff0000u)};
                    const f32x4 x1 = (f32x4){__uint_as_float(u.z << 16), __uint_as_float(u.z & 0xffff0000u), __uint_as_float(u.w << 16), __uint_as_float(u.w & 0xffff0000u)};
                    a0 += w[j][0] * x0; a1 += w[j][1] * x1; }
#pragma unroll
                for (int e = 0; e < 4; ++e) { a0[e] = siluf(a0[e]); a1[e] = siluf(a1[e]); }
                v4u o; o.x = pk2(a0[0], a0[1]); o.y = pk2(a0[2], a0[3]); o.z = pk2(a1[0], a1[1]); o.w = pk2(a1[2], a1[3]);
                *(v4u*)(dst + (size_t)i * CONVC) = o;
            }
        }
    }
}
__device__ __forceinline__ void ssd_item_naive(int b, int h, const bf16* XC, const float* DT, const bf16* Z, const float* a_log, const float* d_skip, bf16* YQ, float* SSQ, LAS float* ysq, int tid) {
    const int p = tid >> 3, nc = tid & 7, g = h >> 3;
    for (int dd = 0; dd < 2; ++dd) { const int d = 1 - dd;
        const float a_neg = -expf(a_log[d * 16 + h]);
        float S[16];
#pragma unroll
        for (int j = 0; j < 16; ++j) S[j] = 0.f;
        for (int seq = 0; seq < 2; ++seq) { const int len = seq == 0 ? CTXL : SEQ; const size_t rbase = seq == 0 ? (size_t)ML + (size_t)b * CTXL : (size_t)b * SEQ;
            for (int st = 0; st < len; ++st) { const int t = d ? len - 1 - st : st; const size_t row = rbase + t;
                const float dt = DT[row * 32 + d * 16 + h]; const float dec = expf(dt * a_neg);
                const float xs = bf2f(XC[row * CONVC + h * 64 + p]); const float X = xs * dt;
                const v4u b0 = *(const v4u*)(XC + row * CONVC + 1024 + g * 128 + nc * 16), b1 = *(const v4u*)(XC + row * CONVC + 1024 + g * 128 + nc * 16 + 8);
                const v4u c0 = *(const v4u*)(XC + row * CONVC + 1280 + g * 128 + nc * 16), c1 = *(const v4u*)(XC + row * CONVC + 1280 + g * 128 + nc * 16 + 8);
                const unsigned bw[8] = {b0.x, b0.y, b0.z, b0.w, b1.x, b1.y, b1.z, b1.w}, cw8[8] = {c0.x, c0.y, c0.z, c0.w, c1.x, c1.y, c1.z, c1.w};
                float y = 0.f;
#pragma unroll
                for (int j = 0; j < 8; ++j) { S[2 * j] = S[2 * j] * dec + X * __uint_as_float(bw[j] << 16); y += __uint_as_float(cw8[j] << 16) * S[2 * j];
                    S[2 * j + 1] = S[2 * j + 1] * dec + X * __uint_as_float(bw[j] & 0xffff0000u); y += __uint_as_float(cw8[j] & 0xffff0000u) * S[2 * j + 1]; }
                y += __shfl_xor(y, 1); y += __shfl_xor(y, 2); y += __shfl_xor(y, 4);
                if (seq == 1) {
                    bf16* yp = YQ + row * 2048 + h * 64 + p;
                    if (d == 1) { if (nc == 0) *yp = (bf16)f2bf(y); }
                    else {
                        if (nc == 0) { const float yt = y + bf2f(*yp) + d_skip[h] * xs; const float yg = yt * bf2f(Z[row * 1024 + h * 64 + p]); *yp = (bf16)f2bf(yg); ysq[p] = yg * yg; }
                        __syncthreads();
                        if (tid < 64) { float q = ysq[tid]; q = wave_sum(q); if (tid == 0) SSQ[row * 16 + h] = q; }
                        __syncthreads();
                    }
                }
            }
        }
        VM_WAIT(); __syncthreads();
    }
}

namespace attn_body {
using bf16=__hip_bfloat16;
using bf16x8=__attribute__((ext_vector_type(8)))short;
using s16x4=__attribute__((ext_vector_type(4)))short;
using f32x16=__attribute__((ext_vector_type(16)))float;
using u32x4=__attribute__((ext_vector_type(4)))unsigned;
constexpr int D=64,QP=2048,KP=256;
constexpr int NW=8,QBLK=32,QB=QBLK*NW,KVBLK=64,NQB=SEQ/QB;
constexpr int ATTN_UNIT_ROWS=QB;
__device__ __forceinline__ int crow(int r,int hi){return (r&3)+8*(r>>2)+4*hi;}
#define SBAR() __builtin_amdgcn_sched_barrier(0)
__device__ __forceinline__ void cmask(f32x16&p0,f32x16&p1,int jb,int qrel,int hi){
  const float NEG=-INFINITY; int kb=64*jb+4*hi;
  #pragma unroll
  for(int r=0;r<16;++r){int kv=kb+(r&3)+8*(r>>2); if(kv>qrel)p0[r]=NEG; if(kv+32>qrel)p1[r]=NEG;}
}

constexpr int NSLOT=3, SLOTB=8192;
constexpr int LDS_K=0, LDS_V=NSLOT*SLOTB, LDS_WS=2*NSLOT*SLOTB, LDS_OST=LDS_WS+NW*64*4, LDS_BYTES=LDS_OST+NW*8192;
constexpr float C2=0.125f*1.4426950408889634f;
__device__ __forceinline__ void glds16(const void*gsrc,unsigned lds_dst){unsigned keep;
  asm volatile("s_mov_b32 %0, m0\n\ts_mov_b32 m0, %2\n\ts_nop 0\n\tglobal_load_lds_dwordx4 %1, off\n\ts_mov_b32 m0, %0":"=&s"(keep):"v"(gsrc),"s"(lds_dst):"memory");}
__device__ __forceinline__ float max3f(float a,float b,float c){float r;asm("v_max3_f32 %0, %1, %2, %3":"=v"(r):"v"(a),"v"(b),"v"(c));return r;}
__device__ __forceinline__ float max2f(float a,float b){float r;asm("v_max_f32_e32 %0, %1, %2":"=v"(r):"v"(a),"v"(b));return r;}
__device__ __forceinline__ float fadd_s(float a,float b){float r;asm("v_add_f32_e32 %0, %1, %2":"=v"(r):"v"(a),"v"(b));return r;}
__device__ __forceinline__ float fsub_s(float a,float b){float r;asm("v_sub_f32_e32 %0, %1, %2":"=v"(r):"v"(a),"v"(b));return r;}
typedef float f32x2_t __attribute__((ext_vector_type(2))); typedef float f32x4_t __attribute__((ext_vector_type(4))); typedef __bf16 bf16x2_t __attribute__((ext_vector_type(2)));
__device__ __forceinline__ unsigned cvtpk_s(float lo,float hi){f32x2_t v={lo,hi};bf16x2_t b=__builtin_convertvector(v,bf16x2_t);return __builtin_bit_cast(unsigned,b);}
#define WAIT_BAR(N) asm volatile("s_waitcnt vmcnt(" #N ") lgkmcnt(0)\n\ts_barrier":::"memory")

__device__ __forceinline__ void qkt(f32x16&p0,f32x16&p1,const char*Kslot,const bf16x8*qr,const f32x16&negm,int r32,int hi){
  const char*kb=Kslot+hi*1024+r32*16;
  #pragma unroll
  for(int d0=0;d0<4;++d0){
    const bf16x8 b0=*reinterpret_cast<const bf16x8*>(kb+d0*2048);
    const bf16x8 b1=*reinterpret_cast<const bf16x8*>(kb+d0*2048+512);
    if(d0==0){p0=__builtin_amdgcn_mfma_f32_32x32x16_bf16(b0,qr[0],negm,0,0,0);p1=__builtin_amdgcn_mfma_f32_32x32x16_bf16(b1,qr[0],negm,0,0,0);}
    else{p0=__builtin_amdgcn_mfma_f32_32x32x16_bf16(b0,qr[d0],p0,0,0,0);p1=__builtin_amdgcn_mfma_f32_32x32x16_bf16(b1,qr[d0],p1,0,0,0);}}
}
typedef __attribute__((address_space(3))) const char* lds_cptr;
typedef short v4i16_t __attribute__((ext_vector_type(4)));
__device__ __forceinline__ void kload8(bf16x8*kf,lds_cptr kp){
  kf[0]=*(const __attribute__((address_space(3))) bf16x8*)(kp);      kf[1]=*(const __attribute__((address_space(3))) bf16x8*)(kp+512);
  kf[2]=*(const __attribute__((address_space(3))) bf16x8*)(kp+2048); kf[3]=*(const __attribute__((address_space(3))) bf16x8*)(kp+2560);
  kf[4]=*(const __attribute__((address_space(3))) bf16x8*)(kp+4096); kf[5]=*(const __attribute__((address_space(3))) bf16x8*)(kp+4608);
  kf[6]=*(const __attribute__((address_space(3))) bf16x8*)(kp+6144); kf[7]=*(const __attribute__((address_space(3))) bf16x8*)(kp+6656);
}
__device__ __forceinline__ void kload2(bf16x8*kf,lds_cptr kp,int j){ kf[2*j]=*(const __attribute__((address_space(3))) bf16x8*)(kp+j*2048); kf[2*j+1]=*(const __attribute__((address_space(3))) bf16x8*)(kp+j*2048+512); }
__device__ __forceinline__ s16x4 vtr(lds_cptr p){ return __builtin_bit_cast(s16x4,__builtin_amdgcn_ds_read_tr16_b64_v4i16((__attribute__((address_space(3))) v4i16_t*)p)); }
__device__ __forceinline__ float rowmax(const f32x16&p0,const f32x16&p1){
  float a=max3f(p0[0],p0[1],p1[0]),b=max3f(p0[2],p0[3],p1[1]);a=max3f(a,p1[2],p1[3]);
  #pragma unroll
  for(int r=4;r<16;r+=4){a=max3f(a,p0[r],p0[r+1]);b=max3f(b,p0[r+2],p0[r+3]);a=max3f(a,p1[r],p1[r+1]);b=max3f(b,p1[r+2],p1[r+3]);}
  const float m=max2f(a,b);
  auto rr=__builtin_amdgcn_permlane32_swap(__float_as_uint(m),__float_as_uint(m),false,false);
  return max2f(__uint_as_float(rr[0]),__uint_as_float(rr[1]));
}
__device__ __forceinline__ void pv(f32x16*o,int vb,bf16x8 pa0,bf16x8 pa1,bf16x8 pa2,bf16x8 pa3){
  #pragma unroll
  for(int d0=0;d0<2;++d0){s16x4 lo[4],hi[4];
    #pragma unroll
    for(int ks=0;ks<4;++ks){
      asm volatile("ds_read_b64_tr_b16 %0,%1 offset:%c2":"=&v"(lo[ks]):"v"(vb),"i"(d0*4096+ks*1024):"memory");
      asm volatile("ds_read_b64_tr_b16 %0,%1 offset:%c2":"=&v"(hi[ks]):"v"(vb),"i"(d0*4096+ks*1024+512):"memory");}
    asm volatile("s_waitcnt lgkmcnt(0)":::"memory");SBAR();
    #define PK(k) (bf16x8){lo[k][0],lo[k][1],lo[k][2],lo[k][3],hi[k][0],hi[k][1],hi[k][2],hi[k][3]}
    o[d0]=__builtin_amdgcn_mfma_f32_32x32x16_bf16(pa0,PK(0),o[d0],0,0,0);
    o[d0]=__builtin_amdgcn_mfma_f32_32x32x16_bf16(pa1,PK(1),o[d0],0,0,0);
    o[d0]=__builtin_amdgcn_mfma_f32_32x32x16_bf16(pa2,PK(2),o[d0],0,0,0);
    o[d0]=__builtin_amdgcn_mfma_f32_32x32x16_bf16(pa3,PK(3),o[d0],0,0,0);
    #undef PK
  }
}

#ifndef ATTN_STORE16
#define ATTN_STORE16(p,v) (*(u32x4*)(p)=(v))
#endif
template<int THRL> __device__ __forceinline__ void attn_unit(int b,int h,int qb,bf16*YQb,const bf16*__restrict__ K,const bf16*__restrict__ V,char*shm,int wid_in,float sbound,bf16x8 (&qr)[4],bool first,bool hasNext,int nb,int nh,int nqb,bf16*dummyO=nullptr){
  const int wid=wid_in; int lane=mk_lane(); asm volatile("":"+v"(lane)); const int tid=wid*64+lane,r32=lane&31,hi=lane>>5; (void)tid;
  const long rowbase=(long)b*SEQ; const int q0=qb*QB;
  const bf16*Qw=YQb+(rowbase+q0+wid*QBLK)*QP+1024+h*D;
  const bf16*Kh=K+(long)b*KVL*KP+(h>>2)*D,*Vh=V+(long)b*KVL*KP+(h>>2)*D;
  const unsigned lds0=(unsigned)(uintptr_t)shm;
  float*wsf=(float*)(shm+LDS_WS)+wid*64;
  const bf16*ksrc=Kh+(long)lane*KP+wid*8;
  const bf16*vsrc=Vh+(long)(16*(wid&3)+(lane>>2))*KP+(wid>>2)*32+(lane&3)*8;
  const unsigned kdst=lds0+LDS_K+wid*1024, vdst=lds0+LDS_V+wid*1024;
  #define DMA_K(t,slot) glds16(ksrc+(long)(t)*KVBLK*KP,(unsigned)__builtin_amdgcn_readfirstlane(kdst+(slot)))
  #define DMA_V(t,slot) glds16(vsrc+(long)(t)*KVBLK*KP,(unsigned)__builtin_amdgcn_readfirstlane(vdst+(slot)))
  const int vb0=(int)(lds0+LDS_V)+((lane>>4)&1)*32+(lane&3)*8+(4*hi+((lane&15)>>2))*64;
  const char*Kbase=shm+LDS_K; bf16x8 kf[8];
  const lds_cptr shm3=(lds_cptr)shm; const lds_cptr kp0=shm3+LDS_K+hi*1024+r32*16; const lds_cptr vp0=shm3+LDS_V+((lane>>4)&1)*32+(lane&3)*8+(4*hi+((lane&15)>>2))*64;
  constexpr int NT=KVL/KVBLK;
  if(first){ DMA_K(0,0);DMA_V(0,0);DMA_K(1,SLOTB);
    #pragma unroll
    for(int d0=0;d0<4;++d0)qr[d0]=*reinterpret_cast<const bf16x8*>(&Qw[(long)r32*QP+d0*16+hi*8]); }
  float l_reg=0.f;f32x16 o[2];o[0]=f32x16{};o[1]=f32x16{};f32x16 negm;
  #pragma unroll
  for(int r=0;r<16;++r)negm[r]=-sbound;
  asm volatile("":"+v"(negm));
  #define CMASK(P0,P1,t) do{}while(0)
  #define START(P0,P1) do{ _Pragma("unroll") for(int r=0;r<16;++r)P0[r]=__builtin_amdgcn_exp2f(P0[r]); }while(0)
  #define RESC() do{}while(0)
  f32x16 pA0,pA1,pB0,pB1;
  int sl_prev=0,sl_cur=0,sl_next=SLOTB;
  #define ROT() do{sl_prev=sl_cur;sl_cur=sl_next;sl_next=(sl_next==(NSLOT-1)*SLOTB)?0:sl_next+SLOTB;}while(0)
  if(first){ DMA_K(2,2*SLOTB);
    WAIT_BAR(3); }
  else { WAIT_BAR(4); }
  qkt(pA0,pA1,Kbase,qr,negm,r32,hi);asm volatile("s_nop 15\n\ts_nop 7":"+v"(pA0),"+v"(pA1));CMASK(pA0,pA1,0);
  START(pA0,pA1);
  _Pragma("unroll") for(int r=0;r<16;++r)pA1[r]=__builtin_amdgcn_exp2f(pA1[r]);
  WAIT_BAR(0);
  DMA_K(3,0);DMA_V(1,SLOTB);
  ROT();
  kload8(kf,kp0+sl_cur);
  WAIT_BAR(2);
  s16x4 vlo[8],vhi[8]; u32x4 pw0,pw1,pw2,pw3;
  #define PKW(P,B) cvtpk_s(P[B],P[B+1])
  #define PAF(k) __builtin_bit_cast(bf16x8,pw##k)
  #define VFR(i) (bf16x8){vlo[i][0],vlo[i][1],vlo[i][2],vlo[i][3],vhi[i][0],vhi[i][1],vhi[i][2],vhi[i][3]}
  #define PIN(x) asm volatile("":"+v"(x))
  #define MX3(a,b,c) __builtin_fmaxf(__builtin_fmaxf((a),(b)),(c))
  #define GAPA(MF,A0,A1,A2,A3,W0,W1,PW) do{ MF; sacc+=A0; sacc+=A1; sacc+=A2; sacc+=A3; PIN(sacc); W0; W1; PIN(PW); SBAR(); }while(0)
  #define EX(v) __builtin_amdgcn_exp2f(v)
  #define GAPB(MF,X,B) do{ MF; X[B]=EX(X[B]); X[B+1]=EX(X[B+1]); X[B+2]=EX(X[B+2]); X[B+3]=EX(X[B+3]); PIN(X); SBAR(); }while(0)
  #define VRD(i) do{ vlo[i]=vtr(vp_+(((i)>>2)*4096+((i)&3)*1024)); vhi[i]=vtr(vp_+(((i)>>2)*4096+((i)&3)*1024+512)); }while(0)
  #define KRD(G,j) do{ if(G){ kload2(kf,kp0+sl_next,j); SBAR(); } }while(0)
  #define STEP(C0,C1,P0,P1,t,GK,GV,GL) do{ SBAR(); \
    const lds_cptr vp_=vp0+sl_prev; \
    VRD(0); SBAR(); float sacc=(P0[0]+P0[1]); \
    GAPA(C0=__builtin_amdgcn_mfma_f32_32x32x16_bf16(kf[0],qr[0],negm,0,0,0), P0[2],P0[3],P0[4],P0[5],     pw0[0]=PKW(P0,0), pw0[1]=PKW(P0,2), pw0); \
    VRD(4); SBAR(); GAPA(C1=__builtin_amdgcn_mfma_f32_32x32x16_bf16(kf[1],qr[0],negm,0,0,0), P0[6],P0[7],P0[8],P0[9],     pw0[2]=PKW(P0,4), pw0[3]=PKW(P0,6), pw0); \
    VRD(1); SBAR(); GAPA(C0=__builtin_amdgcn_mfma_f32_32x32x16_bf16(kf[2],qr[1],C0,0,0,0),   P0[10],P0[11],P0[12],P0[13], pw1[0]=PKW(P0,8), pw1[1]=PKW(P0,10), pw1); \
    VRD(5); SBAR(); GAPA(C1=__builtin_amdgcn_mfma_f32_32x32x16_bf16(kf[3],qr[1],C1,0,0,0),   P0[14],P0[15],P1[0],P1[1],   pw1[2]=PKW(P0,12),pw1[3]=PKW(P0,14), pw1); \
    VRD(2); SBAR(); GAPA(C0=__builtin_amdgcn_mfma_f32_32x32x16_bf16(kf[4],qr[2],C0,0,0,0),   P1[2],P1[3],P1[4],P1[5],     pw2[0]=PKW(P1,0), pw2[1]=PKW(P1,2), pw2); \
    VRD(6); SBAR(); GAPA(C1=__builtin_amdgcn_mfma_f32_32x32x16_bf16(kf[5],qr[2],C1,0,0,0),   P1[6],P1[7],P1[8],P1[9],     pw2[2]=PKW(P1,4), pw2[3]=PKW(P1,6), pw2); \
    VRD(3); SBAR(); GAPA(C0=__builtin_amdgcn_mfma_f32_32x32x16_bf16(kf[6],qr[3],C0,0,0,0),   P1[10],P1[11],P1[12],P1[13], pw3[0]=PKW(P1,8), pw3[1]=PKW(P1,10), pw3); \
    VRD(7); SBAR(); GAPA(C1=__builtin_amdgcn_mfma_f32_32x32x16_bf16(kf[7],qr[3],C1,0,0,0),   P1[14],P1[15],0.f,0.f,       pw3[2]=PKW(P1,12),pw3[3]=PKW(P1,14), pw3); \
    l_reg+=sacc; \
    if(GK){DMA_K((t)+3,sl_cur);} if(GV){DMA_V((t)+1,sl_next);} \
    CMASK(C0,C1,t); \
    SBAR(); \
    GAPB(o[0]=__builtin_amdgcn_mfma_f32_32x32x16_bf16(PAF(0),VFR(0),o[0],0,0,0), C0,0); \
    GAPB(o[1]=__builtin_amdgcn_mfma_f32_32x32x16_bf16(PAF(0),VFR(4),o[1],0,0,0), C0,4); \
    KRD(GL,0); GAPB(o[0]=__builtin_amdgcn_mfma_f32_32x32x16_bf16(PAF(1),VFR(1),o[0],0,0,0), C0,8); \
    KRD(GL,1); GAPB(o[1]=__builtin_amdgcn_mfma_f32_32x32x16_bf16(PAF(1),VFR(5),o[1],0,0,0), C0,12); \
    KRD(GL,2); GAPB(o[0]=__builtin_amdgcn_mfma_f32_32x32x16_bf16(PAF(2),VFR(2),o[0],0,0,0), C1,0); \
    KRD(GL,3); GAPB(o[1]=__builtin_amdgcn_mfma_f32_32x32x16_bf16(PAF(2),VFR(6),o[1],0,0,0), C1,4); \
    GAPB(o[0]=__builtin_amdgcn_mfma_f32_32x32x16_bf16(PAF(3),VFR(3),o[0],0,0,0), C1,8); \
    GAPB(o[1]=__builtin_amdgcn_mfma_f32_32x32x16_bf16(PAF(3),VFR(7),o[1],0,0,0), C1,12); \
    }while(0)
  int t=1;
  #undef CMASK
  #define CMASK(P0,P1,t) do{}while(0)
  for(;t+5<NT;t+=2){
    STEP(pB0,pB1,pA0,pA1,t,true,true,true);     WAIT_BAR(2); RESC(); ROT();
    STEP(pA0,pA1,pB0,pB1,t+1,true,true,true);   WAIT_BAR(2); RESC(); ROT();
  }
  #undef CMASK
  #define CMASK(P0,P1,t) do{}while(0)
  #define ENDW(tt) do{ if((tt)+3<NT){WAIT_BAR(2);} else if((tt)+2<NT){WAIT_BAR(1);} else {WAIT_BAR(0);} }while(0)
  for(;t+1<NT;t+=2){
    STEP(pB0,pB1,pA0,pA1,t,(t+3<NT),(t+1<NT),(t+1<NT));       ENDW(t);   RESC(); ROT();
    STEP(pA0,pA1,pB0,pB1,t+1,(t+4<NT),(t+2<NT),(t+2<NT));     ENDW(t+1); RESC(); ROT();
  }
  const bf16*nQw=YQb+((long)nb*SEQ+nqb*QB+wid*QBLK)*QP+1024+nh*D;
  if(hasNext){ const bf16*nK=K+(long)nb*KVL*KP+(nh>>2)*D+(long)lane*KP+wid*8; const bf16*nV=V+(long)nb*KVL*KP+(nh>>2)*D+(long)(16*(wid&3)+(lane>>2))*KP+(wid>>2)*32+(lane&3)*8;
    glds16(nK,(unsigned)__builtin_amdgcn_readfirstlane(kdst)); glds16(nV,(unsigned)__builtin_amdgcn_readfirstlane(vdst)); glds16(nK+(long)KVBLK*KP,(unsigned)__builtin_amdgcn_readfirstlane(kdst+SLOTB)); glds16(nK+(long)2*KVBLK*KP,(unsigned)__builtin_amdgcn_readfirstlane(kdst+2*SLOTB)); }
  STEP(pB0,pB1,pA0,pA1,NT-1,false,false,false); RESC();
  { float sacc=pB0[0]+pB0[1]; _Pragma("unroll") for(int r=2;r<16;++r)sacc+=pB0[r]; _Pragma("unroll") for(int r=0;r<16;++r)sacc+=pB1[r]; l_reg+=sacc;
    pw0=(u32x4){PKW(pB0,0),PKW(pB0,2),PKW(pB0,4),PKW(pB0,6)};pw1=(u32x4){PKW(pB0,8),PKW(pB0,10),PKW(pB0,12),PKW(pB0,14)};pw2=(u32x4){PKW(pB1,0),PKW(pB1,2),PKW(pB1,4),PKW(pB1,6)};pw3=(u32x4){PKW(pB1,8),PKW(pB1,10),PKW(pB1,12),PKW(pB1,14)};
    SBAR(); pv(o,vb0+sl_cur,PAF(0),PAF(1),PAF(2),PAF(3)); }
  if(hasNext){
    #pragma unroll
    for(int d0=0;d0<4;++d0)qr[d0]=*reinterpret_cast<const bf16x8*>(&nQw[(long)r32*QP+d0*16+hi*8]); }
  #undef PKW
  #undef PAF
  #undef VFR
  #undef PIN
  #undef MX3
  #undef GAPA
  #undef GAPB
  #undef EX
  #undef VRD
  #undef KRD
  #undef STEP
  #undef ENDW
  {auto rr=__builtin_amdgcn_permlane32_swap(__float_as_uint(l_reg),__float_as_uint(l_reg),false,false);l_reg=__uint_as_float(rr[0])+__uint_as_float(rr[1]);}
  if(hi==0)wsf[32+r32]=l_reg;asm volatile("s_waitcnt lgkmcnt(0)":::"memory");
  float rli[16];
  #pragma unroll
  for(int r=0;r<16;++r)rli[r]=__builtin_amdgcn_rcpf(wsf[32+crow(r,hi)]);
  bf16*Ow=dummyO?dummyO+(long)(wid*QBLK)*QP:YQb+(rowbase+q0+wid*QBLK)*QP+1024+h*D; const bf16*Gw=YQb+(rowbase+q0+wid*QBLK)*QP+h*D;
  { float*stg=(float*)(shm+LDS_OST)+wid*2048;
    #pragma unroll
    for(int r=0;r<16;++r){const int orow=crow(r,hi);
      #pragma unroll
      for(int d0=0;d0<2;++d0)stg[orow*64+d0*32+r32]=o[d0][r]*rli[r];}
    asm volatile("s_waitcnt lgkmcnt(0)":::"memory");
    #pragma unroll
    for(int i=0;i<4;++i){const int row=i*8+(lane>>3),ch=lane&7; const float*sp=stg+row*64+ch*8;
      const f32x4_t a=*(const f32x4_t*)sp,c=*(const f32x4_t*)(sp+4); const u32x4 g=*(const u32x4*)(Gw+(long)row*QP+ch*8);
      u32x4 v; v[0]=cvtpk_s(a[0]*__uint_as_float(g[0]<<16),a[1]*__uint_as_float(g[0]&0xffff0000u)); v[1]=cvtpk_s(a[2]*__uint_as_float(g[1]<<16),a[3]*__uint_as_float(g[1]&0xffff0000u));
      v[2]=cvtpk_s(c[0]*__uint_as_float(g[2]<<16),c[1]*__uint_as_float(g[2]&0xffff0000u)); v[3]=cvtpk_s(c[2]*__uint_as_float(g[3]<<16),c[3]*__uint_as_float(g[3]&0xffff0000u));
      ATTN_STORE16(Ow+(long)row*QP+ch*8,v);} }
  asm volatile("s_waitcnt lgkmcnt(0)\n\ts_barrier":::"memory");
  #undef DMA_K
  #undef DMA_V
  #undef CMASK
  #undef START
  #undef RESC
  #undef ROT
}
constexpr int ATTN_LDS_BYTES=LDS_BYTES;
struct Order {
  int vcu, G; bool alt;
  __device__ __forceinline__ bool next(int i,int&b,int&h,int&qb)const{
    if(G==256&&!alt){ if(i>=16)return false; const int x=vcu>>5,j=vcu&31,rd=i>>2,k=i&3; const int pair=x*16+rd*4+(j>>3),un=(j&7)*4+k; b=pair>>2; h=(pair&3)*4+(un&3); qb=un>>2; return true; }
    const int U=i*G+vcu; if(U>=4096)return false; b=U>>7; h=(U>>3)&15; qb=U&7; return true; }
};
template<int THRL=8> __device__ __forceinline__ void attn_phase(char*lds,bf16*YQb,const bf16*K,const bf16*V,const Order&S,int wid,float sbound,bf16*dummyO=nullptr){
  int b,h,qb,nb=0,nh=0,nqb=0; bf16x8 qr[4]; bool first=true;
  bool has=S.next(0,b,h,qb);
  for(int i=0;has;++i){ const bool hn=S.next(i+1,nb,nh,nqb);
    attn_unit<THRL>(b,h,qb,YQb,K,V,lds,wid,sbound,qr,first,hn,nb,nh,nqb,dummyO);
    b=nb;h=nh;qb=nqb;has=hn;first=false; }
}
#undef SBAR
#undef WAIT_BAR
}

namespace ssd {
typedef short bf16x8 __attribute__((ext_vector_type(8)));
typedef short s16x4 __attribute__((ext_vector_type(4)));
typedef unsigned u32x2_t __attribute__((ext_vector_type(2)));
constexpr int O_B = 0, O_C = 32768, O_X = 65536, O_XD = 81920, O_ST = 98304, O_SM = 114688;
constexpr float LOG2E = 1.4426950408889634f;
struct Lofs { int fb[4], xb[4], bb, sw; };
__device__ __forceinline__ bf16x8 frag(const LAS unsigned char* img, int fbk, int t) { return *(const LAS bf16x8*)(img + fbk + t * 4096); }
__device__ __forceinline__ s16x4 trd(const LAS unsigned char* p) { typedef short v4i16_t __attribute__((ext_vector_type(4))); return __builtin_bit_cast(s16x4, __builtin_amdgcn_ds_read_tr16_b64_v4i16((LAS v4i16_t*)p)); }
__device__ __forceinline__ bf16x8 trfragX(const LAS unsigned char* img, int xbp, int s0) {
    const s16x4 a = trd(img + xbp + s0 * 128), b = trd(img + xbp + s0 * 128 + 2048);
    return (bf16x8){a[0], a[1], a[2], a[3], b[0], b[1], b[2], b[3]};
}
__device__ __forceinline__ bf16x8 trfragB(const LAS unsigned char* img, int bb, int s0) {
    const s16x4 a = trd(img + bb + s0 * 256), b = trd(img + bb + s0 * 256 + 4096);
    return (bf16x8){a[0], a[1], a[2], a[3], b[0], b[1], b[2], b[3]};
}
__device__ __forceinline__ void unpack4(const u32x2_t u, float (&f)[4]) { f[0] = __uint_as_float(u.x << 16); f[1] = __uint_as_float(u.x & 0xffff0000u); f[2] = __uint_as_float(u.y << 16); f[3] = __uint_as_float(u.y & 0xffff0000u); }
__device__ __forceinline__ void unpack8(const v4u u, float (&f)[8]) {
    f[0] = __uint_as_float(u.x << 16); f[1] = __uint_as_float(u.x & 0xffff0000u); f[2] = __uint_as_float(u.y << 16); f[3] = __uint_as_float(u.y & 0xffff0000u);
    f[4] = __uint_as_float(u.z << 16); f[5] = __uint_as_float(u.z & 0xffff0000u); f[6] = __uint_as_float(u.w << 16); f[7] = __uint_as_float(u.w & 0xffff0000u);
}
#define SSD_MFMA(a, b, c) __builtin_amdgcn_mfma_f32_16x16x32_bf16(a, b, c, 0, 0, 0)

template <int W> __device__ __forceinline__ void diag(f32x4 (&y)[4], const bf16x8 (&cf)[4], const LAS unsigned char* Bi, const LAS unsigned char* Xi, const LAS float* csc, float csl, float skd, int fr, int fq, const Lofs& lo) {
    constexpr int NU = W / 2 + 1;
    bf16x8 bA[2][4], bB[2][4];
#pragma unroll
    for (int kk = 0; kk < 4; ++kk) { bA[0][kk] = frag(Bi, lo.fb[kk], 0); if (1 <= W) bB[0][kk] = frag(Bi, lo.fb[kk], 1); }
#pragma unroll
    for (int u = 0; u < NU; ++u) {
        const int cur = u & 1; const bool has1 = 2 * u + 1 <= W;
        bf16x8 xf[4];
#pragma unroll
        for (int pt = 0; pt < 4; ++pt) xf[pt] = trfragX(Xi, lo.xb[pt], 32 * u);
        const f32x4 c0 = *(const LAS f32x4*)(csc + 32 * u + 4 * fq), c1 = *(const LAS f32x4*)(csc + 32 * u + 16 + 4 * fq);
        if (u + 1 < NU) {
#pragma unroll
            for (int kk = 0; kk < 4; ++kk) { bA[cur ^ 1][kk] = frag(Bi, lo.fb[kk], 2 * u + 2); if (2 * u + 3 <= W) bB[cur ^ 1][kk] = frag(Bi, lo.fb[kk], 2 * u + 3); } }
        asm volatile("" ::: "memory");
        f32x4 a0 = (f32x4){0.f, 0.f, 0.f, 0.f}, a1 = (f32x4){0.f, 0.f, 0.f, 0.f};
#pragma unroll
        for (int kk = 0; kk < 4; ++kk) { a0 = SSD_MFMA(bA[cur][kk], cf[kk], a0); if (has1) a1 = SSD_MFMA(bB[cur][kk], cf[kk], a1); }
        float m0[4], m1[4];
#pragma unroll
        for (int e = 0; e < 4; ++e) {
            m0[e] = a0[e] * __builtin_amdgcn_exp2f(fminf(csl - c0[e], 0.f)); if (2 * u == W) { if (4 * fq + e > fr) m0[e] = 0.f; if (4 * fq + e == fr) m0[e] += skd; }
            m1[e] = has1 ? a1[e] * __builtin_amdgcn_exp2f(fminf(csl - c1[e], 0.f)) : 0.f; if (2 * u + 1 == W) { if (4 * fq + e > fr) m1[e] = 0.f; if (4 * fq + e == fr) m1[e] += skd; } }
        const v4u mw = (v4u){pk2(m0[0], m0[1]), pk2(m0[2], m0[3]), pk2(m1[0], m1[1]), pk2(m1[2], m1[3])};
        const bf16x8 mf = __builtin_bit_cast(bf16x8, mw);
#pragma unroll
        for (int pt = 0; pt < 4; ++pt) y[pt] = SSD_MFMA(xf[pt], mf, y[pt]);
    }
}

template <int SH> __device__ __forceinline__ void ssd_item(int b, int h, const bf16* XC, const float* DT, const bf16* Z, const float* a_log, const float* d_skip, bf16* YQ, float* SSQ,
                                          LAS unsigned char* L, int tid_in, int lane_in, int wave) {
    int tid = tid_in, lane = lane_in; asm volatile("" : "+v"(tid), "+v"(lane));
    const int fr = lane & 15, fq = lane >> 4, g = h >> 3;
    LAS unsigned char* Bi = L + O_B; LAS unsigned char* Ci = L + O_C; LAS unsigned char* Xi = L + O_X; LAS unsigned char* Xdi = L + O_XD; LAS unsigned char* Sti = L + O_ST;
    LAS float* dtv = (LAS float*)(L + O_SM); LAS float* cs2 = dtv + 256;
    const float aneg1 = -expf(a_log[16 + h]) * LOG2E, aneg0 = -expf(a_log[h]) * LOG2E, dsk = d_skip[h];
    Lofs lo;
    { const int q = (lane & 15) >> 2, pp = lane & 3, rr = 4 * fq + q;
#pragma unroll
      for (int kk = 0; kk < 4; ++kk) lo.fb[kk] = fr * 256 + (((4 * kk + fq) ^ fr) << 4);
#pragma unroll
      for (int pt = 0; pt < 4; ++pt) lo.xb[pt] = rr * 128 + ((pt ^ ((rr >> 1) & 3)) << 5) + 8 * pp;
      lo.bb = rr * 256 + (((2 * wave + (pp >> 1)) ^ rr) << 4) + 8 * (pp & 1);
      lo.sw = fr * 256 + (((2 * wave + (fq >> 1)) ^ fr) << 4) + (fq & 1) * 8; }
    const int sB = tid >> 4, cB = tid & 15, sX = tid >> 3, cX = tid & 7;
    const int wB = sB * 256 + ((cB ^ (sB & 15)) << 4);
    const int wX = sX * 128 + (((cX >> 1) ^ ((sX >> 1) & 3)) << 5) + (cX & 1) * 16;
    f32x4 st[4];
#pragma unroll
    for (int pt = 0; pt < 4; ++pt) st[pt] = (f32x4){0.f, 0.f, 0.f, 0.f};
    v4u Bq[4], Cq[4], Xq[2]; float dq0 = 0.f, dq1 = 0.f; bf16x8 cf[4];
#define SSD_DECODE(step, d_, base_, ctx_) const int d_ = 1 - (step) / 18; const int k_##d_ = (step) % 18; const bool ctx_ = k_##d_ < 2; \
    const size_t base_ = ctx_ ? (size_t)ML + (size_t)b * CTXL + (size_t)(d_ ? 1 - k_##d_ : k_##d_) * 128 : (size_t)b * SEQ + (size_t)(d_ ? 17 - k_##d_ : k_##d_ - 2) * 128;
#define SSD_ISSUE(step) do { SSD_DECODE(step, di, basei, ctxi) (void)ctxi; \
        const bf16* cb_ = XC + (SH == 8 ? (size_t)b * SEQ : basei) * CONVC; const int sg_ = di ? -CONVC : CONVC; const int o0_ = di ? 127 * CONVC : 0; \
        const bf16* pb_ = cb_ + (o0_ + sB * sg_ + 1024 + g * 128 + 8 * cB); const bf16* px_ = cb_ + (o0_ + sX * sg_ + h * 64 + 8 * cX); \
        const bf16* pc_ = cb_ + (o0_ + (16 * wave + fr) * sg_ + 1280 + g * 128 + 8 * fq); \
        _Pragma("unroll") for (int k4 = 0; k4 < 4; ++k4) { Bq[k4] = *(const v4u*)(pb_ + k4 * 32 * sg_); Cq[k4] = *(const v4u*)(pc_ + 32 * k4); } \
        _Pragma("unroll") for (int k2 = 0; k2 < 2; ++k2) Xq[k2] = *(const v4u*)(px_ + k2 * 64 * sg_); \
        if (wave == 0) { const size_t r0 = basei + (di ? 127 - 2 * lane : 2 * lane), r1 = basei + (di ? 126 - 2 * lane : 2 * lane + 1); dq0 = DT[r0 * 32 + di * 16 + h]; dq1 = DT[r1 * 32 + di * 16 + h]; } } while (0)
#define SSD_CUMSUM(step, par) do { if (wave == 0) { const float an = (1 - (step) / 18) ? aneg1 : aneg0; const float a0 = dq0 * an, a1 = dq1 * an; float v = a0 + a1; \
        _Pragma("unroll") for (int o = 1; o < 64; o <<= 1) { const float t = __shfl_up(v, o); if (lane >= o) v += t; } \
        dtv[(par) * 128 + 2 * lane] = dq0; dtv[(par) * 128 + 2 * lane + 1] = dq1; cs2[(par) * 128 + 2 * lane] = v - a1; cs2[(par) * 128 + 2 * lane + 1] = v; } } while (0)
#define SSD_WRITE(step, par) do { \
        _Pragma("unroll") for (int k4 = 0; k4 < 4; ++k4) { *(LAS v4u*)(Bi + wB + k4 * 8192) = Bq[k4]; cf[k4] = __builtin_bit_cast(bf16x8, Cq[k4]); } \
        const float cl = cs2[(par) * 128 + 127]; \
        _Pragma("unroll") for (int k2 = 0; k2 < 2; ++k2) { const int s = sX + 64 * k2; const float dts = dtv[(par) * 128 + s], es = __builtin_amdgcn_exp2f(cl - cs2[(par) * 128 + s]); \
            float f[8]; unpack8(Xq[k2], f); _Pragma("unroll") for (int e = 0; e < 8; ++e) f[e] *= dts; \
            v4u xo; xo.x = pk2(f[0], f[1]); xo.y = pk2(f[2], f[3]); xo.z = pk2(f[4], f[5]); xo.w = pk2(f[6], f[7]); \
            _Pragma("unroll") for (int e = 0; e < 8; ++e) f[e] *= es; \
            v4u xd; xd.x = pk2(f[0], f[1]); xd.y = pk2(f[2], f[3]); xd.z = pk2(f[4], f[5]); xd.w = pk2(f[6], f[7]); \
            *(LAS v4u*)(Xi + wX + k2 * 8192) = xo; *(LAS v4u*)(Xdi + wX + k2 * 8192) = xd; } } while (0)
#define SSD_WRITE_STATE() do { _Pragma("unroll") for (int pt = 0; pt < 4; ++pt) { \
        u32x2_t w; w.x = pk2(st[pt][0], st[pt][1]); w.y = pk2(st[pt][2], st[pt][3]); *(LAS u32x2_t*)(Sti + lo.sw + pt * 4096) = w; } } while (0)

    __syncthreads();
    SSD_ISSUE(0); SSD_CUMSUM(0, 0); SSD_WRITE_STATE();
    __syncthreads();
    SSD_WRITE(0, 0);
    __syncthreads();
    for (int step = 0; step < 36; ++step) {
        const int par = step & 1; SSD_DECODE(step, d, base, isctx)
        const int r8 = lane >> 3, c8 = lane & 7;
        size_t orow2[2]; v4u ybv[2], zv[2];
#pragma unroll
        for (int ps = 0; ps < 2; ++ps) { const int l = 16 * wave + 8 * ps + r8; orow2[ps] = base + (d ? 127 - l : l); }
        if (!isctx && d == 0 && SH != 5 && SH != 7) {
#pragma unroll
            for (int ps = 0; ps < 2; ++ps) { ybv[ps] = *(const v4u*)((SH ? YQ + (orow2[ps] & 255) * 2048 : YQ + orow2[ps] * 2048) + h * 64 + 8 * c8); zv[ps] = *(const v4u*)(Z + orow2[ps] * 1024 + h * 64 + 8 * c8); } }
        if (step + 1 < 36 && SH != 3 && SH != 7) SSD_ISSUE(step + 1);
        const LAS float* csc = cs2 + par * 128;
        if (!isctx && SH != 7) {
            const float csl = csc[16 * wave + fr];
            const float skd = d == 0 ? dsk * __builtin_amdgcn_rcpf(dtv[par * 128 + 16 * wave + fr]) : 0.f;
            f32x4 y[4];
#pragma unroll
            for (int pt = 0; pt < 4; ++pt) { y[pt] = (f32x4){0.f, 0.f, 0.f, 0.f};
                if (SH != 6) {
#pragma unroll
                for (int kk = 0; kk < 4; ++kk) y[pt] = SSD_MFMA(frag(Sti, lo.fb[kk], pt), cf[kk], y[pt]); } }
            { const float El = __builtin_amdgcn_exp2f(csl);
#pragma unroll
              for (int pt = 0; pt < 4; ++pt) y[pt] *= El; }
            if (SH != 2) switch (wave) {
                case 0: diag<0>(y, cf, Bi, Xi, csc, csl, skd, fr, fq, lo); break; case 1: diag<1>(y, cf, Bi, Xi, csc, csl, skd, fr, fq, lo); break;
                case 2: diag<2>(y, cf, Bi, Xi, csc, csl, skd, fr, fq, lo); break; case 3: diag<3>(y, cf, Bi, Xi, csc, csl, skd, fr, fq, lo); break;
                case 4: diag<4>(y, cf, Bi, Xi, csc, csl, skd, fr, fq, lo); break; case 5: diag<5>(y, cf, Bi, Xi, csc, csl, skd, fr, fq, lo); break;
                case 6: diag<6>(y, cf, Bi, Xi, csc, csl, skd, fr, fq, lo); break; default: diag<7>(y, cf, Bi, Xi, csc, csl, skd, fr, fq, lo); break;
            }
            LAS unsigned char* stg = Ci + wave * 4096;
#pragma unroll
            for (int pt = 0; pt < 4; ++pt) *(LAS f32x4*)(stg + fr * 256 + (((4 * pt + fq) ^ fr) << 4)) = y[pt];
#pragma unroll
            for (int ps = 0; ps < 2; ++ps) { const int rl = 8 * ps + r8;
                const f32x4 t0 = *(const LAS f32x4*)(stg + rl * 256 + (((2 * c8) ^ rl) << 4)), t1 = *(const LAS f32x4*)(stg + rl * 256 + (((2 * c8 + 1) ^ rl) << 4));
                float v[8] = {t0[0], t0[1], t0[2], t0[3], t1[0], t1[1], t1[2], t1[3]};
                if (d == 0 && SH != 5) { float fb[8], fz[8]; unpack8(ybv[ps], fb); unpack8(zv[ps], fz); float q = 0.f;
#pragma unroll
                    for (int e = 0; e < 8; ++e) { v[e] = (v[e] + fb[e]) * fz[e]; q += v[e] * v[e]; }
                    q += __shfl_xor(q, 1); q += __shfl_xor(q, 2); q += __shfl_xor(q, 4);
                    if (c8 == 0) SSQ[(SH ? (orow2[ps] & 255) : orow2[ps]) * 16 + h] = q; }
                v4u o; o.x = pk2(v[0], v[1]); o.y = pk2(v[2], v[3]); o.z = pk2(v[4], v[5]); o.w = pk2(v[6], v[7]);
                if (SH != 5) *(v4u*)((SH ? YQ + (orow2[ps] & 255) * 2048 : YQ + orow2[ps] * 2048) + h * 64 + 8 * c8) = o; else asm volatile("" :: "v"(o)); }
        }
        if (SH != 6 && SH != 7) { const float dec = __builtin_amdgcn_exp2f(csc[127]);
#pragma unroll
          for (int pt = 0; pt < 4; ++pt) st[pt] *= dec;
#pragma unroll
          for (int kk = 0; kk < 4; ++kk) { const bf16x8 af = trfragB(Bi, lo.bb, 32 * kk);
#pragma unroll
              for (int pt = 0; pt < 4; ++pt) st[pt] = SSD_MFMA(af, trfragX(Xdi, lo.xb[pt], 32 * kk), st[pt]); } }
        if (step + 1 < 36) SSD_CUMSUM(step + 1, par ^ 1);
        if (step == 17) {
#pragma unroll
            for (int pt = 0; pt < 4; ++pt) st[pt] = (f32x4){0.f, 0.f, 0.f, 0.f};
            VM_WAIT();
        }
        __syncthreads();
        SSD_WRITE_STATE();
        if (step + 1 < 36 && SH != 4 && SH != 7) SSD_WRITE(step + 1, par ^ 1);
        __syncthreads();
    }
#undef SSD_DECODE
#undef SSD_ISSUE
#undef SSD_CUMSUM
#undef SSD_WRITE
#undef SSD_WRITE_STATE
}
namespace pr {
template <int CTRL, int ROWMASK> __device__ __forceinline__ float dpp_get(float v) {
    return __builtin_bit_cast(float, __builtin_amdgcn_update_dpp(0, __builtin_bit_cast(int, v), CTRL, ROWMASK, 0xF, false)); }
__device__ __forceinline__ float sum8(float q) {
    q += dpp_get<0xB1, 0xF>(q); q += dpp_get<0x4E, 0xF>(q); q += dpp_get<0x141, 0xF>(q); return q; }
__device__ __forceinline__ float scan64(float v) {
    v += dpp_get<0x111, 0xF>(v); v += dpp_get<0x112, 0xF>(v); v += dpp_get<0x114, 0xF>(v); v += dpp_get<0x118, 0xF>(v);
    v += dpp_get<0x142, 0xA>(v); v += dpp_get<0x143, 0xC>(v); return v; }
constexpr int P_B = 0, P_STG = 32768, P_X = 49152, P_XD = 81920, P_ST0 = 114688, P_ST1 = 132096, P_SM = 148480;
template <int W> __device__ __forceinline__ void diag1(f32x4 (&y)[4], const bf16x8 (&cf)[4], const LAS unsigned char* Bi, const LAS unsigned char* Xi, const LAS float* csc, float csl, float skd, int fr, int fq, const Lofs& lo) {
#pragma unroll
    for (int u = 0; u <= W / 2; ++u) {
        const bool has1 = 2 * u + 1 <= W;
        bf16x8 xf[4];
#pragma unroll
        for (int pt = 0; pt < 4; ++pt) xf[pt] = trfragX(Xi, lo.xb[pt], 32 * u);
        const f32x4 c0 = *(const LAS f32x4*)(csc + 32 * u + 4 * fq), c1 = *(const LAS f32x4*)(csc + 32 * u + 16 + 4 * fq);
        f32x4 a0 = (f32x4){0.f, 0.f, 0.f, 0.f}, a1 = (f32x4){0.f, 0.f, 0.f, 0.f};
#pragma unroll
        for (int kk = 0; kk < 4; ++kk) { a0 = SSD_MFMA(frag(Bi, lo.fb[kk], 2 * u), cf[kk], a0); if (has1) a1 = SSD_MFMA(frag(Bi, lo.fb[kk], 2 * u + 1), cf[kk], a1); }
        float m0[4], m1[4];
#pragma unroll
        for (int e = 0; e < 4; ++e) {
            m0[e] = a0[e] * __builtin_amdgcn_exp2f(fminf(csl - c0[e], 0.f)); if (2 * u == W) { if (4 * fq + e > fr) m0[e] = 0.f; if (4 * fq + e == fr) m0[e] += skd; }
            m1[e] = has1 ? a1[e] * __builtin_amdgcn_exp2f(fminf(csl - c1[e], 0.f)) : 0.f; if (2 * u + 1 == W) { if (4 * fq + e > fr) m1[e] = 0.f; if (4 * fq + e == fr) m1[e] += skd; } }
        const v4u mw = (v4u){pk2(m0[0], m0[1]), pk2(m0[2], m0[3]), pk2(m1[0], m1[1]), pk2(m1[2], m1[3])};
        const bf16x8 mf = __builtin_bit_cast(bf16x8, mw);
#pragma unroll
        for (int pt = 0; pt < 4; ++pt) y[pt] = SSD_MFMA(xf[pt], mf, y[pt]);
    }
}
__device__ __forceinline__ void diag_sw(int wave, f32x4 (&y)[4], const bf16x8 (&cf)[4], const LAS unsigned char* Bi, const LAS unsigned char* Xi, const LAS float* csc, float csl, float skd, int fr, int fq, const Lofs& lo) {
    switch (wave) {
        case 0: diag<0>(y, cf, Bi, Xi, csc, csl, skd, fr, fq, lo); break; case 1: diag<1>(y, cf, Bi, Xi, csc, csl, skd, fr, fq, lo); break;
        case 2: diag<2>(y, cf, Bi, Xi, csc, csl, skd, fr, fq, lo); break; case 3: diag<3>(y, cf, Bi, Xi, csc, csl, skd, fr, fq, lo); break;
        case 4: diag<4>(y, cf, Bi, Xi, csc, csl, skd, fr, fq, lo); break; case 5: diag<5>(y, cf, Bi, Xi, csc, csl, skd, fr, fq, lo); break;
        case 6: diag<6>(y, cf, Bi, Xi, csc, csl, skd, fr, fq, lo); break; default: diag<7>(y, cf, Bi, Xi, csc, csl, skd, fr, fq, lo); break;
    }
}

__device__ __forceinline__ void ssd_pair(int b, int hp, const bf16* XC, const float* DT, const bf16* Z, const float* a_log, const float* d_skip, bf16* YQ, float* SSQ,
                                          LAS unsigned char* L, int tid_in, int lane_in, int wave) {
    int tid = tid_in, lane = lane_in; asm volatile("" : "+v"(tid), "+v"(lane));
    const int fr = lane & 15, fq = lane >> 4, h0 = 2 * hp, g = hp >> 2;
    LAS unsigned char* Bi = L + P_B; LAS unsigned char* Stg = L + P_STG + wave * 2048;
    LAS float* dtv = (LAS float*)(L + P_SM); LAS float* cs2 = dtv + 512;
    const float an00 = -expf(a_log[h0]) * LOG2E, an01 = -expf(a_log[h0 + 1]) * LOG2E, an10 = -expf(a_log[16 + h0]) * LOG2E, an11 = -expf(a_log[16 + h0 + 1]) * LOG2E;
    const float dsk0 = d_skip[h0], dsk1 = d_skip[h0 + 1];
    Lofs lo;
    { const int q = (lane & 15) >> 2, pp = lane & 3, rr = 4 * fq + q;
#pragma unroll
      for (int kk = 0; kk < 4; ++kk) lo.fb[kk] = fr * 256 + (((4 * kk + fq) ^ fr) << 4);
#pragma unroll
      for (int pt = 0; pt < 4; ++pt) lo.xb[pt] = rr * 128 + ((pt ^ ((rr >> 1) & 3)) << 5) + 8 * pp;
      lo.bb = rr * 256 + (((2 * wave + (pp >> 1)) ^ rr) << 4) + 8 * (pp & 1);
      lo.sw = fr * 256 + (((2 * wave + (fq >> 1)) ^ fr) << 4) + (fq & 1) * 8; }
    const int sB = tid >> 4, cB = tid & 15, hx = (tid >> 3) & 1, cX = tid & 7;
    const int wB = sB * 256 + ((cB ^ (sB & 15)) << 4);
    const int wX = hx * 16384 + sB * 128 + (((cX >> 1) ^ ((sB >> 1) & 3)) << 5) + (cX & 1) * 16;
    f32x4 st[2][4];
#pragma unroll
    for (int hh = 0; hh < 2; ++hh)
#pragma unroll
        for (int pt = 0; pt < 4; ++pt) st[hh][pt] = (f32x4){0.f, 0.f, 0.f, 0.f};
    v4u Bq[4], Xq[4]; float dq0 = 0.f, dq1 = 0.f; bf16x8 cf[4];
#define PR_DECODE(step, d_, base_, ctx_) const int d_ = 1 - (step) / 18; const int k_##d_ = (step) % 18; const bool ctx_ = k_##d_ < 2; \
    const size_t base_ = ctx_ ? (size_t)ML + (size_t)b * CTXL + (size_t)(d_ ? 1 - k_##d_ : k_##d_) * 128 : (size_t)b * SEQ + (size_t)(d_ ? 17 - k_##d_ : k_##d_ - 2) * 128;
#define PR_ISSUE(step) do { PR_DECODE(step, di, basei, ctxi) (void)ctxi; \
        const bf16* cb_ = XC + basei * CONVC; const int sg_ = di ? -CONVC : CONVC; const int o0_ = di ? 127 * CONVC : 0; \
        const bf16* pb_ = cb_ + (o0_ + sB * sg_ + 1024 + g * 128 + 8 * cB); const bf16* px_ = cb_ + (o0_ + sB * sg_ + h0 * 64 + 8 * cB); \
        _Pragma("unroll") for (int k4 = 0; k4 < 4; ++k4) { Bq[k4] = *(const v4u*)(pb_ + k4 * 32 * sg_); Xq[k4] = *(const v4u*)(px_ + k4 * 32 * sg_); } \
        if (wave < 2) { const size_t r0 = basei + (di ? 127 - 2 * lane : 2 * lane), r1 = basei + (di ? 126 - 2 * lane : 2 * lane + 1); dq0 = DT[r0 * 32 + di * 16 + h0 + wave]; dq1 = DT[r1 * 32 + di * 16 + h0 + wave]; } } while (0)
#define PR_LOADC(step) do { PR_DECODE(step, dc, basec, ctxc) (void)ctxc; const bf16* pc_ = XC + basec * CONVC + ((dc ? 127 - (16 * wave + fr) : 16 * wave + fr) * CONVC + 1280 + g * 128 + 8 * fq); \
        _Pragma("unroll") for (int k4 = 0; k4 < 4; ++k4) cf[k4] = __builtin_bit_cast(bf16x8, *(const v4u*)(pc_ + 32 * k4)); } while (0)
#define PR_CUMSUM(step, par) do { if (wave < 2) { const float an = (1 - (step) / 18) ? (wave ? an11 : an10) : (wave ? an01 : an00); const float a0 = dq0 * an, a1 = dq1 * an; const float v = scan64(a0 + a1); \
        const int o_ = ((par) * 2 + wave) * 128 + 2 * lane; dtv[o_] = dq0; dtv[o_ + 1] = dq1; cs2[o_] = v - a1; cs2[o_ + 1] = v; } } while (0)
#define PR_WRITE(step, par) do { const int ob_ = ((par) * 2 + hx) * 128; const float cl = cs2[ob_ + 127]; \
        _Pragma("unroll") for (int k4 = 0; k4 < 4; ++k4) { *(LAS v4u*)(Bi + wB + k4 * 8192) = Bq[k4]; \
            const int s = sB + 32 * k4; const float dts = dtv[ob_ + s], es = __builtin_amdgcn_exp2f(cl - cs2[ob_ + s]); \
            float f[8]; unpack8(Xq[k4], f); _Pragma("unroll") for (int e = 0; e < 8; ++e) f[e] *= dts; \
            v4u xo; xo.x = pk2(f[0], f[1]); xo.y = pk2(f[2], f[3]); xo.z = pk2(f[4], f[5]); xo.w = pk2(f[6], f[7]); \
            _Pragma("unroll") for (int e = 0; e < 8; ++e) f[e] *= es; \
            v4u xd; xd.x = pk2(f[0], f[1]); xd.y = pk2(f[2], f[3]); xd.z = pk2(f[4], f[5]); xd.w = pk2(f[6], f[7]); \
            *(LAS v4u*)(L + P_X + wX + k4 * 4096) = xo; *(LAS v4u*)(L + P_XD + wX + k4 * 4096) = xd; } } while (0)
#define PR_WRITE_STATE() do { _Pragma("unroll") for (int pt = 0; pt < 4; ++pt) { \
        u32x2_t w; w.x = pk2(st[0][pt][0], st[0][pt][1]); w.y = pk2(st[0][pt][2], st[0][pt][3]); *(LAS u32x2_t*)(L + P_ST0 + lo.sw + pt * 4096) = w; \
        w.x = pk2(st[1][pt][0], st[1][pt][1]); w.y = pk2(st[1][pt][2], st[1][pt][3]); *(LAS u32x2_t*)(L + P_ST1 + lo.sw + pt * 4096) = w; } } while (0)

    __syncthreads();
    PR_ISSUE(0); PR_LOADC(0); PR_CUMSUM(0, 0); PR_WRITE_STATE();
    __syncthreads();
    PR_WRITE(0, 0);
    __syncthreads();
    for (int step = 0; step < 36; ++step) {
        const int par = step & 1; PR_DECODE(step, d, base, isctx)
        const int r8 = lane >> 3, c8 = lane & 7;
        size_t orow2[2]; v4u ybv[2], zv[2];
#pragma unroll
        for (int ps = 0; ps < 2; ++ps) { const int l = 16 * wave + 8 * ps + r8; orow2[ps] = base + (d ? 127 - l : l); }
        const bool fwdy = !isctx && d == 0;
        if (fwdy) {
#pragma unroll
            for (int ps = 0; ps < 2; ++ps) { ybv[ps] = *(const v4u*)(YQ + orow2[ps] * 2048 + h0 * 64 + 8 * c8); zv[ps] = *(const v4u*)(Z + orow2[ps] * 1024 + h0 * 64 + 8 * c8); } }
        if (step + 1 < 36) PR_ISSUE(step + 1);
        if (!isctx) {
#pragma unroll
            for (int hh = 0; hh < 2; ++hh) {
                const LAS float* csc = cs2 + (par * 2 + hh) * 128;
                const LAS unsigned char* Xi = L + P_X + hh * 16384; const LAS unsigned char* Sti = L + (hh ? P_ST1 : P_ST0);
                const float csl = csc[16 * wave + fr];
                const float skd = d == 0 ? (hh ? dsk1 : dsk0) * __builtin_amdgcn_rcpf(dtv[(par * 2 + hh) * 128 + 16 * wave + fr]) : 0.f;
                f32x4 y[4];
#pragma unroll
                for (int pt = 0; pt < 4; ++pt) { y[pt] = (f32x4){0.f, 0.f, 0.f, 0.f};
#pragma unroll
                    for (int kk = 0; kk < 4; ++kk) y[pt] = SSD_MFMA(frag(Sti, lo.fb[kk], pt), cf[kk], y[pt]); }
                { const float El = __builtin_amdgcn_exp2f(csl);
#pragma unroll
                  for (int pt = 0; pt < 4; ++pt) y[pt] *= El; }
                diag_sw(wave, y, cf, Bi, Xi, csc, csl, skd, fr, fq, lo);
                v4u outv[2];
#pragma unroll
                for (int ps = 0; ps < 2; ++ps) {
                    if ((fr >> 3) == ps) {
#pragma unroll
                        for (int pt = 0; pt < 4; ++pt) *(LAS f32x4*)(Stg + (fr & 7) * 256 + (((4 * pt + fq) ^ fr) << 4)) = y[pt]; }
                    const int key = 8 * ps + r8;
                    const f32x4 t0 = *(const LAS f32x4*)(Stg + r8 * 256 + (((2 * c8) ^ key) << 4)), t1 = *(const LAS f32x4*)(Stg + r8 * 256 + (((2 * c8 + 1) ^ key) << 4));
                    float v[8] = {t0[0], t0[1], t0[2], t0[3], t1[0], t1[1], t1[2], t1[3]};
                    if (d == 0) { float fb[8], fz[8]; unpack8(ybv[ps], fb); unpack8(zv[ps], fz); float q = 0.f;
#pragma unroll
                        for (int e = 0; e < 8; ++e) { v[e] = (v[e] + fb[e]) * fz[e]; q += v[e] * v[e]; }
                        q = sum8(q);
                        if (c8 == 0) SSQ[orow2[ps] * 16 + h0 + hh] = q; }
                    outv[ps].x = pk2(v[0], v[1]); outv[ps].y = pk2(v[2], v[3]); outv[ps].z = pk2(v[4], v[5]); outv[ps].w = pk2(v[6], v[7]);
                }
                asm volatile("" ::: "memory");
                if (hh == 0 && fwdy) {
#pragma unroll
                    for (int ps = 0; ps < 2; ++ps) { ybv[ps] = *(const v4u*)(YQ + orow2[ps] * 2048 + (h0 + 1) * 64 + 8 * c8); zv[ps] = *(const v4u*)(Z + orow2[ps] * 1024 + (h0 + 1) * 64 + 8 * c8); } }
                if (hh == 1 && step + 1 < 36) PR_LOADC(step + 1);
                asm volatile("" ::: "memory");
#pragma unroll
                for (int ps = 0; ps < 2; ++ps) *(v4u*)(YQ + orow2[ps] * 2048 + (h0 + hh) * 64 + 8 * c8) = outv[ps];
            }
        }
        if (isctx && step + 1 < 36) PR_LOADC(step + 1);
        { const float dec0 = __builtin_amdgcn_exp2f(cs2[(par * 2 + 0) * 128 + 127]), dec1 = __builtin_amdgcn_exp2f(cs2[(par * 2 + 1) * 128 + 127]);
#pragma unroll
          for (int pt = 0; pt < 4; ++pt) { st[0][pt] *= dec0; st[1][pt] *= dec1; }
#pragma unroll
          for (int kk = 0; kk < 4; ++kk) { const bf16x8 af = trfragB(Bi, lo.bb, 32 * kk);
#pragma unroll
              for (int pt = 0; pt < 4; ++pt) { st[0][pt] = SSD_MFMA(af, trfragX(L + P_XD, lo.xb[pt], 32 * kk), st[0][pt]); st[1][pt] = SSD_MFMA(af, trfragX(L + P_XD + 16384, lo.xb[pt], 32 * kk), st[1][pt]); } } }
        if (step + 1 < 36) PR_CUMSUM(step + 1, par ^ 1);
        if (step == 17) {
#pragma unroll
            for (int pt = 0; pt < 4; ++pt) { st[0][pt] = (f32x4){0.f, 0.f, 0.f, 0.f}; st[1][pt] = (f32x4){0.f, 0.f, 0.f, 0.f}; }
            VM_WAIT();
        }
        __syncthreads();
        PR_WRITE_STATE();
        if (step + 1 < 36) PR_WRITE(step + 1, par ^ 1);
        __syncthreads();
    }
#undef PR_DECODE
#undef PR_ISSUE
#undef PR_CUMSUM
#undef PR_LOADC
#undef PR_WRITE
#undef PR_WRITE_STATE
}
}
}

__device__ __forceinline__ void ctx_dt_slice(const bf16* H, const bf16* bt1, const float* dt_bias, float* DT, int bx, int G, int wave, int lane) {
    typedef short bf16x8_t __attribute__((ext_vector_type(8)));
    const int fr = lane & 15, fq = lane >> 4;
    for (int sl = bx; sl < MC / 32; sl += G) {
        if (wave < 4) {
            const int r0 = ML + 32 * sl + 16 * (wave >> 1), j0 = 16 * (wave & 1);
            const bf16* ap = H + (size_t)(r0 + fr) * DM + 8 * fq; const bf16* bp = bt1 + (size_t)(2048 + j0 + fr) * DM + 8 * fq;
            f32x4 acc = (f32x4){0.f, 0.f, 0.f, 0.f};
#pragma unroll 8
            for (int kk = 0; kk < 32; ++kk) acc = __builtin_amdgcn_mfma_f32_16x16x32_bf16(*(const bf16x8_t*)(ap + 32 * kk), *(const bf16x8_t*)(bp + 32 * kk), acc, 0, 0, 0);
            const float bias = dt_bias[j0 + fr];
#pragma unroll
            for (int e = 0; e < 4; ++e) { const float v = acc[e] + bias; DT[(size_t)(r0 + 4 * fq + e) * 32 + j0 + fr] = v > 20.f ? v : log1pf(__expf(v)); }
        }
    }
}
constexpr int RING_OFF = 0, RING_BYTES = 131072;
constexpr int LDSCTL_OFF = RING_BYTES, MISC_OFF = LDSCTL_OFF + 320;
constexpr int RSTD_OFF = LDSCTL_OFF + 1024;
constexpr int LDS_BYTES = 155648;
constexpr int CW_BAR = 4096;
constexpr int CW_TMO2 = 8192, CW_CNT = 16384;
constexpr int EXL_OFF = 140288;
constexpr int NPHASE = 7;

struct Args { const float* in[18]; float* out; unsigned char* ws; int ph_lo, ph_hi; };

__global__ void __launch_bounds__(NWAVES * 64, 2) mega(Args args) {
    extern __shared__ __attribute__((aligned(16))) unsigned char lds[];
    LAS unsigned char* ldsp = (LAS unsigned char*)lds;
    volatile LAS unsigned* MISC = (volatile LAS unsigned*)(ldsp + MISC_OFF);
    const int wave = __builtin_amdgcn_readfirstlane((int)threadIdx.x >> 6);
#define PH_IDS() int lane = mk_lane(); asm volatile("" : "+v"(lane)); const int tid = wave * 64 + lane; (void)tid
    const int G = gridDim.x; const int bx = blockIdx.x; const int vcu = (G % 8 == 0) ? (bx % 8) * (G / 8) + bx / 8 : bx;
    unsigned char* ws = args.ws;
    gu32* ctl = (gu32*)(ws + WS_CTL);
    float* mod = (float*)(ws + WS_MOD); float* rope = (float*)(ws + WS_ROPE); float* SSQ = (float*)(ws + WS_SSQ); float* RPART = (float*)(ws + WS_RPART);
    bf16* bt1 = (bf16*)(ws + WS_BT1); bf16* bt2 = (bf16*)(ws + WS_BT2); float* DT = (float*)(ws + WS_DT); bf16* KB = (bf16*)(ws + WS_KB); bf16* VB = (bf16*)(ws + WS_VB);
    bf16* H = (bf16*)(ws + WS_R1); bf16* XC = (bf16*)(ws + WS_R1); bf16* XBC = (bf16*)(ws + WS_XBC); bf16* YQ = (bf16*)(ws + WS_YQ); bf16* Z = (bf16*)(ws + WS_Z);
    { PH_IDS(); for (int u = tid; u < (LDS_BYTES - LDSCTL_OFF) / 4; u += NWAVES * 64) ((LAS unsigned*)(ldsp + LDSCTL_OFF))[u] = 0u; }
    __syncthreads();
    const bool leader = wave == 0 && mk_lane() == 0; (void)leader;
    const int lo = args.ph_lo, hi = args.ph_hi;
    XcdBarrier bar; bar.bar = (unsigned*)(ctl + CW_BAR); bar.x = 0; bar.st = nullptr;
    if (hi - lo > 1) bar = xcd_barrier_post((unsigned*)(ctl + CW_BAR), MISC + 8, leader);
#ifndef DUP_MASK
#define DUP_MASK 0
#endif
#define IN(k) (lo <= (k) && (k) < hi)
#define REP(k) for (int rep_ = 0; rep_ < 1 + ((DUP_MASK >> (k)) & 1); ++rep_)
#define SEAM(k) do { if (IN(k) && IN((k) + 1)) xcd_barrier(bar, wave == 0 && mk_lane() == 0); } while (0)

    if (IN(0)) REP(0) {
        PH_IDS();
        LAS float* ldsf = (LAS float*)(ldsp + RING_OFF);
        if (bx < 48) p0_mod_block(args.in[1], args.in[3], args.in[4], args.in[5], mod, ldsf, bx, tid, lane, wave);
        else if (bx == 48) { for (int i = tid; i < 1024; i += NWAVES * 64) { const int p = i >> 4, f = i & 15; const float inv = powf(10000.f, -(float)f / 16.f); const float ang = (float)p * inv; rope[i] = cosf(ang); rope[1024 + i] = sinf(ang); } }
        LAS float* scr = ldsf + wave * (64 * 33);
        const int gw = ((bx + G - 49) % G) * NWAVES + wave, NGW = G * NWAVES;
        constexpr int I1 = 16 * 168, I2 = 32 * 32;
        for (int it = gw; it < I1 + I2; it += NGW) { if (it < I1) p0_bt1_item(args.in[7], bt1, scr, it, lane); else p0_bt2_item(args.in[16], args.in[15], bt2, scr, it - I1, lane); }
    }
    SEAM(0);
    if (IN(1)) REP(1) {
        PH_IDS();
        const int gw = bx * NWAVES + wave, NGW = G * NWAVES;
        static_assert(MT % (8 * 2048) == 0 || true, "row batches");
        {
            const int step = NGW * 4; int m0 = gw * 4;
            f32x4 va[4][4], vb[4][4];
            if (m0 < MT) p1_load4(va, args.in[0], args.in[2], m0, lane);
            while (m0 < MT) {
                if (m0 + step < MT) p1_load4(vb, args.in[0], args.in[2], m0 + step, lane);
                asm volatile("" ::: "memory");
                p1_proc4(va, mod, args.in[6], H, m0, lane);
                m0 += step; if (m0 >= MT) break;
                if (m0 + step < MT) p1_load4(va, args.in[0], args.in[2], m0 + step, lane);
                asm volatile("" ::: "memory");
                p1_proc4(vb, mod, args.in[6], H, m0, lane);
                m0 += step;
            }
        }
    }
    SEAM(1);

    if (IN(2)) REP(2) {
        pg8::Gemm g{H, bt1, MT, N1, 1024}; pg8::Sched1 S; S.init(G, bx);
        pg8::Epi1 E{KB, VB, XBC, YQ, Z, DT, rope, args.in[13], args.in[14], args.in[10], ldsp + RSTD_OFF};
#ifndef G1_PROBE
#define G1_PROBE 0
#endif
        if (G1_PROBE == 1) { pg8::EpiNull EN; pg8::gemm_phase<pg8::EpiNull, pg8::Sched1, true, true>(ldsp + RING_OFF, g, S, EN, wave); }
        if (G1_PROBE == 2) { pg8::EpiPlainReal EP{KB, VB, XBC, YQ, Z, DT}; pg8::gemm_phase<pg8::EpiPlainReal, pg8::Sched1, true, true>(ldsp + RING_OFF, g, S, EP, wave); }
        if (G1_PROBE == 3) { pg8::gemm_phase<pg8::Epi1, pg8::Sched1, true, true>(ldsp + RING_OFF, g, S, E, wave); }
        pg8::gemm_phase<pg8::Epi1, pg8::Sched1, true, true>(ldsp + RING_OFF, g, S, E, wave);
        { int ln_ = mk_lane(); asm volatile("" : "+v"(ln_)); ctx_dt_slice(H, bt1, args.in[10], DT, bx, G, wave, ln_); }
    }
    SEAM(2);
    if (IN(3)) {
        PH_IDS();
        float sbound;
        { float gq = fabsf(args.in[13][lane]), gk = fabsf(args.in[14][lane]);
#pragma unroll
          for (int o = 1; o < 64; o <<= 1) { gq = fmaxf(gq, __shfl_xor(gq, o)); gk = fmaxf(gk, __shfl_xor(gk, o)); }
          sbound = __uint_as_float(__builtin_amdgcn_readfirstlane(__float_as_uint(C2 * 64.f * gq * gk * 1.01f))); }
        const attn_body::Order S{vcu, G, false};
        const attn_body::Order S2{vcu, G, true};
#ifndef ATTN_SHADOW
#define ATTN_SHADOW 0
#endif
        if (ATTN_SHADOW) attn_body::attn_phase<8>((char*)lds + RING_OFF, (attn_body::bf16*)YQ, (const attn_body::bf16*)KB, (const attn_body::bf16*)VB, ATTN_SHADOW == 2 ? S2 : S, wave, sbound, (attn_body::bf16*)(ws + WS_END + 8 * MiB));
        attn_body::attn_phase<8>((char*)lds + RING_OFF, (attn_body::bf16*)YQ, (const attn_body::bf16*)KB, (const attn_body::bf16*)VB, S, wave, sbound);
        conv_phase(XBC, args.in[8], args.in[9], XC, bx, G, tid);
    }
    SEAM(3);
    if (IN(4)) REP(4) {
        PH_IDS();
#if defined(SSD_NAIVE)
        for (int it = bx; it < NB * 16; it += G) ssd_item_naive(it >> 4, it & 15, XC, DT, Z, args.in[11], args.in[12], YQ, SSQ, (LAS float*)(ldsp + RING_OFF), tid);
#else
#ifndef SSD_SHADOW
#define SSD_SHADOW 0
#endif
        if (SSD_SHADOW) { bf16* dY = (bf16*)(ws + WS_END); float* dS = (float*)(ws + WS_END + 2 * MiB);
            for (int it = vcu; it < NB * 16; it += G) ssd::ssd_item<SSD_SHADOW>(it >> 4, it & 15, XC, DT, Z, args.in[11], args.in[12], dY, dS, ldsp, tid, lane, wave); }
#ifndef SSD_PAIR
#define SSD_PAIR 1
#endif
        if (SSD_PAIR) { for (int it = vcu; it < NB * 8; it += G) { int ln_ = mk_lane(); asm volatile("" : "+v"(ln_)); ssd::pr::ssd_pair(it >> 3, it & 7, XC, DT, Z, args.in[11], args.in[12], YQ, SSQ, ldsp, wave * 64 + ln_, ln_, wave); } }
        else for (int it = vcu; it < NB * 16; it += G) ssd::ssd_item<0>(it >> 4, it & 15, XC, DT, Z, args.in[11], args.in[12], YQ, SSQ, ldsp, tid, lane, wave);
#endif
    }
    SEAM(4);

    if (IN(5)) REP(5) {
        PH_IDS();
        pg8::Sched2 S; S.init(G, bx);
        LAS float* rt = (LAS float*)(ldsp + RSTD_OFF);
        { pg8::Unit u; for (int i = 0; i < 4 && S.next(i, u); ++i) if (tid < 256) { const float* q = SSQ + ((size_t)u.pm * 256 + tid) * 16; float s = 0.f;
#pragma unroll
                for (int j = 0; j < 16; ++j) s += q[j];
                rt[i * 256 + tid] = rsqrtf(s * (1.f / 1024.f) + EPS); } }
        __syncthreads();
        pg8::Gemm g{YQ, bt2, ML, 1024, 2048};
        pg8::Epi2 E{args.in[0], mod, args.in[17], args.out, (unsigned long long*)RPART, (unsigned*)(ctl + CW_CNT), (unsigned*)(ctl + CW_TMO2), (const LAS float*)rt, (LAS float*)(ldsp + EXL_OFF)};
        pg8::gemm_phase<pg8::Epi2, pg8::Sched2, true, true>(ldsp + RING_OFF, g, S, E, wave);
    }

#undef IN
#undef SEAM
}

extern "C" void kernel_launch(void* const* d_in, const int* in_sizes, int n_in, void* d_out, int out_size, void* d_ws, size_t ws_size, hipStream_t stream) {
    if (n_in != 18 || out_size != ML * DM || ws_size < WS_END) { fprintf(stderr, "kernel_launch: unexpected shapes (n_in %d out %d ws %zu); nothing launched\n", n_in, out_size, ws_size); return; }
    static int grid = 0;
    if (grid == 0) {
        int dev = 0, cus = 0;
        if (hipGetDevice(&dev) != hipSuccess || hipDeviceGetAttribute(&cus, hipDeviceAttributeMultiprocessorCount, dev) != hipSuccess) { fprintf(stderr, "kernel_launch: device query failed\n"); grid = -1; return; }
        if (hipFuncSetAttribute((const void*)mega, hipFuncAttributeMaxDynamicSharedMemorySize, LDS_BYTES) != hipSuccess) { fprintf(stderr, "kernel_launch: hipFuncSetAttribute failed\n"); grid = -1; return; }
        int per_cu = 0;
        if (hipOccupancyMaxActiveBlocksPerMultiprocessor(&per_cu, (const void*)mega, NWAVES * 64, LDS_BYTES) != hipSuccess || per_cu < 1) fprintf(stderr, "kernel_launch: note: occupancy query says %d blocks/CU\n", per_cu);
        (void)hipGetLastError();
        grid = cus;
    }
    if (grid < 0) return;
    (void)hipMemsetAsync((unsigned char*)d_ws + WS_CTL, 0, 1 * MiB, stream);
    Args a{};
    for (int i = 0; i < 18; ++i) a.in[i] = (const float*)d_in[i];
    a.out = (float*)d_out; a.ws = (unsigned char*)d_ws; a.ph_lo = 0; a.ph_hi = NPHASE;
    hipLaunchKernelGGL(mega, dim3(grid), dim3(NWAVES * 64), LDS_BYTES, stream, a);
    const hipError_t le = hipPeekAtLastError(); if (le != hipSuccess) fprintf(stderr, "kernel_launch: launch failed: %s\n", hipGetErrorName(le));
}
```
